# Optimizing an MI355X kernel written in HIP

```python
import jax, jax.numpy as jnp
from jax import lax
import numpy as np

D_MODEL = 2048
BATCH = 4
SEQ = 2048
DEPTH = 4

HEAD_DIM = 128
N_HEADS = D_MODEL // HEAD_DIM
BRANCH_WIDTH = N_HEADS * HEAD_DIM
DSWA_PATTERNS = ((128, 1), (512, 4), (2048, 16))
N_GROUPS = 3
DSWA_QBLOCK = 128
MOBA_BLOCK = 256
MOBA_TOPK = 3
MOBA_QCHUNK = 16
N_MIXERS = 2
N_A = (DEPTH + 1) // 2
N_B = DEPTH // 2
A_IN_WIDTH = (3 * N_GROUPS + 1) * BRANCH_WIDTH
B_IN_WIDTH = 4 * BRANCH_WIDTH
EPS = 1e-6
NEG = -1e30

kernel_name = "hybrid_dilated_moba_adaln_trunk"


def rms_norm(x, w):
    xf = x.astype(jnp.float32)
    y = xf * lax.rsqrt(jnp.mean(xf * xf, axis=-1, keepdims=True) + EPS) * w.astype(jnp.float32)
    return y.astype(x.dtype)


def alibi_slopes(n):
    return jnp.exp2(-8.0 * jnp.arange(1, n + 1, dtype=jnp.float32) / n)


def dilated_window_attention(q, k, v, window, dilation, slopes):
    B, S, H, Dh = q.shape
    steps = window // dilation
    QB = DSWA_QBLOCK
    L = S // dilation
    nq = -(-L // QB)
    Lp = nq * QB

    def to_residue(a):
        a = a.reshape(B, L, dilation, H, Dh).transpose(0, 2, 1, 3, 4)
        return jnp.pad(a, ((0, 0), (0, 0), (0, Lp - L), (0, 0), (0, 0)))

    def band(a):
        cur = a.reshape(B, dilation, nq, QB, H, Dh)
        prev = jnp.pad(a, ((0, 0), (0, 0), (QB, 0), (0, 0), (0, 0)))[:, :, :Lp]
        prev = prev.reshape(B, dilation, nq, QB, H, Dh)
        return jnp.concatenate([prev, cur], axis=3)

    qr, kr, vr = to_residue(q), to_residue(k), to_residue(v)
    qb = qr.reshape(B, dilation, nq, QB, H, Dh)
    kw, vw = band(kr), band(vr)
    s = jnp.einsum('brnqhd,brnkhd->brnhqk', qb, kw).astype(jnp.float32) * (Dh ** -0.5)
    qi = jnp.arange(QB)[:, None]
    ki = jnp.arange(2 * QB)[None, :]
    step = qi + QB - ki
    key_l = jnp.arange(nq)[:, None, None] * QB + ki[None] - QB
    ok = ((step >= 0) & (step <= steps))[None] & (key_l >= 0)
    bias = -slopes[:, None, None] * (step * dilation).astype(jnp.float32)
    s = jnp.where(ok[:, None], s + bias, NEG)
    lse = jax.nn.logsumexp(s, axis=-1)
    p = jnp.exp(s - lse[..., None]).astype(v.dtype)
    o = jnp.einsum('brnhqk,brnkhd->brnqhd', p, vw)

    def from_residue(a):
        tail = a.shape[4:]
        a = a.reshape((B, dilation, Lp) + tail)[:, :, :L]
        a = jnp.moveaxis(a, 1, 2)
        return a.reshape((B, S) + tail)

    return from_residue(o), from_residue(jnp.swapaxes(lse, 3, 4))


def dilated_mixer(h, w_in, slopes):
    B, S, _ = h.shape
    parts = jnp.split(h @ w_in, 3 * N_GROUPS + 1, axis=-1)
    heads = lambda a: a.reshape(B, S, N_HEADS, HEAD_DIM)
    outs, lses = [], []
    for g, (window, dilation) in enumerate(DSWA_PATTERNS):
        o, lse = dilated_window_attention(heads(parts[3 * g]), heads(parts[3 * g + 1]),
                                          heads(parts[3 * g + 2]), window, dilation, slopes)
        outs.append(o)
        lses.append(lse)
    alpha = jax.nn.softmax(jnp.stack(lses), axis=0)
    o = jnp.einsum('gbsh,gbshd->bshd', alpha, jnp.stack(outs).astype(jnp.float32))
    return o.reshape(B, S, BRANCH_WIDTH).astype(h.dtype) * jax.nn.silu(parts[-1])


def moba_attention(q, k, v, slopes):
    B, S, H, Dh = q.shape
    BLK = MOBA_BLOCK
    nblk = -(-S // BLK)
    Sp = nblk * BLK
    q, k, v = [jnp.pad(a, ((0, 0), (0, Sp - S), (0, 0), (0, 0))).transpose(0, 2, 1, 3)
               for a in (q, k, v)]
    scale = Dh ** -0.5
    qb = q.reshape(B, H, nblk, BLK, Dh)
    kb = k.reshape(B, H, nblk, BLK, Dh)
    vb = v.reshape(B, H, nblk, BLK, Dh)

    s = jnp.einsum('bhnqd,bhnkd->bhnqk', qb, kb).astype(jnp.float32) * scale
    dist = jnp.arange(BLK)[:, None] - jnp.arange(BLK)[None, :]
    s = jnp.where(dist >= 0, s - slopes[:, None, None, None] * dist.astype(jnp.float32), NEG)
    lse_own = jax.nn.logsumexp(s, axis=-1)
    o_own = jnp.einsum('bhnqk,bhnkd->bhnqd', jnp.exp(s - lse_own[..., None]).astype(v.dtype), vb)
    lse_own = lse_own.reshape(B, H, Sp)
    o_own = o_own.reshape(B, H, Sp, Dh).astype(jnp.float32)

    n_sel = min(MOBA_TOPK, nblk - 1)
    if n_sel == 0:
        o = o_own
    else:
        pos = jnp.arange(Sp)
        qblk = pos // BLK
        kmean = kb.astype(jnp.float32).mean(axis=3).astype(kb.dtype)
        gate = jnp.einsum('bhtd,bhnd->bhtn', q, kmean).astype(jnp.float32)
        past = jnp.arange(nblk)[None, :] < qblk[:, None]
        gate = jnp.where(past, gate, NEG)
        _, idx = lax.top_k(gate, n_sel)
        valid = jnp.arange(n_sel)[None, :] < qblk[:, None]

        QC = MOBA_QCHUNK
        nC = Sp // QC
        q_c = jnp.moveaxis(q.reshape(B, H, nC, QC, Dh), 2, 0)
        i_c = jnp.moveaxis(idx.reshape(B, H, nC, QC, n_sel), 2, 0)
        t_c = pos.reshape(nC, QC)
        v_c = valid.reshape(nC, QC, n_sel)
        bi = jnp.arange(B)[:, None, None, None]
        hi = jnp.arange(H)[None, :, None, None]

        def attend(args):
            qc, ic, tc, vc = args
            kg = kb[bi, hi, ic]
            vg = vb[bi, hi, ic]
            sc = jnp.einsum('bhqd,bhqnkd->bhqnk', qc, kg).astype(jnp.float32) * scale
            kpos = ic[..., None] * BLK + jnp.arange(BLK)
            dd = (tc[:, None, None] - kpos).astype(jnp.float32)
            sc = jnp.where(vc[:, :, None], sc - slopes[:, None, None, None] * dd, NEG)
            sc = sc.reshape(B, H, QC, n_sel * BLK)
            lse = jax.nn.logsumexp(sc, axis=-1)
            p = jnp.exp(sc - lse[..., None]).astype(v.dtype).reshape(B, H, QC, n_sel, BLK)
            return jnp.einsum('bhqnk,bhqnkd->bhqd', p, vg), lse

        o_sel, lse_sel = lax.map(attend, (q_c, i_c, t_c, v_c))
        o_sel = jnp.moveaxis(o_sel, 0, 2).reshape(B, H, Sp, Dh).astype(jnp.float32)
        lse_sel = jnp.moveaxis(lse_sel, 0, 2).reshape(B, H, Sp)
        m = jnp.logaddexp(lse_own, lse_sel)
        o = (jnp.exp(lse_own - m)[..., None] * o_own
             + jnp.exp(lse_sel - m)[..., None] * o_sel)
    return o.transpose(0, 2, 1, 3)[:, :S]


def moba_mixer(h, w_in, slopes):
    B, S, _ = h.shape
    q, k, v, z = jnp.split(h @ w_in, 4, axis=-1)
    heads = lambda a: a.reshape(B, S, N_HEADS, HEAD_DIM)
    o = moba_attention(heads(q), heads(k), heads(v), slopes)
    return o.reshape(B, S, BRANCH_WIDTH).astype(h.dtype) * jax.nn.silu(z)


def setup_inputs(seed: int = 0) -> dict:
    key = jax.random.key(seed)
    ks = jax.random.split(key, 10)
    f32 = jnp.float32
    x = jax.random.normal(ks[0], (BATCH, SEQ, D_MODEL), f32)
    c = jax.random.normal(ks[1], (BATCH, D_MODEL), f32)
    norm_w = 1.0 + 0.02 * jax.random.normal(ks[2], (DEPTH, D_MODEL), f32)
    mod_w = jax.random.normal(ks[3], (DEPTH, D_MODEL, 3 * D_MODEL), f32) * (0.5 * D_MODEL ** -0.5)
    mod_b = 0.02 * jax.random.normal(ks[4], (DEPTH, 3 * D_MODEL), f32)
    a_w_in = jax.random.normal(ks[5], (N_A, D_MODEL, A_IN_WIDTH), f32) * D_MODEL ** -0.5
    a_w_out = jax.random.normal(ks[6], (N_A, BRANCH_WIDTH, D_MODEL), f32) * BRANCH_WIDTH ** -0.5
    b_w_in = jax.random.normal(ks[7], (N_B, D_MODEL, B_IN_WIDTH), f32) * D_MODEL ** -0.5
    b_w_out = jax.random.normal(ks[8], (N_B, BRANCH_WIDTH, D_MODEL), f32) * BRANCH_WIDTH ** -0.5
    final_norm_w = 1.0 + 0.02 * jax.random.normal(ks[9], (D_MODEL,), f32)
    return {"x": x, "c": c, "norm_w": norm_w, "mod_w": mod_w, "mod_b": mod_b,
            "a_w_in": a_w_in, "a_w_out": a_w_out, "b_w_in": b_w_in, "b_w_out": b_w_out,
            "final_norm_w": final_norm_w}


def reference(x, c, norm_w, mod_w, mod_b, a_w_in, a_w_out, b_w_in, b_w_out, final_norm_w):
    slopes = alibi_slopes(N_HEADS)
    cond = jax.nn.silu(c)
    for i in range(DEPTH):
        mod = cond @ mod_w[i] + mod_b[i]
        shift, scale, gate = jnp.split(mod[:, None, :], 3, axis=-1)
        h = rms_norm(x, norm_w[i]) * (1.0 + scale) + shift
        j = i // N_MIXERS
        if i % N_MIXERS == 0:
            y = dilated_mixer(h, a_w_in[j], slopes) @ a_w_out[j]
        else:
            y = moba_mixer(h, b_w_in[j], slopes) @ b_w_out[j]
        x = x + gate * y
    return rms_norm(x, final_norm_w)
```

```cpp
#include <hip/hip_runtime.h>
#include <hip/hip_cooperative_groups.h>
#include <cstdio>
#include <cstdint>
namespace cg = cooperative_groups;

#define LAS __attribute__((address_space(3)))
typedef unsigned short bf16_t;
typedef short bf16x8 __attribute__((ext_vector_type(8)));
typedef short s16x4 __attribute__((ext_vector_type(4)));
typedef float f32x4 __attribute__((ext_vector_type(4)));
typedef float f32x16 __attribute__((ext_vector_type(16)));
typedef unsigned u32x4 __attribute__((ext_vector_type(4)));
typedef unsigned u32x2 __attribute__((ext_vector_type(2)));

constexpr int NB = 4, SEQ = 2048, DM = 2048, MTOK = NB * SEQ, NH = 16, HD = 128, DEPTH = 4;
constexpr int A_N = 10 * DM, B_N = 4 * DM;
constexpr float EPS = 1e-6f;
constexpr float LOG2E = 1.4426950408889634f;
constexpr float C2Q = 0.08838834764831845f * LOG2E;

constexpr size_t MiB = 1u << 20;
constexpr size_t WS_CTL = 0;
constexpr size_t WS_MOD = 1 * MiB;
constexpr size_t WS_KSUM = 2 * MiB;
constexpr size_t WS_LSE = 3 * MiB;
constexpr size_t WS_WAIN = 8 * MiB;
constexpr size_t WS_WBIN = WS_WAIN + 160 * MiB;
constexpr size_t WS_WAOUT = WS_WBIN + 64 * MiB;
constexpr size_t WS_WBOUT = WS_WAOUT + 16 * MiB;
constexpr size_t WS_H = WS_WBOUT + 16 * MiB;
constexpr size_t WS_G = WS_H + 32 * MiB;
constexpr size_t WS_QKV = WS_G + 32 * MiB;
constexpr size_t WS_Z = WS_QKV + 288 * MiB;
constexpr size_t WS_OG = WS_Z + 32 * MiB;
constexpr size_t WS_END = WS_OG + 96 * MiB;
constexpr size_t PART = (size_t)MTOK * DM;

constexpr int LDS_BYTES = 147456;
constexpr int NTHREADS = 512;

__device__ __forceinline__ unsigned cvt_pk_bf16(float lo, float hi) { unsigned r; asm volatile("v_cvt_pk_bf16_f32 %0, %1, %2" : "=v"(r) : "v"(lo), "v"(hi)); return r; }
__device__ __forceinline__ float bf2f(unsigned short v) { return __uint_as_float(((unsigned)v) << 16); }
__device__ __forceinline__ float bflo(unsigned w) { return __uint_as_float(w << 16); }
__device__ __forceinline__ float bfhi(unsigned w) { return __uint_as_float(w & 0xffff0000u); }
__device__ __forceinline__ float wave_sum(float v) {
#pragma unroll
    for (int o = 1; o < 64; o <<= 1) v += __shfl_xor(v, o);
    return v;
}
__device__ __forceinline__ float wave_max(float v) {
#pragma unroll
    for (int o = 1; o < 64; o <<= 1) v = fmaxf(v, __shfl_xor(v, o));
    return v;
}
__device__ __forceinline__ float silu_f(float v) { return v / (1.f + __expf(-v)); }
#define LDS_WAIT() asm volatile("s_waitcnt lgkmcnt(0)" ::: "memory")
__device__ __forceinline__ int otid() { int t = threadIdx.x; asm volatile("" : "+v"(t)); return t; }
template <class T> __device__ __forceinline__ T* optr(T* p) { asm volatile("" : "+s"(p)); return p; }

namespace pg8 {
constexpr int BM = 256, BK = 64, HALF = 128, HTB = HALF * BK * 2, STAGE_BYTES = 8 * HTB, NXCD = 8, WGM = 8;
__host__ __device__ __forceinline__ int lds_byte(int r, int c) { const int st = (r >> 4) * 2 + (c >> 5), rr = r & 15, cc = c & 31, ob = rr * 64 + cc * 2; return st * 1024 + (ob ^ (((ob >> 9) & 1) << 5)); }
__host__ __device__ __forceinline__ void stage_rc(int b, int& R, int& C) { const int st = b / 1024, sb = b % 1024, swz = sb ^ (((sb >> 9) & 1) << 5); R = (st >> 1) * 16 + swz / 64; C = (st & 1) * 32 + (swz % 64) / 2; }
__host__ __device__ __forceinline__ int perm32(int rho) { const int n = rho >> 4, i = rho & 15; return 8 * (i >> 2) + 4 * n + (i & 3); }
struct Unit { int pm, pn; };
struct Gemm { const bf16_t* A; const bf16_t* Bt; int M, N, K; };
struct StaticOrder {
    int nM, nN, nwg, G, c;
    __host__ __device__ void init(int M, int N, int G_, int c_) { nM = M / BM; nN = N / BM; nwg = nM * nN; G = G_; c = c_; }
    __host__ __device__ bool next(int i, Unit& u) const {
        const long L = (long)i * G + c; if (L >= nwg) return false;
        int wgid = (int)L; { const int q = nwg / NXCD, r = nwg % NXCD, xcd = wgid % NXCD, off = wgid / NXCD; wgid = (xcd < r ? xcd * (q + 1) : r * (q + 1) + (xcd - r) * q) + off; }
        const int nig = WGM * nN, gid = wgid / nig, fm = gid * WGM, gsz = (nM - fm) < WGM ? (nM - fm) : WGM;
        u.pm = fm + ((wgid % nig) % gsz); u.pn = (wgid % nig) / gsz; return true;
    }
    __device__ __forceinline__ void a_ready(const Unit&) const {}
    __device__ __forceinline__ void done(const Unit&) const {}
};

struct Epi {
    static constexpr bool PERM = true, AFTER_DRAIN = false;
    int mode;
    bf16_t* qkv; bf16_t* zbuf; float* ksum;
    const float* xin; float* xout; const float* gate;
    __device__ __forceinline__ void operator()(const f32x4 (&acc)[2][2][4][2], const Unit& u, int wr, int wc, int fr, int fq) const {
        if (mode == 2) {
            const int col0 = u.pn * BM + wc * 32 + 8 * fq; const int b = (u.pm * BM) >> 11;
            f32x4 gv[2][2];
#pragma unroll
            for (int bj = 0; bj < 2; ++bj)
#pragma unroll
                for (int n = 0; n < 2; ++n) gv[bj][n] = *(const f32x4*)(gate + b * 6144 + col0 + bj * HALF + 4 * n);
#pragma unroll
            for (int ai = 0; ai < 2; ++ai)
#pragma unroll
                for (int m = 0; m < 4; ++m) { const size_t off = (size_t)(u.pm * BM + ai * HALF + wr * 64 + m * 16 + fr) * DM + col0;
#pragma unroll
                    for (int bj = 0; bj < 2; ++bj)
#pragma unroll
                        for (int n = 0; n < 2; ++n) { const f32x4 xv = *(const f32x4*)(xin + off + bj * HALF + 4 * n);
                            *(f32x4*)(xout + off + bj * HALF + 4 * n) = xv + gv[bj][n] * acc[ai][bj][m][n]; }
                    asm volatile("" ::: "memory"); }
            return;
        }
        const int p = u.pn >> 3, colt = (u.pn & 7) * BM;
        int lg = 0; float sc = 1.f; bf16_t* base;
        if (mode == 0) { if (p == 9) base = zbuf; else { const int g = p / 3, kind = p - 3 * g; lg = 2 * g; base = qkv + (size_t)p * PART; if (kind == 0) sc = C2Q; } }
        else { if (p == 3) base = zbuf; else { base = qkv + (size_t)p * PART; if (p == 0) sc = C2Q; } }
        const int col0 = colt + wc * 32 + 8 * fq;
#pragma unroll
        for (int ai = 0; ai < 2; ++ai)
#pragma unroll
            for (int m = 0; m < 4; ++m) {
                const int row = u.pm * BM + ai * HALF + wr * 64 + m * 16 + fr, b = row >> 11, t = row & 2047;
                const int R = (b << 11) + ((t & ((1 << lg) - 1)) << (11 - lg)) + (t >> lg);
                bf16_t* rowp = base + (size_t)R * DM + col0;
#pragma unroll
                for (int bj = 0; bj < 2; ++bj) { const f32x4 v0 = acc[ai][bj][m][0] * sc, v1 = acc[ai][bj][m][1] * sc;
                    u32x4 w; w.x = cvt_pk_bf16(v0[0], v0[1]); w.y = cvt_pk_bf16(v0[2], v0[3]); w.z = cvt_pk_bf16(v1[0], v1[1]); w.w = cvt_pk_bf16(v1[2], v1[3]);
                    *(u32x4*)(rowp + bj * HALF) = w; } }
        if (mode == 1 && p == 1) {
#pragma unroll
            for (int bj = 0; bj < 2; ++bj)
#pragma unroll
                for (int n = 0; n < 2; ++n) { f32x4 s = {0.f, 0.f, 0.f, 0.f};
#pragma unroll
                    for (int ai = 0; ai < 2; ++ai)
#pragma unroll
                        for (int m = 0; m < 4; ++m) s += acc[ai][bj][m][n];
#pragma unroll
                    for (int j = 0; j < 4; ++j) { float v = s[j]; v += __shfl_xor(v, 1); v += __shfl_xor(v, 2); v += __shfl_xor(v, 4); v += __shfl_xor(v, 8); s[j] = v; }
                    if (fr == 0) *(f32x4*)(ksum + ((size_t)(wr * 32 + u.pm) * DM + colt + bj * HALF + wc * 32 + 8 * fq + 4 * n)) = s; }
        }
    }
};

template <class Epi, class Sched, bool ALIGN_EPI = false, bool SP2 = false>
__device__ __forceinline__ void gemm_phase(LAS unsigned char* lds, const Gemm g, const Sched& S, const Epi& E) {
    const int tid = otid(), wid = __builtin_amdgcn_readfirstlane(tid >> 6), lane = tid & 63, wr = wid >> 2, wc = wid & 3, fr = lane & 15, fq = lane >> 4;
    const int K = g.K, nt = K / BK;
    unsigned voffA[2], voffB[2];
#pragma unroll
    for (int i = 0; i < 2; ++i) { int R, C; stage_rc(tid * 16 + i * 8192, R, C); const int Rb = Epi::PERM ? ((R & ~31) + perm32(R & 31)) : R;
        voffA[i] = (unsigned)(R * K + C) * 2u; voffB[i] = (unsigned)(Rb * K + C) * 2u; }
    const size_t kstep = (size_t)(BK * 2);
    const size_t hstep = (size_t)HALF * K * 2;
    const size_t tstep = 2 * hstep;
    const unsigned ldsw = (unsigned)wid * 1024u;
    const int aoff = lds_byte(wr * 64 + fr, fq * 8), boff = lds_byte(wc * 32 + fr, fq * 8);
#define PG8_SA(b, h) (((b) * 2 + (h)) * HTB)
#define PG8_SB(b, h) ((4 + (b) * 2 + (h)) * HTB)
#define PG8_STAGE(bufoff, gbase, voff) do { _Pragma("unroll") for (int _i = 0; _i < 2; ++_i) \
        __builtin_amdgcn_global_load_lds((const unsigned*)((const char*)(gbase) + (voff)[_i]), (LAS unsigned*)(lds + (bufoff) + ldsw + _i * 8192), 16, 0, 0); } while (0)
#define PG8_LDA(dst, b, h) do { _Pragma("unroll") for (int m = 0; m < 4; ++m) _Pragma("unroll") for (int k = 0; k < 2; ++k) dst[m][k] = *(const LAS bf16x8*)(lds + PG8_SA(b, h) + aoff + m * 2048 + k * 1024); } while (0)
#define PG8_LDB(dst, b, h) do { _Pragma("unroll") for (int n = 0; n < 2; ++n) _Pragma("unroll") for (int k = 0; k < 2; ++k) dst[n][k] = *(const LAS bf16x8*)(lds + PG8_SB(b, h) + boff + n * 2048 + k * 1024); } while (0)
#define PG8_MMA(ai, bj, At, Bt) do { __builtin_amdgcn_s_setprio(1); _Pragma("unroll") for (int m = 0; m < 4; ++m) _Pragma("unroll") for (int n = 0; n < 2; ++n) _Pragma("unroll") for (int k = 0; k < 2; ++k) \
        acc[ai][bj][m][n] = __builtin_amdgcn_mfma_f32_16x16x32_bf16(Bt[n][k], At[m][k], acc[ai][bj][m][n], 0, 0, 0); __builtin_amdgcn_s_setprio(0); } while (0)
#define PG8_WAIT_V(n) asm volatile("s_waitcnt vmcnt(" #n ")" ::: "memory")
#define PG8_WAIT_L(n) asm volatile("s_waitcnt lgkmcnt(" #n ")" ::: "memory")
#define PG8_BAR __builtin_amdgcn_s_barrier()
#define PG8_SCHED __builtin_amdgcn_sched_barrier(0)
    Unit cur, nxt; int ui = 0;
    if (!S.next(0, cur)) return;
    f32x4 acc[2][2][4][2];
#pragma unroll
    for (int a = 0; a < 2; ++a)
#pragma unroll
        for (int b = 0; b < 2; ++b)
#pragma unroll
            for (int m = 0; m < 4; ++m)
#pragma unroll
                for (int n = 0; n < 2; ++n) acc[a][b][m][n] = (f32x4){0.f, 0.f, 0.f, 0.f};
    bf16x8 At[4][2], B0[2][2], B1[2][2];
    const char* cA = (const char*)g.A + (size_t)cur.pm * tstep; const char* cB = (const char*)g.Bt + (size_t)cur.pn * tstep;
    S.a_ready(cur);
    if constexpr (SP2) {
        PG8_STAGE(PG8_SB(0, 0), cB, voffB); PG8_STAGE(PG8_SB(0, 1), cB + hstep, voffB); PG8_STAGE(PG8_SA(0, 0), cA, voffA); PG8_STAGE(PG8_SA(0, 1), cA + hstep, voffA);
        if (wr == 1) PG8_BAR;
        PG8_WAIT_V(2); PG8_BAR;
        PG8_STAGE(PG8_SB(1, 0), cB + kstep, voffB); PG8_STAGE(PG8_SA(1, 0), cA + kstep, voffA); PG8_STAGE(PG8_SB(1, 1), cB + hstep + kstep, voffB);
        PG8_WAIT_V(6); PG8_BAR;
    } else {
        PG8_STAGE(PG8_SB(0, 0), cB, voffB); PG8_STAGE(PG8_SA(0, 0), cA, voffA); PG8_STAGE(PG8_SB(0, 1), cB + hstep, voffB); PG8_STAGE(PG8_SA(0, 1), cA + hstep, voffA);
        if (wr == 1) PG8_BAR;
        PG8_WAIT_V(4); PG8_BAR;
        PG8_STAGE(PG8_SB(1, 0), cB + kstep, voffB); PG8_STAGE(PG8_SA(1, 0), cA + kstep, voffA); PG8_STAGE(PG8_SB(1, 1), cB + hstep + kstep, voffB);
        PG8_WAIT_V(6); PG8_BAR;
    }
    for (;;) {
        const bool has_next = S.next(ui + 1, nxt);
        const char* nA = has_next ? (const char*)g.A + (size_t)nxt.pm * tstep : cA; const char* nB = has_next ? (const char*)g.Bt + (size_t)nxt.pn * tstep : cB;
        for (int t = 0; t < nt; t += 2) {
            const bool last = (t == nt - 2);
            const char* a1 = cA + (size_t)(t + 1) * kstep;
            const char* a2 = last ? nA : cA + (size_t)(t + 2) * kstep; const char* b2 = last ? nB : cB + (size_t)(t + 2) * kstep;
            const char* a3 = a2 + kstep; const char* b3 = b2 + kstep;
            if (last && has_next) S.a_ready(nxt);
            if constexpr (SP2) {
            PG8_LDB(B0, 0, 0); PG8_LDB(B1, 0, 1); PG8_SCHED; PG8_LDA(At, 0, 0); PG8_STAGE(PG8_SA(1, 1), a1 + hstep, voffA);
            PG8_WAIT_V(8); PG8_WAIT_L(0); PG8_BAR; PG8_MMA(0, 0, At, B0); PG8_MMA(0, 1, At, B1); PG8_BAR; PG8_SCHED;
            PG8_LDA(At, 0, 1); PG8_STAGE(PG8_SB(0, 0), b2, voffB); PG8_STAGE(PG8_SB(0, 1), b2 + hstep, voffB); PG8_STAGE(PG8_SA(0, 0), a2, voffA);
            PG8_WAIT_V(8); PG8_WAIT_L(0); PG8_BAR; PG8_MMA(1, 0, At, B0); PG8_MMA(1, 1, At, B1); PG8_BAR; PG8_SCHED;
            PG8_LDB(B0, 1, 0); PG8_LDB(B1, 1, 1); PG8_SCHED; PG8_LDA(At, 1, 0); PG8_STAGE(PG8_SA(0, 1), a2 + hstep, voffA);
            PG8_WAIT_V(8); PG8_WAIT_L(0); PG8_BAR; PG8_MMA(0, 0, At, B0); PG8_MMA(0, 1, At, B1); PG8_BAR; PG8_SCHED;
            PG8_LDA(At, 1, 1); PG8_STAGE(PG8_SB(1, 0), b3, voffB); PG8_STAGE(PG8_SB(1, 1), b3 + hstep, voffB); PG8_STAGE(PG8_SA(1, 0), a3, voffA);
            PG8_WAIT_V(8); PG8_WAIT_L(0); PG8_BAR; PG8_MMA(1, 0, At, B0); PG8_MMA(1, 1, At, B1); PG8_BAR; PG8_SCHED;
            } else {
            PG8_LDB(B0, 0, 0); PG8_SCHED; PG8_LDA(At, 0, 0); PG8_STAGE(PG8_SA(1, 1), a1 + hstep, voffA);
            PG8_WAIT_L(8); PG8_BAR; PG8_WAIT_L(0); PG8_MMA(0, 0, At, B0); PG8_BAR; PG8_SCHED;
            PG8_LDB(B1, 0, 1); PG8_STAGE(PG8_SB(0, 0), b2, voffB);
            PG8_BAR; PG8_WAIT_L(0); PG8_MMA(0, 1, At, B1); PG8_BAR;
            PG8_LDA(At, 0, 1); PG8_STAGE(PG8_SA(0, 0), a2, voffA);
            PG8_BAR; PG8_WAIT_L(0); PG8_MMA(1, 0, At, B0); PG8_BAR; PG8_SCHED;
            PG8_STAGE(PG8_SB(0, 1), b2 + hstep, voffB);
            PG8_WAIT_V(6); PG8_BAR; PG8_MMA(1, 1, At, B1); PG8_BAR;
            PG8_LDB(B0, 1, 0); PG8_SCHED; PG8_LDA(At, 1, 0); PG8_STAGE(PG8_SA(0, 1), a2 + hstep, voffA);
            PG8_WAIT_L(8); PG8_BAR; PG8_WAIT_L(0); PG8_MMA(0, 0, At, B0); PG8_BAR; PG8_SCHED;
            PG8_LDB(B1, 1, 1); PG8_STAGE(PG8_SB(1, 0), b3, voffB);
            PG8_BAR; PG8_WAIT_L(0); PG8_MMA(0, 1, At, B1); PG8_BAR;
            PG8_LDA(At, 1, 1); PG8_STAGE(PG8_SA(1, 0), a3, voffA);
            PG8_BAR; PG8_WAIT_L(0); PG8_MMA(1, 0, At, B0); PG8_BAR; PG8_SCHED;
            PG8_STAGE(PG8_SB(1, 1), b3 + hstep, voffB);
            PG8_WAIT_V(6); PG8_BAR; PG8_MMA(1, 1, At, B1); PG8_BAR;
            }
        }
        if constexpr (ALIGN_EPI) { if (wr == 0) PG8_BAR; }
        if constexpr (!Epi::AFTER_DRAIN) { E(acc, cur, wr, wc, fr, fq); S.done(cur); }
        if (!has_next) break;
#pragma unroll
        for (int a = 0; a < 2; ++a)
#pragma unroll
            for (int b = 0; b < 2; ++b)
#pragma unroll
                for (int m = 0; m < 4; ++m)
#pragma unroll
                    for (int n = 0; n < 2; ++n) acc[a][b][m][n] = (f32x4){0.f, 0.f, 0.f, 0.f};
        cur = nxt; cA = nA; cB = nB; ++ui;
        if constexpr (ALIGN_EPI) { if (wr == 1) PG8_BAR; }
    }
    PG8_WAIT_V(0);
    if constexpr (!ALIGN_EPI) { if (wr == 0) PG8_BAR; }
    PG8_BAR;
#undef PG8_SA
#undef PG8_SB
#undef PG8_STAGE
#undef PG8_LDA
#undef PG8_LDB
#undef PG8_MMA
#undef PG8_WAIT_V
#undef PG8_WAIT_L
#undef PG8_BAR
#undef PG8_SCHED
}
}

struct Params {
    const float *x, *c, *norm_w, *mod_w, *mod_b, *a_w_in, *a_w_out, *b_w_in, *b_w_out, *final_w;
    float* out; unsigned char* ws;
};

__device__ __forceinline__ void p0_mod(const Params& P, unsigned char* lds) {
    const int tid = otid();
    f32x4* condT = (f32x4*)lds;
    float* red = (float*)(lds + 32768);
    float* MOD = (float*)(P.ws + WS_MOD);
    bool have = false;
    for (int item = blockIdx.x; item < 192; item += gridDim.x) {
        if (!have) { have = true;
            for (int k = tid; k < DM; k += NTHREADS) { f32x4 v; v.x = silu_f(P.c[k]); v.y = silu_f(P.c[DM + k]); v.z = silu_f(P.c[2 * DM + k]); v.w = silu_f(P.c[3 * DM + k]); condT[k] = v; }
            __syncthreads(); }
        const int l = item / 48, n0 = (item % 48) * 128, cq = tid & 31, kp = tid >> 5;
        f32x4 a0 = {0.f, 0.f, 0.f, 0.f}, a1 = a0, a2 = a0, a3 = a0;
        const float* wp = P.mod_w + ((size_t)l * DM + kp * 128) * 6144 + n0 + 4 * cq;
#pragma unroll 8
        for (int k = 0; k < 128; ++k) { const f32x4 w = *(const f32x4*)(wp + (size_t)k * 6144); const f32x4 cv = condT[kp * 128 + k];
            a0 += w * cv.x; a1 += w * cv.y; a2 += w * cv.z; a3 += w * cv.w; }
        *(f32x4*)(red + (kp * 4 + 0) * 128 + 4 * cq) = a0; *(f32x4*)(red + (kp * 4 + 1) * 128 + 4 * cq) = a1;
        *(f32x4*)(red + (kp * 4 + 2) * 128 + 4 * cq) = a2; *(f32x4*)(red + (kp * 4 + 3) * 128 + 4 * cq) = a3;
        __syncthreads();
        { const int b = tid >> 7, col = tid & 127; float s = P.mod_b[l * 6144 + n0 + col];
#pragma unroll
            for (int q = 0; q < 16; ++q) s += red[(q * 4 + b) * 128 + col];
            MOD[(l * 4 + b) * 6144 + n0 + col] = s; }
        __syncthreads();
    }
}
__device__ __forceinline__ void p0_transpose_item(const float* W, int N, bf16_t* WT, unsigned char* scr, int item, int lane) {
    const int nblk = N >> 6, kb = item / nblk, nb = item - kb * nblk, k0 = kb * 64, n0 = nb * 64;
    const float* src = W + (size_t)(k0 + (lane >> 4)) * N + n0 + 4 * (lane & 15);
#pragma unroll 4
    for (int i = 0; i < 16; ++i) { const f32x4 v = *(const f32x4*)(src + (size_t)(4 * i) * N);
        unsigned* d = (unsigned*)(scr + (4 * i + (lane >> 4)) * 132 + 8 * (lane & 15));
        d[0] = cvt_pk_bf16(v.x, v.y); d[1] = cvt_pk_bf16(v.z, v.w); }
    LDS_WAIT();
    const int c = lane & 7;
#pragma unroll
    for (int j = 0; j < 8; ++j) { const int n = (lane >> 3) + 8 * j; const unsigned short* s = (const unsigned short*)(scr + (8 * c) * 132 + 2 * n);
        u32x4 o;
        o.x = (unsigned)s[0 * 66] | ((unsigned)s[1 * 66] << 16); o.y = (unsigned)s[2 * 66] | ((unsigned)s[3 * 66] << 16);
        o.z = (unsigned)s[4 * 66] | ((unsigned)s[5 * 66] << 16); o.w = (unsigned)s[6 * 66] | ((unsigned)s[7 * 66] << 16);
        *(u32x4*)(WT + (size_t)(n0 + n) * DM + k0 + 8 * c) = o; }
    LDS_WAIT();
}
__device__ __forceinline__ void p0_weights(const Params& P, unsigned char* lds) {
    const int tid_ = otid(); const int lane = tid_ & 63, wave = __builtin_amdgcn_readfirstlane(tid_ >> 6);
    unsigned char* scr = lds + 65536 + wave * 8448;
    const int gw = blockIdx.x * 8 + wave, NGW = gridDim.x * 8;
    constexpr int I_A = 32 * (A_N / 64), I_B = 32 * (B_N / 64), I_O = 32 * (DM / 64);
    constexpr int TOTAL = 2 * I_A + 2 * I_B + 4 * I_O;
    for (int it = gw; it < TOTAL; it += NGW) {
        int r = it;
        if (r < 2 * I_A) { const int j = r / I_A; p0_transpose_item(P.a_w_in + (size_t)j * DM * A_N, A_N, (bf16_t*)(P.ws + WS_WAIN) + (size_t)j * A_N * DM, scr, r - j * I_A, lane); continue; } r -= 2 * I_A;
        if (r < 2 * I_B) { const int j = r / I_B; p0_transpose_item(P.b_w_in + (size_t)j * DM * B_N, B_N, (bf16_t*)(P.ws + WS_WBIN) + (size_t)j * B_N * DM, scr, r - j * I_B, lane); continue; } r -= 2 * I_B;
        if (r < 2 * I_O) { const int j = r / I_O; p0_transpose_item(P.a_w_out + (size_t)j * DM * DM, DM, (bf16_t*)(P.ws + WS_WAOUT) + (size_t)j * DM * DM, scr, r - j * I_O, lane); continue; } r -= 2 * I_O;
        { const int j = r / I_O; p0_transpose_item(P.b_w_out + (size_t)j * DM * DM, DM, (bf16_t*)(P.ws + WS_WBOUT) + (size_t)j * DM * DM, scr, r - j * I_O, lane); }
    }
}

__device__ __forceinline__ void norm_phase(const Params& P, const float* xin, int layer) {
    const int tid_ = otid(); const int lane = tid_ & 63, wave = __builtin_amdgcn_readfirstlane(tid_ >> 6);
    const int gw = blockIdx.x * 8 + wave, NGW = gridDim.x * 8;
    const float* MOD = (const float*)(P.ws + WS_MOD);
    bf16_t* Hb = (bf16_t*)(P.ws + WS_H);
    for (int r0 = gw * 4; r0 < MTOK; r0 += NGW * 4) {
        const int b = r0 >> 11;
        const float* shift = MOD + (size_t)(layer * 4 + b) * 6144; const float* scale = shift + DM; const float* nw = P.norm_w + layer * DM;
        f32x4 ca[8], cs[8];
#pragma unroll
        for (int j = 0; j < 8; ++j) { const int c = 4 * lane + 256 * j; const f32x4 w = *(const f32x4*)(nw + c), s = *(const f32x4*)(scale + c); ca[j] = w * (s + 1.f); cs[j] = *(const f32x4*)(shift + c); }
        for (int rr = 0; rr < 4; ++rr) {
            const float* xr = xin + (size_t)(r0 + rr) * DM; f32x4 v[8]; float ss = 0.f;
#pragma unroll
            for (int j = 0; j < 8; ++j) { v[j] = *(const f32x4*)(xr + 4 * lane + 256 * j); ss += (v[j].x * v[j].x + v[j].y * v[j].y) + (v[j].z * v[j].z + v[j].w * v[j].w); }
            const float rs = 1.0f / sqrtf(wave_sum(ss) * (1.f / DM) + EPS);
            bf16_t* hr = Hb + (size_t)(r0 + rr) * DM;
#pragma unroll
            for (int j = 0; j < 8; ++j) { const f32x4 h = v[j] * rs * ca[j] + cs[j]; u32x2 w; w.x = cvt_pk_bf16(h.x, h.y); w.y = cvt_pk_bf16(h.z, h.w); *(u32x2*)(hr + 4 * lane + 256 * j) = w; }
        }
    }
}
__device__ __forceinline__ void final_norm_phase(const Params& P) {
    const int tid_ = otid(); const int lane = tid_ & 63, wave = __builtin_amdgcn_readfirstlane(tid_ >> 6);
    const int gw = blockIdx.x * 8 + wave, NGW = gridDim.x * 8;
    f32x4 cw[8];
#pragma unroll
    for (int j = 0; j < 8; ++j) cw[j] = *(const f32x4*)(P.final_w + 4 * lane + 256 * j);
    for (int r = gw; r < MTOK; r += NGW) {
        float* xr = P.out + (size_t)r * DM; f32x4 v[8]; float ss = 0.f;
#pragma unroll
        for (int j = 0; j < 8; ++j) { v[j] = *(const f32x4*)(xr + 4 * lane + 256 * j); ss += (v[j].x * v[j].x + v[j].y * v[j].y) + (v[j].z * v[j].z + v[j].w * v[j].w); }
        const float rs = 1.0f / sqrtf(wave_sum(ss) * (1.f / DM) + EPS);
#pragma unroll
        for (int j = 0; j < 8; ++j) *(f32x4*)(xr + 4 * lane + 256 * j) = v[j] * rs * cw[j];
    }
}

__device__ __forceinline__ void naive_attend(const bf16_t* Kh, const bf16_t* Vh, const float* qf, float* sc, int own_start, int own_len, int blkbase, int mask, int qpos, float slopeL, int lane,
                                             float& o0, float& o1, float& lse2) {
    int base = 0; float mx = -3.0e38f;
    { int m2 = mask;
      for (int rr = 0;; ++rr) { int start, len;
        if (rr == 0) { start = own_start; len = own_len; } else { if (!m2) break; const int j = __builtin_ctz(m2); m2 &= m2 - 1; start = blkbase + (j << 8); len = 256; }
        for (int i = lane; i < len; i += 64) { const int key = start + i; const u32x4* kp = (const u32x4*)(Kh + (size_t)key * DM); float dot = 0.f;
#pragma unroll 4
            for (int cch = 0; cch < 16; ++cch) { const u32x4 w = kp[cch]; const float* q = qf + cch * 8;
                dot += q[0] * bflo(w.x) + q[1] * bfhi(w.x) + q[2] * bflo(w.y) + q[3] * bfhi(w.y) + q[4] * bflo(w.z) + q[5] * bfhi(w.z) + q[6] * bflo(w.w) + q[7] * bfhi(w.w); }
            const float s = dot + slopeL * (float)(key - qpos); sc[base + i] = s; mx = fmaxf(mx, s); }
        base += len; } }
    const int tot = base; mx = wave_max(mx);
    LDS_WAIT();
    float sum = 0.f;
    for (int i = lane; i < tot; i += 64) { const float p = exp2f(sc[i] - mx); sc[i] = p; sum += p; }
    sum = wave_sum(sum);
    LDS_WAIT();
    float a0 = 0.f, a1 = 0.f; base = 0;
    { int m2 = mask;
      for (int rr = 0;; ++rr) { int start, len;
        if (rr == 0) { start = own_start; len = own_len; } else { if (!m2) break; const int j = __builtin_ctz(m2); m2 &= m2 - 1; start = blkbase + (j << 8); len = 256; }
        const bf16_t* vp = Vh + (size_t)start * DM + 2 * lane;
        for (int i = 0; i < len; ++i) { const float p = sc[base + i]; const unsigned w = *(const unsigned*)(vp + (size_t)i * DM); a0 += p * bflo(w); a1 += p * bfhi(w); }
        base += len; } }
    LDS_WAIT();
    const float inv = 1.f / sum; o0 = a0 * inv; o1 = a1 * inv; lse2 = mx + log2f(sum);
}
__device__ __forceinline__ float slope_of(int h) { return exp2f(-0.5f * (float)(h + 1)); }

__device__ __forceinline__ void attn_a_naive(const Params& P, unsigned char* lds) {
    const int tid_ = otid(); const int lane = tid_ & 63, wave = __builtin_amdgcn_readfirstlane(tid_ >> 6);
    float* qf = (float*)(lds + wave * 8192); float* sc = qf + 128;
    const bf16_t* QKV = (const bf16_t*)(P.ws + WS_QKV); bf16_t* OG = (bf16_t*)(P.ws + WS_OG); float* LSE = (float*)(P.ws + WS_LSE);
    const int gw = blockIdx.x * 8 + wave, NGW = gridDim.x * 8;
    for (int it = gw; it < 3 * MTOK * NH; it += NGW) {
        const int h = it & 15, R = (it >> 4) & (MTOK - 1), g = it >> 17;
        const int lg = 2 * g, L = SEQ >> lg;
        const bf16_t* Qp = QKV + (size_t)(3 * g) * PART + (size_t)R * DM + h * HD;
        { const unsigned w = *(const unsigned*)(Qp + 2 * lane); qf[2 * lane] = bflo(w); qf[2 * lane + 1] = bfhi(w); }
        LDS_WAIT();
        const int seq0 = R & ~(L - 1); int lo = R - 128; if (lo < seq0) lo = seq0;
        float o0, o1, lse2;
        naive_attend(QKV + (size_t)(3 * g + 1) * PART + h * HD, QKV + (size_t)(3 * g + 2) * PART + h * HD, qf, sc, lo, R - lo + 1, 0, 0, R, slope_of(h) * (float)(1 << lg) * LOG2E, lane, o0, o1, lse2);
        *(unsigned*)(OG + (size_t)g * PART + (size_t)R * DM + h * HD + 2 * lane) = cvt_pk_bf16(o0, o1);
        if (lane == 0) LSE[((size_t)g * MTOK + R) * NH + h] = lse2;
    }
}
__device__ __forceinline__ void combine_phase(const Params& P) {
    const int tid_ = otid(); const int lane = tid_ & 63, wave = __builtin_amdgcn_readfirstlane(tid_ >> 6);
    const int gw = blockIdx.x * 8 + wave, NGW = gridDim.x * 8;
    const bf16_t* OG = (const bf16_t*)(P.ws + WS_OG); const float* LSE = (const float*)(P.ws + WS_LSE); const bf16_t* Z = (const bf16_t*)(P.ws + WS_Z); bf16_t* G = (bf16_t*)(P.ws + WS_G);
    for (int m = gw; m < MTOK; m += NGW) {
        const int b = m >> 11, t = m & 2047;
        const int R0 = m, R1 = (b << 11) + ((t & 3) << 9) + (t >> 2), R2 = (b << 11) + ((t & 15) << 7) + (t >> 4);
#pragma unroll
        for (int j = 0; j < 4; ++j) { const int col = 8 * lane + 512 * j, h = col >> 7;
            const float l0 = LSE[((size_t)0 * MTOK + R0) * NH + h], l1 = LSE[((size_t)1 * MTOK + R1) * NH + h], l2 = LSE[((size_t)2 * MTOK + R2) * NH + h];
            const float mx = fmaxf(l0, fmaxf(l1, l2)); float e0 = exp2f(l0 - mx), e1 = exp2f(l1 - mx), e2 = exp2f(l2 - mx); const float inv = 1.f / (e0 + e1 + e2); e0 *= inv; e1 *= inv; e2 *= inv;
            const u32x4 a = *(const u32x4*)(OG + (size_t)R0 * DM + col), bb = *(const u32x4*)(OG + PART + (size_t)R1 * DM + col), cc = *(const u32x4*)(OG + 2 * PART + (size_t)R2 * DM + col);
            const u32x4 zz = *(const u32x4*)(Z + (size_t)m * DM + col);
            u32x4 o;
#define CMB(F) { const float v0 = (e0 * bflo(a.F) + e1 * bflo(bb.F) + e2 * bflo(cc.F)) * silu_f(bflo(zz.F)); const float v1 = (e0 * bfhi(a.F) + e1 * bfhi(bb.F) + e2 * bfhi(cc.F)) * silu_f(bfhi(zz.F)); o.F = cvt_pk_bf16(v0, v1); }
            CMB(x) CMB(y) CMB(z) CMB(w)
#undef CMB
            *(u32x4*)(G + (size_t)m * DM + col) = o; }
    }
}
__device__ __forceinline__ void attn_b_naive(const Params& P, unsigned char* lds) {
    const int tid_ = otid(); const int lane = tid_ & 63, wave = __builtin_amdgcn_readfirstlane(tid_ >> 6);
    float* qf = (float*)(lds + wave * 8192); float* sc = qf + 128;
    const bf16_t* QKV = (const bf16_t*)(P.ws + WS_QKV); const bf16_t* Z = (const bf16_t*)(P.ws + WS_Z); bf16_t* G = (bf16_t*)(P.ws + WS_G); const float* KS = (const float*)(P.ws + WS_KSUM);
    const int gw = blockIdx.x * 8 + wave, NGW = gridDim.x * 8;
    for (int it = gw; it < MTOK * NH; it += NGW) {
        const int h = it & 15, m = it >> 4, b = m >> 11, t = m & 2047, n = t >> 8;
        const bf16_t* Qp = QKV + (size_t)m * DM + h * HD;
        float q0, q1; { const unsigned w = *(const unsigned*)(Qp + 2 * lane); q0 = bflo(w); q1 = bfhi(w); qf[2 * lane] = q0; qf[2 * lane + 1] = q1; }
        LDS_WAIT();
        float gt[8];
#pragma unroll
        for (int j = 0; j < 8; ++j) { float v = 0.f;
            if (j < n) { const float* k0 = KS + (size_t)(b * 8 + j) * DM + h * HD + 2 * lane; const float* k1 = k0 + (size_t)32 * DM; v = q0 * (k0[0] + k1[0]) + q1 * (k0[1] + k1[1]); }
            gt[j] = wave_sum(v); }
        int mask = 0;
#pragma unroll
        for (int j = 0; j < 8; ++j) { if (j < n) { int rank = 0;
#pragma unroll
                for (int j2 = 0; j2 < 8; ++j2) if (j2 < n && (gt[j2] > gt[j] || (gt[j2] == gt[j] && j2 < j))) ++rank;
                if (rank < 3) mask |= 1 << j; } }
        float o0, o1, lse2;
        naive_attend(QKV + PART + h * HD, QKV + 2 * PART + h * HD, qf, sc, (b << 11) + (n << 8), (t & 255) + 1, b << 11, mask, m, slope_of(h) * LOG2E, lane, o0, o1, lse2);
        const unsigned zw = *(const unsigned*)(Z + (size_t)m * DM + h * HD + 2 * lane);
        *(unsigned*)(G + (size_t)m * DM + h * HD + 2 * lane) = cvt_pk_bf16(o0 * silu_f(bflo(zw)), o1 * silu_f(bfhi(zw)));
    }
}

__global__ void __launch_bounds__(NTHREADS, 2) fwd_mega(Params P) {
    extern __shared__ __attribute__((aligned(16))) unsigned char lds[];
    cg::grid_group grid = cg::this_grid();
    LAS unsigned char* lds3 = (LAS unsigned char*)lds;
    const bf16_t* Hb = (const bf16_t*)(P.ws + WS_H); const bf16_t* Gb = (const bf16_t*)(P.ws + WS_G);

    p0_mod(P, lds);
    p0_weights(P, lds);
    grid.sync();
    for (int layer = 0; layer < DEPTH; ++layer) {
        const bool isA = (layer & 1) == 0; const int j = layer >> 1;
        const float* xin = layer == 0 ? P.x : P.out;
        norm_phase(P, xin, layer);
        grid.sync();
        {
            pg8::Gemm g{Hb, isA ? (const bf16_t*)(P.ws + WS_WAIN) + (size_t)j * A_N * DM : (const bf16_t*)(P.ws + WS_WBIN) + (size_t)j * B_N * DM, MTOK, isA ? A_N : B_N, DM};
            pg8::StaticOrder S; S.init(MTOK, g.N, (int)gridDim.x, (int)blockIdx.x);
            pg8::Epi E{isA ? 0 : 1, (bf16_t*)(P.ws + WS_QKV), (bf16_t*)(P.ws + WS_Z), (float*)(P.ws + WS_KSUM), nullptr, nullptr, nullptr};
            pg8::gemm_phase<pg8::Epi, pg8::StaticOrder, true, true>(lds3, g, S, E);
        }
        grid.sync();
        if (isA) { attn_a_naive(P, lds); grid.sync(); combine_phase(P); }
        else { attn_b_naive(P, lds); }
        grid.sync();
        {
            pg8::Gemm g{Gb, isA ? (const bf16_t*)(P.ws + WS_WAOUT) + (size_t)j * DM * DM : (const bf16_t*)(P.ws + WS_WBOUT) + (size_t)j * DM * DM, MTOK, DM, DM};
            pg8::StaticOrder S; S.init(MTOK, DM, (int)gridDim.x, (int)blockIdx.x);
            pg8::Epi E{2, nullptr, nullptr, nullptr, xin, P.out, (const float*)(P.ws + WS_MOD) + (size_t)layer * 4 * 6144 + 4096};
            pg8::gemm_phase<pg8::Epi, pg8::StaticOrder, true, true>(lds3, g, S, E);
        }
        grid.sync();
    }
    final_norm_phase(P);
}

extern "C" void kernel_launch(void* const* d_in, const int* in_sizes, int n_in, void* d_out, int out_size, void* d_ws, size_t ws_size, hipStream_t stream) {
    static int grid = 0;
    if (grid == 0) {
        if (n_in != 10 || in_sizes[0] != MTOK * DM || out_size != MTOK * DM || ws_size < WS_END) {
            fprintf(stderr, "kernel_launch: unexpected shapes/workspace (n_in %d, in0 %d, out %d, ws %zu, need %zu)\n", n_in, n_in > 0 ? in_sizes[0] : -1, out_size, ws_size, (size_t)WS_END); grid = -1; return; }
        int dev = 0, cus = 0, per_cu = 0;
        (void)hipGetDevice(&dev); (void)hipDeviceGetAttribute(&cus, hipDeviceAttributeMultiprocessorCount, dev);
        if (hipFuncSetAttribute((const void*)fwd_mega, hipFuncAttributeMaxDynamicSharedMemorySize, LDS_BYTES) != hipSuccess) { fprintf(stderr, "kernel_launch: hipFuncSetAttribute failed\n"); grid = -1; return; }
        if (hipOccupancyMaxActiveBlocksPerMultiprocessor(&per_cu, (const void*)fwd_mega, NTHREADS, LDS_BYTES) != hipSuccess || per_cu < 1) { fprintf(stderr, "kernel_launch: occupancy query says %d\n", per_cu); (void)hipGetLastError(); per_cu = 1; }
        if (per_cu > 1) per_cu = 1;
        grid = cus * per_cu;
    }
    if (grid < 0) return;
    (void)hipMemsetAsync((char*)d_ws + WS_CTL, 0, 1 * MiB, stream);
    Params p{};
    p.x = (const float*)d_in[0]; p.c = (const float*)d_in[1]; p.norm_w = (const float*)d_in[2]; p.mod_w = (const float*)d_in[3]; p.mod_b = (const float*)d_in[4];
    p.a_w_in = (const float*)d_in[5]; p.a_w_out = (const float*)d_in[6]; p.b_w_in = (const float*)d_in[7]; p.b_w_out = (const float*)d_in[8]; p.final_w = (const float*)d_in[9];
    p.out = (float*)d_out; p.ws = (unsigned char*)d_ws;
    void* args[] = {&p};
    hipError_t e = hipLaunchCooperativeKernel((const void*)fwd_mega, dim3(grid), dim3(NTHREADS), args, LDS_BYTES, stream);
    if (e != hipSuccess) fprintf(stderr, "kernel_launch: cooperative launch failed: %s (grid %d)\n", hipGetErrorString(e), grid);
}
```

```cpp
#include <hip/hip_runtime.h>
#include <hip/hip_cooperative_groups.h>
#include <cstdio>
#include <cstdint>
namespace cg = cooperative_groups;
#ifndef ATTN_A_FLASH
#define ATTN_A_FLASH 1
#endif
#ifndef ATTN_B_FLASH
#define ATTN_B_FLASH 1
#endif

#define LAS __attribute__((address_space(3)))
typedef unsigned short bf16_t;
typedef short bf16x8 __attribute__((ext_vector_type(8)));
typedef short s16x4 __attribute__((ext_vector_type(4)));
typedef float f32x4 __attribute__((ext_vector_type(4)));
typedef float f32x16 __attribute__((ext_vector_type(16)));
typedef unsigned u32x4 __attribute__((ext_vector_type(4)));
typedef unsigned u32x2 __attribute__((ext_vector_type(2)));

constexpr int NB = 4, SEQ = 2048, DM = 2048, MTOK = NB * SEQ, NH = 16, HD = 128, DEPTH = 4;
constexpr int A_N = 10 * DM, B_N = 4 * DM;
constexpr float EPS = 1e-6f;
constexpr float LOG2E = 1.4426950408889634f;
constexpr float C2Q = 0.08838834764831845f * LOG2E;

constexpr size_t MiB = 1u << 20;
constexpr size_t WS_CTL = 0;
constexpr size_t WS_MOD = 1 * MiB;
constexpr size_t WS_KSUM = 2 * MiB;
constexpr size_t WS_LSE = 3 * MiB;
constexpr size_t WS_WAIN = 8 * MiB;
constexpr size_t WS_WBIN = WS_WAIN + 160 * MiB;
constexpr size_t WS_WAOUT = WS_WBIN + 64 * MiB;
constexpr size_t WS_WBOUT = WS_WAOUT + 16 * MiB;
constexpr size_t WS_H = WS_WBOUT + 16 * MiB;
constexpr size_t WS_G = WS_H + 32 * MiB;
constexpr size_t WS_QKV = WS_G + 32 * MiB;
constexpr size_t WS_Z = WS_QKV + 288 * MiB;
constexpr size_t WS_OG = WS_Z + 32 * MiB;
constexpr size_t WS_END = WS_OG + 96 * MiB;
constexpr size_t PART = (size_t)MTOK * DM;

constexpr int LDS_BYTES = 147456;
constexpr int NTHREADS = 512;

__device__ __forceinline__ unsigned cvt_pk_bf16(float lo, float hi) { unsigned r; asm volatile("v_cvt_pk_bf16_f32 %0, %1, %2" : "=v"(r) : "v"(lo), "v"(hi)); return r; }
__device__ __forceinline__ float bf2f(unsigned short v) { return __uint_as_float(((unsigned)v) << 16); }
__device__ __forceinline__ float bflo(unsigned w) { return __uint_as_float(w << 16); }
__device__ __forceinline__ float bfhi(unsigned w) { return __uint_as_float(w & 0xffff0000u); }
__device__ __forceinline__ float wave_sum(float v) {
#pragma unroll
    for (int o = 1; o < 64; o <<= 1) v += __shfl_xor(v, o);
    return v;
}
__device__ __forceinline__ float wave_max(float v) {
#pragma unroll
    for (int o = 1; o < 64; o <<= 1) v = fmaxf(v, __shfl_xor(v, o));
    return v;
}
__device__ __forceinline__ float silu_f(float v) { return v / (1.f + __expf(-v)); }
#define LDS_WAIT() asm volatile("s_waitcnt lgkmcnt(0)" ::: "memory")
__device__ __forceinline__ int otid() { int t = threadIdx.x; asm volatile("" : "+v"(t)); return t; }
template <class T> __device__ __forceinline__ T* optr(T* p) { asm volatile("" : "+s"(p)); return p; }

namespace pg8 {
constexpr int BM = 256, BK = 64, HALF = 128, HTB = HALF * BK * 2, STAGE_BYTES = 8 * HTB, NXCD = 8, WGM = 8;
__host__ __device__ __forceinline__ int lds_byte(int r, int c) { const int st = (r >> 4) * 2 + (c >> 5), rr = r & 15, cc = c & 31, ob = rr * 64 + cc * 2; return st * 1024 + (ob ^ (((ob >> 9) & 1) << 5)); }
__host__ __device__ __forceinline__ void stage_rc(int b, int& R, int& C) { const int st = b / 1024, sb = b % 1024, swz = sb ^ (((sb >> 9) & 1) << 5); R = (st >> 1) * 16 + swz / 64; C = (st & 1) * 32 + (swz % 64) / 2; }
__host__ __device__ __forceinline__ int perm32(int rho) { const int n = rho >> 4, i = rho & 15; return 8 * (i >> 2) + 4 * n + (i & 3); }
struct Unit { int pm, pn; };
struct Gemm { const bf16_t* A; const bf16_t* Bt; int M, N, K; };
struct StaticOrder {
    int nM, nN, nwg, G, c;
    __host__ __device__ void init(int M, int N, int G_, int c_) { nM = M / BM; nN = N / BM; nwg = nM * nN; G = G_; c = c_; }
    __host__ __device__ bool next(int i, Unit& u) const {
        const long L = (long)i * G + c; if (L >= nwg) return false;
        int wgid = (int)L; { const int q = nwg / NXCD, r = nwg % NXCD, xcd = wgid % NXCD, off = wgid / NXCD; wgid = (xcd < r ? xcd * (q + 1) : r * (q + 1) + (xcd - r) * q) + off; }
        const int nig = WGM * nN, gid = wgid / nig, fm = gid * WGM, gsz = (nM - fm) < WGM ? (nM - fm) : WGM;
        u.pm = fm + ((wgid % nig) % gsz); u.pn = (wgid % nig) / gsz; return true;
    }
    __device__ __forceinline__ void a_ready(const Unit&) const {}
    __device__ __forceinline__ void done(const Unit&) const {}
};

struct Epi {
    static constexpr bool PERM = true, AFTER_DRAIN = false;
    int mode;
    bf16_t* qkv; bf16_t* zbuf; float* ksum;
    const float* xin; float* xout; const float* gate;
    __device__ __forceinline__ void operator()(const f32x4 (&acc)[2][2][4][2], const Unit& u, int wr, int wc, int fr, int fq) const {
        if (mode == 2) {
            const int col0 = u.pn * BM + wc * 32 + 8 * fq; const int b = (u.pm * BM) >> 11;
            f32x4 gv[2][2];
#pragma unroll
            for (int bj = 0; bj < 2; ++bj)
#pragma unroll
                for (int n = 0; n < 2; ++n) gv[bj][n] = *(const f32x4*)(gate + b * 6144 + col0 + bj * HALF + 4 * n);
#pragma unroll
            for (int ai = 0; ai < 2; ++ai)
#pragma unroll
                for (int m = 0; m < 4; ++m) { const size_t off = (size_t)(u.pm * BM + ai * HALF + wr * 64 + m * 16 + fr) * DM + col0;
#pragma unroll
                    for (int bj = 0; bj < 2; ++bj)
#pragma unroll
                        for (int n = 0; n < 2; ++n) { const f32x4 xv = *(const f32x4*)(xin + off + bj * HALF + 4 * n);
                            *(f32x4*)(xout + off + bj * HALF + 4 * n) = xv + gv[bj][n] * acc[ai][bj][m][n]; }
                    asm volatile("" ::: "memory"); }
            return;
        }
        const int p = u.pn >> 3, colt = (u.pn & 7) * BM;
        int lg = 0; float sc = 1.f; bf16_t* base;
        if (mode == 0) { if (p == 9) base = zbuf; else { const int g = p / 3, kind = p - 3 * g; lg = 2 * g; base = qkv + (size_t)p * PART; if (kind == 0) sc = C2Q; } }
        else { if (p == 3) base = zbuf; else { base = qkv + (size_t)p * PART; if (p == 0) sc = C2Q; } }
        const int col0 = colt + wc * 32 + 8 * fq;
#pragma unroll
        for (int ai = 0; ai < 2; ++ai)
#pragma unroll
            for (int m = 0; m < 4; ++m) {
                const int row = u.pm * BM + ai * HALF + wr * 64 + m * 16 + fr, b = row >> 11, t = row & 2047;
                const int R = (b << 11) + ((t & ((1 << lg) - 1)) << (11 - lg)) + (t >> lg);
                bf16_t* rowp = base + (size_t)R * DM + col0;
#pragma unroll
                for (int bj = 0; bj < 2; ++bj) { const f32x4 v0 = acc[ai][bj][m][0] * sc, v1 = acc[ai][bj][m][1] * sc;
                    u32x4 w; w.x = cvt_pk_bf16(v0[0], v0[1]); w.y = cvt_pk_bf16(v0[2], v0[3]); w.z = cvt_pk_bf16(v1[0], v1[1]); w.w = cvt_pk_bf16(v1[2], v1[3]);
                    *(u32x4*)(rowp + bj * HALF) = w; } }
        if (mode == 1 && p == 1) {
#pragma unroll
            for (int bj = 0; bj < 2; ++bj)
#pragma unroll
                for (int n = 0; n < 2; ++n) { f32x4 s = {0.f, 0.f, 0.f, 0.f};
#pragma unroll
                    for (int ai = 0; ai < 2; ++ai)
#pragma unroll
                        for (int m = 0; m < 4; ++m) s += acc[ai][bj][m][n];
#pragma unroll
                    for (int j = 0; j < 4; ++j) { float v = s[j]; v += __shfl_xor(v, 1); v += __shfl_xor(v, 2); v += __shfl_xor(v, 4); v += __shfl_xor(v, 8); s[j] = v; }
                    if (fr == 0) *(f32x4*)(ksum + ((size_t)(wr * 32 + u.pm) * DM + colt + bj * HALF + wc * 32 + 8 * fq + 4 * n)) = s; }
        }
    }
};

template <class Epi, class Sched, bool ALIGN_EPI = false, bool SP2 = false>
__device__ __forceinline__ void gemm_phase(LAS unsigned char* lds, const Gemm g, const Sched& S, const Epi& E) {
    const int tid = otid(), wid = __builtin_amdgcn_readfirstlane(tid >> 6), lane = tid & 63, wr = wid >> 2, wc = wid & 3, fr = lane & 15, fq = lane >> 4;
    const int K = g.K, nt = K / BK;
    unsigned voffA[2], voffB[2];
#pragma unroll
    for (int i = 0; i < 2; ++i) { int R, C; stage_rc(tid * 16 + i * 8192, R, C); const int Rb = Epi::PERM ? ((R & ~31) + perm32(R & 31)) : R;
        voffA[i] = (unsigned)(R * K + C) * 2u; voffB[i] = (unsigned)(Rb * K + C) * 2u; }
    const size_t kstep = (size_t)(BK * 2);
    const size_t hstep = (size_t)HALF * K * 2;
    const size_t tstep = 2 * hstep;
    const unsigned ldsw = (unsigned)wid * 1024u;
    const int aoff = lds_byte(wr * 64 + fr, fq * 8), boff = lds_byte(wc * 32 + fr, fq * 8);
#define PG8_SA(b, h) (((b) * 2 + (h)) * HTB)
#define PG8_SB(b, h) ((4 + (b) * 2 + (h)) * HTB)
#define PG8_STAGE(bufoff, gbase, voff) do { _Pragma("unroll") for (int _i = 0; _i < 2; ++_i) \
        __builtin_amdgcn_global_load_lds((const unsigned*)((const char*)(gbase) + (voff)[_i]), (LAS unsigned*)(lds + (bufoff) + ldsw + _i * 8192), 16, 0, 0); } while (0)
#define PG8_LDA(dst, b, h) do { _Pragma("unroll") for (int m = 0; m < 4; ++m) _Pragma("unroll") for (int k = 0; k < 2; ++k) dst[m][k] = *(const LAS bf16x8*)(lds + PG8_SA(b, h) + aoff + m * 2048 + k * 1024); } while (0)
#define PG8_LDB(dst, b, h) do { _Pragma("unroll") for (int n = 0; n < 2; ++n) _Pragma("unroll") for (int k = 0; k < 2; ++k) dst[n][k] = *(const LAS bf16x8*)(lds + PG8_SB(b, h) + boff + n * 2048 + k * 1024); } while (0)
#define PG8_MMA(ai, bj, At, Bt) do { __builtin_amdgcn_s_setprio(1); _Pragma("unroll") for (int m = 0; m < 4; ++m) _Pragma("unroll") for (int n = 0; n < 2; ++n) _Pragma("unroll") for (int k = 0; k < 2; ++k) \
        acc[ai][bj][m][n] = __builtin_amdgcn_mfma_f32_16x16x32_bf16(Bt[n][k], At[m][k], acc[ai][bj][m][n], 0, 0, 0); __builtin_amdgcn_s_setprio(0); } while (0)
#define PG8_WAIT_V(n) asm volatile("s_waitcnt vmcnt(" #n ")" ::: "memory")
#define PG8_WAIT_L(n) asm volatile("s_waitcnt lgkmcnt(" #n ")" ::: "memory")
#define PG8_BAR __builtin_amdgcn_s_barrier()
#define PG8_SCHED __builtin_amdgcn_sched_barrier(0)
    Unit cur, nxt; int ui = 0;
    if (!S.next(0, cur)) return;
    f32x4 acc[2][2][4][2];
#pragma unroll
    for (int a = 0; a < 2; ++a)
#pragma unroll
        for (int b = 0; b < 2; ++b)
#pragma unroll
            for (int m = 0; m < 4; ++m)
#pragma unroll
                for (int n = 0; n < 2; ++n) acc[a][b][m][n] = (f32x4){0.f, 0.f, 0.f, 0.f};
    bf16x8 At[4][2], B0[2][2], B1[2][2];
    const char* cA = (const char*)g.A + (size_t)cur.pm * tstep; const char* cB = (const char*)g.Bt + (size_t)cur.pn * tstep;
    S.a_ready(cur);
    if constexpr (SP2) {
        PG8_STAGE(PG8_SB(0, 0), cB, voffB); PG8_STAGE(PG8_SB(0, 1), cB + hstep, voffB); PG8_STAGE(PG8_SA(0, 0), cA, voffA); PG8_STAGE(PG8_SA(0, 1), cA + hstep, voffA);
        if (wr == 1) PG8_BAR;
        PG8_WAIT_V(2); PG8_BAR;
        PG8_STAGE(PG8_SB(1, 0), cB + kstep, voffB); PG8_STAGE(PG8_SA(1, 0), cA + kstep, voffA); PG8_STAGE(PG8_SB(1, 1), cB + hstep + kstep, voffB);
        PG8_WAIT_V(6); PG8_BAR;
    } else {
        PG8_STAGE(PG8_SB(0, 0), cB, voffB); PG8_STAGE(PG8_SA(0, 0), cA, voffA); PG8_STAGE(PG8_SB(0, 1), cB + hstep, voffB); PG8_STAGE(PG8_SA(0, 1), cA + hstep, voffA);
        if (wr == 1) PG8_BAR;
        PG8_WAIT_V(4); PG8_BAR;
        PG8_STAGE(PG8_SB(1, 0), cB + kstep, voffB); PG8_STAGE(PG8_SA(1, 0), cA + kstep, voffA); PG8_STAGE(PG8_SB(1, 1), cB + hstep + kstep, voffB);
        PG8_WAIT_V(6); PG8_BAR;
    }
    for (;;) {
        const bool has_next = S.next(ui + 1, nxt);
        const char* nA = has_next ? (const char*)g.A + (size_t)nxt.pm * tstep : cA; const char* nB = has_next ? (const char*)g.Bt + (size_t)nxt.pn * tstep : cB;
        for (int t = 0; t < nt; t += 2) {
            const bool last = (t == nt - 2);
            const char* a1 = cA + (size_t)(t + 1) * kstep;
            const char* a2 = last ? nA : cA + (size_t)(t + 2) * kstep; const char* b2 = last ? nB : cB + (size_t)(t + 2) * kstep;
            const char* a3 = a2 + kstep; const char* b3 = b2 + kstep;
            if (last && has_next) S.a_ready(nxt);
            if constexpr (SP2) {
            PG8_LDB(B0, 0, 0); PG8_LDB(B1, 0, 1); PG8_SCHED; PG8_LDA(At, 0, 0); PG8_STAGE(PG8_SA(1, 1), a1 + hstep, voffA);
            PG8_WAIT_V(8); PG8_WAIT_L(0); PG8_BAR; PG8_MMA(0, 0, At, B0); PG8_MMA(0, 1, At, B1); PG8_BAR; PG8_SCHED;
            PG8_LDA(At, 0, 1); PG8_STAGE(PG8_SB(0, 0), b2, voffB); PG8_STAGE(PG8_SB(0, 1), b2 + hstep, voffB); PG8_STAGE(PG8_SA(0, 0), a2, voffA);
            PG8_WAIT_V(8); PG8_WAIT_L(0); PG8_BAR; PG8_MMA(1, 0, At, B0); PG8_MMA(1, 1, At, B1); PG8_BAR; PG8_SCHED;
            PG8_LDB(B0, 1, 0); PG8_LDB(B1, 1, 1); PG8_SCHED; PG8_LDA(At, 1, 0); PG8_STAGE(PG8_SA(0, 1), a2 + hstep, voffA);
            PG8_WAIT_V(8); PG8_WAIT_L(0); PG8_BAR; PG8_MMA(0, 0, At, B0); PG8_MMA(0, 1, At, B1); PG8_BAR; PG8_SCHED;
            PG8_LDA(At, 1, 1); PG8_STAGE(PG8_SB(1, 0), b3, voffB); PG8_STAGE(PG8_SB(1, 1), b3 + hstep, voffB); PG8_STAGE(PG8_SA(1, 0), a3, voffA);
            PG8_WAIT_V(8); PG8_WAIT_L(0); PG8_BAR; PG8_MMA(1, 0, At, B0); PG8_MMA(1, 1, At, B1); PG8_BAR; PG8_SCHED;
            } else {
            PG8_LDB(B0, 0, 0); PG8_SCHED; PG8_LDA(At, 0, 0); PG8_STAGE(PG8_SA(1, 1), a1 + hstep, voffA);
            PG8_WAIT_L(8); PG8_BAR; PG8_WAIT_L(0); PG8_MMA(0, 0, At, B0); PG8_BAR; PG8_SCHED;
            PG8_LDB(B1, 0, 1); PG8_STAGE(PG8_SB(0, 0), b2, voffB);
            PG8_BAR; PG8_WAIT_L(0); PG8_MMA(0, 1, At, B1); PG8_BAR;
            PG8_LDA(At, 0, 1); PG8_STAGE(PG8_SA(0, 0), a2, voffA);
            PG8_BAR; PG8_WAIT_L(0); PG8_MMA(1, 0, At, B0); PG8_BAR; PG8_SCHED;
            PG8_STAGE(PG8_SB(0, 1), b2 + hstep, voffB);
            PG8_WAIT_V(6); PG8_BAR; PG8_MMA(1, 1, At, B1); PG8_BAR;
            PG8_LDB(B0, 1, 0); PG8_SCHED; PG8_LDA(At, 1, 0); PG8_STAGE(PG8_SA(0, 1), a2 + hstep, voffA);
            PG8_WAIT_L(8); PG8_BAR; PG8_WAIT_L(0); PG8_MMA(0, 0, At, B0); PG8_BAR; PG8_SCHED;
            PG8_LDB(B1, 1, 1); PG8_STAGE(PG8_SB(1, 0), b3, voffB);
            PG8_BAR; PG8_WAIT_L(0); PG8_MMA(0, 1, At, B1); PG8_BAR;
            PG8_LDA(At, 1, 1); PG8_STAGE(PG8_SA(1, 0), a3, voffA);
            PG8_BAR; PG8_WAIT_L(0); PG8_MMA(1, 0, At, B0); PG8_BAR; PG8_SCHED;
            PG8_STAGE(PG8_SB(1, 1), b3 + hstep, voffB);
            PG8_WAIT_V(6); PG8_BAR; PG8_MMA(1, 1, At, B1); PG8_BAR;
            }
        }
        if constexpr (ALIGN_EPI) { if (wr == 0) PG8_BAR; }
        if constexpr (!Epi::AFTER_DRAIN) { E(acc, cur, wr, wc, fr, fq); S.done(cur); }
        if (!has_next) break;
#pragma unroll
        for (int a = 0; a < 2; ++a)
#pragma unroll
            for (int b = 0; b < 2; ++b)
#pragma unroll
                for (int m = 0; m < 4; ++m)
#pragma unroll
                    for (int n = 0; n < 2; ++n) acc[a][b][m][n] = (f32x4){0.f, 0.f, 0.f, 0.f};
        cur = nxt; cA = nA; cB = nB; ++ui;
        if constexpr (ALIGN_EPI) { if (wr == 1) PG8_BAR; }
    }
    PG8_WAIT_V(0);
    if constexpr (!ALIGN_EPI) { if (wr == 0) PG8_BAR; }
    PG8_BAR;
#undef PG8_SA
#undef PG8_SB
#undef PG8_STAGE
#undef PG8_LDA
#undef PG8_LDB
#undef PG8_MMA
#undef PG8_WAIT_V
#undef PG8_WAIT_L
#undef PG8_BAR
#undef PG8_SCHED
}
}

struct Params {
    const float *x, *c, *norm_w, *mod_w, *mod_b, *a_w_in, *a_w_out, *b_w_in, *b_w_out, *final_w;
    float* out; unsigned char* ws;
};

__device__ __forceinline__ void p0_mod(const Params& P, unsigned char* lds) {
    const int tid = otid();
    f32x4* condT = (f32x4*)lds;
    float* red = (float*)(lds + 32768);
    float* MOD = (float*)(P.ws + WS_MOD);
    bool have = false;
    for (int item = blockIdx.x; item < 192; item += gridDim.x) {
        if (!have) { have = true;
            for (int k = tid; k < DM; k += NTHREADS) { f32x4 v; v.x = silu_f(P.c[k]); v.y = silu_f(P.c[DM + k]); v.z = silu_f(P.c[2 * DM + k]); v.w = silu_f(P.c[3 * DM + k]); condT[k] = v; }
            __syncthreads(); }
        const int l = item / 48, n0 = (item % 48) * 128, cq = tid & 31, kp = tid >> 5;
        f32x4 a0 = {0.f, 0.f, 0.f, 0.f}, a1 = a0, a2 = a0, a3 = a0;
        const float* wp = P.mod_w + ((size_t)l * DM + kp * 128) * 6144 + n0 + 4 * cq;
#pragma unroll 8
        for (int k = 0; k < 128; ++k) { const f32x4 w = *(const f32x4*)(wp + (size_t)k * 6144); const f32x4 cv = condT[kp * 128 + k];
            a0 += w * cv.x; a1 += w * cv.y; a2 += w * cv.z; a3 += w * cv.w; }
        *(f32x4*)(red + (kp * 4 + 0) * 128 + 4 * cq) = a0; *(f32x4*)(red + (kp * 4 + 1) * 128 + 4 * cq) = a1;
        *(f32x4*)(red + (kp * 4 + 2) * 128 + 4 * cq) = a2; *(f32x4*)(red + (kp * 4 + 3) * 128 + 4 * cq) = a3;
        __syncthreads();
        { const int b = tid >> 7, col = tid & 127; float s = P.mod_b[l * 6144 + n0 + col];
#pragma unroll
            for (int q = 0; q < 16; ++q) s += red[(q * 4 + b) * 128 + col];
            MOD[(l * 4 + b) * 6144 + n0 + col] = s; }
        __syncthreads();
    }
}
__device__ __forceinline__ void p0_transpose_item(const float* W, int N, bf16_t* WT, unsigned char* scr, int item, int lane) {
    const int nblk = N >> 6, kb = item / nblk, nb = item - kb * nblk, k0 = kb * 64, n0 = nb * 64;
    const float* src = W + (size_t)(k0 + (lane >> 4)) * N + n0 + 4 * (lane & 15);
#pragma unroll 4
    for (int i = 0; i < 16; ++i) { const f32x4 v = *(const f32x4*)(src + (size_t)(4 * i) * N);
        unsigned* d = (unsigned*)(scr + (4 * i + (lane >> 4)) * 132 + 8 * (lane & 15));
        d[0] = cvt_pk_bf16(v.x, v.y); d[1] = cvt_pk_bf16(v.z, v.w); }
    LDS_WAIT();
    const int c = lane & 7;
#pragma unroll
    for (int j = 0; j < 8; ++j) { const int n = (lane >> 3) + 8 * j; const unsigned short* s = (const unsigned short*)(scr + (8 * c) * 132 + 2 * n);
        u32x4 o;
        o.x = (unsigned)s[0 * 66] | ((unsigned)s[1 * 66] << 16); o.y = (unsigned)s[2 * 66] | ((unsigned)s[3 * 66] << 16);
        o.z = (unsigned)s[4 * 66] | ((unsigned)s[5 * 66] << 16); o.w = (unsigned)s[6 * 66] | ((unsigned)s[7 * 66] << 16);
        *(u32x4*)(WT + (size_t)(n0 + n) * DM + k0 + 8 * c) = o; }
    LDS_WAIT();
}
__device__ __forceinline__ void p0_weights(const Params& P, unsigned char* lds) {
    const int tid_ = otid(); const int lane = tid_ & 63, wave = __builtin_amdgcn_readfirstlane(tid_ >> 6);
    unsigned char* scr = lds + 65536 + wave * 8448;
    const int gw = blockIdx.x * 8 + wave, NGW = gridDim.x * 8;
    constexpr int I_A = 32 * (A_N / 64), I_B = 32 * (B_N / 64), I_O = 32 * (DM / 64);
    constexpr int TOTAL = 2 * I_A + 2 * I_B + 4 * I_O;
    for (int it = gw; it < TOTAL; it += NGW) {
        int r = it;
        if (r < 2 * I_A) { const int j = r / I_A; p0_transpose_item(P.a_w_in + (size_t)j * DM * A_N, A_N, (bf16_t*)(P.ws + WS_WAIN) + (size_t)j * A_N * DM, scr, r - j * I_A, lane); continue; } r -= 2 * I_A;
        if (r < 2 * I_B) { const int j = r / I_B; p0_transpose_item(P.b_w_in + (size_t)j * DM * B_N, B_N, (bf16_t*)(P.ws + WS_WBIN) + (size_t)j * B_N * DM, scr, r - j * I_B, lane); continue; } r -= 2 * I_B;
        if (r < 2 * I_O) { const int j = r / I_O; p0_transpose_item(P.a_w_out + (size_t)j * DM * DM, DM, (bf16_t*)(P.ws + WS_WAOUT) + (size_t)j * DM * DM, scr, r - j * I_O, lane); continue; } r -= 2 * I_O;
        { const int j = r / I_O; p0_transpose_item(P.b_w_out + (size_t)j * DM * DM, DM, (bf16_t*)(P.ws + WS_WBOUT) + (size_t)j * DM * DM, scr, r - j * I_O, lane); }
    }
}

__device__ __forceinline__ void norm_phase(const Params& P, const float* xin, int layer) {
    const int tid_ = otid(); const int lane = tid_ & 63, wave = __builtin_amdgcn_readfirstlane(tid_ >> 6);
    const int gw = blockIdx.x * 8 + wave, NGW = gridDim.x * 8;
    const float* MOD = (const float*)(P.ws + WS_MOD);
    bf16_t* Hb = (bf16_t*)(P.ws + WS_H);
    for (int r0 = gw * 4; r0 < MTOK; r0 += NGW * 4) {
        const int b = r0 >> 11;
        const float* shift = MOD + (size_t)(layer * 4 + b) * 6144; const float* scale = shift + DM; const float* nw = P.norm_w + layer * DM;
        f32x4 ca[8], cs[8];
#pragma unroll
        for (int j = 0; j < 8; ++j) { const int c = 4 * lane + 256 * j; const f32x4 w = *(const f32x4*)(nw + c), s = *(const f32x4*)(scale + c); ca[j] = w * (s + 1.f); cs[j] = *(const f32x4*)(shift + c); }
        for (int rr = 0; rr < 4; ++rr) {
            const float* xr = xin + (size_t)(r0 + rr) * DM; f32x4 v[8]; float ss = 0.f;
#pragma unroll
            for (int j = 0; j < 8; ++j) { v[j] = *(const f32x4*)(xr + 4 * lane + 256 * j); ss += (v[j].x * v[j].x + v[j].y * v[j].y) + (v[j].z * v[j].z + v[j].w * v[j].w); }
            const float rs = 1.0f / sqrtf(wave_sum(ss) * (1.f / DM) + EPS);
            bf16_t* hr = Hb + (size_t)(r0 + rr) * DM;
#pragma unroll
            for (int j = 0; j < 8; ++j) { const f32x4 h = v[j] * rs * ca[j] + cs[j]; u32x2 w; w.x = cvt_pk_bf16(h.x, h.y); w.y = cvt_pk_bf16(h.z, h.w); *(u32x2*)(hr + 4 * lane + 256 * j) = w; }
        }
    }
}
__device__ __forceinline__ void final_norm_phase(const Params& P) {
    const int tid_ = otid(); const int lane = tid_ & 63, wave = __builtin_amdgcn_readfirstlane(tid_ >> 6);
    const int gw = blockIdx.x * 8 + wave, NGW = gridDim.x * 8;
    f32x4 cw[8];
#pragma unroll
    for (int j = 0; j < 8; ++j) cw[j] = *(const f32x4*)(P.final_w + 4 * lane + 256 * j);
    for (int r = gw; r < MTOK; r += NGW) {
        float* xr = P.out + (size_t)r * DM; f32x4 v[8]; float ss = 0.f;
#pragma unroll
        for (int j = 0; j < 8; ++j) { v[j] = *(const f32x4*)(xr + 4 * lane + 256 * j); ss += (v[j].x * v[j].x + v[j].y * v[j].y) + (v[j].z * v[j].z + v[j].w * v[j].w); }
        const float rs = 1.0f / sqrtf(wave_sum(ss) * (1.f / DM) + EPS);
#pragma unroll
        for (int j = 0; j < 8; ++j) *(f32x4*)(xr + 4 * lane + 256 * j) = v[j] * rs * cw[j];
    }
}

__device__ __forceinline__ void naive_attend(const bf16_t* Kh, const bf16_t* Vh, const float* qf, float* sc, int own_start, int own_len, int blkbase, int mask, int qpos, float slopeL, int lane,
                                             float& o0, float& o1, float& lse2) {
    int base = 0; float mx = -3.0e38f;
    { int m2 = mask;
      for (int rr = 0;; ++rr) { int start, len;
        if (rr == 0) { start = own_start; len = own_len; } else { if (!m2) break; const int j = __builtin_ctz(m2); m2 &= m2 - 1; start = blkbase + (j << 8); len = 256; }
        for (int i = lane; i < len; i += 64) { const int key = start + i; const u32x4* kp = (const u32x4*)(Kh + (size_t)key * DM); float dot = 0.f;
#pragma unroll 4
            for (int cch = 0; cch < 16; ++cch) { const u32x4 w = kp[cch]; const float* q = qf + cch * 8;
                dot += q[0] * bflo(w.x) + q[1] * bfhi(w.x) + q[2] * bflo(w.y) + q[3] * bfhi(w.y) + q[4] * bflo(w.z) + q[5] * bfhi(w.z) + q[6] * bflo(w.w) + q[7] * bfhi(w.w); }
            const float s = dot + slopeL * (float)(key - qpos); sc[base + i] = s; mx = fmaxf(mx, s); }
        base += len; } }
    const int tot = base; mx = wave_max(mx);
    LDS_WAIT();
    float sum = 0.f;
    for (int i = lane; i < tot; i += 64) { const float p = exp2f(sc[i] - mx); sc[i] = p; sum += p; }
    sum = wave_sum(sum);
    LDS_WAIT();
    float a0 = 0.f, a1 = 0.f; base = 0;
    { int m2 = mask;
      for (int rr = 0;; ++rr) { int start, len;
        if (rr == 0) { start = own_start; len = own_len; } else { if (!m2) break; const int j = __builtin_ctz(m2); m2 &= m2 - 1; start = blkbase + (j << 8); len = 256; }
        const bf16_t* vp = Vh + (size_t)start * DM + 2 * lane;
        for (int i = 0; i < len; ++i) { const float p = sc[base + i]; const unsigned w = *(const unsigned*)(vp + (size_t)i * DM); a0 += p * bflo(w); a1 += p * bfhi(w); }
        base += len; } }
    LDS_WAIT();
    const float inv = 1.f / sum; o0 = a0 * inv; o1 = a1 * inv; lse2 = mx + log2f(sum);
}
__device__ __forceinline__ float slope_of(int h) { return exp2f(-0.5f * (float)(h + 1)); }

__device__ __forceinline__ void attn_a_naive(const Params& P, unsigned char* lds) {
    const int tid_ = otid(); const int lane = tid_ & 63, wave = __builtin_amdgcn_readfirstlane(tid_ >> 6);
    float* qf = (float*)(lds + wave * 8192); float* sc = qf + 128;
    const bf16_t* QKV = (const bf16_t*)(P.ws + WS_QKV); bf16_t* OG = (bf16_t*)(P.ws + WS_OG); float* LSE = (float*)(P.ws + WS_LSE);
    const int gw = blockIdx.x * 8 + wave, NGW = gridDim.x * 8;
    for (int it = gw; it < 3 * MTOK * NH; it += NGW) {
        const int h = it & 15, R = (it >> 4) & (MTOK - 1), g = it >> 17;
        const int lg = 2 * g, L = SEQ >> lg;
        const bf16_t* Qp = QKV + (size_t)(3 * g) * PART + (size_t)R * DM + h * HD;
        { const unsigned w = *(const unsigned*)(Qp + 2 * lane); qf[2 * lane] = bflo(w); qf[2 * lane + 1] = bfhi(w); }
        LDS_WAIT();
        const int seq0 = R & ~(L - 1); int lo = R - 128; if (lo < seq0) lo = seq0;
        float o0, o1, lse2;
        naive_attend(QKV + (size_t)(3 * g + 1) * PART + h * HD, QKV + (size_t)(3 * g + 2) * PART + h * HD, qf, sc, lo, R - lo + 1, 0, 0, R, slope_of(h) * (float)(1 << lg) * LOG2E, lane, o0, o1, lse2);
        *(unsigned*)(OG + (size_t)g * PART + (size_t)R * DM + h * HD + 2 * lane) = cvt_pk_bf16(o0, o1);
        if (lane == 0) LSE[((size_t)g * MTOK + R) * NH + h] = lse2;
    }
}
__device__ __forceinline__ void combine_phase(const Params& P) {
    const int tid_ = otid(); const int lane = tid_ & 63, wave = __builtin_amdgcn_readfirstlane(tid_ >> 6);
    const int gw = blockIdx.x * 8 + wave, NGW = gridDim.x * 8;
    const bf16_t* OG = (const bf16_t*)(P.ws + WS_OG); const float* LSE = (const float*)(P.ws + WS_LSE); const bf16_t* Z = (const bf16_t*)(P.ws + WS_Z); bf16_t* G = (bf16_t*)(P.ws + WS_G);
    for (int m = gw; m < MTOK; m += NGW) {
        const int b = m >> 11, t = m & 2047;
        const int R0 = m, R1 = (b << 11) + ((t & 3) << 9) + (t >> 2), R2 = (b << 11) + ((t & 15) << 7) + (t >> 4);
#pragma unroll
        for (int j = 0; j < 4; ++j) { const int col = 8 * lane + 512 * j, h = col >> 7;
            const float l0 = LSE[((size_t)0 * MTOK + R0) * NH + h], l1 = LSE[((size_t)1 * MTOK + R1) * NH + h], l2 = LSE[((size_t)2 * MTOK + R2) * NH + h];
            const float mx = fmaxf(l0, fmaxf(l1, l2)); float e0 = exp2f(l0 - mx), e1 = exp2f(l1 - mx), e2 = exp2f(l2 - mx); const float inv = 1.f / (e0 + e1 + e2); e0 *= inv; e1 *= inv; e2 *= inv;
            const u32x4 a = *(const u32x4*)(OG + (size_t)R0 * DM + col), bb = *(const u32x4*)(OG + PART + (size_t)R1 * DM + col), cc = *(const u32x4*)(OG + 2 * PART + (size_t)R2 * DM + col);
            const u32x4 zz = *(const u32x4*)(Z + (size_t)m * DM + col);
            u32x4 o;
#define CMB(F) { const float v0 = (e0 * bflo(a.F) + e1 * bflo(bb.F) + e2 * bflo(cc.F)) * silu_f(bflo(zz.F)); const float v1 = (e0 * bfhi(a.F) + e1 * bfhi(bb.F) + e2 * bfhi(cc.F)) * silu_f(bfhi(zz.F)); o.F = cvt_pk_bf16(v0, v1); }
            CMB(x) CMB(y) CMB(z) CMB(w)
#undef CMB
            *(u32x4*)(G + (size_t)m * DM + col) = o; }
    }
}
__device__ __forceinline__ void attn_b_naive(const Params& P, unsigned char* lds) {
    const int tid_ = otid(); const int lane = tid_ & 63, wave = __builtin_amdgcn_readfirstlane(tid_ >> 6);
    float* qf = (float*)(lds + wave * 8192); float* sc = qf + 128;
    const bf16_t* QKV = (const bf16_t*)(P.ws + WS_QKV); const bf16_t* Z = (const bf16_t*)(P.ws + WS_Z); bf16_t* G = (bf16_t*)(P.ws + WS_G); const float* KS = (const float*)(P.ws + WS_KSUM);
    const int gw = blockIdx.x * 8 + wave, NGW = gridDim.x * 8;
    for (int it = gw; it < MTOK * NH; it += NGW) {
        const int h = it & 15, m = it >> 4, b = m >> 11, t = m & 2047, n = t >> 8;
        const bf16_t* Qp = QKV + (size_t)m * DM + h * HD;
        float q0, q1; { const unsigned w = *(const unsigned*)(Qp + 2 * lane); q0 = bflo(w); q1 = bfhi(w); qf[2 * lane] = q0; qf[2 * lane + 1] = q1; }
        LDS_WAIT();
        float gt[8];
#pragma unroll
        for (int j = 0; j < 8; ++j) { float v = 0.f;
            if (j < n) { const float* k0 = KS + (size_t)(b * 8 + j) * DM + h * HD + 2 * lane; const float* k1 = k0 + (size_t)32 * DM; v = q0 * (k0[0] + k1[0]) + q1 * (k0[1] + k1[1]); }
            gt[j] = wave_sum(v); }
        int mask = 0;
#pragma unroll
        for (int j = 0; j < 8; ++j) { if (j < n) { int rank = 0;
#pragma unroll
                for (int j2 = 0; j2 < 8; ++j2) if (j2 < n && (gt[j2] > gt[j] || (gt[j2] == gt[j] && j2 < j))) ++rank;
                if (rank < 3) mask |= 1 << j; } }
        float o0, o1, lse2;
        naive_attend(QKV + PART + h * HD, QKV + 2 * PART + h * HD, qf, sc, (b << 11) + (n << 8), (t & 255) + 1, b << 11, mask, m, slope_of(h) * LOG2E, lane, o0, o1, lse2);
        const unsigned zw = *(const unsigned*)(Z + (size_t)m * DM + h * HD + 2 * lane);
        *(unsigned*)(G + (size_t)m * DM + h * HD + 2 * lane) = cvt_pk_bf16(o0 * silu_f(bflo(zw)), o1 * silu_f(bfhi(zw)));
    }
}

namespace fa {
constexpr int KVBLK = 64, SHM_K = KVBLK * HD * 2, SHM_V = KVBLK * HD * 2;
constexpr int OFF_V = 0, OFF_K = 2 * SHM_V, OFF_WS = OFF_K + 2 * SHM_K, OFF_OST = OFF_WS + 8 * 256, OST_ROW = 272, OST_WAVE = 32 * OST_ROW;
constexpr int OFF_GK = OFF_OST + 8 * OST_WAVE, OFF_SEL = OFF_GK + 7 * 128 * 4, OFF_END = OFF_SEL + 256 * 4;
static_assert(OFF_END <= LDS_BYTES - 1024, "attention LDS map");
constexpr float THR = 11.5f;
#define KSWZ(row, colB) ((row) * 256 + ((colB) ^ (((row) & 7) << 4)))
#define SBAR() __builtin_amdgcn_sched_barrier(0)
__device__ __forceinline__ int v_st(int k, int c) { const int kk = (k & ~0xC) | ((k & 4) << 1) | ((k & 8) >> 1); return ((kk >> 3) * 4 + (c >> 5)) * 512 + ((kk & 7) * 32 + (c & 31)) * 2; }
__device__ __forceinline__ int v_rd_base(int lane) { return ((lane & 3) << 3) | (((lane >> 2) & 3) << 6) | (((lane >> 4) & 1) << 5) | (((lane >> 5) & 1) << 8); }
constexpr int v_rd_off(int d0, int ks, int half) { return d0 * 512 + ks * 4096 + half * 2048; }
__device__ __forceinline__ int crow(int r, int hi) { return (r & 3) + 8 * (r >> 2) + 4 * hi; }
__device__ __forceinline__ void mask_tile(f32x16& p0, f32x16& p1, int dq, unsigned W) {
    const float NEG = -__builtin_inff();
#pragma unroll
    for (int r = 0; r < 16; ++r) { const int c = (r & 3) + 8 * (r >> 2);
        if ((unsigned)(dq - c) >= W) p0[r] = NEG;
        if ((unsigned)(dq - c - 32) >= W) p1[r] = NEG; }
}
__device__ __forceinline__ void partialSM(f32x16& p0, f32x16& p1, float& m_reg, float& alpha) {
    float pmax = p0[0];
#pragma unroll
    for (int r = 1; r < 16; ++r) pmax = fmaxf(pmax, p0[r]);
#pragma unroll
    for (int r = 0; r < 16; ++r) pmax = fmaxf(pmax, p1[r]);
    { auto rr = __builtin_amdgcn_permlane32_swap(__float_as_uint(pmax), __float_as_uint(pmax), false, false); pmax = fmaxf(__uint_as_float(rr[0]), __uint_as_float(rr[1])); }
    float mn;
    if (__builtin_expect(__all(pmax - m_reg <= THR), 1)) { mn = m_reg; alpha = 1.f; }
    else { mn = fmaxf(m_reg, pmax); alpha = __builtin_amdgcn_exp2f(m_reg - mn); m_reg = mn; }
#pragma unroll
    for (int r = 0; r < 16; ++r) p0[r] = __builtin_amdgcn_exp2f(p0[r] - mn);
#pragma unroll
    for (int r = 0; r < 16; ++r) p1[r] = __builtin_amdgcn_exp2f(p1[r] - mn);
}
__device__ __forceinline__ void finishSM(f32x16& p0, f32x16& p1, float alpha, float& l_reg, bf16x8& pa0, bf16x8& pa1, bf16x8& pa2, bf16x8& pa3) {
    float ps = 0;
#pragma unroll
    for (int r = 0; r < 16; ++r) ps += p0[r];
#pragma unroll
    for (int r = 0; r < 16; ++r) ps += p1[r];
    { auto rr = __builtin_amdgcn_permlane32_swap(__float_as_uint(ps), __float_as_uint(ps), false, false); ps = __uint_as_float(rr[0]) + __uint_as_float(rr[1]); }
    l_reg = l_reg * alpha + ps;
#define PK4(P, B_, OUT) do { unsigned a0 = cvt_pk_bf16(P[B_+0], P[B_+1]), a1 = cvt_pk_bf16(P[B_+2], P[B_+3]);                          \
        unsigned b0 = cvt_pk_bf16(P[B_+4], P[B_+5]), b1 = cvt_pk_bf16(P[B_+6], P[B_+7]);                                             \
        auto r0 = __builtin_amdgcn_permlane32_swap(a0, b0, false, false); auto r1 = __builtin_amdgcn_permlane32_swap(a1, b1, false, false); \
        u32x4 w = {r0[0], r1[0], r0[1], r1[1]}; OUT = *reinterpret_cast<bf16x8*>(&w); } while (0)
    PK4(p0, 0, pa0); PK4(p0, 8, pa1); PK4(p1, 0, pa2); PK4(p1, 8, pa3);
#undef PK4
}
template <int KB>
__device__ __forceinline__ void qkt(f32x16& p0, f32x16& p1, const LAS char* K_lds, int r32, int hi, const bf16x8* qr) {
    const LAS char* kb[4];
#pragma unroll
    for (int dd = 0; dd < 4; ++dd) kb[dd] = K_lds + KB * SHM_K + KSWZ(r32, (dd * 16 + hi * 8) * 2);
#pragma unroll
    for (int d0 = 0; d0 < 8; ++d0) { const LAS char* a = kb[d0 & 3] + (d0 >> 2) * 128;
        const bf16x8 b0 = *reinterpret_cast<const LAS bf16x8*>(a);
        const bf16x8 b1 = *reinterpret_cast<const LAS bf16x8*>(a + 32 * 256);
        p0 = __builtin_amdgcn_mfma_f32_32x32x16_bf16(b0, qr[d0], p0, 0, 0, 0);
        p1 = __builtin_amdgcn_mfma_f32_32x32x16_bf16(b1, qr[d0], p1, 0, 0, 0); }
}
template <int VB>
__device__ __forceinline__ void pv_tile(f32x16* o, int vb0, bf16x8 pa0, bf16x8 pa1, bf16x8 pa2, bf16x8 pa3) {
#define TRRD(dst, off) asm volatile("ds_read_b64_tr_b16 %0, %1 offset:%2" : "=&v"(dst) : "v"(vb0), "i"(off) : "memory")
#define PV_D0(d0) do { s16x4 l0, l1, l2, l3, h0, h1, h2, h3; constexpr int b_ = VB * SHM_V + v_rd_off(d0, 0, 0); \
        TRRD(l0, b_); TRRD(h0, b_ + 2048); TRRD(l1, b_ + 4096); TRRD(h1, b_ + 6144); TRRD(l2, b_ + 8192); TRRD(h2, b_ + 10240); TRRD(l3, b_ + 12288); TRRD(h3, b_ + 14336); \
        asm volatile("s_waitcnt lgkmcnt(0)" ::: "memory"); SBAR();   \
        o[d0] = __builtin_amdgcn_mfma_f32_32x32x16_bf16(pa0, (bf16x8){l0[0], l0[1], l0[2], l0[3], h0[0], h0[1], h0[2], h0[3]}, o[d0], 0, 0, 0);   \
        o[d0] = __builtin_amdgcn_mfma_f32_32x32x16_bf16(pa1, (bf16x8){l1[0], l1[1], l1[2], l1[3], h1[0], h1[1], h1[2], h1[3]}, o[d0], 0, 0, 0);   \
        o[d0] = __builtin_amdgcn_mfma_f32_32x32x16_bf16(pa2, (bf16x8){l2[0], l2[1], l2[2], l2[3], h2[0], h2[1], h2[2], h2[3]}, o[d0], 0, 0, 0);   \
        o[d0] = __builtin_amdgcn_mfma_f32_32x32x16_bf16(pa3, (bf16x8){l3[0], l3[1], l3[2], l3[3], h3[0], h3[1], h3[2], h3[3]}, o[d0], 0, 0, 0); } while (0)
    PV_D0(0); PV_D0(1); PV_D0(2); PV_D0(3);
#undef PV_D0
#undef TRRD
}

template <int MODE, class MK>
__device__ __forceinline__ void flash_block(const bf16_t* Q, const bf16_t* K, const bf16_t* V, int krow0, int NT, int qrow0, float slopeL, const MK& mk,
                                            unsigned char* lds, bf16_t* Og, float* Lse, const bf16_t* Zg, int tid) {
    const int wid = __builtin_amdgcn_readfirstlane(tid >> 6), lane = tid & 63, r32 = lane & 31, hi = lane >> 5;
    const LAS char* K_lds = (const LAS char*)(LAS unsigned char*)lds + OFF_K;
    LAS char* Kw = (LAS char*)(LAS unsigned char*)lds + OFF_K; LAS char* Vw = (LAS char*)(LAS unsigned char*)lds + OFF_V;
    LAS float* wsf = (LAS float*)((LAS unsigned char*)lds + OFF_WS) + wid * 64; LAS float* li_l = wsf; LAS float* al_l = wsf + 32;
    const int sr = tid >> 4, sc = (tid & 15) * 8, vst0 = v_st(sr, sc), vst1 = v_st(32 + sr, sc), kws = KSWZ(sr, sc * 2);
    const int vb0 = (int)(unsigned)(uintptr_t)((LAS unsigned char*)lds) + OFF_V + v_rd_base(lane);
    const int qlo = qrow0 + wid * 32, qm = qlo + r32 - 4 * hi;
    bf16x8 st_k0, st_k1, st_v0, st_v1;
#define SLOAD(kb_) do { const size_t o0_ = (size_t)((kb_) + sr) * DM + sc, o1_ = o0_ + (size_t)32 * DM; \
        st_v0 = *(const bf16x8*)(V + o0_); st_v1 = *(const bf16x8*)(V + o1_); st_k0 = *(const bf16x8*)(K + o0_); st_k1 = *(const bf16x8*)(K + o1_); } while (0)
#define SWRITE(bf) do { *(LAS bf16x8*)(Vw + (bf) * SHM_V + vst0) = st_v0; *(LAS bf16x8*)(Vw + (bf) * SHM_V + vst1) = st_v1; \
        *(LAS bf16x8*)(Kw + (bf) * SHM_K + kws) = st_k0; *(LAS bf16x8*)(Kw + (bf) * SHM_K + kws + 32 * 256) = st_k1; } while (0)
    bf16x8 qr[8];
#pragma unroll
    for (int d0 = 0; d0 < 8; ++d0) qr[d0] = *(const bf16x8*)(Q + (size_t)(wid * 32 + r32) * DM + d0 * 16 + hi * 8);
    SLOAD(krow0); asm volatile("s_waitcnt vmcnt(0)" ::: "memory"); SWRITE(0);
    __syncthreads();
    float m_reg = -1e30f, l_reg = 0.f; f32x16 o[4] = {};
#define STEP(t, KB) do { const int kb_ = krow0 + (t) * KVBLK;                                                                   \
        if ((t) + 1 < NT) SLOAD(kb_ + KVBLK);                                                                                     \
        bool act_, need_; unsigned W_; mk.info(kb_, qlo, r32, act_, need_, W_);                                                 \
        if (act_) { f32x16 p0, p1; const float a0_ = slopeL * (float)(kb_ - qm);                                                  \
            _Pragma("unroll") for (int r = 0; r < 16; ++r) { p0[r] = fmaf(slopeL, (float)((r & 3) + 8 * (r >> 2)), a0_); p1[r] = p0[r] + 32.f * slopeL; } \
            qkt<KB>(p0, p1, K_lds, r32, hi, qr);                                                                                  \
            if (need_) mask_tile(p0, p1, qm - kb_, W_);                                                                           \
            float alpha_; partialSM(p0, p1, m_reg, alpha_);                                                                       \
            bf16x8 pa0, pa1, pa2, pa3; finishSM(p0, p1, alpha_, l_reg, pa0, pa1, pa2, pa3);                                       \
            if (__any(alpha_ < 1.f)) { if (hi == 0) al_l[r32] = alpha_; LDS_WAIT();                                               \
                _Pragma("unroll") for (int d_ = 0; d_ < 4; ++d_) _Pragma("unroll") for (int r = 0; r < 16; ++r) o[d_][r] *= al_l[crow(r, hi)]; } \
            SBAR(); pv_tile<KB>(o, vb0, pa0, pa1, pa2, pa3); }                                                                    \
        if ((t) + 1 < NT) { asm volatile("s_waitcnt vmcnt(0)" ::: "memory"); SWRITE((KB) ^ 1); }                               \
        __syncthreads(); } while (0)
    for (int t = 0; t < NT; t += 2) { STEP(t, 0); STEP(t + 1, 1); }
#undef STEP
#undef SLOAD
#undef SWRITE
    if (hi == 0) li_l[r32] = l_reg;
    LDS_WAIT();
    LAS unsigned char* stg = (LAS unsigned char*)lds + OFF_OST + wid * OST_WAVE;
#pragma unroll
    for (int r = 0; r < 16; ++r) { const int orow = crow(r, hi); const float rl = __builtin_amdgcn_rcpf(li_l[orow]);
#pragma unroll
        for (int d0 = 0; d0 < 4; ++d0) *(LAS unsigned short*)(stg + orow * OST_ROW + (d0 * 32 + r32) * 2) = (unsigned short)(cvt_pk_bf16(o[d0][r] * rl, 0.f) & 0xffffu); }
    LDS_WAIT();
    if (MODE == 0) { if (hi == 0) Lse[(size_t)(qlo + r32) * NH] = m_reg + log2f(l_reg); }
#pragma unroll
    for (int i = 0; i < 8; ++i) { const int row = i * 4 + (lane >> 4), ch = lane & 15;
        u32x4 v = *(const LAS u32x4*)(stg + row * OST_ROW + ch * 16);
        const size_t go = (size_t)(qlo + row) * DM + ch * 8;
        if (MODE == 1) { const u32x4 z = *(const u32x4*)(Zg + go);
            v.x = cvt_pk_bf16(bflo(v.x) * silu_f(bflo(z.x)), bfhi(v.x) * silu_f(bfhi(z.x))); v.y = cvt_pk_bf16(bflo(v.y) * silu_f(bflo(z.y)), bfhi(v.y) * silu_f(bfhi(z.y)));
            v.z = cvt_pk_bf16(bflo(v.z) * silu_f(bflo(z.z)), bfhi(v.z) * silu_f(bfhi(z.z))); v.w = cvt_pk_bf16(bflo(v.w) * silu_f(bflo(z.w)), bfhi(v.w) * silu_f(bfhi(z.w))); }
        *(u32x4*)(Og + go) = v; }
    LDS_WAIT();
}
struct MaskA {
    int L;
    __device__ __forceinline__ void info(int kb, int qlo, int r32, bool& act, bool& need, unsigned& W) const {
        const int seq0 = qlo & ~(L - 1); int lowk = qlo - 128; if (lowk < seq0) lowk = seq0;
        act = (kb <= qlo + 31) && (kb + KVBLK - 1 >= lowk); need = true;
        const int wl = qlo + r32 - seq0 + 1; W = (unsigned)(wl < 129 ? wl : 129);
    }
};
struct MaskB {
    int own0, base0; unsigned sel;
    __device__ __forceinline__ void info(int kb, int qlo, int r32, bool& act, bool& need, unsigned& W) const {
        if (kb >= own0) { act = kb <= qlo + 31; need = kb + KVBLK - 1 > qlo; W = 0x40000000u; }
        else { const int blk = (kb - base0) >> 8; const bool s = (sel >> blk) & 1u; const unsigned long long bal = __ballot(s);
            act = bal != 0ull; need = bal != ~0ull; W = s ? 0x40000000u : 0u; }
    }
};
#undef KSWZ
#undef SBAR
}

__device__ __forceinline__ void attn_a_flash(const Params& P, unsigned char* lds) {
    const int tid = otid();
    const bf16_t* QKV = (const bf16_t*)(P.ws + WS_QKV); bf16_t* OG = (bf16_t*)(P.ws + WS_OG); float* LSE = (float*)(P.ws + WS_LSE);
    for (int it = blockIdx.x; it < 3 * NH * (MTOK / 256); it += gridDim.x) {
        const int g = it >> 9, rem = it & 511, h = rem & 15, rb = rem >> 4;
        const int lg = 2 * g, L = SEQ >> lg, R0 = rb * 256;
        int krow0 = R0 - 128; { const int s0 = R0 & ~(L - 1); if (krow0 < s0) krow0 = s0; }
        const int NT = (R0 + 256 - krow0) >> 6;
        const fa::MaskA mk{L};
        fa::flash_block<0>(QKV + (size_t)(3 * g) * PART + (size_t)R0 * DM + h * HD, QKV + (size_t)(3 * g + 1) * PART + h * HD, QKV + (size_t)(3 * g + 2) * PART + h * HD,
                           krow0, NT, R0, slope_of(h) * (float)(1 << lg) * LOG2E, mk, lds, OG + (size_t)g * PART + h * HD, LSE + (size_t)g * MTOK * NH + h, nullptr, tid);
    }
}
__device__ __forceinline__ void attn_b_flash(const Params& P, unsigned char* lds) {
    const int tid = otid();
    const bf16_t* QKV = (const bf16_t*)(P.ws + WS_QKV); const bf16_t* Z = (const bf16_t*)(P.ws + WS_Z); bf16_t* G = (bf16_t*)(P.ws + WS_G); const float* KS = (const float*)(P.ws + WS_KSUM);
    LAS float* gk = (LAS float*)((LAS unsigned char*)lds + fa::OFF_GK); LAS unsigned* sel_l = (LAS unsigned*)((LAS unsigned char*)lds + fa::OFF_SEL);
    for (int it = blockIdx.x; it < NB * NH * 4; it += gridDim.x) {
        const int bh = it >> 2, s = it & 3, b = bh >> 4, h = bh & 15;
        for (int pass = 0; pass < 2; ++pass) {
            const int n = pass ? 7 - s : s, R0 = (b << 11) + (n << 8);
            unsigned sel = (1u << n) - 1u;
            if (n >= 4) {
                for (int i = tid; i < n * 128; i += NTHREADS) { const float* kp = KS + (size_t)(b * 8 + (i >> 7)) * DM + h * HD + (i & 127); gk[i] = kp[0] + kp[(size_t)32 * DM]; }
                __syncthreads();
                const int row = tid >> 1, half = tid & 1;
                const u32x4* qp = (const u32x4*)(QKV + (size_t)(R0 + row) * DM + h * HD + half * 64);
                float gt[7];
#pragma unroll
                for (int j = 0; j < 7; ++j) gt[j] = 0.f;
#pragma unroll
                for (int c = 0; c < 8; ++c) { const u32x4 w = qp[c]; const float q0 = bflo(w.x), q1 = bfhi(w.x), q2 = bflo(w.y), q3 = bfhi(w.y), q4 = bflo(w.z), q5 = bfhi(w.z), q6 = bflo(w.w), q7 = bfhi(w.w);
#pragma unroll
                    for (int j = 0; j < 7; ++j) if (j < n) { const LAS f32x4* kk = (const LAS f32x4*)(gk + j * 128 + half * 64 + c * 8); const f32x4 ka = kk[0], kb2 = kk[1];
                        gt[j] += (q0 * ka.x + q1 * ka.y) + (q2 * ka.z + q3 * ka.w) + (q4 * kb2.x + q5 * kb2.y) + (q6 * kb2.z + q7 * kb2.w); } }
#pragma unroll
                for (int j = 0; j < 7; ++j) gt[j] += __shfl_xor(gt[j], 1);
                unsigned mask = 0;
#pragma unroll
                for (int j = 0; j < 7; ++j) if (j < n) { int rank = 0;
#pragma unroll
                    for (int j2 = 0; j2 < 7; ++j2) if (j2 < n && (gt[j2] > gt[j] || (gt[j2] == gt[j] && j2 < j))) ++rank;
                    if (rank < 3) mask |= 1u << j; }
                if (half == 0) sel_l[row] = mask;
                __syncthreads();
                sel = sel_l[(tid >> 6) * 32 + (tid & 31)];
            }
            const fa::MaskB mk{R0, b << 11, sel};
            fa::flash_block<1>(QKV + (size_t)R0 * DM + h * HD, QKV + PART + h * HD, QKV + 2 * PART + h * HD, b << 11, 4 * (n + 1), R0, slope_of(h) * LOG2E, mk, lds,
                               G + h * HD, nullptr, Z + h * HD, tid);
        }
    }
}

__global__ void __launch_bounds__(NTHREADS, 2) fwd_mega(Params P) {
    extern __shared__ __attribute__((aligned(16))) unsigned char lds[];
    cg::grid_group grid = cg::this_grid();
    LAS unsigned char* lds3 = (LAS unsigned char*)lds;
    const bf16_t* Hb = (const bf16_t*)(P.ws + WS_H); const bf16_t* Gb = (const bf16_t*)(P.ws + WS_G);

    p0_mod(P, lds);
    p0_weights(P, lds);
    grid.sync();
    for (int layer = 0; layer < DEPTH; ++layer) {
        const bool isA = (layer & 1) == 0; const int j = layer >> 1;
        const float* xin = layer == 0 ? P.x : P.out;
        norm_phase(P, xin, layer);
        grid.sync();
        {
            pg8::Gemm g{Hb, isA ? (const bf16_t*)(P.ws + WS_WAIN) + (size_t)j * A_N * DM : (const bf16_t*)(P.ws + WS_WBIN) + (size_t)j * B_N * DM, MTOK, isA ? A_N : B_N, DM};
            pg8::StaticOrder S; S.init(MTOK, g.N, (int)gridDim.x, (int)blockIdx.x);
            pg8::Epi E{isA ? 0 : 1, (bf16_t*)(P.ws + WS_QKV), (bf16_t*)(P.ws + WS_Z), (float*)(P.ws + WS_KSUM), nullptr, nullptr, nullptr};
            pg8::gemm_phase<pg8::Epi, pg8::StaticOrder, true, true>(lds3, g, S, E);
        }
        grid.sync();
#if ATTN_A_FLASH
        if (isA) { attn_a_flash(P, lds); grid.sync(); combine_phase(P); }
#else
        if (isA) { attn_a_naive(P, lds); grid.sync(); combine_phase(P); }
#endif
#if ATTN_B_FLASH
        else { attn_b_flash(P, lds); }
#else
        else { attn_b_naive(P, lds); }
#endif
        grid.sync();
        {
            pg8::Gemm g{Gb, isA ? (const bf16_t*)(P.ws + WS_WAOUT) + (size_t)j * DM * DM : (const bf16_t*)(P.ws + WS_WBOUT) + (size_t)j * DM * DM, MTOK, DM, DM};
            pg8::StaticOrder S; S.init(MTOK, DM, (int)gridDim.x, (int)blockIdx.x);
            pg8::Epi E{2, nullptr, nullptr, nullptr, xin, P.out, (const float*)(P.ws + WS_MOD) + (size_t)layer * 4 * 6144 + 4096};
            pg8::gemm_phase<pg8::Epi, pg8::StaticOrder, true, true>(lds3, g, S, E);
        }
        grid.sync();
    }
    final_norm_phase(P);
}

extern "C" void kernel_launch(void* const* d_in, const int* in_sizes, int n_in, void* d_out, int out_size, void* d_ws, size_t ws_size, hipStream_t stream) {
    static int grid = 0;
    if (grid == 0) {
        if (n_in != 10 || in_sizes[0] != MTOK * DM || out_size != MTOK * DM || ws_size < WS_END) {
            fprintf(stderr, "kernel_launch: unexpected shapes/workspace (n_in %d, in0 %d, out %d, ws %zu, need %zu)\n", n_in, n_in > 0 ? in_sizes[0] : -1, out_size, ws_size, (size_t)WS_END); grid = -1; return; }
        int dev = 0, cus = 0, per_cu = 0;
        (void)hipGetDevice(&dev); (void)hipDeviceGetAttribute(&cus, hipDeviceAttributeMultiprocessorCount, dev);
        if (hipFuncSetAttribute((const void*)fwd_mega, hipFuncAttributeMaxDynamicSharedMemorySize, LDS_BYTES) != hipSuccess) { fprintf(stderr, "kernel_launch: hipFuncSetAttribute failed\n"); grid = -1; return; }
        if (hipOccupancyMaxActiveBlocksPerMultiprocessor(&per_cu, (const void*)fwd_mega, NTHREADS, LDS_BYTES) != hipSuccess || per_cu < 1) { fprintf(stderr, "kernel_launch: occupancy query says %d\n", per_cu); (void)hipGetLastError(); per_cu = 1; }
        if (per_cu > 1) per_cu = 1;
        grid = cus * per_cu;
    }
    if (grid < 0) return;
    (void)hipMemsetAsync((char*)d_ws + WS_CTL, 0, 1 * MiB, stream);
    Params p{};
    p.x = (const float*)d_in[0]; p.c = (const float*)d_in[1]; p.norm_w = (const float*)d_in[2]; p.mod_w = (const float*)d_in[3]; p.mod_b = (const float*)d_in[4];
    p.a_w_in = (const float*)d_in[5]; p.a_w_out = (const float*)d_in[6]; p.b_w_in = (const float*)d_in[7]; p.b_w_out = (const float*)d_in[8]; p.final_w = (const float*)d_in[9];
    p.out = (float*)d_out; p.ws = (unsigned char*)d_ws;
    void* args[] = {&p};
    hipError_t e = hipLaunchCooperativeKernel((const void*)fwd_mega, dim3(grid), dim3(NTHREADS), args, LDS_BYTES, stream);
    if (e != hipSuccess) fprintf(stderr, "kernel_launch: cooperative launch failed: %s (grid %d)\n", hipGetErrorString(e), grid);
}
```

```cpp
#include <hip/hip_runtime.h>
#include <hip/hip_cooperative_groups.h>
#include <cstdio>
#include <cstdint>
namespace cg = cooperative_groups;
#ifndef ATTN_A_FLASH
#define ATTN_A_FLASH 1
#endif
#ifndef ATTN_B_FLASH
#define ATTN_B_FLASH 1
#endif

#define LAS __attribute__((address_space(3)))
typedef unsigned short bf16_t;
typedef short bf16x8 __attribute__((ext_vector_type(8)));
typedef short s16x4 __attribute__((ext_vector_type(4)));
typedef float f32x4 __attribute__((ext_vector_type(4)));
typedef float f32x16 __attribute__((ext_vector_type(16)));
typedef unsigned u32x4 __attribute__((ext_vector_type(4)));
typedef unsigned u32x2 __attribute__((ext_vector_type(2)));

constexpr int NB = 4, SEQ = 2048, DM = 2048, MTOK = NB * SEQ, NH = 16, HD = 128, DEPTH = 4;
constexpr int A_N = 10 * DM, B_N = 4 * DM;
constexpr float EPS = 1e-6f;
constexpr float LOG2E = 1.4426950408889634f;
constexpr float C2Q = 0.08838834764831845f * LOG2E;

constexpr size_t MiB = 1u << 20;
constexpr size_t WS_CTL = 0;
constexpr size_t WS_MOD = 1 * MiB;
constexpr size_t WS_KSUM = 2 * MiB;
constexpr size_t WS_LSE = 3 * MiB;
constexpr size_t WS_WAIN = 8 * MiB;
constexpr size_t WS_WBIN = WS_WAIN + 160 * MiB;
constexpr size_t WS_WAOUT = WS_WBIN + 64 * MiB;
constexpr size_t WS_WBOUT = WS_WAOUT + 16 * MiB;
constexpr size_t WS_H = WS_WBOUT + 16 * MiB;
constexpr size_t WS_G = WS_H + 32 * MiB;
constexpr size_t WS_QKV = WS_G + 32 * MiB;
constexpr size_t WS_Z = WS_QKV + 288 * MiB;
constexpr size_t WS_OG = WS_Z + 32 * MiB;
constexpr size_t WS_END = WS_OG + 96 * MiB;
constexpr size_t PART = (size_t)MTOK * DM;

constexpr int LDS_BYTES = 147456;
constexpr int NTHREADS = 512;

__device__ __forceinline__ unsigned cvt_pk_bf16(float lo, float hi) { unsigned r; asm volatile("v_cvt_pk_bf16_f32 %0, %1, %2" : "=v"(r) : "v"(lo), "v"(hi)); return r; }
__device__ __forceinline__ float bf2f(unsigned short v) { return __uint_as_float(((unsigned)v) << 16); }
__device__ __forceinline__ float bflo(unsigned w) { return __uint_as_float(w << 16); }
__device__ __forceinline__ float bfhi(unsigned w) { return __uint_as_float(w & 0xffff0000u); }
__device__ __forceinline__ float wave_sum(float v) {
#pragma unroll
    for (int o = 1; o < 64; o <<= 1) v += __shfl_xor(v, o);
    return v;
}
__device__ __forceinline__ float wave_max(float v) {
#pragma unroll
    for (int o = 1; o < 64; o <<= 1) v = fmaxf(v, __shfl_xor(v, o));
    return v;
}
__device__ __forceinline__ float silu_f(float v) { return v / (1.f + __expf(-v)); }
#define LDS_WAIT() asm volatile("s_waitcnt lgkmcnt(0)" ::: "memory")
__device__ __forceinline__ int otid() { int t = threadIdx.x; asm volatile("" : "+v"(t)); return t; }
template <class T> __device__ __forceinline__ T* optr(T* p) { asm volatile("" : "+s"(p)); return p; }

namespace pg8 {
constexpr int BM = 256, BK = 64, HALF = 128, HTB = HALF * BK * 2, STAGE_BYTES = 8 * HTB, NXCD = 8, WGM = 8;
__host__ __device__ __forceinline__ int lds_byte(int r, int c) { const int st = (r >> 4) * 2 + (c >> 5), rr = r & 15, cc = c & 31, ob = rr * 64 + cc * 2; return st * 1024 + (ob ^ (((ob >> 9) & 1) << 5)); }
__host__ __device__ __forceinline__ void stage_rc(int b, int& R, int& C) { const int st = b / 1024, sb = b % 1024, swz = sb ^ (((sb >> 9) & 1) << 5); R = (st >> 1) * 16 + swz / 64; C = (st & 1) * 32 + (swz % 64) / 2; }
__host__ __device__ __forceinline__ int perm32(int rho) { const int n = rho >> 4, i = rho & 15; return 8 * (i >> 2) + 4 * n + (i & 3); }
struct Unit { int pm, pn; };
struct Gemm { const bf16_t* A; const bf16_t* Bt; int M, N, K; };
struct StaticOrder {
    int nM, nN, nwg, G, c;
    __host__ __device__ void init(int M, int N, int G_, int c_) { nM = M / BM; nN = N / BM; nwg = nM * nN; G = G_; c = c_; }
    __host__ __device__ bool next(int i, Unit& u) const {
        const long L = (long)i * G + c; if (L >= nwg) return false;
        int wgid = (int)L; { const int q = nwg / NXCD, r = nwg % NXCD, xcd = wgid % NXCD, off = wgid / NXCD; wgid = (xcd < r ? xcd * (q + 1) : r * (q + 1) + (xcd - r) * q) + off; }
        const int nig = WGM * nN, gid = wgid / nig, fm = gid * WGM, gsz = (nM - fm) < WGM ? (nM - fm) : WGM;
        u.pm = fm + ((wgid % nig) % gsz); u.pn = (wgid % nig) / gsz; return true;
    }
    __device__ __forceinline__ void a_ready(const Unit&) const {}
    __device__ __forceinline__ void done(const Unit&) const {}
};

struct Epi {
    static constexpr bool PERM = true, AFTER_DRAIN = false;
    int mode;
    bf16_t* qkv; bf16_t* zbuf; float* ksum;
    const float* xin; float* xout; const float* gate;
    __device__ __forceinline__ void operator()(const f32x4 (&acc)[2][2][4][2], const Unit& u, int wr, int wc, int fr, int fq) const {
        if (mode == 2) {
            const int col0 = u.pn * BM + wc * 32 + 8 * fq; const int b = (u.pm * BM) >> 11;
            f32x4 gv[2][2];
#pragma unroll
            for (int bj = 0; bj < 2; ++bj)
#pragma unroll
                for (int n = 0; n < 2; ++n) gv[bj][n] = *(const f32x4*)(gate + b * 6144 + col0 + bj * HALF + 4 * n);
#pragma unroll
            for (int ai = 0; ai < 2; ++ai)
#pragma unroll
                for (int m = 0; m < 4; ++m) { const size_t off = (size_t)(u.pm * BM + ai * HALF + wr * 64 + m * 16 + fr) * DM + col0;
#pragma unroll
                    for (int bj = 0; bj < 2; ++bj)
#pragma unroll
                        for (int n = 0; n < 2; ++n) { const f32x4 xv = *(const f32x4*)(xin + off + bj * HALF + 4 * n);
                            *(f32x4*)(xout + off + bj * HALF + 4 * n) = xv + gv[bj][n] * acc[ai][bj][m][n]; }
                    asm volatile("" ::: "memory"); }
            return;
        }
        const int p = u.pn >> 3, colt = (u.pn & 7) * BM;
        int lg = 0; float sc = 1.f; bf16_t* base;
        if (mode == 0) { if (p == 9) base = zbuf; else { const int g = p / 3, kind = p - 3 * g; lg = 2 * g; base = qkv + (size_t)p * PART; if (kind == 0) sc = C2Q; } }
        else { if (p == 3) base = zbuf; else { base = qkv + (size_t)p * PART; if (p == 0) sc = C2Q; } }
        const int col0 = colt + wc * 32 + 8 * fq;
#pragma unroll
        for (int ai = 0; ai < 2; ++ai)
#pragma unroll
            for (int m = 0; m < 4; ++m) {
                const int row = u.pm * BM + ai * HALF + wr * 64 + m * 16 + fr, b = row >> 11, t = row & 2047;
                const int R = (b << 11) + ((t & ((1 << lg) - 1)) << (11 - lg)) + (t >> lg);
                bf16_t* rowp = base + (size_t)R * DM + col0;
#pragma unroll
                for (int bj = 0; bj < 2; ++bj) { const f32x4 v0 = acc[ai][bj][m][0] * sc, v1 = acc[ai][bj][m][1] * sc;
                    u32x4 w; w.x = cvt_pk_bf16(v0[0], v0[1]); w.y = cvt_pk_bf16(v0[2], v0[3]); w.z = cvt_pk_bf16(v1[0], v1[1]); w.w = cvt_pk_bf16(v1[2], v1[3]);
                    *(u32x4*)(rowp + bj * HALF) = w; } }
        if (mode == 1 && p == 1) {
#pragma unroll
            for (int bj = 0; bj < 2; ++bj)
#pragma unroll
                for (int n = 0; n < 2; ++n) { f32x4 s = {0.f, 0.f, 0.f, 0.f};
#pragma unroll
                    for (int ai = 0; ai < 2; ++ai)
#pragma unroll
                        for (int m = 0; m < 4; ++m) s += acc[ai][bj][m][n];
#pragma unroll
                    for (int j = 0; j < 4; ++j) { float v = s[j]; v += __shfl_xor(v, 1); v += __shfl_xor(v, 2); v += __shfl_xor(v, 4); v += __shfl_xor(v, 8); s[j] = v; }
                    if (fr == 0) *(f32x4*)(ksum + ((size_t)(wr * 32 + u.pm) * DM + colt + bj * HALF + wc * 32 + 8 * fq + 4 * n)) = s; }
        }
    }
};

template <class Epi, class Sched, bool ALIGN_EPI = false, bool SP2 = false>
__device__ __forceinline__ void gemm_phase(LAS unsigned char* lds, const Gemm g, const Sched& S, const Epi& E) {
    const int tid = otid(), wid = __builtin_amdgcn_readfirstlane(tid >> 6), lane = tid & 63, wr = wid >> 2, wc = wid & 3, fr = lane & 15, fq = lane >> 4;
    const int K = g.K, nt = K / BK;
    unsigned voffA[2], voffB[2];
#pragma unroll
    for (int i = 0; i < 2; ++i) { int R, C; stage_rc(tid * 16 + i * 8192, R, C); const int Rb = Epi::PERM ? ((R & ~31) + perm32(R & 31)) : R;
        voffA[i] = (unsigned)(R * K + C) * 2u; voffB[i] = (unsigned)(Rb * K + C) * 2u; }
    const size_t kstep = (size_t)(BK * 2);
    const size_t hstep = (size_t)HALF * K * 2;
    const size_t tstep = 2 * hstep;
    const unsigned ldsw = (unsigned)wid * 1024u;
    const int aoff = lds_byte(wr * 64 + fr, fq * 8), boff = lds_byte(wc * 32 + fr, fq * 8);
#define PG8_SA(b, h) (((b) * 2 + (h)) * HTB)
#define PG8_SB(b, h) ((4 + (b) * 2 + (h)) * HTB)
#define PG8_STAGE(bufoff, gbase, voff) do { _Pragma("unroll") for (int _i = 0; _i < 2; ++_i) \
        __builtin_amdgcn_global_load_lds((const unsigned*)((const char*)(gbase) + (voff)[_i]), (LAS unsigned*)(lds + (bufoff) + ldsw + _i * 8192), 16, 0, 0); } while (0)
#define PG8_LDA(dst, b, h) do { _Pragma("unroll") for (int m = 0; m < 4; ++m) _Pragma("unroll") for (int k = 0; k < 2; ++k) dst[m][k] = *(const LAS bf16x8*)(lds + PG8_SA(b, h) + aoff + m * 2048 + k * 1024); } while (0)
#define PG8_LDB(dst, b, h) do { _Pragma("unroll") for (int n = 0; n < 2; ++n) _Pragma("unroll") for (int k = 0; k < 2; ++k) dst[n][k] = *(const LAS bf16x8*)(lds + PG8_SB(b, h) + boff + n * 2048 + k * 1024); } while (0)
#define PG8_MMA(ai, bj, At, Bt) do { __builtin_amdgcn_s_setprio(1); _Pragma("unroll") for (int m = 0; m < 4; ++m) _Pragma("unroll") for (int n = 0; n < 2; ++n) _Pragma("unroll") for (int k = 0; k < 2; ++k) \
        acc[ai][bj][m][n] = __builtin_amdgcn_mfma_f32_16x16x32_bf16(Bt[n][k], At[m][k], acc[ai][bj][m][n], 0, 0, 0); __builtin_amdgcn_s_setprio(0); } while (0)
#define PG8_WAIT_V(n) asm volatile("s_waitcnt vmcnt(" #n ")" ::: "memory")
#define PG8_WAIT_L(n) asm volatile("s_waitcnt lgkmcnt(" #n ")" ::: "memory")
#define PG8_BAR __builtin_amdgcn_s_barrier()
#define PG8_SCHED __builtin_amdgcn_sched_barrier(0)
    Unit cur, nxt; int ui = 0;
    if (!S.next(0, cur)) return;
    f32x4 acc[2][2][4][2];
#pragma unroll
    for (int a = 0; a < 2; ++a)
#pragma unroll
        for (int b = 0; b < 2; ++b)
#pragma unroll
            for (int m = 0; m < 4; ++m)
#pragma unroll
                for (int n = 0; n < 2; ++n) acc[a][b][m][n] = (f32x4){0.f, 0.f, 0.f, 0.f};
    bf16x8 At[4][2], B0[2][2], B1[2][2];
    const char* cA = (const char*)g.A + (size_t)cur.pm * tstep; const char* cB = (const char*)g.Bt + (size_t)cur.pn * tstep;
    S.a_ready(cur);
    if constexpr (SP2) {
        PG8_STAGE(PG8_SB(0, 0), cB, voffB); PG8_STAGE(PG8_SB(0, 1), cB + hstep, voffB); PG8_STAGE(PG8_SA(0, 0), cA, voffA); PG8_STAGE(PG8_SA(0, 1), cA + hstep, voffA);
        if (wr == 1) PG8_BAR;
        PG8_WAIT_V(2); PG8_BAR;
        PG8_STAGE(PG8_SB(1, 0), cB + kstep, voffB); PG8_STAGE(PG8_SA(1, 0), cA + kstep, voffA); PG8_STAGE(PG8_SB(1, 1), cB + hstep + kstep, voffB);
        PG8_WAIT_V(6); PG8_BAR;
    } else {
        PG8_STAGE(PG8_SB(0, 0), cB, voffB); PG8_STAGE(PG8_SA(0, 0), cA, voffA); PG8_STAGE(PG8_SB(0, 1), cB + hstep, voffB); PG8_STAGE(PG8_SA(0, 1), cA + hstep, voffA);
        if (wr == 1) PG8_BAR;
        PG8_WAIT_V(4); PG8_BAR;
        PG8_STAGE(PG8_SB(1, 0), cB + kstep, voffB); PG8_STAGE(PG8_SA(1, 0), cA + kstep, voffA); PG8_STAGE(PG8_SB(1, 1), cB + hstep + kstep, voffB);
        PG8_WAIT_V(6); PG8_BAR;
    }
    for (;;) {
        const bool has_next = S.next(ui + 1, nxt);
        const char* nA = has_next ? (const char*)g.A + (size_t)nxt.pm * tstep : cA; const char* nB = has_next ? (const char*)g.Bt + (size_t)nxt.pn * tstep : cB;
        for (int t = 0; t < nt; t += 2) {
            const bool last = (t == nt - 2);
            const char* a1 = cA + (size_t)(t + 1) * kstep;
            const char* a2 = last ? nA : cA + (size_t)(t + 2) * kstep; const char* b2 = last ? nB : cB + (size_t)(t + 2) * kstep;
            const char* a3 = a2 + kstep; const char* b3 = b2 + kstep;
            if (last && has_next) S.a_ready(nxt);
            if constexpr (SP2) {
            PG8_LDB(B0, 0, 0); PG8_LDB(B1, 0, 1); PG8_SCHED; PG8_LDA(At, 0, 0); PG8_STAGE(PG8_SA(1, 1), a1 + hstep, voffA);
            PG8_WAIT_V(8); PG8_WAIT_L(0); PG8_BAR; PG8_MMA(0, 0, At, B0); PG8_MMA(0, 1, At, B1); PG8_BAR; PG8_SCHED;
            PG8_LDA(At, 0, 1); PG8_STAGE(PG8_SB(0, 0), b2, voffB); PG8_STAGE(PG8_SB(0, 1), b2 + hstep, voffB); PG8_STAGE(PG8_SA(0, 0), a2, voffA);
            PG8_WAIT_V(8); PG8_WAIT_L(0); PG8_BAR; PG8_MMA(1, 0, At, B0); PG8_MMA(1, 1, At, B1); PG8_BAR; PG8_SCHED;
            PG8_LDB(B0, 1, 0); PG8_LDB(B1, 1, 1); PG8_SCHED; PG8_LDA(At, 1, 0); PG8_STAGE(PG8_SA(0, 1), a2 + hstep, voffA);
            PG8_WAIT_V(8); PG8_WAIT_L(0); PG8_BAR; PG8_MMA(0, 0, At, B0); PG8_MMA(0, 1, At, B1); PG8_BAR; PG8_SCHED;
            PG8_LDA(At, 1, 1); PG8_STAGE(PG8_SB(1, 0), b3, voffB); PG8_STAGE(PG8_SB(1, 1), b3 + hstep, voffB); PG8_STAGE(PG8_SA(1, 0), a3, voffA);
            PG8_WAIT_V(8); PG8_WAIT_L(0); PG8_BAR; PG8_MMA(1, 0, At, B0); PG8_MMA(1, 1, At, B1); PG8_BAR; PG8_SCHED;
            } else {
            PG8_LDB(B0, 0, 0); PG8_SCHED; PG8_LDA(At, 0, 0); PG8_STAGE(PG8_SA(1, 1), a1 + hstep, voffA);
            PG8_WAIT_L(8); PG8_BAR; PG8_WAIT_L(0); PG8_MMA(0, 0, At, B0); PG8_BAR; PG8_SCHED;
            PG8_LDB(B1, 0, 1); PG8_STAGE(PG8_SB(0, 0), b2, voffB);
            PG8_BAR; PG8_WAIT_L(0); PG8_MMA(0, 1, At, B1); PG8_BAR;
            PG8_LDA(At, 0, 1); PG8_STAGE(PG8_SA(0, 0), a2, voffA);
            PG8_BAR; PG8_WAIT_L(0); PG8_MMA(1, 0, At, B0); PG8_BAR; PG8_SCHED;
            PG8_STAGE(PG8_SB(0, 1), b2 + hstep, voffB);
            PG8_WAIT_V(6); PG8_BAR; PG8_MMA(1, 1, At, B1); PG8_BAR;
            PG8_LDB(B0, 1, 0); PG8_SCHED; PG8_LDA(At, 1, 0); PG8_STAGE(PG8_SA(0, 1), a2 + hstep, voffA);
            PG8_WAIT_L(8); PG8_BAR; PG8_WAIT_L(0); PG8_MMA(0, 0, At, B0); PG8_BAR; PG8_SCHED;
            PG8_LDB(B1, 1, 1); PG8_STAGE(PG8_SB(1, 0), b3, voffB);
            PG8_BAR; PG8_WAIT_L(0); PG8_MMA(0, 1, At, B1); PG8_BAR;
            PG8_LDA(At, 1, 1); PG8_STAGE(PG8_SA(1, 0), a3, voffA);
            PG8_BAR; PG8_WAIT_L(0); PG8_MMA(1, 0, At, B0); PG8_BAR; PG8_SCHED;
            PG8_STAGE(PG8_SB(1, 1), b3 + hstep, voffB);
            PG8_WAIT_V(6); PG8_BAR; PG8_MMA(1, 1, At, B1); PG8_BAR;
            }
        }
        if constexpr (ALIGN_EPI) { if (wr == 0) PG8_BAR; }
        if constexpr (!Epi::AFTER_DRAIN) { E(acc, cur, wr, wc, fr, fq); S.done(cur); }
        if (!has_next) break;
#pragma unroll
        for (int a = 0; a < 2; ++a)
#pragma unroll
            for (int b = 0; b < 2; ++b)
#pragma unroll
                for (int m = 0; m < 4; ++m)
#pragma unroll
                    for (int n = 0; n < 2; ++n) acc[a][b][m][n] = (f32x4){0.f, 0.f, 0.f, 0.f};
        cur = nxt; cA = nA; cB = nB; ++ui;
        if constexpr (ALIGN_EPI) { if (wr == 1) PG8_BAR; }
    }
    PG8_WAIT_V(0);
    if constexpr (!ALIGN_EPI) { if (wr == 0) PG8_BAR; }
    PG8_BAR;
#undef PG8_SA
#undef PG8_SB
#undef PG8_STAGE
#undef PG8_LDA
#undef PG8_LDB
#undef PG8_MMA
#undef PG8_WAIT_V
#undef PG8_WAIT_L
#undef PG8_BAR
#undef PG8_SCHED
}
}

struct Params {
    const float *x, *c, *norm_w, *mod_w, *mod_b, *a_w_in, *a_w_out, *b_w_in, *b_w_out, *final_w;
    float* out; unsigned char* ws;
};

__device__ __forceinline__ void p0_mod(const Params& P, unsigned char* lds) {
    const int tid = otid();
    f32x4* condT = (f32x4*)lds;
    float* red = (float*)(lds + 32768);
    float* MOD = (float*)(P.ws + WS_MOD);
    bool have = false;
    for (int item = blockIdx.x; item < 192; item += gridDim.x) {
        if (!have) { have = true;
            for (int k = tid; k < DM; k += NTHREADS) { f32x4 v; v.x = silu_f(P.c[k]); v.y = silu_f(P.c[DM + k]); v.z = silu_f(P.c[2 * DM + k]); v.w = silu_f(P.c[3 * DM + k]); condT[k] = v; }
            __syncthreads(); }
        const int l = item / 48, n0 = (item % 48) * 128, cq = tid & 31, kp = tid >> 5;
        f32x4 a0 = {0.f, 0.f, 0.f, 0.f}, a1 = a0, a2 = a0, a3 = a0;
        const float* wp = P.mod_w + ((size_t)l * DM + kp * 128) * 6144 + n0 + 4 * cq;
#pragma unroll 8
        for (int k = 0; k < 128; ++k) { const f32x4 w = *(const f32x4*)(wp + (size_t)k * 6144); const f32x4 cv = condT[kp * 128 + k];
            a0 += w * cv.x; a1 += w * cv.y; a2 += w * cv.z; a3 += w * cv.w; }
        *(f32x4*)(red + (kp * 4 + 0) * 128 + 4 * cq) = a0; *(f32x4*)(red + (kp * 4 + 1) * 128 + 4 * cq) = a1;
        *(f32x4*)(red + (kp * 4 + 2) * 128 + 4 * cq) = a2; *(f32x4*)(red + (kp * 4 + 3) * 128 + 4 * cq) = a3;
        __syncthreads();
        { const int b = tid >> 7, col = tid & 127; float s = P.mod_b[l * 6144 + n0 + col];
#pragma unroll
            for (int q = 0; q < 16; ++q) s += red[(q * 4 + b) * 128 + col];
            MOD[(l * 4 + b) * 6144 + n0 + col] = s; }
        __syncthreads();
    }
}
__device__ __forceinline__ void p0_transpose_item(const float* W, int N, bf16_t* WT, unsigned char* scr, int item, int lane) {
    const int nblk = N >> 6, kb = item / nblk, nb = item - kb * nblk, k0 = kb * 64, n0 = nb * 64;
    const float* src = W + (size_t)(k0 + (lane >> 4)) * N + n0 + 4 * (lane & 15);
#pragma unroll 4
    for (int i = 0; i < 16; ++i) { const f32x4 v = *(const f32x4*)(src + (size_t)(4 * i) * N);
        unsigned* d = (unsigned*)(scr + (4 * i + (lane >> 4)) * 132 + 8 * (lane & 15));
        d[0] = cvt_pk_bf16(v.x, v.y); d[1] = cvt_pk_bf16(v.z, v.w); }
    LDS_WAIT();
    const int c = lane & 7;
#pragma unroll
    for (int j = 0; j < 8; ++j) { const int n = (lane >> 3) + 8 * j; const unsigned short* s = (const unsigned short*)(scr + (8 * c) * 132 + 2 * n);
        u32x4 o;
        o.x = (unsigned)s[0 * 66] | ((unsigned)s[1 * 66] << 16); o.y = (unsigned)s[2 * 66] | ((unsigned)s[3 * 66] << 16);
        o.z = (unsigned)s[4 * 66] | ((unsigned)s[5 * 66] << 16); o.w = (unsigned)s[6 * 66] | ((unsigned)s[7 * 66] << 16);
        *(u32x4*)(WT + (size_t)(n0 + n) * DM + k0 + 8 * c) = o; }
    LDS_WAIT();
}
__device__ __forceinline__ void p0_weights(const Params& P, unsigned char* lds) {
    const int tid_ = otid(); const int lane = tid_ & 63, wave = __builtin_amdgcn_readfirstlane(tid_ >> 6);
    unsigned char* scr = lds + 65536 + wave * 8448;
    const int gw = blockIdx.x * 8 + wave, NGW = gridDim.x * 8;
    constexpr int I_A = 32 * (A_N / 64), I_B = 32 * (B_N / 64), I_O = 32 * (DM / 64);
    constexpr int TOTAL = 2 * I_A + 2 * I_B + 4 * I_O;
    for (int it = gw; it < TOTAL; it += NGW) {
        int r = it;
        if (r < 2 * I_A) { const int j = r / I_A; p0_transpose_item(P.a_w_in + (size_t)j * DM * A_N, A_N, (bf16_t*)(P.ws + WS_WAIN) + (size_t)j * A_N * DM, scr, r - j * I_A, lane); continue; } r -= 2 * I_A;
        if (r < 2 * I_B) { const int j = r / I_B; p0_transpose_item(P.b_w_in + (size_t)j * DM * B_N, B_N, (bf16_t*)(P.ws + WS_WBIN) + (size_t)j * B_N * DM, scr, r - j * I_B, lane); continue; } r -= 2 * I_B;
        if (r < 2 * I_O) { const int j = r / I_O; p0_transpose_item(P.a_w_out + (size_t)j * DM * DM, DM, (bf16_t*)(P.ws + WS_WAOUT) + (size_t)j * DM * DM, scr, r - j * I_O, lane); continue; } r -= 2 * I_O;
        { const int j = r / I_O; p0_transpose_item(P.b_w_out + (size_t)j * DM * DM, DM, (bf16_t*)(P.ws + WS_WBOUT) + (size_t)j * DM * DM, scr, r - j * I_O, lane); }
    }
}

__device__ __forceinline__ void norm_phase(const Params& P, const float* xin, int layer) {
    const int tid_ = otid(); const int lane = tid_ & 63, wave = __builtin_amdgcn_readfirstlane(tid_ >> 6);
    const int gw = blockIdx.x * 8 + wave, NGW = gridDim.x * 8;
    const float* MOD = (const float*)(P.ws + WS_MOD);
    bf16_t* Hb = (bf16_t*)(P.ws + WS_H);
    for (int r0 = gw * 4; r0 < MTOK; r0 += NGW * 4) {
        const int b = r0 >> 11;
        const float* shift = MOD + (size_t)(layer * 4 + b) * 6144; const float* scale = shift + DM; const float* nw = P.norm_w + layer * DM;
        f32x4 ca[8], cs[8];
#pragma unroll
        for (int j = 0; j < 8; ++j) { const int c = 4 * lane + 256 * j; const f32x4 w = *(const f32x4*)(nw + c), s = *(const f32x4*)(scale + c); ca[j] = w * (s + 1.f); cs[j] = *(const f32x4*)(shift + c); }
        for (int rr = 0; rr < 4; ++rr) {
            const float* xr = xin + (size_t)(r0 + rr) * DM; f32x4 v[8]; float ss = 0.f;
#pragma unroll
            for (int j = 0; j < 8; ++j) { v[j] = *(const f32x4*)(xr + 4 * lane + 256 * j); ss += (v[j].x * v[j].x + v[j].y * v[j].y) + (v[j].z * v[j].z + v[j].w * v[j].w); }
            const float rs = 1.0f / sqrtf(wave_sum(ss) * (1.f / DM) + EPS);
            bf16_t* hr = Hb + (size_t)(r0 + rr) * DM;
#pragma unroll
            for (int j = 0; j < 8; ++j) { const f32x4 h = v[j] * rs * ca[j] + cs[j]; u32x2 w; w.x = cvt_pk_bf16(h.x, h.y); w.y = cvt_pk_bf16(h.z, h.w); *(u32x2*)(hr + 4 * lane + 256 * j) = w; }
        }
    }
}
__device__ __forceinline__ void final_norm_phase(const Params& P) {
    const int tid_ = otid(); const int lane = tid_ & 63, wave = __builtin_amdgcn_readfirstlane(tid_ >> 6);
    const int gw = blockIdx.x * 8 + wave, NGW = gridDim.x * 8;
    f32x4 cw[8];
#pragma unroll
    for (int j = 0; j < 8; ++j) cw[j] = *(const f32x4*)(P.final_w + 4 * lane + 256 * j);
    for (int r = gw; r < MTOK; r += NGW) {
        float* xr = P.out + (size_t)r * DM; f32x4 v[8]; float ss = 0.f;
#pragma unroll
        for (int j = 0; j < 8; ++j) { v[j] = *(const f32x4*)(xr + 4 * lane + 256 * j); ss += (v[j].x * v[j].x + v[j].y * v[j].y) + (v[j].z * v[j].z + v[j].w * v[j].w); }
        const float rs = 1.0f / sqrtf(wave_sum(ss) * (1.f / DM) + EPS);
#pragma unroll
        for (int j = 0; j < 8; ++j) *(f32x4*)(xr + 4 * lane + 256 * j) = v[j] * rs * cw[j];
    }
}

__device__ __forceinline__ void naive_attend(const bf16_t* Kh, const bf16_t* Vh, const float* qf, float* sc, int own_start, int own_len, int blkbase, int mask, int qpos, float slopeL, int lane,
                                             float& o0, float& o1, float& lse2) {
    int base = 0; float mx = -3.0e38f;
    { int m2 = mask;
      for (int rr = 0;; ++rr) { int start, len;
        if (rr == 0) { start = own_start; len = own_len; } else { if (!m2) break; const int j = __builtin_ctz(m2); m2 &= m2 - 1; start = blkbase + (j << 8); len = 256; }
        for (int i = lane; i < len; i += 64) { const int key = start + i; const u32x4* kp = (const u32x4*)(Kh + (size_t)key * DM); float dot = 0.f;
#pragma unroll 4
            for (int cch = 0; cch < 16; ++cch) { const u32x4 w = kp[cch]; const float* q = qf + cch * 8;
                dot += q[0] * bflo(w.x) + q[1] * bfhi(w.x) + q[2] * bflo(w.y) + q[3] * bfhi(w.y) + q[4] * bflo(w.z) + q[5] * bfhi(w.z) + q[6] * bflo(w.w) + q[7] * bfhi(w.w); }
            const float s = dot + slopeL * (float)(key - qpos); sc[base + i] = s; mx = fmaxf(mx, s); }
        base += len; } }
    const int tot = base; mx = wave_max(mx);
    LDS_WAIT();
    float sum = 0.f;
    for (int i = lane; i < tot; i += 64) { const float p = exp2f(sc[i] - mx); sc[i] = p; sum += p; }
    sum = wave_sum(sum);
    LDS_WAIT();
    float a0 = 0.f, a1 = 0.f; base = 0;
    { int m2 = mask;
      for (int rr = 0;; ++rr) { int start, len;
        if (rr == 0) { start = own_start; len = own_len; } else { if (!m2) break; const int j = __builtin_ctz(m2); m2 &= m2 - 1; start = blkbase + (j << 8); len = 256; }
        const bf16_t* vp = Vh + (size_t)start * DM + 2 * lane;
        for (int i = 0; i < len; ++i) { const float p = sc[base + i]; const unsigned w = *(const unsigned*)(vp + (size_t)i * DM); a0 += p * bflo(w); a1 += p * bfhi(w); }
        base += len; } }
    LDS_WAIT();
    const float inv = 1.f / sum; o0 = a0 * inv; o1 = a1 * inv; lse2 = mx + log2f(sum);
}
__device__ __forceinline__ float slope_of(int h) { return exp2f(-0.5f * (float)(h + 1)); }

__device__ __forceinline__ void attn_a_naive(const Params& P, unsigned char* lds) {
    const int tid_ = otid(); const int lane = tid_ & 63, wave = __builtin_amdgcn_readfirstlane(tid_ >> 6);
    float* qf = (float*)(lds + wave * 8192); float* sc = qf + 128;
    const bf16_t* QKV = (const bf16_t*)(P.ws + WS_QKV); bf16_t* OG = (bf16_t*)(P.ws + WS_OG); float* LSE = (float*)(P.ws + WS_LSE);
    const int gw = blockIdx.x * 8 + wave, NGW = gridDim.x * 8;
    for (int it = gw; it < 3 * MTOK * NH; it += NGW) {
        const int h = it & 15, R = (it >> 4) & (MTOK - 1), g = it >> 17;
        const int lg = 2 * g, L = SEQ >> lg;
        const bf16_t* Qp = QKV + (size_t)(3 * g) * PART + (size_t)R * DM + h * HD;
        { const unsigned w = *(const unsigned*)(Qp + 2 * lane); qf[2 * lane] = bflo(w); qf[2 * lane + 1] = bfhi(w); }
        LDS_WAIT();
        const int seq0 = R & ~(L - 1); int lo = R - 128; if (lo < seq0) lo = seq0;
        float o0, o1, lse2;
        naive_attend(QKV + (size_t)(3 * g + 1) * PART + h * HD, QKV + (size_t)(3 * g + 2) * PART + h * HD, qf, sc, lo, R - lo + 1, 0, 0, R, slope_of(h) * (float)(1 << lg) * LOG2E, lane, o0, o1, lse2);
        *(unsigned*)(OG + (size_t)g * PART + (size_t)R * DM + h * HD + 2 * lane) = cvt_pk_bf16(o0, o1);
        if (lane == 0) LSE[((size_t)g * MTOK + R) * NH + h] = lse2;
    }
}
__device__ __forceinline__ void combine_phase(const Params& P) {
    const int tid_ = otid(); const int lane = tid_ & 63, wave = __builtin_amdgcn_readfirstlane(tid_ >> 6);
    const int gw = blockIdx.x * 8 + wave, NGW = gridDim.x * 8;
    const bf16_t* OG = (const bf16_t*)(P.ws + WS_OG); const float* LSE = (const float*)(P.ws + WS_LSE); const bf16_t* Z = (const bf16_t*)(P.ws + WS_Z); bf16_t* G = (bf16_t*)(P.ws + WS_G);
    for (int m = gw; m < MTOK; m += NGW) {
        const int b = m >> 11, t = m & 2047;
        const int R0 = m, R1 = (b << 11) + ((t & 3) << 9) + (t >> 2), R2 = (b << 11) + ((t & 15) << 7) + (t >> 4);
#pragma unroll
        for (int j = 0; j < 4; ++j) { const int col = 8 * lane + 512 * j, h = col >> 7;
            const float l0 = LSE[((size_t)0 * MTOK + R0) * NH + h], l1 = LSE[((size_t)1 * MTOK + R1) * NH + h], l2 = LSE[((size_t)2 * MTOK + R2) * NH + h];
            const float mx = fmaxf(l0, fmaxf(l1, l2)); float e0 = exp2f(l0 - mx), e1 = exp2f(l1 - mx), e2 = exp2f(l2 - mx); const float inv = 1.f / (e0 + e1 + e2); e0 *= inv; e1 *= inv; e2 *= inv;
            const u32x4 a = *(const u32x4*)(OG + (size_t)R0 * DM + col), bb = *(const u32x4*)(OG + PART + (size_t)R1 * DM + col), cc = *(const u32x4*)(OG + 2 * PART + (size_t)R2 * DM + col);
            const u32x4 zz = *(const u32x4*)(Z + (size_t)m * DM + col);
            u32x4 o;
#define CMB(F) { const float v0 = (e0 * bflo(a.F) + e1 * bflo(bb.F) + e2 * bflo(cc.F)) * silu_f(bflo(zz.F)); const float v1 = (e0 * bfhi(a.F) + e1 * bfhi(bb.F) + e2 * bfhi(cc.F)) * silu_f(bfhi(zz.F)); o.F = cvt_pk_bf16(v0, v1); }
            CMB(x) CMB(y) CMB(z) CMB(w)
#undef CMB
            *(u32x4*)(G + (size_t)m * DM + col) = o; }
    }
}
__device__ __forceinline__ void attn_b_naive(const Params& P, unsigned char* lds) {
    const int tid_ = otid(); const int lane = tid_ & 63, wave = __builtin_amdgcn_readfirstlane(tid_ >> 6);
    float* qf = (float*)(lds + wave * 8192); float* sc = qf + 128;
    const bf16_t* QKV = (const bf16_t*)(P.ws + WS_QKV); const bf16_t* Z = (const bf16_t*)(P.ws + WS_Z); bf16_t* G = (bf16_t*)(P.ws + WS_G); const float* KS = (const float*)(P.ws + WS_KSUM);
    const int gw = blockIdx.x * 8 + wave, NGW = gridDim.x * 8;
    for (int it = gw; it < MTOK * NH; it += NGW) {
        const int h = it & 15, m = it >> 4, b = m >> 11, t = m & 2047, n = t >> 8;
        const bf16_t* Qp = QKV + (size_t)m * DM + h * HD;
        float q0, q1; { const unsigned w = *(const unsigned*)(Qp + 2 * lane); q0 = bflo(w); q1 = bfhi(w); qf[2 * lane] = q0; qf[2 * lane + 1] = q1; }
        LDS_WAIT();
        float gt[8];
#pragma unroll
        for (int j = 0; j < 8; ++j) { float v = 0.f;
            if (j < n) { const float* k0 = KS + (size_t)(b * 8 + j) * DM + h * HD + 2 * lane; const float* k1 = k0 + (size_t)32 * DM; v = q0 * (k0[0] + k1[0]) + q1 * (k0[1] + k1[1]); }
            gt[j] = wave_sum(v); }
        int mask = 0;
#pragma unroll
        for (int j = 0; j < 8; ++j) { if (j < n) { int rank = 0;
#pragma unroll
                for (int j2 = 0; j2 < 8; ++j2) if (j2 < n && (gt[j2] > gt[j] || (gt[j2] == gt[j] && j2 < j))) ++rank;
                if (rank < 3) mask |= 1 << j; } }
        float o0, o1, lse2;
        naive_attend(QKV + PART + h * HD, QKV + 2 * PART + h * HD, qf, sc, (b << 11) + (n << 8), (t & 255) + 1, b << 11, mask, m, slope_of(h) * LOG2E, lane, o0, o1, lse2);
        const unsigned zw = *(const unsigned*)(Z + (size_t)m * DM + h * HD + 2 * lane);
        *(unsigned*)(G + (size_t)m * DM + h * HD + 2 * lane) = cvt_pk_bf16(o0 * silu_f(bflo(zw)), o1 * silu_f(bfhi(zw)));
    }
}

namespace fa {
constexpr int KVBLK = 64, SHM_K = KVBLK * HD * 2, SHM_V = KVBLK * HD * 2;
constexpr int OFF_V = 0, OFF_K = 2 * SHM_V, OFF_WS = OFF_K + 2 * SHM_K, OFF_OST = OFF_WS + 8 * 256, OST_ROW = 272, OST_WAVE = 32 * OST_ROW;
constexpr int OFF_GK = OFF_OST + 8 * OST_WAVE, OFF_SEL = OFF_GK + 7 * 128 * 4, OFF_END = OFF_SEL + 256 * 4;
static_assert(OFF_END <= LDS_BYTES - 1024, "attention LDS map");
constexpr float THR = 11.5f;
#define KSWZ(row, colB) ((row) * 256 + ((colB) ^ (((row) & 7) << 4)))
#define SBAR() __builtin_amdgcn_sched_barrier(0)
__device__ __forceinline__ int v_st(int k, int c) { const int kk = (k & ~0xC) | ((k & 4) << 1) | ((k & 8) >> 1); return ((kk >> 3) * 4 + (c >> 5)) * 512 + ((kk & 7) * 32 + (c & 31)) * 2; }
__device__ __forceinline__ int v_rd_base(int lane) { return ((lane & 3) << 3) | (((lane >> 2) & 3) << 6) | (((lane >> 4) & 1) << 5) | (((lane >> 5) & 1) << 8); }
constexpr int v_rd_off(int d0, int ks, int half) { return d0 * 512 + ks * 4096 + half * 2048; }
__device__ __forceinline__ int crow(int r, int hi) { return (r & 3) + 8 * (r >> 2) + 4 * hi; }
__device__ __forceinline__ void mask_tile(f32x16& p0, f32x16& p1, int dq, unsigned W) {
    const float NEG = -__builtin_inff();
#pragma unroll
    for (int r = 0; r < 16; ++r) { const int c = (r & 3) + 8 * (r >> 2);
        if ((unsigned)(dq - c) >= W) p0[r] = NEG;
        if ((unsigned)(dq - c - 32) >= W) p1[r] = NEG; }
}
__device__ __forceinline__ void partialSM(f32x16& p0, f32x16& p1, float& m_reg, float& alpha) {
    float pmax = p0[0];
#pragma unroll
    for (int r = 1; r < 16; ++r) pmax = fmaxf(pmax, p0[r]);
#pragma unroll
    for (int r = 0; r < 16; ++r) pmax = fmaxf(pmax, p1[r]);
    { auto rr = __builtin_amdgcn_permlane32_swap(__float_as_uint(pmax), __float_as_uint(pmax), false, false); pmax = fmaxf(__uint_as_float(rr[0]), __uint_as_float(rr[1])); }
    float mn;
    if (__builtin_expect(__all(pmax - m_reg <= THR), 1)) { mn = m_reg; alpha = 1.f; }
    else { mn = fmaxf(m_reg, pmax); alpha = __builtin_amdgcn_exp2f(m_reg - mn); m_reg = mn; }
#pragma unroll
    for (int r = 0; r < 16; ++r) p0[r] = __builtin_amdgcn_exp2f(p0[r] - mn);
#pragma unroll
    for (int r = 0; r < 16; ++r) p1[r] = __builtin_amdgcn_exp2f(p1[r] - mn);
}
__device__ __forceinline__ void finishSM(f32x16& p0, f32x16& p1, float alpha, float& l_reg, bf16x8& pa0, bf16x8& pa1, bf16x8& pa2, bf16x8& pa3) {
    float ps = 0;
#pragma unroll
    for (int r = 0; r < 16; ++r) ps += p0[r];
#pragma unroll
    for (int r = 0; r < 16; ++r) ps += p1[r];
    { auto rr = __builtin_amdgcn_permlane32_swap(__float_as_uint(ps), __float_as_uint(ps), false, false); ps = __uint_as_float(rr[0]) + __uint_as_float(rr[1]); }
    l_reg = l_reg * alpha + ps;
#define PK4(P, B_, OUT) do { unsigned a0 = cvt_pk_bf16(P[B_+0], P[B_+1]), a1 = cvt_pk_bf16(P[B_+2], P[B_+3]);                          \
        unsigned b0 = cvt_pk_bf16(P[B_+4], P[B_+5]), b1 = cvt_pk_bf16(P[B_+6], P[B_+7]);                                             \
        auto r0 = __builtin_amdgcn_permlane32_swap(a0, b0, false, false); auto r1 = __builtin_amdgcn_permlane32_swap(a1, b1, false, false); \
        u32x4 w = {r0[0], r1[0], r0[1], r1[1]}; OUT = *reinterpret_cast<bf16x8*>(&w); } while (0)
    PK4(p0, 0, pa0); PK4(p0, 8, pa1); PK4(p1, 0, pa2); PK4(p1, 8, pa3);
#undef PK4
}
template <int KB>
__device__ __forceinline__ void qkt(f32x16& p0, f32x16& p1, const LAS char* K_lds, int r32, int hi, const bf16x8* qr) {
    const LAS char* kb[4];
#pragma unroll
    for (int dd = 0; dd < 4; ++dd) kb[dd] = K_lds + KB * SHM_K + KSWZ(r32, (dd * 16 + hi * 8) * 2);
#pragma unroll
    for (int d0 = 0; d0 < 8; ++d0) { const LAS char* a = kb[d0 & 3] + (d0 >> 2) * 128;
        const bf16x8 b0 = *reinterpret_cast<const LAS bf16x8*>(a);
        const bf16x8 b1 = *reinterpret_cast<const LAS bf16x8*>(a + 32 * 256);
        p0 = __builtin_amdgcn_mfma_f32_32x32x16_bf16(b0, qr[d0], p0, 0, 0, 0);
        p1 = __builtin_amdgcn_mfma_f32_32x32x16_bf16(b1, qr[d0], p1, 0, 0, 0); }
}
template <int VB>
__device__ __forceinline__ void pv_tile(f32x16* o, int vb0, bf16x8 pa0, bf16x8 pa1, bf16x8 pa2, bf16x8 pa3) {
#define TRRD(dst, off) asm volatile("ds_read_b64_tr_b16 %0, %1 offset:%2" : "=&v"(dst) : "v"(vb0), "i"(off) : "memory")
#define PV_D0(d0) do { s16x4 l0, l1, l2, l3, h0, h1, h2, h3; constexpr int b_ = VB * SHM_V + v_rd_off(d0, 0, 0); \
        TRRD(l0, b_); TRRD(h0, b_ + 2048); TRRD(l1, b_ + 4096); TRRD(h1, b_ + 6144); TRRD(l2, b_ + 8192); TRRD(h2, b_ + 10240); TRRD(l3, b_ + 12288); TRRD(h3, b_ + 14336); \
        asm volatile("s_waitcnt lgkmcnt(0)" ::: "memory"); SBAR();   \
        o[d0] = __builtin_amdgcn_mfma_f32_32x32x16_bf16(pa0, (bf16x8){l0[0], l0[1], l0[2], l0[3], h0[0], h0[1], h0[2], h0[3]}, o[d0], 0, 0, 0);   \
        o[d0] = __builtin_amdgcn_mfma_f32_32x32x16_bf16(pa1, (bf16x8){l1[0], l1[1], l1[2], l1[3], h1[0], h1[1], h1[2], h1[3]}, o[d0], 0, 0, 0);   \
        o[d0] = __builtin_amdgcn_mfma_f32_32x32x16_bf16(pa2, (bf16x8){l2[0], l2[1], l2[2], l2[3], h2[0], h2[1], h2[2], h2[3]}, o[d0], 0, 0, 0);   \
        o[d0] = __builtin_amdgcn_mfma_f32_32x32x16_bf16(pa3, (bf16x8){l3[0], l3[1], l3[2], l3[3], h3[0], h3[1], h3[2], h3[3]}, o[d0], 0, 0, 0); } while (0)
    PV_D0(0); PV_D0(1); PV_D0(2); PV_D0(3);
#undef PV_D0
#undef TRRD
}

template <int MODE, class MK>
__device__ __forceinline__ void flash_block(const bf16_t* Q, const bf16_t* K, const bf16_t* V, int krow0, int NT, int qrow0, float slopeL, const MK& mk,
                                            unsigned char* lds, bf16_t* Og, float* Lse, const bf16_t* Zg, int tid) {
    const int wid = __builtin_amdgcn_readfirstlane(tid >> 6), lane = tid & 63, r32 = lane & 31, hi = lane >> 5;
    const LAS char* K_lds = (const LAS char*)(LAS unsigned char*)lds + OFF_K;
    LAS char* Kw = (LAS char*)(LAS unsigned char*)lds + OFF_K; LAS char* Vw = (LAS char*)(LAS unsigned char*)lds + OFF_V;
    LAS float* wsf = (LAS float*)((LAS unsigned char*)lds + OFF_WS) + wid * 64; LAS float* li_l = wsf; LAS float* al_l = wsf + 32;
    const int sr = tid >> 4, sc = (tid & 15) * 8, vst0 = v_st(sr, sc), vst1 = v_st(32 + sr, sc), kws = KSWZ(sr, sc * 2);
    const int vb0 = (int)(unsigned)(uintptr_t)((LAS unsigned char*)lds) + OFF_V + v_rd_base(lane);
    const int qlo = qrow0 + wid * 32, qm = qlo + r32 - 4 * hi;
    bf16x8 st_k0, st_k1, st_v0, st_v1;
#define SLOAD(kb_) do { const size_t o0_ = (size_t)((kb_) + sr) * DM + sc, o1_ = o0_ + (size_t)32 * DM; \
        st_v0 = *(const bf16x8*)(V + o0_); st_v1 = *(const bf16x8*)(V + o1_); st_k0 = *(const bf16x8*)(K + o0_); st_k1 = *(const bf16x8*)(K + o1_); } while (0)
#define SWRITE(bf) do { *(LAS bf16x8*)(Vw + (bf) * SHM_V + vst0) = st_v0; *(LAS bf16x8*)(Vw + (bf) * SHM_V + vst1) = st_v1; \
        *(LAS bf16x8*)(Kw + (bf) * SHM_K + kws) = st_k0; *(LAS bf16x8*)(Kw + (bf) * SHM_K + kws + 32 * 256) = st_k1; } while (0)
    bf16x8 qr[8];
#pragma unroll
    for (int d0 = 0; d0 < 8; ++d0) qr[d0] = *(const bf16x8*)(Q + (size_t)(wid * 32 + r32) * DM + d0 * 16 + hi * 8);
    SLOAD(krow0); asm volatile("s_waitcnt vmcnt(0)" ::: "memory"); SWRITE(0);
    __syncthreads();
    float m_reg = -1e30f, l_reg = 0.f; f32x16 o[4] = {};
#define STEP(t, KB) do { const int kb_ = krow0 + (t) * KVBLK;                                                                   \
        if ((t) + 1 < NT) SLOAD(kb_ + KVBLK);                                                                                     \
        bool act_, need_; unsigned W_; mk.info(kb_, qlo, r32, act_, need_, W_);                                                 \
        if (act_) { f32x16 p0, p1; const float a0_ = slopeL * (float)(kb_ - qm);                                                  \
            _Pragma("unroll") for (int r = 0; r < 16; ++r) { p0[r] = fmaf(slopeL, (float)((r & 3) + 8 * (r >> 2)), a0_); p1[r] = p0[r] + 32.f * slopeL; } \
            qkt<KB>(p0, p1, K_lds, r32, hi, qr);                                                                                  \
            if (need_) mask_tile(p0, p1, qm - kb_, W_);                                                                           \
            float alpha_; partialSM(p0, p1, m_reg, alpha_);                                                                       \
            bf16x8 pa0, pa1, pa2, pa3; finishSM(p0, p1, alpha_, l_reg, pa0, pa1, pa2, pa3);                                       \
            if (__any(alpha_ < 1.f)) { if (hi == 0) al_l[r32] = alpha_; LDS_WAIT();                                               \
                _Pragma("unroll") for (int d_ = 0; d_ < 4; ++d_) _Pragma("unroll") for (int r = 0; r < 16; ++r) o[d_][r] *= al_l[crow(r, hi)]; } \
            SBAR(); pv_tile<KB>(o, vb0, pa0, pa1, pa2, pa3); }                                                                    \
        if ((t) + 1 < NT) { asm volatile("s_waitcnt vmcnt(0)" ::: "memory"); SWRITE((KB) ^ 1); }                               \
        __syncthreads(); } while (0)
    for (int t = 0; t < NT; t += 2) { STEP(t, 0); STEP(t + 1, 1); }
#undef STEP
#undef SLOAD
#undef SWRITE
    if (hi == 0) li_l[r32] = l_reg;
    LDS_WAIT();
    LAS unsigned char* stg = (LAS unsigned char*)lds + OFF_OST + wid * OST_WAVE;
#pragma unroll
    for (int r = 0; r < 16; ++r) { const int orow = crow(r, hi); const float rl = __builtin_amdgcn_rcpf(li_l[orow]);
#pragma unroll
        for (int d0 = 0; d0 < 4; ++d0) *(LAS unsigned short*)(stg + orow * OST_ROW + (d0 * 32 + r32) * 2) = (unsigned short)(cvt_pk_bf16(o[d0][r] * rl, 0.f) & 0xffffu); }
    LDS_WAIT();
    if (MODE == 0) { if (hi == 0) Lse[(size_t)(qlo + r32) * NH] = m_reg + log2f(l_reg); }
#pragma unroll
    for (int i = 0; i < 8; ++i) { const int row = i * 4 + (lane >> 4), ch = lane & 15;
        u32x4 v = *(const LAS u32x4*)(stg + row * OST_ROW + ch * 16);
        const size_t go = (size_t)(qlo + row) * DM + ch * 8;
        if (MODE == 1) { const u32x4 z = *(const u32x4*)(Zg + go);
            v.x = cvt_pk_bf16(bflo(v.x) * silu_f(bflo(z.x)), bfhi(v.x) * silu_f(bfhi(z.x))); v.y = cvt_pk_bf16(bflo(v.y) * silu_f(bflo(z.y)), bfhi(v.y) * silu_f(bfhi(z.y)));
            v.z = cvt_pk_bf16(bflo(v.z) * silu_f(bflo(z.z)), bfhi(v.z) * silu_f(bfhi(z.z))); v.w = cvt_pk_bf16(bflo(v.w) * silu_f(bflo(z.w)), bfhi(v.w) * silu_f(bfhi(z.w))); }
        *(u32x4*)(Og + go) = v; }
    LDS_WAIT();
}
struct MaskA {
    int L;
    __device__ __forceinline__ void info(int kb, int qlo, int r32, bool& act, bool& need, unsigned& W) const {
        const int seq0 = qlo & ~(L - 1); int lowk = qlo - 128; if (lowk < seq0) lowk = seq0;
        act = (kb <= qlo + 31) && (kb + KVBLK - 1 >= lowk); need = true;
        const int wl = qlo + r32 - seq0 + 1; W = (unsigned)(wl < 129 ? wl : 129);
    }
};
struct MaskB {
    int own0, base0; unsigned sel;
    __device__ __forceinline__ void info(int kb, int qlo, int r32, bool& act, bool& need, unsigned& W) const {
        if (kb >= own0) { act = kb <= qlo + 31; need = kb + KVBLK - 1 > qlo; W = 0x40000000u; }
        else { const int blk = (kb - base0) >> 8; const bool s = (sel >> blk) & 1u; const unsigned long long bal = __ballot(s);
            act = bal != 0ull; need = bal != ~0ull; W = s ? 0x40000000u : 0u; }
    }
};
#undef KSWZ
#undef SBAR
}

__device__ __forceinline__ void attn_a_flash(const Params& P, unsigned char* lds) {
    const int tid = otid();
    const bf16_t* QKV = (const bf16_t*)(P.ws + WS_QKV); bf16_t* OG = (bf16_t*)(P.ws + WS_OG); float* LSE = (float*)(P.ws + WS_LSE);
    for (int it = blockIdx.x; it < 3 * NH * (MTOK / 256); it += gridDim.x) {
        const int g = it >> 9, rem = it & 511, h = rem & 15, rb = rem >> 4;
        const int lg = 2 * g, L = SEQ >> lg, R0 = rb * 256;
        int krow0 = R0 - 128; { const int s0 = R0 & ~(L - 1); if (krow0 < s0) krow0 = s0; }
        const int NT = (R0 + 256 - krow0) >> 6;
        const fa::MaskA mk{L};
        fa::flash_block<0>(QKV + (size_t)(3 * g) * PART + (size_t)R0 * DM + h * HD, QKV + (size_t)(3 * g + 1) * PART + h * HD, QKV + (size_t)(3 * g + 2) * PART + h * HD,
                           krow0, NT, R0, slope_of(h) * (float)(1 << lg) * LOG2E, mk, lds, OG + (size_t)g * PART + h * HD, LSE + (size_t)g * MTOK * NH + h, nullptr, tid);
    }
}
__device__ __forceinline__ void attn_b_flash(const Params& P, unsigned char* lds) {
    const int tid = otid();
    const bf16_t* QKV = (const bf16_t*)(P.ws + WS_QKV); const bf16_t* Z = (const bf16_t*)(P.ws + WS_Z); bf16_t* G = (bf16_t*)(P.ws + WS_G); const float* KS = (const float*)(P.ws + WS_KSUM);
    LAS float* gk = (LAS float*)((LAS unsigned char*)lds + fa::OFF_GK); LAS unsigned* sel_l = (LAS unsigned*)((LAS unsigned char*)lds + fa::OFF_SEL);
    for (int it = blockIdx.x; it < NB * NH * 4; it += gridDim.x) {
        const int bh = it >> 2, s = it & 3, b = bh >> 4, h = bh & 15;
        for (int pass = 0; pass < 2; ++pass) {
            const int n = pass ? 7 - s : s, R0 = (b << 11) + (n << 8);
            unsigned sel = (1u << n) - 1u;
            if (n >= 4) {
                for (int i = tid; i < n * 128; i += NTHREADS) { const float* kp = KS + (size_t)(b * 8 + (i >> 7)) * DM + h * HD + (i & 127); gk[i] = kp[0] + kp[(size_t)32 * DM]; }
                __syncthreads();
                const int row = tid >> 1, half = tid & 1;
                const u32x4* qp = (const u32x4*)(QKV + (size_t)(R0 + row) * DM + h * HD + half * 64);
                float gt[7];
#pragma unroll
                for (int j = 0; j < 7; ++j) gt[j] = 0.f;
#pragma unroll
                for (int c = 0; c < 8; ++c) { const u32x4 w = qp[c]; const float q0 = bflo(w.x), q1 = bfhi(w.x), q2 = bflo(w.y), q3 = bfhi(w.y), q4 = bflo(w.z), q5 = bfhi(w.z), q6 = bflo(w.w), q7 = bfhi(w.w);
#pragma unroll
                    for (int j = 0; j < 7; ++j) if (j < n) { const LAS f32x4* kk = (const LAS f32x4*)(gk + j * 128 + half * 64 + c * 8); const f32x4 ka = kk[0], kb2 = kk[1];
                        gt[j] += (q0 * ka.x + q1 * ka.y) + (q2 * ka.z + q3 * ka.w) + (q4 * kb2.x + q5 * kb2.y) + (q6 * kb2.z + q7 * kb2.w); } }
#pragma unroll
                for (int j = 0; j < 7; ++j) gt[j] += __shfl_xor(gt[j], 1);
                unsigned mask = 0;
#pragma unroll
                for (int j = 0; j < 7; ++j) if (j < n) { int rank = 0;
#pragma unroll
                    for (int j2 = 0; j2 < 7; ++j2) if (j2 < n && (gt[j2] > gt[j] || (gt[j2] == gt[j] && j2 < j))) ++rank;
                    if (rank < 3) mask |= 1u << j; }
                if (half == 0) sel_l[row] = mask;
                __syncthreads();
                sel = sel_l[(tid >> 6) * 32 + (tid & 31)];
            }
            const fa::MaskB mk{R0, b << 11, sel};
            fa::flash_block<1>(QKV + (size_t)R0 * DM + h * HD, QKV + PART + h * HD, QKV + 2 * PART + h * HD, b << 11, 4 * (n + 1), R0, slope_of(h) * LOG2E, mk, lds,
                               G + h * HD, nullptr, Z + h * HD, tid);
        }
    }
}

#define XB_TMO      128
#define XB_XCNT(j)  (256  + 64 * (j))
#define XB_XSUB(j)  (1280 + 64 * (j))
#define XB_XGEN(j)  (2304 + 64 * (j))
#define XB_TOP      3328
#define XB_TOPGEN   3392
#define XCD_BAR_WORDS 3456
#define XB_SPIN_CAP (1u << 20)
__device__ __forceinline__ unsigned xb_ld(unsigned* p)              { return __hip_atomic_load(p, __ATOMIC_RELAXED, __HIP_MEMORY_SCOPE_AGENT); }
__device__ __forceinline__ unsigned xb_add(unsigned* p, unsigned v) { return __hip_atomic_fetch_add(p, v, __ATOMIC_RELAXED, __HIP_MEMORY_SCOPE_AGENT); }
__device__ __forceinline__ unsigned xb_xcc_id() { return (unsigned)__builtin_amdgcn_s_getreg((3 << 11) | 20) & 0xFu; }
#define XB_SPIN(cond, bar) do { unsigned _sp = 0; while (cond) { __builtin_amdgcn_s_sleep(1); \
    if ((++_sp & 255u) == 0u) { if (xb_ld(&(bar)[XB_TMO])) break; if (_sp > XB_SPIN_CAP) { atomicAdd(&(bar)[XB_TMO], 1u); break; } } } } while (0)
struct XcdBarrier { unsigned* bar; unsigned x; volatile LAS unsigned* st; };
__device__ __forceinline__ XcdBarrier xcd_barrier_post(unsigned* bar, volatile LAS unsigned* st) {
    XcdBarrier b; b.bar = bar; b.x = xb_xcc_id(); b.st = st;
    if (threadIdx.x == 0) (void)xb_add(&bar[XB_XCNT(b.x)], 1u);
    return b;
}
__device__ __forceinline__ void xcd_barrier_complete(unsigned* bar, unsigned x, unsigned& nloc, unsigned& nx) {
    const unsigned G = gridDim.x * gridDim.y * gridDim.z;
    unsigned sum, cnt, mine, sp = 0u;
    for (;;) {
        sum = 0u; cnt = 0u; mine = 0u;
#pragma unroll
        for (unsigned j = 0; j < 16; ++j) { const unsigned c = xb_ld(&bar[XB_XCNT(j)]); sum += c; cnt += (c > 0u) ? 1u : 0u; mine = (j == x) ? c : mine; }
        if (sum == G) break;
        __builtin_amdgcn_s_sleep(1);
        if ((++sp & 255u) == 0u) { if (xb_ld(&bar[XB_TMO])) break; if (sp > XB_SPIN_CAP) { atomicAdd(&bar[XB_TMO], 1u); break; } }
    }
    nloc = mine > 0u ? mine : 1u; nx = cnt > 0u ? cnt : 1u;
}
__device__ __forceinline__ void xcd_barrier(const XcdBarrier& b) {
    asm volatile("s_waitcnt vmcnt(0)" ::: "memory");
    __syncthreads();
    if (threadIdx.x == 0) {
        unsigned* bar = b.bar;
        __builtin_amdgcn_s_waitcnt(0);
        unsigned nloc = b.st[0], nx = b.st[1];
        if (nloc == 0u) { xcd_barrier_complete(bar, b.x, nloc, nx); b.st[0] = nloc; b.st[1] = nx; }
        const unsigned old = xb_add(&bar[XB_XSUB(b.x)], 1u);
        const unsigned gen = old / nloc;
        if (old + 1u == (gen + 1u) * nloc) {
            __builtin_amdgcn_fence(__ATOMIC_RELEASE, "agent");
            asm volatile("s_waitcnt vmcnt(0)" ::: "memory");
            const unsigned og = xb_add(&bar[XB_TOP], 1u);
            const unsigned tg = og / nx;
            if (og + 1u == (tg + 1u) * nx) xb_add(&bar[XB_TOPGEN], 1u);
            else XB_SPIN(xb_ld(&bar[XB_TOPGEN]) == tg, bar);
            __builtin_amdgcn_fence(__ATOMIC_ACQUIRE, "agent");
            xb_add(&bar[XB_XGEN(b.x)], 1u);
            asm volatile("s_waitcnt vmcnt(0)" ::: "memory");
        } else {
            XB_SPIN(xb_ld(&bar[XB_XGEN(b.x)]) == gen, bar);
            __builtin_amdgcn_fence(__ATOMIC_ACQUIRE, "agent");
            asm volatile("s_waitcnt vmcnt(0)" ::: "memory");
        }
    }
    __syncthreads();
}

__global__ void __launch_bounds__(NTHREADS, 2) fwd_mega(Params P) {
    extern __shared__ __attribute__((aligned(16))) unsigned char lds[];
    cg::grid_group grid = cg::this_grid();
    LAS unsigned char* lds3 = (LAS unsigned char*)lds;
    const bf16_t* Hb = (const bf16_t*)(P.ws + WS_H); const bf16_t* Gb = (const bf16_t*)(P.ws + WS_G);

    volatile LAS unsigned* bst = (volatile LAS unsigned*)(lds3 + (LDS_BYTES - 64));
    if (threadIdx.x < 2) bst[threadIdx.x] = 0u;
    __syncthreads();
    const XcdBarrier xbar = xcd_barrier_post((unsigned*)(P.ws + WS_CTL), bst);
#define GSYNC() xcd_barrier(xbar)
    p0_mod(P, lds);
    p0_weights(P, lds);
    grid.sync();
    for (int layer = 0; layer < DEPTH; ++layer) {
        const bool isA = (layer & 1) == 0; const int j = layer >> 1;
        const float* xin = layer == 0 ? P.x : P.out;
        norm_phase(P, xin, layer);
        GSYNC();
        {
            pg8::Gemm g{Hb, isA ? (const bf16_t*)(P.ws + WS_WAIN) + (size_t)j * A_N * DM : (const bf16_t*)(P.ws + WS_WBIN) + (size_t)j * B_N * DM, MTOK, isA ? A_N : B_N, DM};
            pg8::StaticOrder S; S.init(MTOK, g.N, (int)gridDim.x, (int)blockIdx.x);
            pg8::Epi E{isA ? 0 : 1, (bf16_t*)(P.ws + WS_QKV), (bf16_t*)(P.ws + WS_Z), (float*)(P.ws + WS_KSUM), nullptr, nullptr, nullptr};
            pg8::gemm_phase<pg8::Epi, pg8::StaticOrder, true, true>(lds3, g, S, E);
        }
        GSYNC();
#if ATTN_A_FLASH
        if (isA) { attn_a_flash(P, lds); GSYNC(); combine_phase(P); }
#else
        if (isA) { attn_a_naive(P, lds); GSYNC(); combine_phase(P); }
#endif
#if ATTN_B_FLASH
        else { attn_b_flash(P, lds); }
#else
        else { attn_b_naive(P, lds); }
#endif
        GSYNC();
        {
            pg8::Gemm g{Gb, isA ? (const bf16_t*)(P.ws + WS_WAOUT) + (size_t)j * DM * DM : (const bf16_t*)(P.ws + WS_WBOUT) + (size_t)j * DM * DM, MTOK, DM, DM};
            pg8::StaticOrder S; S.init(MTOK, DM, (int)gridDim.x, (int)blockIdx.x);
            pg8::Epi E{2, nullptr, nullptr, nullptr, xin, P.out, (const float*)(P.ws + WS_MOD) + (size_t)layer * 4 * 6144 + 4096};
            pg8::gemm_phase<pg8::Epi, pg8::StaticOrder, true, true>(lds3, g, S, E);
        }
        GSYNC();
    }
    final_norm_phase(P);
}

extern "C" void kernel_launch(void* const* d_in, const int* in_sizes, int n_in, void* d_out, int out_size, void* d_ws, size_t ws_size, hipStream_t stream) {
    static int grid = 0;
    if (grid == 0) {
        if (n_in != 10 || in_sizes[0] != MTOK * DM || out_size != MTOK * DM || ws_size < WS_END) {
            fprintf(stderr, "kernel_launch: unexpected shapes/workspace (n_in %d, in0 %d, out %d, ws %zu, need %zu)\n", n_in, n_in > 0 ? in_sizes[0] : -1, out_size, ws_size, (size_t)WS_END); grid = -1; return; }
        int dev = 0, cus = 0, per_cu = 0;
        (void)hipGetDevice(&dev); (void)hipDeviceGetAttribute(&cus, hipDeviceAttributeMultiprocessorCount, dev);
        if (hipFuncSetAttribute((const void*)fwd_mega, hipFuncAttributeMaxDynamicSharedMemorySize, LDS_BYTES) != hipSuccess) { fprintf(stderr, "kernel_launch: hipFuncSetAttribute failed\n"); grid = -1; return; }
        if (hipOccupancyMaxActiveBlocksPerMultiprocessor(&per_cu, (const void*)fwd_mega, NTHREADS, LDS_BYTES) != hipSuccess || per_cu < 1) { fprintf(stderr, "kernel_launch: occupancy query says %d\n", per_cu); (void)hipGetLastError(); per_cu = 1; }
        if (per_cu > 1) per_cu = 1;
        grid = cus * per_cu;
    }
    if (grid < 0) return;
    (void)hipMemsetAsync((char*)d_ws + WS_CTL, 0, 16384, stream);
    Params p{};
    p.x = (const float*)d_in[0]; p.c = (const float*)d_in[1]; p.norm_w = (const float*)d_in[2]; p.mod_w = (const float*)d_in[3]; p.mod_b = (const float*)d_in[4];
    p.a_w_in = (const float*)d_in[5]; p.a_w_out = (const float*)d_in[6]; p.b_w_in = (const float*)d_in[7]; p.b_w_out = (const float*)d_in[8]; p.final_w = (const float*)d_in[9];
    p.out = (float*)d_out; p.ws = (unsigned char*)d_ws;
    void* args[] = {&p};
    hipError_t e = hipLaunchCooperativeKernel((const void*)fwd_mega, dim3(grid), dim3(NTHREADS), args, LDS_BYTES, stream);
    if (e != hipSuccess) fprintf(stderr, "kernel_launch: cooperative launch failed: %s (grid %d)\n", hipGetErrorString(e), grid);
}
```

```cpp
#include <hip/hip_runtime.h>
#include <hip/hip_cooperative_groups.h>
#include <cstdio>
#include <cstdint>
namespace cg = cooperative_groups;
#ifndef ATTN_A_FLASH
#define ATTN_A_FLASH 1
#endif
#ifndef GEMM_ALIGN
#define GEMM_ALIGN true
#endif
#ifndef GEMM_SP2
#define GEMM_SP2 true
#endif
#ifndef PROBE
#define PROBE 0
#endif
#ifndef ATTN_B_FLASH
#define ATTN_B_FLASH 1
#endif

#define LAS __attribute__((address_space(3)))
typedef unsigned short bf16_t;
typedef short bf16x8 __attribute__((ext_vector_type(8)));
typedef short s16x4 __attribute__((ext_vector_type(4)));
typedef float f32x4 __attribute__((ext_vector_type(4)));
typedef float f32x16 __attribute__((ext_vector_type(16)));
typedef unsigned u32x4 __attribute__((ext_vector_type(4)));
typedef unsigned u32x2 __attribute__((ext_vector_type(2)));
typedef int i32x4 __attribute__((ext_vector_type(4)));

constexpr int NB = 4, SEQ = 2048, DM = 2048, MTOK = NB * SEQ, NH = 16, HD = 128, DEPTH = 4;
constexpr int A_N = 10 * DM, B_N = 4 * DM;
constexpr float EPS = 1e-6f;
constexpr float LOG2E = 1.4426950408889634f;
constexpr float C2Q = 0.08838834764831845f * LOG2E;

constexpr size_t MiB = 1u << 20;
constexpr size_t WS_CTL = 0;
constexpr size_t WS_MOD = 1 * MiB;
constexpr size_t WS_KSUM = 2 * MiB;
constexpr size_t WS_LSE = 3 * MiB;
constexpr size_t WS_RS = 5 * MiB;
constexpr size_t WS_CSA = 6 * MiB;
constexpr size_t WS_CSB = 7 * MiB;
constexpr size_t WS_WAIN = 8 * MiB;
constexpr size_t WS_WBQK = WS_WAIN + 80 * MiB;
constexpr size_t WS_WBVZ = WS_WBQK + 32 * MiB;
constexpr size_t WS_WAOUT = WS_WBVZ + 16 * MiB;
constexpr size_t WS_WBOUT = WS_WAOUT + 16 * MiB;
constexpr size_t WS_H = WS_WBOUT + 16 * MiB;
constexpr size_t WS_HQ = WS_H + 32 * MiB;
constexpr size_t WS_G = WS_HQ + 16 * MiB;
constexpr size_t WS_QKV = WS_G + 32 * MiB;
constexpr size_t WS_Z = WS_QKV + 288 * MiB;
constexpr size_t WS_OG = WS_Z + 32 * MiB;
constexpr size_t WS_END = WS_OG + 96 * MiB;
constexpr size_t PART = (size_t)MTOK * DM;

constexpr int LDS_BYTES = 147456;
constexpr int NTHREADS = 512;

__device__ __forceinline__ unsigned cvt_pk_bf16(float lo, float hi) { unsigned r; asm volatile("v_cvt_pk_bf16_f32 %0, %1, %2" : "=v"(r) : "v"(lo), "v"(hi)); return r; }
__device__ __forceinline__ float bf2f(unsigned short v) { return __uint_as_float(((unsigned)v) << 16); }
__device__ __forceinline__ float bflo(unsigned w) { return __uint_as_float(w << 16); }
__device__ __forceinline__ float bfhi(unsigned w) { return __uint_as_float(w & 0xffff0000u); }
__device__ __forceinline__ float wave_sum(float v) {
#pragma unroll
    for (int o = 1; o < 64; o <<= 1) v += __shfl_xor(v, o);
    return v;
}
__device__ __forceinline__ float wave_max(float v) {
#pragma unroll
    for (int o = 1; o < 64; o <<= 1) v = fmaxf(v, __shfl_xor(v, o));
    return v;
}
__device__ __forceinline__ float silu_f(float v) { return v / (1.f + __expf(-v)); }
#define LDS_WAIT() asm volatile("s_waitcnt lgkmcnt(0)" ::: "memory")
__device__ __forceinline__ int otid() { int t = threadIdx.x; asm volatile("" : "+v"(t)); return t; }
template <class T> __device__ __forceinline__ T* optr(T* p) { asm volatile("" : "+s"(p)); return p; }

namespace pg8 {
constexpr int BM = 256, BK = 64, HALF = 128, HTB = HALF * BK * 2, STAGE_BYTES = 8 * HTB, NXCD = 8, WGM = 8;
__host__ __device__ __forceinline__ int lds_byte(int r, int c) { const int st = (r >> 4) * 2 + (c >> 5), rr = r & 15, cc = c & 31, ob = rr * 64 + cc * 2; return st * 1024 + (ob ^ (((ob >> 9) & 1) << 5)); }
__host__ __device__ __forceinline__ void stage_rc(int b, int& R, int& C) { const int st = b / 1024, sb = b % 1024, swz = sb ^ (((sb >> 9) & 1) << 5); R = (st >> 1) * 16 + swz / 64; C = (st & 1) * 32 + (swz % 64) / 2; }
__host__ __device__ __forceinline__ int perm32(int rho) { const int n = rho >> 4, i = rho & 15; return 8 * (i >> 2) + 4 * n + (i & 3); }
struct Unit { int pm, pn; };
struct Gemm { const void* A; const void* Bt; int M, N, KB; };
struct StaticOrder {
    int nM, nN, nwg, G, c;
    __host__ __device__ void init(int M, int N, int G_, int c_) { nM = M / BM; nN = N / BM; nwg = nM * nN; G = G_; c = c_; }
    __host__ __device__ bool next(int i, Unit& u) const {
        const long L = (long)i * G + c; if (L >= nwg) return false;
        int wgid = (int)L; { const int q = nwg / NXCD, r = nwg % NXCD, xcd = wgid % NXCD, off = wgid / NXCD; wgid = (xcd < r ? xcd * (q + 1) : r * (q + 1) + (xcd - r) * q) + off; }
        const int nig = WGM * nN, gid = wgid / nig, fm = gid * WGM, gsz = (nM - fm) < WGM ? (nM - fm) : WGM;
        u.pm = fm + ((wgid % nig) % gsz); u.pn = (wgid % nig) / gsz; return true;
    }
    __device__ __forceinline__ void a_ready(const Unit&) const {}
    __device__ __forceinline__ void done(const Unit&) const {}
};

__device__ __forceinline__ f32x4 acc_f32(const f32x4& a) { return a; }
__device__ __forceinline__ f32x4 acc_f32(const i32x4& a) { return (f32x4){(float)a.x, (float)a.y, (float)a.z, (float)a.w}; }
struct Epi {
    static constexpr bool PERM = true, AFTER_DRAIN = false;
    int mode;
    int pbase;
    bf16_t* qkv; bf16_t* zbuf; float* ksum;
    const float* rs; const float* cs;
    const float* xin; float* xout; const float* gate;
    template <class AccT>
    __device__ __forceinline__ void operator()(const AccT (&acc)[2][2][4][2], const Unit& u, int wr, int wc, int fr, int fq) const {
        constexpr bool I8 = sizeof(AccT) == sizeof(i32x4) && !__is_same(AccT, f32x4);
        if (mode == 2) {
            const int col0 = u.pn * BM + wc * 32 + 8 * fq; const int b = (u.pm * BM) >> 11;
            f32x4 gv[2][2];
#pragma unroll
            for (int bj = 0; bj < 2; ++bj)
#pragma unroll
                for (int n = 0; n < 2; ++n) gv[bj][n] = *(const f32x4*)(gate + b * 6144 + col0 + bj * HALF + 4 * n);
#pragma unroll
            for (int ai = 0; ai < 2; ++ai)
#pragma unroll
                for (int m = 0; m < 4; ++m) { const size_t off = (size_t)(u.pm * BM + ai * HALF + wr * 64 + m * 16 + fr) * DM + col0;
#pragma unroll
                    for (int bj = 0; bj < 2; ++bj)
#pragma unroll
                        for (int n = 0; n < 2; ++n) { const f32x4 xv = *(const f32x4*)(xin + off + bj * HALF + 4 * n);
                            *(f32x4*)(xout + off + bj * HALF + 4 * n) = xv + gv[bj][n] * acc_f32(acc[ai][bj][m][n]); }
                    asm volatile("" ::: "memory"); }
            return;
        }
        const int p = pbase + (u.pn >> 3), colt = (u.pn & 7) * BM;
        int lg = 0; float sc = 1.f; bf16_t* base;
        if (mode == 0) { if (p == 9) base = zbuf; else { const int g = p / 3, kind = p - 3 * g; lg = 2 * g; base = qkv + (size_t)p * PART; if (kind == 0) sc = C2Q; } }
        else { if (p == 3) base = zbuf; else { base = qkv + (size_t)p * PART; if (p == 0) sc = C2Q; } }
        const int col0 = colt + wc * 32 + 8 * fq;
        f32x4 cv[2][2];
        if (I8) {
#pragma unroll
            for (int bj = 0; bj < 2; ++bj)
#pragma unroll
                for (int n = 0; n < 2; ++n) cv[bj][n] = *(const f32x4*)(cs + u.pn * BM + wc * 32 + 8 * fq + bj * HALF + 4 * n) * sc;
        }
#pragma unroll
        for (int ai = 0; ai < 2; ++ai)
#pragma unroll
            for (int m = 0; m < 4; ++m) {
                const int row = u.pm * BM + ai * HALF + wr * 64 + m * 16 + fr, b = row >> 11, t = row & 2047;
                const int R = (b << 11) + ((t & ((1 << lg) - 1)) << (11 - lg)) + (t >> lg);
                bf16_t* rowp = base + (size_t)R * DM + col0;
                float rsv = sc; if (I8) rsv = rs[row];
#pragma unroll
                for (int bj = 0; bj < 2; ++bj) { f32x4 v0 = acc_f32(acc[ai][bj][m][0]) * rsv, v1 = acc_f32(acc[ai][bj][m][1]) * rsv;
                    if (I8) { v0 = v0 * cv[bj][0]; v1 = v1 * cv[bj][1]; }
                    u32x4 w; w.x = cvt_pk_bf16(v0[0], v0[1]); w.y = cvt_pk_bf16(v0[2], v0[3]); w.z = cvt_pk_bf16(v1[0], v1[1]); w.w = cvt_pk_bf16(v1[2], v1[3]);
                    *(u32x4*)(rowp + bj * HALF) = w; } }
        if (!I8 && mode == 1 && p == 1) {
#pragma unroll
            for (int bj = 0; bj < 2; ++bj)
#pragma unroll
                for (int n = 0; n < 2; ++n) { f32x4 s = {0.f, 0.f, 0.f, 0.f};
#pragma unroll
                    for (int ai = 0; ai < 2; ++ai)
#pragma unroll
                        for (int m = 0; m < 4; ++m) s += acc_f32(acc[ai][bj][m][n]);
#pragma unroll
                    for (int j = 0; j < 4; ++j) { float v = s[j]; v += __shfl_xor(v, 1); v += __shfl_xor(v, 2); v += __shfl_xor(v, 4); v += __shfl_xor(v, 8); s[j] = v; }
                    if (fr == 0) *(f32x4*)(ksum + ((size_t)(wr * 32 + u.pm) * DM + colt + bj * HALF + wc * 32 + 8 * fq + 4 * n)) = s; }
        }
    }
};

template <bool I8> struct AccSel { typedef f32x4 type; };
template <> struct AccSel<true> { typedef i32x4 type; };
template <bool I8> __device__ __forceinline__ typename AccSel<I8>::type mma1(bf16x8 b, bf16x8 a, typename AccSel<I8>::type c) {
    if constexpr (I8) return __builtin_amdgcn_mfma_i32_16x16x64_i8(__builtin_bit_cast(i32x4, b), __builtin_bit_cast(i32x4, a), c, 0, 0, 0);
    else return __builtin_amdgcn_mfma_f32_16x16x32_bf16(b, a, c, 0, 0, 0);
}
template <class Epi, class Sched, bool ALIGN_EPI = false, bool SP2 = false, bool I8 = false>
__device__ __forceinline__ void gemm_phase(LAS unsigned char* lds, const Gemm g, const Sched& S, const Epi& E) {
    const int tid = otid(), wid = __builtin_amdgcn_readfirstlane(tid >> 6), lane = tid & 63, wr = wid >> 2, wc = wid & 3, fr = lane & 15, fq = lane >> 4;
    const int KBY = g.KB, nt = KBY / (BK * 2);
    unsigned voffA[2], voffB[2];
#pragma unroll
    for (int i = 0; i < 2; ++i) { int R, C; stage_rc(tid * 16 + i * 8192, R, C); const int Rb = Epi::PERM ? ((R & ~31) + perm32(R & 31)) : R;
        voffA[i] = (unsigned)(R * KBY + C * 2); voffB[i] = (unsigned)(Rb * KBY + C * 2); }
    const size_t kstep = (size_t)(BK * 2);
    const size_t hstep = (size_t)HALF * KBY;
    const size_t tstep = 2 * hstep;
    const unsigned ldsw = (unsigned)wid * 1024u;
    const int aoff = lds_byte(wr * 64 + fr, fq * 8), boff = lds_byte(wc * 32 + fr, fq * 8);
#define PG8_SA(b, h) (((b) * 2 + (h)) * HTB)
#define PG8_SB(b, h) ((4 + (b) * 2 + (h)) * HTB)
#define PG8_STAGE(bufoff, gbase, voff) do { _Pragma("unroll") for (int _i = 0; _i < 2; ++_i) \
        __builtin_amdgcn_global_load_lds((const unsigned*)((const char*)(gbase) + (voff)[_i]), (LAS unsigned*)(lds + (bufoff) + ldsw + _i * 8192), 16, 0, 0); } while (0)
#define PG8_LDA(dst, b, h) do { _Pragma("unroll") for (int m = 0; m < 4; ++m) _Pragma("unroll") for (int k = 0; k < 2; ++k) dst[m][k] = *(const LAS bf16x8*)(lds + PG8_SA(b, h) + aoff + m * 2048 + k * 1024); } while (0)
#define PG8_LDB(dst, b, h) do { _Pragma("unroll") for (int n = 0; n < 2; ++n) _Pragma("unroll") for (int k = 0; k < 2; ++k) dst[n][k] = *(const LAS bf16x8*)(lds + PG8_SB(b, h) + boff + n * 2048 + k * 1024); } while (0)
#define PG8_MMA(ai, bj, At, Bt) do { __builtin_amdgcn_s_setprio(1); _Pragma("unroll") for (int m = 0; m < 4; ++m) _Pragma("unroll") for (int n = 0; n < 2; ++n) _Pragma("unroll") for (int k = 0; k < 2; ++k) \
        acc[ai][bj][m][n] = mma1<I8>(Bt[n][k], At[m][k], acc[ai][bj][m][n]); __builtin_amdgcn_s_setprio(0); } while (0)
#define PG8_WAIT_V(n) asm volatile("s_waitcnt vmcnt(" #n ")" ::: "memory")
#define PG8_WAIT_L(n) asm volatile("s_waitcnt lgkmcnt(" #n ")" ::: "memory")
#define PG8_BAR __builtin_amdgcn_s_barrier()
#define PG8_SCHED __builtin_amdgcn_sched_barrier(0)
    Unit cur, nxt; int ui = 0;
    if (!S.next(0, cur)) return;
    typedef typename AccSel<I8>::type acc_t;
    acc_t acc[2][2][4][2];
#pragma unroll
    for (int a = 0; a < 2; ++a)
#pragma unroll
        for (int b = 0; b < 2; ++b)
#pragma unroll
            for (int m = 0; m < 4; ++m)
#pragma unroll
                for (int n = 0; n < 2; ++n) acc[a][b][m][n] = acc_t{};
    bf16x8 At[4][2], B0[2][2], B1[2][2];
    const char* cA = (const char*)g.A + (size_t)cur.pm * tstep; const char* cB = (const char*)g.Bt + (size_t)cur.pn * tstep;
    S.a_ready(cur);
    if constexpr (SP2) {
        PG8_STAGE(PG8_SB(0, 0), cB, voffB); PG8_STAGE(PG8_SB(0, 1), cB + hstep, voffB); PG8_STAGE(PG8_SA(0, 0), cA, voffA); PG8_STAGE(PG8_SA(0, 1), cA + hstep, voffA);
        if (wr == 1) PG8_BAR;
        PG8_WAIT_V(2); PG8_BAR;
        PG8_STAGE(PG8_SB(1, 0), cB + kstep, voffB); PG8_STAGE(PG8_SA(1, 0), cA + kstep, voffA); PG8_STAGE(PG8_SB(1, 1), cB + hstep + kstep, voffB);
        PG8_WAIT_V(6); PG8_BAR;
    } else {
        PG8_STAGE(PG8_SB(0, 0), cB, voffB); PG8_STAGE(PG8_SA(0, 0), cA, voffA); PG8_STAGE(PG8_SB(0, 1), cB + hstep, voffB); PG8_STAGE(PG8_SA(0, 1), cA + hstep, voffA);
        if (wr == 1) PG8_BAR;
        PG8_WAIT_V(4); PG8_BAR;
        PG8_STAGE(PG8_SB(1, 0), cB + kstep, voffB); PG8_STAGE(PG8_SA(1, 0), cA + kstep, voffA); PG8_STAGE(PG8_SB(1, 1), cB + hstep + kstep, voffB);
        PG8_WAIT_V(6); PG8_BAR;
    }
    for (;;) {
        const bool has_next = S.next(ui + 1, nxt);
        const char* nA = has_next ? (const char*)g.A + (size_t)nxt.pm * tstep : cA; const char* nB = has_next ? (const char*)g.Bt + (size_t)nxt.pn * tstep : cB;
        for (int t = 0; t < nt; t += 2) {
            const bool last = (t == nt - 2);
            const char* a1 = cA + (size_t)(t + 1) * kstep;
            const char* a2 = last ? nA : cA + (size_t)(t + 2) * kstep; const char* b2 = last ? nB : cB + (size_t)(t + 2) * kstep;
            const char* a3 = a2 + kstep; const char* b3 = b2 + kstep;
            if (last && has_next) S.a_ready(nxt);
            if constexpr (SP2) {
            PG8_LDB(B0, 0, 0); PG8_LDB(B1, 0, 1); PG8_SCHED; PG8_LDA(At, 0, 0); PG8_STAGE(PG8_SA(1, 1), a1 + hstep, voffA);
            PG8_WAIT_V(8); PG8_WAIT_L(0); PG8_BAR; PG8_MMA(0, 0, At, B0); PG8_MMA(0, 1, At, B1); PG8_BAR; PG8_SCHED;
            PG8_LDA(At, 0, 1); PG8_STAGE(PG8_SB(0, 0), b2, voffB); PG8_STAGE(PG8_SB(0, 1), b2 + hstep, voffB); PG8_STAGE(PG8_SA(0, 0), a2, voffA);
            PG8_WAIT_V(8); PG8_WAIT_L(0); PG8_BAR; PG8_MMA(1, 0, At, B0); PG8_MMA(1, 1, At, B1); PG8_BAR; PG8_SCHED;
            PG8_LDB(B0, 1, 0); PG8_LDB(B1, 1, 1); PG8_SCHED; PG8_LDA(At, 1, 0); PG8_STAGE(PG8_SA(0, 1), a2 + hstep, voffA);
            PG8_WAIT_V(8); PG8_WAIT_L(0); PG8_BAR; PG8_MMA(0, 0, At, B0); PG8_MMA(0, 1, At, B1); PG8_BAR; PG8_SCHED;
            PG8_LDA(At, 1, 1); PG8_STAGE(PG8_SB(1, 0), b3, voffB); PG8_STAGE(PG8_SB(1, 1), b3 + hstep, voffB); PG8_STAGE(PG8_SA(1, 0), a3, voffA);
            PG8_WAIT_V(8); PG8_WAIT_L(0); PG8_BAR; PG8_MMA(1, 0, At, B0); PG8_MMA(1, 1, At, B1); PG8_BAR; PG8_SCHED;
            } else {
            PG8_LDB(B0, 0, 0); PG8_SCHED; PG8_LDA(At, 0, 0); PG8_STAGE(PG8_SA(1, 1), a1 + hstep, voffA);
            PG8_WAIT_L(8); PG8_BAR; PG8_WAIT_L(0); PG8_MMA(0, 0, At, B0); PG8_BAR; PG8_SCHED;
            PG8_LDB(B1, 0, 1); PG8_STAGE(PG8_SB(0, 0), b2, voffB);
            PG8_BAR; PG8_WAIT_L(0); PG8_MMA(0, 1, At, B1); PG8_BAR;
            PG8_LDA(At, 0, 1); PG8_STAGE(PG8_SA(0, 0), a2, voffA);
            PG8_BAR; PG8_WAIT_L(0); PG8_MMA(1, 0, At, B0); PG8_BAR; PG8_SCHED;
            PG8_STAGE(PG8_SB(0, 1), b2 + hstep, voffB);
            PG8_WAIT_V(6); PG8_BAR; PG8_MMA(1, 1, At, B1); PG8_BAR;
            PG8_LDB(B0, 1, 0); PG8_SCHED; PG8_LDA(At, 1, 0); PG8_STAGE(PG8_SA(0, 1), a2 + hstep, voffA);
            PG8_WAIT_L(8); PG8_BAR; PG8_WAIT_L(0); PG8_MMA(0, 0, At, B0); PG8_BAR; PG8_SCHED;
            PG8_LDB(B1, 1, 1); PG8_STAGE(PG8_SB(1, 0), b3, voffB);
            PG8_BAR; PG8_WAIT_L(0); PG8_MMA(0, 1, At, B1); PG8_BAR;
            PG8_LDA(At, 1, 1); PG8_STAGE(PG8_SA(1, 0), a3, voffA);
            PG8_BAR; PG8_WAIT_L(0); PG8_MMA(1, 0, At, B0); PG8_BAR; PG8_SCHED;
            PG8_STAGE(PG8_SB(1, 1), b3 + hstep, voffB);
            PG8_WAIT_V(6); PG8_BAR; PG8_MMA(1, 1, At, B1); PG8_BAR;
            }
        }
        if constexpr (ALIGN_EPI) { if (wr == 0) PG8_BAR; }
        if constexpr (!Epi::AFTER_DRAIN) { E(acc, cur, wr, wc, fr, fq); S.done(cur); }
        if (!has_next) break;
#pragma unroll
        for (int a = 0; a < 2; ++a)
#pragma unroll
            for (int b = 0; b < 2; ++b)
#pragma unroll
                for (int m = 0; m < 4; ++m)
#pragma unroll
                    for (int n = 0; n < 2; ++n) acc[a][b][m][n] = acc_t{};
        cur = nxt; cA = nA; cB = nB; ++ui;
        if constexpr (ALIGN_EPI) { if (wr == 1) PG8_BAR; }
    }
    PG8_WAIT_V(0);
    if constexpr (!ALIGN_EPI) { if (wr == 0) PG8_BAR; }
    PG8_BAR;
#undef PG8_SA
#undef PG8_SB
#undef PG8_STAGE
#undef PG8_LDA
#undef PG8_LDB
#undef PG8_MMA
#undef PG8_WAIT_V
#undef PG8_WAIT_L
#undef PG8_BAR
#undef PG8_SCHED
}
}

struct Params {
    const float *x, *c, *norm_w, *mod_w, *mod_b, *a_w_in, *a_w_out, *b_w_in, *b_w_out, *final_w;
    float* out; unsigned char* ws;
};

__device__ __forceinline__ void p0_mod(const Params& P, unsigned char* lds) {
    const int tid = otid();
    f32x4* condT = (f32x4*)lds;
    float* red = (float*)(lds + 32768);
    float* MOD = (float*)(P.ws + WS_MOD);
    bool have = false;
    for (int item = blockIdx.x; item < 192; item += gridDim.x) {
        if (!have) { have = true;
            for (int k = tid; k < DM; k += NTHREADS) { f32x4 v; v.x = silu_f(P.c[k]); v.y = silu_f(P.c[DM + k]); v.z = silu_f(P.c[2 * DM + k]); v.w = silu_f(P.c[3 * DM + k]); condT[k] = v; }
            __syncthreads(); }
        const int l = item / 48, n0 = (item % 48) * 128, cq = tid & 31, kp = tid >> 5;
        f32x4 a0 = {0.f, 0.f, 0.f, 0.f}, a1 = a0, a2 = a0, a3 = a0;
        const float* wp = P.mod_w + ((size_t)l * DM + kp * 128) * 6144 + n0 + 4 * cq;
#pragma unroll 8
        for (int k = 0; k < 128; ++k) { const f32x4 w = *(const f32x4*)(wp + (size_t)k * 6144); const f32x4 cv = condT[kp * 128 + k];
            a0 += w * cv.x; a1 += w * cv.y; a2 += w * cv.z; a3 += w * cv.w; }
        *(f32x4*)(red + (kp * 4 + 0) * 128 + 4 * cq) = a0; *(f32x4*)(red + (kp * 4 + 1) * 128 + 4 * cq) = a1;
        *(f32x4*)(red + (kp * 4 + 2) * 128 + 4 * cq) = a2; *(f32x4*)(red + (kp * 4 + 3) * 128 + 4 * cq) = a3;
        __syncthreads();
        { const int b = tid >> 7, col = tid & 127; float s = P.mod_b[l * 6144 + n0 + col];
#pragma unroll
            for (int q = 0; q < 16; ++q) s += red[(q * 4 + b) * 128 + col];
            MOD[(l * 4 + b) * 6144 + n0 + col] = s; }
        __syncthreads();
    }
}
__device__ __forceinline__ void p0_transpose_item(const float* W, int ldn, int ncol0, int nblk, bf16_t* WT, unsigned char* scr, int item, int lane) {
    const int kb = item / nblk, nb = item - kb * nblk, k0 = kb * 64, n0 = nb * 64;
    const float* src = W + (size_t)(k0 + (lane >> 4)) * ldn + ncol0 + n0 + 4 * (lane & 15);
#pragma unroll 4
    for (int i = 0; i < 16; ++i) { const f32x4 v = *(const f32x4*)(src + (size_t)(4 * i) * ldn);
        unsigned* d = (unsigned*)(scr + (4 * i + (lane >> 4)) * 132 + 8 * (lane & 15));
        d[0] = cvt_pk_bf16(v.x, v.y); d[1] = cvt_pk_bf16(v.z, v.w); }
    LDS_WAIT();
    const int c = lane & 7;
#pragma unroll
    for (int j = 0; j < 8; ++j) { const int n = (lane >> 3) + 8 * j; const unsigned short* s = (const unsigned short*)(scr + (8 * c) * 132 + 2 * n);
        u32x4 o;
        o.x = (unsigned)s[0 * 66] | ((unsigned)s[1 * 66] << 16); o.y = (unsigned)s[2 * 66] | ((unsigned)s[3 * 66] << 16);
        o.z = (unsigned)s[4 * 66] | ((unsigned)s[5 * 66] << 16); o.w = (unsigned)s[6 * 66] | ((unsigned)s[7 * 66] << 16);
        *(u32x4*)(WT + (size_t)(n0 + n) * DM + k0 + 8 * c) = o; }
    LDS_WAIT();
}
__device__ __forceinline__ void p0_panel_i8(const float* W, int ldn, int n0, signed char* WT, float* cs, unsigned char* lds, int tid) {
    const int lane = tid & 63, wave = __builtin_amdgcn_readfirstlane(tid >> 6);
    float* maxbuf = (float*)(lds + 131072);
    f32x4 mx = {0.f, 0.f, 0.f, 0.f};
    { const float* src = W + (size_t)(wave * 256 + (lane >> 3)) * ldn + n0 + 4 * (lane & 7);
      unsigned char* dst = lds + (size_t)(wave * 256 + (lane >> 3)) * 64 + 8 * (lane & 7);
#pragma unroll 8
      for (int i = 0; i < 32; ++i) { const f32x4 v = *(const f32x4*)(src + (size_t)(8 * i) * ldn);
          mx.x = fmaxf(mx.x, fabsf(v.x)); mx.y = fmaxf(mx.y, fabsf(v.y)); mx.z = fmaxf(mx.z, fabsf(v.z)); mx.w = fmaxf(mx.w, fabsf(v.w));
          u32x2 w; w.x = cvt_pk_bf16(v.x, v.y); w.y = cvt_pk_bf16(v.z, v.w); *(u32x2*)(dst + (size_t)(8 * i) * 64) = w; } }
#pragma unroll
    for (int o = 8; o < 64; o <<= 1) { mx.x = fmaxf(mx.x, __shfl_xor(mx.x, o)); mx.y = fmaxf(mx.y, __shfl_xor(mx.y, o)); mx.z = fmaxf(mx.z, __shfl_xor(mx.z, o)); mx.w = fmaxf(mx.w, __shfl_xor(mx.w, o)); }
    if (lane < 8) *(f32x4*)(maxbuf + wave * 32 + 4 * lane) = mx;
    __syncthreads();
    { const int n = tid & 31, kc = tid >> 5;
      float cm = maxbuf[n];
#pragma unroll
      for (int w = 1; w < 8; ++w) cm = fmaxf(cm, maxbuf[w * 32 + n]);
      const float inv = cm > 0.f ? 127.f / cm : 0.f;
      if (kc == 0) cs[n0 + n] = cm > 0.f ? cm * (1.f / 127.f) : 1.f;
      const unsigned short* t = (const unsigned short*)lds + (size_t)(kc * 128) * 32 + n;
      signed char* orow = WT + (size_t)(n0 + n) * DM + kc * 128;
#pragma unroll 2
      for (int i = 0; i < 8; ++i) { unsigned w[4];
#pragma unroll
          for (int q = 0; q < 4; ++q) { unsigned acc = 0;
#pragma unroll
              for (int e = 0; e < 4; ++e) { const float v = bf2f(t[(size_t)(16 * i + 4 * q + e) * 32]) * inv; int iv = (int)rintf(v); iv = iv > 127 ? 127 : (iv < -127 ? -127 : iv); acc |= ((unsigned)iv & 0xffu) << (8 * e); }
              w[q] = acc; }
          *(u32x4*)(orow + 16 * i) = (u32x4){w[0], w[1], w[2], w[3]}; } }
    __syncthreads();
}
__device__ __forceinline__ void p0_weights(const Params& P, unsigned char* lds) {
    const int tid_ = otid(); const int lane = tid_ & 63, wave = __builtin_amdgcn_readfirstlane(tid_ >> 6);
    constexpr int PA = A_N / 32, PB = 4096 / 32, NPANEL = 2 * PA + 2 * PB;
    for (int it = blockIdx.x; it < NPANEL; it += gridDim.x) {
        if (it < 2 * PA) { const int j = it / PA, pnl = it - j * PA;
            p0_panel_i8(P.a_w_in + (size_t)j * DM * A_N, A_N, pnl * 32, (signed char*)(P.ws + WS_WAIN) + (size_t)j * A_N * DM, (float*)(P.ws + WS_CSA) + j * A_N, lds, tid_); }
        else { const int r = it - 2 * PA, j = r / PB, pnl = r - j * PB;
            p0_panel_i8(P.b_w_in + (size_t)j * DM * B_N + 4096, B_N, pnl * 32, (signed char*)(P.ws + WS_WBVZ) + (size_t)j * 4096 * DM, (float*)(P.ws + WS_CSB) + j * 4096, lds, tid_); }
    }
    unsigned char* scr = lds + 65536 + wave * 8448;
    const int gw = blockIdx.x * 8 + wave, NGW = gridDim.x * 8;
    constexpr int I_B = 32 * 64, I_O = 32 * 32, TOTAL = 2 * I_B + 4 * I_O;
    for (int it = gw; it < TOTAL; it += NGW) {
        int r = it;
        if (r < 2 * I_B) { const int j = r / I_B; p0_transpose_item(P.b_w_in + (size_t)j * DM * B_N, B_N, 0, 64, (bf16_t*)(P.ws + WS_WBQK) + (size_t)j * 4096 * DM, scr, r - j * I_B, lane); continue; } r -= 2 * I_B;
        if (r < 2 * I_O) { const int j = r / I_O; p0_transpose_item(P.a_w_out + (size_t)j * DM * DM, DM, 0, 32, (bf16_t*)(P.ws + WS_WAOUT) + (size_t)j * DM * DM, scr, r - j * I_O, lane); continue; } r -= 2 * I_O;
        { const int j = r / I_O; p0_transpose_item(P.b_w_out + (size_t)j * DM * DM, DM, 0, 32, (bf16_t*)(P.ws + WS_WBOUT) + (size_t)j * DM * DM, scr, r - j * I_O, lane); }
    }
}

__device__ __forceinline__ void norm_phase(const Params& P, const float* xin, int layer, bool want_bf16) {
    const int tid_ = otid(); const int lane = tid_ & 63, wave = __builtin_amdgcn_readfirstlane(tid_ >> 6);
    const int gw = blockIdx.x * 8 + wave, NGW = gridDim.x * 8;
    const float* MOD = (const float*)(P.ws + WS_MOD);
    bf16_t* Hb = (bf16_t*)(P.ws + WS_H); unsigned char* Hq = P.ws + WS_HQ; float* RS = (float*)(P.ws + WS_RS);
    for (int r0 = gw * 4; r0 < MTOK; r0 += NGW * 4) {
        const int b = r0 >> 11;
        const float* shift = MOD + (size_t)(layer * 4 + b) * 6144; const float* scale = shift + DM; const float* nw = P.norm_w + layer * DM;
        f32x4 ca[8], cs[8];
#pragma unroll
        for (int j = 0; j < 8; ++j) { const int c = 4 * lane + 256 * j; const f32x4 w = *(const f32x4*)(nw + c), s = *(const f32x4*)(scale + c); ca[j] = w * (s + 1.f); cs[j] = *(const f32x4*)(shift + c); }
        for (int rr = 0; rr < 4; ++rr) {
            const float* xr = xin + (size_t)(r0 + rr) * DM; f32x4 v[8]; float ss = 0.f;
#pragma unroll
            for (int j = 0; j < 8; ++j) { v[j] = *(const f32x4*)(xr + 4 * lane + 256 * j); ss += (v[j].x * v[j].x + v[j].y * v[j].y) + (v[j].z * v[j].z + v[j].w * v[j].w); }
            const float rs = 1.0f / sqrtf(wave_sum(ss) * (1.f / DM) + EPS);
            float am = 0.f;
#pragma unroll
            for (int j = 0; j < 8; ++j) { v[j] = v[j] * rs * ca[j] + cs[j]; am = fmaxf(am, fmaxf(fmaxf(fabsf(v[j].x), fabsf(v[j].y)), fmaxf(fabsf(v[j].z), fabsf(v[j].w)))); }
            am = wave_max(am);
            const float inv = am > 0.f ? 127.f / am : 0.f;
            if (lane == 0) RS[r0 + rr] = am > 0.f ? am * (1.f / 127.f) : 1.f;
            unsigned char* qr = Hq + (size_t)(r0 + rr) * DM;
#pragma unroll
            for (int j = 0; j < 8; ++j) { const f32x4 h = v[j] * inv;
                const int i0 = (int)rintf(h.x), i1 = (int)rintf(h.y), i2 = (int)rintf(h.z), i3 = (int)rintf(h.w);
                *(unsigned*)(qr + 4 * lane + 256 * j) = ((unsigned)i0 & 0xffu) | (((unsigned)i1 & 0xffu) << 8) | (((unsigned)i2 & 0xffu) << 16) | (((unsigned)i3 & 0xffu) << 24); }
            if (want_bf16) { bf16_t* hr = Hb + (size_t)(r0 + rr) * DM;
#pragma unroll
                for (int j = 0; j < 8; ++j) { u32x2 w; w.x = cvt_pk_bf16(v[j].x, v[j].y); w.y = cvt_pk_bf16(v[j].z, v[j].w); *(u32x2*)(hr + 4 * lane + 256 * j) = w; } }
        }
    }
}
__device__ __forceinline__ void final_norm_phase(const Params& P) {
    const int tid_ = otid(); const int lane = tid_ & 63, wave = __builtin_amdgcn_readfirstlane(tid_ >> 6);
    const int gw = blockIdx.x * 8 + wave, NGW = gridDim.x * 8;
    f32x4 cw[8];
#pragma unroll
    for (int j = 0; j < 8; ++j) cw[j] = *(const f32x4*)(P.final_w + 4 * lane + 256 * j);
    for (int r = gw; r < MTOK; r += NGW) {
        float* xr = P.out + (size_t)r * DM; f32x4 v[8]; float ss = 0.f;
#pragma unroll
        for (int j = 0; j < 8; ++j) { v[j] = *(const f32x4*)(xr + 4 * lane + 256 * j); ss += (v[j].x * v[j].x + v[j].y * v[j].y) + (v[j].z * v[j].z + v[j].w * v[j].w); }
        const float rs = 1.0f / sqrtf(wave_sum(ss) * (1.f / DM) + EPS);
#pragma unroll
        for (int j = 0; j < 8; ++j) *(f32x4*)(xr + 4 * lane + 256 * j) = v[j] * rs * cw[j];
    }
}

__device__ __forceinline__ void naive_attend(const bf16_t* Kh, const bf16_t* Vh, const float* qf, float* sc, int own_start, int own_len, int blkbase, int mask, int qpos, float slopeL, int lane,
                                             float& o0, float& o1, float& lse2) {
    int base = 0; float mx = -3.0e38f;
    { int m2 = mask;
      for (int rr = 0;; ++rr) { int start, len;
        if (rr == 0) { start = own_start; len = own_len; } else { if (!m2) break; const int j = __builtin_ctz(m2); m2 &= m2 - 1; start = blkbase + (j << 8); len = 256; }
        for (int i = lane; i < len; i += 64) { const int key = start + i; const u32x4* kp = (const u32x4*)(Kh + (size_t)key * DM); float dot = 0.f;
#pragma unroll 4
            for (int cch = 0; cch < 16; ++cch) { const u32x4 w = kp[cch]; const float* q = qf + cch * 8;
                dot += q[0] * bflo(w.x) + q[1] * bfhi(w.x) + q[2] * bflo(w.y) + q[3] * bfhi(w.y) + q[4] * bflo(w.z) + q[5] * bfhi(w.z) + q[6] * bflo(w.w) + q[7] * bfhi(w.w); }
            const float s = dot + slopeL * (float)(key - qpos); sc[base + i] = s; mx = fmaxf(mx, s); }
        base += len; } }
    const int tot = base; mx = wave_max(mx);
    LDS_WAIT();
    float sum = 0.f;
    for (int i = lane; i < tot; i += 64) { const float p = exp2f(sc[i] - mx); sc[i] = p; sum += p; }
    sum = wave_sum(sum);
    LDS_WAIT();
    float a0 = 0.f, a1 = 0.f; base = 0;
    { int m2 = mask;
      for (int rr = 0;; ++rr) { int start, len;
        if (rr == 0) { start = own_start; len = own_len; } else { if (!m2) break; const int j = __builtin_ctz(m2); m2 &= m2 - 1; start = blkbase + (j << 8); len = 256; }
        const bf16_t* vp = Vh + (size_t)start * DM + 2 * lane;
        for (int i = 0; i < len; ++i) { const float p = sc[base + i]; const unsigned w = *(const unsigned*)(vp + (size_t)i * DM); a0 += p * bflo(w); a1 += p * bfhi(w); }
        base += len; } }
    LDS_WAIT();
    const float inv = 1.f / sum; o0 = a0 * inv; o1 = a1 * inv; lse2 = mx + log2f(sum);
}
__device__ __forceinline__ float slope_of(int h) { return exp2f(-0.5f * (float)(h + 1)); }

__device__ __forceinline__ void attn_a_naive(const Params& P, unsigned char* lds) {
    const int tid_ = otid(); const int lane = tid_ & 63, wave = __builtin_amdgcn_readfirstlane(tid_ >> 6);
    float* qf = (float*)(lds + wave * 8192); float* sc = qf + 128;
    const bf16_t* QKV = (const bf16_t*)(P.ws + WS_QKV); bf16_t* OG = (bf16_t*)(P.ws + WS_OG); float* LSE = (float*)(P.ws + WS_LSE);
    const int gw = blockIdx.x * 8 + wave, NGW = gridDim.x * 8;
    for (int it = gw; it < 3 * MTOK * NH; it += NGW) {
        const int h = it & 15, R = (it >> 4) & (MTOK - 1), g = it >> 17;
        const int lg = 2 * g, L = SEQ >> lg;
        const bf16_t* Qp = QKV + (size_t)(3 * g) * PART + (size_t)R * DM + h * HD;
        { const unsigned w = *(const unsigned*)(Qp + 2 * lane); qf[2 * lane] = bflo(w); qf[2 * lane + 1] = bfhi(w); }
        LDS_WAIT();
        const int seq0 = R & ~(L - 1); int lo = R - 128; if (lo < seq0) lo = seq0;
        float o0, o1, lse2;
        naive_attend(QKV + (size_t)(3 * g + 1) * PART + h * HD, QKV + (size_t)(3 * g + 2) * PART + h * HD, qf, sc, lo, R - lo + 1, 0, 0, R, slope_of(h) * (float)(1 << lg) * LOG2E, lane, o0, o1, lse2);
        *(unsigned*)(OG + (size_t)g * PART + (size_t)R * DM + h * HD + 2 * lane) = cvt_pk_bf16(o0, o1);
        if (lane == 0) LSE[((size_t)g * MTOK + R) * NH + h] = lse2;
    }
}
__device__ __forceinline__ void combine_phase(const Params& P) {
    const int tid_ = otid(); const int lane = tid_ & 63, wave = __builtin_amdgcn_readfirstlane(tid_ >> 6);
    const int gw = blockIdx.x * 8 + wave, NGW = gridDim.x * 8;
    const bf16_t* OG = (const bf16_t*)(P.ws + WS_OG); const float* LSE = (const float*)(P.ws + WS_LSE); const bf16_t* Z = (const bf16_t*)(P.ws + WS_Z); bf16_t* G = (bf16_t*)(P.ws + WS_G);
    for (int m = gw; m < MTOK; m += NGW) {
        const int b = m >> 11, t = m & 2047;
        const int R0 = m, R1 = (b << 11) + ((t & 3) << 9) + (t >> 2), R2 = (b << 11) + ((t & 15) << 7) + (t >> 4);
#pragma unroll
        for (int j = 0; j < 4; ++j) { const int col = 8 * lane + 512 * j, h = col >> 7;
            const float l0 = LSE[((size_t)0 * MTOK + R0) * NH + h], l1 = LSE[((size_t)1 * MTOK + R1) * NH + h], l2 = LSE[((size_t)2 * MTOK + R2) * NH + h];
            const float mx = fmaxf(l0, fmaxf(l1, l2)); float e0 = exp2f(l0 - mx), e1 = exp2f(l1 - mx), e2 = exp2f(l2 - mx); const float inv = 1.f / (e0 + e1 + e2); e0 *= inv; e1 *= inv; e2 *= inv;
            const u32x4 a = *(const u32x4*)(OG + (size_t)R0 * DM + col), bb = *(const u32x4*)(OG + PART + (size_t)R1 * DM + col), cc = *(const u32x4*)(OG + 2 * PART + (size_t)R2 * DM + col);
            const u32x4 zz = *(const u32x4*)(Z + (size_t)m * DM + col);
            u32x4 o;
#define CMB(F) { const float v0 = (e0 * bflo(a.F) + e1 * bflo(bb.F) + e2 * bflo(cc.F)) * silu_f(bflo(zz.F)); const float v1 = (e0 * bfhi(a.F) + e1 * bfhi(bb.F) + e2 * bfhi(cc.F)) * silu_f(bfhi(zz.F)); o.F = cvt_pk_bf16(v0, v1); }
            CMB(x) CMB(y) CMB(z) CMB(w)
#undef CMB
            *(u32x4*)(G + (size_t)m * DM + col) = o; }
    }
}
__device__ __forceinline__ void attn_b_naive(const Params& P, unsigned char* lds) {
    const int tid_ = otid(); const int lane = tid_ & 63, wave = __builtin_amdgcn_readfirstlane(tid_ >> 6);
    float* qf = (float*)(lds + wave * 8192); float* sc = qf + 128;
    const bf16_t* QKV = (const bf16_t*)(P.ws + WS_QKV); const bf16_t* Z = (const bf16_t*)(P.ws + WS_Z); bf16_t* G = (bf16_t*)(P.ws + WS_G); const float* KS = (const float*)(P.ws + WS_KSUM);
    const int gw = blockIdx.x * 8 + wave, NGW = gridDim.x * 8;
    for (int it = gw; it < MTOK * NH; it += NGW) {
        const int h = it & 15, m = it >> 4, b = m >> 11, t = m & 2047, n = t >> 8;
        const bf16_t* Qp = QKV + (size_t)m * DM + h * HD;
        float q0, q1; { const unsigned w = *(const unsigned*)(Qp + 2 * lane); q0 = bflo(w); q1 = bfhi(w); qf[2 * lane] = q0; qf[2 * lane + 1] = q1; }
        LDS_WAIT();
        float gt[8];
#pragma unroll
        for (int j = 0; j < 8; ++j) { float v = 0.f;
            if (j < n) { const float* k0 = KS + (size_t)(b * 8 + j) * DM + h * HD + 2 * lane; const float* k1 = k0 + (size_t)32 * DM; v = q0 * (k0[0] + k1[0]) + q1 * (k0[1] + k1[1]); }
            gt[j] = wave_sum(v); }
        int mask = 0;
#pragma unroll
        for (int j = 0; j < 8; ++j) { if (j < n) { int rank = 0;
#pragma unroll
                for (int j2 = 0; j2 < 8; ++j2) if (j2 < n && (gt[j2] > gt[j] || (gt[j2] == gt[j] && j2 < j))) ++rank;
                if (rank < 3) mask |= 1 << j; } }
        float o0, o1, lse2;
        naive_attend(QKV + PART + h * HD, QKV + 2 * PART + h * HD, qf, sc, (b << 11) + (n << 8), (t & 255) + 1, b << 11, mask, m, slope_of(h) * LOG2E, lane, o0, o1, lse2);
        const unsigned zw = *(const unsigned*)(Z + (size_t)m * DM + h * HD + 2 * lane);
        *(unsigned*)(G + (size_t)m * DM + h * HD + 2 * lane) = cvt_pk_bf16(o0 * silu_f(bflo(zw)), o1 * silu_f(bfhi(zw)));
    }
}

namespace fa {
constexpr int KVBLK = 64, SHM_K = KVBLK * HD * 2, SHM_V = KVBLK * HD * 2;
constexpr int OFF_V = 0, OFF_K = 2 * SHM_V, OFF_WS = OFF_K + 2 * SHM_K, OFF_OST = OFF_WS + 8 * 256, OST_ROW = 272, OST_WAVE = 32 * OST_ROW;
constexpr int OFF_GK = OFF_OST + 8 * OST_WAVE, OFF_SEL = OFF_GK + 7 * 128 * 4, OFF_END = OFF_SEL + 256 * 4;
static_assert(OFF_END <= LDS_BYTES - 1024, "attention LDS map");
constexpr float THR = 11.5f;
#define KSWZ(row, colB) ((row) * 256 + ((colB) ^ (((row) & 7) << 4)))
#define SBAR() __builtin_amdgcn_sched_barrier(0)
__device__ __forceinline__ int v_st(int k, int c) { const int kk = (k & ~0xC) | ((k & 4) << 1) | ((k & 8) >> 1); return ((kk >> 3) * 4 + (c >> 5)) * 512 + ((kk & 7) * 32 + (c & 31)) * 2; }
__device__ __forceinline__ int v_rd_base(int lane) { return ((lane & 3) << 3) | (((lane >> 2) & 3) << 6) | (((lane >> 4) & 1) << 5) | (((lane >> 5) & 1) << 8); }
constexpr int v_rd_off(int d0, int ks, int half) { return d0 * 512 + ks * 4096 + half * 2048; }
__device__ __forceinline__ int crow(int r, int hi) { return (r & 3) + 8 * (r >> 2) + 4 * hi; }
__device__ __forceinline__ void mask_tile(f32x16& p0, f32x16& p1, int dq, unsigned W) {
    const float NEG = -__builtin_inff();
#pragma unroll
    for (int r = 0; r < 16; ++r) { const int c = (r & 3) + 8 * (r >> 2);
        if ((unsigned)(dq - c) >= W) p0[r] = NEG;
        if ((unsigned)(dq - c - 32) >= W) p1[r] = NEG; }
}
__device__ __forceinline__ void partialSM(f32x16& p0, f32x16& p1, float& m_reg, float& alpha) {
    float pmax = p0[0];
#pragma unroll
    for (int r = 1; r < 16; ++r) pmax = fmaxf(pmax, p0[r]);
#pragma unroll
    for (int r = 0; r < 16; ++r) pmax = fmaxf(pmax, p1[r]);
    { auto rr = __builtin_amdgcn_permlane32_swap(__float_as_uint(pmax), __float_as_uint(pmax), false, false); pmax = fmaxf(__uint_as_float(rr[0]), __uint_as_float(rr[1])); }
    float mn;
    if (__builtin_expect(__all(pmax - m_reg <= THR), 1)) { mn = m_reg; alpha = 1.f; }
    else { mn = fmaxf(m_reg, pmax); alpha = __builtin_amdgcn_exp2f(m_reg - mn); m_reg = mn; }
#pragma unroll
    for (int r = 0; r < 16; ++r) p0[r] = __builtin_amdgcn_exp2f(p0[r] - mn);
#pragma unroll
    for (int r = 0; r < 16; ++r) p1[r] = __builtin_amdgcn_exp2f(p1[r] - mn);
}
__device__ __forceinline__ void finishSM(f32x16& p0, f32x16& p1, float alpha, float& l_reg, bf16x8& pa0, bf16x8& pa1, bf16x8& pa2, bf16x8& pa3) {
    float ps = 0;
#pragma unroll
    for (int r = 0; r < 16; ++r) ps += p0[r];
#pragma unroll
    for (int r = 0; r < 16; ++r) ps += p1[r];
    { auto rr = __builtin_amdgcn_permlane32_swap(__float_as_uint(ps), __float_as_uint(ps), false, false); ps = __uint_as_float(rr[0]) + __uint_as_float(rr[1]); }
    l_reg = l_reg * alpha + ps;
#define PK4(P, B_, OUT) do { unsigned a0 = cvt_pk_bf16(P[B_+0], P[B_+1]), a1 = cvt_pk_bf16(P[B_+2], P[B_+3]);                          \
        unsigned b0 = cvt_pk_bf16(P[B_+4], P[B_+5]), b1 = cvt_pk_bf16(P[B_+6], P[B_+7]);                                             \
        auto r0 = __builtin_amdgcn_permlane32_swap(a0, b0, false, false); auto r1 = __builtin_amdgcn_permlane32_swap(a1, b1, false, false); \
        u32x4 w = {r0[0], r1[0], r0[1], r1[1]}; OUT = *reinterpret_cast<bf16x8*>(&w); } while (0)
    PK4(p0, 0, pa0); PK4(p0, 8, pa1); PK4(p1, 0, pa2); PK4(p1, 8, pa3);
#undef PK4
}
template <int KB>
__device__ __forceinline__ void qkt(f32x16& p0, f32x16& p1, const LAS char* K_lds, int r32, int hi, const bf16x8* qr) {
    const LAS char* kb[4];
#pragma unroll
    for (int dd = 0; dd < 4; ++dd) kb[dd] = K_lds + KB * SHM_K + KSWZ(r32, (dd * 16 + hi * 8) * 2);
#pragma unroll
    for (int d0 = 0; d0 < 8; ++d0) { const LAS char* a = kb[d0 & 3] + (d0 >> 2) * 128;
        const bf16x8 b0 = *reinterpret_cast<const LAS bf16x8*>(a);
        const bf16x8 b1 = *reinterpret_cast<const LAS bf16x8*>(a + 32 * 256);
        p0 = __builtin_amdgcn_mfma_f32_32x32x16_bf16(b0, qr[d0], p0, 0, 0, 0);
        p1 = __builtin_amdgcn_mfma_f32_32x32x16_bf16(b1, qr[d0], p1, 0, 0, 0); }
}
template <int VB>
__device__ __forceinline__ void pv_tile(f32x16* o, int vb0, bf16x8 pa0, bf16x8 pa1, bf16x8 pa2, bf16x8 pa3) {
#define TRRD(dst, off) asm volatile("ds_read_b64_tr_b16 %0, %1 offset:%2" : "=&v"(dst) : "v"(vb0), "i"(off) : "memory")
#define PV_D0(d0) do { s16x4 l0, l1, l2, l3, h0, h1, h2, h3; constexpr int b_ = VB * SHM_V + v_rd_off(d0, 0, 0); \
        TRRD(l0, b_); TRRD(h0, b_ + 2048); TRRD(l1, b_ + 4096); TRRD(h1, b_ + 6144); TRRD(l2, b_ + 8192); TRRD(h2, b_ + 10240); TRRD(l3, b_ + 12288); TRRD(h3, b_ + 14336); \
        asm volatile("s_waitcnt lgkmcnt(0)" ::: "memory"); SBAR();   \
        o[d0] = __builtin_amdgcn_mfma_f32_32x32x16_bf16(pa0, (bf16x8){l0[0], l0[1], l0[2], l0[3], h0[0], h0[1], h0[2], h0[3]}, o[d0], 0, 0, 0);   \
        o[d0] = __builtin_amdgcn_mfma_f32_32x32x16_bf16(pa1, (bf16x8){l1[0], l1[1], l1[2], l1[3], h1[0], h1[1], h1[2], h1[3]}, o[d0], 0, 0, 0);   \
        o[d0] = __builtin_amdgcn_mfma_f32_32x32x16_bf16(pa2, (bf16x8){l2[0], l2[1], l2[2], l2[3], h2[0], h2[1], h2[2], h2[3]}, o[d0], 0, 0, 0);   \
        o[d0] = __builtin_amdgcn_mfma_f32_32x32x16_bf16(pa3, (bf16x8){l3[0], l3[1], l3[2], l3[3], h3[0], h3[1], h3[2], h3[3]}, o[d0], 0, 0, 0); } while (0)
    PV_D0(0); PV_D0(1); PV_D0(2); PV_D0(3);
#undef PV_D0
#undef TRRD
}

template <int MODE, class MK>
__device__ __forceinline__ void flash_block(const bf16_t* Q, const bf16_t* K, const bf16_t* V, int krow0, int NT, int qrow0, float slopeL, const MK& mk,
                                            unsigned char* lds, bf16_t* Og, float* Lse, const bf16_t* Zg, int tid) {
    const int wid = __builtin_amdgcn_readfirstlane(tid >> 6), lane = tid & 63, r32 = lane & 31, hi = lane >> 5;
    const LAS char* K_lds = (const LAS char*)(LAS unsigned char*)lds + OFF_K;
    LAS char* Kw = (LAS char*)(LAS unsigned char*)lds + OFF_K; LAS char* Vw = (LAS char*)(LAS unsigned char*)lds + OFF_V;
    LAS float* wsf = (LAS float*)((LAS unsigned char*)lds + OFF_WS) + wid * 64; LAS float* li_l = wsf; LAS float* al_l = wsf + 32;
    const int sr = tid >> 4, sc = (tid & 15) * 8, vst0 = v_st(sr, sc), vst1 = v_st(32 + sr, sc), kws = KSWZ(sr, sc * 2);
    const int vb0 = (int)(unsigned)(uintptr_t)((LAS unsigned char*)lds) + OFF_V + v_rd_base(lane);
    const int qlo = qrow0 + wid * 32, qm = qlo + r32 - 4 * hi;
    bf16x8 st_k0, st_k1, st_v0, st_v1;
#define SLOAD(kb_) do { const size_t o0_ = (size_t)((kb_) + sr) * DM + sc, o1_ = o0_ + (size_t)32 * DM; \
        st_v0 = *(const bf16x8*)(V + o0_); st_v1 = *(const bf16x8*)(V + o1_); st_k0 = *(const bf16x8*)(K + o0_); st_k1 = *(const bf16x8*)(K + o1_); } while (0)
#define SWRITE(bf) do { *(LAS bf16x8*)(Vw + (bf) * SHM_V + vst0) = st_v0; *(LAS bf16x8*)(Vw + (bf) * SHM_V + vst1) = st_v1; \
        *(LAS bf16x8*)(Kw + (bf) * SHM_K + kws) = st_k0; *(LAS bf16x8*)(Kw + (bf) * SHM_K + kws + 32 * 256) = st_k1; } while (0)
    bf16x8 qr[8];
#pragma unroll
    for (int d0 = 0; d0 < 8; ++d0) qr[d0] = *(const bf16x8*)(Q + (size_t)(wid * 32 + r32) * DM + d0 * 16 + hi * 8);
    SLOAD(krow0); asm volatile("s_waitcnt vmcnt(0)" ::: "memory"); SWRITE(0);
    __syncthreads();
    float m_reg = -1e30f, l_reg = 0.f; f32x16 o[4] = {};
#define STEP(t, KB) do { const int kb_ = krow0 + (t) * KVBLK;                                                                   \
        if ((t) + 1 < NT) SLOAD(kb_ + KVBLK);                                                                                     \
        bool act_, need_; unsigned W_; mk.info(kb_, qlo, r32, act_, need_, W_);                                                 \
        if (act_) { f32x16 p0, p1; const float a0_ = slopeL * (float)(kb_ - qm);                                                  \
            _Pragma("unroll") for (int r = 0; r < 16; ++r) { p0[r] = fmaf(slopeL, (float)((r & 3) + 8 * (r >> 2)), a0_); p1[r] = p0[r] + 32.f * slopeL; } \
            qkt<KB>(p0, p1, K_lds, r32, hi, qr);                                                                                  \
            if (need_) mask_tile(p0, p1, qm - kb_, W_);                                                                           \
            float alpha_; partialSM(p0, p1, m_reg, alpha_);                                                                       \
            bf16x8 pa0, pa1, pa2, pa3; finishSM(p0, p1, alpha_, l_reg, pa0, pa1, pa2, pa3);                                       \
            if (__any(alpha_ < 1.f)) { if (hi == 0) al_l[r32] = alpha_; LDS_WAIT();                                               \
                _Pragma("unroll") for (int d_ = 0; d_ < 4; ++d_) _Pragma("unroll") for (int r = 0; r < 16; ++r) o[d_][r] *= al_l[crow(r, hi)]; } \
            SBAR(); pv_tile<KB>(o, vb0, pa0, pa1, pa2, pa3); }                                                                    \
        if ((t) + 1 < NT) { asm volatile("s_waitcnt vmcnt(0)" ::: "memory"); SWRITE((KB) ^ 1); }                               \
        __syncthreads(); } while (0)
    for (int t = 0; t < NT; t += 2) { STEP(t, 0); STEP(t + 1, 1); }
#undef STEP
#undef SLOAD
#undef SWRITE
    if (hi == 0) li_l[r32] = l_reg;
    LDS_WAIT();
    LAS unsigned char* stg = (LAS unsigned char*)lds + OFF_OST + wid * OST_WAVE;
#pragma unroll
    for (int r = 0; r < 16; ++r) { const int orow = crow(r, hi); const float rl = __builtin_amdgcn_rcpf(li_l[orow]);
#pragma unroll
        for (int d0 = 0; d0 < 4; ++d0) *(LAS unsigned short*)(stg + orow * OST_ROW + (d0 * 32 + r32) * 2) = (unsigned short)(cvt_pk_bf16(o[d0][r] * rl, 0.f) & 0xffffu); }
    LDS_WAIT();
    if (MODE == 0) { if (hi == 0) Lse[(size_t)(qlo + r32) * NH] = m_reg + log2f(l_reg); }
#pragma unroll
    for (int i = 0; i < 8; ++i) { const int row = i * 4 + (lane >> 4), ch = lane & 15;
        u32x4 v = *(const LAS u32x4*)(stg + row * OST_ROW + ch * 16);
        const size_t go = (size_t)(qlo + row) * DM + ch * 8;
        if (MODE == 1) { const u32x4 z = *(const u32x4*)(Zg + go);
            v.x = cvt_pk_bf16(bflo(v.x) * silu_f(bflo(z.x)), bfhi(v.x) * silu_f(bfhi(z.x))); v.y = cvt_pk_bf16(bflo(v.y) * silu_f(bflo(z.y)), bfhi(v.y) * silu_f(bfhi(z.y)));
            v.z = cvt_pk_bf16(bflo(v.z) * silu_f(bflo(z.z)), bfhi(v.z) * silu_f(bfhi(z.z))); v.w = cvt_pk_bf16(bflo(v.w) * silu_f(bflo(z.w)), bfhi(v.w) * silu_f(bfhi(z.w))); }
        *(u32x4*)(Og + go) = v; }
    LDS_WAIT();
}
struct MaskA {
    int L;
    __device__ __forceinline__ void info(int kb, int qlo, int r32, bool& act, bool& need, unsigned& W) const {
        const int seq0 = qlo & ~(L - 1); int lowk = qlo - 128; if (lowk < seq0) lowk = seq0;
        act = (kb <= qlo + 31) && (kb + KVBLK - 1 >= lowk); need = true;
        const int wl = qlo + r32 - seq0 + 1; W = (unsigned)(wl < 129 ? wl : 129);
    }
};
struct MaskB {
    int own0, base0; unsigned sel;
    __device__ __forceinline__ void info(int kb, int qlo, int r32, bool& act, bool& need, unsigned& W) const {
        if (kb >= own0) { act = kb <= qlo + 31; need = kb + KVBLK - 1 > qlo; W = 0x40000000u; }
        else { const int blk = (kb - base0) >> 8; const bool s = (sel >> blk) & 1u; const unsigned long long bal = __ballot(s);
            act = bal != 0ull; need = bal != ~0ull; W = s ? 0x40000000u : 0u; }
    }
};
#undef KSWZ
#undef SBAR
}

__device__ __forceinline__ void attn_a_flash(const Params& P, unsigned char* lds) {
    const int tid = otid();
    const bf16_t* QKV = (const bf16_t*)(P.ws + WS_QKV); bf16_t* OG = (bf16_t*)(P.ws + WS_OG); float* LSE = (float*)(P.ws + WS_LSE);
    for (int it = blockIdx.x; it < 3 * NH * (MTOK / 256); it += gridDim.x) {
        const int g = it >> 9, rem = it & 511, h = rem & 15, rb = rem >> 4;
        const int lg = 2 * g, L = SEQ >> lg, R0 = rb * 256;
        int krow0 = R0 - 128; { const int s0 = R0 & ~(L - 1); if (krow0 < s0) krow0 = s0; }
        const int NT = (R0 + 256 - krow0) >> 6;
        const fa::MaskA mk{L};
        fa::flash_block<0>(QKV + (size_t)(3 * g) * PART + (size_t)R0 * DM + h * HD, QKV + (size_t)(3 * g + 1) * PART + h * HD, QKV + (size_t)(3 * g + 2) * PART + h * HD,
                           krow0, NT, R0, slope_of(h) * (float)(1 << lg) * LOG2E, mk, lds, OG + (size_t)g * PART + h * HD, LSE + (size_t)g * MTOK * NH + h, nullptr, tid);
    }
}
__device__ __forceinline__ void attn_b_flash(const Params& P, unsigned char* lds) {
    const int tid = otid();
    const bf16_t* QKV = (const bf16_t*)(P.ws + WS_QKV); const bf16_t* Z = (const bf16_t*)(P.ws + WS_Z); bf16_t* G = (bf16_t*)(P.ws + WS_G); const float* KS = (const float*)(P.ws + WS_KSUM);
    LAS float* gk = (LAS float*)((LAS unsigned char*)lds + fa::OFF_GK); LAS unsigned* sel_l = (LAS unsigned*)((LAS unsigned char*)lds + fa::OFF_SEL);
    for (int it = blockIdx.x; it < NB * NH * 4; it += gridDim.x) {
        const int bh = it >> 2, s = it & 3, b = bh >> 4, h = bh & 15;
        for (int pass = 0; pass < 2; ++pass) {
            const int n = pass ? 7 - s : s, R0 = (b << 11) + (n << 8);
            unsigned sel = (1u << n) - 1u;
            if (n >= 4) {
                for (int i = tid; i < n * 128; i += NTHREADS) { const float* kp = KS + (size_t)(b * 8 + (i >> 7)) * DM + h * HD + (i & 127); gk[i] = kp[0] + kp[(size_t)32 * DM]; }
                __syncthreads();
                const int row = tid >> 1, half = tid & 1;
                const u32x4* qp = (const u32x4*)(QKV + (size_t)(R0 + row) * DM + h * HD + half * 64);
                float gt[7];
#pragma unroll
                for (int j = 0; j < 7; ++j) gt[j] = 0.f;
#pragma unroll
                for (int c = 0; c < 8; ++c) { const u32x4 w = qp[c]; const float q0 = bflo(w.x), q1 = bfhi(w.x), q2 = bflo(w.y), q3 = bfhi(w.y), q4 = bflo(w.z), q5 = bfhi(w.z), q6 = bflo(w.w), q7 = bfhi(w.w);
#pragma unroll
                    for (int j = 0; j < 7; ++j) if (j < n) { const LAS f32x4* kk = (const LAS f32x4*)(gk + j * 128 + half * 64 + c * 8); const f32x4 ka = kk[0], kb2 = kk[1];
                        gt[j] += (q0 * ka.x + q1 * ka.y) + (q2 * ka.z + q3 * ka.w) + (q4 * kb2.x + q5 * kb2.y) + (q6 * kb2.z + q7 * kb2.w); } }
#pragma unroll
                for (int j = 0; j < 7; ++j) gt[j] += __shfl_xor(gt[j], 1);
                unsigned mask = 0;
#pragma unroll
                for (int j = 0; j < 7; ++j) if (j < n) { int rank = 0;
#pragma unroll
                    for (int j2 = 0; j2 < 7; ++j2) if (j2 < n && (gt[j2] > gt[j] || (gt[j2] == gt[j] && j2 < j))) ++rank;
                    if (rank < 3) mask |= 1u << j; }
                if (half == 0) sel_l[row] = mask;
                __syncthreads();
                sel = sel_l[(tid >> 6) * 32 + (tid & 31)];
            }
            const fa::MaskB mk{R0, b << 11, sel};
            fa::flash_block<1>(QKV + (size_t)R0 * DM + h * HD, QKV + PART + h * HD, QKV + 2 * PART + h * HD, b << 11, 4 * (n + 1), R0, slope_of(h) * LOG2E, mk, lds,
                               G + h * HD, nullptr, Z + h * HD, tid);
        }
    }
}

#define XB_TMO      128
#define XB_XCNT(j)  (256  + 64 * (j))
#define XB_XSUB(j)  (1280 + 64 * (j))
#define XB_XGEN(j)  (2304 + 64 * (j))
#define XB_TOP      3328
#define XB_TOPGEN   3392
#define XCD_BAR_WORDS 3456
#define XB_SPIN_CAP (1u << 20)
__device__ __forceinline__ unsigned xb_ld(unsigned* p)              { return __hip_atomic_load(p, __ATOMIC_RELAXED, __HIP_MEMORY_SCOPE_AGENT); }
__device__ __forceinline__ unsigned xb_add(unsigned* p, unsigned v) { return __hip_atomic_fetch_add(p, v, __ATOMIC_RELAXED, __HIP_MEMORY_SCOPE_AGENT); }
__device__ __forceinline__ unsigned xb_xcc_id() { return (unsigned)__builtin_amdgcn_s_getreg((3 << 11) | 20) & 0xFu; }
#define XB_SPIN(cond, bar) do { unsigned _sp = 0; while (cond) { __builtin_amdgcn_s_sleep(1); \
    if ((++_sp & 255u) == 0u) { if (xb_ld(&(bar)[XB_TMO])) break; if (_sp > XB_SPIN_CAP) { atomicAdd(&(bar)[XB_TMO], 1u); break; } } } } while (0)
struct XcdBarrier { unsigned* bar; unsigned x; volatile LAS unsigned* st; };
__device__ __forceinline__ XcdBarrier xcd_barrier_post(unsigned* bar, volatile LAS unsigned* st) {
    XcdBarrier b; b.bar = bar; b.x = xb_xcc_id(); b.st = st;
    if (threadIdx.x == 0) (void)xb_add(&bar[XB_XCNT(b.x)], 1u);
    return b;
}
__device__ __forceinline__ void xcd_barrier_complete(unsigned* bar, unsigned x, unsigned& nloc, unsigned& nx) {
    const unsigned G = gridDim.x * gridDim.y * gridDim.z;
    unsigned sum, cnt, mine, sp = 0u;
    for (;;) {
        sum = 0u; cnt = 0u; mine = 0u;
#pragma unroll
        for (unsigned j = 0; j < 16; ++j) { const unsigned c = xb_ld(&bar[XB_XCNT(j)]); sum += c; cnt += (c > 0u) ? 1u : 0u; mine = (j == x) ? c : mine; }
        if (sum == G) break;
        __builtin_amdgcn_s_sleep(1);
        if ((++sp & 255u) == 0u) { if (xb_ld(&bar[XB_TMO])) break; if (sp > XB_SPIN_CAP) { atomicAdd(&bar[XB_TMO], 1u); break; } }
    }
    nloc = mine > 0u ? mine : 1u; nx = cnt > 0u ? cnt : 1u;
}
__device__ __forceinline__ void xcd_barrier(const XcdBarrier& b) {
    asm volatile("s_waitcnt vmcnt(0)" ::: "memory");
    __syncthreads();
    if (threadIdx.x == 0) {
        unsigned* bar = b.bar;
        __builtin_amdgcn_s_waitcnt(0);
        unsigned nloc = b.st[0], nx = b.st[1];
        if (nloc == 0u) { xcd_barrier_complete(bar, b.x, nloc, nx); b.st[0] = nloc; b.st[1] = nx; }
        const unsigned old = xb_add(&bar[XB_XSUB(b.x)], 1u);
        const unsigned gen = old / nloc;
        if (old + 1u == (gen + 1u) * nloc) {
            __builtin_amdgcn_fence(__ATOMIC_RELEASE, "agent");
            asm volatile("s_waitcnt vmcnt(0)" ::: "memory");
            const unsigned og = xb_add(&bar[XB_TOP], 1u);
            const unsigned tg = og / nx;
            if (og + 1u == (tg + 1u) * nx) xb_add(&bar[XB_TOPGEN], 1u);
            else XB_SPIN(xb_ld(&bar[XB_TOPGEN]) == tg, bar);
            __builtin_amdgcn_fence(__ATOMIC_ACQUIRE, "agent");
            xb_add(&bar[XB_XGEN(b.x)], 1u);
            asm volatile("s_waitcnt vmcnt(0)" ::: "memory");
        } else {
            XB_SPIN(xb_ld(&bar[XB_XGEN(b.x)]) == gen, bar);
            __builtin_amdgcn_fence(__ATOMIC_ACQUIRE, "agent");
            asm volatile("s_waitcnt vmcnt(0)" ::: "memory");
        }
    }
    __syncthreads();
}

__global__ void __launch_bounds__(NTHREADS, 2) fwd_mega(Params P) {
    extern __shared__ __attribute__((aligned(16))) unsigned char lds[];
    cg::grid_group grid = cg::this_grid();
    LAS unsigned char* lds3 = (LAS unsigned char*)lds;

    volatile LAS unsigned* bst = (volatile LAS unsigned*)(lds3 + (LDS_BYTES - 64));
    if (threadIdx.x < 2) bst[threadIdx.x] = 0u;
    __syncthreads();
    const XcdBarrier xbar = xcd_barrier_post((unsigned*)(P.ws + WS_CTL), bst);
#define GSYNC() xcd_barrier(xbar)
    p0_mod(P, lds);
    p0_weights(P, lds);
#if PROBE == 1
    __syncthreads(); p0_mod(P, lds); p0_weights(P, lds);
#endif
    grid.sync();
    for (int layer = 0; layer < DEPTH; ++layer) {
        const bool isA = (layer & 1) == 0; const int j = layer >> 1;
        const float* xin = layer == 0 ? P.x : P.out;
        norm_phase(P, xin, layer, !isA);
#if PROBE == 2
        norm_phase(P, xin, layer, !isA);
#endif
#if PROBE == 6
        GSYNC(); GSYNC(); GSYNC(); GSYNC(); GSYNC();
#endif
        GSYNC();
        {
            if (!isA) {
                pg8::Gemm g{P.ws + WS_H, P.ws + WS_WBQK + (size_t)j * 4096 * DM * 2, MTOK, 4096, DM * 2};
                pg8::StaticOrder S; S.init(MTOK, 4096, (int)gridDim.x, (int)blockIdx.x);
                pg8::Epi E{1, 0, (bf16_t*)(P.ws + WS_QKV), (bf16_t*)(P.ws + WS_Z), (float*)(P.ws + WS_KSUM), nullptr, nullptr, nullptr, nullptr, nullptr};
                pg8::gemm_phase<pg8::Epi, pg8::StaticOrder, GEMM_ALIGN, GEMM_SP2, false>(lds3, g, S, E);
            }
            {
                pg8::Gemm g{P.ws + WS_HQ, isA ? P.ws + WS_WAIN + (size_t)j * A_N * DM : P.ws + WS_WBVZ + (size_t)j * 4096 * DM, MTOK, isA ? A_N : 4096, DM};
                pg8::StaticOrder S; S.init(MTOK, g.N, (int)gridDim.x, (int)blockIdx.x);
                pg8::Epi E{isA ? 0 : 1, isA ? 0 : 2, (bf16_t*)(P.ws + WS_QKV), (bf16_t*)(P.ws + WS_Z), nullptr, (const float*)(P.ws + WS_RS),
                           isA ? (const float*)(P.ws + WS_CSA) + j * A_N : (const float*)(P.ws + WS_CSB) + j * 4096, nullptr, nullptr, nullptr};
                pg8::gemm_phase<pg8::Epi, pg8::StaticOrder, GEMM_ALIGN, GEMM_SP2, true>(lds3, g, S, E);
#if PROBE == 7
                pg8::gemm_phase<pg8::Epi, pg8::StaticOrder, GEMM_ALIGN, GEMM_SP2, true>(lds3, g, S, E);
#endif
            }
        }
        GSYNC();
#if PROBE == 3
        if (isA) attn_a_flash(P, lds);
#endif
#if PROBE == 4
        if (!isA) attn_b_flash(P, lds);
#endif
        if (isA) { attn_a_flash(P, lds); GSYNC(); combine_phase(P);
#if PROBE == 5
            combine_phase(P);
#endif
        }
        else { attn_b_flash(P, lds); }
        GSYNC();
        {
            pg8::Gemm g{P.ws + WS_G, isA ? P.ws + WS_WAOUT + (size_t)j * DM * DM * 2 : P.ws + WS_WBOUT + (size_t)j * DM * DM * 2, MTOK, DM, DM * 2};
            pg8::StaticOrder S; S.init(MTOK, DM, (int)gridDim.x, (int)blockIdx.x);
            pg8::Epi E{2, 0, nullptr, nullptr, nullptr, nullptr, nullptr, xin, P.out, (const float*)(P.ws + WS_MOD) + (size_t)layer * 4 * 6144 + 4096};
            pg8::gemm_phase<pg8::Epi, pg8::StaticOrder, GEMM_ALIGN, GEMM_SP2, false>(lds3, g, S, E);
        }
        GSYNC();
    }
    final_norm_phase(P);
}

extern "C" void kernel_launch(void* const* d_in, const int* in_sizes, int n_in, void* d_out, int out_size, void* d_ws, size_t ws_size, hipStream_t stream) {
    static int grid = 0;
    if (grid == 0) {
        if (n_in != 10 || in_sizes[0] != MTOK * DM || out_size != MTOK * DM || ws_size < WS_END) {
            fprintf(stderr, "kernel_launch: unexpected shapes/workspace (n_in %d, in0 %d, out %d, ws %zu, need %zu)\n", n_in, n_in > 0 ? in_sizes[0] : -1, out_size, ws_size, (size_t)WS_END); grid = -1; return; }
        int dev = 0, cus = 0, per_cu = 0;
        (void)hipGetDevice(&dev); (void)hipDeviceGetAttribute(&cus, hipDeviceAttributeMultiprocessorCount, dev);
        if (hipFuncSetAttribute((const void*)fwd_mega, hipFuncAttributeMaxDynamicSharedMemorySize, LDS_BYTES) != hipSuccess) { fprintf(stderr, "kernel_launch: hipFuncSetAttribute failed\n"); grid = -1; return; }
        if (hipOccupancyMaxActiveBlocksPerMultiprocessor(&per_cu, (const void*)fwd_mega, NTHREADS, LDS_BYTES) != hipSuccess || per_cu < 1) { fprintf(stderr, "kernel_launch: occupancy query says %d\n", per_cu); (void)hipGetLastError(); per_cu = 1; }
        if (per_cu > 1) per_cu = 1;
        grid = cus * per_cu;
    }
    if (grid < 0) return;
    (void)hipMemsetAsync((char*)d_ws + WS_CTL, 0, 16384, stream);
    Params p{};
    p.x = (const float*)d_in[0]; p.c = (const float*)d_in[1]; p.norm_w = (const float*)d_in[2]; p.mod_w = (const float*)d_in[3]; p.mod_b = (const float*)d_in[4];
    p.a_w_in = (const float*)d_in[5]; p.a_w_out = (const float*)d_in[6]; p.b_w_in = (const float*)d_in[7]; p.b_w_out = (const float*)d_in[8]; p.final_w = (const float*)d_in[9];
    p.out = (float*)d_out; p.ws = (unsigned char*)d_ws;
    void* args[] = {&p};
    hipError_t e = hipLaunchCooperativeKernel((const void*)fwd_mega, dim3(grid), dim3(NTHREADS), args, LDS_BYTES, stream);
    if (e != hipSuccess) fprintf(stderr, "kernel_launch: cooperative launch failed: %s (grid %d)\n", hipGetErrorString(e), grid);
}
```

```cpp
#include <hip/hip_runtime.h>
#include <hip/hip_cooperative_groups.h>
#include <cstdio>
#include <cstdint>
namespace cg = cooperative_groups;
#ifndef ATTN_A_FLASH
#define ATTN_A_FLASH 1
#endif
#ifndef GEMM_ALIGN
#define GEMM_ALIGN true
#endif
#ifndef GEMM_SP2
#define GEMM_SP2 true
#endif
#ifndef PROBE
#define PROBE 0
#endif
#ifndef USE_CG_SYNC
#define USE_CG_SYNC 0
#endif
#ifndef ATTN_PIPE
#define ATTN_PIPE 1
#endif
#ifndef ATTN_DMA
#define ATTN_DMA 1
#endif
#ifndef ATTN_B_FLASH
#define ATTN_B_FLASH 1
#endif

#define LAS __attribute__((address_space(3)))
typedef unsigned short bf16_t;
typedef short bf16x8 __attribute__((ext_vector_type(8)));
typedef short s16x4 __attribute__((ext_vector_type(4)));
typedef float f32x4 __attribute__((ext_vector_type(4)));
typedef float f32x16 __attribute__((ext_vector_type(16)));
typedef unsigned u32x4 __attribute__((ext_vector_type(4)));
typedef unsigned u32x2 __attribute__((ext_vector_type(2)));
typedef int i32x4 __attribute__((ext_vector_type(4)));

constexpr int NB = 4, SEQ = 2048, DM = 2048, MTOK = NB * SEQ, NH = 16, HD = 128, DEPTH = 4;
constexpr int A_N = 10 * DM, B_N = 4 * DM;
constexpr float EPS = 1e-6f;
constexpr float LOG2E = 1.4426950408889634f;
constexpr float C2Q = 0.08838834764831845f * LOG2E;

constexpr size_t MiB = 1u << 20;
constexpr size_t WS_CTL = 0;
constexpr size_t WS_MOD = 1 * MiB;
constexpr size_t WS_KSUM = 2 * MiB;
constexpr size_t WS_LSE = 3 * MiB;
constexpr size_t WS_RS = 5 * MiB;
constexpr size_t WS_CSA = 6 * MiB;
constexpr size_t WS_CSB = 7 * MiB;
constexpr size_t WS_WAIN = 8 * MiB;
constexpr size_t WS_WBQK = WS_WAIN + 80 * MiB;
constexpr size_t WS_WBVZ = WS_WBQK + 32 * MiB;
constexpr size_t WS_WAOUT = WS_WBVZ + 16 * MiB;
constexpr size_t WS_WBOUT = WS_WAOUT + 16 * MiB;
constexpr size_t WS_H = WS_WBOUT + 16 * MiB;
constexpr size_t WS_HQ = WS_H + 32 * MiB;
constexpr size_t WS_G = WS_HQ + 16 * MiB;
constexpr size_t WS_QKV = WS_G + 32 * MiB;
constexpr size_t WS_Z = WS_QKV + 288 * MiB;
constexpr size_t WS_OG = WS_Z + 32 * MiB;
constexpr size_t WS_END = WS_OG + 96 * MiB;
constexpr size_t PART = (size_t)MTOK * DM;

constexpr int LDS_BYTES = 147456;
constexpr int NTHREADS = 512;

__device__ __forceinline__ unsigned cvt_pk_bf16(float lo, float hi) { unsigned r; asm volatile("v_cvt_pk_bf16_f32 %0, %1, %2" : "=v"(r) : "v"(lo), "v"(hi)); return r; }
__device__ __forceinline__ float bf2f(unsigned short v) { return __uint_as_float(((unsigned)v) << 16); }
__device__ __forceinline__ float bflo(unsigned w) { return __uint_as_float(w << 16); }
__device__ __forceinline__ float bfhi(unsigned w) { return __uint_as_float(w & 0xffff0000u); }
__device__ __forceinline__ float wave_sum(float v) {
#pragma unroll
    for (int o = 1; o < 64; o <<= 1) v += __shfl_xor(v, o);
    return v;
}
__device__ __forceinline__ float wave_max(float v) {
#pragma unroll
    for (int o = 1; o < 64; o <<= 1) v = fmaxf(v, __shfl_xor(v, o));
    return v;
}
__device__ __forceinline__ float silu_f(float v) { return v / (1.f + __expf(-v)); }
#define LDS_WAIT() asm volatile("s_waitcnt lgkmcnt(0)" ::: "memory")
__device__ __forceinline__ int otid(int wv) { int l; asm volatile("v_mbcnt_lo_u32_b32 %0, -1, 0\n\tv_mbcnt_hi_u32_b32 %0, -1, %0" : "=v"(l)); return (wv << 6) | l; }
template <class T> __device__ __forceinline__ T* optr(T* p) { asm volatile("" : "+s"(p)); return p; }
__device__ __forceinline__ int obid() { int b = blockIdx.x; asm volatile("" : "+s"(b)); return b; }

namespace pg8 {
constexpr int BM = 256, BK = 64, HALF = 128, HTB = HALF * BK * 2, STAGE_BYTES = 8 * HTB, NXCD = 8, WGM = 8;
__host__ __device__ __forceinline__ int lds_byte(int r, int c) { const int st = (r >> 4) * 2 + (c >> 5), rr = r & 15, cc = c & 31, ob = rr * 64 + cc * 2; return st * 1024 + (ob ^ (((ob >> 9) & 1) << 5)); }
__host__ __device__ __forceinline__ void stage_rc(int b, int& R, int& C) { const int st = b / 1024, sb = b % 1024, swz = sb ^ (((sb >> 9) & 1) << 5); R = (st >> 1) * 16 + swz / 64; C = (st & 1) * 32 + (swz % 64) / 2; }
__host__ __device__ __forceinline__ int perm32(int rho) { const int n = rho >> 4, i = rho & 15; return 8 * (i >> 2) + 4 * n + (i & 3); }
struct Unit { int pm, pn; };
struct Gemm { const void* A; const void* Bt; int M, N, KB; };
struct StaticOrder {
    int nM, nN, nwg, G, c;
    __host__ __device__ void init(int M, int N, int G_, int c_) { nM = M / BM; nN = N / BM; nwg = nM * nN; G = G_; c = c_; }
    __host__ __device__ bool next(int i, Unit& u) const {
        const long L = (long)i * G + c; if (L >= nwg) return false;
        int wgid = (int)L; { const int q = nwg / NXCD, r = nwg % NXCD, xcd = wgid % NXCD, off = wgid / NXCD; wgid = (xcd < r ? xcd * (q + 1) : r * (q + 1) + (xcd - r) * q) + off; }
        const int nig = WGM * nN, gid = wgid / nig, fm = gid * WGM, gsz = (nM - fm) < WGM ? (nM - fm) : WGM;
        u.pm = fm + ((wgid % nig) % gsz); u.pn = (wgid % nig) / gsz; return true;
    }
    __device__ __forceinline__ void a_ready(const Unit&) const {}
    __device__ __forceinline__ void done(const Unit&) const {}
};

__device__ __forceinline__ f32x4 acc_f32(const f32x4& a) { return a; }
__device__ __forceinline__ f32x4 acc_f32(const i32x4& a) { return (f32x4){(float)a.x, (float)a.y, (float)a.z, (float)a.w}; }
struct Epi {
    static constexpr bool PERM = true, AFTER_DRAIN = false;
    int mode;
    int pbase;
    bf16_t* qkv; bf16_t* zbuf; float* ksum;
    const float* rs; const float* cs;
    const float* xin; float* xout; const float* gate;
    template <class AccT>
    __device__ __forceinline__ void operator()(const AccT (&acc)[2][2][4][2], const Unit& u, int wr, int wc, int fr, int fq) const {
        constexpr bool I8 = sizeof(AccT) == sizeof(i32x4) && !__is_same(AccT, f32x4);
        if (mode == 2) {
            const int col0 = u.pn * BM + wc * 32 + 8 * fq; const int b = (u.pm * BM) >> 11;
            f32x4 gv[2][2];
#pragma unroll
            for (int bj = 0; bj < 2; ++bj)
#pragma unroll
                for (int n = 0; n < 2; ++n) gv[bj][n] = *(const f32x4*)(gate + b * 6144 + col0 + bj * HALF + 4 * n);
#pragma unroll
            for (int ai = 0; ai < 2; ++ai)
#pragma unroll
                for (int m = 0; m < 4; ++m) { const size_t off = (size_t)(u.pm * BM + ai * HALF + wr * 64 + m * 16 + fr) * DM + col0;
#pragma unroll
                    for (int bj = 0; bj < 2; ++bj)
#pragma unroll
                        for (int n = 0; n < 2; ++n) { const f32x4 xv = *(const f32x4*)(xin + off + bj * HALF + 4 * n);
                            *(f32x4*)(xout + off + bj * HALF + 4 * n) = xv + gv[bj][n] * acc_f32(acc[ai][bj][m][n]); }
                    asm volatile("" ::: "memory"); }
            return;
        }
        const int p = pbase + (u.pn >> 3), colt = (u.pn & 7) * BM;
        int lg = 0; float sc = 1.f; bf16_t* base;
        if (mode == 0) { if (p == 9) base = zbuf; else { const int g = p / 3, kind = p - 3 * g; lg = 2 * g; base = qkv + (size_t)p * PART; if (kind == 0) sc = C2Q; } }
        else { if (p == 3) base = zbuf; else { base = qkv + (size_t)p * PART; if (p == 0) sc = C2Q; } }
        const int col0 = colt + wc * 32 + 8 * fq;
        f32x4 cv[2][2];
        if (I8) {
#pragma unroll
            for (int bj = 0; bj < 2; ++bj)
#pragma unroll
                for (int n = 0; n < 2; ++n) cv[bj][n] = *(const f32x4*)(cs + u.pn * BM + wc * 32 + 8 * fq + bj * HALF + 4 * n) * sc;
        }
#pragma unroll
        for (int ai = 0; ai < 2; ++ai)
#pragma unroll
            for (int m = 0; m < 4; ++m) {
                const int row = u.pm * BM + ai * HALF + wr * 64 + m * 16 + fr, b = row >> 11, t = row & 2047;
                const int R = (b << 11) + ((t & ((1 << lg) - 1)) << (11 - lg)) + (t >> lg);
                bf16_t* rowp = base + (size_t)R * DM + col0;
                float rsv = sc; if (I8) rsv = rs[row];
#pragma unroll
                for (int bj = 0; bj < 2; ++bj) { f32x4 v0 = acc_f32(acc[ai][bj][m][0]) * rsv, v1 = acc_f32(acc[ai][bj][m][1]) * rsv;
                    if (I8) { v0 = v0 * cv[bj][0]; v1 = v1 * cv[bj][1]; }
                    u32x4 w; w.x = cvt_pk_bf16(v0[0], v0[1]); w.y = cvt_pk_bf16(v0[2], v0[3]); w.z = cvt_pk_bf16(v1[0], v1[1]); w.w = cvt_pk_bf16(v1[2], v1[3]);
                    *(u32x4*)(rowp + bj * HALF) = w; } }
        if (!I8 && mode == 1 && p == 1) {
#pragma unroll
            for (int bj = 0; bj < 2; ++bj)
#pragma unroll
                for (int n = 0; n < 2; ++n) { f32x4 s = {0.f, 0.f, 0.f, 0.f};
#pragma unroll
                    for (int ai = 0; ai < 2; ++ai)
#pragma unroll
                        for (int m = 0; m < 4; ++m) s += acc_f32(acc[ai][bj][m][n]);
#pragma unroll
                    for (int j = 0; j < 4; ++j) { float v = s[j]; v += __shfl_xor(v, 1); v += __shfl_xor(v, 2); v += __shfl_xor(v, 4); v += __shfl_xor(v, 8); s[j] = v; }
                    if (fr == 0) *(f32x4*)(ksum + ((size_t)(wr * 32 + u.pm) * DM + colt + bj * HALF + wc * 32 + 8 * fq + 4 * n)) = s; }
        }
    }
};

template <bool I8> struct AccSel { typedef f32x4 type; };
template <> struct AccSel<true> { typedef i32x4 type; };
template <bool I8> __device__ __forceinline__ typename AccSel<I8>::type mma1(bf16x8 b, bf16x8 a, typename AccSel<I8>::type c) {
    if constexpr (I8) return __builtin_amdgcn_mfma_i32_16x16x64_i8(__builtin_bit_cast(i32x4, b), __builtin_bit_cast(i32x4, a), c, 0, 0, 0);
    else return __builtin_amdgcn_mfma_f32_16x16x32_bf16(b, a, c, 0, 0, 0);
}
template <class Epi, class Sched, bool ALIGN_EPI = false, bool SP2 = false, bool I8 = false>
__device__ __forceinline__ void gemm_phase(LAS unsigned char* lds, const Gemm g, const Sched& S, const Epi& E, int wv) {
    const int tid = otid(wv), wid = __builtin_amdgcn_readfirstlane(tid >> 6), lane = tid & 63, wr = wid >> 2, wc = wid & 3, fr = lane & 15, fq = lane >> 4;
    const int KBY = g.KB, nt = KBY / (BK * 2);
    unsigned voffA[2], voffB[2];
#pragma unroll
    for (int i = 0; i < 2; ++i) { int R, C; stage_rc(tid * 16 + i * 8192, R, C); const int Rb = Epi::PERM ? ((R & ~31) + perm32(R & 31)) : R;
        voffA[i] = (unsigned)(R * KBY + C * 2); voffB[i] = (unsigned)(Rb * KBY + C * 2); }
    const size_t kstep = (size_t)(BK * 2);
    const size_t hstep = (size_t)HALF * KBY;
    const size_t tstep = 2 * hstep;
    const unsigned ldsw = (unsigned)wid * 1024u;
    const int aoff = lds_byte(wr * 64 + fr, fq * 8), boff = lds_byte(wc * 32 + fr, fq * 8);
#define PG8_SA(b, h) (((b) * 2 + (h)) * HTB)
#define PG8_SB(b, h) ((4 + (b) * 2 + (h)) * HTB)
#define PG8_STAGE(bufoff, gbase, voff) do { _Pragma("unroll") for (int _i = 0; _i < 2; ++_i) \
        __builtin_amdgcn_global_load_lds((const unsigned*)((const char*)(gbase) + (voff)[_i]), (LAS unsigned*)(lds + (bufoff) + ldsw + _i * 8192), 16, 0, 0); } while (0)
#define PG8_LDA(dst, b, h) do { _Pragma("unroll") for (int m = 0; m < 4; ++m) _Pragma("unroll") for (int k = 0; k < 2; ++k) dst[m][k] = *(const LAS bf16x8*)(lds + PG8_SA(b, h) + aoff + m * 2048 + k * 1024); } while (0)
#define PG8_LDB(dst, b, h) do { _Pragma("unroll") for (int n = 0; n < 2; ++n) _Pragma("unroll") for (int k = 0; k < 2; ++k) dst[n][k] = *(const LAS bf16x8*)(lds + PG8_SB(b, h) + boff + n * 2048 + k * 1024); } while (0)
#define PG8_MMA(ai, bj, At, Bt) do { __builtin_amdgcn_s_setprio(1); _Pragma("unroll") for (int m = 0; m < 4; ++m) _Pragma("unroll") for (int n = 0; n < 2; ++n) _Pragma("unroll") for (int k = 0; k < 2; ++k) \
        acc[ai][bj][m][n] = mma1<I8>(Bt[n][k], At[m][k], acc[ai][bj][m][n]); __builtin_amdgcn_s_setprio(0); } while (0)
#define PG8_WAIT_V(n) asm volatile("s_waitcnt vmcnt(" #n ")" ::: "memory")
#define PG8_WAIT_L(n) asm volatile("s_waitcnt lgkmcnt(" #n ")" ::: "memory")
#define PG8_BAR __builtin_amdgcn_s_barrier()
#define PG8_SCHED __builtin_amdgcn_sched_barrier(0)
    Unit cur, nxt; int ui = 0;
    if (!S.next(0, cur)) return;
    typedef typename AccSel<I8>::type acc_t;
    acc_t acc[2][2][4][2];
#pragma unroll
    for (int a = 0; a < 2; ++a)
#pragma unroll
        for (int b = 0; b < 2; ++b)
#pragma unroll
            for (int m = 0; m < 4; ++m)
#pragma unroll
                for (int n = 0; n < 2; ++n) acc[a][b][m][n] = acc_t{};
    bf16x8 At[4][2], B0[2][2], B1[2][2];
    const char* cA = (const char*)g.A + (size_t)cur.pm * tstep; const char* cB = (const char*)g.Bt + (size_t)cur.pn * tstep;
    S.a_ready(cur);
    if constexpr (SP2) {
        PG8_STAGE(PG8_SB(0, 0), cB, voffB); PG8_STAGE(PG8_SB(0, 1), cB + hstep, voffB); PG8_STAGE(PG8_SA(0, 0), cA, voffA); PG8_STAGE(PG8_SA(0, 1), cA + hstep, voffA);
        if (wr == 1) PG8_BAR;
        PG8_WAIT_V(2); PG8_BAR;
        PG8_STAGE(PG8_SB(1, 0), cB + kstep, voffB); PG8_STAGE(PG8_SA(1, 0), cA + kstep, voffA); PG8_STAGE(PG8_SB(1, 1), cB + hstep + kstep, voffB);
        PG8_WAIT_V(6); PG8_BAR;
    } else {
        PG8_STAGE(PG8_SB(0, 0), cB, voffB); PG8_STAGE(PG8_SA(0, 0), cA, voffA); PG8_STAGE(PG8_SB(0, 1), cB + hstep, voffB); PG8_STAGE(PG8_SA(0, 1), cA + hstep, voffA);
        if (wr == 1) PG8_BAR;
        PG8_WAIT_V(4); PG8_BAR;
        PG8_STAGE(PG8_SB(1, 0), cB + kstep, voffB); PG8_STAGE(PG8_SA(1, 0), cA + kstep, voffA); PG8_STAGE(PG8_SB(1, 1), cB + hstep + kstep, voffB);
        PG8_WAIT_V(6); PG8_BAR;
    }
    for (;;) {
        const bool has_next = S.next(ui + 1, nxt);
        const char* nA = has_next ? (const char*)g.A + (size_t)nxt.pm * tstep : cA; const char* nB = has_next ? (const char*)g.Bt + (size_t)nxt.pn * tstep : cB;
        for (int t = 0; t < nt; t += 2) {
            const bool last = (t == nt - 2);
            const char* a1 = cA + (size_t)(t + 1) * kstep;
            const char* a2 = last ? nA : cA + (size_t)(t + 2) * kstep; const char* b2 = last ? nB : cB + (size_t)(t + 2) * kstep;
            const char* a3 = a2 + kstep; const char* b3 = b2 + kstep;
            if (last && has_next) S.a_ready(nxt);
            if constexpr (SP2) {
            PG8_LDB(B0, 0, 0); PG8_LDB(B1, 0, 1); PG8_SCHED; PG8_LDA(At, 0, 0); PG8_STAGE(PG8_SA(1, 1), a1 + hstep, voffA);
            PG8_WAIT_V(8); PG8_WAIT_L(0); PG8_BAR; PG8_MMA(0, 0, At, B0); PG8_MMA(0, 1, At, B1); PG8_BAR; PG8_SCHED;
            PG8_LDA(At, 0, 1); PG8_STAGE(PG8_SB(0, 0), b2, voffB); PG8_STAGE(PG8_SB(0, 1), b2 + hstep, voffB); PG8_STAGE(PG8_SA(0, 0), a2, voffA);
            PG8_WAIT_V(8); PG8_WAIT_L(0); PG8_BAR; PG8_MMA(1, 0, At, B0); PG8_MMA(1, 1, At, B1); PG8_BAR; PG8_SCHED;
            PG8_LDB(B0, 1, 0); PG8_LDB(B1, 1, 1); PG8_SCHED; PG8_LDA(At, 1, 0); PG8_STAGE(PG8_SA(0, 1), a2 + hstep, voffA);
            PG8_WAIT_V(8); PG8_WAIT_L(0); PG8_BAR; PG8_MMA(0, 0, At, B0); PG8_MMA(0, 1, At, B1); PG8_BAR; PG8_SCHED;
            PG8_LDA(At, 1, 1); PG8_STAGE(PG8_SB(1, 0), b3, voffB); PG8_STAGE(PG8_SB(1, 1), b3 + hstep, voffB); PG8_STAGE(PG8_SA(1, 0), a3, voffA);
            PG8_WAIT_V(8); PG8_WAIT_L(0); PG8_BAR; PG8_MMA(1, 0, At, B0); PG8_MMA(1, 1, At, B1); PG8_BAR; PG8_SCHED;
            } else {
            PG8_LDB(B0, 0, 0); PG8_SCHED; PG8_LDA(At, 0, 0); PG8_STAGE(PG8_SA(1, 1), a1 + hstep, voffA);
            PG8_WAIT_L(8); PG8_BAR; PG8_WAIT_L(0); PG8_MMA(0, 0, At, B0); PG8_BAR; PG8_SCHED;
            PG8_LDB(B1, 0, 1); PG8_STAGE(PG8_SB(0, 0), b2, voffB);
            PG8_BAR; PG8_WAIT_L(0); PG8_MMA(0, 1, At, B1); PG8_BAR;
            PG8_LDA(At, 0, 1); PG8_STAGE(PG8_SA(0, 0), a2, voffA);
            PG8_BAR; PG8_WAIT_L(0); PG8_MMA(1, 0, At, B0); PG8_BAR; PG8_SCHED;
            PG8_STAGE(PG8_SB(0, 1), b2 + hstep, voffB);
            PG8_WAIT_V(6); PG8_BAR; PG8_MMA(1, 1, At, B1); PG8_BAR;
            PG8_LDB(B0, 1, 0); PG8_SCHED; PG8_LDA(At, 1, 0); PG8_STAGE(PG8_SA(0, 1), a2 + hstep, voffA);
            PG8_WAIT_L(8); PG8_BAR; PG8_WAIT_L(0); PG8_MMA(0, 0, At, B0); PG8_BAR; PG8_SCHED;
            PG8_LDB(B1, 1, 1); PG8_STAGE(PG8_SB(1, 0), b3, voffB);
            PG8_BAR; PG8_WAIT_L(0); PG8_MMA(0, 1, At, B1); PG8_BAR;
            PG8_LDA(At, 1, 1); PG8_STAGE(PG8_SA(1, 0), a3, voffA);
            PG8_BAR; PG8_WAIT_L(0); PG8_MMA(1, 0, At, B0); PG8_BAR; PG8_SCHED;
            PG8_STAGE(PG8_SB(1, 1), b3 + hstep, voffB);
            PG8_WAIT_V(6); PG8_BAR; PG8_MMA(1, 1, At, B1); PG8_BAR;
            }
        }
        if constexpr (ALIGN_EPI) { if (wr == 0) PG8_BAR; }
        if constexpr (!Epi::AFTER_DRAIN) { E(acc, cur, wr, wc, fr, fq); S.done(cur); }
        if (!has_next) break;
#pragma unroll
        for (int a = 0; a < 2; ++a)
#pragma unroll
            for (int b = 0; b < 2; ++b)
#pragma unroll
                for (int m = 0; m < 4; ++m)
#pragma unroll
                    for (int n = 0; n < 2; ++n) acc[a][b][m][n] = acc_t{};
        cur = nxt; cA = nA; cB = nB; ++ui;
        if constexpr (ALIGN_EPI) { if (wr == 1) PG8_BAR; }
    }
    PG8_WAIT_V(0);
    if constexpr (!ALIGN_EPI) { if (wr == 0) PG8_BAR; }
    PG8_BAR;
#undef PG8_SA
#undef PG8_SB
#undef PG8_STAGE
#undef PG8_LDA
#undef PG8_LDB
#undef PG8_MMA
#undef PG8_WAIT_V
#undef PG8_WAIT_L
#undef PG8_BAR
#undef PG8_SCHED
}
}

struct Params {
    const float *x, *c, *norm_w, *mod_w, *mod_b, *a_w_in, *a_w_out, *b_w_in, *b_w_out, *final_w;
    float* out; unsigned char* ws;
};

typedef const __attribute__((address_space(4))) Params CParams;
__device__ __forceinline__ CParams& PP() { CParams* p = (CParams*)__builtin_amdgcn_kernarg_segment_ptr(); asm volatile("" : "+s"(p)); return *p; }

__device__ __forceinline__ void p0_mod(unsigned char* lds, int wv) {
    CParams& P = PP();
    const int tid = otid(wv);
    f32x4* condT = (f32x4*)lds;
    float* red = (float*)(lds + 32768);
    float* MOD = (float*)(P.ws + WS_MOD);
    bool have = false;
    for (int item = obid(); item < 192; item += gridDim.x) {
        if (!have) { have = true;
            for (int k = tid; k < DM; k += NTHREADS) { f32x4 v; v.x = silu_f(P.c[k]); v.y = silu_f(P.c[DM + k]); v.z = silu_f(P.c[2 * DM + k]); v.w = silu_f(P.c[3 * DM + k]); condT[k] = v; }
            __syncthreads(); }
        const int l = item / 48, n0 = (item % 48) * 128, cq = tid & 31, kp = tid >> 5;
        f32x4 a0 = {0.f, 0.f, 0.f, 0.f}, a1 = a0, a2 = a0, a3 = a0;
        const float* wp = P.mod_w + ((size_t)l * DM + kp * 128) * 6144 + n0 + 4 * cq;
#pragma unroll 8
        for (int k = 0; k < 128; ++k) { const f32x4 w = *(const f32x4*)(wp + (size_t)k * 6144); const f32x4 cv = condT[kp * 128 + k];
            a0 += w * cv.x; a1 += w * cv.y; a2 += w * cv.z; a3 += w * cv.w; }
        *(f32x4*)(red + (kp * 4 + 0) * 128 + 4 * cq) = a0; *(f32x4*)(red + (kp * 4 + 1) * 128 + 4 * cq) = a1;
        *(f32x4*)(red + (kp * 4 + 2) * 128 + 4 * cq) = a2; *(f32x4*)(red + (kp * 4 + 3) * 128 + 4 * cq) = a3;
        __syncthreads();
        { const int b = tid >> 7, col = tid & 127; float s = P.mod_b[l * 6144 + n0 + col];
#pragma unroll
            for (int q = 0; q < 16; ++q) s += red[(q * 4 + b) * 128 + col];
            MOD[(l * 4 + b) * 6144 + n0 + col] = s; }
        __syncthreads();
    }
}
__device__ __forceinline__ void p0_transpose_item(const float* W, int ldn, int ncol0, int nblk, bf16_t* WT, unsigned char* scr, int item, int lane) {
    const int kb = item / nblk, nb = item - kb * nblk, k0 = kb * 64, n0 = nb * 64;
    const float* src = W + (size_t)(k0 + (lane >> 4)) * ldn + ncol0 + n0 + 4 * (lane & 15);
#pragma unroll 4
    for (int i = 0; i < 16; ++i) { const f32x4 v = *(const f32x4*)(src + (size_t)(4 * i) * ldn);
        unsigned* d = (unsigned*)(scr + (4 * i + (lane >> 4)) * 132 + 8 * (lane & 15));
        d[0] = cvt_pk_bf16(v.x, v.y); d[1] = cvt_pk_bf16(v.z, v.w); }
    LDS_WAIT();
    const int c = lane & 7;
#pragma unroll
    for (int j = 0; j < 8; ++j) { const int n = (lane >> 3) + 8 * j; const unsigned short* s = (const unsigned short*)(scr + (8 * c) * 132 + 2 * n);
        u32x4 o;
        o.x = (unsigned)s[0 * 66] | ((unsigned)s[1 * 66] << 16); o.y = (unsigned)s[2 * 66] | ((unsigned)s[3 * 66] << 16);
        o.z = (unsigned)s[4 * 66] | ((unsigned)s[5 * 66] << 16); o.w = (unsigned)s[6 * 66] | ((unsigned)s[7 * 66] << 16);
        *(u32x4*)(WT + (size_t)(n0 + n) * DM + k0 + 8 * c) = o; }
    LDS_WAIT();
}
__device__ __forceinline__ void p0_panel_i8(const float* W, int ldn, int n0, signed char* WT, float* cs, unsigned char* lds, int tid) {
    const int lane = tid & 63, wave = __builtin_amdgcn_readfirstlane(tid >> 6);
    float* maxbuf = (float*)(lds + 131072);
    f32x4 mx = {0.f, 0.f, 0.f, 0.f};
    { const float* src = W + (size_t)(wave * 256 + (lane >> 3)) * ldn + n0 + 4 * (lane & 7);
      unsigned char* dst = lds + (size_t)(wave * 256 + (lane >> 3)) * 64 + 8 * (lane & 7);
#pragma unroll 8
      for (int i = 0; i < 32; ++i) { const f32x4 v = *(const f32x4*)(src + (size_t)(8 * i) * ldn);
          mx.x = fmaxf(mx.x, fabsf(v.x)); mx.y = fmaxf(mx.y, fabsf(v.y)); mx.z = fmaxf(mx.z, fabsf(v.z)); mx.w = fmaxf(mx.w, fabsf(v.w));
          u32x2 w; w.x = cvt_pk_bf16(v.x, v.y); w.y = cvt_pk_bf16(v.z, v.w); *(u32x2*)(dst + (size_t)(8 * i) * 64) = w; } }
#pragma unroll
    for (int o = 8; o < 64; o <<= 1) { mx.x = fmaxf(mx.x, __shfl_xor(mx.x, o)); mx.y = fmaxf(mx.y, __shfl_xor(mx.y, o)); mx.z = fmaxf(mx.z, __shfl_xor(mx.z, o)); mx.w = fmaxf(mx.w, __shfl_xor(mx.w, o)); }
    if (lane < 8) *(f32x4*)(maxbuf + wave * 32 + 4 * lane) = mx;
    __syncthreads();
    { const int n = tid & 31, kc = tid >> 5;
      float cm = maxbuf[n];
#pragma unroll
      for (int w = 1; w < 8; ++w) cm = fmaxf(cm, maxbuf[w * 32 + n]);
      const float inv = cm > 0.f ? 127.f / cm : 0.f;
      if (kc == 0) cs[n0 + n] = cm > 0.f ? cm * (1.f / 127.f) : 1.f;
      const unsigned short* t = (const unsigned short*)lds + (size_t)(kc * 128) * 32 + n;
      signed char* orow = WT + (size_t)(n0 + n) * DM + kc * 128;
#pragma unroll 2
      for (int i = 0; i < 8; ++i) { unsigned w[4];
#pragma unroll
          for (int q = 0; q < 4; ++q) { unsigned acc = 0;
#pragma unroll
              for (int e = 0; e < 4; ++e) { const float v = bf2f(t[(size_t)(16 * i + 4 * q + e) * 32]) * inv; int iv = (int)rintf(v); iv = iv > 127 ? 127 : (iv < -127 ? -127 : iv); acc |= ((unsigned)iv & 0xffu) << (8 * e); }
              w[q] = acc; }
          *(u32x4*)(orow + 16 * i) = (u32x4){w[0], w[1], w[2], w[3]}; } }
    __syncthreads();
}
__device__ __forceinline__ void p0_weights(unsigned char* lds, int wv) {
    CParams& P = PP();
    const int tid_ = otid(wv); const int lane = tid_ & 63, wave = __builtin_amdgcn_readfirstlane(tid_ >> 6);
    constexpr int PA = A_N / 32, PB = 4096 / 32, NPANEL = 2 * PA + 2 * PB;
    for (int it = obid(); it < NPANEL; it += gridDim.x) {
        if (it < 2 * PA) { const int j = it / PA, pnl = it - j * PA;
            p0_panel_i8(P.a_w_in + (size_t)j * DM * A_N, A_N, pnl * 32, (signed char*)(P.ws + WS_WAIN) + (size_t)j * A_N * DM, (float*)(P.ws + WS_CSA) + j * A_N, lds, tid_); }
        else { const int r = it - 2 * PA, j = r / PB, pnl = r - j * PB;
            p0_panel_i8(P.b_w_in + (size_t)j * DM * B_N + 4096, B_N, pnl * 32, (signed char*)(P.ws + WS_WBVZ) + (size_t)j * 4096 * DM, (float*)(P.ws + WS_CSB) + j * 4096, lds, tid_); }
    }
    unsigned char* scr = lds + 65536 + wave * 8448;
    const int gw = obid() * 8 + wave, NGW = gridDim.x * 8;
    constexpr int I_B = 32 * 64, I_O = 32 * 32, TOTAL = 2 * I_B + 4 * I_O;
    for (int it = gw; it < TOTAL; it += NGW) {
        int r = it;
        if (r < 2 * I_B) { const int j = r / I_B; p0_transpose_item(P.b_w_in + (size_t)j * DM * B_N, B_N, 0, 64, (bf16_t*)(P.ws + WS_WBQK) + (size_t)j * 4096 * DM, scr, r - j * I_B, lane); continue; } r -= 2 * I_B;
        if (r < 2 * I_O) { const int j = r / I_O; p0_transpose_item(P.a_w_out + (size_t)j * DM * DM, DM, 0, 32, (bf16_t*)(P.ws + WS_WAOUT) + (size_t)j * DM * DM, scr, r - j * I_O, lane); continue; } r -= 2 * I_O;
        { const int j = r / I_O; p0_transpose_item(P.b_w_out + (size_t)j * DM * DM, DM, 0, 32, (bf16_t*)(P.ws + WS_WBOUT) + (size_t)j * DM * DM, scr, r - j * I_O, lane); }
    }
}

__device__ __forceinline__ void norm_phase(int layer, bool want_bf16, int wv) {
    CParams& P = PP(); const float* xin = layer == 0 ? P.x : P.out;
    const int tid_ = otid(wv); const int lane = tid_ & 63, wave = __builtin_amdgcn_readfirstlane(tid_ >> 6);
    const int gw = obid() * 8 + wave, NGW = gridDim.x * 8;
    const float* MOD = (const float*)(P.ws + WS_MOD);
    bf16_t* Hb = (bf16_t*)(P.ws + WS_H); unsigned char* Hq = P.ws + WS_HQ; float* RS = (float*)(P.ws + WS_RS);
    for (int r0 = gw * 4; r0 < MTOK; r0 += NGW * 4) {
        const int b = r0 >> 11;
        const float* shift = MOD + (size_t)(layer * 4 + b) * 6144; const float* scale = shift + DM; const float* nw = P.norm_w + layer * DM;
        f32x4 ca[8], cs[8];
#pragma unroll
        for (int j = 0; j < 8; ++j) { const int c = 4 * lane + 256 * j; const f32x4 w = *(const f32x4*)(nw + c), s = *(const f32x4*)(scale + c); ca[j] = w * (s + 1.f); cs[j] = *(const f32x4*)(shift + c); }
        for (int rr = 0; rr < 4; ++rr) {
            const float* xr = xin + (size_t)(r0 + rr) * DM; f32x4 v[8]; float ss = 0.f;
#pragma unroll
            for (int j = 0; j < 8; ++j) { v[j] = *(const f32x4*)(xr + 4 * lane + 256 * j); ss += (v[j].x * v[j].x + v[j].y * v[j].y) + (v[j].z * v[j].z + v[j].w * v[j].w); }
            const float rs = 1.0f / sqrtf(wave_sum(ss) * (1.f / DM) + EPS);
            float am = 0.f;
#pragma unroll
            for (int j = 0; j < 8; ++j) { v[j] = v[j] * rs * ca[j] + cs[j]; am = fmaxf(am, fmaxf(fmaxf(fabsf(v[j].x), fabsf(v[j].y)), fmaxf(fabsf(v[j].z), fabsf(v[j].w)))); }
            am = wave_max(am);
            const float inv = am > 0.f ? 127.f / am : 0.f;
            if (lane == 0) RS[r0 + rr] = am > 0.f ? am * (1.f / 127.f) : 1.f;
            unsigned char* qr = Hq + (size_t)(r0 + rr) * DM;
#pragma unroll
            for (int j = 0; j < 8; ++j) { const f32x4 h = v[j] * inv;
                const int i0 = (int)rintf(h.x), i1 = (int)rintf(h.y), i2 = (int)rintf(h.z), i3 = (int)rintf(h.w);
                *(unsigned*)(qr + 4 * lane + 256 * j) = ((unsigned)i0 & 0xffu) | (((unsigned)i1 & 0xffu) << 8) | (((unsigned)i2 & 0xffu) << 16) | (((unsigned)i3 & 0xffu) << 24); }
            if (want_bf16) { bf16_t* hr = Hb + (size_t)(r0 + rr) * DM;
#pragma unroll
                for (int j = 0; j < 8; ++j) { u32x2 w; w.x = cvt_pk_bf16(v[j].x, v[j].y); w.y = cvt_pk_bf16(v[j].z, v[j].w); *(u32x2*)(hr + 4 * lane + 256 * j) = w; } }
        }
    }
}
__device__ __forceinline__ void final_norm_phase(int wv) {
    CParams& P = PP();
    const int tid_ = otid(wv); const int lane = tid_ & 63, wave = __builtin_amdgcn_readfirstlane(tid_ >> 6);
    const int gw = obid() * 8 + wave, NGW = gridDim.x * 8;
    f32x4 cw[8];
#pragma unroll
    for (int j = 0; j < 8; ++j) cw[j] = *(const f32x4*)(P.final_w + 4 * lane + 256 * j);
    for (int r = gw; r < MTOK; r += NGW) {
        float* xr = P.out + (size_t)r * DM; f32x4 v[8]; float ss = 0.f;
#pragma unroll
        for (int j = 0; j < 8; ++j) { v[j] = *(const f32x4*)(xr + 4 * lane + 256 * j); ss += (v[j].x * v[j].x + v[j].y * v[j].y) + (v[j].z * v[j].z + v[j].w * v[j].w); }
        const float rs = 1.0f / sqrtf(wave_sum(ss) * (1.f / DM) + EPS);
#pragma unroll
        for (int j = 0; j < 8; ++j) *(f32x4*)(xr + 4 * lane + 256 * j) = v[j] * rs * cw[j];
    }
}

__device__ __forceinline__ void naive_attend(const bf16_t* Kh, const bf16_t* Vh, const float* qf, float* sc, int own_start, int own_len, int blkbase, int mask, int qpos, float slopeL, int lane,
                                             float& o0, float& o1, float& lse2) {
    int base = 0; float mx = -3.0e38f;
    { int m2 = mask;
      for (int rr = 0;; ++rr) { int start, len;
        if (rr == 0) { start = own_start; len = own_len; } else { if (!m2) break; const int j = __builtin_ctz(m2); m2 &= m2 - 1; start = blkbase + (j << 8); len = 256; }
        for (int i = lane; i < len; i += 64) { const int key = start + i; const u32x4* kp = (const u32x4*)(Kh + (size_t)key * DM); float dot = 0.f;
#pragma unroll 4
            for (int cch = 0; cch < 16; ++cch) { const u32x4 w = kp[cch]; const float* q = qf + cch * 8;
                dot += q[0] * bflo(w.x) + q[1] * bfhi(w.x) + q[2] * bflo(w.y) + q[3] * bfhi(w.y) + q[4] * bflo(w.z) + q[5] * bfhi(w.z) + q[6] * bflo(w.w) + q[7] * bfhi(w.w); }
            const float s = dot + slopeL * (float)(key - qpos); sc[base + i] = s; mx = fmaxf(mx, s); }
        base += len; } }
    const int tot = base; mx = wave_max(mx);
    LDS_WAIT();
    float sum = 0.f;
    for (int i = lane; i < tot; i += 64) { const float p = exp2f(sc[i] - mx); sc[i] = p; sum += p; }
    sum = wave_sum(sum);
    LDS_WAIT();
    float a0 = 0.f, a1 = 0.f; base = 0;
    { int m2 = mask;
      for (int rr = 0;; ++rr) { int start, len;
        if (rr == 0) { start = own_start; len = own_len; } else { if (!m2) break; const int j = __builtin_ctz(m2); m2 &= m2 - 1; start = blkbase + (j << 8); len = 256; }
        const bf16_t* vp = Vh + (size_t)start * DM + 2 * lane;
        for (int i = 0; i < len; ++i) { const float p = sc[base + i]; const unsigned w = *(const unsigned*)(vp + (size_t)i * DM); a0 += p * bflo(w); a1 += p * bfhi(w); }
        base += len; } }
    LDS_WAIT();
    const float inv = 1.f / sum; o0 = a0 * inv; o1 = a1 * inv; lse2 = mx + log2f(sum);
}
__device__ __forceinline__ float slope_of(int h) { return exp2f(-0.5f * (float)(h + 1)); }

__device__ __forceinline__ void attn_a_naive(unsigned char* lds, int wv) {
    CParams& P = PP();
    const int tid_ = otid(wv); const int lane = tid_ & 63, wave = __builtin_amdgcn_readfirstlane(tid_ >> 6);
    float* qf = (float*)(lds + wave * 8192); float* sc = qf + 128;
    const bf16_t* QKV = (const bf16_t*)(P.ws + WS_QKV); bf16_t* OG = (bf16_t*)(P.ws + WS_OG); float* LSE = (float*)(P.ws + WS_LSE);
    const int gw = obid() * 8 + wave, NGW = gridDim.x * 8;
    for (int it = gw; it < 3 * MTOK * NH; it += NGW) {
        const int h = it & 15, R = (it >> 4) & (MTOK - 1), g = it >> 17;
        const int lg = 2 * g, L = SEQ >> lg;
        const bf16_t* Qp = QKV + (size_t)(3 * g) * PART + (size_t)R * DM + h * HD;
        { const unsigned w = *(const unsigned*)(Qp + 2 * lane); qf[2 * lane] = bflo(w); qf[2 * lane + 1] = bfhi(w); }
        LDS_WAIT();
        const int seq0 = R & ~(L - 1); int lo = R - 128; if (lo < seq0) lo = seq0;
        float o0, o1, lse2;
        naive_attend(QKV + (size_t)(3 * g + 1) * PART + h * HD, QKV + (size_t)(3 * g + 2) * PART + h * HD, qf, sc, lo, R - lo + 1, 0, 0, R, slope_of(h) * (float)(1 << lg) * LOG2E, lane, o0, o1, lse2);
        *(unsigned*)(OG + (size_t)g * PART + (size_t)R * DM + h * HD + 2 * lane) = cvt_pk_bf16(o0, o1);
        if (lane == 0) LSE[((size_t)g * MTOK + R) * NH + h] = lse2;
    }
}
__device__ __forceinline__ void combine_phase(int wv) {
    CParams& P = PP();
    const int tid_ = otid(wv); const int lane = tid_ & 63, wave = __builtin_amdgcn_readfirstlane(tid_ >> 6);
    const int gw = obid() * 8 + wave, NGW = gridDim.x * 8;
    const bf16_t* OG = (const bf16_t*)(P.ws + WS_OG); const float* LSE = (const float*)(P.ws + WS_LSE); const bf16_t* Z = (const bf16_t*)(P.ws + WS_Z); bf16_t* G = (bf16_t*)(P.ws + WS_G);
    for (int m = gw; m < MTOK; m += NGW) {
        const int b = m >> 11, t = m & 2047;
        const int R0 = m, R1 = (b << 11) + ((t & 3) << 9) + (t >> 2), R2 = (b << 11) + ((t & 15) << 7) + (t >> 4);
#pragma unroll
        for (int j = 0; j < 4; ++j) { const int col = 8 * lane + 512 * j, h = col >> 7;
            const float l0 = LSE[((size_t)0 * MTOK + R0) * NH + h], l1 = LSE[((size_t)1 * MTOK + R1) * NH + h], l2 = LSE[((size_t)2 * MTOK + R2) * NH + h];
            const float mx = fmaxf(l0, fmaxf(l1, l2)); float e0 = exp2f(l0 - mx), e1 = exp2f(l1 - mx), e2 = exp2f(l2 - mx); const float inv = 1.f / (e0 + e1 + e2); e0 *= inv; e1 *= inv; e2 *= inv;
            const u32x4 a = *(const u32x4*)(OG + (size_t)R0 * DM + col), bb = *(const u32x4*)(OG + PART + (size_t)R1 * DM + col), cc = *(const u32x4*)(OG + 2 * PART + (size_t)R2 * DM + col);
            const u32x4 zz = *(const u32x4*)(Z + (size_t)m * DM + col);
            u32x4 o;
#define CMB(F) { const float v0 = (e0 * bflo(a.F) + e1 * bflo(bb.F) + e2 * bflo(cc.F)) * silu_f(bflo(zz.F)); const float v1 = (e0 * bfhi(a.F) + e1 * bfhi(bb.F) + e2 * bfhi(cc.F)) * silu_f(bfhi(zz.F)); o.F = cvt_pk_bf16(v0, v1); }
            CMB(x) CMB(y) CMB(z) CMB(w)
#undef CMB
            *(u32x4*)(G + (size_t)m * DM + col) = o; }
    }
}
__device__ __forceinline__ void attn_b_naive(unsigned char* lds, int wv) {
    CParams& P = PP();
    const int tid_ = otid(wv); const int lane = tid_ & 63, wave = __builtin_amdgcn_readfirstlane(tid_ >> 6);
    float* qf = (float*)(lds + wave * 8192); float* sc = qf + 128;
    const bf16_t* QKV = (const bf16_t*)(P.ws + WS_QKV); const bf16_t* Z = (const bf16_t*)(P.ws + WS_Z); bf16_t* G = (bf16_t*)(P.ws + WS_G); const float* KS = (const float*)(P.ws + WS_KSUM);
    const int gw = obid() * 8 + wave, NGW = gridDim.x * 8;
    for (int it = gw; it < MTOK * NH; it += NGW) {
        const int h = it & 15, m = it >> 4, b = m >> 11, t = m & 2047, n = t >> 8;
        const bf16_t* Qp = QKV + (size_t)m * DM + h * HD;
        float q0, q1; { const unsigned w = *(const unsigned*)(Qp + 2 * lane); q0 = bflo(w); q1 = bfhi(w); qf[2 * lane] = q0; qf[2 * lane + 1] = q1; }
        LDS_WAIT();
        float gt[8];
#pragma unroll
        for (int j = 0; j < 8; ++j) { float v = 0.f;
            if (j < n) { const float* k0 = KS + (size_t)(b * 8 + j) * DM + h * HD + 2 * lane; const float* k1 = k0 + (size_t)32 * DM; v = q0 * (k0[0] + k1[0]) + q1 * (k0[1] + k1[1]); }
            gt[j] = wave_sum(v); }
        int mask = 0;
#pragma unroll
        for (int j = 0; j < 8; ++j) { if (j < n) { int rank = 0;
#pragma unroll
                for (int j2 = 0; j2 < 8; ++j2) if (j2 < n && (gt[j2] > gt[j] || (gt[j2] == gt[j] && j2 < j))) ++rank;
                if (rank < 3) mask |= 1 << j; } }
        float o0, o1, lse2;
        naive_attend(QKV + PART + h * HD, QKV + 2 * PART + h * HD, qf, sc, (b << 11) + (n << 8), (t & 255) + 1, b << 11, mask, m, slope_of(h) * LOG2E, lane, o0, o1, lse2);
        const unsigned zw = *(const unsigned*)(Z + (size_t)m * DM + h * HD + 2 * lane);
        *(unsigned*)(G + (size_t)m * DM + h * HD + 2 * lane) = cvt_pk_bf16(o0 * silu_f(bflo(zw)), o1 * silu_f(bfhi(zw)));
    }
}

namespace fa {
constexpr int KVBLK = 64, SHM_K = KVBLK * HD * 2, SHM_V = KVBLK * HD * 2;
constexpr int OFF_V = 0, OFF_K = 2 * SHM_V, OFF_WS = OFF_K + 2 * SHM_K, OFF_OST = OFF_WS + 8 * 256, OST_ROW = 272, OST_WAVE = 32 * OST_ROW;
constexpr int OFF_GK = OFF_OST + 8 * OST_WAVE, OFF_SEL = OFF_GK + 7 * 128 * 4, OFF_END = OFF_SEL + 256 * 4;
static_assert(OFF_END <= LDS_BYTES - 1024, "attention LDS map");
constexpr float THR = 11.5f;
#define KSWZ(row, colB) ((row) * 256 + ((colB) ^ (((row) & 7) << 4)))
#define SBAR() __builtin_amdgcn_sched_barrier(0)
__device__ __forceinline__ int v_st(int k, int c) { const int kk = (k & ~0xC) | ((k & 4) << 1) | ((k & 8) >> 1); return ((kk >> 3) * 4 + (c >> 5)) * 512 + ((kk & 7) * 32 + (c & 31)) * 2; }
__device__ __forceinline__ int v_rd_base(int lane) { return ((lane & 3) << 3) | (((lane >> 2) & 3) << 6) | (((lane >> 4) & 1) << 5) | (((lane >> 5) & 1) << 8); }
constexpr int v_rd_off(int d0, int ks, int half) { return d0 * 512 + ks * 4096 + half * 2048; }
__device__ __forceinline__ int crow(int r, int hi) { return (r & 3) + 8 * (r >> 2) + 4 * hi; }
__device__ __forceinline__ void mask_tile(f32x16& p0, f32x16& p1, int dq, unsigned W) {
    const float NEG = -__builtin_inff();
#pragma unroll
    for (int r = 0; r < 16; ++r) { const int c = (r & 3) + 8 * (r >> 2);
        if ((unsigned)(dq - c) >= W) p0[r] = NEG;
        if ((unsigned)(dq - c - 32) >= W) p1[r] = NEG; }
}
__device__ __forceinline__ void partialSM(f32x16& p0, f32x16& p1, float& m_reg, float& alpha) {
    float pmax = p0[0];
#pragma unroll
    for (int r = 1; r < 16; ++r) pmax = fmaxf(pmax, p0[r]);
#pragma unroll
    for (int r = 0; r < 16; ++r) pmax = fmaxf(pmax, p1[r]);
    { auto rr = __builtin_amdgcn_permlane32_swap(__float_as_uint(pmax), __float_as_uint(pmax), false, false); pmax = fmaxf(__uint_as_float(rr[0]), __uint_as_float(rr[1])); }
    float mn;
    if (__builtin_expect(__all(pmax - m_reg <= THR), 1)) { mn = m_reg; alpha = 1.f; }
    else { mn = fmaxf(m_reg, pmax); alpha = __builtin_amdgcn_exp2f(m_reg - mn); m_reg = mn; }
#pragma unroll
    for (int r = 0; r < 16; ++r) p0[r] = __builtin_amdgcn_exp2f(p0[r] - mn);
#pragma unroll
    for (int r = 0; r < 16; ++r) p1[r] = __builtin_amdgcn_exp2f(p1[r] - mn);
}
__device__ __forceinline__ void finishSM(f32x16& p0, f32x16& p1, float alpha, float& l_reg, bf16x8& pa0, bf16x8& pa1, bf16x8& pa2, bf16x8& pa3) {
    float ps = 0;
#pragma unroll
    for (int r = 0; r < 16; ++r) ps += p0[r];
#pragma unroll
    for (int r = 0; r < 16; ++r) ps += p1[r];
    { auto rr = __builtin_amdgcn_permlane32_swap(__float_as_uint(ps), __float_as_uint(ps), false, false); ps = __uint_as_float(rr[0]) + __uint_as_float(rr[1]); }
    l_reg = l_reg * alpha + ps;
#define PK4(P, B_, OUT) do { unsigned a0 = cvt_pk_bf16(P[B_+0], P[B_+1]), a1 = cvt_pk_bf16(P[B_+2], P[B_+3]);                          \
        unsigned b0 = cvt_pk_bf16(P[B_+4], P[B_+5]), b1 = cvt_pk_bf16(P[B_+6], P[B_+7]);                                             \
        auto r0 = __builtin_amdgcn_permlane32_swap(a0, b0, false, false); auto r1 = __builtin_amdgcn_permlane32_swap(a1, b1, false, false); \
        u32x4 w = {r0[0], r1[0], r0[1], r1[1]}; OUT = *reinterpret_cast<bf16x8*>(&w); } while (0)
    PK4(p0, 0, pa0); PK4(p0, 8, pa1); PK4(p1, 0, pa2); PK4(p1, 8, pa3);
#undef PK4
}
template <int KB>
__device__ __forceinline__ void qkt(f32x16& p0, f32x16& p1, const LAS char* K_lds, int r32, int hi, const bf16x8* qr) {
    const LAS char* kb[4];
#pragma unroll
    for (int dd = 0; dd < 4; ++dd) kb[dd] = K_lds + KB * SHM_K + KSWZ(r32, (dd * 16 + hi * 8) * 2);
#pragma unroll
    for (int d0 = 0; d0 < 8; ++d0) { const LAS char* a = kb[d0 & 3] + (d0 >> 2) * 128;
        const bf16x8 b0 = *reinterpret_cast<const LAS bf16x8*>(a);
        const bf16x8 b1 = *reinterpret_cast<const LAS bf16x8*>(a + 32 * 256);
        p0 = __builtin_amdgcn_mfma_f32_32x32x16_bf16(b0, qr[d0], p0, 0, 0, 0);
        p1 = __builtin_amdgcn_mfma_f32_32x32x16_bf16(b1, qr[d0], p1, 0, 0, 0); }
}
template <int VB>
__device__ __forceinline__ void pv_tile(f32x16* o, int vb0, bf16x8 pa0, bf16x8 pa1, bf16x8 pa2, bf16x8 pa3) {
#define TRRD(dst, off) asm volatile("ds_read_b64_tr_b16 %0, %1 offset:%2" : "=&v"(dst) : "v"(vb0), "i"(off) : "memory")
#define PV_D0(d0) do { s16x4 l0, l1, l2, l3, h0, h1, h2, h3; constexpr int b_ = VB * SHM_V + v_rd_off(d0, 0, 0); \
        TRRD(l0, b_); TRRD(h0, b_ + 2048); TRRD(l1, b_ + 4096); TRRD(h1, b_ + 6144); TRRD(l2, b_ + 8192); TRRD(h2, b_ + 10240); TRRD(l3, b_ + 12288); TRRD(h3, b_ + 14336); \
        asm volatile("s_waitcnt lgkmcnt(0)" ::: "memory"); SBAR();   \
        o[d0] = __builtin_amdgcn_mfma_f32_32x32x16_bf16(pa0, (bf16x8){l0[0], l0[1], l0[2], l0[3], h0[0], h0[1], h0[2], h0[3]}, o[d0], 0, 0, 0);   \
        o[d0] = __builtin_amdgcn_mfma_f32_32x32x16_bf16(pa1, (bf16x8){l1[0], l1[1], l1[2], l1[3], h1[0], h1[1], h1[2], h1[3]}, o[d0], 0, 0, 0);   \
        o[d0] = __builtin_amdgcn_mfma_f32_32x32x16_bf16(pa2, (bf16x8){l2[0], l2[1], l2[2], l2[3], h2[0], h2[1], h2[2], h2[3]}, o[d0], 0, 0, 0);   \
        o[d0] = __builtin_amdgcn_mfma_f32_32x32x16_bf16(pa3, (bf16x8){l3[0], l3[1], l3[2], l3[3], h3[0], h3[1], h3[2], h3[3]}, o[d0], 0, 0, 0); } while (0)
    PV_D0(0); PV_D0(1); PV_D0(2); PV_D0(3);
#undef PV_D0
#undef TRRD
}

template <int MODE, class MK>
__device__ __forceinline__ void flash_block(const bf16_t* Q, const bf16_t* K, const bf16_t* V, int krow0, int NT, int qrow0, float slopeL, const MK& mk,
                                            unsigned char* lds, bf16_t* Og, float* Lse, const bf16_t* Zg, int tid) {
    const int wid = __builtin_amdgcn_readfirstlane(tid >> 6), lane = tid & 63, r32 = lane & 31, hi = lane >> 5;
    const LAS char* K_lds = (const LAS char*)(LAS unsigned char*)lds + OFF_K;
    LAS char* Kw = (LAS char*)(LAS unsigned char*)lds + OFF_K; LAS char* Vw = (LAS char*)(LAS unsigned char*)lds + OFF_V;
    LAS float* wsf = (LAS float*)((LAS unsigned char*)lds + OFF_WS) + wid * 64; LAS float* li_l = wsf; LAS float* al_l = wsf + 32;
    const int sr = tid >> 4, sc = (tid & 15) * 8, vst0 = v_st(sr, sc), vst1 = v_st(32 + sr, sc), kws = KSWZ(sr, sc * 2);
    const int vb0 = (int)(unsigned)(uintptr_t)((LAS unsigned char*)lds) + OFF_V + v_rd_base(lane);
    const int qlo = qrow0 + wid * 32, qm = qlo + r32 - 4 * hi;
    bf16x8 st_k0, st_k1, st_v0, st_v1;
#define SLOAD(kb_) do { const size_t o0_ = (size_t)((kb_) + sr) * DM + sc, o1_ = o0_ + (size_t)32 * DM; \
        st_v0 = *(const bf16x8*)(V + o0_); st_v1 = *(const bf16x8*)(V + o1_); st_k0 = *(const bf16x8*)(K + o0_); st_k1 = *(const bf16x8*)(K + o1_); } while (0)
#define SWRITE(bf) do { *(LAS bf16x8*)(Vw + (bf) * SHM_V + vst0) = st_v0; *(LAS bf16x8*)(Vw + (bf) * SHM_V + vst1) = st_v1; \
        *(LAS bf16x8*)(Kw + (bf) * SHM_K + kws) = st_k0; *(LAS bf16x8*)(Kw + (bf) * SHM_K + kws + 32 * 256) = st_k1; } while (0)
    bf16x8 qr[8];
#pragma unroll
    for (int d0 = 0; d0 < 8; ++d0) qr[d0] = *(const bf16x8*)(Q + (size_t)(wid * 32 + r32) * DM + d0 * 16 + hi * 8);
    SLOAD(krow0); asm volatile("s_waitcnt vmcnt(0)" ::: "memory"); SWRITE(0);
    __syncthreads();
    float m_reg = -1e30f, l_reg = 0.f; f32x16 o[4] = {};
#define STEP(t, KB) do { const int kb_ = krow0 + (t) * KVBLK;                                                                   \
        if ((t) + 1 < NT) SLOAD(kb_ + KVBLK);                                                                                     \
        bool act_, need_; unsigned W_; mk.info(kb_, qlo, r32, act_, need_, W_);                                                 \
        if (act_) { f32x16 p0, p1; const float a0_ = slopeL * (float)(kb_ - qm);                                                  \
            _Pragma("unroll") for (int r = 0; r < 16; ++r) { p0[r] = fmaf(slopeL, (float)((r & 3) + 8 * (r >> 2)), a0_); p1[r] = p0[r] + 32.f * slopeL; } \
            qkt<KB>(p0, p1, K_lds, r32, hi, qr);                                                                                  \
            if (need_) mask_tile(p0, p1, qm - kb_, W_);                                                                           \
            float alpha_; partialSM(p0, p1, m_reg, alpha_);                                                                       \
            bf16x8 pa0, pa1, pa2, pa3; finishSM(p0, p1, alpha_, l_reg, pa0, pa1, pa2, pa3);                                       \
            if (__any(alpha_ < 1.f)) { if (hi == 0) al_l[r32] = alpha_; LDS_WAIT();                                               \
                _Pragma("unroll") for (int d_ = 0; d_ < 4; ++d_) _Pragma("unroll") for (int r = 0; r < 16; ++r) o[d_][r] *= al_l[crow(r, hi)]; } \
            SBAR(); pv_tile<KB>(o, vb0, pa0, pa1, pa2, pa3); }                                                                    \
        if ((t) + 1 < NT) { asm volatile("s_waitcnt vmcnt(0)" ::: "memory"); SWRITE((KB) ^ 1); }                               \
        __syncthreads(); } while (0)
    for (int t = 0; t < NT; t += 2) { STEP(t, 0); STEP(t + 1, 1); }
#undef STEP
#undef SLOAD
#undef SWRITE
    if (hi == 0) li_l[r32] = l_reg;
    LDS_WAIT();
    LAS unsigned char* stg = (LAS unsigned char*)lds + OFF_OST + wid * OST_WAVE;
#pragma unroll
    for (int r = 0; r < 16; ++r) { const int orow = crow(r, hi); const float rl = __builtin_amdgcn_rcpf(li_l[orow]);
#pragma unroll
        for (int d0 = 0; d0 < 4; ++d0) *(LAS unsigned short*)(stg + orow * OST_ROW + (d0 * 32 + r32) * 2) = (unsigned short)(cvt_pk_bf16(o[d0][r] * rl, 0.f) & 0xffffu); }
    LDS_WAIT();
    if (MODE == 0) { if (hi == 0) Lse[(size_t)(qlo + r32) * NH] = m_reg + log2f(l_reg); }
#pragma unroll
    for (int i = 0; i < 8; ++i) { const int row = i * 4 + (lane >> 4), ch = lane & 15;
        u32x4 v = *(const LAS u32x4*)(stg + row * OST_ROW + ch * 16);
        const size_t go = (size_t)(qlo + row) * DM + ch * 8;
        if (MODE == 1) { const u32x4 z = *(const u32x4*)(Zg + go);
            v.x = cvt_pk_bf16(bflo(v.x) * silu_f(bflo(z.x)), bfhi(v.x) * silu_f(bfhi(z.x))); v.y = cvt_pk_bf16(bflo(v.y) * silu_f(bflo(z.y)), bfhi(v.y) * silu_f(bfhi(z.y)));
            v.z = cvt_pk_bf16(bflo(v.z) * silu_f(bflo(z.z)), bfhi(v.z) * silu_f(bfhi(z.z))); v.w = cvt_pk_bf16(bflo(v.w) * silu_f(bflo(z.w)), bfhi(v.w) * silu_f(bfhi(z.w))); }
        *(u32x4*)(Og + go) = v; }
    LDS_WAIT();
}
struct MaskA {
    int L;
    __device__ __forceinline__ void info(int kb, int qlo, int r32, bool& act, bool& need, unsigned& W) const {
        const int seq0 = qlo & ~(L - 1); int lowk = qlo - 128; if (lowk < seq0) lowk = seq0;
        act = (kb <= qlo + 31) && (kb + KVBLK - 1 >= lowk); need = true;
        const int wl = qlo + r32 - seq0 + 1; W = (unsigned)(wl < 129 ? wl : 129);
    }
};
struct MaskB {
    int own0, base0; unsigned sel;
    __device__ __forceinline__ void info(int kb, int qlo, int r32, bool& act, bool& need, unsigned& W) const {
        if (kb >= own0) { act = kb <= qlo + 31; need = kb + KVBLK - 1 > qlo; W = 0x40000000u; }
        else { const int blk = (kb - base0) >> 8; const bool s = (sel >> blk) & 1u; const unsigned long long bal = __ballot(s);
            act = bal != 0ull; need = bal != ~0ull; W = s ? 0x40000000u : 0u; }
    }
};
#undef KSWZ
#undef SBAR
}

namespace fb {
using namespace fa;
#define KSWZ(row, colB) ((row) * 256 + ((colB) ^ (((row) & 7) << 4)))
#define SBAR() __builtin_amdgcn_sched_barrier(0)
struct Blk {
    unsigned qoff, koff, voff;
    unsigned ooff, xoff;
    int R0, kb0, NT;
    float slopeL;
    int L, base0;
};
struct Nxt { unsigned qoff, koff, voff; int kb0; };
struct Seam { bf16x8 qr[8]; bf16x8 st_v0, st_v1, st_k0, st_k1; };
__device__ __forceinline__ void tile_info(const Blk& c, int kb, int qlo, int r32, unsigned sel, bool& act, bool& need, unsigned& W) {
    if (c.L > 0) { const int seq0 = qlo & ~(c.L - 1); int lowk = qlo - 128; if (lowk < seq0) lowk = seq0;
        act = (kb <= qlo + 31) && (kb + KVBLK - 1 >= lowk); need = true; const int wl = qlo + r32 - seq0 + 1; W = (unsigned)(wl < 129 ? wl : 129); }
    else if (kb >= c.R0) { act = kb <= qlo + 31; need = kb + KVBLK - 1 > qlo; W = 0x40000000u; }
    else { const int blk = (kb - c.base0) >> 8; const bool sb = (sel >> blk) & 1u; const unsigned long long bal = __ballot(sb);
        act = bal != 0ull; need = bal != ~0ull; W = sb ? 0x40000000u : 0u; }
}
template <int KB>
__device__ __forceinline__ void qkt2(f32x16& p0, f32x16& p1, const LAS char* K_lds, int r32, int hi, const bf16x8* qr, bool act, float slopeL, float a0) {
    if (!act) { const float NEG = -__builtin_inff();
#pragma unroll
        for (int r = 0; r < 16; ++r) { p0[r] = NEG; p1[r] = NEG; } return; }
#pragma unroll
    for (int r = 0; r < 16; ++r) { p0[r] = fmaf(slopeL, (float)((r & 3) + 8 * (r >> 2)), a0); p1[r] = fmaf(slopeL, (float)((r & 3) + 8 * (r >> 2) + 32), a0); }
    qkt<KB>(p0, p1, K_lds, r32, hi, qr);
}
#define ROWP(off, k0, rr) (wsb + ((size_t)(off) + (size_t)(k0) * (DM * 2)) + (unsigned)(((rr) * DM + sc) * 2))
#define VMW() asm volatile("s_waitcnt vmcnt(0)" ::: "memory")
#define SLOAD_H(Kp, Vp, k0) do { S.st_v0 = *(const bf16x8*)ROWP(Vp, k0, sr); S.st_v1 = *(const bf16x8*)ROWP(Vp, k0, 32 + sr); \
                                 S.st_k0 = *(const bf16x8*)ROWP(Kp, k0, sr); S.st_k1 = *(const bf16x8*)ROWP(Kp, k0, 32 + sr); } while (0)
#define SWRITE_HK(bf) do { *(LAS bf16x8*)(Kw + (bf) * SHM_K + kws) = S.st_k0; *(LAS bf16x8*)(Kw + (bf) * SHM_K + kws + 32 * 256) = S.st_k1; } while (0)
#define SWRITE_HV(bf) do { *(LAS bf16x8*)(Vw + (bf) * SHM_V + vst0) = S.st_v0; *(LAS bf16x8*)(Vw + (bf) * SHM_V + vst1) = S.st_v1; } while (0)
#define SWRITE_H(bf) do { SWRITE_HV(bf); SWRITE_HK(bf); } while (0)
__device__ __forceinline__ void prime(const unsigned char* wsb, const Blk& cur, unsigned char* lds, Seam& S, int tid) {
    const int wid = __builtin_amdgcn_readfirstlane(tid >> 6), lane = tid & 63, r32 = lane & 31, hi = lane >> 5;
    const int sr = tid >> 4, sc = (tid & 15) * 8, kws = KSWZ(sr, sc * 2);
    LAS char* Kw = (LAS char*)(LAS unsigned char*)lds + OFF_K;
#pragma unroll
    for (int d0 = 0; d0 < 8; ++d0) S.qr[d0] = *(const bf16x8*)(wsb + (size_t)cur.qoff + (unsigned)(((wid * 32 + r32) * DM + d0 * 16 + hi * 8) * 2));
    SLOAD_H(cur.koff, cur.voff, cur.kb0); VMW(); SWRITE_HK(0);
    __syncthreads();
}
template <int MODE>
__device__ __forceinline__ void block(const unsigned char* wsb, const Blk& cur, const Nxt& nxt, unsigned sel, unsigned char* lds, Seam& S, int tid) {
    const int wid = __builtin_amdgcn_readfirstlane(tid >> 6), lane = tid & 63, r32 = lane & 31, hi = lane >> 5;
    const LAS char* K_lds = (const LAS char*)(LAS unsigned char*)lds + OFF_K;
    LAS char* Kw = (LAS char*)(LAS unsigned char*)lds + OFF_K; LAS char* Vw = (LAS char*)(LAS unsigned char*)lds + OFF_V;
    LAS float* wsf = (LAS float*)((LAS unsigned char*)lds + OFF_WS) + wid * 64; LAS float* li_l = wsf; LAS float* al_l = wsf + 32;
    const int sr = tid >> 4, sc = (tid & 15) * 8, vst0 = v_st(sr, sc), vst1 = v_st(32 + sr, sc), kws = KSWZ(sr, sc * 2);
    const int vb0 = (int)(unsigned)(uintptr_t)((LAS unsigned char*)lds) + OFF_V + v_rd_base(lane);
    const int NT = cur.NT, qlo = cur.R0 + wid * 32, qm = qlo + r32 - 4 * hi;
    const float slopeL = cur.slopeL;
    const unsigned Kh = cur.koff, Vh = cur.voff;
    float m_reg = -1e30f, l_reg = 0.f; f32x16 o[4] = {};
#define KBASE(t) (cur.kb0 + (t) * KVBLK)
#define RESC(a) do { if (__any((a) < 1.f)) { if (hi == 0) al_l[r32] = (a); LDS_WAIT(); \
        _Pragma("unroll") for (int d_ = 0; d_ < 4; ++d_) _Pragma("unroll") for (int r = 0; r < 16; ++r) o[d_][r] *= al_l[crow(r, hi)]; } } while (0)
#define QKT(PX0, PX1, t, KB, ACTV) do { const int kb_ = KBASE(t); bool nd_; unsigned W_; tile_info(cur, kb_, qlo, r32, sel, ACTV, nd_, W_); \
        qkt2<KB>(PX0, PX1, K_lds, r32, hi, S.qr, ACTV, slopeL, slopeL * (float)(kb_ - qm)); } while (0)
#define MASKT(PX0, PX1, t) do { const int kb_ = KBASE(t); bool ac_, nd_; unsigned W_; tile_info(cur, kb_, qlo, r32, sel, ac_, nd_, W_); \
        if (ac_ && nd_) mask_tile(PX0, PX1, qm - kb_, W_); } while (0)
    f32x16 pA0, pA1, pB0, pB1; float alA, alB; bf16x8 pa0, pa1, pa2, pa3; bool actA, actB;
    SWRITE_HV(0); SBAR();
    SLOAD_H(Kh, Vh, KBASE(1));
    SBAR(); QKT(pA0, pA1, 0, 0, actA);
    MASKT(pA0, pA1, 0); partialSM(pA0, pA1, m_reg, alA);
    VMW(); SWRITE_H(1);
    __syncthreads();
#define HALF_STEP(PX0, PX1, alX, actX, PY0, PY1, alY, actY, t, KB, VB, SB) do {                                                 \
        SBAR(); QKT(PX0, PX1, t, KB, actX);                                                                                   \
        finishSM(PY0, PY1, alY, l_reg, pa0, pa1, pa2, pa3); SBAR();                                                           \
        if ((t) + 1 < NT) { SLOAD_H(Kh, Vh, KBASE((t) + 1)); SBAR(); }                                                        \
        if (actY) pv_tile<VB>(o, vb0, pa0, pa1, pa2, pa3);                                                                    \
        MASKT(PX0, PX1, (t)); partialSM(PX0, PX1, m_reg, alX);                                                                \
        __syncthreads();                                                                                                      \
        if ((t) + 1 < NT) { VMW(); SWRITE_H(SB); }                                                                            \
        RESC(alX); __syncthreads(); } while (0)
    for (int t = 1; t + 1 < NT; t += 2) {
        HALF_STEP(pB0, pB1, alB, actB, pA0, pA1, alA, actA, t, 1, 0, 0);
        HALF_STEP(pA0, pA1, alA, actA, pB0, pB1, alB, actB, t + 1, 0, 1, 1);
    }
    SBAR(); QKT(pB0, pB1, NT - 1, 1, actB); SBAR();
    SLOAD_H(nxt.koff, nxt.voff, nxt.kb0); SBAR();
#pragma unroll
    for (int d0 = 0; d0 < 8; ++d0) S.qr[d0] = *(const bf16x8*)(wsb + (size_t)nxt.qoff + (unsigned)(((wid * 32 + r32) * DM + d0 * 16 + hi * 8) * 2));
    SBAR();
    finishSM(pA0, pA1, alA, l_reg, pa0, pa1, pa2, pa3); SBAR();
    if (actA) pv_tile<0>(o, vb0, pa0, pa1, pa2, pa3);
    MASKT(pB0, pB1, NT - 1); partialSM(pB0, pB1, m_reg, alB); __syncthreads(); RESC(alB);
    finishSM(pB0, pB1, alB, l_reg, pa0, pa1, pa2, pa3); SBAR();
    if (actB) pv_tile<1>(o, vb0, pa0, pa1, pa2, pa3);
    SBAR(); asm volatile("s_waitcnt vmcnt(8)" ::: "memory"); SWRITE_HK(0); SBAR();
    int tid2 = tid; asm volatile("" : "+v"(tid2));
    const int lane2 = tid2 & 63, r32e = lane2 & 31, hie = lane2 >> 5;
    if (hie == 0) li_l[r32e] = l_reg;
    LDS_WAIT();
    LAS unsigned char* stg = (LAS unsigned char*)lds + OFF_OST + wid * OST_WAVE;
#pragma unroll
    for (int r = 0; r < 16; ++r) { const int orow = crow(r, hie); const float rl = __builtin_amdgcn_rcpf(li_l[orow]);
#pragma unroll
        for (int d0 = 0; d0 < 4; ++d0) *(LAS unsigned short*)(stg + orow * OST_ROW + (d0 * 32 + r32e) * 2) = (unsigned short)(cvt_pk_bf16(o[d0][r] * rl, 0.f) & 0xffffu); }
    LDS_WAIT();
    if (MODE == 0) { if (hie == 0) *(float*)(const_cast<unsigned char*>(wsb) + (size_t)cur.xoff + (unsigned)((qlo + r32e) * NH * 4)) = m_reg + log2f(l_reg); }
#pragma unroll
    for (int i = 0; i < 8; ++i) { const int row = i * 4 + (lane2 >> 4), ch = lane2 & 15;
        u32x4 v = *(const LAS u32x4*)(stg + row * OST_ROW + ch * 16);
        const unsigned go = (unsigned)(((qlo + row) * DM + ch * 8) * 2);
        if (MODE == 1) { const u32x4 z = *(const u32x4*)(wsb + (size_t)cur.xoff + go);
            v.x = cvt_pk_bf16(bflo(v.x) * silu_f(bflo(z.x)), bfhi(v.x) * silu_f(bfhi(z.x))); v.y = cvt_pk_bf16(bflo(v.y) * silu_f(bflo(z.y)), bfhi(v.y) * silu_f(bfhi(z.y)));
            v.z = cvt_pk_bf16(bflo(v.z) * silu_f(bflo(z.z)), bfhi(v.z) * silu_f(bfhi(z.z))); v.w = cvt_pk_bf16(bflo(v.w) * silu_f(bflo(z.w)), bfhi(v.w) * silu_f(bfhi(z.w))); }
        *(u32x4*)(const_cast<unsigned char*>(wsb) + (size_t)cur.ooff + go) = v; }
    __syncthreads();
#undef KBASE
#undef RESC
#undef QKT
#undef MASKT
#undef HALF_STEP
}
#undef ROWP
#undef VMW
#undef SLOAD_H
#undef SWRITE_HK
#undef SWRITE_HV
#undef SWRITE_H
#undef KSWZ
#undef SBAR
}

namespace fc {
using namespace fa;
constexpr int NSLOT = 3;
constexpr int R_K = 0, R_V = NSLOT * SHM_K, R_WS = R_V + NSLOT * SHM_V, R_OST = R_WS + 8 * 256, OSTR = 144, OSTW = 32 * OSTR;
constexpr int R_GK = R_OST + 8 * OSTW, R_SEL = R_GK + 7 * 128 * 4, R_END = R_SEL + 256 * 4;
static_assert(R_END <= LDS_BYTES - 64, "attention LDS map");
#define KSWZ(row, colB) ((row) * 256 + ((colB) ^ (((row) & 7) << 4)))
#define SBAR() __builtin_amdgcn_sched_barrier(0)
struct Blk {
    unsigned qoff, koff, voff, ooff, xoff;
    int R0, kb0, NT;
    float slopeL;
    int L, base0;
};
struct Nxt { unsigned qoff, koff, voff; int kb0; };
__device__ __forceinline__ void glds16(const void* sbase, unsigned voff, unsigned lds_dst) { unsigned keep;
    asm volatile("s_mov_b32 %0, m0\n\ts_mov_b32 m0, %3\n\ts_nop 0\n\tglobal_load_lds_dwordx4 %1, %2\n\ts_mov_b32 m0, %0" : "=&s"(keep) : "v"(voff), "s"(sbase), "s"(lds_dst) : "memory"); }
__device__ __forceinline__ void qkt_r(f32x16& p0, f32x16& p1, const LAS char* Kslot, int r32, int hi, const bf16x8* qr) {
    const LAS char* kb[4];
#pragma unroll
    for (int dd = 0; dd < 4; ++dd) kb[dd] = Kslot + KSWZ(r32, (dd * 16 + hi * 8) * 2);
#pragma unroll
    for (int d0 = 0; d0 < 8; ++d0) { const LAS char* a = kb[d0 & 3] + (d0 >> 2) * 128;
        const bf16x8 b0 = *reinterpret_cast<const LAS bf16x8*>(a);
        const bf16x8 b1 = *reinterpret_cast<const LAS bf16x8*>(a + 32 * 256);
        p0 = __builtin_amdgcn_mfma_f32_32x32x16_bf16(b0, qr[d0], p0, 0, 0, 0);
        p1 = __builtin_amdgcn_mfma_f32_32x32x16_bf16(b1, qr[d0], p1, 0, 0, 0); }
}
__device__ __forceinline__ void pv_r(f32x16* o, int vb, bf16x8 pa0, bf16x8 pa1, bf16x8 pa2, bf16x8 pa3) {
#define TRRD(dst, off) asm volatile("ds_read_b64_tr_b16 %0, %1 offset:%2" : "=&v"(dst) : "v"(vb), "i"(off) : "memory")
#define PV_D0(d0) do { s16x4 l0, l1, l2, l3, h0, h1, h2, h3; constexpr int b_ = v_rd_off(d0, 0, 0); \
        TRRD(l0, b_); TRRD(h0, b_ + 2048); TRRD(l1, b_ + 4096); TRRD(h1, b_ + 6144); TRRD(l2, b_ + 8192); TRRD(h2, b_ + 10240); TRRD(l3, b_ + 12288); TRRD(h3, b_ + 14336); \
        asm volatile("s_waitcnt lgkmcnt(0)" ::: "memory"); SBAR();   \
        o[d0] = __builtin_amdgcn_mfma_f32_32x32x16_bf16(pa0, (bf16x8){l0[0], l0[1], l0[2], l0[3], h0[0], h0[1], h0[2], h0[3]}, o[d0], 0, 0, 0);   \
        o[d0] = __builtin_amdgcn_mfma_f32_32x32x16_bf16(pa1, (bf16x8){l1[0], l1[1], l1[2], l1[3], h1[0], h1[1], h1[2], h1[3]}, o[d0], 0, 0, 0);   \
        o[d0] = __builtin_amdgcn_mfma_f32_32x32x16_bf16(pa2, (bf16x8){l2[0], l2[1], l2[2], l2[3], h2[0], h2[1], h2[2], h2[3]}, o[d0], 0, 0, 0);   \
        o[d0] = __builtin_amdgcn_mfma_f32_32x32x16_bf16(pa3, (bf16x8){l3[0], l3[1], l3[2], l3[3], h3[0], h3[1], h3[2], h3[3]}, o[d0], 0, 0, 0); } while (0)
    PV_D0(0); PV_D0(1); PV_D0(2); PV_D0(3);
#undef PV_D0
#undef TRRD
}
__device__ __forceinline__ void tile_info(const Blk& c, int kb, int qlo, int r32, unsigned sel, bool& act, bool& need, unsigned& W, bool& dead) {
    dead = false;
    if (c.L > 0) { const int seq0 = qlo & ~(c.L - 1); int lowk = qlo - 128; if (lowk < seq0) lowk = seq0;
        act = (kb <= qlo + 31) && (kb + KVBLK - 1 >= lowk); need = true; const int wl = qlo + r32 - seq0 + 1; W = (unsigned)(wl < 129 ? wl : 129); }
    else if (kb >= c.R0) { act = kb <= qlo + 31; need = kb + KVBLK - 1 > qlo; W = 0x40000000u; }
    else { const int blk = (kb - c.base0) >> 8; const bool sb = (sel >> blk) & 1u; act = __ballot(sb) != 0ull; need = false; W = 0x40000000u; dead = !sb; }
}
struct Ring { int kt; };
__device__ __forceinline__ int nx3(int s) { return s == 2 ? 0 : s + 1; }
struct DmaLane { unsigned vk0, vk1, vv0, vv1; };
__device__ __forceinline__ DmaLane dma_lane(int wid, int lane) {
    DmaLane d;
    { const int row0 = wid * 8 + (lane >> 4), row1 = row0 + 4, cs = lane & 15;
      d.vk0 = (unsigned)(row0 * DM * 2 + ((cs ^ (row0 & 7)) * 16)); d.vk1 = (unsigned)(row1 * DM * 2 + ((cs ^ (row1 & 7)) * 16)); }
    { const int gi = lane & 31, kk = wid * 8 + (gi >> 2), k = (kk & ~0xC) | ((kk & 4) << 1) | ((kk & 8) >> 1);
      const int c0 = ((lane >> 5)) * 32 + (gi & 3) * 8, c1 = c0 + 64;
      d.vv0 = (unsigned)(k * DM * 2 + c0 * 2); d.vv1 = (unsigned)(k * DM * 2 + c1 * 2); }
    return d;
}
#define DMA_K(srcoff, kbrow, slot) do { const unsigned char* sb_ = wsb + ((size_t)(srcoff) + (size_t)(kbrow) * (DM * 2)); const unsigned ld_ = ldsb + R_K + (slot) * SHM_K + wid * 2048; \
        glds16(sb_, dl.vk0, ld_); glds16(sb_, dl.vk1, ld_ + 1024); } while (0)
#define DMA_V(srcoff, kbrow, slot) do { const unsigned char* sb_ = wsb + ((size_t)(srcoff) + (size_t)(kbrow) * (DM * 2)); const unsigned ld_ = ldsb + R_V + (slot) * SHM_V + wid * 2048; \
        glds16(sb_, dl.vv0, ld_); glds16(sb_, dl.vv1, ld_ + 1024); } while (0)
#define WAITBAR(N) asm volatile("s_waitcnt vmcnt(" #N ") lgkmcnt(0)\n\ts_barrier" ::: "memory")
__device__ __forceinline__ void prime(const unsigned char* wsb, const Blk& cur, unsigned char* lds, bf16x8* qr, Ring& rg, int tid) {
    const int wid = __builtin_amdgcn_readfirstlane(tid >> 6), lane = tid & 63, r32 = lane & 31, hi = lane >> 5;
    const unsigned ldsb = (unsigned)(uintptr_t)((LAS unsigned char*)lds);
    const DmaLane dl = dma_lane(wid, lane);
    DMA_K(cur.koff, cur.kb0, 0); DMA_V(cur.voff, cur.kb0, 0); DMA_K(cur.koff, cur.kb0 + KVBLK, 1);
#pragma unroll
    for (int d0 = 0; d0 < 8; ++d0) qr[d0] = *(const bf16x8*)(wsb + (size_t)cur.qoff + (unsigned)(((wid * 32 + r32) * DM + d0 * 16 + hi * 8) * 2));
    rg.kt = 0;
    WAITBAR(0);
}
template <int MODE>
__device__ __forceinline__ void block(const unsigned char* wsb, const Blk& cur, const Nxt& nxt, bool has_next, unsigned sel, unsigned char* lds, bf16x8* qr, Ring& rg, int tid) {
    const int wid = __builtin_amdgcn_readfirstlane(tid >> 6), lane = tid & 63, r32 = lane & 31, hi = lane >> 5;
    const unsigned ldsb = (unsigned)(uintptr_t)((LAS unsigned char*)lds);
    const LAS char* K_lds = (const LAS char*)(LAS unsigned char*)lds + R_K;
    LAS float* wsf = (LAS float*)((LAS unsigned char*)lds + R_WS) + wid * 64; LAS float* li_l = wsf; LAS float* al_l = wsf + 32;
    const int vbl = (int)ldsb + R_V + v_rd_base(lane);
    const DmaLane dl = dma_lane(wid, lane);
    const int NT = cur.NT, qlo = cur.R0 + wid * 32, qm = qlo + r32 - 4 * hi;
    const float slopeL = cur.slopeL;
    float m_reg = -1e30f, l_reg = 0.f; f32x16 o[4] = {};
    int kt = rg.kt;
#define RESC(a) do { if (__any((a) < 1.f)) { if (hi == 0) al_l[r32] = (a); LDS_WAIT(); \
        _Pragma("unroll") for (int d_ = 0; d_ < 4; ++d_) _Pragma("unroll") for (int r = 0; r < 16; ++r) o[d_][r] *= al_l[crow(r, hi)]; } } while (0)
#define STEPX(PX0, PX1, alX, actX, PY0, PY1, alY, actY, t, HAVEY) do {                                                                \
        const int kb_ = cur.kb0 + (t) * KVBLK; bool nd_, dd_; unsigned W_; tile_info(cur, kb_, qlo, r32, sel, actX, nd_, W_, dd_);   \
        SBAR();                                                                                                                       \
        if (actX) { const float a0_ = dd_ ? -__builtin_inff() : slopeL * (float)(kb_ - qm);                                           \
            _Pragma("unroll") for (int r = 0; r < 16; ++r) { PX0[r] = fmaf(slopeL, (float)((r & 3) + 8 * (r >> 2)), a0_); PX1[r] = fmaf(slopeL, (float)((r & 3) + 8 * (r >> 2) + 32), a0_); } \
            qkt_r(PX0, PX1, K_lds + kt * SHM_K, r32, hi, qr); }                                                                       \
        else { _Pragma("unroll") for (int r = 0; r < 16; ++r) { PX0[r] = -__builtin_inff(); PX1[r] = -__builtin_inff(); } }           \
        if (HAVEY) finishSM(PY0, PY1, alY, l_reg, pa0, pa1, pa2, pa3);                                                                \
        SBAR();                                                                                                                       \
        { const int s2_ = kt == 0 ? 2 : kt - 1, s1_ = nx3(kt);                           \
          const bool in2_ = (t) + 2 < NT, in1_ = (t) + 1 < NT;                                                                        \
          if (in2_) DMA_K(cur.koff, kb_ + 2 * KVBLK, s2_); else if (has_next) DMA_K(nxt.koff, nxt.kb0 + ((t) + 2 - NT) * KVBLK, s2_);        \
          if (in1_) DMA_V(cur.voff, kb_ + KVBLK, s1_); else if (has_next) DMA_V(nxt.voff, nxt.kb0 + ((t) + 1 - NT) * KVBLK, s1_); }         \
        SBAR();                                                                                                                       \
        if (HAVEY) { if (actY) pv_r(o, vbl + (kt == 0 ? 2 : kt - 1) * SHM_V, pa0, pa1, pa2, pa3); }                                   \
        if (actX && nd_) mask_tile(PX0, PX1, qm - kb_, W_);                                                                           \
        partialSM(PX0, PX1, m_reg, alX);                                                                                              \
        RESC(alX);                                                                                                                    \
        if ((t) + 2 < NT || has_next) WAITBAR(4); else if ((t) + 1 < NT) WAITBAR(2); else WAITBAR(0);                                 \
        kt = nx3(kt); } while (0)
    f32x16 pA0, pA1, pB0, pB1; float alA = 1.f, alB = 1.f; bf16x8 pa0, pa1, pa2, pa3; bool actA = false, actB = false;
    STEPX(pA0, pA1, alA, actA, pB0, pB1, alB, actB, 0, false);
    STEPX(pB0, pB1, alB, actB, pA0, pA1, alA, actA, 1, true);
    for (int t = 2; t < NT; t += 2) {
        STEPX(pA0, pA1, alA, actA, pB0, pB1, alB, actB, t, true);
        STEPX(pB0, pB1, alB, actB, pA0, pA1, alA, actA, t + 1, true);
    }
    finishSM(pB0, pB1, alB, l_reg, pa0, pa1, pa2, pa3); SBAR();
    if (actB) pv_r(o, vbl + (kt == 0 ? 2 : kt - 1) * SHM_V, pa0, pa1, pa2, pa3);
    SBAR();
    if (has_next) {
#pragma unroll
        for (int d0 = 0; d0 < 8; ++d0) qr[d0] = *(const bf16x8*)(wsb + (size_t)nxt.qoff + (unsigned)(((wid * 32 + r32) * DM + d0 * 16 + hi * 8) * 2));
    }
    SBAR();
    rg.kt = kt;
    int tid2 = tid; asm volatile("" : "+v"(tid2));
    const int lane2 = tid2 & 63, r32e = lane2 & 31, hie = lane2 >> 5;
    if (hie == 0) li_l[r32e] = l_reg;
    LDS_WAIT();
    if (MODE == 0) { if (hie == 0) *(float*)(const_cast<unsigned char*>(wsb) + (size_t)cur.xoff + (unsigned)((qlo + r32e) * NH * 4)) = m_reg + log2f(l_reg); }
    LAS unsigned char* stg = (LAS unsigned char*)lds + R_OST + wid * OSTW;
    float rl[16];
#pragma unroll
    for (int r = 0; r < 16; ++r) rl[r] = __builtin_amdgcn_rcpf(li_l[crow(r, hie)]);
#pragma unroll
    for (int hf = 0; hf < 2; ++hf) {
#pragma unroll
        for (int r = 0; r < 16; ++r) { const int orow = crow(r, hie);
#pragma unroll
            for (int dd = 0; dd < 2; ++dd) *(LAS unsigned short*)(stg + orow * OSTR + (dd * 32 + r32e) * 2) = (unsigned short)(cvt_pk_bf16(o[2 * hf + dd][r] * rl[r], 0.f) & 0xffffu); }
        LDS_WAIT();
#pragma unroll
        for (int i = 0; i < 4; ++i) { const int row = i * 8 + (lane2 >> 3), ch = lane2 & 7;
            u32x4 v = *(const LAS u32x4*)(stg + row * OSTR + ch * 16);
            const unsigned go = (unsigned)(((qlo + row) * DM + hf * 64 + ch * 8) * 2);
            if (MODE == 1) { const u32x4 z = *(const u32x4*)(wsb + (size_t)cur.xoff + go);
                v.x = cvt_pk_bf16(bflo(v.x) * silu_f(bflo(z.x)), bfhi(v.x) * silu_f(bfhi(z.x))); v.y = cvt_pk_bf16(bflo(v.y) * silu_f(bflo(z.y)), bfhi(v.y) * silu_f(bfhi(z.y)));
                v.z = cvt_pk_bf16(bflo(v.z) * silu_f(bflo(z.z)), bfhi(v.z) * silu_f(bfhi(z.z))); v.w = cvt_pk_bf16(bflo(v.w) * silu_f(bflo(z.w)), bfhi(v.w) * silu_f(bfhi(z.w))); }
            *(u32x4*)(const_cast<unsigned char*>(wsb) + (size_t)cur.ooff + go) = v; }
        LDS_WAIT();
    }
#undef RESC
#undef STEPX
}
#undef DMA_K
#undef DMA_V
#undef WAITBAR
#undef KSWZ
#undef SBAR
}

__device__ __forceinline__ fb::Blk blk_a(int it) {
    const int g = it >> 9, rem = it & 511, h = rem & 15, rb = rem >> 4, lg = 2 * g, L = SEQ >> lg, R0 = rb * 256;
    int kb0 = R0 - 128; { const int s0 = R0 & ~(L - 1); if (kb0 < s0) kb0 = s0; }
    fb::Blk b;
    b.qoff = (unsigned)(WS_QKV + ((size_t)(3 * g) * PART + (size_t)R0 * DM + h * HD) * 2); b.koff = (unsigned)(WS_QKV + ((size_t)(3 * g + 1) * PART + h * HD) * 2); b.voff = (unsigned)(WS_QKV + ((size_t)(3 * g + 2) * PART + h * HD) * 2);
    b.ooff = (unsigned)(WS_OG + ((size_t)g * PART + h * HD) * 2); b.xoff = (unsigned)(WS_LSE + ((size_t)g * MTOK * NH + h) * 4);
    b.R0 = R0; b.kb0 = kb0; b.NT = (R0 + 256 - kb0) >> 6; b.slopeL = slope_of(h) * (float)(1 << lg) * LOG2E; b.L = L; b.base0 = 0;
    return b;
}
__device__ __forceinline__ void attn_a_pipe(unsigned char* lds, int wv) {
    CParams& P = PP();
    const int tid = otid(wv);
    const unsigned char* wsb = P.ws;
    constexpr int TOTAL = 3 * NH * (MTOK / 256);
    int it = obid(); if (it >= TOTAL) return;
    fb::Blk cur = blk_a(it);
    fb::Seam S;
    fb::prime(wsb, cur, lds, S, tid);
    for (;;) {
        const int itn = it + (int)gridDim.x; const bool last = itn >= TOTAL;
        const fb::Blk nb = last ? cur : blk_a(itn);
        const fb::Nxt nxt{nb.qoff, nb.koff, nb.voff, nb.kb0};
        fb::block<0>(wsb, cur, nxt, 0u, lds, S, tid);
        if (last) break;
        cur = nb; it = itn;
    }
}
__device__ __forceinline__ int vit_b(int it) { return (it < 256) ? ((it & 7) * 32 + (it >> 3)) : it; }
__device__ __forceinline__ fb::Blk blk_b(int it_, int pass) {
    const int it = vit_b(it_); const int bh = it >> 2, s = it & 3, b = bh >> 4, h = bh & 15, n = pass ? 7 - s : s, R0 = (b << 11) + (n << 8);
    fb::Blk k;
    k.qoff = (unsigned)(WS_QKV + ((size_t)R0 * DM + h * HD) * 2); k.koff = (unsigned)(WS_QKV + (PART + h * HD) * 2); k.voff = (unsigned)(WS_QKV + (2 * PART + h * HD) * 2);
    k.ooff = (unsigned)(WS_G + (size_t)(h * HD) * 2); k.xoff = (unsigned)(WS_Z + (size_t)(h * HD) * 2);
    k.R0 = R0; k.kb0 = b << 11; k.NT = 4 * (n + 1); k.slopeL = slope_of(h) * LOG2E; k.L = 0; k.base0 = b << 11;
    return k;
}
__device__ __forceinline__ unsigned moba_gate(const unsigned char* wsb, unsigned char* lds, int b, int h, int n, int R0, int tid) {
    unsigned sel = (1u << n) - 1u;
    if (n >= 4) {
        asm volatile("" : "+v"(tid));
        const bf16_t* QKV = (const bf16_t*)(wsb + WS_QKV); const float* KS = (const float*)(wsb + WS_KSUM);
        LAS float* gk = (LAS float*)((LAS unsigned char*)lds + fa::OFF_GK); LAS unsigned* sel_l = (LAS unsigned*)((LAS unsigned char*)lds + fa::OFF_SEL);
        for (int i = tid; i < n * 128; i += NTHREADS) { const float* kp = KS + (size_t)(b * 8 + (i >> 7)) * DM + h * HD + (i & 127); gk[i] = kp[0] + kp[(size_t)32 * DM]; }
        __syncthreads();
        const int row = tid >> 1, half = tid & 1;
        const u32x4* qp = (const u32x4*)(QKV + (size_t)(R0 + row) * DM + h * HD + half * 64);
        float gt[7];
#pragma unroll
        for (int j = 0; j < 7; ++j) gt[j] = 0.f;
#pragma unroll
        for (int c = 0; c < 8; ++c) { const u32x4 w = qp[c]; const float q0 = bflo(w.x), q1 = bfhi(w.x), q2 = bflo(w.y), q3 = bfhi(w.y), q4 = bflo(w.z), q5 = bfhi(w.z), q6 = bflo(w.w), q7 = bfhi(w.w);
#pragma unroll
            for (int j = 0; j < 7; ++j) if (j < n) { const LAS f32x4* kk = (const LAS f32x4*)(gk + j * 128 + half * 64 + c * 8); const f32x4 ka = kk[0], kb2 = kk[1];
                gt[j] += (q0 * ka.x + q1 * ka.y) + (q2 * ka.z + q3 * ka.w) + (q4 * kb2.x + q5 * kb2.y) + (q6 * kb2.z + q7 * kb2.w); } }
#pragma unroll
        for (int j = 0; j < 7; ++j) gt[j] += __shfl_xor(gt[j], 1);
        unsigned mask = 0;
#pragma unroll
        for (int j = 0; j < 7; ++j) if (j < n) { int rank = 0;
#pragma unroll
            for (int j2 = 0; j2 < 7; ++j2) if (j2 < n && (gt[j2] > gt[j] || (gt[j2] == gt[j] && j2 < j))) ++rank;
            if (rank < 3) mask |= 1u << j; }
        if (half == 0) sel_l[row] = mask;
        __syncthreads();
        sel = sel_l[(tid >> 6) * 32 + (tid & 31)];
    }
    return sel;
}
__device__ __forceinline__ void attn_b_pipe(unsigned char* lds, int wv) {
    CParams& P = PP();
    const int tid = otid(wv);
    const unsigned char* wsb = P.ws;
    constexpr int TOTAL = NB * NH * 4;
    int it = obid(); if (it >= TOTAL) return;
    int pass = 0;
    fb::Blk cur = blk_b(it, 0);
    fb::Seam S;
    fb::prime(wsb, cur, lds, S, tid);
    for (;;) {
        int itn = it, passn = pass + 1; if (passn == 2) { passn = 0; itn = it + (int)gridDim.x; }
        const bool last = itn >= TOTAL;
        const fb::Blk nb = last ? cur : blk_b(itn, passn);
        const fb::Nxt nxt{nb.qoff, nb.koff, nb.voff, nb.kb0};
        const int vi = vit_b(it), bh = vi >> 2, s = vi & 3, n = pass ? 7 - s : s;
        const unsigned sel = moba_gate(wsb, lds, bh >> 4, bh & 15, n, cur.R0, tid);
        fb::block<1>(wsb, cur, nxt, sel, lds, S, tid);
        if (last) break;
        cur = nb; it = itn; pass = passn;
    }
}

__device__ __forceinline__ fc::Blk cblk_a(int it) { const fb::Blk b = blk_a(it); return fc::Blk{b.qoff, b.koff, b.voff, b.ooff, b.xoff, b.R0, b.kb0, b.NT, b.slopeL, b.L, b.base0}; }
__device__ __forceinline__ fc::Blk cblk_b(int it, int pass) { const fb::Blk b = blk_b(it, pass); return fc::Blk{b.qoff, b.koff, b.voff, b.ooff, b.xoff, b.R0, b.kb0, b.NT, b.slopeL, b.L, b.base0}; }
__device__ __forceinline__ void attn_a_dma(unsigned char* lds, int wv) {
    CParams& P = PP();
    const int tid = otid(wv);
    const unsigned char* wsb = P.ws;
    constexpr int TOTAL = 3 * NH * (MTOK / 256);
    int it = obid(); if (it >= TOTAL) return;
    fc::Blk cur = cblk_a(it);
    bf16x8 qr[8]; fc::Ring rg;
    fc::prime(wsb, cur, lds, qr, rg, tid);
    for (;;) {
        const int itn = it + (int)gridDim.x; const bool last = itn >= TOTAL;
        const fc::Blk nb = last ? cur : cblk_a(itn);
        const fc::Nxt nxt{nb.qoff, nb.koff, nb.voff, nb.kb0};
        fc::block<0>(wsb, cur, nxt, !last, 0u, lds, qr, rg, tid);
        if (last) break;
        cur = nb; it = itn;
    }
}
__device__ __forceinline__ void attn_b_dma(unsigned char* lds, int wv) {
    CParams& P = PP();
    const int tid = otid(wv);
    const unsigned char* wsb = P.ws;
    constexpr int TOTAL = NB * NH * 4;
    int it = obid(); if (it >= TOTAL) return;
    int pass = 0;
    fc::Blk cur = cblk_b(it, 0);
    bf16x8 qr[8]; fc::Ring rg;
    fc::prime(wsb, cur, lds, qr, rg, tid);
    for (;;) {
        int itn = it, passn = pass + 1; if (passn == 2) { passn = 0; itn = it + (int)gridDim.x; }
        const bool last = itn >= TOTAL;
        const fc::Blk nb = last ? cur : cblk_b(itn, passn);
        const fc::Nxt nxt{nb.qoff, nb.koff, nb.voff, nb.kb0};
        const int vi = vit_b(it), bh = vi >> 2, s = vi & 3, n = pass ? 7 - s : s;
        const unsigned sel = moba_gate(wsb, lds, bh >> 4, bh & 15, n, cur.R0, tid);
        fc::block<1>(wsb, cur, nxt, !last, sel, lds, qr, rg, tid);
        if (last) break;
        cur = nb; it = itn; pass = passn;
    }
}

__device__ __forceinline__ void attn_a_flash(unsigned char* lds, int wv) {
    CParams& P = PP();
    const int tid = otid(wv);
    const bf16_t* QKV = (const bf16_t*)(P.ws + WS_QKV); bf16_t* OG = (bf16_t*)(P.ws + WS_OG); float* LSE = (float*)(P.ws + WS_LSE);
    for (int it = obid(); it < 3 * NH * (MTOK / 256); it += gridDim.x) {
        const int g = it >> 9, rem = it & 511, h = rem & 15, rb = rem >> 4;
        const int lg = 2 * g, L = SEQ >> lg, R0 = rb * 256;
        int krow0 = R0 - 128; { const int s0 = R0 & ~(L - 1); if (krow0 < s0) krow0 = s0; }
        const int NT = (R0 + 256 - krow0) >> 6;
        const fa::MaskA mk{L};
        fa::flash_block<0>(QKV + (size_t)(3 * g) * PART + (size_t)R0 * DM + h * HD, QKV + (size_t)(3 * g + 1) * PART + h * HD, QKV + (size_t)(3 * g + 2) * PART + h * HD,
                           krow0, NT, R0, slope_of(h) * (float)(1 << lg) * LOG2E, mk, lds, OG + (size_t)g * PART + h * HD, LSE + (size_t)g * MTOK * NH + h, nullptr, tid);
    }
}
__device__ __forceinline__ void attn_b_flash(unsigned char* lds, int wv) {
    CParams& P = PP();
    const int tid = otid(wv);
    const bf16_t* QKV = (const bf16_t*)(P.ws + WS_QKV); const bf16_t* Z = (const bf16_t*)(P.ws + WS_Z); bf16_t* G = (bf16_t*)(P.ws + WS_G); const float* KS = (const float*)(P.ws + WS_KSUM);
    LAS float* gk = (LAS float*)((LAS unsigned char*)lds + fa::OFF_GK); LAS unsigned* sel_l = (LAS unsigned*)((LAS unsigned char*)lds + fa::OFF_SEL);
    for (int it = obid(); it < NB * NH * 4; it += gridDim.x) {
        const int bh = it >> 2, s = it & 3, b = bh >> 4, h = bh & 15;
        for (int pass = 0; pass < 2; ++pass) {
            const int n = pass ? 7 - s : s, R0 = (b << 11) + (n << 8);
            unsigned sel = (1u << n) - 1u;
            if (n >= 4) {
                for (int i = tid; i < n * 128; i += NTHREADS) { const float* kp = KS + (size_t)(b * 8 + (i >> 7)) * DM + h * HD + (i & 127); gk[i] = kp[0] + kp[(size_t)32 * DM]; }
                __syncthreads();
                const int row = tid >> 1, half = tid & 1;
                const u32x4* qp = (const u32x4*)(QKV + (size_t)(R0 + row) * DM + h * HD + half * 64);
                float gt[7];
#pragma unroll
                for (int j = 0; j < 7; ++j) gt[j] = 0.f;
#pragma unroll
                for (int c = 0; c < 8; ++c) { const u32x4 w = qp[c]; const float q0 = bflo(w.x), q1 = bfhi(w.x), q2 = bflo(w.y), q3 = bfhi(w.y), q4 = bflo(w.z), q5 = bfhi(w.z), q6 = bflo(w.w), q7 = bfhi(w.w);
#pragma unroll
                    for (int j = 0; j < 7; ++j) if (j < n) { const LAS f32x4* kk = (const LAS f32x4*)(gk + j * 128 + half * 64 + c * 8); const f32x4 ka = kk[0], kb2 = kk[1];
                        gt[j] += (q0 * ka.x + q1 * ka.y) + (q2 * ka.z + q3 * ka.w) + (q4 * kb2.x + q5 * kb2.y) + (q6 * kb2.z + q7 * kb2.w); } }
#pragma unroll
                for (int j = 0; j < 7; ++j) gt[j] += __shfl_xor(gt[j], 1);
                unsigned mask = 0;
#pragma unroll
                for (int j = 0; j < 7; ++j) if (j < n) { int rank = 0;
#pragma unroll
                    for (int j2 = 0; j2 < 7; ++j2) if (j2 < n && (gt[j2] > gt[j] || (gt[j2] == gt[j] && j2 < j))) ++rank;
                    if (rank < 3) mask |= 1u << j; }
                if (half == 0) sel_l[row] = mask;
                __syncthreads();
                sel = sel_l[(tid >> 6) * 32 + (tid & 31)];
            }
            const fa::MaskB mk{R0, b << 11, sel};
            fa::flash_block<1>(QKV + (size_t)R0 * DM + h * HD, QKV + PART + h * HD, QKV + 2 * PART + h * HD, b << 11, 4 * (n + 1), R0, slope_of(h) * LOG2E, mk, lds,
                               G + h * HD, nullptr, Z + h * HD, tid);
        }
    }
}

#define XB_TMO      128
#define XB_XCNT(j)  (256  + 64 * (j))
#define XB_XSUB(j)  (1280 + 64 * (j))
#define XB_XGEN(j)  (2304 + 64 * (j))
#define XB_TOP      3328
#define XB_TOPGEN   3392
#define XCD_BAR_WORDS 3456
#define XB_SPIN_CAP (1u << 20)
__device__ __forceinline__ unsigned xb_ld(unsigned* p)              { return __hip_atomic_load(p, __ATOMIC_RELAXED, __HIP_MEMORY_SCOPE_AGENT); }
__device__ __forceinline__ unsigned xb_add(unsigned* p, unsigned v) { return __hip_atomic_fetch_add(p, v, __ATOMIC_RELAXED, __HIP_MEMORY_SCOPE_AGENT); }
__device__ __forceinline__ unsigned xb_xcc_id() { return (unsigned)__builtin_amdgcn_s_getreg((3 << 11) | 20) & 0xFu; }
#define XB_SPIN(cond, bar) do { unsigned _sp = 0; while (cond) { __builtin_amdgcn_s_sleep(1); \
    if ((++_sp & 255u) == 0u) { if (xb_ld(&(bar)[XB_TMO])) break; if (_sp > XB_SPIN_CAP) { atomicAdd(&(bar)[XB_TMO], 1u); break; } } } } while (0)
struct XcdBarrier { unsigned* bar; unsigned x; volatile LAS unsigned* st; };
__device__ __forceinline__ XcdBarrier xcd_barrier_post(unsigned* bar, volatile LAS unsigned* st) {
    XcdBarrier b; b.bar = bar; b.x = xb_xcc_id(); b.st = st;
    if (threadIdx.x == 0) (void)xb_add(&bar[XB_XCNT(b.x)], 1u);
    return b;
}
__device__ __forceinline__ void xcd_barrier_complete(unsigned* bar, unsigned x, unsigned& nloc, unsigned& nx) {
    const unsigned G = gridDim.x * gridDim.y * gridDim.z;
    unsigned sum, cnt, mine, sp = 0u;
    for (;;) {
        sum = 0u; cnt = 0u; mine = 0u;
#pragma unroll
        for (unsigned j = 0; j < 16; ++j) { const unsigned c = xb_ld(&bar[XB_XCNT(j)]); sum += c; cnt += (c > 0u) ? 1u : 0u; mine = (j == x) ? c : mine; }
        if (sum == G) break;
        __builtin_amdgcn_s_sleep(1);
        if ((++sp & 255u) == 0u) { if (xb_ld(&bar[XB_TMO])) break; if (sp > XB_SPIN_CAP) { atomicAdd(&bar[XB_TMO], 1u); break; } }
    }
    nloc = mine > 0u ? mine : 1u; nx = cnt > 0u ? cnt : 1u;
}
__device__ __forceinline__ void xcd_barrier(const XcdBarrier& b) {
    asm volatile("s_waitcnt vmcnt(0)" ::: "memory");
    __syncthreads();
    if (threadIdx.x == 0) {
        unsigned* bar = b.bar;
        __builtin_amdgcn_s_waitcnt(0);
        unsigned nloc = b.st[0], nx = b.st[1];
        if (nloc == 0u) { xcd_barrier_complete(bar, b.x, nloc, nx); b.st[0] = nloc; b.st[1] = nx; }
        const unsigned old = xb_add(&bar[XB_XSUB(b.x)], 1u);
        const unsigned gen = old / nloc;
        if (old + 1u == (gen + 1u) * nloc) {
            __builtin_amdgcn_fence(__ATOMIC_RELEASE, "agent");
            asm volatile("s_waitcnt vmcnt(0)" ::: "memory");
            const unsigned og = xb_add(&bar[XB_TOP], 1u);
            const unsigned tg = og / nx;
            if (og + 1u == (tg + 1u) * nx) xb_add(&bar[XB_TOPGEN], 1u);
            else XB_SPIN(xb_ld(&bar[XB_TOPGEN]) == tg, bar);
            __builtin_amdgcn_fence(__ATOMIC_ACQUIRE, "agent");
            xb_add(&bar[XB_XGEN(b.x)], 1u);
            asm volatile("s_waitcnt vmcnt(0)" ::: "memory");
        } else {
            XB_SPIN(xb_ld(&bar[XB_XGEN(b.x)]) == gen, bar);
            __builtin_amdgcn_fence(__ATOMIC_ACQUIRE, "agent");
            asm volatile("s_waitcnt vmcnt(0)" ::: "memory");
        }
    }
    __syncthreads();
}

__global__ void __launch_bounds__(NTHREADS, 2) fwd_mega(Params Pin) {
    extern __shared__ __attribute__((aligned(16))) unsigned char lds[];
#if USE_CG_SYNC
    cg::grid_group grid = cg::this_grid();
#endif
    LAS unsigned char* lds3 = (LAS unsigned char*)lds;
    (void)Pin;
    const int wv = __builtin_amdgcn_readfirstlane((int)threadIdx.x >> 6);
    volatile LAS unsigned* bst = (volatile LAS unsigned*)(lds3 + (LDS_BYTES - 64));
    if (threadIdx.x < 2) bst[threadIdx.x] = 0u;
    __syncthreads();
    (void)xcd_barrier_post((unsigned*)(PP().ws + WS_CTL), bst);
#define GSYNC() do { XcdBarrier xb_; xb_.bar = (unsigned*)(PP().ws + WS_CTL); xb_.x = xb_xcc_id(); xb_.st = bst; xcd_barrier(xb_); } while (0)
    p0_mod(lds, wv);
    p0_weights(lds, wv);
#if PROBE == 1
    __syncthreads(); p0_mod(lds, wv); p0_weights(lds, wv);
#endif
#if USE_CG_SYNC
    grid.sync();
#else
    GSYNC();
#endif
    for (int layer = 0; layer < DEPTH; ++layer) {
        const bool isA = (layer & 1) == 0; const int j = layer >> 1;
        norm_phase(layer, !isA, wv);
#if PROBE == 2
        norm_phase(layer, !isA, wv);
#endif
#if PROBE == 6
        GSYNC(); GSYNC(); GSYNC(); GSYNC(); GSYNC();
#endif
        GSYNC();
        {
            if (!isA) {
                unsigned char* ws = PP().ws;
                pg8::Gemm g{ws + WS_H, ws + WS_WBQK + (size_t)j * 4096 * DM * 2, MTOK, 4096, DM * 2};
                pg8::StaticOrder S; S.init(MTOK, 4096, (int)gridDim.x, obid());
                pg8::Epi E{1, 0, (bf16_t*)(ws + WS_QKV), (bf16_t*)(ws + WS_Z), (float*)(ws + WS_KSUM), nullptr, nullptr, nullptr, nullptr, nullptr};
                pg8::gemm_phase<pg8::Epi, pg8::StaticOrder, GEMM_ALIGN, GEMM_SP2, false>(lds3, g, S, E, wv);
            }
            {
                unsigned char* ws = PP().ws;
                pg8::Gemm g{ws + WS_HQ, isA ? ws + WS_WAIN + (size_t)j * A_N * DM : ws + WS_WBVZ + (size_t)j * 4096 * DM, MTOK, isA ? A_N : 4096, DM};
                pg8::StaticOrder S; S.init(MTOK, g.N, (int)gridDim.x, obid());
                pg8::Epi E{isA ? 0 : 1, isA ? 0 : 2, (bf16_t*)(ws + WS_QKV), (bf16_t*)(ws + WS_Z), nullptr, (const float*)(ws + WS_RS),
                           isA ? (const float*)(ws + WS_CSA) + j * A_N : (const float*)(ws + WS_CSB) + j * 4096, nullptr, nullptr, nullptr};
                pg8::gemm_phase<pg8::Epi, pg8::StaticOrder, GEMM_ALIGN, GEMM_SP2, true>(lds3, g, S, E, wv);
#if PROBE == 7
                pg8::gemm_phase<pg8::Epi, pg8::StaticOrder, GEMM_ALIGN, GEMM_SP2, true>(lds3, g, S, E, wv);
#endif
            }
        }
        GSYNC();
#if PROBE == 3
        if (isA) attn_a_dma(lds, wv);
#endif
#if PROBE == 4
        if (!isA) attn_b_dma(lds, wv);
#endif
#if ATTN_DMA
        if (isA) { attn_a_dma(lds, wv); GSYNC(); combine_phase(wv);
#elif ATTN_PIPE
        if (isA) { attn_a_pipe(lds, wv); GSYNC(); combine_phase(wv);
#else
        if (isA) { attn_a_flash(lds, wv); GSYNC(); combine_phase(wv);
#endif
#if PROBE == 5
            combine_phase(wv);
#endif
        }
#if ATTN_DMA
        else { attn_b_dma(lds, wv); }
#elif ATTN_PIPE
        else { attn_b_pipe(lds, wv); }
#else
        else { attn_b_flash(lds, wv); }
#endif
        GSYNC();
        {
            CParams& P = PP(); unsigned char* ws = P.ws;
            pg8::Gemm g{ws + WS_G, isA ? ws + WS_WAOUT + (size_t)j * DM * DM * 2 : ws + WS_WBOUT + (size_t)j * DM * DM * 2, MTOK, DM, DM * 2};
            pg8::StaticOrder S; S.init(MTOK, DM, (int)gridDim.x, obid());
            pg8::Epi E{2, 0, nullptr, nullptr, nullptr, nullptr, nullptr, layer == 0 ? P.x : P.out, P.out, (const float*)(ws + WS_MOD) + (size_t)layer * 4 * 6144 + 4096};
            pg8::gemm_phase<pg8::Epi, pg8::StaticOrder, GEMM_ALIGN, GEMM_SP2, false>(lds3, g, S, E, wv);
        }
        GSYNC();
    }
    final_norm_phase(wv);
}

extern "C" void kernel_launch(void* const* d_in, const int* in_sizes, int n_in, void* d_out, int out_size, void* d_ws, size_t ws_size, hipStream_t stream) {
    static int grid = 0;
    if (grid == 0) {
        if (n_in != 10 || in_sizes[0] != MTOK * DM || out_size != MTOK * DM || ws_size < WS_END) {
            fprintf(stderr, "kernel_launch: unexpected shapes/workspace (n_in %d, in0 %d, out %d, ws %zu, need %zu)\n", n_in, n_in > 0 ? in_sizes[0] : -1, out_size, ws_size, (size_t)WS_END); grid = -1; return; }
        int dev = 0, cus = 0, per_cu = 0;
        (void)hipGetDevice(&dev); (void)hipDeviceGetAttribute(&cus, hipDeviceAttributeMultiprocessorCount, dev);
        if (hipFuncSetAttribute((const void*)fwd_mega, hipFuncAttributeMaxDynamicSharedMemorySize, LDS_BYTES) != hipSuccess) { fprintf(stderr, "kernel_launch: hipFuncSetAttribute failed\n"); grid = -1; return; }
        if (hipOccupancyMaxActiveBlocksPerMultiprocessor(&per_cu, (const void*)fwd_mega, NTHREADS, LDS_BYTES) != hipSuccess || per_cu < 1) { fprintf(stderr, "kernel_launch: occupancy query says %d\n", per_cu); (void)hipGetLastError(); per_cu = 1; }
        if (per_cu > 1) per_cu = 1;
        grid = cus * per_cu;
    }
    if (grid < 0) return;
    (void)hipMemsetAsync((char*)d_ws + WS_CTL, 0, 16384, stream);
    Params p{};
    p.x = (const float*)d_in[0]; p.c = (const float*)d_in[1]; p.norm_w = (const float*)d_in[2]; p.mod_w = (const float*)d_in[3]; p.mod_b = (const float*)d_in[4];
    p.a_w_in = (const float*)d_in[5]; p.a_w_out = (const float*)d_in[6]; p.b_w_in = (const float*)d_in[7]; p.b_w_out = (const float*)d_in[8]; p.final_w = (const float*)d_in[9];
    p.out = (float*)d_out; p.ws = (unsigned char*)d_ws;
    void* args[] = {&p};
    hipError_t e = hipLaunchCooperativeKernel((const void*)fwd_mega, dim3(grid), dim3(NTHREADS), args, LDS_BYTES, stream);
    if (e != hipSuccess) fprintf(stderr, "kernel_launch: cooperative launch failed: %s (grid %d)\n", hipGetErrorString(e), grid);
}
```

```cpp
#include <hip/hip_runtime.h>
#include <hip/hip_cooperative_groups.h>
#include <cstdio>
#include <cstdint>
namespace cg = cooperative_groups;
#ifndef ATTN_A_FLASH
#define ATTN_A_FLASH 1
#endif
#ifndef GEMM_ALIGN
#define GEMM_ALIGN true
#endif
#ifndef GEMM_SP2
#define GEMM_SP2 true
#endif
#ifndef PROBE
#define PROBE 0
#endif
#ifndef MOBA_QK_I8
#define MOBA_QK_I8 1
#endif
#ifndef OUTA_I8
#define OUTA_I8 0
#endif
#ifndef GCLIP
#define GCLIP 1.0e9f
#endif
#ifndef STAGGER_TICKS
#define STAGGER_TICKS 0
#endif
#ifndef USE_CG_SYNC
#define USE_CG_SYNC 0
#endif
#ifndef ATTN_PIPE
#define ATTN_PIPE 1
#endif
#ifndef EPI_SC1
#define EPI_SC1 1
#endif
#ifndef FUSE_COMBINE
#define FUSE_COMBINE 1
#endif
#ifndef ATTN_DMA
#define ATTN_DMA 1
#endif
#ifndef ATTN_HS
#define ATTN_HS 0
#endif
#ifndef ATTN_B_FLASH
#define ATTN_B_FLASH 1
#endif

#define LAS __attribute__((address_space(3)))
typedef unsigned short bf16_t;
typedef short bf16x8 __attribute__((ext_vector_type(8)));
typedef short s16x4 __attribute__((ext_vector_type(4)));
typedef float f32x4 __attribute__((ext_vector_type(4)));
typedef float f32x16 __attribute__((ext_vector_type(16)));
typedef unsigned u32x4 __attribute__((ext_vector_type(4)));
typedef unsigned u32x2 __attribute__((ext_vector_type(2)));
typedef int i32x4 __attribute__((ext_vector_type(4)));

constexpr int NB = 4, SEQ = 2048, DM = 2048, MTOK = NB * SEQ, NH = 16, HD = 128, DEPTH = 4;
constexpr int A_N = 10 * DM, B_N = 4 * DM;
constexpr float EPS = 1e-6f;
constexpr float LOG2E = 1.4426950408889634f;
constexpr float C2Q = 0.08838834764831845f * LOG2E;

constexpr size_t MiB = 1u << 20;
constexpr size_t WS_CTL = 0;
constexpr size_t WS_MOD = 1 * MiB;
constexpr size_t WS_KSUM = 2 * MiB;
constexpr size_t WS_LSE = 3 * MiB;
constexpr size_t WS_RS = 5 * MiB;
constexpr size_t WS_CSA = 6 * MiB;
constexpr size_t WS_CSB = 7 * MiB;
constexpr size_t WS_CSO = 7 * MiB + 512 * 1024;
constexpr size_t WS_WAIN = 8 * MiB;
constexpr size_t WS_WBQK = WS_WAIN + 80 * MiB;
constexpr size_t WS_WBVZ = WS_WBQK + 32 * MiB;
constexpr size_t WS_WAOUT = WS_WBVZ + 16 * MiB;
constexpr size_t WS_WBOUT = WS_WAOUT + 16 * MiB;
constexpr size_t WS_H = WS_WBOUT + 16 * MiB;
constexpr size_t WS_HQ = WS_H + 32 * MiB;
constexpr size_t WS_G = WS_HQ + 16 * MiB;
constexpr size_t WS_QKV = WS_G + 32 * MiB;
constexpr size_t WS_Z = WS_QKV + 288 * MiB;
constexpr size_t WS_OG = WS_Z + 32 * MiB;
constexpr size_t WS_END = WS_OG + 96 * MiB;
constexpr size_t PART = (size_t)MTOK * DM;

constexpr int LDS_BYTES = 147456;
constexpr int NTHREADS = 512;

typedef float f32x2_t __attribute__((ext_vector_type(2))); typedef __bf16 bf16x2_t __attribute__((ext_vector_type(2)));
__device__ __forceinline__ unsigned cvt_pk_bf16(float lo, float hi) { f32x2_t v = {lo, hi}; bf16x2_t b = __builtin_convertvector(v, bf16x2_t); return __builtin_bit_cast(unsigned, b); }
__device__ __forceinline__ float bf2f(unsigned short v) { return __uint_as_float(((unsigned)v) << 16); }
__device__ __forceinline__ float bflo(unsigned w) { return __uint_as_float(w << 16); }
__device__ __forceinline__ float bfhi(unsigned w) { return __uint_as_float(w & 0xffff0000u); }
template <int M> __device__ __forceinline__ float sx(float v) {
    if constexpr (M == 32) { auto r = __builtin_amdgcn_permlane32_swap(__float_as_uint(v), __float_as_uint(v), false, false); return __uint_as_float(((__builtin_amdgcn_mbcnt_hi(~0u, __builtin_amdgcn_mbcnt_lo(~0u, 0u)) & 32u) ? r[0] : r[1])); }
    else return __uint_as_float((unsigned)__builtin_amdgcn_ds_swizzle((int)__float_as_uint(v), (M << 10) | 0x1f));
}
__device__ __forceinline__ float wave_sum(float v) { v += sx<1>(v); v += sx<2>(v); v += sx<4>(v); v += sx<8>(v); v += sx<16>(v);
    { auto r = __builtin_amdgcn_permlane32_swap(__float_as_uint(v), __float_as_uint(v), false, false); v = __uint_as_float(r[0]) + __uint_as_float(r[1]); } return v; }
__device__ __forceinline__ float wave_max(float v) { v = fmaxf(v, sx<1>(v)); v = fmaxf(v, sx<2>(v)); v = fmaxf(v, sx<4>(v)); v = fmaxf(v, sx<8>(v)); v = fmaxf(v, sx<16>(v));
    { auto r = __builtin_amdgcn_permlane32_swap(__float_as_uint(v), __float_as_uint(v), false, false); v = fmaxf(__uint_as_float(r[0]), __uint_as_float(r[1])); } return v; }
__device__ __forceinline__ float silu_f(float v) { return v * __builtin_amdgcn_rcpf(1.f + __builtin_amdgcn_exp2f(-1.4426950408889634f * v)); }
#define LDS_WAIT() asm volatile("s_waitcnt lgkmcnt(0)" ::: "memory")
template <class V> __device__ __forceinline__ void store_wt(void* p, V v) { static_assert(sizeof(V) == 16, "16-byte vectors only");
    asm volatile("global_store_dwordx4 %0, %1, off sc0 sc1\n\ts_nop 1" :: "v"(p), "v"(v) : "memory"); }
__device__ __forceinline__ int otid(int wv) { int l; asm volatile("v_mbcnt_lo_u32_b32 %0, -1, 0\n\tv_mbcnt_hi_u32_b32 %0, -1, %0" : "=v"(l)); return (wv << 6) | l; }
template <class T> __device__ __forceinline__ T* optr(T* p) { asm volatile("" : "+s"(p)); return p; }
__device__ __forceinline__ int obid() { int b = blockIdx.x; asm volatile("" : "+s"(b)); return b; }

namespace pg8 {
constexpr int BM = 256, BK = 64, HALF = 128, HTB = HALF * BK * 2, STAGE_BYTES = 8 * HTB, NXCD = 8, WGM = 4;
__host__ __device__ __forceinline__ int lds_byte(int r, int c) { const int st = (r >> 4) * 2 + (c >> 5), rr = r & 15, cc = c & 31, ob = rr * 64 + cc * 2; return st * 1024 + (ob ^ (((ob >> 9) & 1) << 5)); }
__host__ __device__ __forceinline__ void stage_rc(int b, int& R, int& C) { const int st = b / 1024, sb = b % 1024, swz = sb ^ (((sb >> 9) & 1) << 5); R = (st >> 1) * 16 + swz / 64; C = (st & 1) * 32 + (swz % 64) / 2; }
__host__ __device__ __forceinline__ int perm32(int rho) { const int n = rho >> 4, i = rho & 15; return 8 * (i >> 2) + 4 * n + (i & 3); }
struct Unit { int pm, pn; };
struct Gemm { const void* A; const void* Bt; int M, N, KB; };
struct StaticOrder {
    int nM, nN, nwg, G, c;
    __host__ __device__ void init(int M, int N, int G_, int c_) { nM = M / BM; nN = N / BM; nwg = nM * nN; G = G_; c = c_; }
    __host__ __device__ bool next(int i, Unit& u) const {
        const long L = (long)i * G + c; if (L >= nwg) return false;
        int wgid = (int)L; { const int q = nwg / NXCD, r = nwg % NXCD, xcd = wgid % NXCD, off = wgid / NXCD; wgid = (xcd < r ? xcd * (q + 1) : r * (q + 1) + (xcd - r) * q) + off; }
        const int nig = WGM * nN, gid = wgid / nig, fm = gid * WGM, gsz = (nM - fm) < WGM ? (nM - fm) : WGM;
        u.pm = fm + ((wgid % nig) % gsz); u.pn = (wgid % nig) / gsz; return true;
    }
    __device__ __forceinline__ void a_ready(const Unit&) const {}
    __device__ __forceinline__ void done(const Unit&) const {}
};

__device__ __forceinline__ f32x4 acc_f32(const f32x4& a) { return a; }
__device__ __forceinline__ f32x4 acc_f32(const i32x4& a) { return (f32x4){(float)a.x, (float)a.y, (float)a.z, (float)a.w}; }
template <int MS> struct EpiT {
    static constexpr bool PERM = true, AFTER_DRAIN = false;
    int mode;
    int pbase;
    bf16_t* qkv; bf16_t* zbuf; float* ksum;
    const float* rs; const float* cs;
    const float* xin; float* xout; const float* gate;
    template <class AccT>
    __device__ __forceinline__ void operator()(const AccT (&acc)[2][2][4][2], const Unit& u, int wr, int wc, int fr, int fq) const {
        constexpr bool I8 = sizeof(AccT) == sizeof(i32x4) && !__is_same(AccT, f32x4);
        if ((MS & 1) && PROBE != 0 && mode == 3) {
#pragma unroll
            for (int ai = 0; ai < 2; ++ai)
#pragma unroll
                for (int bj = 0; bj < 2; ++bj)
#pragma unroll
                    for (int m = 0; m < 4; ++m)
#pragma unroll
                        for (int n = 0; n < 2; ++n) asm volatile("" :: "v"(acc[ai][bj][m][n]));
            return; }
        if ((MS & 2) && mode == 2) {
            const int col0 = u.pn * BM + wc * 32 + 8 * fq; const int b = (u.pm * BM) >> 11;
            f32x4 gv[2][2];
#pragma unroll
            for (int bj = 0; bj < 2; ++bj)
#pragma unroll
                for (int n = 0; n < 2; ++n) { gv[bj][n] = *(const f32x4*)(gate + b * 6144 + col0 + bj * HALF + 4 * n); if (I8) gv[bj][n] = gv[bj][n] * *(const f32x4*)(cs + col0 + bj * HALF + 4 * n); }
#pragma unroll
            for (int ai = 0; ai < 2; ++ai) {
                f32x4 xv[4][2][2]; float rsv[4];
#pragma unroll
                for (int m = 0; m < 4; ++m) { const int row = u.pm * BM + ai * HALF + wr * 64 + m * 16 + fr; const size_t off = (size_t)row * DM + col0; rsv[m] = I8 ? rs[row] : 1.f;
#pragma unroll
                    for (int bj = 0; bj < 2; ++bj)
#pragma unroll
                        for (int n = 0; n < 2; ++n) xv[m][bj][n] = *(const f32x4*)(xin + off + bj * HALF + 4 * n); }
                asm volatile("" ::: "memory");
#pragma unroll
                for (int m = 0; m < 4; ++m) { const size_t off = (size_t)(u.pm * BM + ai * HALF + wr * 64 + m * 16 + fr) * DM + col0;
#pragma unroll
                    for (int bj = 0; bj < 2; ++bj)
#pragma unroll
                        for (int n = 0; n < 2; ++n) *(f32x4*)(xout + off + bj * HALF + 4 * n) = xv[m][bj][n] + gv[bj][n] * (acc_f32(acc[ai][bj][m][n]) * rsv[m]); }
                asm volatile("" ::: "memory"); }
            return;
        }
        if (!(MS & 1)) return;
        const int p = pbase + (u.pn >> 3), colt = (u.pn & 7) * BM;
        int lg = 0; float sc = 1.f; bf16_t* base;
        const bool pr_nostore = mode == 4, pr_window = mode == 5, pr_pitch = mode >= 6;
        const int ldo = mode == 6 ? 2112 : DM;
        if (mode == 0 || mode >= 4) { if (p == 9) base = zbuf; else { const int g = p / 3, kind = p - 3 * g; lg = 2 * g; base = qkv + (size_t)p * PART; if (kind == 0) sc = C2Q; } }
        else { if (p == 3) base = zbuf; else { base = qkv + (size_t)p * PART; if (p == 0) sc = C2Q; } }
        const int col0 = colt + wc * 32 + 8 * fq;
        f32x4 cv[2][2];
        if (I8) {
#pragma unroll
            for (int bj = 0; bj < 2; ++bj)
#pragma unroll
                for (int n = 0; n < 2; ++n) cv[bj][n] = *(const f32x4*)(cs + u.pn * BM + wc * 32 + 8 * fq + bj * HALF + 4 * n) * sc;
        }
        float rsa[2][4];
#pragma unroll
        for (int ai = 0; ai < 2; ++ai)
#pragma unroll
            for (int m = 0; m < 4; ++m) rsa[ai][m] = I8 ? rs[u.pm * BM + ai * HALF + wr * 64 + m * 16 + fr] : sc;
#pragma unroll
        for (int ai = 0; ai < 2; ++ai)
#pragma unroll
            for (int m = 0; m < 4; ++m) {
                const int row = u.pm * BM + ai * HALF + wr * 64 + m * 16 + fr, b = row >> 11, t = row & 2047;
                const int R = (b << 11) + ((t & ((1 << lg) - 1)) << (11 - lg)) + (t >> lg);
                bf16_t* rowp = pr_pitch ? (qkv + (size_t)(p % 3) * 4096 * 2112 + (size_t)(R & 4095) * ldo + col0) : (base + (size_t)(pr_window ? (R & 255) : R) * DM + col0);
                const float rsv = rsa[ai][m];
#pragma unroll
                for (int bj = 0; bj < 2; ++bj) { f32x4 v0 = acc_f32(acc[ai][bj][m][0]) * rsv, v1 = acc_f32(acc[ai][bj][m][1]) * rsv;
                    if (I8) { v0 = v0 * cv[bj][0]; v1 = v1 * cv[bj][1]; }
                    u32x4 w; w.x = cvt_pk_bf16(v0[0], v0[1]); w.y = cvt_pk_bf16(v0[2], v0[3]); w.z = cvt_pk_bf16(v1[0], v1[1]); w.w = cvt_pk_bf16(v1[2], v1[3]);
                    if (pr_nostore) asm volatile("" :: "v"(w));
                    else {
#if EPI_SC1
                        asm volatile("global_store_dwordx4 %0, %1, off sc0 sc1\n\ts_nop 1" :: "v"(rowp + bj * HALF), "v"(w) : "memory");
#else
                        *(u32x4*)(rowp + bj * HALF) = w;
#endif
                    } } }
        if (mode == 1 && p == 1) {
#pragma unroll
            for (int bj = 0; bj < 2; ++bj)
#pragma unroll
                for (int n = 0; n < 2; ++n) { f32x4 s = {0.f, 0.f, 0.f, 0.f};
#pragma unroll
                    for (int ai = 0; ai < 2; ++ai)
#pragma unroll
                        for (int m = 0; m < 4; ++m) s += acc_f32(acc[ai][bj][m][n]) * (I8 ? rsa[ai][m] : 1.f);
                    if (I8) s = s * cv[bj][n];
#pragma unroll
                    for (int j = 0; j < 4; ++j) { float v = s[j]; v += sx<1>(v); v += sx<2>(v); v += sx<4>(v); v += sx<8>(v); s[j] = v; }
                    if (fr == 0) *(f32x4*)(ksum + ((size_t)(wr * 32 + u.pm) * DM + colt + bj * HALF + wc * 32 + 8 * fq + 4 * n)) = s; }
        }
    }
};

typedef EpiT<1> EpiIn; typedef EpiT<2> EpiOut;
template <bool I8> struct AccSel { typedef f32x4 type; };
template <> struct AccSel<true> { typedef i32x4 type; };
template <bool I8> __device__ __forceinline__ typename AccSel<I8>::type mma1(bf16x8 b, bf16x8 a, typename AccSel<I8>::type c) {
    if constexpr (I8) return __builtin_amdgcn_mfma_i32_16x16x64_i8(__builtin_bit_cast(i32x4, b), __builtin_bit_cast(i32x4, a), c, 0, 0, 0);
    else return __builtin_amdgcn_mfma_f32_16x16x32_bf16(b, a, c, 0, 0, 0);
}
template <class Epi, class Sched, bool ALIGN_EPI = false, bool SP2 = false, bool I8 = false>
__device__ __forceinline__ void gemm_phase(LAS unsigned char* lds, const Gemm g, const Sched& S, const Epi& E, int wv) {
    const int tid = otid(wv), wid = __builtin_amdgcn_readfirstlane(tid >> 6), lane = tid & 63, wr = wid >> 2, wc = wid & 3, fr = lane & 15, fq = lane >> 4;
    const int KBY = g.KB, nt = KBY / (BK * 2);
    unsigned voffA[2], voffB[2];
#pragma unroll
    for (int i = 0; i < 2; ++i) { int R, C; stage_rc(tid * 16 + i * 8192, R, C); const int Rb = Epi::PERM ? ((R & ~31) + perm32(R & 31)) : R;
        voffA[i] = (unsigned)(R * KBY + C * 2); voffB[i] = (unsigned)(Rb * KBY + C * 2); }
    const size_t kstep = (size_t)(BK * 2);
    const size_t hstep = (size_t)HALF * KBY;
    const size_t tstep = 2 * hstep;
    const unsigned ldsw = (unsigned)wid * 1024u;
    const int aoff = lds_byte(wr * 64 + fr, fq * 8), boff = lds_byte(wc * 32 + fr, fq * 8);
#define PG8_SA(b, h) (((b) * 2 + (h)) * HTB)
#define PG8_SB(b, h) ((4 + (b) * 2 + (h)) * HTB)
#define PG8_STAGE(bufoff, gbase, voff) do { _Pragma("unroll") for (int _i = 0; _i < 2; ++_i) \
        __builtin_amdgcn_global_load_lds((const unsigned*)((const char*)(gbase) + (voff)[_i]), (LAS unsigned*)(lds + (bufoff) + ldsw + _i * 8192), 16, 0, 0); } while (0)
#define PG8_LDA(dst, b, h) do { _Pragma("unroll") for (int m = 0; m < 4; ++m) _Pragma("unroll") for (int k = 0; k < 2; ++k) dst[m][k] = *(const LAS bf16x8*)(lds + PG8_SA(b, h) + aoff + m * 2048 + k * 1024); } while (0)
#define PG8_LDB(dst, b, h) do { _Pragma("unroll") for (int n = 0; n < 2; ++n) _Pragma("unroll") for (int k = 0; k < 2; ++k) dst[n][k] = *(const LAS bf16x8*)(lds + PG8_SB(b, h) + boff + n * 2048 + k * 1024); } while (0)
#define PG8_MMA(ai, bj, At, Bt) do { __builtin_amdgcn_s_setprio(1); _Pragma("unroll") for (int m = 0; m < 4; ++m) _Pragma("unroll") for (int n = 0; n < 2; ++n) _Pragma("unroll") for (int k = 0; k < 2; ++k) \
        acc[ai][bj][m][n] = mma1<I8>(Bt[n][k], At[m][k], acc[ai][bj][m][n]); __builtin_amdgcn_s_setprio(0); } while (0)
#define PG8_WAIT_V(n) asm volatile("s_waitcnt vmcnt(" #n ")" ::: "memory")
#define PG8_WAIT_L(n) asm volatile("s_waitcnt lgkmcnt(" #n ")" ::: "memory")
#define PG8_BAR __builtin_amdgcn_s_barrier()
#define PG8_SCHED __builtin_amdgcn_sched_barrier(0)
    Unit cur, nxt; int ui = 0;
    if (!S.next(0, cur)) return;
    typedef typename AccSel<I8>::type acc_t;
    acc_t acc[2][2][4][2];
#pragma unroll
    for (int a = 0; a < 2; ++a)
#pragma unroll
        for (int b = 0; b < 2; ++b)
#pragma unroll
            for (int m = 0; m < 4; ++m)
#pragma unroll
                for (int n = 0; n < 2; ++n) acc[a][b][m][n] = acc_t{};
    bf16x8 At[4][2], B0[2][2], B1[2][2];
    const char* cA = (const char*)g.A + (size_t)cur.pm * tstep; const char* cB = (const char*)g.Bt + (size_t)cur.pn * tstep;
    S.a_ready(cur);
    if constexpr (SP2) {
        PG8_STAGE(PG8_SB(0, 0), cB, voffB); PG8_STAGE(PG8_SB(0, 1), cB + hstep, voffB); PG8_STAGE(PG8_SA(0, 0), cA, voffA); PG8_STAGE(PG8_SA(0, 1), cA + hstep, voffA);
        if (wr == 1) PG8_BAR;
        PG8_WAIT_V(2); PG8_BAR;
        PG8_STAGE(PG8_SB(1, 0), cB + kstep, voffB); PG8_STAGE(PG8_SA(1, 0), cA + kstep, voffA); PG8_STAGE(PG8_SB(1, 1), cB + hstep + kstep, voffB);
        PG8_WAIT_V(0); PG8_BAR;
    } else {
        PG8_STAGE(PG8_SB(0, 0), cB, voffB); PG8_STAGE(PG8_SA(0, 0), cA, voffA); PG8_STAGE(PG8_SB(0, 1), cB + hstep, voffB); PG8_STAGE(PG8_SA(0, 1), cA + hstep, voffA);
        if (wr == 1) PG8_BAR;
        PG8_WAIT_V(4); PG8_BAR;
        PG8_STAGE(PG8_SB(1, 0), cB + kstep, voffB); PG8_STAGE(PG8_SA(1, 0), cA + kstep, voffA); PG8_STAGE(PG8_SB(1, 1), cB + hstep + kstep, voffB);
        PG8_WAIT_V(6); PG8_BAR;
    }
    for (;;) {
        const bool has_next = S.next(ui + 1, nxt);
        const char* nA = has_next ? (const char*)g.A + (size_t)nxt.pm * tstep : cA; const char* nB = has_next ? (const char*)g.Bt + (size_t)nxt.pn * tstep : cB;
#define PG8_KPAIR_SP2(WA, WB) do {                                                                                                              \
            PG8_LDB(B0, 0, 0); PG8_LDB(B1, 0, 1); PG8_SCHED; PG8_LDA(At, 0, 0); PG8_STAGE(PG8_SA(1, 1), a1 + hstep, voffA);                      \
            PG8_WAIT_V(WA); PG8_WAIT_L(0); PG8_BAR; PG8_MMA(0, 0, At, B0); PG8_MMA(0, 1, At, B1); PG8_BAR; PG8_SCHED;                             \
            PG8_LDA(At, 0, 1); PG8_STAGE(PG8_SB(0, 0), b2, voffB); PG8_STAGE(PG8_SB(0, 1), b2 + hstep, voffB); PG8_STAGE(PG8_SA(0, 0), a2, voffA); \
            PG8_WAIT_V(WB); PG8_WAIT_L(0); PG8_BAR; PG8_MMA(1, 0, At, B0); PG8_MMA(1, 1, At, B1); PG8_BAR; PG8_SCHED;                             \
            PG8_LDB(B0, 1, 0); PG8_LDB(B1, 1, 1); PG8_SCHED; PG8_LDA(At, 1, 0); PG8_STAGE(PG8_SA(0, 1), a2 + hstep, voffA);                      \
            PG8_WAIT_V(8); PG8_WAIT_L(0); PG8_BAR; PG8_MMA(0, 0, At, B0); PG8_MMA(0, 1, At, B1); PG8_BAR; PG8_SCHED;                              \
            PG8_LDA(At, 1, 1); PG8_STAGE(PG8_SB(1, 0), b3, voffB); PG8_STAGE(PG8_SB(1, 1), b3 + hstep, voffB); PG8_STAGE(PG8_SA(1, 0), a3, voffA); \
            PG8_WAIT_V(8); PG8_WAIT_L(0); PG8_BAR; PG8_MMA(1, 0, At, B0); PG8_MMA(1, 1, At, B1); PG8_BAR; PG8_SCHED; } while (0)
        if constexpr (SP2) {
            { const char* a1 = cA + kstep; const char* a2 = cA + 2 * kstep; const char* b2 = cB + 2 * kstep; const char* a3 = a2 + kstep; const char* b3 = b2 + kstep;
              PG8_KPAIR_SP2(18, 24); }
            for (int t = 2; t < nt; t += 2) {
                const bool last = (t == nt - 2);
                const char* a1 = cA + (size_t)(t + 1) * kstep;
                const char* a2 = last ? nA : cA + (size_t)(t + 2) * kstep; const char* b2 = last ? nB : cB + (size_t)(t + 2) * kstep;
                const char* a3 = a2 + kstep; const char* b3 = b2 + kstep;
                if (last && has_next) S.a_ready(nxt);
                PG8_KPAIR_SP2(8, 8);
            }
        } else
        for (int t = 0; t < nt; t += 2) {
            const bool last = (t == nt - 2);
            const char* a1 = cA + (size_t)(t + 1) * kstep;
            const char* a2 = last ? nA : cA + (size_t)(t + 2) * kstep; const char* b2 = last ? nB : cB + (size_t)(t + 2) * kstep;
            const char* a3 = a2 + kstep; const char* b3 = b2 + kstep;
            if (last && has_next) S.a_ready(nxt);
            if constexpr (SP2) {
            PG8_LDB(B0, 0, 0); PG8_LDB(B1, 0, 1); PG8_SCHED; PG8_LDA(At, 0, 0); PG8_STAGE(PG8_SA(1, 1), a1 + hstep, voffA);
            PG8_WAIT_V(8); PG8_WAIT_L(0); PG8_BAR; PG8_MMA(0, 0, At, B0); PG8_MMA(0, 1, At, B1); PG8_BAR; PG8_SCHED;
            PG8_LDA(At, 0, 1); PG8_STAGE(PG8_SB(0, 0), b2, voffB); PG8_STAGE(PG8_SB(0, 1), b2 + hstep, voffB); PG8_STAGE(PG8_SA(0, 0), a2, voffA);
            PG8_WAIT_V(8); PG8_WAIT_L(0); PG8_BAR; PG8_MMA(1, 0, At, B0); PG8_MMA(1, 1, At, B1); PG8_BAR; PG8_SCHED;
            PG8_LDB(B0, 1, 0); PG8_LDB(B1, 1, 1); PG8_SCHED; PG8_LDA(At, 1, 0); PG8_STAGE(PG8_SA(0, 1), a2 + hstep, voffA);
            PG8_WAIT_V(8); PG8_WAIT_L(0); PG8_BAR; PG8_MMA(0, 0, At, B0); PG8_MMA(0, 1, At, B1); PG8_BAR; PG8_SCHED;
            PG8_LDA(At, 1, 1); PG8_STAGE(PG8_SB(1, 0), b3, voffB); PG8_STAGE(PG8_SB(1, 1), b3 + hstep, voffB); PG8_STAGE(PG8_SA(1, 0), a3, voffA);
            PG8_WAIT_V(8); PG8_WAIT_L(0); PG8_BAR; PG8_MMA(1, 0, At, B0); PG8_MMA(1, 1, At, B1); PG8_BAR; PG8_SCHED;
            } else {
            PG8_LDB(B0, 0, 0); PG8_SCHED; PG8_LDA(At, 0, 0); PG8_STAGE(PG8_SA(1, 1), a1 + hstep, voffA);
            PG8_WAIT_L(8); PG8_BAR; PG8_WAIT_L(0); PG8_MMA(0, 0, At, B0); PG8_BAR; PG8_SCHED;
            PG8_LDB(B1, 0, 1); PG8_STAGE(PG8_SB(0, 0), b2, voffB);
            PG8_BAR; PG8_WAIT_L(0); PG8_MMA(0, 1, At, B1); PG8_BAR;
            PG8_LDA(At, 0, 1); PG8_STAGE(PG8_SA(0, 0), a2, voffA);
            PG8_BAR; PG8_WAIT_L(0); PG8_MMA(1, 0, At, B0); PG8_BAR; PG8_SCHED;
            PG8_STAGE(PG8_SB(0, 1), b2 + hstep, voffB);
            PG8_WAIT_V(6); PG8_BAR; PG8_MMA(1, 1, At, B1); PG8_BAR;
            PG8_LDB(B0, 1, 0); PG8_SCHED; PG8_LDA(At, 1, 0); PG8_STAGE(PG8_SA(0, 1), a2 + hstep, voffA);
            PG8_WAIT_L(8); PG8_BAR; PG8_WAIT_L(0); PG8_MMA(0, 0, At, B0); PG8_BAR; PG8_SCHED;
            PG8_LDB(B1, 1, 1); PG8_STAGE(PG8_SB(1, 0), b3, voffB);
            PG8_BAR; PG8_WAIT_L(0); PG8_MMA(0, 1, At, B1); PG8_BAR;
            PG8_LDA(At, 1, 1); PG8_STAGE(PG8_SA(1, 0), a3, voffA);
            PG8_BAR; PG8_WAIT_L(0); PG8_MMA(1, 0, At, B0); PG8_BAR; PG8_SCHED;
            PG8_STAGE(PG8_SB(1, 1), b3 + hstep, voffB);
            PG8_WAIT_V(6); PG8_BAR; PG8_MMA(1, 1, At, B1); PG8_BAR;
            }
        }
        if constexpr (ALIGN_EPI) { if (wr == 0) PG8_BAR; }
        if constexpr (SP2) { if (has_next) PG8_WAIT_V(0); }
        if constexpr (!Epi::AFTER_DRAIN) { int fr2 = fr, fq2 = fq; asm volatile("" : "+v"(fr2), "+v"(fq2));
            E(acc, cur, wr, wc, fr2, fq2); S.done(cur); }
        if (!has_next) break;
#pragma unroll
        for (int a = 0; a < 2; ++a)
#pragma unroll
            for (int b = 0; b < 2; ++b)
#pragma unroll
                for (int m = 0; m < 4; ++m)
#pragma unroll
                    for (int n = 0; n < 2; ++n) acc[a][b][m][n] = acc_t{};
        cur = nxt; cA = nA; cB = nB; ++ui;
        if constexpr (ALIGN_EPI) { if (wr == 1) PG8_BAR; }
    }
    PG8_WAIT_V(0);
    if constexpr (!ALIGN_EPI) { if (wr == 0) PG8_BAR; }
    PG8_BAR;
#undef PG8_KPAIR_SP2
#undef PG8_SA
#undef PG8_SB
#undef PG8_STAGE
#undef PG8_LDA
#undef PG8_LDB
#undef PG8_MMA
#undef PG8_WAIT_V
#undef PG8_WAIT_L
#undef PG8_BAR
#undef PG8_SCHED
}
}

struct Params {
    const float *x, *c, *norm_w, *mod_w, *mod_b, *a_w_in, *a_w_out, *b_w_in, *b_w_out, *final_w;
    float* out; unsigned char* ws;
};

typedef const __attribute__((address_space(4))) Params CParams;
__device__ __forceinline__ CParams& PP() { CParams* p = (CParams*)__builtin_amdgcn_kernarg_segment_ptr(); asm volatile("" : "+s"(p)); return *p; }

__device__ __forceinline__ void p0_mod(unsigned char* lds, int wv) {
    CParams& P = PP();
    const int tid = otid(wv);
    f32x4* condT = (f32x4*)lds;
    float* red = (float*)(lds + 32768);
    float* MOD = (float*)(P.ws + WS_MOD);
    bool have = false;
    for (int item = obid(); item < 768; item += gridDim.x) {
        if (!have) { have = true;
            for (int k = tid; k < DM; k += NTHREADS) { f32x4 v; v.x = silu_f(P.c[k]); v.y = silu_f(P.c[DM + k]); v.z = silu_f(P.c[2 * DM + k]); v.w = silu_f(P.c[3 * DM + k]); condT[k] = v; }
            __syncthreads(); }
        const int l = item / 192, n0 = (item % 192) * 32, cq = tid & 7, kp = tid >> 3;
        f32x4 a0 = {0.f, 0.f, 0.f, 0.f}, a1 = a0, a2 = a0, a3 = a0;
        const float* wp = P.mod_w + ((size_t)l * DM + kp * 32) * 6144 + n0 + 4 * cq;
#pragma unroll 16
        for (int k = 0; k < 32; ++k) { const f32x4 w = *(const f32x4*)(wp + (size_t)k * 6144); const f32x4 cv = condT[kp * 32 + k];
            a0 += w * cv.x; a1 += w * cv.y; a2 += w * cv.z; a3 += w * cv.w; }
        *(f32x4*)(red + (kp * 4 + 0) * 32 + 4 * cq) = a0; *(f32x4*)(red + (kp * 4 + 1) * 32 + 4 * cq) = a1;
        *(f32x4*)(red + (kp * 4 + 2) * 32 + 4 * cq) = a2; *(f32x4*)(red + (kp * 4 + 3) * 32 + 4 * cq) = a3;
        __syncthreads();
        if (tid < 128) { const int b = tid >> 5, col = tid & 31; float s = P.mod_b[l * 6144 + n0 + col];
#pragma unroll 8
            for (int q = 0; q < 64; ++q) s += red[(q * 4 + b) * 32 + col];
            MOD[(l * 4 + b) * 6144 + n0 + col] = s; }
        __syncthreads();
    }
}
__device__ __forceinline__ void p0_transpose_item(const float* W, int ldn, int ncol0, int nblk, bf16_t* WT, unsigned char* scr, int item, int lane) {
    const int kb = item / nblk, nb = item - kb * nblk, k0 = kb * 64, n0 = nb * 64;
    const float* src = W + (size_t)(k0 + (lane >> 4)) * ldn + ncol0 + n0 + 4 * (lane & 15);
#pragma unroll 4
    for (int i = 0; i < 16; ++i) { const f32x4 v = *(const f32x4*)(src + (size_t)(4 * i) * ldn);
        unsigned* d = (unsigned*)(scr + (4 * i + (lane >> 4)) * 132 + 8 * (lane & 15));
        d[0] = cvt_pk_bf16(v.x, v.y); d[1] = cvt_pk_bf16(v.z, v.w); }
    LDS_WAIT();
    const int c = lane & 7;
#pragma unroll
    for (int j = 0; j < 8; ++j) { const int n = (lane >> 3) + 8 * j; const unsigned short* s = (const unsigned short*)(scr + (8 * c) * 132 + 2 * n);
        u32x4 o;
        o.x = (unsigned)s[0 * 66] | ((unsigned)s[1 * 66] << 16); o.y = (unsigned)s[2 * 66] | ((unsigned)s[3 * 66] << 16);
        o.z = (unsigned)s[4 * 66] | ((unsigned)s[5 * 66] << 16); o.w = (unsigned)s[6 * 66] | ((unsigned)s[7 * 66] << 16);
        *(u32x4*)(WT + (size_t)(n0 + n) * DM + k0 + 8 * c) = o; }
    LDS_WAIT();
}
__device__ __forceinline__ void p0_panel_i8(const float* W, int ldn, int n0, signed char* WT, float* cs, unsigned char* lds, int tid) {
    const int lane = tid & 63, wave = __builtin_amdgcn_readfirstlane(tid >> 6);
    float* maxbuf = (float*)(lds + 131072);
    f32x4 mx = {0.f, 0.f, 0.f, 0.f};
    { const float* src = W + (size_t)(wave * 256 + (lane >> 3)) * ldn + n0 + 4 * (lane & 7);
      unsigned char* dst = lds + (size_t)(wave * 256 + (lane >> 3)) * 64 + 8 * (lane & 7);
#pragma unroll 16
      for (int i = 0; i < 32; ++i) { const f32x4 v = *(const f32x4*)(src + (size_t)(8 * i) * ldn);
          mx.x = fmaxf(mx.x, fabsf(v.x)); mx.y = fmaxf(mx.y, fabsf(v.y)); mx.z = fmaxf(mx.z, fabsf(v.z)); mx.w = fmaxf(mx.w, fabsf(v.w));
          u32x2 w; w.x = cvt_pk_bf16(v.x, v.y); w.y = cvt_pk_bf16(v.z, v.w); *(u32x2*)(dst + (size_t)(8 * i) * 64) = w; } }
#pragma unroll
    for (int q = 0; q < 4; ++q) { float v = mx[q]; v = fmaxf(v, sx<8>(v)); v = fmaxf(v, sx<16>(v)); { auto r = __builtin_amdgcn_permlane32_swap(__float_as_uint(v), __float_as_uint(v), false, false); v = fmaxf(__uint_as_float(r[0]), __uint_as_float(r[1])); } mx[q] = v; }
    if (lane < 8) *(f32x4*)(maxbuf + wave * 32 + 4 * lane) = mx;
    __syncthreads();
    { const int n = tid & 31, kc = tid >> 5;
      float cm = maxbuf[n];
#pragma unroll
      for (int w = 1; w < 8; ++w) cm = fmaxf(cm, maxbuf[w * 32 + n]);
      const float inv = cm > 0.f ? 127.f / cm : 0.f;
      if (kc == 0) cs[n0 + n] = cm > 0.f ? cm * (1.f / 127.f) : 1.f;
      const unsigned short* t = (const unsigned short*)lds + (size_t)(kc * 128) * 32 + n;
      signed char* orow = WT + (size_t)(n0 + n) * DM + kc * 128;
#pragma unroll 2
      for (int i = 0; i < 8; ++i) { unsigned w[4];
#pragma unroll
          for (int q = 0; q < 4; ++q) { unsigned acc = 0;
#pragma unroll
              for (int e = 0; e < 4; ++e) { const float v = bf2f(t[(size_t)(16 * i + 4 * q + e) * 32]) * inv; int iv = (int)rintf(v); iv = iv > 127 ? 127 : (iv < -127 ? -127 : iv); acc |= ((unsigned)iv & 0xffu) << (8 * e); }
              w[q] = acc; }
          *(u32x4*)(orow + 16 * i) = (u32x4){w[0], w[1], w[2], w[3]}; } }
    __syncthreads();
}
__device__ __forceinline__ void p0_weights(unsigned char* lds, int wv) {
    CParams& P = PP();
    const int tid_ = otid(wv); const int lane = tid_ & 63, wave = __builtin_amdgcn_readfirstlane(tid_ >> 6);
    constexpr int PA = A_N / 32, PB = (MOBA_QK_I8 ? B_N : 4096) / 32, PO = DM / 32, NPANEL = 2 * PA + 2 * PB + (OUTA_I8 ? 2 * PO : 0);
    for (int it = obid(); it < NPANEL; it += gridDim.x) {
        if (it < 2 * PA) { const int j = it / PA, pnl = it - j * PA;
            p0_panel_i8(P.a_w_in + (size_t)j * DM * A_N, A_N, pnl * 32, (signed char*)(P.ws + WS_WAIN) + (size_t)j * A_N * DM, (float*)(P.ws + WS_CSA) + j * A_N, lds, tid_); }
        else if (it < 2 * PA + 2 * PB) { const int r = it - 2 * PA, j = r / PB, pnl = r - j * PB;
#if MOBA_QK_I8
            p0_panel_i8(P.b_w_in + (size_t)j * DM * B_N, B_N, pnl * 32, (signed char*)(P.ws + WS_WBQK) + (size_t)j * B_N * DM, (float*)(P.ws + WS_CSB) + j * B_N, lds, tid_); }
#else
            p0_panel_i8(P.b_w_in + (size_t)j * DM * B_N + 4096, B_N, pnl * 32, (signed char*)(P.ws + WS_WBVZ) + (size_t)j * 4096 * DM, (float*)(P.ws + WS_CSB) + j * 4096, lds, tid_); }
#endif
#if OUTA_I8
        else { const int r = it - 2 * PA - 2 * PB, j = r / PO, pnl = r - j * PO;
            p0_panel_i8(P.a_w_out + (size_t)j * DM * DM, DM, pnl * 32, (signed char*)(P.ws + WS_WAOUT) + (size_t)j * DM * DM, (float*)(P.ws + WS_CSO) + j * DM, lds, tid_); }
#endif
    }
    unsigned char* scr = lds + 65536 + wave * 8448;
    const int gw = obid() * 8 + wave, NGW = gridDim.x * 8;
    constexpr int I_B = MOBA_QK_I8 ? 0 : 32 * 64, I_O = 32 * 32, I_AO = OUTA_I8 ? 0 : 32 * 32, TOTAL = 2 * I_B + 2 * I_AO + 2 * I_O;
    for (int it = gw; it < TOTAL; it += NGW) {
        int r = it;
        if (I_B > 0 && r < 2 * I_B) { const int j = r / (I_B > 0 ? I_B : 1); p0_transpose_item(P.b_w_in + (size_t)j * DM * B_N, B_N, 0, 64, (bf16_t*)(P.ws + WS_WBQK) + (size_t)j * 4096 * DM, scr, r - j * I_B, lane); continue; } r -= 2 * I_B;
        if (I_AO > 0 && r < 2 * I_AO) { const int j = r / (I_AO > 0 ? I_AO : 1); p0_transpose_item(P.a_w_out + (size_t)j * DM * DM, DM, 0, 32, (bf16_t*)(P.ws + WS_WAOUT) + (size_t)j * DM * DM, scr, r - j * I_AO, lane); continue; } r -= 2 * I_AO;
        { const int j = r / I_O; p0_transpose_item(P.b_w_out + (size_t)j * DM * DM, DM, 0, 32, (bf16_t*)(P.ws + WS_WBOUT) + (size_t)j * DM * DM, scr, r - j * I_O, lane); }
    }
}

__device__ __forceinline__ void norm_phase(int layer, bool want_bf16, int wv) {
    CParams& P = PP(); const float* xin = layer == 0 ? P.x : P.out;
    const int tid_ = otid(wv); const int lane = tid_ & 63, wave = __builtin_amdgcn_readfirstlane(tid_ >> 6);
    const int gw = obid() * 8 + wave, NGW = gridDim.x * 8;
    const float* MOD = (const float*)(P.ws + WS_MOD);
    bf16_t* Hb = (bf16_t*)(P.ws + WS_H); unsigned char* Hq = P.ws + WS_HQ; float* RS = (float*)(P.ws + WS_RS);
    for (int r0 = gw * 4; r0 < MTOK; r0 += NGW * 4) {
        const int b = r0 >> 11;
        const float* shift = MOD + (size_t)(layer * 4 + b) * 6144; const float* scale = shift + DM; const float* nw = P.norm_w + layer * DM;
        f32x4 ca[8], cs[8];
#pragma unroll
        for (int j = 0; j < 8; ++j) { const int c = 4 * lane + 256 * j; const f32x4 w = *(const f32x4*)(nw + c), s = *(const f32x4*)(scale + c); ca[j] = w * (s + 1.f); cs[j] = *(const f32x4*)(shift + c); }
        for (int rr = 0; rr < 4; ++rr) {
            const float* xr = xin + (size_t)(r0 + rr) * DM; f32x4 v[8]; float ss = 0.f;
#pragma unroll
            for (int j = 0; j < 8; ++j) { v[j] = *(const f32x4*)(xr + 4 * lane + 256 * j); ss += (v[j].x * v[j].x + v[j].y * v[j].y) + (v[j].z * v[j].z + v[j].w * v[j].w); }
            const float rs = 1.0f / sqrtf(wave_sum(ss) * (1.f / DM) + EPS);
            float am = 0.f;
#pragma unroll
            for (int j = 0; j < 8; ++j) { v[j] = v[j] * rs * ca[j] + cs[j]; am = fmaxf(am, fmaxf(fmaxf(fabsf(v[j].x), fabsf(v[j].y)), fmaxf(fabsf(v[j].z), fabsf(v[j].w)))); }
            am = wave_max(am);
            const float inv = am > 0.f ? 127.f / am : 0.f;
            if (lane == 0) RS[r0 + rr] = am > 0.f ? am * (1.f / 127.f) : 1.f;
            unsigned char* qr = Hq + (size_t)(r0 + rr) * DM;
#pragma unroll
            for (int j = 0; j < 8; ++j) { const f32x4 h = v[j] * inv;
                const int i0 = (int)rintf(h.x), i1 = (int)rintf(h.y), i2 = (int)rintf(h.z), i3 = (int)rintf(h.w);
                *(unsigned*)(qr + 4 * lane + 256 * j) = ((unsigned)i0 & 0xffu) | (((unsigned)i1 & 0xffu) << 8) | (((unsigned)i2 & 0xffu) << 16) | (((unsigned)i3 & 0xffu) << 24); }
            if (want_bf16) { bf16_t* hr = Hb + (size_t)(r0 + rr) * DM;
#pragma unroll
                for (int j = 0; j < 8; ++j) { u32x2 w; w.x = cvt_pk_bf16(v[j].x, v[j].y); w.y = cvt_pk_bf16(v[j].z, v[j].w); *(u32x2*)(hr + 4 * lane + 256 * j) = w; } }
        }
    }
}
__device__ __forceinline__ void final_norm_phase(int wv) {
    CParams& P = PP();
    const int tid_ = otid(wv); const int lane = tid_ & 63, wave = __builtin_amdgcn_readfirstlane(tid_ >> 6);
    const int gw = obid() * 8 + wave, NGW = gridDim.x * 8;
    f32x4 cw[8];
#pragma unroll
    for (int j = 0; j < 8; ++j) cw[j] = *(const f32x4*)(P.final_w + 4 * lane + 256 * j);
    for (int r = gw; r < MTOK; r += NGW) {
        float* xr = P.out + (size_t)r * DM; f32x4 v[8]; float ss = 0.f;
#pragma unroll
        for (int j = 0; j < 8; ++j) { v[j] = *(const f32x4*)(xr + 4 * lane + 256 * j); ss += (v[j].x * v[j].x + v[j].y * v[j].y) + (v[j].z * v[j].z + v[j].w * v[j].w); }
        const float rs = 1.0f / sqrtf(wave_sum(ss) * (1.f / DM) + EPS);
#pragma unroll
        for (int j = 0; j < 8; ++j) *(f32x4*)(xr + 4 * lane + 256 * j) = v[j] * rs * cw[j];
    }
}

__device__ __forceinline__ void naive_attend(const bf16_t* Kh, const bf16_t* Vh, const float* qf, float* sc, int own_start, int own_len, int blkbase, int mask, int qpos, float slopeL, int lane,
                                             float& o0, float& o1, float& lse2) {
    int base = 0; float mx = -3.0e38f;
    { int m2 = mask;
      for (int rr = 0;; ++rr) { int start, len;
        if (rr == 0) { start = own_start; len = own_len; } else { if (!m2) break; const int j = __builtin_ctz(m2); m2 &= m2 - 1; start = blkbase + (j << 8); len = 256; }
        for (int i = lane; i < len; i += 64) { const int key = start + i; const u32x4* kp = (const u32x4*)(Kh + (size_t)key * DM); float dot = 0.f;
#pragma unroll 4
            for (int cch = 0; cch < 16; ++cch) { const u32x4 w = kp[cch]; const float* q = qf + cch * 8;
                dot += q[0] * bflo(w.x) + q[1] * bfhi(w.x) + q[2] * bflo(w.y) + q[3] * bfhi(w.y) + q[4] * bflo(w.z) + q[5] * bfhi(w.z) + q[6] * bflo(w.w) + q[7] * bfhi(w.w); }
            const float s = dot + slopeL * (float)(key - qpos); sc[base + i] = s; mx = fmaxf(mx, s); }
        base += len; } }
    const int tot = base; mx = wave_max(mx);
    LDS_WAIT();
    float sum = 0.f;
    for (int i = lane; i < tot; i += 64) { const float p = exp2f(sc[i] - mx); sc[i] = p; sum += p; }
    sum = wave_sum(sum);
    LDS_WAIT();
    float a0 = 0.f, a1 = 0.f; base = 0;
    { int m2 = mask;
      for (int rr = 0;; ++rr) { int start, len;
        if (rr == 0) { start = own_start; len = own_len; } else { if (!m2) break; const int j = __builtin_ctz(m2); m2 &= m2 - 1; start = blkbase + (j << 8); len = 256; }
        const bf16_t* vp = Vh + (size_t)start * DM + 2 * lane;
        for (int i = 0; i < len; ++i) { const float p = sc[base + i]; const unsigned w = *(const unsigned*)(vp + (size_t)i * DM); a0 += p * bflo(w); a1 += p * bfhi(w); }
        base += len; } }
    LDS_WAIT();
    const float inv = 1.f / sum; o0 = a0 * inv; o1 = a1 * inv; lse2 = mx + log2f(sum);
}
__device__ __forceinline__ float slope_of(int h) { return exp2f(-0.5f * (float)(h + 1)); }

__device__ __forceinline__ void attn_a_naive(unsigned char* lds, int wv) {
    CParams& P = PP();
    const int tid_ = otid(wv); const int lane = tid_ & 63, wave = __builtin_amdgcn_readfirstlane(tid_ >> 6);
    float* qf = (float*)(lds + wave * 8192); float* sc = qf + 128;
    const bf16_t* QKV = (const bf16_t*)(P.ws + WS_QKV); bf16_t* OG = (bf16_t*)(P.ws + WS_OG); float* LSE = (float*)(P.ws + WS_LSE);
    const int gw = obid() * 8 + wave, NGW = gridDim.x * 8;
    for (int it = gw; it < 3 * MTOK * NH; it += NGW) {
        const int h = it & 15, R = (it >> 4) & (MTOK - 1), g = it >> 17;
        const int lg = 2 * g, L = SEQ >> lg;
        const bf16_t* Qp = QKV + (size_t)(3 * g) * PART + (size_t)R * DM + h * HD;
        { const unsigned w = *(const unsigned*)(Qp + 2 * lane); qf[2 * lane] = bflo(w); qf[2 * lane + 1] = bfhi(w); }
        LDS_WAIT();
        const int seq0 = R & ~(L - 1); int lo = R - 128; if (lo < seq0) lo = seq0;
        float o0, o1, lse2;
        naive_attend(QKV + (size_t)(3 * g + 1) * PART + h * HD, QKV + (size_t)(3 * g + 2) * PART + h * HD, qf, sc, lo, R - lo + 1, 0, 0, R, slope_of(h) * (float)(1 << lg) * LOG2E, lane, o0, o1, lse2);
        *(unsigned*)(OG + (size_t)g * PART + (size_t)R * DM + h * HD + 2 * lane) = cvt_pk_bf16(o0, o1);
        if (lane == 0) LSE[((size_t)g * MTOK + R) * NH + h] = lse2;
    }
}
__device__ __forceinline__ void combine_phase(int wv) {
    CParams& P = PP();
    const int tid_ = otid(wv); const int lane = tid_ & 63, wave = __builtin_amdgcn_readfirstlane(tid_ >> 6);
    const int gw = obid() * 8 + wave, NGW = gridDim.x * 8;
    const bf16_t* OG = (const bf16_t*)(P.ws + WS_OG); const float* LSE = (const float*)(P.ws + WS_LSE); const bf16_t* Z = (const bf16_t*)(P.ws + WS_Z);
    unsigned char* GQ = P.ws + WS_HQ; float* RS = (float*)(P.ws + WS_RS);
    for (int m = gw; m < MTOK; m += NGW) {
        const int b = m >> 11, t = m & 2047;
        const int R0 = m, R1 = (b << 11) + ((t & 3) << 9) + (t >> 2), R2 = (b << 11) + ((t & 15) << 7) + (t >> 4);
        float v[4][8]; float am = 0.f, sq = 0.f;
#pragma unroll
        for (int j = 0; j < 4; ++j) { const int col = 8 * lane + 512 * j, h = col >> 7;
            const float l0 = LSE[((size_t)0 * MTOK + R0) * NH + h], l1 = LSE[((size_t)1 * MTOK + R1) * NH + h], l2 = LSE[((size_t)2 * MTOK + R2) * NH + h];
            const float mx = fmaxf(l0, fmaxf(l1, l2)); float e0 = exp2f(l0 - mx), e1 = exp2f(l1 - mx), e2 = exp2f(l2 - mx); const float inv = 1.f / (e0 + e1 + e2); e0 *= inv; e1 *= inv; e2 *= inv;
            const u32x4 a = *(const u32x4*)(OG + (size_t)R0 * DM + col), bb = *(const u32x4*)(OG + PART + (size_t)R1 * DM + col), cc = *(const u32x4*)(OG + 2 * PART + (size_t)R2 * DM + col);
            const u32x4 zz = *(const u32x4*)(Z + (size_t)m * DM + col);
#define CMB(F, I) { v[j][I] = (e0 * bflo(a.F) + e1 * bflo(bb.F) + e2 * bflo(cc.F)) * silu_f(bflo(zz.F)); v[j][I + 1] = (e0 * bfhi(a.F) + e1 * bfhi(bb.F) + e2 * bfhi(cc.F)) * silu_f(bfhi(zz.F)); \
                    am = fmaxf(am, fmaxf(fabsf(v[j][I]), fabsf(v[j][I + 1]))); sq += v[j][I] * v[j][I] + v[j][I + 1] * v[j][I + 1]; }
            CMB(x, 0) CMB(y, 2) CMB(z, 4) CMB(w, 6)
#undef CMB
        }
#if !OUTA_I8
        { bf16_t* Gr = (bf16_t*)(P.ws + WS_G) + (size_t)m * DM;
#pragma unroll
          for (int j = 0; j < 4; ++j) { u32x4 o; o.x = cvt_pk_bf16(v[j][0], v[j][1]); o.y = cvt_pk_bf16(v[j][2], v[j][3]); o.z = cvt_pk_bf16(v[j][4], v[j][5]); o.w = cvt_pk_bf16(v[j][6], v[j][7]); *(u32x4*)(Gr + 8 * lane + 512 * j) = o; }
          continue; }
#endif
        am = wave_max(am); sq = wave_sum(sq);
        am = fminf(am, GCLIP * sqrtf(sq * (1.f / DM)));
        const float inv = am > 0.f ? 127.f / am : 0.f;
        if (lane == 0) RS[m] = am > 0.f ? am * (1.f / 127.f) : 1.f;
#pragma unroll
        for (int j = 0; j < 4; ++j) { unsigned w0 = 0, w1 = 0;
#pragma unroll
            for (int e = 0; e < 4; ++e) { w0 |= ((unsigned)(int)rintf(fminf(fmaxf(v[j][e] * inv, -127.f), 127.f)) & 0xffu) << (8 * e); w1 |= ((unsigned)(int)rintf(fminf(fmaxf(v[j][4 + e] * inv, -127.f), 127.f)) & 0xffu) << (8 * e); }
            *(u32x2*)(GQ + (size_t)m * DM + 8 * lane + 512 * j) = (u32x2){w0, w1}; }
    }
}
__device__ __forceinline__ void attn_b_naive(unsigned char* lds, int wv) {
    CParams& P = PP();
    const int tid_ = otid(wv); const int lane = tid_ & 63, wave = __builtin_amdgcn_readfirstlane(tid_ >> 6);
    float* qf = (float*)(lds + wave * 8192); float* sc = qf + 128;
    const bf16_t* QKV = (const bf16_t*)(P.ws + WS_QKV); const bf16_t* Z = (const bf16_t*)(P.ws + WS_Z); bf16_t* G = (bf16_t*)(P.ws + WS_G); const float* KS = (const float*)(P.ws + WS_KSUM);
    const int gw = obid() * 8 + wave, NGW = gridDim.x * 8;
    for (int it = gw; it < MTOK * NH; it += NGW) {
        const int h = it & 15, m = it >> 4, b = m >> 11, t = m & 2047, n = t >> 8;
        const bf16_t* Qp = QKV + (size_t)m * DM + h * HD;
        float q0, q1; { const unsigned w = *(const unsigned*)(Qp + 2 * lane); q0 = bflo(w); q1 = bfhi(w); qf[2 * lane] = q0; qf[2 * lane + 1] = q1; }
        LDS_WAIT();
        float gt[8];
#pragma unroll
        for (int j = 0; j < 8; ++j) { float v = 0.f;
            if (j < n) { const float* k0 = KS + (size_t)(b * 8 + j) * DM + h * HD + 2 * lane; const float* k1 = k0 + (size_t)32 * DM; v = q0 * (k0[0] + k1[0]) + q1 * (k0[1] + k1[1]); }
            gt[j] = wave_sum(v); }
        int mask = 0;
#pragma unroll
        for (int j = 0; j < 8; ++j) { if (j < n) { int rank = 0;
#pragma unroll
                for (int j2 = 0; j2 < 8; ++j2) if (j2 < n && (gt[j2] > gt[j] || (gt[j2] == gt[j] && j2 < j))) ++rank;
                if (rank < 3) mask |= 1 << j; } }
        float o0, o1, lse2;
        naive_attend(QKV + PART + h * HD, QKV + 2 * PART + h * HD, qf, sc, (b << 11) + (n << 8), (t & 255) + 1, b << 11, mask, m, slope_of(h) * LOG2E, lane, o0, o1, lse2);
        const unsigned zw = *(const unsigned*)(Z + (size_t)m * DM + h * HD + 2 * lane);
        *(unsigned*)(G + (size_t)m * DM + h * HD + 2 * lane) = cvt_pk_bf16(o0 * silu_f(bflo(zw)), o1 * silu_f(bfhi(zw)));
    }
}

namespace fa {
constexpr int KVBLK = 64, SHM_K = KVBLK * HD * 2, SHM_V = KVBLK * HD * 2;
constexpr int OFF_V = 0, OFF_K = 2 * SHM_V, OFF_WS = OFF_K + 2 * SHM_K, OFF_OST = OFF_WS + 8 * 256, OST_ROW = 272, OST_WAVE = 32 * OST_ROW;
constexpr int OFF_GK = OFF_OST + 8 * OST_WAVE, OFF_SEL = OFF_GK + 7 * 128 * 4, OFF_END = OFF_SEL + 256 * 4;
static_assert(OFF_END <= LDS_BYTES - 1024, "attention LDS map");
constexpr float THR = 11.5f;
#define KSWZ(row, colB) ((row) * 256 + ((colB) ^ (((row) & 7) << 4)))
#define SBAR() __builtin_amdgcn_sched_barrier(0)
__device__ __forceinline__ int v_st(int k, int c) { const int kk = (k & ~0xC) | ((k & 4) << 1) | ((k & 8) >> 1); return ((kk >> 3) * 4 + (c >> 5)) * 512 + ((kk & 7) * 32 + (c & 31)) * 2; }
__device__ __forceinline__ int v_rd_base(int lane) { return ((lane & 3) << 3) | (((lane >> 2) & 3) << 6) | (((lane >> 4) & 1) << 5) | (((lane >> 5) & 1) << 8); }
constexpr int v_rd_off(int d0, int ks, int half) { return d0 * 512 + ks * 4096 + half * 2048; }
__device__ __forceinline__ int crow(int r, int hi) { return (r & 3) + 8 * (r >> 2) + 4 * hi; }
__device__ __forceinline__ void mask_tile(f32x16& p0, f32x16& p1, int dq, unsigned W) {
    const float NEG = -__builtin_inff();
#pragma unroll
    for (int r = 0; r < 16; ++r) { const int c = (r & 3) + 8 * (r >> 2);
        if ((unsigned)(dq - c) >= W) p0[r] = NEG;
        if ((unsigned)(dq - c - 32) >= W) p1[r] = NEG; }
}
__device__ __forceinline__ void partialSM(f32x16& p0, f32x16& p1, float& m_reg, float& alpha) {
    float pmax = p0[0];
#pragma unroll
    for (int r = 1; r < 16; ++r) pmax = fmaxf(pmax, p0[r]);
#pragma unroll
    for (int r = 0; r < 16; ++r) pmax = fmaxf(pmax, p1[r]);
    { auto rr = __builtin_amdgcn_permlane32_swap(__float_as_uint(pmax), __float_as_uint(pmax), false, false); pmax = fmaxf(__uint_as_float(rr[0]), __uint_as_float(rr[1])); }
    float mn;
    if (__builtin_expect(__all(pmax - m_reg <= THR), 1)) { mn = m_reg; alpha = 1.f; }
    else { mn = fmaxf(m_reg, pmax); alpha = __builtin_amdgcn_exp2f(m_reg - mn); m_reg = mn; }
#pragma unroll
    for (int r = 0; r < 16; ++r) p0[r] = __builtin_amdgcn_exp2f(p0[r] - mn);
#pragma unroll
    for (int r = 0; r < 16; ++r) p1[r] = __builtin_amdgcn_exp2f(p1[r] - mn);
}
__device__ __forceinline__ void finishSM(f32x16& p0, f32x16& p1, float alpha, float& l_reg, bf16x8& pa0, bf16x8& pa1, bf16x8& pa2, bf16x8& pa3) {
    float ps = 0;
#pragma unroll
    for (int r = 0; r < 16; ++r) ps += p0[r];
#pragma unroll
    for (int r = 0; r < 16; ++r) ps += p1[r];
    { auto rr = __builtin_amdgcn_permlane32_swap(__float_as_uint(ps), __float_as_uint(ps), false, false); ps = __uint_as_float(rr[0]) + __uint_as_float(rr[1]); }
    l_reg = l_reg * alpha + ps;
#define PK4(P, B_, OUT) do { unsigned a0 = cvt_pk_bf16(P[B_+0], P[B_+1]), a1 = cvt_pk_bf16(P[B_+2], P[B_+3]);                          \
        unsigned b0 = cvt_pk_bf16(P[B_+4], P[B_+5]), b1 = cvt_pk_bf16(P[B_+6], P[B_+7]);                                             \
        auto r0 = __builtin_amdgcn_permlane32_swap(a0, b0, false, false); auto r1 = __builtin_amdgcn_permlane32_swap(a1, b1, false, false); \
        u32x4 w = {r0[0], r1[0], r0[1], r1[1]}; OUT = *reinterpret_cast<bf16x8*>(&w); } while (0)
    PK4(p0, 0, pa0); PK4(p0, 8, pa1); PK4(p1, 0, pa2); PK4(p1, 8, pa3);
#undef PK4
}
template <int KB>
__device__ __forceinline__ void qkt(f32x16& p0, f32x16& p1, const LAS char* K_lds, int r32, int hi, const bf16x8* qr) {
    const LAS char* kb[4];
#pragma unroll
    for (int dd = 0; dd < 4; ++dd) kb[dd] = K_lds + KB * SHM_K + KSWZ(r32, (dd * 16 + hi * 8) * 2);
#pragma unroll
    for (int d0 = 0; d0 < 8; ++d0) { const LAS char* a = kb[d0 & 3] + (d0 >> 2) * 128;
        const bf16x8 b0 = *reinterpret_cast<const LAS bf16x8*>(a);
        const bf16x8 b1 = *reinterpret_cast<const LAS bf16x8*>(a + 32 * 256);
        p0 = __builtin_amdgcn_mfma_f32_32x32x16_bf16(b0, qr[d0], p0, 0, 0, 0);
        p1 = __builtin_amdgcn_mfma_f32_32x32x16_bf16(b1, qr[d0], p1, 0, 0, 0); }
}
template <int VB>
__device__ __forceinline__ void pv_tile(f32x16* o, int vb0, bf16x8 pa0, bf16x8 pa1, bf16x8 pa2, bf16x8 pa3) {
#define TRRD(dst, off) asm volatile("ds_read_b64_tr_b16 %0, %1 offset:%2" : "=&v"(dst) : "v"(vb0), "i"(off) : "memory")
#define PV_D0(d0) do { s16x4 l0, l1, l2, l3, h0, h1, h2, h3; constexpr int b_ = VB * SHM_V + v_rd_off(d0, 0, 0); \
        TRRD(l0, b_); TRRD(h0, b_ + 2048); TRRD(l1, b_ + 4096); TRRD(h1, b_ + 6144); TRRD(l2, b_ + 8192); TRRD(h2, b_ + 10240); TRRD(l3, b_ + 12288); TRRD(h3, b_ + 14336); \
        asm volatile("s_waitcnt lgkmcnt(0)" ::: "memory"); SBAR();   \
        o[d0] = __builtin_amdgcn_mfma_f32_32x32x16_bf16(pa0, (bf16x8){l0[0], l0[1], l0[2], l0[3], h0[0], h0[1], h0[2], h0[3]}, o[d0], 0, 0, 0);   \
        o[d0] = __builtin_amdgcn_mfma_f32_32x32x16_bf16(pa1, (bf16x8){l1[0], l1[1], l1[2], l1[3], h1[0], h1[1], h1[2], h1[3]}, o[d0], 0, 0, 0);   \
        o[d0] = __builtin_amdgcn_mfma_f32_32x32x16_bf16(pa2, (bf16x8){l2[0], l2[1], l2[2], l2[3], h2[0], h2[1], h2[2], h2[3]}, o[d0], 0, 0, 0);   \
        o[d0] = __builtin_amdgcn_mfma_f32_32x32x16_bf16(pa3, (bf16x8){l3[0], l3[1], l3[2], l3[3], h3[0], h3[1], h3[2], h3[3]}, o[d0], 0, 0, 0); } while (0)
    PV_D0(0); PV_D0(1); PV_D0(2); PV_D0(3);
#undef PV_D0
#undef TRRD
}

template <int MODE, class MK>
__device__ __forceinline__ void flash_block(const bf16_t* Q, const bf16_t* K, const bf16_t* V, int krow0, int NT, int qrow0, float slopeL, const MK& mk,
                                            unsigned char* lds, bf16_t* Og, float* Lse, const bf16_t* Zg, int tid) {
    const int wid = __builtin_amdgcn_readfirstlane(tid >> 6), lane = tid & 63, r32 = lane & 31, hi = lane >> 5;
    const LAS char* K_lds = (const LAS char*)(LAS unsigned char*)lds + OFF_K;
    LAS char* Kw = (LAS char*)(LAS unsigned char*)lds + OFF_K; LAS char* Vw = (LAS char*)(LAS unsigned char*)lds + OFF_V;
    LAS float* wsf = (LAS float*)((LAS unsigned char*)lds + OFF_WS) + wid * 64; LAS float* li_l = wsf; LAS float* al_l = wsf + 32;
    const int sr = tid >> 4, sc = (tid & 15) * 8, vst0 = v_st(sr, sc), vst1 = v_st(32 + sr, sc), kws = KSWZ(sr, sc * 2);
    const int vb0 = (int)(unsigned)(uintptr_t)((LAS unsigned char*)lds) + OFF_V + v_rd_base(lane);
    const int qlo = qrow0 + wid * 32, qm = qlo + r32 - 4 * hi;
    bf16x8 st_k0, st_k1, st_v0, st_v1;
#define SLOAD(kb_) do { const size_t o0_ = (size_t)((kb_) + sr) * DM + sc, o1_ = o0_ + (size_t)32 * DM; \
        st_v0 = *(const bf16x8*)(V + o0_); st_v1 = *(const bf16x8*)(V + o1_); st_k0 = *(const bf16x8*)(K + o0_); st_k1 = *(const bf16x8*)(K + o1_); } while (0)
#define SWRITE(bf) do { *(LAS bf16x8*)(Vw + (bf) * SHM_V + vst0) = st_v0; *(LAS bf16x8*)(Vw + (bf) * SHM_V + vst1) = st_v1; \
        *(LAS bf16x8*)(Kw + (bf) * SHM_K + kws) = st_k0; *(LAS bf16x8*)(Kw + (bf) * SHM_K + kws + 32 * 256) = st_k1; } while (0)
    bf16x8 qr[8];
#pragma unroll
    for (int d0 = 0; d0 < 8; ++d0) qr[d0] = *(const bf16x8*)(Q + (size_t)(wid * 32 + r32) * DM + d0 * 16 + hi * 8);
    SLOAD(krow0); asm volatile("s_waitcnt vmcnt(0)" ::: "memory"); SWRITE(0);
    __syncthreads();
    float m_reg = -1e30f, l_reg = 0.f; f32x16 o[4] = {};
#define STEP(t, KB) do { const int kb_ = krow0 + (t) * KVBLK;                                                                   \
        if ((t) + 1 < NT) SLOAD(kb_ + KVBLK);                                                                                     \
        bool act_, need_; unsigned W_; mk.info(kb_, qlo, r32, act_, need_, W_);                                                 \
        if (act_) { f32x16 p0, p1; const float a0_ = slopeL * (float)(kb_ - qm);                                                  \
            _Pragma("unroll") for (int r = 0; r < 16; ++r) { p0[r] = fmaf(slopeL, (float)((r & 3) + 8 * (r >> 2)), a0_); p1[r] = p0[r] + 32.f * slopeL; } \
            qkt<KB>(p0, p1, K_lds, r32, hi, qr);                                                                                  \
            if (need_) mask_tile(p0, p1, qm - kb_, W_);                                                                           \
            float alpha_; partialSM(p0, p1, m_reg, alpha_);                                                                       \
            bf16x8 pa0, pa1, pa2, pa3; finishSM(p0, p1, alpha_, l_reg, pa0, pa1, pa2, pa3);                                       \
            if (__any(alpha_ < 1.f)) { if (hi == 0) al_l[r32] = alpha_; LDS_WAIT();                                               \
                _Pragma("unroll") for (int d_ = 0; d_ < 4; ++d_) _Pragma("unroll") for (int r = 0; r < 16; ++r) o[d_][r] *= al_l[crow(r, hi)]; } \
            SBAR(); pv_tile<KB>(o, vb0, pa0, pa1, pa2, pa3); }                                                                    \
        if ((t) + 1 < NT) { asm volatile("s_waitcnt vmcnt(0)" ::: "memory"); SWRITE((KB) ^ 1); }                               \
        __syncthreads(); } while (0)
    for (int t = 0; t < NT; t += 2) { STEP(t, 0); STEP(t + 1, 1); }
#undef STEP
#undef SLOAD
#undef SWRITE
    if (hi == 0) li_l[r32] = l_reg;
    LDS_WAIT();
    LAS unsigned char* stg = (LAS unsigned char*)lds + OFF_OST + wid * OST_WAVE;
#pragma unroll
    for (int r = 0; r < 16; ++r) { const int orow = crow(r, hi); const float rl = __builtin_amdgcn_rcpf(li_l[orow]);
#pragma unroll
        for (int d0 = 0; d0 < 4; ++d0) *(LAS unsigned short*)(stg + orow * OST_ROW + (d0 * 32 + r32) * 2) = (unsigned short)(cvt_pk_bf16(o[d0][r] * rl, 0.f) & 0xffffu); }
    LDS_WAIT();
    if (MODE == 0) { if (hi == 0) Lse[(size_t)(qlo + r32) * NH] = m_reg + log2f(l_reg); }
#pragma unroll
    for (int i = 0; i < 8; ++i) { const int row = i * 4 + (lane >> 4), ch = lane & 15;
        u32x4 v = *(const LAS u32x4*)(stg + row * OST_ROW + ch * 16);
        const size_t go = (size_t)(qlo + row) * DM + ch * 8;
        if (MODE == 1) { const u32x4 z = *(const u32x4*)(Zg + go);
            v.x = cvt_pk_bf16(bflo(v.x) * silu_f(bflo(z.x)), bfhi(v.x) * silu_f(bfhi(z.x))); v.y = cvt_pk_bf16(bflo(v.y) * silu_f(bflo(z.y)), bfhi(v.y) * silu_f(bfhi(z.y)));
            v.z = cvt_pk_bf16(bflo(v.z) * silu_f(bflo(z.z)), bfhi(v.z) * silu_f(bfhi(z.z))); v.w = cvt_pk_bf16(bflo(v.w) * silu_f(bflo(z.w)), bfhi(v.w) * silu_f(bfhi(z.w))); }
        *(u32x4*)(Og + go) = v; }
    LDS_WAIT();
}
struct MaskA {
    int L;
    __device__ __forceinline__ void info(int kb, int qlo, int r32, bool& act, bool& need, unsigned& W) const {
        const int seq0 = qlo & ~(L - 1); int lowk = qlo - 128; if (lowk < seq0) lowk = seq0;
        act = (kb <= qlo + 31) && (kb + KVBLK - 1 >= lowk); need = true;
        const int wl = qlo + r32 - seq0 + 1; W = (unsigned)(wl < 129 ? wl : 129);
    }
};
struct MaskB {
    int own0, base0; unsigned sel;
    __device__ __forceinline__ void info(int kb, int qlo, int r32, bool& act, bool& need, unsigned& W) const {
        if (kb >= own0) { act = kb <= qlo + 31; need = kb + KVBLK - 1 > qlo; W = 0x40000000u; }
        else { const int blk = (kb - base0) >> 8; const bool s = (sel >> blk) & 1u; const unsigned long long bal = __ballot(s);
            act = bal != 0ull; need = bal != ~0ull; W = s ? 0x40000000u : 0u; }
    }
};
#undef KSWZ
#undef SBAR
}

namespace fb {
using namespace fa;
#define KSWZ(row, colB) ((row) * 256 + ((colB) ^ (((row) & 7) << 4)))
#define SBAR() __builtin_amdgcn_sched_barrier(0)
struct Blk {
    unsigned qoff, koff, voff;
    unsigned ooff, xoff;
    int R0, kb0, NT;
    float slopeL;
    int L, base0;
};
struct Nxt { unsigned qoff, koff, voff; int kb0; };
struct Seam { bf16x8 qr[8]; bf16x8 st_v0, st_v1, st_k0, st_k1; };
__device__ __forceinline__ void tile_info(const Blk& c, int kb, int qlo, int r32, unsigned sel, bool& act, bool& need, unsigned& W) {
    if (c.L > 0) { const int seq0 = qlo & ~(c.L - 1); int lowk = qlo - 128; if (lowk < seq0) lowk = seq0;
        act = (kb <= qlo + 31) && (kb + KVBLK - 1 >= lowk); need = true; const int wl = qlo + r32 - seq0 + 1; W = (unsigned)(wl < 129 ? wl : 129); }
    else if (kb >= c.R0) { act = kb <= qlo + 31; need = kb + KVBLK - 1 > qlo; W = 0x40000000u; }
    else { const int blk = (kb - c.base0) >> 8; const bool sb = (sel >> blk) & 1u; const unsigned long long bal = __ballot(sb);
        act = bal != 0ull; need = bal != ~0ull; W = sb ? 0x40000000u : 0u; }
}
template <int KB>
__device__ __forceinline__ void qkt2(f32x16& p0, f32x16& p1, const LAS char* K_lds, int r32, int hi, const bf16x8* qr, bool act, float slopeL, float a0) {
    if (!act) { const float NEG = -__builtin_inff();
#pragma unroll
        for (int r = 0; r < 16; ++r) { p0[r] = NEG; p1[r] = NEG; } return; }
#pragma unroll
    for (int r = 0; r < 16; ++r) { p0[r] = fmaf(slopeL, (float)((r & 3) + 8 * (r >> 2)), a0); p1[r] = fmaf(slopeL, (float)((r & 3) + 8 * (r >> 2) + 32), a0); }
    qkt<KB>(p0, p1, K_lds, r32, hi, qr);
}
#define ROWP(off, k0, rr) (wsb + ((size_t)(off) + (size_t)(k0) * (DM * 2)) + (unsigned)(((rr) * DM + sc) * 2))
#define VMW() asm volatile("s_waitcnt vmcnt(0)" ::: "memory")
#define SLOAD_H(Kp, Vp, k0) do { S.st_v0 = *(const bf16x8*)ROWP(Vp, k0, sr); S.st_v1 = *(const bf16x8*)ROWP(Vp, k0, 32 + sr); \
                                 S.st_k0 = *(const bf16x8*)ROWP(Kp, k0, sr); S.st_k1 = *(const bf16x8*)ROWP(Kp, k0, 32 + sr); } while (0)
#define SWRITE_HK(bf) do { *(LAS bf16x8*)(Kw + (bf) * SHM_K + kws) = S.st_k0; *(LAS bf16x8*)(Kw + (bf) * SHM_K + kws + 32 * 256) = S.st_k1; } while (0)
#define SWRITE_HV(bf) do { *(LAS bf16x8*)(Vw + (bf) * SHM_V + vst0) = S.st_v0; *(LAS bf16x8*)(Vw + (bf) * SHM_V + vst1) = S.st_v1; } while (0)
#define SWRITE_H(bf) do { SWRITE_HV(bf); SWRITE_HK(bf); } while (0)
__device__ __forceinline__ void prime(const unsigned char* wsb, const Blk& cur, unsigned char* lds, Seam& S, int tid) {
    const int wid = __builtin_amdgcn_readfirstlane(tid >> 6), lane = tid & 63, r32 = lane & 31, hi = lane >> 5;
    const int sr = tid >> 4, sc = (tid & 15) * 8, kws = KSWZ(sr, sc * 2);
    LAS char* Kw = (LAS char*)(LAS unsigned char*)lds + OFF_K;
#pragma unroll
    for (int d0 = 0; d0 < 8; ++d0) S.qr[d0] = *(const bf16x8*)(wsb + (size_t)cur.qoff + (unsigned)(((wid * 32 + r32) * DM + d0 * 16 + hi * 8) * 2));
    SLOAD_H(cur.koff, cur.voff, cur.kb0); VMW(); SWRITE_HK(0);
    __syncthreads();
}
template <int MODE>
__device__ __forceinline__ void block(const unsigned char* wsb, const Blk& cur, const Nxt& nxt, unsigned sel, unsigned char* lds, Seam& S, int tid) {
    const int wid = __builtin_amdgcn_readfirstlane(tid >> 6), lane = tid & 63, r32 = lane & 31, hi = lane >> 5;
    const LAS char* K_lds = (const LAS char*)(LAS unsigned char*)lds + OFF_K;
    LAS char* Kw = (LAS char*)(LAS unsigned char*)lds + OFF_K; LAS char* Vw = (LAS char*)(LAS unsigned char*)lds + OFF_V;
    LAS float* wsf = (LAS float*)((LAS unsigned char*)lds + OFF_WS) + wid * 64; LAS float* li_l = wsf; LAS float* al_l = wsf + 32;
    const int sr = tid >> 4, sc = (tid & 15) * 8, vst0 = v_st(sr, sc), vst1 = v_st(32 + sr, sc), kws = KSWZ(sr, sc * 2);
    const int vb0 = (int)(unsigned)(uintptr_t)((LAS unsigned char*)lds) + OFF_V + v_rd_base(lane);
    const int NT = cur.NT, qlo = cur.R0 + wid * 32, qm = qlo + r32 - 4 * hi;
    const float slopeL = cur.slopeL;
    const unsigned Kh = cur.koff, Vh = cur.voff;
    float m_reg = -1e30f, l_reg = 0.f; f32x16 o[4] = {};
#define KBASE(t) (cur.kb0 + (t) * KVBLK)
#define RESC(a) do { if (__any((a) < 1.f)) { if (hi == 0) al_l[r32] = (a); LDS_WAIT(); \
        _Pragma("unroll") for (int d_ = 0; d_ < 4; ++d_) _Pragma("unroll") for (int r = 0; r < 16; ++r) o[d_][r] *= al_l[crow(r, hi)]; } } while (0)
#define QKT(PX0, PX1, t, KB, ACTV) do { const int kb_ = KBASE(t); bool nd_; unsigned W_; tile_info(cur, kb_, qlo, r32, sel, ACTV, nd_, W_); \
        qkt2<KB>(PX0, PX1, K_lds, r32, hi, S.qr, ACTV, slopeL, slopeL * (float)(kb_ - qm)); } while (0)
#define MASKT(PX0, PX1, t) do { const int kb_ = KBASE(t); bool ac_, nd_; unsigned W_; tile_info(cur, kb_, qlo, r32, sel, ac_, nd_, W_); \
        if (ac_ && nd_) mask_tile(PX0, PX1, qm - kb_, W_); } while (0)
    f32x16 pA0, pA1, pB0, pB1; float alA, alB; bf16x8 pa0, pa1, pa2, pa3; bool actA, actB;
    SWRITE_HV(0); SBAR();
    SLOAD_H(Kh, Vh, KBASE(1));
    SBAR(); QKT(pA0, pA1, 0, 0, actA);
    MASKT(pA0, pA1, 0); partialSM(pA0, pA1, m_reg, alA);
    VMW(); SWRITE_H(1);
    __syncthreads();
#define HALF_STEP(PX0, PX1, alX, actX, PY0, PY1, alY, actY, t, KB, VB, SB) do {                                                 \
        SBAR(); QKT(PX0, PX1, t, KB, actX);                                                                                   \
        finishSM(PY0, PY1, alY, l_reg, pa0, pa1, pa2, pa3); SBAR();                                                           \
        if ((t) + 1 < NT) { SLOAD_H(Kh, Vh, KBASE((t) + 1)); SBAR(); }                                                        \
        if (actY) pv_tile<VB>(o, vb0, pa0, pa1, pa2, pa3);                                                                    \
        MASKT(PX0, PX1, (t)); partialSM(PX0, PX1, m_reg, alX);                                                                \
        __syncthreads();                                                                                                      \
        if ((t) + 1 < NT) { VMW(); SWRITE_H(SB); }                                                                            \
        RESC(alX); __syncthreads(); } while (0)
    for (int t = 1; t + 1 < NT; t += 2) {
        HALF_STEP(pB0, pB1, alB, actB, pA0, pA1, alA, actA, t, 1, 0, 0);
        HALF_STEP(pA0, pA1, alA, actA, pB0, pB1, alB, actB, t + 1, 0, 1, 1);
    }
    SBAR(); QKT(pB0, pB1, NT - 1, 1, actB); SBAR();
    SLOAD_H(nxt.koff, nxt.voff, nxt.kb0); SBAR();
#pragma unroll
    for (int d0 = 0; d0 < 8; ++d0) S.qr[d0] = *(const bf16x8*)(wsb + (size_t)nxt.qoff + (unsigned)(((wid * 32 + r32) * DM + d0 * 16 + hi * 8) * 2));
    SBAR();
    finishSM(pA0, pA1, alA, l_reg, pa0, pa1, pa2, pa3); SBAR();
    if (actA) pv_tile<0>(o, vb0, pa0, pa1, pa2, pa3);
    MASKT(pB0, pB1, NT - 1); partialSM(pB0, pB1, m_reg, alB); __syncthreads(); RESC(alB);
    finishSM(pB0, pB1, alB, l_reg, pa0, pa1, pa2, pa3); SBAR();
    if (actB) pv_tile<1>(o, vb0, pa0, pa1, pa2, pa3);
    SBAR(); asm volatile("s_waitcnt vmcnt(8)" ::: "memory"); SWRITE_HK(0); SBAR();
    int tid2 = tid; asm volatile("" : "+v"(tid2));
    const int lane2 = tid2 & 63, r32e = lane2 & 31, hie = lane2 >> 5;
    if (hie == 0) li_l[r32e] = l_reg;
    LDS_WAIT();
    LAS unsigned char* stg = (LAS unsigned char*)lds + OFF_OST + wid * OST_WAVE;
#pragma unroll
    for (int r = 0; r < 16; ++r) { const int orow = crow(r, hie); const float rl = __builtin_amdgcn_rcpf(li_l[orow]);
#pragma unroll
        for (int d0 = 0; d0 < 4; ++d0) *(LAS unsigned short*)(stg + orow * OST_ROW + (d0 * 32 + r32e) * 2) = (unsigned short)(cvt_pk_bf16(o[d0][r] * rl, 0.f) & 0xffffu); }
    LDS_WAIT();
    if (MODE == 0) { if (hie == 0) *(float*)(const_cast<unsigned char*>(wsb) + (size_t)cur.xoff + (unsigned)((qlo + r32e) * NH * 4)) = m_reg + log2f(l_reg); }
#pragma unroll
    for (int i = 0; i < 8; ++i) { const int row = i * 4 + (lane2 >> 4), ch = lane2 & 15;
        u32x4 v = *(const LAS u32x4*)(stg + row * OST_ROW + ch * 16);
        const unsigned go = (unsigned)(((qlo + row) * DM + ch * 8) * 2);
        if (MODE == 1) { const u32x4 z = *(const u32x4*)(wsb + (size_t)cur.xoff + go);
            v.x = cvt_pk_bf16(bflo(v.x) * silu_f(bflo(z.x)), bfhi(v.x) * silu_f(bfhi(z.x))); v.y = cvt_pk_bf16(bflo(v.y) * silu_f(bflo(z.y)), bfhi(v.y) * silu_f(bfhi(z.y)));
            v.z = cvt_pk_bf16(bflo(v.z) * silu_f(bflo(z.z)), bfhi(v.z) * silu_f(bfhi(z.z))); v.w = cvt_pk_bf16(bflo(v.w) * silu_f(bflo(z.w)), bfhi(v.w) * silu_f(bfhi(z.w))); }
        *(u32x4*)(const_cast<unsigned char*>(wsb) + (size_t)cur.ooff + go) = v; }
    __syncthreads();
#undef KBASE
#undef RESC
#undef QKT
#undef MASKT
#undef HALF_STEP
}
#undef ROWP
#undef VMW
#undef SLOAD_H
#undef SWRITE_HK
#undef SWRITE_HV
#undef SWRITE_H
#undef KSWZ
#undef SBAR
}

namespace fc {
using namespace fa;
constexpr int NSLOT = 3;
constexpr int R_K = 0, R_V = NSLOT * SHM_K, R_WS = R_V + NSLOT * SHM_V, WSW = 96, R_OST = R_WS + 8 * WSW * 4, OSTR = 144, OSTW = 32 * OSTR;
constexpr int R_GK = R_OST + 8 * OSTW, R_SEL = R_GK + 2 * 7 * 128 * 4, R_END = R_SEL + 256 * 4;
static_assert(R_END <= LDS_BYTES - 64, "attention LDS map");
#define KSWZ(row, colB) ((row) * 256 + ((colB) ^ (((row) & 7) << 4)))
#define SBAR() __builtin_amdgcn_sched_barrier(0)
struct Blk {
    unsigned qoff, koff, voff, ooff, xoff;
    unsigned zoff, goff;
    int R0, kb0, NT;
    float slopeL;
    int L, base0;
};
struct Nxt { unsigned qoff, koff, voff; int kb0; };
__device__ __forceinline__ void glds16(const void* sbase, unsigned voff, unsigned lds_dst) { unsigned keep;
    asm volatile("s_mov_b32 %0, m0\n\ts_mov_b32 m0, %3\n\ts_nop 0\n\tglobal_load_lds_dwordx4 %1, %2\n\ts_mov_b32 m0, %0" : "=&s"(keep) : "v"(voff), "s"(sbase), "s"(lds_dst) : "memory"); }
__device__ __forceinline__ void qkt_r(f32x16& p0, f32x16& p1, const LAS char* Kslot, int r32, int hi, const bf16x8* qr) {
    const LAS char* kb[4];
#pragma unroll
    for (int dd = 0; dd < 4; ++dd) kb[dd] = Kslot + KSWZ(r32, (dd * 16 + hi * 8) * 2);
    bf16x8 c0 = *reinterpret_cast<const LAS bf16x8*>(kb[0]), c1 = *reinterpret_cast<const LAS bf16x8*>(kb[0] + 32 * 256);
#pragma unroll
    for (int d0 = 0; d0 < 8; ++d0) {
        bf16x8 n0 = c0, n1 = c1;
        if (d0 < 7) { const LAS char* a = kb[(d0 + 1) & 3] + ((d0 + 1) >> 2) * 128; n0 = *reinterpret_cast<const LAS bf16x8*>(a); n1 = *reinterpret_cast<const LAS bf16x8*>(a + 32 * 256); }
        p0 = __builtin_amdgcn_mfma_f32_32x32x16_bf16(c0, qr[d0], p0, 0, 0, 0);
        p1 = __builtin_amdgcn_mfma_f32_32x32x16_bf16(c1, qr[d0], p1, 0, 0, 0);
        c0 = n0; c1 = n1; }
}
__device__ __forceinline__ void pv_r(f32x16* o, int vb, bf16x8 pa0, bf16x8 pa1, bf16x8 pa2, bf16x8 pa3) {
#define TRRD(dst, off) asm volatile("ds_read_b64_tr_b16 %0, %1 offset:%2" : "=&v"(dst) : "v"(vb), "i"(off) : "memory")
#define PV_D0(d0) do { s16x4 l0, l1, l2, l3, h0, h1, h2, h3; constexpr int b_ = v_rd_off(d0, 0, 0); \
        TRRD(l0, b_); TRRD(h0, b_ + 2048); TRRD(l1, b_ + 4096); TRRD(h1, b_ + 6144); TRRD(l2, b_ + 8192); TRRD(h2, b_ + 10240); TRRD(l3, b_ + 12288); TRRD(h3, b_ + 14336); \
        asm volatile("s_waitcnt lgkmcnt(0)" ::: "memory"); SBAR();   \
        o[d0] = __builtin_amdgcn_mfma_f32_32x32x16_bf16(pa0, (bf16x8){l0[0], l0[1], l0[2], l0[3], h0[0], h0[1], h0[2], h0[3]}, o[d0], 0, 0, 0);   \
        o[d0] = __builtin_amdgcn_mfma_f32_32x32x16_bf16(pa1, (bf16x8){l1[0], l1[1], l1[2], l1[3], h1[0], h1[1], h1[2], h1[3]}, o[d0], 0, 0, 0);   \
        o[d0] = __builtin_amdgcn_mfma_f32_32x32x16_bf16(pa2, (bf16x8){l2[0], l2[1], l2[2], l2[3], h2[0], h2[1], h2[2], h2[3]}, o[d0], 0, 0, 0);   \
        o[d0] = __builtin_amdgcn_mfma_f32_32x32x16_bf16(pa3, (bf16x8){l3[0], l3[1], l3[2], l3[3], h3[0], h3[1], h3[2], h3[3]}, o[d0], 0, 0, 0); } while (0)
    PV_D0(0); PV_D0(1); PV_D0(2); PV_D0(3);
#undef PV_D0
#undef TRRD
}
__device__ __forceinline__ void tile_info(const Blk& c, int kb, int qlo, int r32, unsigned sel, bool& act, bool& need, unsigned& W, bool& dead) {
    dead = false;
    if (c.L > 0) { const int seq0 = qlo & ~(c.L - 1); int lowk = qlo - 128; if (lowk < seq0) lowk = seq0;
        act = (kb <= qlo + 31) && (kb + KVBLK - 1 >= lowk); need = true; const int wl = qlo + r32 - seq0 + 1; W = (unsigned)(wl < 129 ? wl : 129); }
    else if (kb >= c.R0) { act = kb <= qlo + 31; need = kb + KVBLK - 1 > qlo; W = 0x40000000u; }
    else { const int blk = (kb - c.base0) >> 8; const bool sb = (sel >> blk) & 1u; act = __ballot(sb) != 0ull; need = false; W = 0x40000000u; dead = !sb; }
}
struct Ring { int kt; };
__device__ __forceinline__ int nx3(int s) { return s == 2 ? 0 : s + 1; }
struct DmaLane { unsigned vk0, vk1, vv0, vv1; };
__device__ __forceinline__ DmaLane dma_lane(int wid, int lane) {
    DmaLane d;
    { const int row0 = wid * 8 + (lane >> 4), row1 = row0 + 4, cs = lane & 15;
      d.vk0 = (unsigned)(row0 * DM * 2 + ((cs ^ (row0 & 7)) * 16)); d.vk1 = (unsigned)(row1 * DM * 2 + ((cs ^ (row1 & 7)) * 16)); }
    { const int gi = lane & 31, kk = wid * 8 + (gi >> 2), k = (kk & ~0xC) | ((kk & 4) << 1) | ((kk & 8) >> 1);
      const int c0 = ((lane >> 5)) * 32 + (gi & 3) * 8, c1 = c0 + 64;
      d.vv0 = (unsigned)(k * DM * 2 + c0 * 2); d.vv1 = (unsigned)(k * DM * 2 + c1 * 2); }
    return d;
}
#define DMA_K(srcoff, kbrow, slot) do { const unsigned char* sb_ = wsb + ((size_t)(srcoff) + (size_t)(kbrow) * (DM * 2)); const unsigned ld_ = ldsb + R_K + (slot) * SHM_K + wid * 2048; \
        glds16(sb_, dl.vk0, ld_); glds16(sb_, dl.vk1, ld_ + 1024); } while (0)
#define DMA_V(srcoff, kbrow, slot) do { const unsigned char* sb_ = wsb + ((size_t)(srcoff) + (size_t)(kbrow) * (DM * 2)); const unsigned ld_ = ldsb + R_V + (slot) * SHM_V + wid * 2048; \
        glds16(sb_, dl.vv0, ld_); glds16(sb_, dl.vv1, ld_ + 1024); } while (0)
#define WAITBAR(N) asm volatile("s_waitcnt vmcnt(" #N ") lgkmcnt(0)\n\ts_barrier" ::: "memory")
__device__ __forceinline__ void prime(const unsigned char* wsb, const Blk& cur, unsigned char* lds, bf16x8* qr, Ring& rg, int tid) {
    const int wid = __builtin_amdgcn_readfirstlane(tid >> 6), lane = tid & 63, r32 = lane & 31, hi = lane >> 5;
    const unsigned ldsb = (unsigned)(uintptr_t)((LAS unsigned char*)lds);
    const DmaLane dl = dma_lane(wid, lane);
    DMA_K(cur.koff, cur.kb0, 0); DMA_V(cur.voff, cur.kb0, 0); DMA_K(cur.koff, cur.kb0 + KVBLK, 1);
#pragma unroll
    for (int d0 = 0; d0 < 8; ++d0) qr[d0] = *(const bf16x8*)(wsb + (size_t)cur.qoff + (unsigned)(((wid * 32 + r32) * DM + d0 * 16 + hi * 8) * 2));
    rg.kt = 0;
    WAITBAR(0);
}
template <int MODE>
__device__ __forceinline__ void block(const unsigned char* wsb, const Blk& cur, const Nxt& nxt, bool has_next, unsigned sel, unsigned char* lds, bf16x8* qr, Ring& rg, int tid) {
    const int wid = __builtin_amdgcn_readfirstlane(tid >> 6), lane = tid & 63, r32 = lane & 31, hi = lane >> 5;
    const unsigned ldsb = (unsigned)(uintptr_t)((LAS unsigned char*)lds);
    const LAS char* K_lds = (const LAS char*)(LAS unsigned char*)lds + R_K;
    LAS float* wsf = (LAS float*)((LAS unsigned char*)lds + R_WS) + wid * WSW; LAS float* li_l = wsf; LAS float* al_l = wsf + 32;
    const int vbl = (int)ldsb + R_V + v_rd_base(lane);
    const DmaLane dl = dma_lane(wid, lane);
    const int NT = cur.NT, qlo = cur.R0 + wid * 32, qm = qlo + r32 - 4 * hi;
    const float slopeL = cur.slopeL;
    float m_reg = -1e30f, l_reg = 0.f; f32x16 o[4] = {};
    int kt = rg.kt;
#define RESC(a) do { if (__any((a) < 1.f)) { if (hi == 0) al_l[r32] = (a); LDS_WAIT(); \
        _Pragma("unroll") for (int d_ = 0; d_ < 4; ++d_) _Pragma("unroll") for (int r = 0; r < 16; ++r) o[d_][r] *= al_l[crow(r, hi)]; } } while (0)
#define STEPX(PX0, PX1, alX, actX, PY0, PY1, alY, actY, t, HAVEY) do {                                                                \
        const int kb_ = cur.kb0 + (t) * KVBLK; bool nd_, dd_; unsigned W_; tile_info(cur, kb_, qlo, r32, sel, actX, nd_, W_, dd_);   \
        SBAR();                                                                                                                       \
        if (actX) { const float a0_ = dd_ ? -__builtin_inff() : slopeL * (float)(kb_ - qm);                                           \
            _Pragma("unroll") for (int r = 0; r < 16; ++r) { PX0[r] = fmaf(slopeL, (float)((r & 3) + 8 * (r >> 2)), a0_); PX1[r] = fmaf(slopeL, (float)((r & 3) + 8 * (r >> 2) + 32), a0_); } \
            qkt_r(PX0, PX1, K_lds + kt * SHM_K, r32, hi, qr);                                                                         \
            if (HAVEY) finishSM(PY0, PY1, alY, l_reg, pa0, pa1, pa2, pa3); }                                                          \
        else { _Pragma("unroll") for (int r = 0; r < 16; ++r) { PX0[r] = -__builtin_inff(); PX1[r] = -__builtin_inff(); }             \
            if (HAVEY) finishSM(PY0, PY1, alY, l_reg, pa0, pa1, pa2, pa3); }                                                          \
        SBAR();                                                                                                                       \
        { const int s2_ = kt == 0 ? 2 : kt - 1, s1_ = nx3(kt);                           \
          const bool in2_ = (t) + 2 < NT, in1_ = (t) + 1 < NT;                                                                        \
          if (in2_) DMA_K(cur.koff, kb_ + 2 * KVBLK, s2_); else if (has_next) DMA_K(nxt.koff, nxt.kb0 + ((t) + 2 - NT) * KVBLK, s2_);        \
          if (in1_) DMA_V(cur.voff, kb_ + KVBLK, s1_); else if (has_next) DMA_V(nxt.voff, nxt.kb0 + ((t) + 1 - NT) * KVBLK, s1_); }         \
        SBAR();                                                                                                                       \
        if (HAVEY) { if (actY) pv_r(o, vbl + (kt == 0 ? 2 : kt - 1) * SHM_V, pa0, pa1, pa2, pa3); }                                   \
        if (actX && nd_) mask_tile(PX0, PX1, qm - kb_, W_);                                                                           \
        partialSM(PX0, PX1, m_reg, alX);                                                                                              \
        RESC(alX);                                                                                                                    \
        if ((t) + 2 < NT || has_next) WAITBAR(4); else if ((t) + 1 < NT) WAITBAR(2); else WAITBAR(0);                                 \
        kt = nx3(kt); } while (0)
    f32x16 pA0, pA1, pB0, pB1; float alA = 1.f, alB = 1.f; bf16x8 pa0, pa1, pa2, pa3; bool actA = false, actB = false;
    STEPX(pA0, pA1, alA, actA, pB0, pB1, alB, actB, 0, false);
    STEPX(pB0, pB1, alB, actB, pA0, pA1, alA, actA, 1, true);
    for (int t = 2; t < NT; t += 2) {
        STEPX(pA0, pA1, alA, actA, pB0, pB1, alB, actB, t, true);
        STEPX(pB0, pB1, alB, actB, pA0, pA1, alA, actA, t + 1, true);
    }
    finishSM(pB0, pB1, alB, l_reg, pa0, pa1, pa2, pa3); SBAR();
    if (actB) pv_r(o, vbl + (kt == 0 ? 2 : kt - 1) * SHM_V, pa0, pa1, pa2, pa3);
    SBAR();
    if (has_next) {
#pragma unroll
        for (int d0 = 0; d0 < 8; ++d0) qr[d0] = *(const bf16x8*)(wsb + (size_t)nxt.qoff + (unsigned)(((wid * 32 + r32) * DM + d0 * 16 + hi * 8) * 2));
    }
    SBAR();
    rg.kt = kt;
    int tid2 = tid; asm volatile("" : "+v"(tid2));
    const int lane2 = tid2 & 63, r32e = lane2 & 31, hie = lane2 >> 5;
    unsigned char* wsw = const_cast<unsigned char*>(wsb);
    if (MODE == 2) {
        if (hie == 0) { const int R = qlo + r32e, bb = R >> 11, t = ((R & 127) << 4) | ((R >> 7) & 15), T0 = (bb << 11) + t, T1 = (bb << 11) + ((t & 3) << 9) + (t >> 2);
            const float l2 = m_reg + log2f(l_reg);
            const float l0 = *(const float*)(wsb + (size_t)cur.xoff + (unsigned)(T0 * NH * 4)), l1 = *(const float*)(wsb + (size_t)cur.xoff + (size_t)MTOK * NH * 4 + (unsigned)(T1 * NH * 4));
            const float mx = fmaxf(l0, fmaxf(l1, l2)); const float e0 = exp2f(l0 - mx), e1 = exp2f(l1 - mx), e2 = exp2f(l2 - mx), inv = 1.f / (e0 + e1 + e2);
            li_l[r32e] = e2 * inv / l_reg; al_l[r32e] = e0 * inv; al_l[32 + r32e] = e1 * inv; }
    } else { if (hie == 0) li_l[r32e] = 1.f / l_reg; }
    LDS_WAIT();
    if (MODE == 0) { if (hie == 0) *(float*)(wsw + (size_t)cur.xoff + (unsigned)((qlo + r32e) * NH * 4)) = m_reg + log2f(l_reg); }
    LAS unsigned char* stg = (LAS unsigned char*)lds + R_OST + wid * OSTW;
    float rl[16];
#pragma unroll
    for (int r = 0; r < 16; ++r) rl[r] = li_l[crow(r, hie)];
    u32x4 pg0[4], pg1[4], pzz[4]; unsigned tof[4];
#define PREF(hf_) do { _Pragma("unroll") for (int i = 0; i < 4; ++i) { const int row = i * 8 + (lane2 >> 3), ch = lane2 & 7; const unsigned cb = (unsigned)(((hf_) * 64 + ch * 8) * 2); \
            const int R = qlo + row, bb = R >> 11, t = ((R & 127) << 4) | ((R >> 7) & 15), T0 = (bb << 11) + t, T1 = (bb << 11) + ((t & 3) << 9) + (t >> 2);                    \
            tof[i] = (unsigned)(T0 * DM * 2);                                                                                                                                   \
            pg0[i] = *(const u32x4*)(wsb + (size_t)cur.ooff + tof[i] + cb); pg1[i] = *(const u32x4*)(wsb + (size_t)cur.ooff + (size_t)PART * 2 + (unsigned)(T1 * DM * 2) + cb); \
            pzz[i] = *(const u32x4*)(wsb + (size_t)cur.zoff + tof[i] + cb); } } while (0)
    if (MODE == 2) PREF(0);
#pragma unroll
    for (int hf = 0; hf < 2; ++hf) {
#pragma unroll
        for (int r = 0; r < 16; ++r) { const int orow = crow(r, hie);
#pragma unroll
            for (int dd = 0; dd < 2; ++dd) *(LAS unsigned short*)(stg + orow * OSTR + (dd * 32 + r32e) * 2) = (unsigned short)(cvt_pk_bf16(o[2 * hf + dd][r] * rl[r], 0.f) & 0xffffu); }
        LDS_WAIT();
        if (MODE == 2) {
            u32x4 vv[4];
#pragma unroll
            for (int i = 0; i < 4; ++i) { const int row = i * 8 + (lane2 >> 3), ch = lane2 & 7;
                u32x4 v = *(const LAS u32x4*)(stg + row * OSTR + ch * 16);
                const float a0 = al_l[row], a1 = al_l[32 + row]; const u32x4 g0 = pg0[i], g1 = pg1[i], z = pzz[i];
#define MRG(F) v.F = cvt_pk_bf16((bflo(v.F) + a0 * bflo(g0.F) + a1 * bflo(g1.F)) * silu_f(bflo(z.F)), (bfhi(v.F) + a0 * bfhi(g0.F) + a1 * bfhi(g1.F)) * silu_f(bfhi(z.F)));
                MRG(x) MRG(y) MRG(z) MRG(w)
#undef MRG
                vv[i] = v; }
            unsigned tsv[4];
#pragma unroll
            for (int i = 0; i < 4; ++i) tsv[i] = tof[i];
            if (hf == 0) PREF(1);
#pragma unroll
            for (int i = 0; i < 4; ++i) { const int ch = lane2 & 7; store_wt(wsw + (size_t)cur.goff + tsv[i] + (unsigned)((hf * 64 + ch * 8) * 2), vv[i]); }
        } else {
#pragma unroll
            for (int i = 0; i < 4; ++i) { const int row = i * 8 + (lane2 >> 3), ch = lane2 & 7;
                u32x4 v = *(const LAS u32x4*)(stg + row * OSTR + ch * 16);
                const unsigned go = (unsigned)((qlo + row) * DM * 2) + (unsigned)((hf * 64 + ch * 8) * 2);
                if (MODE == 1) { const u32x4 z = *(const u32x4*)(wsb + (size_t)cur.xoff + go);
                    v.x = cvt_pk_bf16(bflo(v.x) * silu_f(bflo(z.x)), bfhi(v.x) * silu_f(bfhi(z.x))); v.y = cvt_pk_bf16(bflo(v.y) * silu_f(bflo(z.y)), bfhi(v.y) * silu_f(bfhi(z.y)));
                    v.z = cvt_pk_bf16(bflo(v.z) * silu_f(bflo(z.z)), bfhi(v.z) * silu_f(bfhi(z.z))); v.w = cvt_pk_bf16(bflo(v.w) * silu_f(bflo(z.w)), bfhi(v.w) * silu_f(bfhi(z.w))); }
                store_wt(wsw + (size_t)cur.ooff + go, v); } }
        LDS_WAIT();
    }
#undef PREF
#undef RESC
#undef STEPX
}
#undef DMA_K
#undef DMA_V
#undef WAITBAR
#undef KSWZ
#undef SBAR
}

namespace fd {
using namespace fa;
using fc::Blk; using fc::Nxt; using fc::Ring; using fc::DmaLane; using fc::dma_lane; using fc::glds16; using fc::qkt_r; using fc::pv_r; using fc::tile_info; using fc::nx3;
using fc::R_K; using fc::R_V; using fc::R_WS; using fc::R_OST; using fc::OSTR; using fc::OSTW;
#define SBAR() __builtin_amdgcn_sched_barrier(0)
#define DMA_K(srcoff, kbrow, slot) do { const unsigned char* sb_ = wsb + ((size_t)(srcoff) + (size_t)(kbrow) * (DM * 2)); const unsigned ld_ = ldsb + R_K + (slot) * SHM_K + wid * 2048; \
        glds16(sb_, dl.vk0, ld_); glds16(sb_, dl.vk1, ld_ + 1024); } while (0)
#define DMA_V(srcoff, kbrow, slot) do { const unsigned char* sb_ = wsb + ((size_t)(srcoff) + (size_t)(kbrow) * (DM * 2)); const unsigned ld_ = ldsb + R_V + (slot) * SHM_V + wid * 2048; \
        glds16(sb_, dl.vv0, ld_); glds16(sb_, dl.vv1, ld_ + 1024); } while (0)
#define WAITBAR(N) asm volatile("s_waitcnt vmcnt(" #N ") lgkmcnt(0)\n\ts_barrier" ::: "memory")
__device__ __forceinline__ void softmax_tile(f32x16& p0, f32x16& p1, float& m_reg, float& l_reg, float& alpha, bf16x8& pa0, bf16x8& pa1, bf16x8& pa2, bf16x8& pa3) {
    partialSM(p0, p1, m_reg, alpha);
    finishSM(p0, p1, alpha, l_reg, pa0, pa1, pa2, pa3);
}
__device__ __forceinline__ void prime(const unsigned char* wsb, const Blk& cur, unsigned char* lds, bf16x8* qr, Ring& rg, int tid) {
    const int wid = __builtin_amdgcn_readfirstlane(tid >> 6), lane = tid & 63, r32 = lane & 31, hi = lane >> 5;
    const unsigned ldsb = (unsigned)(uintptr_t)((LAS unsigned char*)lds);
    const DmaLane dl = dma_lane(wid, lane);
    DMA_K(cur.koff, cur.kb0, 0); DMA_V(cur.voff, cur.kb0, 0); DMA_K(cur.koff, cur.kb0 + KVBLK, 1);
#pragma unroll
    for (int d0 = 0; d0 < 8; ++d0) qr[d0] = *(const bf16x8*)(wsb + (size_t)cur.qoff + (unsigned)(((wid * 32 + r32) * DM + d0 * 16 + hi * 8) * 2));
    rg.kt = 0;
    WAITBAR(0);
    if (wid >= 4) WAITBAR(0);
}
__device__ __forceinline__ void finish(int tid) {
    const int wid = __builtin_amdgcn_readfirstlane(tid >> 6);
    if (wid < 4) WAITBAR(0);
}
template <int MODE>
__device__ __forceinline__ void block(const unsigned char* wsb, const Blk& cur, const Nxt& nxt, bool has_next, unsigned sel, unsigned char* lds, bf16x8* qr, Ring& rg, int tid) {
    const int wid = __builtin_amdgcn_readfirstlane(tid >> 6), lane = tid & 63, r32 = lane & 31, hi = lane >> 5;
    const unsigned ldsb = (unsigned)(uintptr_t)((LAS unsigned char*)lds);
    const LAS char* K_lds = (const LAS char*)(LAS unsigned char*)lds + R_K;
    LAS float* wsf = (LAS float*)((LAS unsigned char*)lds + R_WS) + wid * fc::WSW; LAS float* li_l = wsf; LAS float* al_l = wsf + 32;
    const int vbl = (int)ldsb + R_V + v_rd_base(lane);
    const DmaLane dl = dma_lane(wid, lane);
    const int NT = cur.NT, qlo = cur.R0 + wid * 32, qm = qlo + r32 - 4 * hi;
    const float slopeL = cur.slopeL;
    float m_reg = -1e30f, l_reg = 0.f; f32x16 o[4] = {};
    int kt = rg.kt;
    f32x16 p0, p1; bf16x8 pa0, pa1, pa2, pa3; bool actP = false;
    for (int t = 0; t < NT; ++t) {
        const int kb_ = cur.kb0 + t * KVBLK; bool act, nd_, dd_; unsigned W_; tile_info(cur, kb_, qlo, r32, sel, act, nd_, W_, dd_);
        { const int s2_ = kt == 0 ? 2 : kt - 1, s1_ = nx3(kt);
          const bool in2_ = t + 2 < NT, in1_ = t + 1 < NT;
          if (in2_) DMA_K(cur.koff, kb_ + 2 * KVBLK, s2_); else if (has_next) DMA_K(nxt.koff, nxt.kb0 + (t + 2 - NT) * KVBLK, s2_);
          if (in1_) DMA_V(cur.voff, kb_ + KVBLK, s1_); else if (has_next) DMA_V(nxt.voff, nxt.kb0 + (t + 1 - NT) * KVBLK, s1_); }
        SBAR();
        if (act) { const float a0_ = dd_ ? -__builtin_inff() : slopeL * (float)(kb_ - qm);
#pragma unroll
            for (int r = 0; r < 16; ++r) { p0[r] = fmaf(slopeL, (float)((r & 3) + 8 * (r >> 2)), a0_); p1[r] = fmaf(slopeL, (float)((r & 3) + 8 * (r >> 2) + 32), a0_); }
            qkt_r(p0, p1, K_lds + kt * SHM_K, r32, hi, qr); }
        if (actP) pv_r(o, vbl + (kt == 0 ? 2 : kt - 1) * SHM_V, pa0, pa1, pa2, pa3);
        SBAR();
        if (t + 2 < NT || has_next) WAITBAR(4); else WAITBAR(0);
        if (act) { float alpha;
            if (nd_) mask_tile(p0, p1, qm - kb_, W_);
            softmax_tile(p0, p1, m_reg, l_reg, alpha, pa0, pa1, pa2, pa3);
            if (__any(alpha < 1.f)) { if (hi == 0) al_l[r32] = alpha; LDS_WAIT();
#pragma unroll
                for (int d_ = 0; d_ < 4; ++d_)
#pragma unroll
                    for (int r = 0; r < 16; ++r) o[d_][r] *= al_l[crow(r, hi)]; } }
        actP = act;
        SBAR();
        if (t + 2 < NT || has_next) WAITBAR(4); else WAITBAR(0);
        kt = nx3(kt);
    }
    if (actP) pv_r(o, vbl + (kt == 0 ? 2 : kt - 1) * SHM_V, pa0, pa1, pa2, pa3);
    SBAR();
    if (has_next) {
#pragma unroll
        for (int d0 = 0; d0 < 8; ++d0) qr[d0] = *(const bf16x8*)(wsb + (size_t)nxt.qoff + (unsigned)(((wid * 32 + r32) * DM + d0 * 16 + hi * 8) * 2));
    }
    SBAR();
    rg.kt = kt;
    if (has_next) WAITBAR(4); else WAITBAR(0);
    int tid2 = tid; asm volatile("" : "+v"(tid2));
    const int lane2 = tid2 & 63, r32e = lane2 & 31, hie = lane2 >> 5;
    if (hie == 0) li_l[r32e] = l_reg;
    LDS_WAIT();
    if (MODE == 0) { if (hie == 0) *(float*)(const_cast<unsigned char*>(wsb) + (size_t)cur.xoff + (unsigned)((qlo + r32e) * NH * 4)) = m_reg + log2f(l_reg); }
    LAS unsigned char* stg = (LAS unsigned char*)lds + R_OST + wid * OSTW;
    float rl[16];
#pragma unroll
    for (int r = 0; r < 16; ++r) rl[r] = __builtin_amdgcn_rcpf(li_l[crow(r, hie)]);
#pragma unroll
    for (int hf = 0; hf < 2; ++hf) {
#pragma unroll
        for (int r = 0; r < 16; ++r) { const int orow = crow(r, hie);
#pragma unroll
            for (int dd = 0; dd < 2; ++dd) *(LAS unsigned short*)(stg + orow * OSTR + (dd * 32 + r32e) * 2) = (unsigned short)(cvt_pk_bf16(o[2 * hf + dd][r] * rl[r], 0.f) & 0xffffu); }
        LDS_WAIT();
#pragma unroll
        for (int i = 0; i < 4; ++i) { const int row = i * 8 + (lane2 >> 3), ch = lane2 & 7;
            u32x4 v = *(const LAS u32x4*)(stg + row * OSTR + ch * 16);
            const unsigned go = (unsigned)(((qlo + row) * DM + hf * 64 + ch * 8) * 2);
            if (MODE == 1) { const u32x4 z = *(const u32x4*)(wsb + (size_t)cur.xoff + go);
                v.x = cvt_pk_bf16(bflo(v.x) * silu_f(bflo(z.x)), bfhi(v.x) * silu_f(bfhi(z.x))); v.y = cvt_pk_bf16(bflo(v.y) * silu_f(bflo(z.y)), bfhi(v.y) * silu_f(bfhi(z.y)));
                v.z = cvt_pk_bf16(bflo(v.z) * silu_f(bflo(z.z)), bfhi(v.z) * silu_f(bfhi(z.z))); v.w = cvt_pk_bf16(bflo(v.w) * silu_f(bflo(z.w)), bfhi(v.w) * silu_f(bfhi(z.w))); }
            *(u32x4*)(const_cast<unsigned char*>(wsb) + (size_t)cur.ooff + go) = v; }
        LDS_WAIT();
    }
    if (has_next) WAITBAR(4); else WAITBAR(0);
}
#undef DMA_K
#undef DMA_V
#undef WAITBAR
#undef SBAR
}

__device__ __forceinline__ fb::Blk blk_a(int it) {
    const int g = it >> 9, rem = it & 511, h = rem & 15, rb = rem < 256 ? (rem >> 4) : 31 - ((rem - 256) >> 4), lg = 2 * g, L = SEQ >> lg, R0 = rb * 256;
    int kb0 = R0 - 128; { const int s0 = R0 & ~(L - 1); if (kb0 < s0) kb0 = s0; }
    fb::Blk b;
    b.qoff = (unsigned)(WS_QKV + ((size_t)(3 * g) * PART + (size_t)R0 * DM + h * HD) * 2); b.koff = (unsigned)(WS_QKV + ((size_t)(3 * g + 1) * PART + h * HD) * 2); b.voff = (unsigned)(WS_QKV + ((size_t)(3 * g + 2) * PART + h * HD) * 2);
    b.ooff = (unsigned)(WS_OG + ((size_t)g * PART + h * HD) * 2); b.xoff = (unsigned)(WS_LSE + ((size_t)g * MTOK * NH + h) * 4);
    b.R0 = R0; b.kb0 = kb0; b.NT = (R0 + 256 - kb0) >> 6; b.slopeL = slope_of(h) * (float)(1 << lg) * LOG2E; b.L = L; b.base0 = 0;
    return b;
}
__device__ __forceinline__ void attn_a_pipe(unsigned char* lds, int wv) {
    CParams& P = PP();
    const int tid = otid(wv);
    const unsigned char* wsb = P.ws;
    constexpr int TOTAL = 3 * NH * (MTOK / 256);
    int it = obid(); if (it >= TOTAL) return;
    fb::Blk cur = blk_a(it);
    fb::Seam S;
    fb::prime(wsb, cur, lds, S, tid);
    for (;;) {
        const int itn = it + (int)gridDim.x; const bool last = itn >= TOTAL;
        const fb::Blk nb = last ? cur : blk_a(itn);
        const fb::Nxt nxt{nb.qoff, nb.koff, nb.voff, nb.kb0};
        fb::block<0>(wsb, cur, nxt, 0u, lds, S, tid);
        if (last) break;
        cur = nb; it = itn;
    }
}
__device__ __forceinline__ int vit_b(int it) { return (it < 256) ? ((it & 7) * 32 + (it >> 3)) : it; }
__device__ __forceinline__ fb::Blk blk_b(int it_, int pass) {
    const int it = vit_b(it_); const int bh = it >> 2, s = it & 3, b = bh >> 4, h = bh & 15, n = pass ? 7 - s : s, R0 = (b << 11) + (n << 8);
    fb::Blk k;
    k.qoff = (unsigned)(WS_QKV + ((size_t)R0 * DM + h * HD) * 2); k.koff = (unsigned)(WS_QKV + (PART + h * HD) * 2); k.voff = (unsigned)(WS_QKV + (2 * PART + h * HD) * 2);
    k.ooff = (unsigned)(WS_G + (size_t)(h * HD) * 2); k.xoff = (unsigned)(WS_Z + (size_t)(h * HD) * 2);
    k.R0 = R0; k.kb0 = b << 11; k.NT = 4 * (n + 1); k.slopeL = slope_of(h) * LOG2E; k.L = 0; k.base0 = b << 11;
    return k;
}
__device__ __forceinline__ unsigned moba_gate(const unsigned char* wsb, unsigned char* lds, int b, int h, int n, int R0, int tid) {
    unsigned sel = (1u << n) - 1u;
    if (n >= 4) {
        asm volatile("" : "+v"(tid));
        const bf16_t* QKV = (const bf16_t*)(wsb + WS_QKV); const float* KS = (const float*)(wsb + WS_KSUM);
        LAS float* gk = (LAS float*)((LAS unsigned char*)lds + fc::R_GK); LAS unsigned* sel_l = (LAS unsigned*)((LAS unsigned char*)lds + fc::R_SEL);
        for (int i = tid; i < n * 128; i += NTHREADS) { const float* kp = KS + (size_t)(b * 8 + (i >> 7)) * DM + h * HD + (i & 127); gk[i] = kp[0] + kp[(size_t)32 * DM]; }
        __syncthreads();
        const int row = tid >> 1, half = tid & 1;
        const u32x4* qp = (const u32x4*)(QKV + (size_t)(R0 + row) * DM + h * HD + half * 64);
        float gt[7];
#pragma unroll
        for (int j = 0; j < 7; ++j) gt[j] = 0.f;
#pragma unroll
        for (int c = 0; c < 8; ++c) { const u32x4 w = qp[c]; const float q0 = bflo(w.x), q1 = bfhi(w.x), q2 = bflo(w.y), q3 = bfhi(w.y), q4 = bflo(w.z), q5 = bfhi(w.z), q6 = bflo(w.w), q7 = bfhi(w.w);
#pragma unroll
            for (int j = 0; j < 7; ++j) if (j < n) { const LAS f32x4* kk = (const LAS f32x4*)(gk + j * 128 + half * 64 + c * 8); const f32x4 ka = kk[0], kb2 = kk[1];
                gt[j] += (q0 * ka.x + q1 * ka.y) + (q2 * ka.z + q3 * ka.w) + (q4 * kb2.x + q5 * kb2.y) + (q6 * kb2.z + q7 * kb2.w); } }
#pragma unroll
        for (int j = 0; j < 7; ++j) gt[j] += sx<1>(gt[j]);
        unsigned mask = 0;
#pragma unroll
        for (int j = 0; j < 7; ++j) if (j < n) { int rank = 0;
#pragma unroll
            for (int j2 = 0; j2 < 7; ++j2) if (j2 < n && (gt[j2] > gt[j] || (gt[j2] == gt[j] && j2 < j))) ++rank;
            if (rank < 3) mask |= 1u << j; }
        if (half == 0) sel_l[row] = mask;
        __syncthreads();
        sel = sel_l[(tid >> 6) * 32 + (tid & 31)];
    }
    return sel;
}
__device__ __forceinline__ void attn_b_pipe(unsigned char* lds, int wv) {
    CParams& P = PP();
    const int tid = otid(wv);
    const unsigned char* wsb = P.ws;
    constexpr int TOTAL = NB * NH * 4;
    int it = obid(); if (it >= TOTAL) return;
    int pass = 0;
    fb::Blk cur = blk_b(it, 0);
    fb::Seam S;
    fb::prime(wsb, cur, lds, S, tid);
    for (;;) {
        int itn = it, passn = pass + 1; if (passn == 2) { passn = 0; itn = it + (int)gridDim.x; }
        const bool last = itn >= TOTAL;
        const fb::Blk nb = last ? cur : blk_b(itn, passn);
        const fb::Nxt nxt{nb.qoff, nb.koff, nb.voff, nb.kb0};
        const int vi = vit_b(it), bh = vi >> 2, s = vi & 3, n = pass ? 7 - s : s;
        const unsigned sel = moba_gate(wsb, lds, bh >> 4, bh & 15, n, cur.R0, tid);
        fb::block<1>(wsb, cur, nxt, sel, lds, S, tid);
        if (last) break;
        cur = nb; it = itn; pass = passn;
    }
}

__device__ __forceinline__ fc::Blk cblk_a(int it) { const fb::Blk b = blk_a(it); const int h = it & 15, g = it >> 9;
    fc::Blk c{b.qoff, b.koff, b.voff, b.ooff, b.xoff, 0u, 0u, b.R0, b.kb0, b.NT, b.slopeL, b.L, b.base0};
    if (g == 2) { c.ooff = (unsigned)(WS_OG + (size_t)(h * HD) * 2); c.xoff = (unsigned)(WS_LSE + (size_t)h * 4); c.zoff = (unsigned)(WS_Z + (size_t)(h * HD) * 2); c.goff = (unsigned)(WS_G + (size_t)(h * HD) * 2); }
    return c; }
__device__ __forceinline__ fc::Blk cblk_b(int it, int pass) { const fb::Blk b = blk_b(it, pass); return fc::Blk{b.qoff, b.koff, b.voff, b.ooff, b.xoff, 0u, 0u, b.R0, b.kb0, b.NT, b.slopeL, b.L, b.base0}; }
template <int MODE>
__device__ __forceinline__ void attn_a_dma(unsigned char* lds, int wv, int first, int count) {
    CParams& P = PP();
    const int tid = otid(wv);
    const unsigned char* wsb = P.ws;
    int it = obid(); if (it >= count) return;
    fc::Blk cur = cblk_a(first + it);
    bf16x8 qr[8]; fc::Ring rg;
    fc::prime(wsb, cur, lds, qr, rg, tid);
    for (;;) {
        const int itn = it + (int)gridDim.x; const bool last = itn >= count;
        const fc::Blk nb = last ? cur : cblk_a(first + itn);
        const fc::Nxt nxt{nb.qoff, nb.koff, nb.voff, nb.kb0};
        fc::block<MODE>(wsb, cur, nxt, !last, 0u, lds, qr, rg, tid);
        if (last) break;
        cur = nb; it = itn;
    }
}
__device__ __forceinline__ void attn_b_dma(unsigned char* lds, int wv) {
    CParams& P = PP();
    const int tid = otid(wv);
    const unsigned char* wsb = P.ws;
    constexpr int TOTAL = NB * NH * 4;
    int it = obid(); if (it >= TOTAL) return;
    int pass = 0;
    fc::Blk cur = cblk_b(it, 0);
    bf16x8 qr[8]; fc::Ring rg;
    fc::prime(wsb, cur, lds, qr, rg, tid);
    for (;;) {
        int itn = it, passn = pass + 1; if (passn == 2) { passn = 0; itn = it + (int)gridDim.x; }
        const bool last = itn >= TOTAL;
        const fc::Blk nb = last ? cur : cblk_b(itn, passn);
        const fc::Nxt nxt{nb.qoff, nb.koff, nb.voff, nb.kb0};
        const int vi = vit_b(it), bh = vi >> 2, s = vi & 3, n = pass ? 7 - s : s;
        const unsigned sel = moba_gate(wsb, lds, bh >> 4, bh & 15, n, cur.R0, tid);
        fc::block<1>(wsb, cur, nxt, !last, sel, lds, qr, rg, tid);
        if (last) break;
        cur = nb; it = itn; pass = passn;
    }
}

__device__ __forceinline__ unsigned moba_gate2(const unsigned char* wsb, unsigned char* lds, int b, int h, int n, int R0, int tid) {
    unsigned sel = (1u << n) - 1u;
    if (n >= 4) {
        asm volatile("" : "+v"(tid));
        const int grp = tid >> 8, tin = tid & 255;
        const bf16_t* QKV = (const bf16_t*)(wsb + WS_QKV); const float* KS = (const float*)(wsb + WS_KSUM);
        LAS float* gk = (LAS float*)((LAS unsigned char*)lds + fc::R_GK) + grp * (7 * 128); LAS unsigned* sel_l = (LAS unsigned*)((LAS unsigned char*)lds + fc::R_SEL);
        for (int i = tin; i < n * 128; i += 256) { const float* kp = KS + (size_t)(b * 8 + (i >> 7)) * DM + h * HD + (i & 127); gk[i] = kp[0] + kp[(size_t)32 * DM]; }
        __syncthreads();
        const int row = grp * 128 + (tin >> 1), half = tin & 1;
        const u32x4* qp = (const u32x4*)(QKV + (size_t)(R0 + row) * DM + h * HD + half * 64);
        float gt[7];
#pragma unroll
        for (int j = 0; j < 7; ++j) gt[j] = 0.f;
#pragma unroll
        for (int c = 0; c < 8; ++c) { const u32x4 w = qp[c]; const float q0 = bflo(w.x), q1 = bfhi(w.x), q2 = bflo(w.y), q3 = bfhi(w.y), q4 = bflo(w.z), q5 = bfhi(w.z), q6 = bflo(w.w), q7 = bfhi(w.w);
#pragma unroll
            for (int j = 0; j < 7; ++j) if (j < n) { const LAS f32x4* kk = (const LAS f32x4*)(gk + j * 128 + half * 64 + c * 8); const f32x4 ka = kk[0], kb2 = kk[1];
                gt[j] += (q0 * ka.x + q1 * ka.y) + (q2 * ka.z + q3 * ka.w) + (q4 * kb2.x + q5 * kb2.y) + (q6 * kb2.z + q7 * kb2.w); } }
#pragma unroll
        for (int j = 0; j < 7; ++j) gt[j] += sx<1>(gt[j]);
        unsigned mask = 0;
#pragma unroll
        for (int j = 0; j < 7; ++j) if (j < n) { int rank = 0;
#pragma unroll
            for (int j2 = 0; j2 < 7; ++j2) if (j2 < n && (gt[j2] > gt[j] || (gt[j2] == gt[j] && j2 < j))) ++rank;
            if (rank < 3) mask |= 1u << j; }
        if (half == 0) sel_l[row] = mask;
        __syncthreads();
        sel = sel_l[(tid >> 6) * 32 + (tid & 31)];
    }
    return sel;
}
__device__ __forceinline__ void attn_a_hs(unsigned char* lds, int wv) {
    CParams& P = PP();
    const int tid = otid(wv);
    const unsigned char* wsb = P.ws;
    constexpr int TOTAL = 3 * NH * (MTOK / 256);
    int it = obid(); if (it >= TOTAL) return;
    fc::Blk cur = cblk_a(it);
    bf16x8 qr[8]; fc::Ring rg;
    fd::prime(wsb, cur, lds, qr, rg, tid);
    for (;;) {
        const int itn = it + (int)gridDim.x; const bool last = itn >= TOTAL;
        const fc::Blk nb = last ? cur : cblk_a(itn);
        const fc::Nxt nxt{nb.qoff, nb.koff, nb.voff, nb.kb0};
        fd::block<0>(wsb, cur, nxt, !last, 0u, lds, qr, rg, tid);
        if (last) break;
        cur = nb; it = itn;
    }
    fd::finish(tid);
}
__device__ __forceinline__ void attn_b_hs(unsigned char* lds, int wv) {
    CParams& P = PP();
    const int tid = otid(wv);
    const unsigned char* wsb = P.ws;
    constexpr int TOTAL = NB * NH * 4;
    int it = obid(); if (it >= TOTAL) return;
    int pass = 0;
    fc::Blk cur = cblk_b(it, 0);
    bf16x8 qr[8]; fc::Ring rg;
    fd::prime(wsb, cur, lds, qr, rg, tid);
    for (;;) {
        int itn = it, passn = pass + 1; if (passn == 2) { passn = 0; itn = it + (int)gridDim.x; }
        const bool last = itn >= TOTAL;
        const fc::Blk nb = last ? cur : cblk_b(itn, passn);
        const fc::Nxt nxt{nb.qoff, nb.koff, nb.voff, nb.kb0};
        const int vi = vit_b(it), bh = vi >> 2, s = vi & 3, n = pass ? 7 - s : s;
        const unsigned sel = moba_gate2(wsb, lds, bh >> 4, bh & 15, n, cur.R0, tid);
        fd::block<1>(wsb, cur, nxt, !last, sel, lds, qr, rg, tid);
        if (last) break;
        cur = nb; it = itn; pass = passn;
    }
    fd::finish(tid);
}

__device__ __forceinline__ void attn_a_flash(unsigned char* lds, int wv) {
    CParams& P = PP();
    const int tid = otid(wv);
    const bf16_t* QKV = (const bf16_t*)(P.ws + WS_QKV); bf16_t* OG = (bf16_t*)(P.ws + WS_OG); float* LSE = (float*)(P.ws + WS_LSE);
    for (int it = obid(); it < 3 * NH * (MTOK / 256); it += gridDim.x) {
        const int g = it >> 9, rem = it & 511, h = rem & 15, rb = rem >> 4;
        const int lg = 2 * g, L = SEQ >> lg, R0 = rb * 256;
        int krow0 = R0 - 128; { const int s0 = R0 & ~(L - 1); if (krow0 < s0) krow0 = s0; }
        const int NT = (R0 + 256 - krow0) >> 6;
        const fa::MaskA mk{L};
        fa::flash_block<0>(QKV + (size_t)(3 * g) * PART + (size_t)R0 * DM + h * HD, QKV + (size_t)(3 * g + 1) * PART + h * HD, QKV + (size_t)(3 * g + 2) * PART + h * HD,
                           krow0, NT, R0, slope_of(h) * (float)(1 << lg) * LOG2E, mk, lds, OG + (size_t)g * PART + h * HD, LSE + (size_t)g * MTOK * NH + h, nullptr, tid);
    }
}
__device__ __forceinline__ void attn_b_flash(unsigned char* lds, int wv) {
    CParams& P = PP();
    const int tid = otid(wv);
    const bf16_t* QKV = (const bf16_t*)(P.ws + WS_QKV); const bf16_t* Z = (const bf16_t*)(P.ws + WS_Z); bf16_t* G = (bf16_t*)(P.ws + WS_G); const float* KS = (const float*)(P.ws + WS_KSUM);
    LAS float* gk = (LAS float*)((LAS unsigned char*)lds + fa::OFF_GK); LAS unsigned* sel_l = (LAS unsigned*)((LAS unsigned char*)lds + fa::OFF_SEL);
    for (int it = obid(); it < NB * NH * 4; it += gridDim.x) {
        const int bh = it >> 2, s = it & 3, b = bh >> 4, h = bh & 15;
        for (int pass = 0; pass < 2; ++pass) {
            const int n = pass ? 7 - s : s, R0 = (b << 11) + (n << 8);
            unsigned sel = (1u << n) - 1u;
            if (n >= 4) {
                for (int i = tid; i < n * 128; i += NTHREADS) { const float* kp = KS + (size_t)(b * 8 + (i >> 7)) * DM + h * HD + (i & 127); gk[i] = kp[0] + kp[(size_t)32 * DM]; }
                __syncthreads();
                const int row = tid >> 1, half = tid & 1;
                const u32x4* qp = (const u32x4*)(QKV + (size_t)(R0 + row) * DM + h * HD + half * 64);
                float gt[7];
#pragma unroll
                for (int j = 0; j < 7; ++j) gt[j] = 0.f;
#pragma unroll
                for (int c = 0; c < 8; ++c) { const u32x4 w = qp[c]; const float q0 = bflo(w.x), q1 = bfhi(w.x), q2 = bflo(w.y), q3 = bfhi(w.y), q4 = bflo(w.z), q5 = bfhi(w.z), q6 = bflo(w.w), q7 = bfhi(w.w);
#pragma unroll
                    for (int j = 0; j < 7; ++j) if (j < n) { const LAS f32x4* kk = (const LAS f32x4*)(gk + j * 128 + half * 64 + c * 8); const f32x4 ka = kk[0], kb2 = kk[1];
                        gt[j] += (q0 * ka.x + q1 * ka.y) + (q2 * ka.z + q3 * ka.w) + (q4 * kb2.x + q5 * kb2.y) + (q6 * kb2.z + q7 * kb2.w); } }
#pragma unroll
                for (int j = 0; j < 7; ++j) gt[j] += sx<1>(gt[j]);
                unsigned mask = 0;
#pragma unroll
                for (int j = 0; j < 7; ++j) if (j < n) { int rank = 0;
#pragma unroll
                    for (int j2 = 0; j2 < 7; ++j2) if (j2 < n && (gt[j2] > gt[j] || (gt[j2] == gt[j] && j2 < j))) ++rank;
                    if (rank < 3) mask |= 1u << j; }
                if (half == 0) sel_l[row] = mask;
                __syncthreads();
                sel = sel_l[(tid >> 6) * 32 + (tid & 31)];
            }
            const fa::MaskB mk{R0, b << 11, sel};
            fa::flash_block<1>(QKV + (size_t)R0 * DM + h * HD, QKV + PART + h * HD, QKV + 2 * PART + h * HD, b << 11, 4 * (n + 1), R0, slope_of(h) * LOG2E, mk, lds,
                               G + h * HD, nullptr, Z + h * HD, tid);
        }
    }
}

#define XB_TMO      128
#define XB_XCNT(j)  (256  + 64 * (j))
#define XB_XSUB(j)  (1280 + 64 * (j))
#define XB_XGEN(j)  (2304 + 64 * (j))
#define XB_TOP      3328
#define XB_TOPGEN   3392
#define XCD_BAR_WORDS 3456
#define XB_SPIN_CAP (1u << 20)
__device__ __forceinline__ unsigned xb_ld(unsigned* p)              { return __hip_atomic_load(p, __ATOMIC_RELAXED, __HIP_MEMORY_SCOPE_AGENT); }
__device__ __forceinline__ unsigned xb_add(unsigned* p, unsigned v) { return __hip_atomic_fetch_add(p, v, __ATOMIC_RELAXED, __HIP_MEMORY_SCOPE_AGENT); }
__device__ __forceinline__ unsigned xb_xcc_id() { return (unsigned)__builtin_amdgcn_s_getreg((3 << 11) | 20) & 0xFu; }
#define XB_SPIN(cond, bar) do { unsigned _sp = 0; while (cond) { __builtin_amdgcn_s_sleep(1); \
    if ((++_sp & 255u) == 0u) { if (xb_ld(&(bar)[XB_TMO])) break; if (_sp > XB_SPIN_CAP) { atomicAdd(&(bar)[XB_TMO], 1u); break; } } } } while (0)
struct XcdBarrier { unsigned* bar; unsigned x; volatile LAS unsigned* st; };
__device__ __forceinline__ XcdBarrier xcd_barrier_post(unsigned* bar, volatile LAS unsigned* st) {
    XcdBarrier b; b.bar = bar; b.x = xb_xcc_id(); b.st = st;
    if (threadIdx.x == 0) (void)xb_add(&bar[XB_XCNT(b.x)], 1u);
    return b;
}
__device__ __forceinline__ void xcd_barrier_complete(unsigned* bar, unsigned x, unsigned& nloc, unsigned& nx) {
    const unsigned G = gridDim.x * gridDim.y * gridDim.z;
    unsigned sum, cnt, mine, sp = 0u;
    for (;;) {
        sum = 0u; cnt = 0u; mine = 0u;
#pragma unroll
        for (unsigned j = 0; j < 16; ++j) { const unsigned c = xb_ld(&bar[XB_XCNT(j)]); sum += c; cnt += (c > 0u) ? 1u : 0u; mine = (j == x) ? c : mine; }
        if (sum == G) break;
        __builtin_amdgcn_s_sleep(1);
        if ((++sp & 255u) == 0u) { if (xb_ld(&bar[XB_TMO])) break; if (sp > XB_SPIN_CAP) { atomicAdd(&bar[XB_TMO], 1u); break; } }
    }
    nloc = mine > 0u ? mine : 1u; nx = cnt > 0u ? cnt : 1u;
}
__device__ __forceinline__ void xcd_barrier(const XcdBarrier& b) {
    asm volatile("s_waitcnt vmcnt(0)" ::: "memory");
    __syncthreads();
    if (threadIdx.x == 0) {
        unsigned* bar = b.bar;
        __builtin_amdgcn_s_waitcnt(0);
        unsigned nloc = b.st[0], nx = b.st[1];
        if (nloc == 0u) { xcd_barrier_complete(bar, b.x, nloc, nx); b.st[0] = nloc; b.st[1] = nx; }
        const unsigned old = xb_add(&bar[XB_XSUB(b.x)], 1u);
        const unsigned gen = old / nloc;
        if (old + 1u == (gen + 1u) * nloc) {
            __builtin_amdgcn_fence(__ATOMIC_RELEASE, "agent");
            asm volatile("s_waitcnt vmcnt(0)" ::: "memory");
            const unsigned og = xb_add(&bar[XB_TOP], 1u);
            const unsigned tg = og / nx;
            if (og + 1u == (tg + 1u) * nx) xb_add(&bar[XB_TOPGEN], 1u);
            else XB_SPIN(xb_ld(&bar[XB_TOPGEN]) == tg, bar);
            __builtin_amdgcn_fence(__ATOMIC_ACQUIRE, "agent");
            xb_add(&bar[XB_XGEN(b.x)], 1u);
            asm volatile("s_waitcnt vmcnt(0)" ::: "memory");
        } else {
            XB_SPIN(xb_ld(&bar[XB_XGEN(b.x)]) == gen, bar);
            __builtin_amdgcn_fence(__ATOMIC_ACQUIRE, "agent");
            asm volatile("s_waitcnt vmcnt(0)" ::: "memory");
        }
    }
    __syncthreads();
}

__global__ void __launch_bounds__(NTHREADS, 2) fwd_mega(Params Pin) {
    extern __shared__ __attribute__((aligned(16))) unsigned char lds[];
#if USE_CG_SYNC
    cg::grid_group grid = cg::this_grid();
#endif
    LAS unsigned char* lds3 = (LAS unsigned char*)lds;
    (void)Pin;
    const int wv = __builtin_amdgcn_readfirstlane((int)threadIdx.x >> 6);
    volatile LAS unsigned* bst = (volatile LAS unsigned*)(lds3 + (LDS_BYTES - 64));
    if (threadIdx.x < 2) bst[threadIdx.x] = 0u;
    __syncthreads();
    (void)xcd_barrier_post((unsigned*)(PP().ws + WS_CTL), bst);
#define GSYNC() do { XcdBarrier xb_; xb_.bar = (unsigned*)(PP().ws + WS_CTL); xb_.x = xb_xcc_id(); xb_.st = bst; xcd_barrier(xb_); } while (0)
    p0_mod(lds, wv);
    p0_weights(lds, wv);
#if PROBE == 1
    __syncthreads(); p0_mod(lds, wv); p0_weights(lds, wv);
#endif
#if USE_CG_SYNC
    grid.sync();
#else
    GSYNC();
#endif
    for (int layer = 0; layer < DEPTH; ++layer) {
        const bool isA = (layer & 1) == 0; const int j = layer >> 1;
        norm_phase(layer, !isA && !MOBA_QK_I8, wv);
#if PROBE == 2
        norm_phase(layer, !isA && !MOBA_QK_I8, wv);
#endif
#if PROBE == 6
        GSYNC(); GSYNC(); GSYNC(); GSYNC(); GSYNC();
#endif
        GSYNC();
        {
#if !MOBA_QK_I8
            if (!isA) {
                unsigned char* ws = PP().ws;
                pg8::Gemm g{ws + WS_H, ws + WS_WBQK + (size_t)j * 4096 * DM * 2, MTOK, 4096, DM * 2};
                pg8::StaticOrder S; S.init(MTOK, 4096, (int)gridDim.x, obid());
                pg8::EpiIn E{1, 0, (bf16_t*)(ws + WS_QKV), (bf16_t*)(ws + WS_Z), (float*)(ws + WS_KSUM), nullptr, nullptr, nullptr, nullptr, nullptr};
                pg8::gemm_phase<pg8::EpiIn, pg8::StaticOrder, GEMM_ALIGN, GEMM_SP2, false>(lds3, g, S, E, wv);
            }
#endif
            {
                unsigned char* ws = PP().ws;
#if MOBA_QK_I8
                pg8::Gemm g{ws + WS_HQ, isA ? ws + WS_WAIN + (size_t)j * A_N * DM : ws + WS_WBQK + (size_t)j * B_N * DM, MTOK, isA ? A_N : B_N, DM};
                pg8::StaticOrder S; S.init(MTOK, g.N, (int)gridDim.x, obid());
                pg8::EpiIn E{isA ? 0 : 1, 0, (bf16_t*)(ws + WS_QKV), (bf16_t*)(ws + WS_Z), (float*)(ws + WS_KSUM), (const float*)(ws + WS_RS),
                           isA ? (const float*)(ws + WS_CSA) + j * A_N : (const float*)(ws + WS_CSB) + j * B_N, nullptr, nullptr, nullptr};
#else
                pg8::Gemm g{ws + WS_HQ, isA ? ws + WS_WAIN + (size_t)j * A_N * DM : ws + WS_WBVZ + (size_t)j * 4096 * DM, MTOK, isA ? A_N : 4096, DM};
                pg8::StaticOrder S; S.init(MTOK, g.N, (int)gridDim.x, obid());
                pg8::EpiIn E{isA ? 0 : 1, isA ? 0 : 2, (bf16_t*)(ws + WS_QKV), (bf16_t*)(ws + WS_Z), nullptr, (const float*)(ws + WS_RS),
                           isA ? (const float*)(ws + WS_CSA) + j * A_N : (const float*)(ws + WS_CSB) + j * 4096, nullptr, nullptr, nullptr};
#endif
#if STAGGER_TICKS > 0
                if (isA) {
                    const unsigned long long t0_ = __builtin_amdgcn_s_memrealtime(); const unsigned long long dl_ = (unsigned long long)((obid() >> 3) & 7) * STAGGER_TICKS;
                    while (__builtin_amdgcn_s_memrealtime() - t0_ < dl_) __builtin_amdgcn_s_sleep(8);
                }
#endif
                pg8::gemm_phase<pg8::EpiIn, pg8::StaticOrder, GEMM_ALIGN, GEMM_SP2, true>(lds3, g, S, E, wv);
#if PROBE == 7
                pg8::gemm_phase<pg8::EpiIn, pg8::StaticOrder, GEMM_ALIGN, GEMM_SP2, true>(lds3, g, S, E, wv);
#endif
#if PROBE == 12 || PROBE == 13
                if (isA) { pg8::EpiIn E3 = E; E3.mode = PROBE == 12 ? 6 : 7; E3.qkv = (bf16_t*)(ws + WS_OG); pg8::gemm_phase<pg8::EpiIn, pg8::StaticOrder, GEMM_ALIGN, GEMM_SP2, true>(lds3, g, S, E3, wv); }
#endif
#if PROBE == 10 || PROBE == 11
                if (isA) { pg8::EpiIn E3 = E; E3.mode = PROBE == 10 ? 4 : 5; E3.qkv = (bf16_t*)(ws + WS_OG); pg8::gemm_phase<pg8::EpiIn, pg8::StaticOrder, GEMM_ALIGN, GEMM_SP2, true>(lds3, g, S, E3, wv); }
#endif
#if PROBE == 9
                { pg8::EpiIn E3 = E; E3.mode = 3; pg8::gemm_phase<pg8::EpiIn, pg8::StaticOrder, GEMM_ALIGN, GEMM_SP2, true>(lds3, g, S, E3, wv); }
#endif
            }
        }
        GSYNC();
#if PROBE == 3
        if (isA) attn_a_dma<0>(lds, wv, 0, 1024);
#endif
#if PROBE == 4
        if (!isA) attn_b_hs(lds, wv);
#endif
#if ATTN_HS
        if (isA) { attn_a_hs(lds, wv); GSYNC(); combine_phase(wv);
#elif ATTN_DMA
#if FUSE_COMBINE && !OUTA_I8
        if (isA) { attn_a_dma<0>(lds, wv, 0, 1024); GSYNC(); attn_a_dma<2>(lds, wv, 1024, 512);
#if PROBE == 14
            attn_a_dma<2>(lds, wv, 1024, 512);
#endif
#else
        if (isA) { attn_a_dma<0>(lds, wv, 0, 1536); GSYNC(); combine_phase(wv);
#endif
#elif ATTN_PIPE
        if (isA) { attn_a_pipe(lds, wv); GSYNC(); combine_phase(wv);
#else
        if (isA) { attn_a_flash(lds, wv); GSYNC(); combine_phase(wv);
#endif
#if PROBE == 5
            combine_phase(wv);
#endif
        }
#if ATTN_HS
        else { attn_b_hs(lds, wv); }
#elif ATTN_DMA
        else { attn_b_dma(lds, wv); }
#elif ATTN_PIPE
        else { attn_b_pipe(lds, wv); }
#else
        else { attn_b_flash(lds, wv); }
#endif
        GSYNC();
        {
            CParams& P = PP(); unsigned char* ws = P.ws;
            const bool i8o = OUTA_I8 && isA;
            pg8::Gemm g{i8o ? ws + WS_HQ : ws + WS_G, isA ? ws + WS_WAOUT + (size_t)j * DM * DM * (OUTA_I8 ? 1 : 2) : ws + WS_WBOUT + (size_t)j * DM * DM * 2, MTOK, DM, i8o ? DM : DM * 2};
            pg8::StaticOrder S; S.init(MTOK, DM, (int)gridDim.x, obid());
            pg8::EpiOut E{2, 0, nullptr, nullptr, nullptr, (const float*)(ws + WS_RS), (const float*)(ws + WS_CSO) + j * DM, layer == 0 ? P.x : P.out, P.out, (const float*)(ws + WS_MOD) + (size_t)layer * 4 * 6144 + 4096};
            {
                pg8::Unit u0; int ui = 0;
                while (S.next(ui, u0)) { const int t_ = otid(wv); const int w_ = __builtin_amdgcn_readfirstlane(t_ >> 6);
                    const float* xt = E.xin + (size_t)(u0.pm * 256 + (t_ >> 1)) * DM + u0.pn * 256 + (t_ & 1) * 128;
#pragma unroll
                    for (int q = 0; q < 4; ++q) __builtin_amdgcn_global_load_lds((const unsigned*)(xt + q * 32), (LAS unsigned*)(lds3 + 131072 + w_ * 1024 + q * 256), 4, 0, 0);
                    ++ui; } }
#if OUTA_I8
            if (isA) pg8::gemm_phase<pg8::EpiOut, pg8::StaticOrder, GEMM_ALIGN, GEMM_SP2, true>(lds3, g, S, E, wv);
            else
#endif
            pg8::gemm_phase<pg8::EpiOut, pg8::StaticOrder, GEMM_ALIGN, GEMM_SP2, false>(lds3, g, S, E, wv);
        }
        GSYNC();
    }
    final_norm_phase(wv);
}

extern "C" void kernel_launch(void* const* d_in, const int* in_sizes, int n_in, void* d_out, int out_size, void* d_ws, size_t ws_size, hipStream_t stream) {
    static int grid = 0;
    if (grid == 0) {
        if (n_in != 10 || in_sizes[0] != MTOK * DM || out_size != MTOK * DM || ws_size < WS_END) {
            fprintf(stderr, "kernel_launch: unexpected shapes/workspace (n_in %d, in0 %d, out %d, ws %zu, need %zu)\n", n_in, n_in > 0 ? in_sizes[0] : -1, out_size, ws_size, (size_t)WS_END); grid = -1; return; }
        int dev = 0, cus = 0, per_cu = 0;
        (void)hipGetDevice(&dev); (void)hipDeviceGetAttribute(&cus, hipDeviceAttributeMultiprocessorCount, dev);
        if (hipFuncSetAttribute((const void*)fwd_mega, hipFuncAttributeMaxDynamicSharedMemorySize, LDS_BYTES) != hipSuccess) { fprintf(stderr, "kernel_launch: hipFuncSetAttribute failed\n"); grid = -1; return; }
        if (hipOccupancyMaxActiveBlocksPerMultiprocessor(&per_cu, (const void*)fwd_mega, NTHREADS, LDS_BYTES) != hipSuccess || per_cu < 1) { fprintf(stderr, "kernel_launch: occupancy query says %d\n", per_cu); (void)hipGetLastError(); per_cu = 1; }
        if (per_cu > 1) per_cu = 1;
        grid = cus * per_cu;
    }
    if (grid < 0) return;
    (void)hipMemsetAsync((char*)d_ws + WS_CTL, 0, 16384, stream);
    Params p{};
    p.x = (const float*)d_in[0]; p.c = (const float*)d_in[1]; p.norm_w = (const float*)d_in[2]; p.mod_w = (const float*)d_in[3]; p.mod_b = (const float*)d_in[4];
    p.a_w_in = (const float*)d_in[5]; p.a_w_out = (const float*)d_in[6]; p.b_w_in = (const float*)d_in[7]; p.b_w_out = (const float*)d_in[8]; p.final_w = (const float*)d_in[9];
    p.out = (float*)d_out; p.ws = (unsigned char*)d_ws;
    void* args[] = {&p};
    hipError_t e = hipLaunchCooperativeKernel((const void*)fwd_mega, dim3(grid), dim3(NTHREADS), args, LDS_BYTES, stream);
    if (e != hipSuccess) fprintf(stderr, "kernel_launch: cooperative launch failed: %s (grid %d)\n", hipGetErrorString(e), grid);
}
```

```cpp
#include <hip/hip_runtime.h>
#include <hip/hip_cooperative_groups.h>
#include <cstdio>
#include <cstdint>
namespace cg = cooperative_groups;
#ifndef ATTN_A_FLASH
#define ATTN_A_FLASH 1
#endif
#ifndef GEMM_ALIGN
#define GEMM_ALIGN true
#endif
#ifndef GEMM_SP2
#define GEMM_SP2 true
#endif
#ifndef PROBE
#define PROBE 0
#endif
#ifndef MOBA_QK_I8
#define MOBA_QK_I8 1
#endif
#ifndef OUTA_I8
#define OUTA_I8 0
#endif
#ifndef GCLIP
#define GCLIP 1.0e9f
#endif
#ifndef STAGGER_TICKS
#define STAGGER_TICKS 0
#endif
#ifndef USE_CG_SYNC
#define USE_CG_SYNC 0
#endif
#ifndef ATTN_PIPE
#define ATTN_PIPE 1
#endif
#ifndef EPI_SC1
#define EPI_SC1 1
#endif
#ifndef FUSE_COMBINE
#define FUSE_COMBINE 1
#endif
#ifndef ATTN_DMA
#define ATTN_DMA 1
#endif
#ifndef ATTN_HS
#define ATTN_HS 0
#endif
#ifndef ATTN_B_FLASH
#define ATTN_B_FLASH 1
#endif

#define LAS __attribute__((address_space(3)))
typedef unsigned short bf16_t;
typedef short bf16x8 __attribute__((ext_vector_type(8)));
typedef short s16x4 __attribute__((ext_vector_type(4)));
typedef float f32x4 __attribute__((ext_vector_type(4)));
typedef float f32x16 __attribute__((ext_vector_type(16)));
typedef unsigned u32x4 __attribute__((ext_vector_type(4)));
typedef unsigned u32x2 __attribute__((ext_vector_type(2)));
typedef int i32x4 __attribute__((ext_vector_type(4)));

constexpr int NB = 4, SEQ = 2048, DM = 2048, MTOK = NB * SEQ, NH = 16, HD = 128, DEPTH = 4;
constexpr int A_N = 10 * DM, B_N = 4 * DM;
constexpr float EPS = 1e-6f;
constexpr float LOG2E = 1.4426950408889634f;
constexpr float C2Q = 0.08838834764831845f * LOG2E;

constexpr size_t MiB = 1u << 20;
constexpr size_t WS_CTL = 0;
constexpr size_t WS_MOD = 1 * MiB;
constexpr size_t WS_KSUM = 2 * MiB;
constexpr size_t WS_LSE = 3 * MiB;
constexpr size_t WS_RS = 5 * MiB;
constexpr size_t WS_CSA = 6 * MiB;
constexpr size_t WS_CSB = 7 * MiB;
constexpr size_t WS_CSO = 7 * MiB + 512 * 1024;
constexpr size_t WS_WAIN = 8 * MiB;
constexpr size_t WS_WBQK = WS_WAIN + 80 * MiB;
constexpr size_t WS_WBVZ = WS_WBQK + 32 * MiB;
constexpr size_t WS_WAOUT = WS_WBVZ + 16 * MiB;
constexpr size_t WS_WBOUT = WS_WAOUT + 16 * MiB;
constexpr size_t WS_H = WS_WBOUT + 16 * MiB;
constexpr size_t WS_HQ = WS_H + 32 * MiB;
constexpr size_t WS_G = WS_HQ + 16 * MiB;
constexpr size_t WS_QKV = WS_G + 32 * MiB;
constexpr size_t WS_Z = WS_QKV + 288 * MiB;
constexpr size_t WS_OG = WS_Z + 32 * MiB;
constexpr size_t WS_END = WS_OG + 96 * MiB;
constexpr size_t PART = (size_t)MTOK * DM;

constexpr int LDS_BYTES = 147456;
constexpr int NTHREADS = 512;

typedef float f32x2_t __attribute__((ext_vector_type(2))); typedef __bf16 bf16x2_t __attribute__((ext_vector_type(2)));
__device__ __forceinline__ unsigned cvt_pk_bf16(float lo, float hi) { f32x2_t v = {lo, hi}; bf16x2_t b = __builtin_convertvector(v, bf16x2_t); return __builtin_bit_cast(unsigned, b); }
__device__ __forceinline__ float bf2f(unsigned short v) { return __uint_as_float(((unsigned)v) << 16); }
__device__ __forceinline__ float bflo(unsigned w) { return __uint_as_float(w << 16); }
__device__ __forceinline__ float bfhi(unsigned w) { return __uint_as_float(w & 0xffff0000u); }
__device__ __forceinline__ float wave_sum(float v) {
#pragma unroll
    for (int o = 1; o < 64; o <<= 1) v += __shfl_xor(v, o);
    return v;
}
__device__ __forceinline__ float wave_max(float v) {
#pragma unroll
    for (int o = 1; o < 64; o <<= 1) v = fmaxf(v, __shfl_xor(v, o));
    return v;
}
__device__ __forceinline__ float silu_f(float v) { return v * __builtin_amdgcn_rcpf(1.f + __builtin_amdgcn_exp2f(-1.4426950408889634f * v)); }
#define LDS_WAIT() asm volatile("s_waitcnt lgkmcnt(0)" ::: "memory")
template <class V> __device__ __forceinline__ void store_wt(void* p, V v) { static_assert(sizeof(V) == 16, "16-byte vectors only");
    asm volatile("global_store_dwordx4 %0, %1, off sc0 sc1\n\ts_nop 1" :: "v"(p), "v"(v) : "memory"); }
__device__ __forceinline__ int otid(int wv) { int l; asm volatile("v_mbcnt_lo_u32_b32 %0, -1, 0\n\tv_mbcnt_hi_u32_b32 %0, -1, %0" : "=v"(l)); return (wv << 6) | l; }
template <class T> __device__ __forceinline__ T* optr(T* p) { asm volatile("" : "+s"(p)); return p; }
__device__ __forceinline__ int obid() { int b = blockIdx.x; asm volatile("" : "+s"(b)); return b; }

namespace pg8 {
constexpr int BM = 256, BK = 64, HALF = 128, HTB = HALF * BK * 2, STAGE_BYTES = 8 * HTB, NXCD = 8, WGM = 4;
__host__ __device__ __forceinline__ int lds_byte(int r, int c) { const int st = (r >> 4) * 2 + (c >> 5), rr = r & 15, cc = c & 31, ob = rr * 64 + cc * 2; return st * 1024 + (ob ^ (((ob >> 9) & 1) << 5)); }
__host__ __device__ __forceinline__ void stage_rc(int b, int& R, int& C) { const int st = b / 1024, sb = b % 1024, swz = sb ^ (((sb >> 9) & 1) << 5); R = (st >> 1) * 16 + swz / 64; C = (st & 1) * 32 + (swz % 64) / 2; }
__host__ __device__ __forceinline__ int perm32(int rho) { const int n = rho >> 4, i = rho & 15; return 8 * (i >> 2) + 4 * n + (i & 3); }
struct Unit { int pm, pn; };
struct Gemm { const void* A; const void* Bt; int M, N, KB; };
struct StaticOrder {
    int nM, nN, nwg, G, c;
    __host__ __device__ void init(int M, int N, int G_, int c_) { nM = M / BM; nN = N / BM; nwg = nM * nN; G = G_; c = c_; }
    __host__ __device__ bool next(int i, Unit& u) const {
        const long L = (long)i * G + c; if (L >= nwg) return false;
        int wgid = (int)L; { const int q = nwg / NXCD, r = nwg % NXCD, xcd = wgid % NXCD, off = wgid / NXCD; wgid = (xcd < r ? xcd * (q + 1) : r * (q + 1) + (xcd - r) * q) + off; }
        const int nig = WGM * nN, gid = wgid / nig, fm = gid * WGM, gsz = (nM - fm) < WGM ? (nM - fm) : WGM;
        u.pm = fm + ((wgid % nig) % gsz); u.pn = (wgid % nig) / gsz; return true;
    }
    __device__ __forceinline__ void a_ready(const Unit&) const {}
    __device__ __forceinline__ void done(const Unit&) const {}
};

__device__ __forceinline__ f32x4 acc_f32(const f32x4& a) { return a; }
__device__ __forceinline__ f32x4 acc_f32(const i32x4& a) { return (f32x4){(float)a.x, (float)a.y, (float)a.z, (float)a.w}; }
struct Epi {
    static constexpr bool PERM = true, AFTER_DRAIN = false;
    int mode;
    int pbase;
    bf16_t* qkv; bf16_t* zbuf; float* ksum;
    const float* rs; const float* cs;
    const float* xin; float* xout; const float* gate;
    template <class AccT>
    __device__ __forceinline__ void operator()(const AccT (&acc)[2][2][4][2], const Unit& u, int wr, int wc, int fr, int fq) const {
        constexpr bool I8 = sizeof(AccT) == sizeof(i32x4) && !__is_same(AccT, f32x4);
        if (mode == 3) {
#pragma unroll
            for (int ai = 0; ai < 2; ++ai)
#pragma unroll
                for (int bj = 0; bj < 2; ++bj)
#pragma unroll
                    for (int m = 0; m < 4; ++m)
#pragma unroll
                        for (int n = 0; n < 2; ++n) asm volatile("" :: "v"(acc[ai][bj][m][n]));
            return; }
        if (mode == 2) {
            const int col0 = u.pn * BM + wc * 32 + 8 * fq; const int b = (u.pm * BM) >> 11;
            f32x4 gv[2][2];
#pragma unroll
            for (int bj = 0; bj < 2; ++bj)
#pragma unroll
                for (int n = 0; n < 2; ++n) { gv[bj][n] = *(const f32x4*)(gate + b * 6144 + col0 + bj * HALF + 4 * n); if (I8) gv[bj][n] = gv[bj][n] * *(const f32x4*)(cs + col0 + bj * HALF + 4 * n); }
#pragma unroll
            for (int ai = 0; ai < 2; ++ai) {
                f32x4 xv[4][2][2]; float rsv[4];
#pragma unroll
                for (int m = 0; m < 4; ++m) { const int row = u.pm * BM + ai * HALF + wr * 64 + m * 16 + fr; const size_t off = (size_t)row * DM + col0; rsv[m] = I8 ? rs[row] : 1.f;
#pragma unroll
                    for (int bj = 0; bj < 2; ++bj)
#pragma unroll
                        for (int n = 0; n < 2; ++n) xv[m][bj][n] = *(const f32x4*)(xin + off + bj * HALF + 4 * n); }
                asm volatile("" ::: "memory");
#pragma unroll
                for (int m = 0; m < 4; ++m) { const size_t off = (size_t)(u.pm * BM + ai * HALF + wr * 64 + m * 16 + fr) * DM + col0;
#pragma unroll
                    for (int bj = 0; bj < 2; ++bj)
#pragma unroll
                        for (int n = 0; n < 2; ++n) *(f32x4*)(xout + off + bj * HALF + 4 * n) = xv[m][bj][n] + gv[bj][n] * (acc_f32(acc[ai][bj][m][n]) * rsv[m]); }
                asm volatile("" ::: "memory"); }
            return;
        }
        const int p = pbase + (u.pn >> 3), colt = (u.pn & 7) * BM;
        int lg = 0; float sc = 1.f; bf16_t* base;
        const bool pr_nostore = mode == 4, pr_window = mode == 5, pr_pitch = mode >= 6;
        const int ldo = mode == 6 ? 2112 : DM;
        if (mode == 0 || mode >= 4) { if (p == 9) base = zbuf; else { const int g = p / 3, kind = p - 3 * g; lg = 2 * g; base = qkv + (size_t)p * PART; if (kind == 0) sc = C2Q; } }
        else { if (p == 3) base = zbuf; else { base = qkv + (size_t)p * PART; if (p == 0) sc = C2Q; } }
        const int col0 = colt + wc * 32 + 8 * fq;
        f32x4 cv[2][2];
        if (I8) {
#pragma unroll
            for (int bj = 0; bj < 2; ++bj)
#pragma unroll
                for (int n = 0; n < 2; ++n) cv[bj][n] = *(const f32x4*)(cs + u.pn * BM + wc * 32 + 8 * fq + bj * HALF + 4 * n) * sc;
        }
        float rsa[2][4];
#pragma unroll
        for (int ai = 0; ai < 2; ++ai)
#pragma unroll
            for (int m = 0; m < 4; ++m) rsa[ai][m] = I8 ? rs[u.pm * BM + ai * HALF + wr * 64 + m * 16 + fr] : sc;
#pragma unroll
        for (int ai = 0; ai < 2; ++ai)
#pragma unroll
            for (int m = 0; m < 4; ++m) {
                const int row = u.pm * BM + ai * HALF + wr * 64 + m * 16 + fr, b = row >> 11, t = row & 2047;
                const int R = (b << 11) + ((t & ((1 << lg) - 1)) << (11 - lg)) + (t >> lg);
                bf16_t* rowp = pr_pitch ? (qkv + (size_t)(p % 3) * 4096 * 2112 + (size_t)(R & 4095) * ldo + col0) : (base + (size_t)(pr_window ? (R & 255) : R) * DM + col0);
                const float rsv = rsa[ai][m];
#pragma unroll
                for (int bj = 0; bj < 2; ++bj) { f32x4 v0 = acc_f32(acc[ai][bj][m][0]) * rsv, v1 = acc_f32(acc[ai][bj][m][1]) * rsv;
                    if (I8) { v0 = v0 * cv[bj][0]; v1 = v1 * cv[bj][1]; }
                    u32x4 w; w.x = cvt_pk_bf16(v0[0], v0[1]); w.y = cvt_pk_bf16(v0[2], v0[3]); w.z = cvt_pk_bf16(v1[0], v1[1]); w.w = cvt_pk_bf16(v1[2], v1[3]);
                    if (pr_nostore) asm volatile("" :: "v"(w));
                    else {
#if EPI_SC1
                        asm volatile("global_store_dwordx4 %0, %1, off sc0 sc1\n\ts_nop 1" :: "v"(rowp + bj * HALF), "v"(w) : "memory");
#else
                        *(u32x4*)(rowp + bj * HALF) = w;
#endif
                    } } }
        if (mode == 1 && p == 1) {
#pragma unroll
            for (int bj = 0; bj < 2; ++bj)
#pragma unroll
                for (int n = 0; n < 2; ++n) { f32x4 s = {0.f, 0.f, 0.f, 0.f};
#pragma unroll
                    for (int ai = 0; ai < 2; ++ai)
#pragma unroll
                        for (int m = 0; m < 4; ++m) s += acc_f32(acc[ai][bj][m][n]) * (I8 ? rsa[ai][m] : 1.f);
                    if (I8) s = s * cv[bj][n];
#pragma unroll
                    for (int j = 0; j < 4; ++j) { float v = s[j]; v += __shfl_xor(v, 1); v += __shfl_xor(v, 2); v += __shfl_xor(v, 4); v += __shfl_xor(v, 8); s[j] = v; }
                    if (fr == 0) *(f32x4*)(ksum + ((size_t)(wr * 32 + u.pm) * DM + colt + bj * HALF + wc * 32 + 8 * fq + 4 * n)) = s; }
        }
    }
};

template <bool I8> struct AccSel { typedef f32x4 type; };
template <> struct AccSel<true> { typedef i32x4 type; };
template <bool I8> __device__ __forceinline__ typename AccSel<I8>::type mma1(bf16x8 b, bf16x8 a, typename AccSel<I8>::type c) {
    if constexpr (I8) return __builtin_amdgcn_mfma_i32_16x16x64_i8(__builtin_bit_cast(i32x4, b), __builtin_bit_cast(i32x4, a), c, 0, 0, 0);
    else return __builtin_amdgcn_mfma_f32_16x16x32_bf16(b, a, c, 0, 0, 0);
}
template <class Epi, class Sched, bool ALIGN_EPI = false, bool SP2 = false, bool I8 = false>
__device__ __forceinline__ void gemm_phase(LAS unsigned char* lds, const Gemm g, const Sched& S, const Epi& E, int wv) {
    const int tid = otid(wv), wid = __builtin_amdgcn_readfirstlane(tid >> 6), lane = tid & 63, wr = wid >> 2, wc = wid & 3, fr = lane & 15, fq = lane >> 4;
    const int KBY = g.KB, nt = KBY / (BK * 2);
    unsigned voffA[2], voffB[2];
#pragma unroll
    for (int i = 0; i < 2; ++i) { int R, C; stage_rc(tid * 16 + i * 8192, R, C); const int Rb = Epi::PERM ? ((R & ~31) + perm32(R & 31)) : R;
        voffA[i] = (unsigned)(R * KBY + C * 2); voffB[i] = (unsigned)(Rb * KBY + C * 2); }
    const size_t kstep = (size_t)(BK * 2);
    const size_t hstep = (size_t)HALF * KBY;
    const size_t tstep = 2 * hstep;
    const unsigned ldsw = (unsigned)wid * 1024u;
    const int aoff = lds_byte(wr * 64 + fr, fq * 8), boff = lds_byte(wc * 32 + fr, fq * 8);
#define PG8_SA(b, h) (((b) * 2 + (h)) * HTB)
#define PG8_SB(b, h) ((4 + (b) * 2 + (h)) * HTB)
#define PG8_STAGE(bufoff, gbase, voff) do { _Pragma("unroll") for (int _i = 0; _i < 2; ++_i) \
        __builtin_amdgcn_global_load_lds((const unsigned*)((const char*)(gbase) + (voff)[_i]), (LAS unsigned*)(lds + (bufoff) + ldsw + _i * 8192), 16, 0, 0); } while (0)
#define PG8_LDA(dst, b, h) do { _Pragma("unroll") for (int m = 0; m < 4; ++m) _Pragma("unroll") for (int k = 0; k < 2; ++k) dst[m][k] = *(const LAS bf16x8*)(lds + PG8_SA(b, h) + aoff + m * 2048 + k * 1024); } while (0)
#define PG8_LDB(dst, b, h) do { _Pragma("unroll") for (int n = 0; n < 2; ++n) _Pragma("unroll") for (int k = 0; k < 2; ++k) dst[n][k] = *(const LAS bf16x8*)(lds + PG8_SB(b, h) + boff + n * 2048 + k * 1024); } while (0)
#define PG8_MMA(ai, bj, At, Bt) do { __builtin_amdgcn_s_setprio(1); _Pragma("unroll") for (int m = 0; m < 4; ++m) _Pragma("unroll") for (int n = 0; n < 2; ++n) _Pragma("unroll") for (int k = 0; k < 2; ++k) \
        acc[ai][bj][m][n] = mma1<I8>(Bt[n][k], At[m][k], acc[ai][bj][m][n]); __builtin_amdgcn_s_setprio(0); } while (0)
#define PG8_WAIT_V(n) asm volatile("s_waitcnt vmcnt(" #n ")" ::: "memory")
#define PG8_WAIT_L(n) asm volatile("s_waitcnt lgkmcnt(" #n ")" ::: "memory")
#define PG8_BAR __builtin_amdgcn_s_barrier()
#define PG8_SCHED __builtin_amdgcn_sched_barrier(0)
    Unit cur, nxt; int ui = 0;
    if (!S.next(0, cur)) return;
    typedef typename AccSel<I8>::type acc_t;
    acc_t acc[2][2][4][2];
#pragma unroll
    for (int a = 0; a < 2; ++a)
#pragma unroll
        for (int b = 0; b < 2; ++b)
#pragma unroll
            for (int m = 0; m < 4; ++m)
#pragma unroll
                for (int n = 0; n < 2; ++n) acc[a][b][m][n] = acc_t{};
    bf16x8 At[4][2], B0[2][2], B1[2][2];
    const char* cA = (const char*)g.A + (size_t)cur.pm * tstep; const char* cB = (const char*)g.Bt + (size_t)cur.pn * tstep;
    S.a_ready(cur);
    if constexpr (SP2) {
        PG8_STAGE(PG8_SB(0, 0), cB, voffB); PG8_STAGE(PG8_SB(0, 1), cB + hstep, voffB); PG8_STAGE(PG8_SA(0, 0), cA, voffA); PG8_STAGE(PG8_SA(0, 1), cA + hstep, voffA);
        if (wr == 1) PG8_BAR;
        PG8_WAIT_V(2); PG8_BAR;
        PG8_STAGE(PG8_SB(1, 0), cB + kstep, voffB); PG8_STAGE(PG8_SA(1, 0), cA + kstep, voffA); PG8_STAGE(PG8_SB(1, 1), cB + hstep + kstep, voffB);
        PG8_WAIT_V(6); PG8_BAR;
    } else {
        PG8_STAGE(PG8_SB(0, 0), cB, voffB); PG8_STAGE(PG8_SA(0, 0), cA, voffA); PG8_STAGE(PG8_SB(0, 1), cB + hstep, voffB); PG8_STAGE(PG8_SA(0, 1), cA + hstep, voffA);
        if (wr == 1) PG8_BAR;
        PG8_WAIT_V(4); PG8_BAR;
        PG8_STAGE(PG8_SB(1, 0), cB + kstep, voffB); PG8_STAGE(PG8_SA(1, 0), cA + kstep, voffA); PG8_STAGE(PG8_SB(1, 1), cB + hstep + kstep, voffB);
        PG8_WAIT_V(6); PG8_BAR;
    }
    for (;;) {
        const bool has_next = S.next(ui + 1, nxt);
        const char* nA = has_next ? (const char*)g.A + (size_t)nxt.pm * tstep : cA; const char* nB = has_next ? (const char*)g.Bt + (size_t)nxt.pn * tstep : cB;
        for (int t = 0; t < nt; t += 2) {
            const bool last = (t == nt - 2);
            const char* a1 = cA + (size_t)(t + 1) * kstep;
            const char* a2 = last ? nA : cA + (size_t)(t + 2) * kstep; const char* b2 = last ? nB : cB + (size_t)(t + 2) * kstep;
            const char* a3 = a2 + kstep; const char* b3 = b2 + kstep;
            if (last && has_next) S.a_ready(nxt);
            if constexpr (SP2) {
            PG8_LDB(B0, 0, 0); PG8_LDB(B1, 0, 1); PG8_SCHED; PG8_LDA(At, 0, 0); PG8_STAGE(PG8_SA(1, 1), a1 + hstep, voffA);
            PG8_WAIT_V(8); PG8_WAIT_L(0); PG8_BAR; PG8_MMA(0, 0, At, B0); PG8_MMA(0, 1, At, B1); PG8_BAR; PG8_SCHED;
            PG8_LDA(At, 0, 1); PG8_STAGE(PG8_SB(0, 0), b2, voffB); PG8_STAGE(PG8_SB(0, 1), b2 + hstep, voffB); PG8_STAGE(PG8_SA(0, 0), a2, voffA);
            PG8_WAIT_V(8); PG8_WAIT_L(0); PG8_BAR; PG8_MMA(1, 0, At, B0); PG8_MMA(1, 1, At, B1); PG8_BAR; PG8_SCHED;
            PG8_LDB(B0, 1, 0); PG8_LDB(B1, 1, 1); PG8_SCHED; PG8_LDA(At, 1, 0); PG8_STAGE(PG8_SA(0, 1), a2 + hstep, voffA);
            PG8_WAIT_V(8); PG8_WAIT_L(0); PG8_BAR; PG8_MMA(0, 0, At, B0); PG8_MMA(0, 1, At, B1); PG8_BAR; PG8_SCHED;
            PG8_LDA(At, 1, 1); PG8_STAGE(PG8_SB(1, 0), b3, voffB); PG8_STAGE(PG8_SB(1, 1), b3 + hstep, voffB); PG8_STAGE(PG8_SA(1, 0), a3, voffA);
            PG8_WAIT_V(8); PG8_WAIT_L(0); PG8_BAR; PG8_MMA(1, 0, At, B0); PG8_MMA(1, 1, At, B1); PG8_BAR; PG8_SCHED;
            } else {
            PG8_LDB(B0, 0, 0); PG8_SCHED; PG8_LDA(At, 0, 0); PG8_STAGE(PG8_SA(1, 1), a1 + hstep, voffA);
            PG8_WAIT_L(8); PG8_BAR; PG8_WAIT_L(0); PG8_MMA(0, 0, At, B0); PG8_BAR; PG8_SCHED;
            PG8_LDB(B1, 0, 1); PG8_STAGE(PG8_SB(0, 0), b2, voffB);
            PG8_BAR; PG8_WAIT_L(0); PG8_MMA(0, 1, At, B1); PG8_BAR;
            PG8_LDA(At, 0, 1); PG8_STAGE(PG8_SA(0, 0), a2, voffA);
            PG8_BAR; PG8_WAIT_L(0); PG8_MMA(1, 0, At, B0); PG8_BAR; PG8_SCHED;
            PG8_STAGE(PG8_SB(0, 1), b2 + hstep, voffB);
            PG8_WAIT_V(6); PG8_BAR; PG8_MMA(1, 1, At, B1); PG8_BAR;
            PG8_LDB(B0, 1, 0); PG8_SCHED; PG8_LDA(At, 1, 0); PG8_STAGE(PG8_SA(0, 1), a2 + hstep, voffA);
            PG8_WAIT_L(8); PG8_BAR; PG8_WAIT_L(0); PG8_MMA(0, 0, At, B0); PG8_BAR; PG8_SCHED;
            PG8_LDB(B1, 1, 1); PG8_STAGE(PG8_SB(1, 0), b3, voffB);
            PG8_BAR; PG8_WAIT_L(0); PG8_MMA(0, 1, At, B1); PG8_BAR;
            PG8_LDA(At, 1, 1); PG8_STAGE(PG8_SA(1, 0), a3, voffA);
            PG8_BAR; PG8_WAIT_L(0); PG8_MMA(1, 0, At, B0); PG8_BAR; PG8_SCHED;
            PG8_STAGE(PG8_SB(1, 1), b3 + hstep, voffB);
            PG8_WAIT_V(6); PG8_BAR; PG8_MMA(1, 1, At, B1); PG8_BAR;
            }
        }
        if constexpr (ALIGN_EPI) { if (wr == 0) PG8_BAR; }
        if constexpr (!Epi::AFTER_DRAIN) { E(acc, cur, wr, wc, fr, fq); S.done(cur); }
        if (!has_next) break;
#pragma unroll
        for (int a = 0; a < 2; ++a)
#pragma unroll
            for (int b = 0; b < 2; ++b)
#pragma unroll
                for (int m = 0; m < 4; ++m)
#pragma unroll
                    for (int n = 0; n < 2; ++n) acc[a][b][m][n] = acc_t{};
        cur = nxt; cA = nA; cB = nB; ++ui;
        if constexpr (ALIGN_EPI) { if (wr == 1) PG8_BAR; }
    }
    PG8_WAIT_V(0);
    if constexpr (!ALIGN_EPI) { if (wr == 0) PG8_BAR; }
    PG8_BAR;
#undef PG8_SA
#undef PG8_SB
#undef PG8_STAGE
#undef PG8_LDA
#undef PG8_LDB
#undef PG8_MMA
#undef PG8_WAIT_V
#undef PG8_WAIT_L
#undef PG8_BAR
#undef PG8_SCHED
}
}

struct Params {
    const float *x, *c, *norm_w, *mod_w, *mod_b, *a_w_in, *a_w_out, *b_w_in, *b_w_out, *final_w;
    float* out; unsigned char* ws;
};

typedef const __attribute__((address_space(4))) Params CParams;
__device__ __forceinline__ CParams& PP() { CParams* p = (CParams*)__builtin_amdgcn_kernarg_segment_ptr(); asm volatile("" : "+s"(p)); return *p; }

__device__ __forceinline__ void p0_mod(unsigned char* lds, int wv) {
    CParams& P = PP();
    const int tid = otid(wv);
    f32x4* condT = (f32x4*)lds;
    float* red = (float*)(lds + 32768);
    float* MOD = (float*)(P.ws + WS_MOD);
    bool have = false;
    for (int item = obid(); item < 768; item += gridDim.x) {
        if (!have) { have = true;
            for (int k = tid; k < DM; k += NTHREADS) { f32x4 v; v.x = silu_f(P.c[k]); v.y = silu_f(P.c[DM + k]); v.z = silu_f(P.c[2 * DM + k]); v.w = silu_f(P.c[3 * DM + k]); condT[k] = v; }
            __syncthreads(); }
        const int l = item / 192, n0 = (item % 192) * 32, cq = tid & 7, kp = tid >> 3;
        f32x4 a0 = {0.f, 0.f, 0.f, 0.f}, a1 = a0, a2 = a0, a3 = a0;
        const float* wp = P.mod_w + ((size_t)l * DM + kp * 32) * 6144 + n0 + 4 * cq;
#pragma unroll 16
        for (int k = 0; k < 32; ++k) { const f32x4 w = *(const f32x4*)(wp + (size_t)k * 6144); const f32x4 cv = condT[kp * 32 + k];
            a0 += w * cv.x; a1 += w * cv.y; a2 += w * cv.z; a3 += w * cv.w; }
        *(f32x4*)(red + (kp * 4 + 0) * 32 + 4 * cq) = a0; *(f32x4*)(red + (kp * 4 + 1) * 32 + 4 * cq) = a1;
        *(f32x4*)(red + (kp * 4 + 2) * 32 + 4 * cq) = a2; *(f32x4*)(red + (kp * 4 + 3) * 32 + 4 * cq) = a3;
        __syncthreads();
        if (tid < 128) { const int b = tid >> 5, col = tid & 31; float s = P.mod_b[l * 6144 + n0 + col];
#pragma unroll 8
            for (int q = 0; q < 64; ++q) s += red[(q * 4 + b) * 32 + col];
            MOD[(l * 4 + b) * 6144 + n0 + col] = s; }
        __syncthreads();
    }
}
__device__ __forceinline__ void p0_transpose_item(const float* W, int ldn, int ncol0, int nblk, bf16_t* WT, unsigned char* scr, int item, int lane) {
    const int kb = item / nblk, nb = item - kb * nblk, k0 = kb * 64, n0 = nb * 64;
    const float* src = W + (size_t)(k0 + (lane >> 4)) * ldn + ncol0 + n0 + 4 * (lane & 15);
#pragma unroll 4
    for (int i = 0; i < 16; ++i) { const f32x4 v = *(const f32x4*)(src + (size_t)(4 * i) * ldn);
        unsigned* d = (unsigned*)(scr + (4 * i + (lane >> 4)) * 132 + 8 * (lane & 15));
        d[0] = cvt_pk_bf16(v.x, v.y); d[1] = cvt_pk_bf16(v.z, v.w); }
    LDS_WAIT();
    const int c = lane & 7;
#pragma unroll
    for (int j = 0; j < 8; ++j) { const int n = (lane >> 3) + 8 * j; const unsigned short* s = (const unsigned short*)(scr + (8 * c) * 132 + 2 * n);
        u32x4 o;
        o.x = (unsigned)s[0 * 66] | ((unsigned)s[1 * 66] << 16); o.y = (unsigned)s[2 * 66] | ((unsigned)s[3 * 66] << 16);
        o.z = (unsigned)s[4 * 66] | ((unsigned)s[5 * 66] << 16); o.w = (unsigned)s[6 * 66] | ((unsigned)s[7 * 66] << 16);
        *(u32x4*)(WT + (size_t)(n0 + n) * DM + k0 + 8 * c) = o; }
    LDS_WAIT();
}
__device__ __forceinline__ void p0_panel_i8(const float* W, int ldn, int n0, signed char* WT, float* cs, unsigned char* lds, int tid) {
    const int lane = tid & 63, wave = __builtin_amdgcn_readfirstlane(tid >> 6);
    float* maxbuf = (float*)(lds + 131072);
    f32x4 mx = {0.f, 0.f, 0.f, 0.f};
    { const float* src = W + (size_t)(wave * 256 + (lane >> 3)) * ldn + n0 + 4 * (lane & 7);
      unsigned char* dst = lds + (size_t)(wave * 256 + (lane >> 3)) * 64 + 8 * (lane & 7);
#pragma unroll 16
      for (int i = 0; i < 32; ++i) { const f32x4 v = *(const f32x4*)(src + (size_t)(8 * i) * ldn);
          mx.x = fmaxf(mx.x, fabsf(v.x)); mx.y = fmaxf(mx.y, fabsf(v.y)); mx.z = fmaxf(mx.z, fabsf(v.z)); mx.w = fmaxf(mx.w, fabsf(v.w));
          u32x2 w; w.x = cvt_pk_bf16(v.x, v.y); w.y = cvt_pk_bf16(v.z, v.w); *(u32x2*)(dst + (size_t)(8 * i) * 64) = w; } }
#pragma unroll
    for (int o = 8; o < 64; o <<= 1) { mx.x = fmaxf(mx.x, __shfl_xor(mx.x, o)); mx.y = fmaxf(mx.y, __shfl_xor(mx.y, o)); mx.z = fmaxf(mx.z, __shfl_xor(mx.z, o)); mx.w = fmaxf(mx.w, __shfl_xor(mx.w, o)); }
    if (lane < 8) *(f32x4*)(maxbuf + wave * 32 + 4 * lane) = mx;
    __syncthreads();
    { const int n = tid & 31, kc = tid >> 5;
      float cm = maxbuf[n];
#pragma unroll
      for (int w = 1; w < 8; ++w) cm = fmaxf(cm, maxbuf[w * 32 + n]);
      const float inv = cm > 0.f ? 127.f / cm : 0.f;
      if (kc == 0) cs[n0 + n] = cm > 0.f ? cm * (1.f / 127.f) : 1.f;
      const unsigned short* t = (const unsigned short*)lds + (size_t)(kc * 128) * 32 + n;
      signed char* orow = WT + (size_t)(n0 + n) * DM + kc * 128;
#pragma unroll 2
      for (int i = 0; i < 8; ++i) { unsigned w[4];
#pragma unroll
          for (int q = 0; q < 4; ++q) { unsigned acc = 0;
#pragma unroll
              for (int e = 0; e < 4; ++e) { const float v = bf2f(t[(size_t)(16 * i + 4 * q + e) * 32]) * inv; int iv = (int)rintf(v); iv = iv > 127 ? 127 : (iv < -127 ? -127 : iv); acc |= ((unsigned)iv & 0xffu) << (8 * e); }
              w[q] = acc; }
          *(u32x4*)(orow + 16 * i) = (u32x4){w[0], w[1], w[2], w[3]}; } }
    __syncthreads();
}
__device__ __forceinline__ void p0_weights(unsigned char* lds, int wv) {
    CParams& P = PP();
    const int tid_ = otid(wv); const int lane = tid_ & 63, wave = __builtin_amdgcn_readfirstlane(tid_ >> 6);
    constexpr int PA = A_N / 32, PB = (MOBA_QK_I8 ? B_N : 4096) / 32, PO = DM / 32, NPANEL = 2 * PA + 2 * PB + (OUTA_I8 ? 2 * PO : 0);
    for (int it = obid(); it < NPANEL; it += gridDim.x) {
        if (it < 2 * PA) { const int j = it / PA, pnl = it - j * PA;
            p0_panel_i8(P.a_w_in + (size_t)j * DM * A_N, A_N, pnl * 32, (signed char*)(P.ws + WS_WAIN) + (size_t)j * A_N * DM, (float*)(P.ws + WS_CSA) + j * A_N, lds, tid_); }
        else if (it < 2 * PA + 2 * PB) { const int r = it - 2 * PA, j = r / PB, pnl = r - j * PB;
#if MOBA_QK_I8
            p0_panel_i8(P.b_w_in + (size_t)j * DM * B_N, B_N, pnl * 32, (signed char*)(P.ws + WS_WBQK) + (size_t)j * B_N * DM, (float*)(P.ws + WS_CSB) + j * B_N, lds, tid_); }
#else
            p0_panel_i8(P.b_w_in + (size_t)j * DM * B_N + 4096, B_N, pnl * 32, (signed char*)(P.ws + WS_WBVZ) + (size_t)j * 4096 * DM, (float*)(P.ws + WS_CSB) + j * 4096, lds, tid_); }
#endif
#if OUTA_I8
        else { const int r = it - 2 * PA - 2 * PB, j = r / PO, pnl = r - j * PO;
            p0_panel_i8(P.a_w_out + (size_t)j * DM * DM, DM, pnl * 32, (signed char*)(P.ws + WS_WAOUT) + (size_t)j * DM * DM, (float*)(P.ws + WS_CSO) + j * DM, lds, tid_); }
#endif
    }
    unsigned char* scr = lds + 65536 + wave * 8448;
    const int gw = obid() * 8 + wave, NGW = gridDim.x * 8;
    constexpr int I_B = MOBA_QK_I8 ? 0 : 32 * 64, I_O = 32 * 32, I_AO = OUTA_I8 ? 0 : 32 * 32, TOTAL = 2 * I_B + 2 * I_AO + 2 * I_O;
    for (int it = gw; it < TOTAL; it += NGW) {
        int r = it;
        if (I_B > 0 && r < 2 * I_B) { const int j = r / (I_B > 0 ? I_B : 1); p0_transpose_item(P.b_w_in + (size_t)j * DM * B_N, B_N, 0, 64, (bf16_t*)(P.ws + WS_WBQK) + (size_t)j * 4096 * DM, scr, r - j * I_B, lane); continue; } r -= 2 * I_B;
        if (I_AO > 0 && r < 2 * I_AO) { const int j = r / (I_AO > 0 ? I_AO : 1); p0_transpose_item(P.a_w_out + (size_t)j * DM * DM, DM, 0, 32, (bf16_t*)(P.ws + WS_WAOUT) + (size_t)j * DM * DM, scr, r - j * I_AO, lane); continue; } r -= 2 * I_AO;
        { const int j = r / I_O; p0_transpose_item(P.b_w_out + (size_t)j * DM * DM, DM, 0, 32, (bf16_t*)(P.ws + WS_WBOUT) + (size_t)j * DM * DM, scr, r - j * I_O, lane); }
    }
}

__device__ __forceinline__ void norm_phase(int layer, bool want_bf16, int wv) {
    CParams& P = PP(); const float* xin = layer == 0 ? P.x : P.out;
    const int tid_ = otid(wv); const int lane = tid_ & 63, wave = __builtin_amdgcn_readfirstlane(tid_ >> 6);
    const int gw = obid() * 8 + wave, NGW = gridDim.x * 8;
    const float* MOD = (const float*)(P.ws + WS_MOD);
    bf16_t* Hb = (bf16_t*)(P.ws + WS_H); unsigned char* Hq = P.ws + WS_HQ; float* RS = (float*)(P.ws + WS_RS);
    for (int r0 = gw * 4; r0 < MTOK; r0 += NGW * 4) {
        const int b = r0 >> 11;
        const float* shift = MOD + (size_t)(layer * 4 + b) * 6144; const float* scale = shift + DM; const float* nw = P.norm_w + layer * DM;
        f32x4 ca[8], cs[8];
#pragma unroll
        for (int j = 0; j < 8; ++j) { const int c = 4 * lane + 256 * j; const f32x4 w = *(const f32x4*)(nw + c), s = *(const f32x4*)(scale + c); ca[j] = w * (s + 1.f); cs[j] = *(const f32x4*)(shift + c); }
        for (int rr = 0; rr < 4; ++rr) {
            const float* xr = xin + (size_t)(r0 + rr) * DM; f32x4 v[8]; float ss = 0.f;
#pragma unroll
            for (int j = 0; j < 8; ++j) { v[j] = *(const f32x4*)(xr + 4 * lane + 256 * j); ss += (v[j].x * v[j].x + v[j].y * v[j].y) + (v[j].z * v[j].z + v[j].w * v[j].w); }
            const float rs = 1.0f / sqrtf(wave_sum(ss) * (1.f / DM) + EPS);
            float am = 0.f;
#pragma unroll
            for (int j = 0; j < 8; ++j) { v[j] = v[j] * rs * ca[j] + cs[j]; am = fmaxf(am, fmaxf(fmaxf(fabsf(v[j].x), fabsf(v[j].y)), fmaxf(fabsf(v[j].z), fabsf(v[j].w)))); }
            am = wave_max(am);
            const float inv = am > 0.f ? 127.f / am : 0.f;
            if (lane == 0) RS[r0 + rr] = am > 0.f ? am * (1.f / 127.f) : 1.f;
            unsigned char* qr = Hq + (size_t)(r0 + rr) * DM;
#pragma unroll
            for (int j = 0; j < 8; ++j) { const f32x4 h = v[j] * inv;
                const int i0 = (int)rintf(h.x), i1 = (int)rintf(h.y), i2 = (int)rintf(h.z), i3 = (int)rintf(h.w);
                *(unsigned*)(qr + 4 * lane + 256 * j) = ((unsigned)i0 & 0xffu) | (((unsigned)i1 & 0xffu) << 8) | (((unsigned)i2 & 0xffu) << 16) | (((unsigned)i3 & 0xffu) << 24); }
            if (want_bf16) { bf16_t* hr = Hb + (size_t)(r0 + rr) * DM;
#pragma unroll
                for (int j = 0; j < 8; ++j) { u32x2 w; w.x = cvt_pk_bf16(v[j].x, v[j].y); w.y = cvt_pk_bf16(v[j].z, v[j].w); *(u32x2*)(hr + 4 * lane + 256 * j) = w; } }
        }
    }
}
__device__ __forceinline__ void final_norm_phase(int wv) {
    CParams& P = PP();
    const int tid_ = otid(wv); const int lane = tid_ & 63, wave = __builtin_amdgcn_readfirstlane(tid_ >> 6);
    const int gw = obid() * 8 + wave, NGW = gridDim.x * 8;
    f32x4 cw[8];
#pragma unroll
    for (int j = 0; j < 8; ++j) cw[j] = *(const f32x4*)(P.final_w + 4 * lane + 256 * j);
    for (int r = gw; r < MTOK; r += NGW) {
        float* xr = P.out + (size_t)r * DM; f32x4 v[8]; float ss = 0.f;
#pragma unroll
        for (int j = 0; j < 8; ++j) { v[j] = *(const f32x4*)(xr + 4 * lane + 256 * j); ss += (v[j].x * v[j].x + v[j].y * v[j].y) + (v[j].z * v[j].z + v[j].w * v[j].w); }
        const float rs = 1.0f / sqrtf(wave_sum(ss) * (1.f / DM) + EPS);
#pragma unroll
        for (int j = 0; j < 8; ++j) *(f32x4*)(xr + 4 * lane + 256 * j) = v[j] * rs * cw[j];
    }
}

__device__ __forceinline__ void naive_attend(const bf16_t* Kh, const bf16_t* Vh, const float* qf, float* sc, int own_start, int own_len, int blkbase, int mask, int qpos, float slopeL, int lane,
                                             float& o0, float& o1, float& lse2) {
    int base = 0; float mx = -3.0e38f;
    { int m2 = mask;
      for (int rr = 0;; ++rr) { int start, len;
        if (rr == 0) { start = own_start; len = own_len; } else { if (!m2) break; const int j = __builtin_ctz(m2); m2 &= m2 - 1; start = blkbase + (j << 8); len = 256; }
        for (int i = lane; i < len; i += 64) { const int key = start + i; const u32x4* kp = (const u32x4*)(Kh + (size_t)key * DM); float dot = 0.f;
#pragma unroll 4
            for (int cch = 0; cch < 16; ++cch) { const u32x4 w = kp[cch]; const float* q = qf + cch * 8;
                dot += q[0] * bflo(w.x) + q[1] * bfhi(w.x) + q[2] * bflo(w.y) + q[3] * bfhi(w.y) + q[4] * bflo(w.z) + q[5] * bfhi(w.z) + q[6] * bflo(w.w) + q[7] * bfhi(w.w); }
            const float s = dot + slopeL * (float)(key - qpos); sc[base + i] = s; mx = fmaxf(mx, s); }
        base += len; } }
    const int tot = base; mx = wave_max(mx);
    LDS_WAIT();
    float sum = 0.f;
    for (int i = lane; i < tot; i += 64) { const float p = exp2f(sc[i] - mx); sc[i] = p; sum += p; }
    sum = wave_sum(sum);
    LDS_WAIT();
    float a0 = 0.f, a1 = 0.f; base = 0;
    { int m2 = mask;
      for (int rr = 0;; ++rr) { int start, len;
        if (rr == 0) { start = own_start; len = own_len; } else { if (!m2) break; const int j = __builtin_ctz(m2); m2 &= m2 - 1; start = blkbase + (j << 8); len = 256; }
        const bf16_t* vp = Vh + (size_t)start * DM + 2 * lane;
        for (int i = 0; i < len; ++i) { const float p = sc[base + i]; const unsigned w = *(const unsigned*)(vp + (size_t)i * DM); a0 += p * bflo(w); a1 += p * bfhi(w); }
        base += len; } }
    LDS_WAIT();
    const float inv = 1.f / sum; o0 = a0 * inv; o1 = a1 * inv; lse2 = mx + log2f(sum);
}
__device__ __forceinline__ float slope_of(int h) { return exp2f(-0.5f * (float)(h + 1)); }

__device__ __forceinline__ void attn_a_naive(unsigned char* lds, int wv) {
    CParams& P = PP();
    const int tid_ = otid(wv); const int lane = tid_ & 63, wave = __builtin_amdgcn_readfirstlane(tid_ >> 6);
    float* qf = (float*)(lds + wave * 8192); float* sc = qf + 128;
    const bf16_t* QKV = (const bf16_t*)(P.ws + WS_QKV); bf16_t* OG = (bf16_t*)(P.ws + WS_OG); float* LSE = (float*)(P.ws + WS_LSE);
    const int gw = obid() * 8 + wave, NGW = gridDim.x * 8;
    for (int it = gw; it < 3 * MTOK * NH; it += NGW) {
        const int h = it & 15, R = (it >> 4) & (MTOK - 1), g = it >> 17;
        const int lg = 2 * g, L = SEQ >> lg;
        const bf16_t* Qp = QKV + (size_t)(3 * g) * PART + (size_t)R * DM + h * HD;
        { const unsigned w = *(const unsigned*)(Qp + 2 * lane); qf[2 * lane] = bflo(w); qf[2 * lane + 1] = bfhi(w); }
        LDS_WAIT();
        const int seq0 = R & ~(L - 1); int lo = R - 128; if (lo < seq0) lo = seq0;
        float o0, o1, lse2;
        naive_attend(QKV + (size_t)(3 * g + 1) * PART + h * HD, QKV + (size_t)(3 * g + 2) * PART + h * HD, qf, sc, lo, R - lo + 1, 0, 0, R, slope_of(h) * (float)(1 << lg) * LOG2E, lane, o0, o1, lse2);
        *(unsigned*)(OG + (size_t)g * PART + (size_t)R * DM + h * HD + 2 * lane) = cvt_pk_bf16(o0, o1);
        if (lane == 0) LSE[((size_t)g * MTOK + R) * NH + h] = lse2;
    }
}
__device__ __forceinline__ void combine_phase(int wv) {
    CParams& P = PP();
    const int tid_ = otid(wv); const int lane = tid_ & 63, wave = __builtin_amdgcn_readfirstlane(tid_ >> 6);
    const int gw = obid() * 8 + wave, NGW = gridDim.x * 8;
    const bf16_t* OG = (const bf16_t*)(P.ws + WS_OG); const float* LSE = (const float*)(P.ws + WS_LSE); const bf16_t* Z = (const bf16_t*)(P.ws + WS_Z);
    unsigned char* GQ = P.ws + WS_HQ; float* RS = (float*)(P.ws + WS_RS);
    for (int m = gw; m < MTOK; m += NGW) {
        const int b = m >> 11, t = m & 2047;
        const int R0 = m, R1 = (b << 11) + ((t & 3) << 9) + (t >> 2), R2 = (b << 11) + ((t & 15) << 7) + (t >> 4);
        float v[4][8]; float am = 0.f, sq = 0.f;
#pragma unroll
        for (int j = 0; j < 4; ++j) { const int col = 8 * lane + 512 * j, h = col >> 7;
            const float l0 = LSE[((size_t)0 * MTOK + R0) * NH + h], l1 = LSE[((size_t)1 * MTOK + R1) * NH + h], l2 = LSE[((size_t)2 * MTOK + R2) * NH + h];
            const float mx = fmaxf(l0, fmaxf(l1, l2)); float e0 = exp2f(l0 - mx), e1 = exp2f(l1 - mx), e2 = exp2f(l2 - mx); const float inv = 1.f / (e0 + e1 + e2); e0 *= inv; e1 *= inv; e2 *= inv;
            const u32x4 a = *(const u32x4*)(OG + (size_t)R0 * DM + col), bb = *(const u32x4*)(OG + PART + (size_t)R1 * DM + col), cc = *(const u32x4*)(OG + 2 * PART + (size_t)R2 * DM + col);
            const u32x4 zz = *(const u32x4*)(Z + (size_t)m * DM + col);
#define CMB(F, I) { v[j][I] = (e0 * bflo(a.F) + e1 * bflo(bb.F) + e2 * bflo(cc.F)) * silu_f(bflo(zz.F)); v[j][I + 1] = (e0 * bfhi(a.F) + e1 * bfhi(bb.F) + e2 * bfhi(cc.F)) * silu_f(bfhi(zz.F)); \
                    am = fmaxf(am, fmaxf(fabsf(v[j][I]), fabsf(v[j][I + 1]))); sq += v[j][I] * v[j][I] + v[j][I + 1] * v[j][I + 1]; }
            CMB(x, 0) CMB(y, 2) CMB(z, 4) CMB(w, 6)
#undef CMB
        }
#if !OUTA_I8
        { bf16_t* Gr = (bf16_t*)(P.ws + WS_G) + (size_t)m * DM;
#pragma unroll
          for (int j = 0; j < 4; ++j) { u32x4 o; o.x = cvt_pk_bf16(v[j][0], v[j][1]); o.y = cvt_pk_bf16(v[j][2], v[j][3]); o.z = cvt_pk_bf16(v[j][4], v[j][5]); o.w = cvt_pk_bf16(v[j][6], v[j][7]); *(u32x4*)(Gr + 8 * lane + 512 * j) = o; }
          continue; }
#endif
        am = wave_max(am); sq = wave_sum(sq);
        am = fminf(am, GCLIP * sqrtf(sq * (1.f / DM)));
        const float inv = am > 0.f ? 127.f / am : 0.f;
        if (lane == 0) RS[m] = am > 0.f ? am * (1.f / 127.f) : 1.f;
#pragma unroll
        for (int j = 0; j < 4; ++j) { unsigned w0 = 0, w1 = 0;
#pragma unroll
            for (int e = 0; e < 4; ++e) { w0 |= ((unsigned)(int)rintf(fminf(fmaxf(v[j][e] * inv, -127.f), 127.f)) & 0xffu) << (8 * e); w1 |= ((unsigned)(int)rintf(fminf(fmaxf(v[j][4 + e] * inv, -127.f), 127.f)) & 0xffu) << (8 * e); }
            *(u32x2*)(GQ + (size_t)m * DM + 8 * lane + 512 * j) = (u32x2){w0, w1}; }
    }
}
__device__ __forceinline__ void attn_b_naive(unsigned char* lds, int wv) {
    CParams& P = PP();
    const int tid_ = otid(wv); const int lane = tid_ & 63, wave = __builtin_amdgcn_readfirstlane(tid_ >> 6);
    float* qf = (float*)(lds + wave * 8192); float* sc = qf + 128;
    const bf16_t* QKV = (const bf16_t*)(P.ws + WS_QKV); const bf16_t* Z = (const bf16_t*)(P.ws + WS_Z); bf16_t* G = (bf16_t*)(P.ws + WS_G); const float* KS = (const float*)(P.ws + WS_KSUM);
    const int gw = obid() * 8 + wave, NGW = gridDim.x * 8;
    for (int it = gw; it < MTOK * NH; it += NGW) {
        const int h = it & 15, m = it >> 4, b = m >> 11, t = m & 2047, n = t >> 8;
        const bf16_t* Qp = QKV + (size_t)m * DM + h * HD;
        float q0, q1; { const unsigned w = *(const unsigned*)(Qp + 2 * lane); q0 = bflo(w); q1 = bfhi(w); qf[2 * lane] = q0; qf[2 * lane + 1] = q1; }
        LDS_WAIT();
        float gt[8];
#pragma unroll
        for (int j = 0; j < 8; ++j) { float v = 0.f;
            if (j < n) { const float* k0 = KS + (size_t)(b * 8 + j) * DM + h * HD + 2 * lane; const float* k1 = k0 + (size_t)32 * DM; v = q0 * (k0[0] + k1[0]) + q1 * (k0[1] + k1[1]); }
            gt[j] = wave_sum(v); }
        int mask = 0;
#pragma unroll
        for (int j = 0; j < 8; ++j) { if (j < n) { int rank = 0;
#pragma unroll
                for (int j2 = 0; j2 < 8; ++j2) if (j2 < n && (gt[j2] > gt[j] || (gt[j2] == gt[j] && j2 < j))) ++rank;
                if (rank < 3) mask |= 1 << j; } }
        float o0, o1, lse2;
        naive_attend(QKV + PART + h * HD, QKV + 2 * PART + h * HD, qf, sc, (b << 11) + (n << 8), (t & 255) + 1, b << 11, mask, m, slope_of(h) * LOG2E, lane, o0, o1, lse2);
        const unsigned zw = *(const unsigned*)(Z + (size_t)m * DM + h * HD + 2 * lane);
        *(unsigned*)(G + (size_t)m * DM + h * HD + 2 * lane) = cvt_pk_bf16(o0 * silu_f(bflo(zw)), o1 * silu_f(bfhi(zw)));
    }
}

namespace fa {
constexpr int KVBLK = 64, SHM_K = KVBLK * HD * 2, SHM_V = KVBLK * HD * 2;
constexpr int OFF_V = 0, OFF_K = 2 * SHM_V, OFF_WS = OFF_K + 2 * SHM_K, OFF_OST = OFF_WS + 8 * 256, OST_ROW = 272, OST_WAVE = 32 * OST_ROW;
constexpr int OFF_GK = OFF_OST + 8 * OST_WAVE, OFF_SEL = OFF_GK + 7 * 128 * 4, OFF_END = OFF_SEL + 256 * 4;
static_assert(OFF_END <= LDS_BYTES - 1024, "attention LDS map");
constexpr float THR = 11.5f;
#define KSWZ(row, colB) ((row) * 256 + ((colB) ^ (((row) & 7) << 4)))
#define SBAR() __builtin_amdgcn_sched_barrier(0)
__device__ __forceinline__ int v_st(int k, int c) { const int kk = (k & ~0xC) | ((k & 4) << 1) | ((k & 8) >> 1); return ((kk >> 3) * 4 + (c >> 5)) * 512 + ((kk & 7) * 32 + (c & 31)) * 2; }
__device__ __forceinline__ int v_rd_base(int lane) { return ((lane & 3) << 3) | (((lane >> 2) & 3) << 6) | (((lane >> 4) & 1) << 5) | (((lane >> 5) & 1) << 8); }
constexpr int v_rd_off(int d0, int ks, int half) { return d0 * 512 + ks * 4096 + half * 2048; }
__device__ __forceinline__ int crow(int r, int hi) { return (r & 3) + 8 * (r >> 2) + 4 * hi; }
__device__ __forceinline__ void mask_tile(f32x16& p0, f32x16& p1, int dq, unsigned W) {
    const float NEG = -__builtin_inff();
#pragma unroll
    for (int r = 0; r < 16; ++r) { const int c = (r & 3) + 8 * (r >> 2);
        if ((unsigned)(dq - c) >= W) p0[r] = NEG;
        if ((unsigned)(dq - c - 32) >= W) p1[r] = NEG; }
}
__device__ __forceinline__ void partialSM(f32x16& p0, f32x16& p1, float& m_reg, float& alpha) {
    float pmax = p0[0];
#pragma unroll
    for (int r = 1; r < 16; ++r) pmax = fmaxf(pmax, p0[r]);
#pragma unroll
    for (int r = 0; r < 16; ++r) pmax = fmaxf(pmax, p1[r]);
    { auto rr = __builtin_amdgcn_permlane32_swap(__float_as_uint(pmax), __float_as_uint(pmax), false, false); pmax = fmaxf(__uint_as_float(rr[0]), __uint_as_float(rr[1])); }
    float mn;
    if (__builtin_expect(__all(pmax - m_reg <= THR), 1)) { mn = m_reg; alpha = 1.f; }
    else { mn = fmaxf(m_reg, pmax); alpha = __builtin_amdgcn_exp2f(m_reg - mn); m_reg = mn; }
#pragma unroll
    for (int r = 0; r < 16; ++r) p0[r] = __builtin_amdgcn_exp2f(p0[r] - mn);
#pragma unroll
    for (int r = 0; r < 16; ++r) p1[r] = __builtin_amdgcn_exp2f(p1[r] - mn);
}
__device__ __forceinline__ void finishSM(f32x16& p0, f32x16& p1, float alpha, float& l_reg, bf16x8& pa0, bf16x8& pa1, bf16x8& pa2, bf16x8& pa3) {
    float ps = 0;
#pragma unroll
    for (int r = 0; r < 16; ++r) ps += p0[r];
#pragma unroll
    for (int r = 0; r < 16; ++r) ps += p1[r];
    { auto rr = __builtin_amdgcn_permlane32_swap(__float_as_uint(ps), __float_as_uint(ps), false, false); ps = __uint_as_float(rr[0]) + __uint_as_float(rr[1]); }
    l_reg = l_reg * alpha + ps;
#define PK4(P, B_, OUT) do { unsigned a0 = cvt_pk_bf16(P[B_+0], P[B_+1]), a1 = cvt_pk_bf16(P[B_+2], P[B_+3]);                          \
        unsigned b0 = cvt_pk_bf16(P[B_+4], P[B_+5]), b1 = cvt_pk_bf16(P[B_+6], P[B_+7]);                                             \
        auto r0 = __builtin_amdgcn_permlane32_swap(a0, b0, false, false); auto r1 = __builtin_amdgcn_permlane32_swap(a1, b1, false, false); \
        u32x4 w = {r0[0], r1[0], r0[1], r1[1]}; OUT = *reinterpret_cast<bf16x8*>(&w); } while (0)
    PK4(p0, 0, pa0); PK4(p0, 8, pa1); PK4(p1, 0, pa2); PK4(p1, 8, pa3);
#undef PK4
}
template <int KB>
__device__ __forceinline__ void qkt(f32x16& p0, f32x16& p1, const LAS char* K_lds, int r32, int hi, const bf16x8* qr) {
    const LAS char* kb[4];
#pragma unroll
    for (int dd = 0; dd < 4; ++dd) kb[dd] = K_lds + KB * SHM_K + KSWZ(r32, (dd * 16 + hi * 8) * 2);
#pragma unroll
    for (int d0 = 0; d0 < 8; ++d0) { const LAS char* a = kb[d0 & 3] + (d0 >> 2) * 128;
        const bf16x8 b0 = *reinterpret_cast<const LAS bf16x8*>(a);
        const bf16x8 b1 = *reinterpret_cast<const LAS bf16x8*>(a + 32 * 256);
        p0 = __builtin_amdgcn_mfma_f32_32x32x16_bf16(b0, qr[d0], p0, 0, 0, 0);
        p1 = __builtin_amdgcn_mfma_f32_32x32x16_bf16(b1, qr[d0], p1, 0, 0, 0); }
}
template <int VB>
__device__ __forceinline__ void pv_tile(f32x16* o, int vb0, bf16x8 pa0, bf16x8 pa1, bf16x8 pa2, bf16x8 pa3) {
#define TRRD(dst, off) asm volatile("ds_read_b64_tr_b16 %0, %1 offset:%2" : "=&v"(dst) : "v"(vb0), "i"(off) : "memory")
#define PV_D0(d0) do { s16x4 l0, l1, l2, l3, h0, h1, h2, h3; constexpr int b_ = VB * SHM_V + v_rd_off(d0, 0, 0); \
        TRRD(l0, b_); TRRD(h0, b_ + 2048); TRRD(l1, b_ + 4096); TRRD(h1, b_ + 6144); TRRD(l2, b_ + 8192); TRRD(h2, b_ + 10240); TRRD(l3, b_ + 12288); TRRD(h3, b_ + 14336); \
        asm volatile("s_waitcnt lgkmcnt(0)" ::: "memory"); SBAR();   \
        o[d0] = __builtin_amdgcn_mfma_f32_32x32x16_bf16(pa0, (bf16x8){l0[0], l0[1], l0[2], l0[3], h0[0], h0[1], h0[2], h0[3]}, o[d0], 0, 0, 0);   \
        o[d0] = __builtin_amdgcn_mfma_f32_32x32x16_bf16(pa1, (bf16x8){l1[0], l1[1], l1[2], l1[3], h1[0], h1[1], h1[2], h1[3]}, o[d0], 0, 0, 0);   \
        o[d0] = __builtin_amdgcn_mfma_f32_32x32x16_bf16(pa2, (bf16x8){l2[0], l2[1], l2[2], l2[3], h2[0], h2[1], h2[2], h2[3]}, o[d0], 0, 0, 0);   \
        o[d0] = __builtin_amdgcn_mfma_f32_32x32x16_bf16(pa3, (bf16x8){l3[0], l3[1], l3[2], l3[3], h3[0], h3[1], h3[2], h3[3]}, o[d0], 0, 0, 0); } while (0)
    PV_D0(0); PV_D0(1); PV_D0(2); PV_D0(3);
#undef PV_D0
#undef TRRD
}

template <int MODE, class MK>
__device__ __forceinline__ void flash_block(const bf16_t* Q, const bf16_t* K, const bf16_t* V, int krow0, int NT, int qrow0, float slopeL, const MK& mk,
                                            unsigned char* lds, bf16_t* Og, float* Lse, const bf16_t* Zg, int tid) {
    const int wid = __builtin_amdgcn_readfirstlane(tid >> 6), lane = tid & 63, r32 = lane & 31, hi = lane >> 5;
    const LAS char* K_lds = (const LAS char*)(LAS unsigned char*)lds + OFF_K;
    LAS char* Kw = (LAS char*)(LAS unsigned char*)lds + OFF_K; LAS char* Vw = (LAS char*)(LAS unsigned char*)lds + OFF_V;
    LAS float* wsf = (LAS float*)((LAS unsigned char*)lds + OFF_WS) + wid * 64; LAS float* li_l = wsf; LAS float* al_l = wsf + 32;
    const int sr = tid >> 4, sc = (tid & 15) * 8, vst0 = v_st(sr, sc), vst1 = v_st(32 + sr, sc), kws = KSWZ(sr, sc * 2);
    const int vb0 = (int)(unsigned)(uintptr_t)((LAS unsigned char*)lds) + OFF_V + v_rd_base(lane);
    const int qlo = qrow0 + wid * 32, qm = qlo + r32 - 4 * hi;
    bf16x8 st_k0, st_k1, st_v0, st_v1;
#define SLOAD(kb_) do { const size_t o0_ = (size_t)((kb_) + sr) * DM + sc, o1_ = o0_ + (size_t)32 * DM; \
        st_v0 = *(const bf16x8*)(V + o0_); st_v1 = *(const bf16x8*)(V + o1_); st_k0 = *(const bf16x8*)(K + o0_); st_k1 = *(const bf16x8*)(K + o1_); } while (0)
#define SWRITE(bf) do { *(LAS bf16x8*)(Vw + (bf) * SHM_V + vst0) = st_v0; *(LAS bf16x8*)(Vw + (bf) * SHM_V + vst1) = st_v1; \
        *(LAS bf16x8*)(Kw + (bf) * SHM_K + kws) = st_k0; *(LAS bf16x8*)(Kw + (bf) * SHM_K + kws + 32 * 256) = st_k1; } while (0)
    bf16x8 qr[8];
#pragma unroll
    for (int d0 = 0; d0 < 8; ++d0) qr[d0] = *(const bf16x8*)(Q + (size_t)(wid * 32 + r32) * DM + d0 * 16 + hi * 8);
    SLOAD(krow0); asm volatile("s_waitcnt vmcnt(0)" ::: "memory"); SWRITE(0);
    __syncthreads();
    float m_reg = -1e30f, l_reg = 0.f; f32x16 o[4] = {};
#define STEP(t, KB) do { const int kb_ = krow0 + (t) * KVBLK;                                                                   \
        if ((t) + 1 < NT) SLOAD(kb_ + KVBLK);                                                                                     \
        bool act_, need_; unsigned W_; mk.info(kb_, qlo, r32, act_, need_, W_);                                                 \
        if (act_) { f32x16 p0, p1; const float a0_ = slopeL * (float)(kb_ - qm);                                                  \
            _Pragma("unroll") for (int r = 0; r < 16; ++r) { p0[r] = fmaf(slopeL, (float)((r & 3) + 8 * (r >> 2)), a0_); p1[r] = p0[r] + 32.f * slopeL; } \
            qkt<KB>(p0, p1, K_lds, r32, hi, qr);                                                                                  \
            if (need_) mask_tile(p0, p1, qm - kb_, W_);                                                                           \
            float alpha_; partialSM(p0, p1, m_reg, alpha_);                                                                       \
            bf16x8 pa0, pa1, pa2, pa3; finishSM(p0, p1, alpha_, l_reg, pa0, pa1, pa2, pa3);                                       \
            if (__any(alpha_ < 1.f)) { if (hi == 0) al_l[r32] = alpha_; LDS_WAIT();                                               \
                _Pragma("unroll") for (int d_ = 0; d_ < 4; ++d_) _Pragma("unroll") for (int r = 0; r < 16; ++r) o[d_][r] *= al_l[crow(r, hi)]; } \
            SBAR(); pv_tile<KB>(o, vb0, pa0, pa1, pa2, pa3); }                                                                    \
        if ((t) + 1 < NT) { asm volatile("s_waitcnt vmcnt(0)" ::: "memory"); SWRITE((KB) ^ 1); }                               \
        __syncthreads(); } while (0)
    for (int t = 0; t < NT; t += 2) { STEP(t, 0); STEP(t + 1, 1); }
#undef STEP
#undef SLOAD
#undef SWRITE
    if (hi == 0) li_l[r32] = l_reg;
    LDS_WAIT();
    LAS unsigned char* stg = (LAS unsigned char*)lds + OFF_OST + wid * OST_WAVE;
#pragma unroll
    for (int r = 0; r < 16; ++r) { const int orow = crow(r, hi); const float rl = __builtin_amdgcn_rcpf(li_l[orow]);
#pragma unroll
        for (int d0 = 0; d0 < 4; ++d0) *(LAS unsigned short*)(stg + orow * OST_ROW + (d0 * 32 + r32) * 2) = (unsigned short)(cvt_pk_bf16(o[d0][r] * rl, 0.f) & 0xffffu); }
    LDS_WAIT();
    if (MODE == 0) { if (hi == 0) Lse[(size_t)(qlo + r32) * NH] = m_reg + log2f(l_reg); }
#pragma unroll
    for (int i = 0; i < 8; ++i) { const int row = i * 4 + (lane >> 4), ch = lane & 15;
        u32x4 v = *(const LAS u32x4*)(stg + row * OST_ROW + ch * 16);
        const size_t go = (size_t)(qlo + row) * DM + ch * 8;
        if (MODE == 1) { const u32x4 z = *(const u32x4*)(Zg + go);
            v.x = cvt_pk_bf16(bflo(v.x) * silu_f(bflo(z.x)), bfhi(v.x) * silu_f(bfhi(z.x))); v.y = cvt_pk_bf16(bflo(v.y) * silu_f(bflo(z.y)), bfhi(v.y) * silu_f(bfhi(z.y)));
            v.z = cvt_pk_bf16(bflo(v.z) * silu_f(bflo(z.z)), bfhi(v.z) * silu_f(bfhi(z.z))); v.w = cvt_pk_bf16(bflo(v.w) * silu_f(bflo(z.w)), bfhi(v.w) * silu_f(bfhi(z.w))); }
        *(u32x4*)(Og + go) = v; }
    LDS_WAIT();
}
struct MaskA {
    int L;
    __device__ __forceinline__ void info(int kb, int qlo, int r32, bool& act, bool& need, unsigned& W) const {
        const int seq0 = qlo & ~(L - 1); int lowk = qlo - 128; if (lowk < seq0) lowk = seq0;
        act = (kb <= qlo + 31) && (kb + KVBLK - 1 >= lowk); need = true;
        const int wl = qlo + r32 - seq0 + 1; W = (unsigned)(wl < 129 ? wl : 129);
    }
};
struct MaskB {
    int own0, base0; unsigned sel;
    __device__ __forceinline__ void info(int kb, int qlo, int r32, bool& act, bool& need, unsigned& W) const {
        if (kb >= own0) { act = kb <= qlo + 31; need = kb + KVBLK - 1 > qlo; W = 0x40000000u; }
        else { const int blk = (kb - base0) >> 8; const bool s = (sel >> blk) & 1u; const unsigned long long bal = __ballot(s);
            act = bal != 0ull; need = bal != ~0ull; W = s ? 0x40000000u : 0u; }
    }
};
#undef KSWZ
#undef SBAR
}

namespace fb {
using namespace fa;
#define KSWZ(row, colB) ((row) * 256 + ((colB) ^ (((row) & 7) << 4)))
#define SBAR() __builtin_amdgcn_sched_barrier(0)
struct Blk {
    unsigned qoff, koff, voff;
    unsigned ooff, xoff;
    int R0, kb0, NT;
    float slopeL;
    int L, base0;
};
struct Nxt { unsigned qoff, koff, voff; int kb0; };
struct Seam { bf16x8 qr[8]; bf16x8 st_v0, st_v1, st_k0, st_k1; };
__device__ __forceinline__ void tile_info(const Blk& c, int kb, int qlo, int r32, unsigned sel, bool& act, bool& need, unsigned& W) {
    if (c.L > 0) { const int seq0 = qlo & ~(c.L - 1); int lowk = qlo - 128; if (lowk < seq0) lowk = seq0;
        act = (kb <= qlo + 31) && (kb + KVBLK - 1 >= lowk); need = true; const int wl = qlo + r32 - seq0 + 1; W = (unsigned)(wl < 129 ? wl : 129); }
    else if (kb >= c.R0) { act = kb <= qlo + 31; need = kb + KVBLK - 1 > qlo; W = 0x40000000u; }
    else { const int blk = (kb - c.base0) >> 8; const bool sb = (sel >> blk) & 1u; const unsigned long long bal = __ballot(sb);
        act = bal != 0ull; need = bal != ~0ull; W = sb ? 0x40000000u : 0u; }
}
template <int KB>
__device__ __forceinline__ void qkt2(f32x16& p0, f32x16& p1, const LAS char* K_lds, int r32, int hi, const bf16x8* qr, bool act, float slopeL, float a0) {
    if (!act) { const float NEG = -__builtin_inff();
#pragma unroll
        for (int r = 0; r < 16; ++r) { p0[r] = NEG; p1[r] = NEG; } return; }
#pragma unroll
    for (int r = 0; r < 16; ++r) { p0[r] = fmaf(slopeL, (float)((r & 3) + 8 * (r >> 2)), a0); p1[r] = fmaf(slopeL, (float)((r & 3) + 8 * (r >> 2) + 32), a0); }
    qkt<KB>(p0, p1, K_lds, r32, hi, qr);
}
#define ROWP(off, k0, rr) (wsb + ((size_t)(off) + (size_t)(k0) * (DM * 2)) + (unsigned)(((rr) * DM + sc) * 2))
#define VMW() asm volatile("s_waitcnt vmcnt(0)" ::: "memory")
#define SLOAD_H(Kp, Vp, k0) do { S.st_v0 = *(const bf16x8*)ROWP(Vp, k0, sr); S.st_v1 = *(const bf16x8*)ROWP(Vp, k0, 32 + sr); \
                                 S.st_k0 = *(const bf16x8*)ROWP(Kp, k0, sr); S.st_k1 = *(const bf16x8*)ROWP(Kp, k0, 32 + sr); } while (0)
#define SWRITE_HK(bf) do { *(LAS bf16x8*)(Kw + (bf) * SHM_K + kws) = S.st_k0; *(LAS bf16x8*)(Kw + (bf) * SHM_K + kws + 32 * 256) = S.st_k1; } while (0)
#define SWRITE_HV(bf) do { *(LAS bf16x8*)(Vw + (bf) * SHM_V + vst0) = S.st_v0; *(LAS bf16x8*)(Vw + (bf) * SHM_V + vst1) = S.st_v1; } while (0)
#define SWRITE_H(bf) do { SWRITE_HV(bf); SWRITE_HK(bf); } while (0)
__device__ __forceinline__ void prime(const unsigned char* wsb, const Blk& cur, unsigned char* lds, Seam& S, int tid) {
    const int wid = __builtin_amdgcn_readfirstlane(tid >> 6), lane = tid & 63, r32 = lane & 31, hi = lane >> 5;
    const int sr = tid >> 4, sc = (tid & 15) * 8, kws = KSWZ(sr, sc * 2);
    LAS char* Kw = (LAS char*)(LAS unsigned char*)lds + OFF_K;
#pragma unroll
    for (int d0 = 0; d0 < 8; ++d0) S.qr[d0] = *(const bf16x8*)(wsb + (size_t)cur.qoff + (unsigned)(((wid * 32 + r32) * DM + d0 * 16 + hi * 8) * 2));
    SLOAD_H(cur.koff, cur.voff, cur.kb0); VMW(); SWRITE_HK(0);
    __syncthreads();
}
template <int MODE>
__device__ __forceinline__ void block(const unsigned char* wsb, const Blk& cur, const Nxt& nxt, unsigned sel, unsigned char* lds, Seam& S, int tid) {
    const int wid = __builtin_amdgcn_readfirstlane(tid >> 6), lane = tid & 63, r32 = lane & 31, hi = lane >> 5;
    const LAS char* K_lds = (const LAS char*)(LAS unsigned char*)lds + OFF_K;
    LAS char* Kw = (LAS char*)(LAS unsigned char*)lds + OFF_K; LAS char* Vw = (LAS char*)(LAS unsigned char*)lds + OFF_V;
    LAS float* wsf = (LAS float*)((LAS unsigned char*)lds + OFF_WS) + wid * 64; LAS float* li_l = wsf; LAS float* al_l = wsf + 32;
    const int sr = tid >> 4, sc = (tid & 15) * 8, vst0 = v_st(sr, sc), vst1 = v_st(32 + sr, sc), kws = KSWZ(sr, sc * 2);
    const int vb0 = (int)(unsigned)(uintptr_t)((LAS unsigned char*)lds) + OFF_V + v_rd_base(lane);
    const int NT = cur.NT, qlo = cur.R0 + wid * 32, qm = qlo + r32 - 4 * hi;
    const float slopeL = cur.slopeL;
    const unsigned Kh = cur.koff, Vh = cur.voff;
    float m_reg = -1e30f, l_reg = 0.f; f32x16 o[4] = {};
#define KBASE(t) (cur.kb0 + (t) * KVBLK)
#define RESC(a) do { if (__any((a) < 1.f)) { if (hi == 0) al_l[r32] = (a); LDS_WAIT(); \
        _Pragma("unroll") for (int d_ = 0; d_ < 4; ++d_) _Pragma("unroll") for (int r = 0; r < 16; ++r) o[d_][r] *= al_l[crow(r, hi)]; } } while (0)
#define QKT(PX0, PX1, t, KB, ACTV) do { const int kb_ = KBASE(t); bool nd_; unsigned W_; tile_info(cur, kb_, qlo, r32, sel, ACTV, nd_, W_); \
        qkt2<KB>(PX0, PX1, K_lds, r32, hi, S.qr, ACTV, slopeL, slopeL * (float)(kb_ - qm)); } while (0)
#define MASKT(PX0, PX1, t) do { const int kb_ = KBASE(t); bool ac_, nd_; unsigned W_; tile_info(cur, kb_, qlo, r32, sel, ac_, nd_, W_); \
        if (ac_ && nd_) mask_tile(PX0, PX1, qm - kb_, W_); } while (0)
    f32x16 pA0, pA1, pB0, pB1; float alA, alB; bf16x8 pa0, pa1, pa2, pa3; bool actA, actB;
    SWRITE_HV(0); SBAR();
    SLOAD_H(Kh, Vh, KBASE(1));
    SBAR(); QKT(pA0, pA1, 0, 0, actA);
    MASKT(pA0, pA1, 0); partialSM(pA0, pA1, m_reg, alA);
    VMW(); SWRITE_H(1);
    __syncthreads();
#define HALF_STEP(PX0, PX1, alX, actX, PY0, PY1, alY, actY, t, KB, VB, SB) do {                                                 \
        SBAR(); QKT(PX0, PX1, t, KB, actX);                                                                                   \
        finishSM(PY0, PY1, alY, l_reg, pa0, pa1, pa2, pa3); SBAR();                                                           \
        if ((t) + 1 < NT) { SLOAD_H(Kh, Vh, KBASE((t) + 1)); SBAR(); }                                                        \
        if (actY) pv_tile<VB>(o, vb0, pa0, pa1, pa2, pa3);                                                                    \
        MASKT(PX0, PX1, (t)); partialSM(PX0, PX1, m_reg, alX);                                                                \
        __syncthreads();                                                                                                      \
        if ((t) + 1 < NT) { VMW(); SWRITE_H(SB); }                                                                            \
        RESC(alX); __syncthreads(); } while (0)
    for (int t = 1; t + 1 < NT; t += 2) {
        HALF_STEP(pB0, pB1, alB, actB, pA0, pA1, alA, actA, t, 1, 0, 0);
        HALF_STEP(pA0, pA1, alA, actA, pB0, pB1, alB, actB, t + 1, 0, 1, 1);
    }
    SBAR(); QKT(pB0, pB1, NT - 1, 1, actB); SBAR();
    SLOAD_H(nxt.koff, nxt.voff, nxt.kb0); SBAR();
#pragma unroll
    for (int d0 = 0; d0 < 8; ++d0) S.qr[d0] = *(const bf16x8*)(wsb + (size_t)nxt.qoff + (unsigned)(((wid * 32 + r32) * DM + d0 * 16 + hi * 8) * 2));
    SBAR();
    finishSM(pA0, pA1, alA, l_reg, pa0, pa1, pa2, pa3); SBAR();
    if (actA) pv_tile<0>(o, vb0, pa0, pa1, pa2, pa3);
    MASKT(pB0, pB1, NT - 1); partialSM(pB0, pB1, m_reg, alB); __syncthreads(); RESC(alB);
    finishSM(pB0, pB1, alB, l_reg, pa0, pa1, pa2, pa3); SBAR();
    if (actB) pv_tile<1>(o, vb0, pa0, pa1, pa2, pa3);
    SBAR(); asm volatile("s_waitcnt vmcnt(8)" ::: "memory"); SWRITE_HK(0); SBAR();
    int tid2 = tid; asm volatile("" : "+v"(tid2));
    const int lane2 = tid2 & 63, r32e = lane2 & 31, hie = lane2 >> 5;
    if (hie == 0) li_l[r32e] = l_reg;
    LDS_WAIT();
    LAS unsigned char* stg = (LAS unsigned char*)lds + OFF_OST + wid * OST_WAVE;
#pragma unroll
    for (int r = 0; r < 16; ++r) { const int orow = crow(r, hie); const float rl = __builtin_amdgcn_rcpf(li_l[orow]);
#pragma unroll
        for (int d0 = 0; d0 < 4; ++d0) *(LAS unsigned short*)(stg + orow * OST_ROW + (d0 * 32 + r32e) * 2) = (unsigned short)(cvt_pk_bf16(o[d0][r] * rl, 0.f) & 0xffffu); }
    LDS_WAIT();
    if (MODE == 0) { if (hie == 0) *(float*)(const_cast<unsigned char*>(wsb) + (size_t)cur.xoff + (unsigned)((qlo + r32e) * NH * 4)) = m_reg + log2f(l_reg); }
#pragma unroll
    for (int i = 0; i < 8; ++i) { const int row = i * 4 + (lane2 >> 4), ch = lane2 & 15;
        u32x4 v = *(const LAS u32x4*)(stg + row * OST_ROW + ch * 16);
        const unsigned go = (unsigned)(((qlo + row) * DM + ch * 8) * 2);
        if (MODE == 1) { const u32x4 z = *(const u32x4*)(wsb + (size_t)cur.xoff + go);
            v.x = cvt_pk_bf16(bflo(v.x) * silu_f(bflo(z.x)), bfhi(v.x) * silu_f(bfhi(z.x))); v.y = cvt_pk_bf16(bflo(v.y) * silu_f(bflo(z.y)), bfhi(v.y) * silu_f(bfhi(z.y)));
            v.z = cvt_pk_bf16(bflo(v.z) * silu_f(bflo(z.z)), bfhi(v.z) * silu_f(bfhi(z.z))); v.w = cvt_pk_bf16(bflo(v.w) * silu_f(bflo(z.w)), bfhi(v.w) * silu_f(bfhi(z.w))); }
        *(u32x4*)(const_cast<unsigned char*>(wsb) + (size_t)cur.ooff + go) = v; }
    __syncthreads();
#undef KBASE
#undef RESC
#undef QKT
#undef MASKT
#undef HALF_STEP
}
#undef ROWP
#undef VMW
#undef SLOAD_H
#undef SWRITE_HK
#undef SWRITE_HV
#undef SWRITE_H
#undef KSWZ
#undef SBAR
}

namespace fc {
using namespace fa;
constexpr int NSLOT = 3;
constexpr int R_K = 0, R_V = NSLOT * SHM_K, R_WS = R_V + NSLOT * SHM_V, WSW = 96, R_OST = R_WS + 8 * WSW * 4, OSTR = 144, OSTW = 32 * OSTR;
constexpr int R_GK = R_OST + 8 * OSTW, R_SEL = R_GK + 2 * 7 * 128 * 4, R_END = R_SEL + 256 * 4;
static_assert(R_END <= LDS_BYTES - 64, "attention LDS map");
#define KSWZ(row, colB) ((row) * 256 + ((colB) ^ (((row) & 7) << 4)))
#define SBAR() __builtin_amdgcn_sched_barrier(0)
struct Blk {
    unsigned qoff, koff, voff, ooff, xoff;
    unsigned zoff, goff;
    int R0, kb0, NT;
    float slopeL;
    int L, base0;
};
struct Nxt { unsigned qoff, koff, voff; int kb0; };
__device__ __forceinline__ void glds16(const void* sbase, unsigned voff, unsigned lds_dst) { unsigned keep;
    asm volatile("s_mov_b32 %0, m0\n\ts_mov_b32 m0, %3\n\ts_nop 0\n\tglobal_load_lds_dwordx4 %1, %2\n\ts_mov_b32 m0, %0" : "=&s"(keep) : "v"(voff), "s"(sbase), "s"(lds_dst) : "memory"); }
__device__ __forceinline__ void qkt_r(f32x16& p0, f32x16& p1, const LAS char* Kslot, int r32, int hi, const bf16x8* qr) {
    const LAS char* kb[4];
#pragma unroll
    for (int dd = 0; dd < 4; ++dd) kb[dd] = Kslot + KSWZ(r32, (dd * 16 + hi * 8) * 2);
    bf16x8 c0 = *reinterpret_cast<const LAS bf16x8*>(kb[0]), c1 = *reinterpret_cast<const LAS bf16x8*>(kb[0] + 32 * 256);
#pragma unroll
    for (int d0 = 0; d0 < 8; ++d0) {
        bf16x8 n0 = c0, n1 = c1;
        if (d0 < 7) { const LAS char* a = kb[(d0 + 1) & 3] + ((d0 + 1) >> 2) * 128; n0 = *reinterpret_cast<const LAS bf16x8*>(a); n1 = *reinterpret_cast<const LAS bf16x8*>(a + 32 * 256); }
        p0 = __builtin_amdgcn_mfma_f32_32x32x16_bf16(c0, qr[d0], p0, 0, 0, 0);
        p1 = __builtin_amdgcn_mfma_f32_32x32x16_bf16(c1, qr[d0], p1, 0, 0, 0);
        c0 = n0; c1 = n1; }
}
__device__ __forceinline__ void pv_r(f32x16* o, int vb, bf16x8 pa0, bf16x8 pa1, bf16x8 pa2, bf16x8 pa3) {
#define TRRD(dst, off) asm volatile("ds_read_b64_tr_b16 %0, %1 offset:%2" : "=&v"(dst) : "v"(vb), "i"(off) : "memory")
#define PV_D0(d0) do { s16x4 l0, l1, l2, l3, h0, h1, h2, h3; constexpr int b_ = v_rd_off(d0, 0, 0); \
        TRRD(l0, b_); TRRD(h0, b_ + 2048); TRRD(l1, b_ + 4096); TRRD(h1, b_ + 6144); TRRD(l2, b_ + 8192); TRRD(h2, b_ + 10240); TRRD(l3, b_ + 12288); TRRD(h3, b_ + 14336); \
        asm volatile("s_waitcnt lgkmcnt(0)" ::: "memory"); SBAR();   \
        o[d0] = __builtin_amdgcn_mfma_f32_32x32x16_bf16(pa0, (bf16x8){l0[0], l0[1], l0[2], l0[3], h0[0], h0[1], h0[2], h0[3]}, o[d0], 0, 0, 0);   \
        o[d0] = __builtin_amdgcn_mfma_f32_32x32x16_bf16(pa1, (bf16x8){l1[0], l1[1], l1[2], l1[3], h1[0], h1[1], h1[2], h1[3]}, o[d0], 0, 0, 0);   \
        o[d0] = __builtin_amdgcn_mfma_f32_32x32x16_bf16(pa2, (bf16x8){l2[0], l2[1], l2[2], l2[3], h2[0], h2[1], h2[2], h2[3]}, o[d0], 0, 0, 0);   \
        o[d0] = __builtin_amdgcn_mfma_f32_32x32x16_bf16(pa3, (bf16x8){l3[0], l3[1], l3[2], l3[3], h3[0], h3[1], h3[2], h3[3]}, o[d0], 0, 0, 0); } while (0)
    PV_D0(0); PV_D0(1); PV_D0(2); PV_D0(3);
#undef PV_D0
#undef TRRD
}
__device__ __forceinline__ void tile_info(const Blk& c, int kb, int qlo, int r32, unsigned sel, bool& act, bool& need, unsigned& W, bool& dead) {
    dead = false;
    if (c.L > 0) { const int seq0 = qlo & ~(c.L - 1); int lowk = qlo - 128; if (lowk < seq0) lowk = seq0;
        act = (kb <= qlo + 31) && (kb + KVBLK - 1 >= lowk); need = true; const int wl = qlo + r32 - seq0 + 1; W = (unsigned)(wl < 129 ? wl : 129); }
    else if (kb >= c.R0) { act = kb <= qlo + 31; need = kb + KVBLK - 1 > qlo; W = 0x40000000u; }
    else { const int blk = (kb - c.base0) >> 8; const bool sb = (sel >> blk) & 1u; act = __ballot(sb) != 0ull; need = false; W = 0x40000000u; dead = !sb; }
}
struct Ring { int kt; };
__device__ __forceinline__ int nx3(int s) { return s == 2 ? 0 : s + 1; }
struct DmaLane { unsigned vk0, vk1, vv0, vv1; };
__device__ __forceinline__ DmaLane dma_lane(int wid, int lane) {
    DmaLane d;
    { const int row0 = wid * 8 + (lane >> 4), row1 = row0 + 4, cs = lane & 15;
      d.vk0 = (unsigned)(row0 * DM * 2 + ((cs ^ (row0 & 7)) * 16)); d.vk1 = (unsigned)(row1 * DM * 2 + ((cs ^ (row1 & 7)) * 16)); }
    { const int gi = lane & 31, kk = wid * 8 + (gi >> 2), k = (kk & ~0xC) | ((kk & 4) << 1) | ((kk & 8) >> 1);
      const int c0 = ((lane >> 5)) * 32 + (gi & 3) * 8, c1 = c0 + 64;
      d.vv0 = (unsigned)(k * DM * 2 + c0 * 2); d.vv1 = (unsigned)(k * DM * 2 + c1 * 2); }
    return d;
}
#define DMA_K(srcoff, kbrow, slot) do { const unsigned char* sb_ = wsb + ((size_t)(srcoff) + (size_t)(kbrow) * (DM * 2)); const unsigned ld_ = ldsb + R_K + (slot) * SHM_K + wid * 2048; \
        glds16(sb_, dl.vk0, ld_); glds16(sb_, dl.vk1, ld_ + 1024); } while (0)
#define DMA_V(srcoff, kbrow, slot) do { const unsigned char* sb_ = wsb + ((size_t)(srcoff) + (size_t)(kbrow) * (DM * 2)); const unsigned ld_ = ldsb + R_V + (slot) * SHM_V + wid * 2048; \
        glds16(sb_, dl.vv0, ld_); glds16(sb_, dl.vv1, ld_ + 1024); } while (0)
#define WAITBAR(N) asm volatile("s_waitcnt vmcnt(" #N ") lgkmcnt(0)\n\ts_barrier" ::: "memory")
__device__ __forceinline__ void prime(const unsigned char* wsb, const Blk& cur, unsigned char* lds, bf16x8* qr, Ring& rg, int tid) {
    const int wid = __builtin_amdgcn_readfirstlane(tid >> 6), lane = tid & 63, r32 = lane & 31, hi = lane >> 5;
    const unsigned ldsb = (unsigned)(uintptr_t)((LAS unsigned char*)lds);
    const DmaLane dl = dma_lane(wid, lane);
    DMA_K(cur.koff, cur.kb0, 0); DMA_V(cur.voff, cur.kb0, 0); DMA_K(cur.koff, cur.kb0 + KVBLK, 1);
#pragma unroll
    for (int d0 = 0; d0 < 8; ++d0) qr[d0] = *(const bf16x8*)(wsb + (size_t)cur.qoff + (unsigned)(((wid * 32 + r32) * DM + d0 * 16 + hi * 8) * 2));
    rg.kt = 0;
    WAITBAR(0);
}
template <int MODE>
__device__ __forceinline__ void block(const unsigned char* wsb, const Blk& cur, const Nxt& nxt, bool has_next, unsigned sel, unsigned char* lds, bf16x8* qr, Ring& rg, int tid) {
    const int wid = __builtin_amdgcn_readfirstlane(tid >> 6), lane = tid & 63, r32 = lane & 31, hi = lane >> 5;
    const unsigned ldsb = (unsigned)(uintptr_t)((LAS unsigned char*)lds);
    const LAS char* K_lds = (const LAS char*)(LAS unsigned char*)lds + R_K;
    LAS float* wsf = (LAS float*)((LAS unsigned char*)lds + R_WS) + wid * WSW; LAS float* li_l = wsf; LAS float* al_l = wsf + 32;
    const int vbl = (int)ldsb + R_V + v_rd_base(lane);
    const DmaLane dl = dma_lane(wid, lane);
    const int NT = cur.NT, qlo = cur.R0 + wid * 32, qm = qlo + r32 - 4 * hi;
    const float slopeL = cur.slopeL;
    float m_reg = -1e30f, l_reg = 0.f; f32x16 o[4] = {};
    int kt = rg.kt;
#define RESC(a) do { if (__any((a) < 1.f)) { if (hi == 0) al_l[r32] = (a); LDS_WAIT(); \
        _Pragma("unroll") for (int d_ = 0; d_ < 4; ++d_) _Pragma("unroll") for (int r = 0; r < 16; ++r) o[d_][r] *= al_l[crow(r, hi)]; } } while (0)
#define STEPX(PX0, PX1, alX, actX, PY0, PY1, alY, actY, t, HAVEY) do {                                                                \
        const int kb_ = cur.kb0 + (t) * KVBLK; bool nd_, dd_; unsigned W_; tile_info(cur, kb_, qlo, r32, sel, actX, nd_, W_, dd_);   \
        SBAR();                                                                                                                       \
        if (actX) { const float a0_ = dd_ ? -__builtin_inff() : slopeL * (float)(kb_ - qm);                                           \
            _Pragma("unroll") for (int r = 0; r < 16; ++r) { PX0[r] = fmaf(slopeL, (float)((r & 3) + 8 * (r >> 2)), a0_); PX1[r] = fmaf(slopeL, (float)((r & 3) + 8 * (r >> 2) + 32), a0_); } \
            qkt_r(PX0, PX1, K_lds + kt * SHM_K, r32, hi, qr);                                                                         \
            if (HAVEY) finishSM(PY0, PY1, alY, l_reg, pa0, pa1, pa2, pa3); }                                                          \
        else { _Pragma("unroll") for (int r = 0; r < 16; ++r) { PX0[r] = -__builtin_inff(); PX1[r] = -__builtin_inff(); }             \
            if (HAVEY) finishSM(PY0, PY1, alY, l_reg, pa0, pa1, pa2, pa3); }                                                          \
        SBAR();                                                                                                                       \
        { const int s2_ = kt == 0 ? 2 : kt - 1, s1_ = nx3(kt);                           \
          const bool in2_ = (t) + 2 < NT, in1_ = (t) + 1 < NT;                                                                        \
          if (in2_) DMA_K(cur.koff, kb_ + 2 * KVBLK, s2_); else if (has_next) DMA_K(nxt.koff, nxt.kb0 + ((t) + 2 - NT) * KVBLK, s2_);        \
          if (in1_) DMA_V(cur.voff, kb_ + KVBLK, s1_); else if (has_next) DMA_V(nxt.voff, nxt.kb0 + ((t) + 1 - NT) * KVBLK, s1_); }         \
        SBAR();                                                                                                                       \
        if (HAVEY) { if (actY) pv_r(o, vbl + (kt == 0 ? 2 : kt - 1) * SHM_V, pa0, pa1, pa2, pa3); }                                   \
        if (actX && nd_) mask_tile(PX0, PX1, qm - kb_, W_);                                                                           \
        partialSM(PX0, PX1, m_reg, alX);                                                                                              \
        RESC(alX);                                                                                                                    \
        if ((t) + 2 < NT || has_next) WAITBAR(4); else if ((t) + 1 < NT) WAITBAR(2); else WAITBAR(0);                                 \
        kt = nx3(kt); } while (0)
    f32x16 pA0, pA1, pB0, pB1; float alA = 1.f, alB = 1.f; bf16x8 pa0, pa1, pa2, pa3; bool actA = false, actB = false;
    STEPX(pA0, pA1, alA, actA, pB0, pB1, alB, actB, 0, false);
    STEPX(pB0, pB1, alB, actB, pA0, pA1, alA, actA, 1, true);
    for (int t = 2; t < NT; t += 2) {
        STEPX(pA0, pA1, alA, actA, pB0, pB1, alB, actB, t, true);
        STEPX(pB0, pB1, alB, actB, pA0, pA1, alA, actA, t + 1, true);
    }
    finishSM(pB0, pB1, alB, l_reg, pa0, pa1, pa2, pa3); SBAR();
    if (actB) pv_r(o, vbl + (kt == 0 ? 2 : kt - 1) * SHM_V, pa0, pa1, pa2, pa3);
    SBAR();
    if (has_next) {
#pragma unroll
        for (int d0 = 0; d0 < 8; ++d0) qr[d0] = *(const bf16x8*)(wsb + (size_t)nxt.qoff + (unsigned)(((wid * 32 + r32) * DM + d0 * 16 + hi * 8) * 2));
    }
    SBAR();
    rg.kt = kt;
    int tid2 = tid; asm volatile("" : "+v"(tid2));
    const int lane2 = tid2 & 63, r32e = lane2 & 31, hie = lane2 >> 5;
    unsigned char* wsw = const_cast<unsigned char*>(wsb);
    if (MODE == 2) {
        if (hie == 0) { const int R = qlo + r32e, bb = R >> 11, t = ((R & 127) << 4) | ((R >> 7) & 15), T0 = (bb << 11) + t, T1 = (bb << 11) + ((t & 3) << 9) + (t >> 2);
            const float l2 = m_reg + log2f(l_reg);
            const float l0 = *(const float*)(wsb + (size_t)cur.xoff + (unsigned)(T0 * NH * 4)), l1 = *(const float*)(wsb + (size_t)cur.xoff + (size_t)MTOK * NH * 4 + (unsigned)(T1 * NH * 4));
            const float mx = fmaxf(l0, fmaxf(l1, l2)); const float e0 = exp2f(l0 - mx), e1 = exp2f(l1 - mx), e2 = exp2f(l2 - mx), inv = 1.f / (e0 + e1 + e2);
            li_l[r32e] = e2 * inv / l_reg; al_l[r32e] = e0 * inv; al_l[32 + r32e] = e1 * inv; }
    } else { if (hie == 0) li_l[r32e] = 1.f / l_reg; }
    LDS_WAIT();
    if (MODE == 0) { if (hie == 0) *(float*)(wsw + (size_t)cur.xoff + (unsigned)((qlo + r32e) * NH * 4)) = m_reg + log2f(l_reg); }
    LAS unsigned char* stg = (LAS unsigned char*)lds + R_OST + wid * OSTW;
    float rl[16];
#pragma unroll
    for (int r = 0; r < 16; ++r) rl[r] = li_l[crow(r, hie)];
    u32x4 pg0[4], pg1[4], pzz[4]; unsigned tof[4];
#define PREF(hf_) do { _Pragma("unroll") for (int i = 0; i < 4; ++i) { const int row = i * 8 + (lane2 >> 3), ch = lane2 & 7; const unsigned cb = (unsigned)(((hf_) * 64 + ch * 8) * 2); \
            const int R = qlo + row, bb = R >> 11, t = ((R & 127) << 4) | ((R >> 7) & 15), T0 = (bb << 11) + t, T1 = (bb << 11) + ((t & 3) << 9) + (t >> 2);                    \
            tof[i] = (unsigned)(T0 * DM * 2);                                                                                                                                   \
            pg0[i] = *(const u32x4*)(wsb + (size_t)cur.ooff + tof[i] + cb); pg1[i] = *(const u32x4*)(wsb + (size_t)cur.ooff + (size_t)PART * 2 + (unsigned)(T1 * DM * 2) + cb); \
            pzz[i] = *(const u32x4*)(wsb + (size_t)cur.zoff + tof[i] + cb); } } while (0)
    if (MODE == 2) PREF(0);
#pragma unroll
    for (int hf = 0; hf < 2; ++hf) {
#pragma unroll
        for (int r = 0; r < 16; ++r) { const int orow = crow(r, hie);
#pragma unroll
            for (int dd = 0; dd < 2; ++dd) *(LAS unsigned short*)(stg + orow * OSTR + (dd * 32 + r32e) * 2) = (unsigned short)(cvt_pk_bf16(o[2 * hf + dd][r] * rl[r], 0.f) & 0xffffu); }
        LDS_WAIT();
        if (MODE == 2) {
            u32x4 vv[4];
#pragma unroll
            for (int i = 0; i < 4; ++i) { const int row = i * 8 + (lane2 >> 3), ch = lane2 & 7;
                u32x4 v = *(const LAS u32x4*)(stg + row * OSTR + ch * 16);
                const float a0 = al_l[row], a1 = al_l[32 + row]; const u32x4 g0 = pg0[i], g1 = pg1[i], z = pzz[i];
#define MRG(F) v.F = cvt_pk_bf16((bflo(v.F) + a0 * bflo(g0.F) + a1 * bflo(g1.F)) * silu_f(bflo(z.F)), (bfhi(v.F) + a0 * bfhi(g0.F) + a1 * bfhi(g1.F)) * silu_f(bfhi(z.F)));
                MRG(x) MRG(y) MRG(z) MRG(w)
#undef MRG
                vv[i] = v; }
            unsigned tsv[4];
#pragma unroll
            for (int i = 0; i < 4; ++i) tsv[i] = tof[i];
            if (hf == 0) PREF(1);
#pragma unroll
            for (int i = 0; i < 4; ++i) { const int ch = lane2 & 7; store_wt(wsw + (size_t)cur.goff + tsv[i] + (unsigned)((hf * 64 + ch * 8) * 2), vv[i]); }
        } else {
#pragma unroll
            for (int i = 0; i < 4; ++i) { const int row = i * 8 + (lane2 >> 3), ch = lane2 & 7;
                u32x4 v = *(const LAS u32x4*)(stg + row * OSTR + ch * 16);
                const unsigned go = (unsigned)((qlo + row) * DM * 2) + (unsigned)((hf * 64 + ch * 8) * 2);
                if (MODE == 1) { const u32x4 z = *(const u32x4*)(wsb + (size_t)cur.xoff + go);
                    v.x = cvt_pk_bf16(bflo(v.x) * silu_f(bflo(z.x)), bfhi(v.x) * silu_f(bfhi(z.x))); v.y = cvt_pk_bf16(bflo(v.y) * silu_f(bflo(z.y)), bfhi(v.y) * silu_f(bfhi(z.y)));
                    v.z = cvt_pk_bf16(bflo(v.z) * silu_f(bflo(z.z)), bfhi(v.z) * silu_f(bfhi(z.z))); v.w = cvt_pk_bf16(bflo(v.w) * silu_f(bflo(z.w)), bfhi(v.w) * silu_f(bfhi(z.w))); }
                store_wt(wsw + (size_t)cur.ooff + go, v); } }
        LDS_WAIT();
    }
#undef PREF
#undef RESC
#undef STEPX
}
#undef DMA_K
#undef DMA_V
#undef WAITBAR
#undef KSWZ
#undef SBAR
}

namespace fd {
using namespace fa;
using fc::Blk; using fc::Nxt; using fc::Ring; using fc::DmaLane; using fc::dma_lane; using fc::glds16; using fc::qkt_r; using fc::pv_r; using fc::tile_info; using fc::nx3;
using fc::R_K; using fc::R_V; using fc::R_WS; using fc::R_OST; using fc::OSTR; using fc::OSTW;
#define SBAR() __builtin_amdgcn_sched_barrier(0)
#define DMA_K(srcoff, kbrow, slot) do { const unsigned char* sb_ = wsb + ((size_t)(srcoff) + (size_t)(kbrow) * (DM * 2)); const unsigned ld_ = ldsb + R_K + (slot) * SHM_K + wid * 2048; \
        glds16(sb_, dl.vk0, ld_); glds16(sb_, dl.vk1, ld_ + 1024); } while (0)
#define DMA_V(srcoff, kbrow, slot) do { const unsigned char* sb_ = wsb + ((size_t)(srcoff) + (size_t)(kbrow) * (DM * 2)); const unsigned ld_ = ldsb + R_V + (slot) * SHM_V + wid * 2048; \
        glds16(sb_, dl.vv0, ld_); glds16(sb_, dl.vv1, ld_ + 1024); } while (0)
#define WAITBAR(N) asm volatile("s_waitcnt vmcnt(" #N ") lgkmcnt(0)\n\ts_barrier" ::: "memory")
__device__ __forceinline__ void softmax_tile(f32x16& p0, f32x16& p1, float& m_reg, float& l_reg, float& alpha, bf16x8& pa0, bf16x8& pa1, bf16x8& pa2, bf16x8& pa3) {
    partialSM(p0, p1, m_reg, alpha);
    finishSM(p0, p1, alpha, l_reg, pa0, pa1, pa2, pa3);
}
__device__ __forceinline__ void prime(const unsigned char* wsb, const Blk& cur, unsigned char* lds, bf16x8* qr, Ring& rg, int tid) {
    const int wid = __builtin_amdgcn_readfirstlane(tid >> 6), lane = tid & 63, r32 = lane & 31, hi = lane >> 5;
    const unsigned ldsb = (unsigned)(uintptr_t)((LAS unsigned char*)lds);
    const DmaLane dl = dma_lane(wid, lane);
    DMA_K(cur.koff, cur.kb0, 0); DMA_V(cur.voff, cur.kb0, 0); DMA_K(cur.koff, cur.kb0 + KVBLK, 1);
#pragma unroll
    for (int d0 = 0; d0 < 8; ++d0) qr[d0] = *(const bf16x8*)(wsb + (size_t)cur.qoff + (unsigned)(((wid * 32 + r32) * DM + d0 * 16 + hi * 8) * 2));
    rg.kt = 0;
    WAITBAR(0);
    if (wid >= 4) WAITBAR(0);
}
__device__ __forceinline__ void finish(int tid) {
    const int wid = __builtin_amdgcn_readfirstlane(tid >> 6);
    if (wid < 4) WAITBAR(0);
}
template <int MODE>
__device__ __forceinline__ void block(const unsigned char* wsb, const Blk& cur, const Nxt& nxt, bool has_next, unsigned sel, unsigned char* lds, bf16x8* qr, Ring& rg, int tid) {
    const int wid = __builtin_amdgcn_readfirstlane(tid >> 6), lane = tid & 63, r32 = lane & 31, hi = lane >> 5;
    const unsigned ldsb = (unsigned)(uintptr_t)((LAS unsigned char*)lds);
    const LAS char* K_lds = (const LAS char*)(LAS unsigned char*)lds + R_K;
    LAS float* wsf = (LAS float*)((LAS unsigned char*)lds + R_WS) + wid * fc::WSW; LAS float* li_l = wsf; LAS float* al_l = wsf + 32;
    const int vbl = (int)ldsb + R_V + v_rd_base(lane);
    const DmaLane dl = dma_lane(wid, lane);
    const int NT = cur.NT, qlo = cur.R0 + wid * 32, qm = qlo + r32 - 4 * hi;
    const float slopeL = cur.slopeL;
    float m_reg = -1e30f, l_reg = 0.f; f32x16 o[4] = {};
    int kt = rg.kt;
    f32x16 p0, p1; bf16x8 pa0, pa1, pa2, pa3; bool actP = false;
    for (int t = 0; t < NT; ++t) {
        const int kb_ = cur.kb0 + t * KVBLK; bool act, nd_, dd_; unsigned W_; tile_info(cur, kb_, qlo, r32, sel, act, nd_, W_, dd_);
        { const int s2_ = kt == 0 ? 2 : kt - 1, s1_ = nx3(kt);
          const bool in2_ = t + 2 < NT, in1_ = t + 1 < NT;
          if (in2_) DMA_K(cur.koff, kb_ + 2 * KVBLK, s2_); else if (has_next) DMA_K(nxt.koff, nxt.kb0 + (t + 2 - NT) * KVBLK, s2_);
          if (in1_) DMA_V(cur.voff, kb_ + KVBLK, s1_); else if (has_next) DMA_V(nxt.voff, nxt.kb0 + (t + 1 - NT) * KVBLK, s1_); }
        SBAR();
        if (act) { const float a0_ = dd_ ? -__builtin_inff() : slopeL * (float)(kb_ - qm);
#pragma unroll
            for (int r = 0; r < 16; ++r) { p0[r] = fmaf(slopeL, (float)((r & 3) + 8 * (r >> 2)), a0_); p1[r] = fmaf(slopeL, (float)((r & 3) + 8 * (r >> 2) + 32), a0_); }
            qkt_r(p0, p1, K_lds + kt * SHM_K, r32, hi, qr); }
        if (actP) pv_r(o, vbl + (kt == 0 ? 2 : kt - 1) * SHM_V, pa0, pa1, pa2, pa3);
        SBAR();
        if (t + 2 < NT || has_next) WAITBAR(4); else WAITBAR(0);
        if (act) { float alpha;
            if (nd_) mask_tile(p0, p1, qm - kb_, W_);
            softmax_tile(p0, p1, m_reg, l_reg, alpha, pa0, pa1, pa2, pa3);
            if (__any(alpha < 1.f)) { if (hi == 0) al_l[r32] = alpha; LDS_WAIT();
#pragma unroll
                for (int d_ = 0; d_ < 4; ++d_)
#pragma unroll
                    for (int r = 0; r < 16; ++r) o[d_][r] *= al_l[crow(r, hi)]; } }
        actP = act;
        SBAR();
        if (t + 2 < NT || has_next) WAITBAR(4); else WAITBAR(0);
        kt = nx3(kt);
    }
    if (actP) pv_r(o, vbl + (kt == 0 ? 2 : kt - 1) * SHM_V, pa0, pa1, pa2, pa3);
    SBAR();
    if (has_next) {
#pragma unroll
        for (int d0 = 0; d0 < 8; ++d0) qr[d0] = *(const bf16x8*)(wsb + (size_t)nxt.qoff + (unsigned)(((wid * 32 + r32) * DM + d0 * 16 + hi * 8) * 2));
    }
    SBAR();
    rg.kt = kt;
    if (has_next) WAITBAR(4); else WAITBAR(0);
    int tid2 = tid; asm volatile("" : "+v"(tid2));
    const int lane2 = tid2 & 63, r32e = lane2 & 31, hie = lane2 >> 5;
    if (hie == 0) li_l[r32e] = l_reg;
    LDS_WAIT();
    if (MODE == 0) { if (hie == 0) *(float*)(const_cast<unsigned char*>(wsb) + (size_t)cur.xoff + (unsigned)((qlo + r32e) * NH * 4)) = m_reg + log2f(l_reg); }
    LAS unsigned char* stg = (LAS unsigned char*)lds + R_OST + wid * OSTW;
    float rl[16];
#pragma unroll
    for (int r = 0; r < 16; ++r) rl[r] = __builtin_amdgcn_rcpf(li_l[crow(r, hie)]);
#pragma unroll
    for (int hf = 0; hf < 2; ++hf) {
#pragma unroll
        for (int r = 0; r < 16; ++r) { const int orow = crow(r, hie);
#pragma unroll
            for (int dd = 0; dd < 2; ++dd) *(LAS unsigned short*)(stg + orow * OSTR + (dd * 32 + r32e) * 2) = (unsigned short)(cvt_pk_bf16(o[2 * hf + dd][r] * rl[r], 0.f) & 0xffffu); }
        LDS_WAIT();
#pragma unroll
        for (int i = 0; i < 4; ++i) { const int row = i * 8 + (lane2 >> 3), ch = lane2 & 7;
            u32x4 v = *(const LAS u32x4*)(stg + row * OSTR + ch * 16);
            const unsigned go = (unsigned)(((qlo + row) * DM + hf * 64 + ch * 8) * 2);
            if (MODE == 1) { const u32x4 z = *(const u32x4*)(wsb + (size_t)cur.xoff + go);
                v.x = cvt_pk_bf16(bflo(v.x) * silu_f(bflo(z.x)), bfhi(v.x) * silu_f(bfhi(z.x))); v.y = cvt_pk_bf16(bflo(v.y) * silu_f(bflo(z.y)), bfhi(v.y) * silu_f(bfhi(z.y)));
                v.z = cvt_pk_bf16(bflo(v.z) * silu_f(bflo(z.z)), bfhi(v.z) * silu_f(bfhi(z.z))); v.w = cvt_pk_bf16(bflo(v.w) * silu_f(bflo(z.w)), bfhi(v.w) * silu_f(bfhi(z.w))); }
            *(u32x4*)(const_cast<unsigned char*>(wsb) + (size_t)cur.ooff + go) = v; }
        LDS_WAIT();
    }
    if (has_next) WAITBAR(4); else WAITBAR(0);
}
#undef DMA_K
#undef DMA_V
#undef WAITBAR
#undef SBAR
}

__device__ __forceinline__ fb::Blk blk_a(int it) {
    const int g = it >> 9, rem = it & 511, h = rem & 15, rb = rem < 256 ? (rem >> 4) : 31 - ((rem - 256) >> 4), lg = 2 * g, L = SEQ >> lg, R0 = rb * 256;
    int kb0 = R0 - 128; { const int s0 = R0 & ~(L - 1); if (kb0 < s0) kb0 = s0; }
    fb::Blk b;
    b.qoff = (unsigned)(WS_QKV + ((size_t)(3 * g) * PART + (size_t)R0 * DM + h * HD) * 2); b.koff = (unsigned)(WS_QKV + ((size_t)(3 * g + 1) * PART + h * HD) * 2); b.voff = (unsigned)(WS_QKV + ((size_t)(3 * g + 2) * PART + h * HD) * 2);
    b.ooff = (unsigned)(WS_OG + ((size_t)g * PART + h * HD) * 2); b.xoff = (unsigned)(WS_LSE + ((size_t)g * MTOK * NH + h) * 4);
    b.R0 = R0; b.kb0 = kb0; b.NT = (R0 + 256 - kb0) >> 6; b.slopeL = slope_of(h) * (float)(1 << lg) * LOG2E; b.L = L; b.base0 = 0;
    return b;
}
__device__ __forceinline__ void attn_a_pipe(unsigned char* lds, int wv) {
    CParams& P = PP();
    const int tid = otid(wv);
    const unsigned char* wsb = P.ws;
    constexpr int TOTAL = 3 * NH * (MTOK / 256);
    int it = obid(); if (it >= TOTAL) return;
    fb::Blk cur = blk_a(it);
    fb::Seam S;
    fb::prime(wsb, cur, lds, S, tid);
    for (;;) {
        const int itn = it + (int)gridDim.x; const bool last = itn >= TOTAL;
        const fb::Blk nb = last ? cur : blk_a(itn);
        const fb::Nxt nxt{nb.qoff, nb.koff, nb.voff, nb.kb0};
        fb::block<0>(wsb, cur, nxt, 0u, lds, S, tid);
        if (last) break;
        cur = nb; it = itn;
    }
}
__device__ __forceinline__ int vit_b(int it) { return (it < 256) ? ((it & 7) * 32 + (it >> 3)) : it; }
__device__ __forceinline__ fb::Blk blk_b(int it_, int pass) {
    const int it = vit_b(it_); const int bh = it >> 2, s = it & 3, b = bh >> 4, h = bh & 15, n = pass ? 7 - s : s, R0 = (b << 11) + (n << 8);
    fb::Blk k;
    k.qoff = (unsigned)(WS_QKV + ((size_t)R0 * DM + h * HD) * 2); k.koff = (unsigned)(WS_QKV + (PART + h * HD) * 2); k.voff = (unsigned)(WS_QKV + (2 * PART + h * HD) * 2);
    k.ooff = (unsigned)(WS_G + (size_t)(h * HD) * 2); k.xoff = (unsigned)(WS_Z + (size_t)(h * HD) * 2);
    k.R0 = R0; k.kb0 = b << 11; k.NT = 4 * (n + 1); k.slopeL = slope_of(h) * LOG2E; k.L = 0; k.base0 = b << 11;
    return k;
}
__device__ __forceinline__ unsigned moba_gate(const unsigned char* wsb, unsigned char* lds, int b, int h, int n, int R0, int tid) {
    unsigned sel = (1u << n) - 1u;
    if (n >= 4) {
        asm volatile("" : "+v"(tid));
        const bf16_t* QKV = (const bf16_t*)(wsb + WS_QKV); const float* KS = (const float*)(wsb + WS_KSUM);
        LAS float* gk = (LAS float*)((LAS unsigned char*)lds + fc::R_GK); LAS unsigned* sel_l = (LAS unsigned*)((LAS unsigned char*)lds + fc::R_SEL);
        for (int i = tid; i < n * 128; i += NTHREADS) { const float* kp = KS + (size_t)(b * 8 + (i >> 7)) * DM + h * HD + (i & 127); gk[i] = kp[0] + kp[(size_t)32 * DM]; }
        __syncthreads();
        const int row = tid >> 1, half = tid & 1;
        const u32x4* qp = (const u32x4*)(QKV + (size_t)(R0 + row) * DM + h * HD + half * 64);
        float gt[7];
#pragma unroll
        for (int j = 0; j < 7; ++j) gt[j] = 0.f;
#pragma unroll
        for (int c = 0; c < 8; ++c) { const u32x4 w = qp[c]; const float q0 = bflo(w.x), q1 = bfhi(w.x), q2 = bflo(w.y), q3 = bfhi(w.y), q4 = bflo(w.z), q5 = bfhi(w.z), q6 = bflo(w.w), q7 = bfhi(w.w);
#pragma unroll
            for (int j = 0; j < 7; ++j) if (j < n) { const LAS f32x4* kk = (const LAS f32x4*)(gk + j * 128 + half * 64 + c * 8); const f32x4 ka = kk[0], kb2 = kk[1];
                gt[j] += (q0 * ka.x + q1 * ka.y) + (q2 * ka.z + q3 * ka.w) + (q4 * kb2.x + q5 * kb2.y) + (q6 * kb2.z + q7 * kb2.w); } }
#pragma unroll
        for (int j = 0; j < 7; ++j) gt[j] += __shfl_xor(gt[j], 1);
        unsigned mask = 0;
#pragma unroll
        for (int j = 0; j < 7; ++j) if (j < n) { int rank = 0;
#pragma unroll
            for (int j2 = 0; j2 < 7; ++j2) if (j2 < n && (gt[j2] > gt[j] || (gt[j2] == gt[j] && j2 < j))) ++rank;
            if (rank < 3) mask |= 1u << j; }
        if (half == 0) sel_l[row] = mask;
        __syncthreads();
        sel = sel_l[(tid >> 6) * 32 + (tid & 31)];
    }
    return sel;
}
__device__ __forceinline__ void attn_b_pipe(unsigned char* lds, int wv) {
    CParams& P = PP();
    const int tid = otid(wv);
    const unsigned char* wsb = P.ws;
    constexpr int TOTAL = NB * NH * 4;
    int it = obid(); if (it >= TOTAL) return;
    int pass = 0;
    fb::Blk cur = blk_b(it, 0);
    fb::Seam S;
    fb::prime(wsb, cur, lds, S, tid);
    for (;;) {
        int itn = it, passn = pass + 1; if (passn == 2) { passn = 0; itn = it + (int)gridDim.x; }
        const bool last = itn >= TOTAL;
        const fb::Blk nb = last ? cur : blk_b(itn, passn);
        const fb::Nxt nxt{nb.qoff, nb.koff, nb.voff, nb.kb0};
        const int vi = vit_b(it), bh = vi >> 2, s = vi & 3, n = pass ? 7 - s : s;
        const unsigned sel = moba_gate(wsb, lds, bh >> 4, bh & 15, n, cur.R0, tid);
        fb::block<1>(wsb, cur, nxt, sel, lds, S, tid);
        if (last) break;
        cur = nb; it = itn; pass = passn;
    }
}

__device__ __forceinline__ fc::Blk cblk_a(int it) { const fb::Blk b = blk_a(it); const int h = it & 15, g = it >> 9;
    fc::Blk c{b.qoff, b.koff, b.voff, b.ooff, b.xoff, 0u, 0u, b.R0, b.kb0, b.NT, b.slopeL, b.L, b.base0};
    if (g == 2) { c.ooff = (unsigned)(WS_OG + (size_t)(h * HD) * 2); c.xoff = (unsigned)(WS_LSE + (size_t)h * 4); c.zoff = (unsigned)(WS_Z + (size_t)(h * HD) * 2); c.goff = (unsigned)(WS_G + (size_t)(h * HD) * 2); }
    return c; }
__device__ __forceinline__ fc::Blk cblk_b(int it, int pass) { const fb::Blk b = blk_b(it, pass); return fc::Blk{b.qoff, b.koff, b.voff, b.ooff, b.xoff, 0u, 0u, b.R0, b.kb0, b.NT, b.slopeL, b.L, b.base0}; }
template <int MODE>
__device__ __forceinline__ void attn_a_dma(unsigned char* lds, int wv, int first, int count) {
    CParams& P = PP();
    const int tid = otid(wv);
    const unsigned char* wsb = P.ws;
    int it = obid(); if (it >= count) return;
    fc::Blk cur = cblk_a(first + it);
    bf16x8 qr[8]; fc::Ring rg;
    fc::prime(wsb, cur, lds, qr, rg, tid);
    for (;;) {
        const int itn = it + (int)gridDim.x; const bool last = itn >= count;
        const fc::Blk nb = last ? cur : cblk_a(first + itn);
        const fc::Nxt nxt{nb.qoff, nb.koff, nb.voff, nb.kb0};
        fc::block<MODE>(wsb, cur, nxt, !last, 0u, lds, qr, rg, tid);
        if (last) break;
        cur = nb; it = itn;
    }
}
__device__ __forceinline__ void attn_b_dma(unsigned char* lds, int wv) {
    CParams& P = PP();
    const int tid = otid(wv);
    const unsigned char* wsb = P.ws;
    constexpr int TOTAL = NB * NH * 4;
    int it = obid(); if (it >= TOTAL) return;
    int pass = 0;
    fc::Blk cur = cblk_b(it, 0);
    bf16x8 qr[8]; fc::Ring rg;
    fc::prime(wsb, cur, lds, qr, rg, tid);
    for (;;) {
        int itn = it, passn = pass + 1; if (passn == 2) { passn = 0; itn = it + (int)gridDim.x; }
        const bool last = itn >= TOTAL;
        const fc::Blk nb = last ? cur : cblk_b(itn, passn);
        const fc::Nxt nxt{nb.qoff, nb.koff, nb.voff, nb.kb0};
        const int vi = vit_b(it), bh = vi >> 2, s = vi & 3, n = pass ? 7 - s : s;
        const unsigned sel = moba_gate(wsb, lds, bh >> 4, bh & 15, n, cur.R0, tid);
        fc::block<1>(wsb, cur, nxt, !last, sel, lds, qr, rg, tid);
        if (last) break;
        cur = nb; it = itn; pass = passn;
    }
}

__device__ __forceinline__ unsigned moba_gate2(const unsigned char* wsb, unsigned char* lds, int b, int h, int n, int R0, int tid) {
    unsigned sel = (1u << n) - 1u;
    if (n >= 4) {
        asm volatile("" : "+v"(tid));
        const int grp = tid >> 8, tin = tid & 255;
        const bf16_t* QKV = (const bf16_t*)(wsb + WS_QKV); const float* KS = (const float*)(wsb + WS_KSUM);
        LAS float* gk = (LAS float*)((LAS unsigned char*)lds + fc::R_GK) + grp * (7 * 128); LAS unsigned* sel_l = (LAS unsigned*)((LAS unsigned char*)lds + fc::R_SEL);
        for (int i = tin; i < n * 128; i += 256) { const float* kp = KS + (size_t)(b * 8 + (i >> 7)) * DM + h * HD + (i & 127); gk[i] = kp[0] + kp[(size_t)32 * DM]; }
        __syncthreads();
        const int row = grp * 128 + (tin >> 1), half = tin & 1;
        const u32x4* qp = (const u32x4*)(QKV + (size_t)(R0 + row) * DM + h * HD + half * 64);
        float gt[7];
#pragma unroll
        for (int j = 0; j < 7; ++j) gt[j] = 0.f;
#pragma unroll
        for (int c = 0; c < 8; ++c) { const u32x4 w = qp[c]; const float q0 = bflo(w.x), q1 = bfhi(w.x), q2 = bflo(w.y), q3 = bfhi(w.y), q4 = bflo(w.z), q5 = bfhi(w.z), q6 = bflo(w.w), q7 = bfhi(w.w);
#pragma unroll
            for (int j = 0; j < 7; ++j) if (j < n) { const LAS f32x4* kk = (const LAS f32x4*)(gk + j * 128 + half * 64 + c * 8); const f32x4 ka = kk[0], kb2 = kk[1];
                gt[j] += (q0 * ka.x + q1 * ka.y) + (q2 * ka.z + q3 * ka.w) + (q4 * kb2.x + q5 * kb2.y) + (q6 * kb2.z + q7 * kb2.w); } }
#pragma unroll
        for (int j = 0; j < 7; ++j) gt[j] += __shfl_xor(gt[j], 1);
        unsigned mask = 0;
#pragma unroll
        for (int j = 0; j < 7; ++j) if (j < n) { int rank = 0;
#pragma unroll
            for (int j2 = 0; j2 < 7; ++j2) if (j2 < n && (gt[j2] > gt[j] || (gt[j2] == gt[j] && j2 < j))) ++rank;
            if (rank < 3) mask |= 1u << j; }
        if (half == 0) sel_l[row] = mask;
        __syncthreads();
        sel = sel_l[(tid >> 6) * 32 + (tid & 31)];
    }
    return sel;
}
__device__ __forceinline__ void attn_a_hs(unsigned char* lds, int wv) {
    CParams& P = PP();
    const int tid = otid(wv);
    const unsigned char* wsb = P.ws;
    constexpr int TOTAL = 3 * NH * (MTOK / 256);
    int it = obid(); if (it >= TOTAL) return;
    fc::Blk cur = cblk_a(it);
    bf16x8 qr[8]; fc::Ring rg;
    fd::prime(wsb, cur, lds, qr, rg, tid);
    for (;;) {
        const int itn = it + (int)gridDim.x; const bool last = itn >= TOTAL;
        const fc::Blk nb = last ? cur : cblk_a(itn);
        const fc::Nxt nxt{nb.qoff, nb.koff, nb.voff, nb.kb0};
        fd::block<0>(wsb, cur, nxt, !last, 0u, lds, qr, rg, tid);
        if (last) break;
        cur = nb; it = itn;
    }
    fd::finish(tid);
}
__device__ __forceinline__ void attn_b_hs(unsigned char* lds, int wv) {
    CParams& P = PP();
    const int tid = otid(wv);
    const unsigned char* wsb = P.ws;
    constexpr int TOTAL = NB * NH * 4;
    int it = obid(); if (it >= TOTAL) return;
    int pass = 0;
    fc::Blk cur = cblk_b(it, 0);
    bf16x8 qr[8]; fc::Ring rg;
    fd::prime(wsb, cur, lds, qr, rg, tid);
    for (;;) {
        int itn = it, passn = pass + 1; if (passn == 2) { passn = 0; itn = it + (int)gridDim.x; }
        const bool last = itn >= TOTAL;
        const fc::Blk nb = last ? cur : cblk_b(itn, passn);
        const fc::Nxt nxt{nb.qoff, nb.koff, nb.voff, nb.kb0};
        const int vi = vit_b(it), bh = vi >> 2, s = vi & 3, n = pass ? 7 - s : s;
        const unsigned sel = moba_gate2(wsb, lds, bh >> 4, bh & 15, n, cur.R0, tid);
        fd::block<1>(wsb, cur, nxt, !last, sel, lds, qr, rg, tid);
        if (last) break;
        cur = nb; it = itn; pass = passn;
    }
    fd::finish(tid);
}

__device__ __forceinline__ void attn_a_flash(unsigned char* lds, int wv) {
    CParams& P = PP();
    const int tid = otid(wv);
    const bf16_t* QKV = (const bf16_t*)(P.ws + WS_QKV); bf16_t* OG = (bf16_t*)(P.ws + WS_OG); float* LSE = (float*)(P.ws + WS_LSE);
    for (int it = obid(); it < 3 * NH * (MTOK / 256); it += gridDim.x) {
        const int g = it >> 9, rem = it & 511, h = rem & 15, rb = rem >> 4;
        const int lg = 2 * g, L = SEQ >> lg, R0 = rb * 256;
        int krow0 = R0 - 128; { const int s0 = R0 & ~(L - 1); if (krow0 < s0) krow0 = s0; }
        const int NT = (R0 + 256 - krow0) >> 6;
        const fa::MaskA mk{L};
        fa::flash_block<0>(QKV + (size_t)(3 * g) * PART + (size_t)R0 * DM + h * HD, QKV + (size_t)(3 * g + 1) * PART + h * HD, QKV + (size_t)(3 * g + 2) * PART + h * HD,
                           krow0, NT, R0, slope_of(h) * (float)(1 << lg) * LOG2E, mk, lds, OG + (size_t)g * PART + h * HD, LSE + (size_t)g * MTOK * NH + h, nullptr, tid);
    }
}
__device__ __forceinline__ void attn_b_flash(unsigned char* lds, int wv) {
    CParams& P = PP();
    const int tid = otid(wv);
    const bf16_t* QKV = (const bf16_t*)(P.ws + WS_QKV); const bf16_t* Z = (const bf16_t*)(P.ws + WS_Z); bf16_t* G = (bf16_t*)(P.ws + WS_G); const float* KS = (const float*)(P.ws + WS_KSUM);
    LAS float* gk = (LAS float*)((LAS unsigned char*)lds + fa::OFF_GK); LAS unsigned* sel_l = (LAS unsigned*)((LAS unsigned char*)lds + fa::OFF_SEL);
    for (int it = obid(); it < NB * NH * 4; it += gridDim.x) {
        const int bh = it >> 2, s = it & 3, b = bh >> 4, h = bh & 15;
        for (int pass = 0; pass < 2; ++pass) {
            const int n = pass ? 7 - s : s, R0 = (b << 11) + (n << 8);
            unsigned sel = (1u << n) - 1u;
            if (n >= 4) {
                for (int i = tid; i < n * 128; i += NTHREADS) { const float* kp = KS + (size_t)(b * 8 + (i >> 7)) * DM + h * HD + (i & 127); gk[i] = kp[0] + kp[(size_t)32 * DM]; }
                __syncthreads();
                const int row = tid >> 1, half = tid & 1;
                const u32x4* qp = (const u32x4*)(QKV + (size_t)(R0 + row) * DM + h * HD + half * 64);
                float gt[7];
#pragma unroll
                for (int j = 0; j < 7; ++j) gt[j] = 0.f;
#pragma unroll
                for (int c = 0; c < 8; ++c) { const u32x4 w = qp[c]; const float q0 = bflo(w.x), q1 = bfhi(w.x), q2 = bflo(w.y), q3 = bfhi(w.y), q4 = bflo(w.z), q5 = bfhi(w.z), q6 = bflo(w.w), q7 = bfhi(w.w);
#pragma unroll
                    for (int j = 0; j < 7; ++j) if (j < n) { const LAS f32x4* kk = (const LAS f32x4*)(gk + j * 128 + half * 64 + c * 8); const f32x4 ka = kk[0], kb2 = kk[1];
                        gt[j] += (q0 * ka.x + q1 * ka.y) + (q2 * ka.z + q3 * ka.w) + (q4 * kb2.x + q5 * kb2.y) + (q6 * kb2.z + q7 * kb2.w); } }
#pragma unroll
                for (int j = 0; j < 7; ++j) gt[j] += __shfl_xor(gt[j], 1);
                unsigned mask = 0;
#pragma unroll
                for (int j = 0; j < 7; ++j) if (j < n) { int rank = 0;
#pragma unroll
                    for (int j2 = 0; j2 < 7; ++j2) if (j2 < n && (gt[j2] > gt[j] || (gt[j2] == gt[j] && j2 < j))) ++rank;
                    if (rank < 3) mask |= 1u << j; }
                if (half == 0) sel_l[row] = mask;
                __syncthreads();
                sel = sel_l[(tid >> 6) * 32 + (tid & 31)];
            }
            const fa::MaskB mk{R0, b << 11, sel};
            fa::flash_block<1>(QKV + (size_t)R0 * DM + h * HD, QKV + PART + h * HD, QKV + 2 * PART + h * HD, b << 11, 4 * (n + 1), R0, slope_of(h) * LOG2E, mk, lds,
                               G + h * HD, nullptr, Z + h * HD, tid);
        }
    }
}

#define XB_TMO      128
#define XB_XCNT(j)  (256  + 64 * (j))
#define XB_XSUB(j)  (1280 + 64 * (j))
#define XB_XGEN(j)  (2304 + 64 * (j))
#define XB_TOP      3328
#define XB_TOPGEN   3392
#define XCD_BAR_WORDS 3456
#define XB_SPIN_CAP (1u << 20)
__device__ __forceinline__ unsigned xb_ld(unsigned* p)              { return __hip_atomic_load(p, __ATOMIC_RELAXED, __HIP_MEMORY_SCOPE_AGENT); }
__device__ __forceinline__ unsigned xb_add(unsigned* p, unsigned v) { return __hip_atomic_fetch_add(p, v, __ATOMIC_RELAXED, __HIP_MEMORY_SCOPE_AGENT); }
__device__ __forceinline__ unsigned xb_xcc_id() { return (unsigned)__builtin_amdgcn_s_getreg((3 << 11) | 20) & 0xFu; }
#define XB_SPIN(cond, bar) do { unsigned _sp = 0; while (cond) { __builtin_amdgcn_s_sleep(1); \
    if ((++_sp & 255u) == 0u) { if (xb_ld(&(bar)[XB_TMO])) break; if (_sp > XB_SPIN_CAP) { atomicAdd(&(bar)[XB_TMO], 1u); break; } } } } while (0)
struct XcdBarrier { unsigned* bar; unsigned x; volatile LAS unsigned* st; };
__device__ __forceinline__ XcdBarrier xcd_barrier_post(unsigned* bar, volatile LAS unsigned* st) {
    XcdBarrier b; b.bar = bar; b.x = xb_xcc_id(); b.st = st;
    if (threadIdx.x == 0) (void)xb_add(&bar[XB_XCNT(b.x)], 1u);
    return b;
}
__device__ __forceinline__ void xcd_barrier_complete(unsigned* bar, unsigned x, unsigned& nloc, unsigned& nx) {
    const unsigned G = gridDim.x * gridDim.y * gridDim.z;
    unsigned sum, cnt, mine, sp = 0u;
    for (;;) {
        sum = 0u; cnt = 0u; mine = 0u;
#pragma unroll
        for (unsigned j = 0; j < 16; ++j) { const unsigned c = xb_ld(&bar[XB_XCNT(j)]); sum += c; cnt += (c > 0u) ? 1u : 0u; mine = (j == x) ? c : mine; }
        if (sum == G) break;
        __builtin_amdgcn_s_sleep(1);
        if ((++sp & 255u) == 0u) { if (xb_ld(&bar[XB_TMO])) break; if (sp > XB_SPIN_CAP) { atomicAdd(&bar[XB_TMO], 1u); break; } }
    }
    nloc = mine > 0u ? mine : 1u; nx = cnt > 0u ? cnt : 1u;
}
__device__ __forceinline__ void xcd_barrier(const XcdBarrier& b) {
    asm volatile("s_waitcnt vmcnt(0)" ::: "memory");
    __syncthreads();
    if (threadIdx.x == 0) {
        unsigned* bar = b.bar;
        __builtin_amdgcn_s_waitcnt(0);
        unsigned nloc = b.st[0], nx = b.st[1];
        if (nloc == 0u) { xcd_barrier_complete(bar, b.x, nloc, nx); b.st[0] = nloc; b.st[1] = nx; }
        const unsigned old = xb_add(&bar[XB_XSUB(b.x)], 1u);
        const unsigned gen = old / nloc;
        if (old + 1u == (gen + 1u) * nloc) {
            __builtin_amdgcn_fence(__ATOMIC_RELEASE, "agent");
            asm volatile("s_waitcnt vmcnt(0)" ::: "memory");
            const unsigned og = xb_add(&bar[XB_TOP], 1u);
            const unsigned tg = og / nx;
            if (og + 1u == (tg + 1u) * nx) xb_add(&bar[XB_TOPGEN], 1u);
            else XB_SPIN(xb_ld(&bar[XB_TOPGEN]) == tg, bar);
            __builtin_amdgcn_fence(__ATOMIC_ACQUIRE, "agent");
            xb_add(&bar[XB_XGEN(b.x)], 1u);
            asm volatile("s_waitcnt vmcnt(0)" ::: "memory");
        } else {
            XB_SPIN(xb_ld(&bar[XB_XGEN(b.x)]) == gen, bar);
            __builtin_amdgcn_fence(__ATOMIC_ACQUIRE, "agent");
            asm volatile("s_waitcnt vmcnt(0)" ::: "memory");
        }
    }
    __syncthreads();
}

__global__ void __launch_bounds__(NTHREADS, 2) fwd_mega(Params Pin) {
    extern __shared__ __attribute__((aligned(16))) unsigned char lds[];
#if USE_CG_SYNC
    cg::grid_group grid = cg::this_grid();
#endif
    LAS unsigned char* lds3 = (LAS unsigned char*)lds;
    (void)Pin;
    const int wv = __builtin_amdgcn_readfirstlane((int)threadIdx.x >> 6);
    volatile LAS unsigned* bst = (volatile LAS unsigned*)(lds3 + (LDS_BYTES - 64));
    if (threadIdx.x < 2) bst[threadIdx.x] = 0u;
    __syncthreads();
    (void)xcd_barrier_post((unsigned*)(PP().ws + WS_CTL), bst);
#define GSYNC() do { XcdBarrier xb_; xb_.bar = (unsigned*)(PP().ws + WS_CTL); xb_.x = xb_xcc_id(); xb_.st = bst; xcd_barrier(xb_); } while (0)
    p0_mod(lds, wv);
    p0_weights(lds, wv);
#if PROBE == 1
    __syncthreads(); p0_mod(lds, wv); p0_weights(lds, wv);
#endif
#if USE_CG_SYNC
    grid.sync();
#else
    GSYNC();
#endif
    for (int layer = 0; layer < DEPTH; ++layer) {
        const bool isA = (layer & 1) == 0; const int j = layer >> 1;
        norm_phase(layer, !isA && !MOBA_QK_I8, wv);
#if PROBE == 2
        norm_phase(layer, !isA && !MOBA_QK_I8, wv);
#endif
#if PROBE == 6
        GSYNC(); GSYNC(); GSYNC(); GSYNC(); GSYNC();
#endif
        GSYNC();
        {
#if !MOBA_QK_I8
            if (!isA) {
                unsigned char* ws = PP().ws;
                pg8::Gemm g{ws + WS_H, ws + WS_WBQK + (size_t)j * 4096 * DM * 2, MTOK, 4096, DM * 2};
                pg8::StaticOrder S; S.init(MTOK, 4096, (int)gridDim.x, obid());
                pg8::Epi E{1, 0, (bf16_t*)(ws + WS_QKV), (bf16_t*)(ws + WS_Z), (float*)(ws + WS_KSUM), nullptr, nullptr, nullptr, nullptr, nullptr};
                pg8::gemm_phase<pg8::Epi, pg8::StaticOrder, GEMM_ALIGN, GEMM_SP2, false>(lds3, g, S, E, wv);
            }
#endif
            {
                unsigned char* ws = PP().ws;
#if MOBA_QK_I8
                pg8::Gemm g{ws + WS_HQ, isA ? ws + WS_WAIN + (size_t)j * A_N * DM : ws + WS_WBQK + (size_t)j * B_N * DM, MTOK, isA ? A_N : B_N, DM};
                pg8::StaticOrder S; S.init(MTOK, g.N, (int)gridDim.x, obid());
                pg8::Epi E{isA ? 0 : 1, 0, (bf16_t*)(ws + WS_QKV), (bf16_t*)(ws + WS_Z), (float*)(ws + WS_KSUM), (const float*)(ws + WS_RS),
                           isA ? (const float*)(ws + WS_CSA) + j * A_N : (const float*)(ws + WS_CSB) + j * B_N, nullptr, nullptr, nullptr};
#else
                pg8::Gemm g{ws + WS_HQ, isA ? ws + WS_WAIN + (size_t)j * A_N * DM : ws + WS_WBVZ + (size_t)j * 4096 * DM, MTOK, isA ? A_N : 4096, DM};
                pg8::StaticOrder S; S.init(MTOK, g.N, (int)gridDim.x, obid());
                pg8::Epi E{isA ? 0 : 1, isA ? 0 : 2, (bf16_t*)(ws + WS_QKV), (bf16_t*)(ws + WS_Z), nullptr, (const float*)(ws + WS_RS),
                           isA ? (const float*)(ws + WS_CSA) + j * A_N : (const float*)(ws + WS_CSB) + j * 4096, nullptr, nullptr, nullptr};
#endif
#if STAGGER_TICKS > 0
                if (isA) {
                    const unsigned long long t0_ = __builtin_amdgcn_s_memrealtime(); const unsigned long long dl_ = (unsigned long long)((obid() >> 3) & 7) * STAGGER_TICKS;
                    while (__builtin_amdgcn_s_memrealtime() - t0_ < dl_) __builtin_amdgcn_s_sleep(8);
                }
#endif
                pg8::gemm_phase<pg8::Epi, pg8::StaticOrder, GEMM_ALIGN, GEMM_SP2, true>(lds3, g, S, E, wv);
#if PROBE == 7
                pg8::gemm_phase<pg8::Epi, pg8::StaticOrder, GEMM_ALIGN, GEMM_SP2, true>(lds3, g, S, E, wv);
#endif
#if PROBE == 12 || PROBE == 13
                if (isA) { pg8::Epi E3 = E; E3.mode = PROBE == 12 ? 6 : 7; E3.qkv = (bf16_t*)(ws + WS_OG); pg8::gemm_phase<pg8::Epi, pg8::StaticOrder, GEMM_ALIGN, GEMM_SP2, true>(lds3, g, S, E3, wv); }
#endif
#if PROBE == 10 || PROBE == 11
                if (isA) { pg8::Epi E3 = E; E3.mode = PROBE == 10 ? 4 : 5; E3.qkv = (bf16_t*)(ws + WS_OG); pg8::gemm_phase<pg8::Epi, pg8::StaticOrder, GEMM_ALIGN, GEMM_SP2, true>(lds3, g, S, E3, wv); }
#endif
#if PROBE == 9
                { pg8::Epi E3 = E; E3.mode = 3; pg8::gemm_phase<pg8::Epi, pg8::StaticOrder, GEMM_ALIGN, GEMM_SP2, true>(lds3, g, S, E3, wv); }
#endif
            }
        }
        GSYNC();
#if PROBE == 3
        if (isA) attn_a_dma<0>(lds, wv, 0, 1024);
#endif
#if PROBE == 4
        if (!isA) attn_b_hs(lds, wv);
#endif
#if ATTN_HS
        if (isA) { attn_a_hs(lds, wv); GSYNC(); combine_phase(wv);
#elif ATTN_DMA
#if FUSE_COMBINE && !OUTA_I8
        if (isA) { attn_a_dma<0>(lds, wv, 0, 1024); GSYNC(); attn_a_dma<2>(lds, wv, 1024, 512);
#if PROBE == 14
            attn_a_dma<2>(lds, wv, 1024, 512);
#endif
#else
        if (isA) { attn_a_dma<0>(lds, wv, 0, 1536); GSYNC(); combine_phase(wv);
#endif
#elif ATTN_PIPE
        if (isA) { attn_a_pipe(lds, wv); GSYNC(); combine_phase(wv);
#else
        if (isA) { attn_a_flash(lds, wv); GSYNC(); combine_phase(wv);
#endif
#if PROBE == 5
            combine_phase(wv);
#endif
        }
#if ATTN_HS
        else { attn_b_hs(lds, wv); }
#elif ATTN_DMA
        else { attn_b_dma(lds, wv); }
#elif ATTN_PIPE
        else { attn_b_pipe(lds, wv); }
#else
        else { attn_b_flash(lds, wv); }
#endif
        GSYNC();
        {
            CParams& P = PP(); unsigned char* ws = P.ws;
            const bool i8o = OUTA_I8 && isA;
            pg8::Gemm g{i8o ? ws + WS_HQ : ws + WS_G, isA ? ws + WS_WAOUT + (size_t)j * DM * DM * (OUTA_I8 ? 1 : 2) : ws + WS_WBOUT + (size_t)j * DM * DM * 2, MTOK, DM, i8o ? DM : DM * 2};
            pg8::StaticOrder S; S.init(MTOK, DM, (int)gridDim.x, obid());
            pg8::Epi E{2, 0, nullptr, nullptr, nullptr, (const float*)(ws + WS_RS), (const float*)(ws + WS_CSO) + j * DM, layer == 0 ? P.x : P.out, P.out, (const float*)(ws + WS_MOD) + (size_t)layer * 4 * 6144 + 4096};
            {
                pg8::Unit u0; int ui = 0;
                while (S.next(ui, u0)) { const int t_ = otid(wv); const int w_ = __builtin_amdgcn_readfirstlane(t_ >> 6);
                    const float* xt = E.xin + (size_t)(u0.pm * 256 + (t_ >> 1)) * DM + u0.pn * 256 + (t_ & 1) * 128;
#pragma unroll
                    for (int q = 0; q < 4; ++q) __builtin_amdgcn_global_load_lds((const unsigned*)(xt + q * 32), (LAS unsigned*)(lds3 + 131072 + w_ * 1024 + q * 256), 4, 0, 0);
                    ++ui; } }
#if OUTA_I8
            if (isA) pg8::gemm_phase<pg8::Epi, pg8::StaticOrder, GEMM_ALIGN, GEMM_SP2, true>(lds3, g, S, E, wv);
            else
#endif
            pg8::gemm_phase<pg8::Epi, pg8::StaticOrder, GEMM_ALIGN, GEMM_SP2, false>(lds3, g, S, E, wv);
        }
        GSYNC();
    }
    final_norm_phase(wv);
}

extern "C" void kernel_launch(void* const* d_in, const int* in_sizes, int n_in, void* d_out, int out_size, void* d_ws, size_t ws_size, hipStream_t stream) {
    static int grid = 0;
    if (grid == 0) {
        if (n_in != 10 || in_sizes[0] != MTOK * DM || out_size != MTOK * DM || ws_size < WS_END) {
            fprintf(stderr, "kernel_launch: unexpected shapes/workspace (n_in %d, in0 %d, out %d, ws %zu, need %zu)\n", n_in, n_in > 0 ? in_sizes[0] : -1, out_size, ws_size, (size_t)WS_END); grid = -1; return; }
        int dev = 0, cus = 0, per_cu = 0;
        (void)hipGetDevice(&dev); (void)hipDeviceGetAttribute(&cus, hipDeviceAttributeMultiprocessorCount, dev);
        if (hipFuncSetAttribute((const void*)fwd_mega, hipFuncAttributeMaxDynamicSharedMemorySize, LDS_BYTES) != hipSuccess) { fprintf(stderr, "kernel_launch: hipFuncSetAttribute failed\n"); grid = -1; return; }
        if (hipOccupancyMaxActiveBlocksPerMultiprocessor(&per_cu, (const void*)fwd_mega, NTHREADS, LDS_BYTES) != hipSuccess || per_cu < 1) { fprintf(stderr, "kernel_launch: occupancy query says %d\n", per_cu); (void)hipGetLastError(); per_cu = 1; }
        if (per_cu > 1) per_cu = 1;
        grid = cus * per_cu;
    }
    if (grid < 0) return;
    (void)hipMemsetAsync((char*)d_ws + WS_CTL, 0, 16384, stream);
    Params p{};
    p.x = (const float*)d_in[0]; p.c = (const float*)d_in[1]; p.norm_w = (const float*)d_in[2]; p.mod_w = (const float*)d_in[3]; p.mod_b = (const float*)d_in[4];
    p.a_w_in = (const float*)d_in[5]; p.a_w_out = (const float*)d_in[6]; p.b_w_in = (const float*)d_in[7]; p.b_w_out = (const float*)d_in[8]; p.final_w = (const float*)d_in[9];
    p.out = (float*)d_out; p.ws = (unsigned char*)d_ws;
    void* args[] = {&p};
    hipError_t e = hipLaunchCooperativeKernel((const void*)fwd_mega, dim3(grid), dim3(NTHREADS), args, LDS_BYTES, stream);
    if (e != hipSuccess) fprintf(stderr, "kernel_launch: cooperative launch failed: %s (grid %d)\n", hipGetErrorString(e), grid);
}
```

```cpp
#include <hip/hip_runtime.h>
#include <hip/hip_cooperative_groups.h>
#include <cstdio>
#include <cstdint>
namespace cg = cooperative_groups;
#ifndef ATTN_A_FLASH
#define ATTN_A_FLASH 1
#endif
#ifndef GEMM_ALIGN
#define GEMM_ALIGN true
#endif
#ifndef GEMM_SP2
#define GEMM_SP2 true
#endif
#ifndef PROBE
#define PROBE 0
#endif
#ifndef MOBA_QK_I8
#define MOBA_QK_I8 1
#endif
#ifndef OUTA_I8
#define OUTA_I8 0
#endif
#ifndef GCLIP
#define GCLIP 1.0e9f
#endif
#ifndef STAGGER_TICKS
#define STAGGER_TICKS 0
#endif
#ifndef USE_CG_SYNC
#define USE_CG_SYNC 0
#endif
#ifndef ATTN_PIPE
#define ATTN_PIPE 1
#endif
#ifndef EPI_SC1
#define EPI_SC1 1
#endif
#ifndef FUSE_COMBINE
#define FUSE_COMBINE 1
#endif
#ifndef ATTN_DMA
#define ATTN_DMA 1
#endif
#ifndef ATTN_HS
#define ATTN_HS 0
#endif
#ifndef ATTN_B_FLASH
#define ATTN_B_FLASH 1
#endif

#define LAS __attribute__((address_space(3)))
typedef unsigned short bf16_t;
typedef short bf16x8 __attribute__((ext_vector_type(8)));
typedef short s16x4 __attribute__((ext_vector_type(4)));
typedef float f32x4 __attribute__((ext_vector_type(4)));
typedef float f32x16 __attribute__((ext_vector_type(16)));
typedef unsigned u32x4 __attribute__((ext_vector_type(4)));
typedef unsigned u32x2 __attribute__((ext_vector_type(2)));
typedef int i32x4 __attribute__((ext_vector_type(4)));

constexpr int NB = 4, SEQ = 2048, DM = 2048, MTOK = NB * SEQ, NH = 16, HD = 128, DEPTH = 4;
constexpr int A_N = 10 * DM, B_N = 4 * DM;
constexpr float EPS = 1e-6f;
constexpr float LOG2E = 1.4426950408889634f;
constexpr float C2Q = 0.08838834764831845f * LOG2E;

constexpr size_t MiB = 1u << 20;
constexpr size_t WS_CTL = 0;
constexpr size_t WS_MOD = 1 * MiB;
constexpr size_t WS_KSUM = 2 * MiB;
constexpr size_t WS_LSE = 3 * MiB;
constexpr size_t WS_RS = 5 * MiB;
constexpr size_t WS_CSA = 6 * MiB;
constexpr size_t WS_CSB = 7 * MiB;
constexpr size_t WS_CSO = 7 * MiB + 512 * 1024;
constexpr size_t WS_WAIN = 8 * MiB;
constexpr size_t WS_WBQK = WS_WAIN + 80 * MiB;
constexpr size_t WS_WBVZ = WS_WBQK + 32 * MiB;
constexpr size_t WS_WAOUT = WS_WBVZ + 16 * MiB;
constexpr size_t WS_WBOUT = WS_WAOUT + 16 * MiB;
constexpr size_t WS_H = WS_WBOUT + 16 * MiB;
constexpr size_t WS_HQ = WS_H + 32 * MiB;
constexpr size_t WS_G = WS_HQ + 16 * MiB;
constexpr size_t WS_QKV = WS_G + 32 * MiB;
constexpr size_t WS_Z = WS_QKV + 288 * MiB;
constexpr size_t WS_OG = WS_Z + 32 * MiB;
constexpr size_t WS_END = WS_OG + 96 * MiB;
constexpr size_t PART = (size_t)MTOK * DM;

constexpr int LDS_BYTES = 147456;
constexpr int NTHREADS = 512;

typedef float f32x2_t __attribute__((ext_vector_type(2))); typedef __bf16 bf16x2_t __attribute__((ext_vector_type(2)));
__device__ __forceinline__ unsigned cvt_pk_bf16(float lo, float hi) { f32x2_t v = {lo, hi}; bf16x2_t b = __builtin_convertvector(v, bf16x2_t); return __builtin_bit_cast(unsigned, b); }
__device__ __forceinline__ float bf2f(unsigned short v) { return __uint_as_float(((unsigned)v) << 16); }
__device__ __forceinline__ float bflo(unsigned w) { return __uint_as_float(w << 16); }
__device__ __forceinline__ float bfhi(unsigned w) { return __uint_as_float(w & 0xffff0000u); }
__device__ __forceinline__ float wave_sum(float v) {
#pragma unroll
    for (int o = 1; o < 64; o <<= 1) v += __shfl_xor(v, o);
    return v;
}
__device__ __forceinline__ float wave_max(float v) {
#pragma unroll
    for (int o = 1; o < 64; o <<= 1) v = fmaxf(v, __shfl_xor(v, o));
    return v;
}
__device__ __forceinline__ float silu_f(float v) { return v * __builtin_amdgcn_rcpf(1.f + __builtin_amdgcn_exp2f(-1.4426950408889634f * v)); }
#define LDS_WAIT() asm volatile("s_waitcnt lgkmcnt(0)" ::: "memory")
template <class V> __device__ __forceinline__ void store_wt(void* p, V v) { static_assert(sizeof(V) == 16, "16-byte vectors only");
    asm volatile("global_store_dwordx4 %0, %1, off sc0 sc1\n\ts_nop 1" :: "v"(p), "v"(v) : "memory"); }
__device__ __forceinline__ int otid(int wv) { int l; asm volatile("v_mbcnt_lo_u32_b32 %0, -1, 0\n\tv_mbcnt_hi_u32_b32 %0, -1, %0" : "=v"(l)); return (wv << 6) | l; }
template <class T> __device__ __forceinline__ T* optr(T* p) { asm volatile("" : "+s"(p)); return p; }
__device__ __forceinline__ int obid() { int b = blockIdx.x; asm volatile("" : "+s"(b)); return b; }

namespace pg8 {
constexpr int BM = 256, BK = 64, HALF = 128, HTB = HALF * BK * 2, STAGE_BYTES = 8 * HTB, NXCD = 8, WGM = 4;
__host__ __device__ __forceinline__ int lds_byte(int r, int c) { const int st = (r >> 4) * 2 + (c >> 5), rr = r & 15, cc = c & 31, ob = rr * 64 + cc * 2; return st * 1024 + (ob ^ (((ob >> 9) & 1) << 5)); }
__host__ __device__ __forceinline__ void stage_rc(int b, int& R, int& C) { const int st = b / 1024, sb = b % 1024, swz = sb ^ (((sb >> 9) & 1) << 5); R = (st >> 1) * 16 + swz / 64; C = (st & 1) * 32 + (swz % 64) / 2; }
__host__ __device__ __forceinline__ int perm32(int rho) { const int n = rho >> 4, i = rho & 15; return 8 * (i >> 2) + 4 * n + (i & 3); }
struct Unit { int pm, pn; };
struct Gemm { const void* A; const void* Bt; int M, N, KB; };
struct StaticOrder {
    int nM, nN, nwg, G, c;
    __host__ __device__ void init(int M, int N, int G_, int c_) { nM = M / BM; nN = N / BM; nwg = nM * nN; G = G_; c = c_; }
    __host__ __device__ bool next(int i, Unit& u) const {
        const long L = (long)i * G + c; if (L >= nwg) return false;
        int wgid = (int)L; { const int q = nwg / NXCD, r = nwg % NXCD, xcd = wgid % NXCD, off = wgid / NXCD; wgid = (xcd < r ? xcd * (q + 1) : r * (q + 1) + (xcd - r) * q) + off; }
        const int nig = WGM * nN, gid = wgid / nig, fm = gid * WGM, gsz = (nM - fm) < WGM ? (nM - fm) : WGM;
        u.pm = fm + ((wgid % nig) % gsz); u.pn = (wgid % nig) / gsz; return true;
    }
    __device__ __forceinline__ void a_ready(const Unit&) const {}
    __device__ __forceinline__ void done(const Unit&) const {}
};

__device__ __forceinline__ f32x4 acc_f32(const f32x4& a) { return a; }
__device__ __forceinline__ f32x4 acc_f32(const i32x4& a) { return (f32x4){(float)a.x, (float)a.y, (float)a.z, (float)a.w}; }
struct Epi {
    static constexpr bool PERM = true, AFTER_DRAIN = false;
    int mode;
    int pbase;
    bf16_t* qkv; bf16_t* zbuf; float* ksum;
    const float* rs; const float* cs;
    const float* xin; float* xout; const float* gate;
    template <class AccT>
    __device__ __forceinline__ void operator()(const AccT (&acc)[2][2][4][2], const Unit& u, int wr, int wc, int fr, int fq) const {
        constexpr bool I8 = sizeof(AccT) == sizeof(i32x4) && !__is_same(AccT, f32x4);
        if (mode == 3) {
#pragma unroll
            for (int ai = 0; ai < 2; ++ai)
#pragma unroll
                for (int bj = 0; bj < 2; ++bj)
#pragma unroll
                    for (int m = 0; m < 4; ++m)
#pragma unroll
                        for (int n = 0; n < 2; ++n) asm volatile("" :: "v"(acc[ai][bj][m][n]));
            return; }
        if (mode == 2) {
            const int col0 = u.pn * BM + wc * 64 + 8 * fq; const int b = (u.pm * BM) >> 11;
            f32x4 gv[2][2];
#pragma unroll
            for (int bj = 0; bj < 2; ++bj)
#pragma unroll
                for (int n = 0; n < 2; ++n) { gv[bj][n] = *(const f32x4*)(gate + b * 6144 + col0 + bj * 32 + 4 * n); if (I8) gv[bj][n] = gv[bj][n] * *(const f32x4*)(cs + col0 + bj * 32 + 4 * n); }
#pragma unroll
            for (int ai = 0; ai < 2; ++ai) {
                f32x4 xv[4][2][2]; float rsv[4];
#pragma unroll
                for (int m = 0; m < 4; ++m) { const int row = u.pm * BM + ai * HALF + wr * 64 + m * 16 + fr; const size_t off = (size_t)row * DM + col0; rsv[m] = I8 ? rs[row] : 1.f;
#pragma unroll
                    for (int bj = 0; bj < 2; ++bj)
#pragma unroll
                        for (int n = 0; n < 2; ++n) xv[m][bj][n] = *(const f32x4*)(xin + off + bj * 32 + 4 * n); }
                asm volatile("" ::: "memory");
#pragma unroll
                for (int m = 0; m < 4; ++m) { const size_t off = (size_t)(u.pm * BM + ai * HALF + wr * 64 + m * 16 + fr) * DM + col0;
#pragma unroll
                    for (int bj = 0; bj < 2; ++bj)
#pragma unroll
                        for (int n = 0; n < 2; ++n) *(f32x4*)(xout + off + bj * 32 + 4 * n) = xv[m][bj][n] + gv[bj][n] * (acc_f32(acc[ai][bj][m][n]) * rsv[m]); }
                asm volatile("" ::: "memory"); }
            return;
        }
        const int p = pbase + (u.pn >> 3), colt = (u.pn & 7) * BM;
        int lg = 0; float sc = 1.f; bf16_t* base;
        const bool pr_nostore = mode == 4, pr_window = mode == 5, pr_pitch = mode >= 6;
        const int ldo = mode == 6 ? 2112 : DM;
        if (mode == 0 || mode >= 4) { if (p == 9) base = zbuf; else { const int g = p / 3, kind = p - 3 * g; lg = 2 * g; base = qkv + (size_t)p * PART; if (kind == 0) sc = C2Q; } }
        else { if (p == 3) base = zbuf; else { base = qkv + (size_t)p * PART; if (p == 0) sc = C2Q; } }
        const int col0 = colt + wc * 64 + 8 * fq;
        f32x4 cv[2][2];
        if (I8) {
#pragma unroll
            for (int bj = 0; bj < 2; ++bj)
#pragma unroll
                for (int n = 0; n < 2; ++n) cv[bj][n] = *(const f32x4*)(cs + u.pn * BM + wc * 64 + 8 * fq + bj * 32 + 4 * n) * sc;
        }
        float rsa[2][4];
#pragma unroll
        for (int ai = 0; ai < 2; ++ai)
#pragma unroll
            for (int m = 0; m < 4; ++m) rsa[ai][m] = I8 ? rs[u.pm * BM + ai * HALF + wr * 64 + m * 16 + fr] : sc;
#pragma unroll
        for (int ai = 0; ai < 2; ++ai)
#pragma unroll
            for (int m = 0; m < 4; ++m) {
                const int row = u.pm * BM + ai * HALF + wr * 64 + m * 16 + fr, b = row >> 11, t = row & 2047;
                const int R = (b << 11) + ((t & ((1 << lg) - 1)) << (11 - lg)) + (t >> lg);
                bf16_t* rowp = pr_pitch ? (qkv + (size_t)(p % 3) * 4096 * 2112 + (size_t)(R & 4095) * ldo + col0) : (base + (size_t)(pr_window ? (R & 255) : R) * DM + col0);
                const float rsv = rsa[ai][m];
#pragma unroll
                for (int bj = 0; bj < 2; ++bj) { f32x4 v0 = acc_f32(acc[ai][bj][m][0]) * rsv, v1 = acc_f32(acc[ai][bj][m][1]) * rsv;
                    if (I8) { v0 = v0 * cv[bj][0]; v1 = v1 * cv[bj][1]; }
                    u32x4 w; w.x = cvt_pk_bf16(v0[0], v0[1]); w.y = cvt_pk_bf16(v0[2], v0[3]); w.z = cvt_pk_bf16(v1[0], v1[1]); w.w = cvt_pk_bf16(v1[2], v1[3]);
                    if (pr_nostore) asm volatile("" :: "v"(w));
                    else {
#if EPI_SC1
                        asm volatile("global_store_dwordx4 %0, %1, off sc0 sc1\n\ts_nop 1" :: "v"(rowp + bj * 32), "v"(w) : "memory");
#else
                        *(u32x4*)(rowp + bj * 32) = w;
#endif
                    } } }
        if (mode == 1 && p == 1) {
#pragma unroll
            for (int bj = 0; bj < 2; ++bj)
#pragma unroll
                for (int n = 0; n < 2; ++n) { f32x4 s = {0.f, 0.f, 0.f, 0.f};
#pragma unroll
                    for (int ai = 0; ai < 2; ++ai)
#pragma unroll
                        for (int m = 0; m < 4; ++m) s += acc_f32(acc[ai][bj][m][n]) * (I8 ? rsa[ai][m] : 1.f);
                    if (I8) s = s * cv[bj][n];
#pragma unroll
                    for (int j = 0; j < 4; ++j) { float v = s[j]; v += __shfl_xor(v, 1); v += __shfl_xor(v, 2); v += __shfl_xor(v, 4); v += __shfl_xor(v, 8); s[j] = v; }
                    if (fr == 0) *(f32x4*)(ksum + ((size_t)(wr * 32 + u.pm) * DM + colt + bj * 32 + wc * 64 + 8 * fq + 4 * n)) = s; }
        }
    }
};

template <bool I8> struct AccSel { typedef f32x4 type; };
template <> struct AccSel<true> { typedef i32x4 type; };
template <bool I8> __device__ __forceinline__ typename AccSel<I8>::type mma1(bf16x8 b, bf16x8 a, typename AccSel<I8>::type c) {
    if constexpr (I8) return __builtin_amdgcn_mfma_i32_16x16x64_i8(__builtin_bit_cast(i32x4, b), __builtin_bit_cast(i32x4, a), c, 0, 0, 0);
    else return __builtin_amdgcn_mfma_f32_16x16x32_bf16(b, a, c, 0, 0, 0);
}
template <class Epi, class Sched, bool ALIGN_EPI = false, bool SP2 = false, bool I8 = false>
__device__ __forceinline__ void gemm_phase(LAS unsigned char* lds, const Gemm g, const Sched& S, const Epi& E, int wv) {
    const int tid = otid(wv), wid = __builtin_amdgcn_readfirstlane(tid >> 6), lane = tid & 63, wr = wid >> 2, wc = wid & 3, fr = lane & 15, fq = lane >> 4;
    const int KBY = g.KB, nt = KBY / (BK * 2);
    unsigned voffA[2], voffB[2];
#pragma unroll
    for (int i = 0; i < 2; ++i) { int R, C; stage_rc(tid * 16 + i * 8192, R, C); const int Rb = Epi::PERM ? ((R & ~31) + perm32(R & 31)) : R;
        voffA[i] = (unsigned)(R * KBY + C * 2); voffB[i] = (unsigned)((Epi::PERM ? ((R >> 5) * 64 + perm32(R & 31)) : Rb) * KBY + C * 2); }
    const size_t kstep = (size_t)(BK * 2);
    const size_t hstep = (size_t)HALF * KBY;
    const size_t hstepB = Epi::PERM ? (size_t)32 * KBY : hstep;
    const size_t tstep = 2 * hstep;
    const unsigned ldsw = (unsigned)wid * 1024u;
    const int aoff = lds_byte(wr * 64 + fr, fq * 8), boff = lds_byte(wc * 32 + fr, fq * 8);
#define PG8_SA(b, h) (((b) * 2 + (h)) * HTB)
#define PG8_SB(b, h) ((4 + (b) * 2 + (h)) * HTB)
#define PG8_STAGE(bufoff, gbase, voff) do { _Pragma("unroll") for (int _i = 0; _i < 2; ++_i) \
        __builtin_amdgcn_global_load_lds((const unsigned*)((const char*)(gbase) + (voff)[_i]), (LAS unsigned*)(lds + (bufoff) + ldsw + _i * 8192), 16, 0, 0); } while (0)
#define PG8_LDA(dst, b, h) do { _Pragma("unroll") for (int m = 0; m < 4; ++m) _Pragma("unroll") for (int k = 0; k < 2; ++k) dst[m][k] = *(const LAS bf16x8*)(lds + PG8_SA(b, h) + aoff + m * 2048 + k * 1024); } while (0)
#define PG8_LDB(dst, b, h) do { _Pragma("unroll") for (int n = 0; n < 2; ++n) _Pragma("unroll") for (int k = 0; k < 2; ++k) dst[n][k] = *(const LAS bf16x8*)(lds + PG8_SB(b, h) + boff + n * 2048 + k * 1024); } while (0)
#define PG8_MMA(ai, bj, At, Bt) do { __builtin_amdgcn_s_setprio(1); _Pragma("unroll") for (int m = 0; m < 4; ++m) _Pragma("unroll") for (int n = 0; n < 2; ++n) _Pragma("unroll") for (int k = 0; k < 2; ++k) \
        acc[ai][bj][m][n] = mma1<I8>(Bt[n][k], At[m][k], acc[ai][bj][m][n]); __builtin_amdgcn_s_setprio(0); } while (0)
#define PG8_WAIT_V(n) asm volatile("s_waitcnt vmcnt(" #n ")" ::: "memory")
#define PG8_WAIT_L(n) asm volatile("s_waitcnt lgkmcnt(" #n ")" ::: "memory")
#define PG8_BAR __builtin_amdgcn_s_barrier()
#define PG8_SCHED __builtin_amdgcn_sched_barrier(0)
    Unit cur, nxt; int ui = 0;
    if (!S.next(0, cur)) return;
    typedef typename AccSel<I8>::type acc_t;
    acc_t acc[2][2][4][2];
#pragma unroll
    for (int a = 0; a < 2; ++a)
#pragma unroll
        for (int b = 0; b < 2; ++b)
#pragma unroll
            for (int m = 0; m < 4; ++m)
#pragma unroll
                for (int n = 0; n < 2; ++n) acc[a][b][m][n] = acc_t{};
    bf16x8 At[4][2], B0[2][2], B1[2][2];
    const char* cA = (const char*)g.A + (size_t)cur.pm * tstep; const char* cB = (const char*)g.Bt + (size_t)cur.pn * tstep;
    S.a_ready(cur);
    if constexpr (SP2) {
        PG8_STAGE(PG8_SB(0, 0), cB, voffB); PG8_STAGE(PG8_SB(0, 1), cB + hstepB, voffB); PG8_STAGE(PG8_SA(0, 0), cA, voffA); PG8_STAGE(PG8_SA(0, 1), cA + hstep, voffA);
        if (wr == 1) PG8_BAR;
        PG8_WAIT_V(2); PG8_BAR;
        PG8_STAGE(PG8_SB(1, 0), cB + kstep, voffB); PG8_STAGE(PG8_SA(1, 0), cA + kstep, voffA); PG8_STAGE(PG8_SB(1, 1), cB + hstepB + kstep, voffB);
        PG8_WAIT_V(6); PG8_BAR;
    } else {
        PG8_STAGE(PG8_SB(0, 0), cB, voffB); PG8_STAGE(PG8_SA(0, 0), cA, voffA); PG8_STAGE(PG8_SB(0, 1), cB + hstepB, voffB); PG8_STAGE(PG8_SA(0, 1), cA + hstep, voffA);
        if (wr == 1) PG8_BAR;
        PG8_WAIT_V(4); PG8_BAR;
        PG8_STAGE(PG8_SB(1, 0), cB + kstep, voffB); PG8_STAGE(PG8_SA(1, 0), cA + kstep, voffA); PG8_STAGE(PG8_SB(1, 1), cB + hstepB + kstep, voffB);
        PG8_WAIT_V(6); PG8_BAR;
    }
    for (;;) {
        const bool has_next = S.next(ui + 1, nxt);
        const char* nA = has_next ? (const char*)g.A + (size_t)nxt.pm * tstep : cA; const char* nB = has_next ? (const char*)g.Bt + (size_t)nxt.pn * tstep : cB;
        for (int t = 0; t < nt; t += 2) {
            const bool last = (t == nt - 2);
            const char* a1 = cA + (size_t)(t + 1) * kstep;
            const char* a2 = last ? nA : cA + (size_t)(t + 2) * kstep; const char* b2 = last ? nB : cB + (size_t)(t + 2) * kstep;
            const char* a3 = a2 + kstep; const char* b3 = b2 + kstep;
            if (last && has_next) S.a_ready(nxt);
            if constexpr (SP2) {
            PG8_LDB(B0, 0, 0); PG8_LDB(B1, 0, 1); PG8_SCHED; PG8_LDA(At, 0, 0); PG8_STAGE(PG8_SA(1, 1), a1 + hstep, voffA);
            PG8_WAIT_V(8); PG8_WAIT_L(0); PG8_BAR; PG8_MMA(0, 0, At, B0); PG8_MMA(0, 1, At, B1); PG8_BAR; PG8_SCHED;
            PG8_LDA(At, 0, 1); PG8_STAGE(PG8_SB(0, 0), b2, voffB); PG8_STAGE(PG8_SB(0, 1), b2 + hstepB, voffB); PG8_STAGE(PG8_SA(0, 0), a2, voffA);
            PG8_WAIT_V(8); PG8_WAIT_L(0); PG8_BAR; PG8_MMA(1, 0, At, B0); PG8_MMA(1, 1, At, B1); PG8_BAR; PG8_SCHED;
            PG8_LDB(B0, 1, 0); PG8_LDB(B1, 1, 1); PG8_SCHED; PG8_LDA(At, 1, 0); PG8_STAGE(PG8_SA(0, 1), a2 + hstep, voffA);
            PG8_WAIT_V(8); PG8_WAIT_L(0); PG8_BAR; PG8_MMA(0, 0, At, B0); PG8_MMA(0, 1, At, B1); PG8_BAR; PG8_SCHED;
            PG8_LDA(At, 1, 1); PG8_STAGE(PG8_SB(1, 0), b3, voffB); PG8_STAGE(PG8_SB(1, 1), b3 + hstepB, voffB); PG8_STAGE(PG8_SA(1, 0), a3, voffA);
            PG8_WAIT_V(8); PG8_WAIT_L(0); PG8_BAR; PG8_MMA(1, 0, At, B0); PG8_MMA(1, 1, At, B1); PG8_BAR; PG8_SCHED;
            } else {
            PG8_LDB(B0, 0, 0); PG8_SCHED; PG8_LDA(At, 0, 0); PG8_STAGE(PG8_SA(1, 1), a1 + hstep, voffA);
            PG8_WAIT_L(8); PG8_BAR; PG8_WAIT_L(0); PG8_MMA(0, 0, At, B0); PG8_BAR; PG8_SCHED;
            PG8_LDB(B1, 0, 1); PG8_STAGE(PG8_SB(0, 0), b2, voffB);
            PG8_BAR; PG8_WAIT_L(0); PG8_MMA(0, 1, At, B1); PG8_BAR;
            PG8_LDA(At, 0, 1); PG8_STAGE(PG8_SA(0, 0), a2, voffA);
            PG8_BAR; PG8_WAIT_L(0); PG8_MMA(1, 0, At, B0); PG8_BAR; PG8_SCHED;
            PG8_STAGE(PG8_SB(0, 1), b2 + hstepB, voffB);
            PG8_WAIT_V(6); PG8_BAR; PG8_MMA(1, 1, At, B1); PG8_BAR;
            PG8_LDB(B0, 1, 0); PG8_SCHED; PG8_LDA(At, 1, 0); PG8_STAGE(PG8_SA(0, 1), a2 + hstep, voffA);
            PG8_WAIT_L(8); PG8_BAR; PG8_WAIT_L(0); PG8_MMA(0, 0, At, B0); PG8_BAR; PG8_SCHED;
            PG8_LDB(B1, 1, 1); PG8_STAGE(PG8_SB(1, 0), b3, voffB);
            PG8_BAR; PG8_WAIT_L(0); PG8_MMA(0, 1, At, B1); PG8_BAR;
            PG8_LDA(At, 1, 1); PG8_STAGE(PG8_SA(1, 0), a3, voffA);
            PG8_BAR; PG8_WAIT_L(0); PG8_MMA(1, 0, At, B0); PG8_BAR; PG8_SCHED;
            PG8_STAGE(PG8_SB(1, 1), b3 + hstepB, voffB);
            PG8_WAIT_V(6); PG8_BAR; PG8_MMA(1, 1, At, B1); PG8_BAR;
            }
        }
        if constexpr (ALIGN_EPI) { if (wr == 0) PG8_BAR; }
        if constexpr (!Epi::AFTER_DRAIN) { E(acc, cur, wr, wc, fr, fq); S.done(cur); }
        if (!has_next) break;
#pragma unroll
        for (int a = 0; a < 2; ++a)
#pragma unroll
            for (int b = 0; b < 2; ++b)
#pragma unroll
                for (int m = 0; m < 4; ++m)
#pragma unroll
                    for (int n = 0; n < 2; ++n) acc[a][b][m][n] = acc_t{};
        cur = nxt; cA = nA; cB = nB; ++ui;
        if constexpr (ALIGN_EPI) { if (wr == 1) PG8_BAR; }
    }
    PG8_WAIT_V(0);
    if constexpr (!ALIGN_EPI) { if (wr == 0) PG8_BAR; }
    PG8_BAR;
#undef PG8_SA
#undef PG8_SB
#undef PG8_STAGE
#undef PG8_LDA
#undef PG8_LDB
#undef PG8_MMA
#undef PG8_WAIT_V
#undef PG8_WAIT_L
#undef PG8_BAR
#undef PG8_SCHED
}
}

struct Params {
    const float *x, *c, *norm_w, *mod_w, *mod_b, *a_w_in, *a_w_out, *b_w_in, *b_w_out, *final_w;
    float* out; unsigned char* ws;
};

typedef const __attribute__((address_space(4))) Params CParams;
__device__ __forceinline__ CParams& PP() { CParams* p = (CParams*)__builtin_amdgcn_kernarg_segment_ptr(); asm volatile("" : "+s"(p)); return *p; }

__device__ __forceinline__ void p0_mod(unsigned char* lds, int wv) {
    CParams& P = PP();
    const int tid = otid(wv);
    f32x4* condT = (f32x4*)lds;
    float* red = (float*)(lds + 32768);
    float* MOD = (float*)(P.ws + WS_MOD);
    bool have = false;
    for (int item = obid(); item < 768; item += gridDim.x) {
        if (!have) { have = true;
            for (int k = tid; k < DM; k += NTHREADS) { f32x4 v; v.x = silu_f(P.c[k]); v.y = silu_f(P.c[DM + k]); v.z = silu_f(P.c[2 * DM + k]); v.w = silu_f(P.c[3 * DM + k]); condT[k] = v; }
            __syncthreads(); }
        const int l = item / 192, n0 = (item % 192) * 32, cq = tid & 7, kp = tid >> 3;
        f32x4 a0 = {0.f, 0.f, 0.f, 0.f}, a1 = a0, a2 = a0, a3 = a0;
        const float* wp = P.mod_w + ((size_t)l * DM + kp * 32) * 6144 + n0 + 4 * cq;
#pragma unroll 16
        for (int k = 0; k < 32; ++k) { const f32x4 w = *(const f32x4*)(wp + (size_t)k * 6144); const f32x4 cv = condT[kp * 32 + k];
            a0 += w * cv.x; a1 += w * cv.y; a2 += w * cv.z; a3 += w * cv.w; }
        *(f32x4*)(red + (kp * 4 + 0) * 32 + 4 * cq) = a0; *(f32x4*)(red + (kp * 4 + 1) * 32 + 4 * cq) = a1;
        *(f32x4*)(red + (kp * 4 + 2) * 32 + 4 * cq) = a2; *(f32x4*)(red + (kp * 4 + 3) * 32 + 4 * cq) = a3;
        __syncthreads();
        if (tid < 128) { const int b = tid >> 5, col = tid & 31; float s = P.mod_b[l * 6144 + n0 + col];
#pragma unroll 8
            for (int q = 0; q < 64; ++q) s += red[(q * 4 + b) * 32 + col];
            MOD[(l * 4 + b) * 6144 + n0 + col] = s; }
        __syncthreads();
    }
}
__device__ __forceinline__ void p0_transpose_item(const float* W, int ldn, int ncol0, int nblk, bf16_t* WT, unsigned char* scr, int item, int lane) {
    const int kb = item / nblk, nb = item - kb * nblk, k0 = kb * 64, n0 = nb * 64;
    const float* src = W + (size_t)(k0 + (lane >> 4)) * ldn + ncol0 + n0 + 4 * (lane & 15);
#pragma unroll 4
    for (int i = 0; i < 16; ++i) { const f32x4 v = *(const f32x4*)(src + (size_t)(4 * i) * ldn);
        unsigned* d = (unsigned*)(scr + (4 * i + (lane >> 4)) * 132 + 8 * (lane & 15));
        d[0] = cvt_pk_bf16(v.x, v.y); d[1] = cvt_pk_bf16(v.z, v.w); }
    LDS_WAIT();
    const int c = lane & 7;
#pragma unroll
    for (int j = 0; j < 8; ++j) { const int n = (lane >> 3) + 8 * j; const unsigned short* s = (const unsigned short*)(scr + (8 * c) * 132 + 2 * n);
        u32x4 o;
        o.x = (unsigned)s[0 * 66] | ((unsigned)s[1 * 66] << 16); o.y = (unsigned)s[2 * 66] | ((unsigned)s[3 * 66] << 16);
        o.z = (unsigned)s[4 * 66] | ((unsigned)s[5 * 66] << 16); o.w = (unsigned)s[6 * 66] | ((unsigned)s[7 * 66] << 16);
        *(u32x4*)(WT + (size_t)(n0 + n) * DM + k0 + 8 * c) = o; }
    LDS_WAIT();
}
__device__ __forceinline__ void p0_panel_i8(const float* W, int ldn, int n0, signed char* WT, float* cs, unsigned char* lds, int tid) {
    const int lane = tid & 63, wave = __builtin_amdgcn_readfirstlane(tid >> 6);
    float* maxbuf = (float*)(lds + 131072);
    f32x4 mx = {0.f, 0.f, 0.f, 0.f};
    { const float* src = W + (size_t)(wave * 256 + (lane >> 3)) * ldn + n0 + 4 * (lane & 7);
      unsigned char* dst = lds + (size_t)(wave * 256 + (lane >> 3)) * 64 + 8 * (lane & 7);
#pragma unroll 16
      for (int i = 0; i < 32; ++i) { const f32x4 v = *(const f32x4*)(src + (size_t)(8 * i) * ldn);
          mx.x = fmaxf(mx.x, fabsf(v.x)); mx.y = fmaxf(mx.y, fabsf(v.y)); mx.z = fmaxf(mx.z, fabsf(v.z)); mx.w = fmaxf(mx.w, fabsf(v.w));
          u32x2 w; w.x = cvt_pk_bf16(v.x, v.y); w.y = cvt_pk_bf16(v.z, v.w); *(u32x2*)(dst + (size_t)(8 * i) * 64) = w; } }
#pragma unroll
    for (int o = 8; o < 64; o <<= 1) { mx.x = fmaxf(mx.x, __shfl_xor(mx.x, o)); mx.y = fmaxf(mx.y, __shfl_xor(mx.y, o)); mx.z = fmaxf(mx.z, __shfl_xor(mx.z, o)); mx.w = fmaxf(mx.w, __shfl_xor(mx.w, o)); }
    if (lane < 8) *(f32x4*)(maxbuf + wave * 32 + 4 * lane) = mx;
    __syncthreads();
    { const int n = tid & 31, kc = tid >> 5;
      float cm = maxbuf[n];
#pragma unroll
      for (int w = 1; w < 8; ++w) cm = fmaxf(cm, maxbuf[w * 32 + n]);
      const float inv = cm > 0.f ? 127.f / cm : 0.f;
      if (kc == 0) cs[n0 + n] = cm > 0.f ? cm * (1.f / 127.f) : 1.f;
      const unsigned short* t = (const unsigned short*)lds + (size_t)(kc * 128) * 32 + n;
      signed char* orow = WT + (size_t)(n0 + n) * DM + kc * 128;
#pragma unroll 2
      for (int i = 0; i < 8; ++i) { unsigned w[4];
#pragma unroll
          for (int q = 0; q < 4; ++q) { unsigned acc = 0;
#pragma unroll
              for (int e = 0; e < 4; ++e) { const float v = bf2f(t[(size_t)(16 * i + 4 * q + e) * 32]) * inv; int iv = (int)rintf(v); iv = iv > 127 ? 127 : (iv < -127 ? -127 : iv); acc |= ((unsigned)iv & 0xffu) << (8 * e); }
              w[q] = acc; }
          *(u32x4*)(orow + 16 * i) = (u32x4){w[0], w[1], w[2], w[3]}; } }
    __syncthreads();
}
__device__ __forceinline__ void p0_weights(unsigned char* lds, int wv) {
    CParams& P = PP();
    const int tid_ = otid(wv); const int lane = tid_ & 63, wave = __builtin_amdgcn_readfirstlane(tid_ >> 6);
    constexpr int PA = A_N / 32, PB = (MOBA_QK_I8 ? B_N : 4096) / 32, PO = DM / 32, NPANEL = 2 * PA + 2 * PB + (OUTA_I8 ? 2 * PO : 0);
    for (int it = obid(); it < NPANEL; it += gridDim.x) {
        if (it < 2 * PA) { const int j = it / PA, pnl = it - j * PA;
            p0_panel_i8(P.a_w_in + (size_t)j * DM * A_N, A_N, pnl * 32, (signed char*)(P.ws + WS_WAIN) + (size_t)j * A_N * DM, (float*)(P.ws + WS_CSA) + j * A_N, lds, tid_); }
        else if (it < 2 * PA + 2 * PB) { const int r = it - 2 * PA, j = r / PB, pnl = r - j * PB;
#if MOBA_QK_I8
            p0_panel_i8(P.b_w_in + (size_t)j * DM * B_N, B_N, pnl * 32, (signed char*)(P.ws + WS_WBQK) + (size_t)j * B_N * DM, (float*)(P.ws + WS_CSB) + j * B_N, lds, tid_); }
#else
            p0_panel_i8(P.b_w_in + (size_t)j * DM * B_N + 4096, B_N, pnl * 32, (signed char*)(P.ws + WS_WBVZ) + (size_t)j * 4096 * DM, (float*)(P.ws + WS_CSB) + j * 4096, lds, tid_); }
#endif
#if OUTA_I8
        else { const int r = it - 2 * PA - 2 * PB, j = r / PO, pnl = r - j * PO;
            p0_panel_i8(P.a_w_out + (size_t)j * DM * DM, DM, pnl * 32, (signed char*)(P.ws + WS_WAOUT) + (size_t)j * DM * DM, (float*)(P.ws + WS_CSO) + j * DM, lds, tid_); }
#endif
    }
    unsigned char* scr = lds + 65536 + wave * 8448;
    const int gw = obid() * 8 + wave, NGW = gridDim.x * 8;
    constexpr int I_B = MOBA_QK_I8 ? 0 : 32 * 64, I_O = 32 * 32, I_AO = OUTA_I8 ? 0 : 32 * 32, TOTAL = 2 * I_B + 2 * I_AO + 2 * I_O;
    for (int it = gw; it < TOTAL; it += NGW) {
        int r = it;
        if (I_B > 0 && r < 2 * I_B) { const int j = r / (I_B > 0 ? I_B : 1); p0_transpose_item(P.b_w_in + (size_t)j * DM * B_N, B_N, 0, 64, (bf16_t*)(P.ws + WS_WBQK) + (size_t)j * 4096 * DM, scr, r - j * I_B, lane); continue; } r -= 2 * I_B;
        if (I_AO > 0 && r < 2 * I_AO) { const int j = r / (I_AO > 0 ? I_AO : 1); p0_transpose_item(P.a_w_out + (size_t)j * DM * DM, DM, 0, 32, (bf16_t*)(P.ws + WS_WAOUT) + (size_t)j * DM * DM, scr, r - j * I_AO, lane); continue; } r -= 2 * I_AO;
        { const int j = r / I_O; p0_transpose_item(P.b_w_out + (size_t)j * DM * DM, DM, 0, 32, (bf16_t*)(P.ws + WS_WBOUT) + (size_t)j * DM * DM, scr, r - j * I_O, lane); }
    }
}

__device__ __forceinline__ void norm_phase(int layer, bool want_bf16, int wv) {
    CParams& P = PP(); const float* xin = layer == 0 ? P.x : P.out;
    const int tid_ = otid(wv); const int lane = tid_ & 63, wave = __builtin_amdgcn_readfirstlane(tid_ >> 6);
    const int gw = obid() * 8 + wave, NGW = gridDim.x * 8;
    const float* MOD = (const float*)(P.ws + WS_MOD);
    bf16_t* Hb = (bf16_t*)(P.ws + WS_H); unsigned char* Hq = P.ws + WS_HQ; float* RS = (float*)(P.ws + WS_RS);
    for (int r0 = gw * 4; r0 < MTOK; r0 += NGW * 4) {
        const int b = r0 >> 11;
        const float* shift = MOD + (size_t)(layer * 4 + b) * 6144; const float* scale = shift + DM; const float* nw = P.norm_w + layer * DM;
        f32x4 ca[8], cs[8];
#pragma unroll
        for (int j = 0; j < 8; ++j) { const int c = 4 * lane + 256 * j; const f32x4 w = *(const f32x4*)(nw + c), s = *(const f32x4*)(scale + c); ca[j] = w * (s + 1.f); cs[j] = *(const f32x4*)(shift + c); }
        for (int rr = 0; rr < 4; ++rr) {
            const float* xr = xin + (size_t)(r0 + rr) * DM; f32x4 v[8]; float ss = 0.f;
#pragma unroll
            for (int j = 0; j < 8; ++j) { v[j] = *(const f32x4*)(xr + 4 * lane + 256 * j); ss += (v[j].x * v[j].x + v[j].y * v[j].y) + (v[j].z * v[j].z + v[j].w * v[j].w); }
            const float rs = 1.0f / sqrtf(wave_sum(ss) * (1.f / DM) + EPS);
            float am = 0.f;
#pragma unroll
            for (int j = 0; j < 8; ++j) { v[j] = v[j] * rs * ca[j] + cs[j]; am = fmaxf(am, fmaxf(fmaxf(fabsf(v[j].x), fabsf(v[j].y)), fmaxf(fabsf(v[j].z), fabsf(v[j].w)))); }
            am = wave_max(am);
            const float inv = am > 0.f ? 127.f / am : 0.f;
            if (lane == 0) RS[r0 + rr] = am > 0.f ? am * (1.f / 127.f) : 1.f;
            unsigned char* qr = Hq + (size_t)(r0 + rr) * DM;
#pragma unroll
            for (int j = 0; j < 8; ++j) { const f32x4 h = v[j] * inv;
                const int i0 = (int)rintf(h.x), i1 = (int)rintf(h.y), i2 = (int)rintf(h.z), i3 = (int)rintf(h.w);
                *(unsigned*)(qr + 4 * lane + 256 * j) = ((unsigned)i0 & 0xffu) | (((unsigned)i1 & 0xffu) << 8) | (((unsigned)i2 & 0xffu) << 16) | (((unsigned)i3 & 0xffu) << 24); }
            if (want_bf16) { bf16_t* hr = Hb + (size_t)(r0 + rr) * DM;
#pragma unroll
                for (int j = 0; j < 8; ++j) { u32x2 w; w.x = cvt_pk_bf16(v[j].x, v[j].y); w.y = cvt_pk_bf16(v[j].z, v[j].w); *(u32x2*)(hr + 4 * lane + 256 * j) = w; } }
        }
    }
}
__device__ __forceinline__ void final_norm_phase(int wv) {
    CParams& P = PP();
    const int tid_ = otid(wv); const int lane = tid_ & 63, wave = __builtin_amdgcn_readfirstlane(tid_ >> 6);
    const int gw = obid() * 8 + wave, NGW = gridDim.x * 8;
    f32x4 cw[8];
#pragma unroll
    for (int j = 0; j < 8; ++j) cw[j] = *(const f32x4*)(P.final_w + 4 * lane + 256 * j);
    for (int r = gw; r < MTOK; r += NGW) {
        float* xr = P.out + (size_t)r * DM; f32x4 v[8]; float ss = 0.f;
#pragma unroll
        for (int j = 0; j < 8; ++j) { v[j] = *(const f32x4*)(xr + 4 * lane + 256 * j); ss += (v[j].x * v[j].x + v[j].y * v[j].y) + (v[j].z * v[j].z + v[j].w * v[j].w); }
        const float rs = 1.0f / sqrtf(wave_sum(ss) * (1.f / DM) + EPS);
#pragma unroll
        for (int j = 0; j < 8; ++j) *(f32x4*)(xr + 4 * lane + 256 * j) = v[j] * rs * cw[j];
    }
}

__device__ __forceinline__ void naive_attend(const bf16_t* Kh, const bf16_t* Vh, const float* qf, float* sc, int own_start, int own_len, int blkbase, int mask, int qpos, float slopeL, int lane,
                                             float& o0, float& o1, float& lse2) {
    int base = 0; float mx = -3.0e38f;
    { int m2 = mask;
      for (int rr = 0;; ++rr) { int start, len;
        if (rr == 0) { start = own_start; len = own_len; } else { if (!m2) break; const int j = __builtin_ctz(m2); m2 &= m2 - 1; start = blkbase + (j << 8); len = 256; }
        for (int i = lane; i < len; i += 64) { const int key = start + i; const u32x4* kp = (const u32x4*)(Kh + (size_t)key * DM); float dot = 0.f;
#pragma unroll 4
            for (int cch = 0; cch < 16; ++cch) { const u32x4 w = kp[cch]; const float* q = qf + cch * 8;
                dot += q[0] * bflo(w.x) + q[1] * bfhi(w.x) + q[2] * bflo(w.y) + q[3] * bfhi(w.y) + q[4] * bflo(w.z) + q[5] * bfhi(w.z) + q[6] * bflo(w.w) + q[7] * bfhi(w.w); }
            const float s = dot + slopeL * (float)(key - qpos); sc[base + i] = s; mx = fmaxf(mx, s); }
        base += len; } }
    const int tot = base; mx = wave_max(mx);
    LDS_WAIT();
    float sum = 0.f;
    for (int i = lane; i < tot; i += 64) { const float p = exp2f(sc[i] - mx); sc[i] = p; sum += p; }
    sum = wave_sum(sum);
    LDS_WAIT();
    float a0 = 0.f, a1 = 0.f; base = 0;
    { int m2 = mask;
      for (int rr = 0;; ++rr) { int start, len;
        if (rr == 0) { start = own_start; len = own_len; } else { if (!m2) break; const int j = __builtin_ctz(m2); m2 &= m2 - 1; start = blkbase + (j << 8); len = 256; }
        const bf16_t* vp = Vh + (size_t)start * DM + 2 * lane;
        for (int i = 0; i < len; ++i) { const float p = sc[base + i]; const unsigned w = *(const unsigned*)(vp + (size_t)i * DM); a0 += p * bflo(w); a1 += p * bfhi(w); }
        base += len; } }
    LDS_WAIT();
    const float inv = 1.f / sum; o0 = a0 * inv; o1 = a1 * inv; lse2 = mx + log2f(sum);
}
__device__ __forceinline__ float slope_of(int h) { return exp2f(-0.5f * (float)(h + 1)); }

__device__ __forceinline__ void attn_a_naive(unsigned char* lds, int wv) {
    CParams& P = PP();
    const int tid_ = otid(wv); const int lane = tid_ & 63, wave = __builtin_amdgcn_readfirstlane(tid_ >> 6);
    float* qf = (float*)(lds + wave * 8192); float* sc = qf + 128;
    const bf16_t* QKV = (const bf16_t*)(P.ws + WS_QKV); bf16_t* OG = (bf16_t*)(P.ws + WS_OG); float* LSE = (float*)(P.ws + WS_LSE);
    const int gw = obid() * 8 + wave, NGW = gridDim.x * 8;
    for (int it = gw; it < 3 * MTOK * NH; it += NGW) {
        const int h = it & 15, R = (it >> 4) & (MTOK - 1), g = it >> 17;
        const int lg = 2 * g, L = SEQ >> lg;
        const bf16_t* Qp = QKV + (size_t)(3 * g) * PART + (size_t)R * DM + h * HD;
        { const unsigned w = *(const unsigned*)(Qp + 2 * lane); qf[2 * lane] = bflo(w); qf[2 * lane + 1] = bfhi(w); }
        LDS_WAIT();
        const int seq0 = R & ~(L - 1); int lo = R - 128; if (lo < seq0) lo = seq0;
        float o0, o1, lse2;
        naive_attend(QKV + (size_t)(3 * g + 1) * PART + h * HD, QKV + (size_t)(3 * g + 2) * PART + h * HD, qf, sc, lo, R - lo + 1, 0, 0, R, slope_of(h) * (float)(1 << lg) * LOG2E, lane, o0, o1, lse2);
        *(unsigned*)(OG + (size_t)g * PART + (size_t)R * DM + h * HD + 2 * lane) = cvt_pk_bf16(o0, o1);
        if (lane == 0) LSE[((size_t)g * MTOK + R) * NH + h] = lse2;
    }
}
__device__ __forceinline__ void combine_phase(int wv) {
    CParams& P = PP();
    const int tid_ = otid(wv); const int lane = tid_ & 63, wave = __builtin_amdgcn_readfirstlane(tid_ >> 6);
    const int gw = obid() * 8 + wave, NGW = gridDim.x * 8;
    const bf16_t* OG = (const bf16_t*)(P.ws + WS_OG); const float* LSE = (const float*)(P.ws + WS_LSE); const bf16_t* Z = (const bf16_t*)(P.ws + WS_Z);
    unsigned char* GQ = P.ws + WS_HQ; float* RS = (float*)(P.ws + WS_RS);
    for (int m = gw; m < MTOK; m += NGW) {
        const int b = m >> 11, t = m & 2047;
        const int R0 = m, R1 = (b << 11) + ((t & 3) << 9) + (t >> 2), R2 = (b << 11) + ((t & 15) << 7) + (t >> 4);
        float v[4][8]; float am = 0.f, sq = 0.f;
#pragma unroll
        for (int j = 0; j < 4; ++j) { const int col = 8 * lane + 512 * j, h = col >> 7;
            const float l0 = LSE[((size_t)0 * MTOK + R0) * NH + h], l1 = LSE[((size_t)1 * MTOK + R1) * NH + h], l2 = LSE[((size_t)2 * MTOK + R2) * NH + h];
            const float mx = fmaxf(l0, fmaxf(l1, l2)); float e0 = exp2f(l0 - mx), e1 = exp2f(l1 - mx), e2 = exp2f(l2 - mx); const float inv = 1.f / (e0 + e1 + e2); e0 *= inv; e1 *= inv; e2 *= inv;
            const u32x4 a = *(const u32x4*)(OG + (size_t)R0 * DM + col), bb = *(const u32x4*)(OG + PART + (size_t)R1 * DM + col), cc = *(const u32x4*)(OG + 2 * PART + (size_t)R2 * DM + col);
            const u32x4 zz = *(const u32x4*)(Z + (size_t)m * DM + col);
#define CMB(F, I) { v[j][I] = (e0 * bflo(a.F) + e1 * bflo(bb.F) + e2 * bflo(cc.F)) * silu_f(bflo(zz.F)); v[j][I + 1] = (e0 * bfhi(a.F) + e1 * bfhi(bb.F) + e2 * bfhi(cc.F)) * silu_f(bfhi(zz.F)); \
                    am = fmaxf(am, fmaxf(fabsf(v[j][I]), fabsf(v[j][I + 1]))); sq += v[j][I] * v[j][I] + v[j][I + 1] * v[j][I + 1]; }
            CMB(x, 0) CMB(y, 2) CMB(z, 4) CMB(w, 6)
#undef CMB
        }
#if !OUTA_I8
        { bf16_t* Gr = (bf16_t*)(P.ws + WS_G) + (size_t)m * DM;
#pragma unroll
          for (int j = 0; j < 4; ++j) { u32x4 o; o.x = cvt_pk_bf16(v[j][0], v[j][1]); o.y = cvt_pk_bf16(v[j][2], v[j][3]); o.z = cvt_pk_bf16(v[j][4], v[j][5]); o.w = cvt_pk_bf16(v[j][6], v[j][7]); *(u32x4*)(Gr + 8 * lane + 512 * j) = o; }
          continue; }
#endif
        am = wave_max(am); sq = wave_sum(sq);
        am = fminf(am, GCLIP * sqrtf(sq * (1.f / DM)));
        const float inv = am > 0.f ? 127.f / am : 0.f;
        if (lane == 0) RS[m] = am > 0.f ? am * (1.f / 127.f) : 1.f;
#pragma unroll
        for (int j = 0; j < 4; ++j) { unsigned w0 = 0, w1 = 0;
#pragma unroll
            for (int e = 0; e < 4; ++e) { w0 |= ((unsigned)(int)rintf(fminf(fmaxf(v[j][e] * inv, -127.f), 127.f)) & 0xffu) << (8 * e); w1 |= ((unsigned)(int)rintf(fminf(fmaxf(v[j][4 + e] * inv, -127.f), 127.f)) & 0xffu) << (8 * e); }
            *(u32x2*)(GQ + (size_t)m * DM + 8 * lane + 512 * j) = (u32x2){w0, w1}; }
    }
}
__device__ __forceinline__ void attn_b_naive(unsigned char* lds, int wv) {
    CParams& P = PP();
    const int tid_ = otid(wv); const int lane = tid_ & 63, wave = __builtin_amdgcn_readfirstlane(tid_ >> 6);
    float* qf = (float*)(lds + wave * 8192); float* sc = qf + 128;
    const bf16_t* QKV = (const bf16_t*)(P.ws + WS_QKV); const bf16_t* Z = (const bf16_t*)(P.ws + WS_Z); bf16_t* G = (bf16_t*)(P.ws + WS_G); const float* KS = (const float*)(P.ws + WS_KSUM);
    const int gw = obid() * 8 + wave, NGW = gridDim.x * 8;
    for (int it = gw; it < MTOK * NH; it += NGW) {
        const int h = it & 15, m = it >> 4, b = m >> 11, t = m & 2047, n = t >> 8;
        const bf16_t* Qp = QKV + (size_t)m * DM + h * HD;
        float q0, q1; { const unsigned w = *(const unsigned*)(Qp + 2 * lane); q0 = bflo(w); q1 = bfhi(w); qf[2 * lane] = q0; qf[2 * lane + 1] = q1; }
        LDS_WAIT();
        float gt[8];
#pragma unroll
        for (int j = 0; j < 8; ++j) { float v = 0.f;
            if (j < n) { const float* k0 = KS + (size_t)(b * 8 + j) * DM + h * HD + 2 * lane; const float* k1 = k0 + (size_t)32 * DM; v = q0 * (k0[0] + k1[0]) + q1 * (k0[1] + k1[1]); }
            gt[j] = wave_sum(v); }
        int mask = 0;
#pragma unroll
        for (int j = 0; j < 8; ++j) { if (j < n) { int rank = 0;
#pragma unroll
                for (int j2 = 0; j2 < 8; ++j2) if (j2 < n && (gt[j2] > gt[j] || (gt[j2] == gt[j] && j2 < j))) ++rank;
                if (rank < 3) mask |= 1 << j; } }
        float o0, o1, lse2;
        naive_attend(QKV + PART + h * HD, QKV + 2 * PART + h * HD, qf, sc, (b << 11) + (n << 8), (t & 255) + 1, b << 11, mask, m, slope_of(h) * LOG2E, lane, o0, o1, lse2);
        const unsigned zw = *(const unsigned*)(Z + (size_t)m * DM + h * HD + 2 * lane);
        *(unsigned*)(G + (size_t)m * DM + h * HD + 2 * lane) = cvt_pk_bf16(o0 * silu_f(bflo(zw)), o1 * silu_f(bfhi(zw)));
    }
}

namespace fa {
constexpr int KVBLK = 64, SHM_K = KVBLK * HD * 2, SHM_V = KVBLK * HD * 2;
constexpr int OFF_V = 0, OFF_K = 2 * SHM_V, OFF_WS = OFF_K + 2 * SHM_K, OFF_OST = OFF_WS + 8 * 256, OST_ROW = 272, OST_WAVE = 32 * OST_ROW;
constexpr int OFF_GK = OFF_OST + 8 * OST_WAVE, OFF_SEL = OFF_GK + 7 * 128 * 4, OFF_END = OFF_SEL + 256 * 4;
static_assert(OFF_END <= LDS_BYTES - 1024, "attention LDS map");
constexpr float THR = 11.5f;
#define KSWZ(row, colB) ((row) * 256 + ((colB) ^ (((row) & 7) << 4)))
#define SBAR() __builtin_amdgcn_sched_barrier(0)
__device__ __forceinline__ int v_st(int k, int c) { const int kk = (k & ~0xC) | ((k & 4) << 1) | ((k & 8) >> 1); return ((kk >> 3) * 4 + (c >> 5)) * 512 + ((kk & 7) * 32 + (c & 31)) * 2; }
__device__ __forceinline__ int v_rd_base(int lane) { return ((lane & 3) << 3) | (((lane >> 2) & 3) << 6) | (((lane >> 4) & 1) << 5) | (((lane >> 5) & 1) << 8); }
constexpr int v_rd_off(int d0, int ks, int half) { return d0 * 512 + ks * 4096 + half * 2048; }
__device__ __forceinline__ int crow(int r, int hi) { return (r & 3) + 8 * (r >> 2) + 4 * hi; }
__device__ __forceinline__ void mask_tile(f32x16& p0, f32x16& p1, int dq, unsigned W) {
    const float NEG = -__builtin_inff();
#pragma unroll
    for (int r = 0; r < 16; ++r) { const int c = (r & 3) + 8 * (r >> 2);
        if ((unsigned)(dq - c) >= W) p0[r] = NEG;
        if ((unsigned)(dq - c - 32) >= W) p1[r] = NEG; }
}
__device__ __forceinline__ void partialSM(f32x16& p0, f32x16& p1, float& m_reg, float& alpha) {
    float pmax = p0[0];
#pragma unroll
    for (int r = 1; r < 16; ++r) pmax = fmaxf(pmax, p0[r]);
#pragma unroll
    for (int r = 0; r < 16; ++r) pmax = fmaxf(pmax, p1[r]);
    { auto rr = __builtin_amdgcn_permlane32_swap(__float_as_uint(pmax), __float_as_uint(pmax), false, false); pmax = fmaxf(__uint_as_float(rr[0]), __uint_as_float(rr[1])); }
    float mn;
    if (__builtin_expect(__all(pmax - m_reg <= THR), 1)) { mn = m_reg; alpha = 1.f; }
    else { mn = fmaxf(m_reg, pmax); alpha = __builtin_amdgcn_exp2f(m_reg - mn); m_reg = mn; }
#pragma unroll
    for (int r = 0; r < 16; ++r) p0[r] = __builtin_amdgcn_exp2f(p0[r] - mn);
#pragma unroll
    for (int r = 0; r < 16; ++r) p1[r] = __builtin_amdgcn_exp2f(p1[r] - mn);
}
__device__ __forceinline__ void finishSM(f32x16& p0, f32x16& p1, float alpha, float& l_reg, bf16x8& pa0, bf16x8& pa1, bf16x8& pa2, bf16x8& pa3) {
    float ps = 0;
#pragma unroll
    for (int r = 0; r < 16; ++r) ps += p0[r];
#pragma unroll
    for (int r = 0; r < 16; ++r) ps += p1[r];
    { auto rr = __builtin_amdgcn_permlane32_swap(__float_as_uint(ps), __float_as_uint(ps), false, false); ps = __uint_as_float(rr[0]) + __uint_as_float(rr[1]); }
    l_reg = l_reg * alpha + ps;
#define PK4(P, B_, OUT) do { unsigned a0 = cvt_pk_bf16(P[B_+0], P[B_+1]), a1 = cvt_pk_bf16(P[B_+2], P[B_+3]);                          \
        unsigned b0 = cvt_pk_bf16(P[B_+4], P[B_+5]), b1 = cvt_pk_bf16(P[B_+6], P[B_+7]);                                             \
        auto r0 = __builtin_amdgcn_permlane32_swap(a0, b0, false, false); auto r1 = __builtin_amdgcn_permlane32_swap(a1, b1, false, false); \
        u32x4 w = {r0[0], r1[0], r0[1], r1[1]}; OUT = *reinterpret_cast<bf16x8*>(&w); } while (0)
    PK4(p0, 0, pa0); PK4(p0, 8, pa1); PK4(p1, 0, pa2); PK4(p1, 8, pa3);
#undef PK4
}
template <int KB>
__device__ __forceinline__ void qkt(f32x16& p0, f32x16& p1, const LAS char* K_lds, int r32, int hi, const bf16x8* qr) {
    const LAS char* kb[4];
#pragma unroll
    for (int dd = 0; dd < 4; ++dd) kb[dd] = K_lds + KB * SHM_K + KSWZ(r32, (dd * 16 + hi * 8) * 2);
#pragma unroll
    for (int d0 = 0; d0 < 8; ++d0) { const LAS char* a = kb[d0 & 3] + (d0 >> 2) * 128;
        const bf16x8 b0 = *reinterpret_cast<const LAS bf16x8*>(a);
        const bf16x8 b1 = *reinterpret_cast<const LAS bf16x8*>(a + 32 * 256);
        p0 = __builtin_amdgcn_mfma_f32_32x32x16_bf16(b0, qr[d0], p0, 0, 0, 0);
        p1 = __builtin_amdgcn_mfma_f32_32x32x16_bf16(b1, qr[d0], p1, 0, 0, 0); }
}
template <int VB>
__device__ __forceinline__ void pv_tile(f32x16* o, int vb0, bf16x8 pa0, bf16x8 pa1, bf16x8 pa2, bf16x8 pa3) {
#define TRRD(dst, off) asm volatile("ds_read_b64_tr_b16 %0, %1 offset:%2" : "=&v"(dst) : "v"(vb0), "i"(off) : "memory")
#define PV_D0(d0) do { s16x4 l0, l1, l2, l3, h0, h1, h2, h3; constexpr int b_ = VB * SHM_V + v_rd_off(d0, 0, 0); \
        TRRD(l0, b_); TRRD(h0, b_ + 2048); TRRD(l1, b_ + 4096); TRRD(h1, b_ + 6144); TRRD(l2, b_ + 8192); TRRD(h2, b_ + 10240); TRRD(l3, b_ + 12288); TRRD(h3, b_ + 14336); \
        asm volatile("s_waitcnt lgkmcnt(0)" ::: "memory"); SBAR();   \
        o[d0] = __builtin_amdgcn_mfma_f32_32x32x16_bf16(pa0, (bf16x8){l0[0], l0[1], l0[2], l0[3], h0[0], h0[1], h0[2], h0[3]}, o[d0], 0, 0, 0);   \
        o[d0] = __builtin_amdgcn_mfma_f32_32x32x16_bf16(pa1, (bf16x8){l1[0], l1[1], l1[2], l1[3], h1[0], h1[1], h1[2], h1[3]}, o[d0], 0, 0, 0);   \
        o[d0] = __builtin_amdgcn_mfma_f32_32x32x16_bf16(pa2, (bf16x8){l2[0], l2[1], l2[2], l2[3], h2[0], h2[1], h2[2], h2[3]}, o[d0], 0, 0, 0);   \
        o[d0] = __builtin_amdgcn_mfma_f32_32x32x16_bf16(pa3, (bf16x8){l3[0], l3[1], l3[2], l3[3], h3[0], h3[1], h3[2], h3[3]}, o[d0], 0, 0, 0); } while (0)
    PV_D0(0); PV_D0(1); PV_D0(2); PV_D0(3);
#undef PV_D0
#undef TRRD
}

template <int MODE, class MK>
__device__ __forceinline__ void flash_block(const bf16_t* Q, const bf16_t* K, const bf16_t* V, int krow0, int NT, int qrow0, float slopeL, const MK& mk,
                                            unsigned char* lds, bf16_t* Og, float* Lse, const bf16_t* Zg, int tid) {
    const int wid = __builtin_amdgcn_readfirstlane(tid >> 6), lane = tid & 63, r32 = lane & 31, hi = lane >> 5;
    const LAS char* K_lds = (const LAS char*)(LAS unsigned char*)lds + OFF_K;
    LAS char* Kw = (LAS char*)(LAS unsigned char*)lds + OFF_K; LAS char* Vw = (LAS char*)(LAS unsigned char*)lds + OFF_V;
    LAS float* wsf = (LAS float*)((LAS unsigned char*)lds + OFF_WS) + wid * 64; LAS float* li_l = wsf; LAS float* al_l = wsf + 32;
    const int sr = tid >> 4, sc = (tid & 15) * 8, vst0 = v_st(sr, sc), vst1 = v_st(32 + sr, sc), kws = KSWZ(sr, sc * 2);
    const int vb0 = (int)(unsigned)(uintptr_t)((LAS unsigned char*)lds) + OFF_V + v_rd_base(lane);
    const int qlo = qrow0 + wid * 32, qm = qlo + r32 - 4 * hi;
    bf16x8 st_k0, st_k1, st_v0, st_v1;
#define SLOAD(kb_) do { const size_t o0_ = (size_t)((kb_) + sr) * DM + sc, o1_ = o0_ + (size_t)32 * DM; \
        st_v0 = *(const bf16x8*)(V + o0_); st_v1 = *(const bf16x8*)(V + o1_); st_k0 = *(const bf16x8*)(K + o0_); st_k1 = *(const bf16x8*)(K + o1_); } while (0)
#define SWRITE(bf) do { *(LAS bf16x8*)(Vw + (bf) * SHM_V + vst0) = st_v0; *(LAS bf16x8*)(Vw + (bf) * SHM_V + vst1) = st_v1; \
        *(LAS bf16x8*)(Kw + (bf) * SHM_K + kws) = st_k0; *(LAS bf16x8*)(Kw + (bf) * SHM_K + kws + 32 * 256) = st_k1; } while (0)
    bf16x8 qr[8];
#pragma unroll
    for (int d0 = 0; d0 < 8; ++d0) qr[d0] = *(const bf16x8*)(Q + (size_t)(wid * 32 + r32) * DM + d0 * 16 + hi * 8);
    SLOAD(krow0); asm volatile("s_waitcnt vmcnt(0)" ::: "memory"); SWRITE(0);
    __syncthreads();
    float m_reg = -1e30f, l_reg = 0.f; f32x16 o[4] = {};
#define STEP(t, KB) do { const int kb_ = krow0 + (t) * KVBLK;                                                                   \
        if ((t) + 1 < NT) SLOAD(kb_ + KVBLK);                                                                                     \
        bool act_, need_; unsigned W_; mk.info(kb_, qlo, r32, act_, need_, W_);                                                 \
        if (act_) { f32x16 p0, p1; const float a0_ = slopeL * (float)(kb_ - qm);                                                  \
            _Pragma("unroll") for (int r = 0; r < 16; ++r) { p0[r] = fmaf(slopeL, (float)((r & 3) + 8 * (r >> 2)), a0_); p1[r] = p0[r] + 32.f * slopeL; } \
            qkt<KB>(p0, p1, K_lds, r32, hi, qr);                                                                                  \
            if (need_) mask_tile(p0, p1, qm - kb_, W_);                                                                           \
            float alpha_; partialSM(p0, p1, m_reg, alpha_);                                                                       \
            bf16x8 pa0, pa1, pa2, pa3; finishSM(p0, p1, alpha_, l_reg, pa0, pa1, pa2, pa3);                                       \
            if (__any(alpha_ < 1.f)) { if (hi == 0) al_l[r32] = alpha_; LDS_WAIT();                                               \
                _Pragma("unroll") for (int d_ = 0; d_ < 4; ++d_) _Pragma("unroll") for (int r = 0; r < 16; ++r) o[d_][r] *= al_l[crow(r, hi)]; } \
            SBAR(); pv_tile<KB>(o, vb0, pa0, pa1, pa2, pa3); }                                                                    \
        if ((t) + 1 < NT) { asm volatile("s_waitcnt vmcnt(0)" ::: "memory"); SWRITE((KB) ^ 1); }                               \
        __syncthreads(); } while (0)
    for (int t = 0; t < NT; t += 2) { STEP(t, 0); STEP(t + 1, 1); }
#undef STEP
#undef SLOAD
#undef SWRITE
    if (hi == 0) li_l[r32] = l_reg;
    LDS_WAIT();
    LAS unsigned char* stg = (LAS unsigned char*)lds + OFF_OST + wid * OST_WAVE;
#pragma unroll
    for (int r = 0; r < 16; ++r) { const int orow = crow(r, hi); const float rl = __builtin_amdgcn_rcpf(li_l[orow]);
#pragma unroll
        for (int d0 = 0; d0 < 4; ++d0) *(LAS unsigned short*)(stg + orow * OST_ROW + (d0 * 32 + r32) * 2) = (unsigned short)(cvt_pk_bf16(o[d0][r] * rl, 0.f) & 0xffffu); }
    LDS_WAIT();
    if (MODE == 0) { if (hi == 0) Lse[(size_t)(qlo + r32) * NH] = m_reg + log2f(l_reg); }
#pragma unroll
    for (int i = 0; i < 8; ++i) { const int row = i * 4 + (lane >> 4), ch = lane & 15;
        u32x4 v = *(const LAS u32x4*)(stg + row * OST_ROW + ch * 16);
        const size_t go = (size_t)(qlo + row) * DM + ch * 8;
        if (MODE == 1) { const u32x4 z = *(const u32x4*)(Zg + go);
            v.x = cvt_pk_bf16(bflo(v.x) * silu_f(bflo(z.x)), bfhi(v.x) * silu_f(bfhi(z.x))); v.y = cvt_pk_bf16(bflo(v.y) * silu_f(bflo(z.y)), bfhi(v.y) * silu_f(bfhi(z.y)));
            v.z = cvt_pk_bf16(bflo(v.z) * silu_f(bflo(z.z)), bfhi(v.z) * silu_f(bfhi(z.z))); v.w = cvt_pk_bf16(bflo(v.w) * silu_f(bflo(z.w)), bfhi(v.w) * silu_f(bfhi(z.w))); }
        *(u32x4*)(Og + go) = v; }
    LDS_WAIT();
}
struct MaskA {
    int L;
    __device__ __forceinline__ void info(int kb, int qlo, int r32, bool& act, bool& need, unsigned& W) const {
        const int seq0 = qlo & ~(L - 1); int lowk = qlo - 128; if (lowk < seq0) lowk = seq0;
        act = (kb <= qlo + 31) && (kb + KVBLK - 1 >= lowk); need = true;
        const int wl = qlo + r32 - seq0 + 1; W = (unsigned)(wl < 129 ? wl : 129);
    }
};
struct MaskB {
    int own0, base0; unsigned sel;
    __device__ __forceinline__ void info(int kb, int qlo, int r32, bool& act, bool& need, unsigned& W) const {
        if (kb >= own0) { act = kb <= qlo + 31; need = kb + KVBLK - 1 > qlo; W = 0x40000000u; }
        else { const int blk = (kb - base0) >> 8; const bool s = (sel >> blk) & 1u; const unsigned long long bal = __ballot(s);
            act = bal != 0ull; need = bal != ~0ull; W = s ? 0x40000000u : 0u; }
    }
};
#undef KSWZ
#undef SBAR
}

namespace fb {
using namespace fa;
#define KSWZ(row, colB) ((row) * 256 + ((colB) ^ (((row) & 7) << 4)))
#define SBAR() __builtin_amdgcn_sched_barrier(0)
struct Blk {
    unsigned qoff, koff, voff;
    unsigned ooff, xoff;
    int R0, kb0, NT;
    float slopeL;
    int L, base0;
};
struct Nxt { unsigned qoff, koff, voff; int kb0; };
struct Seam { bf16x8 qr[8]; bf16x8 st_v0, st_v1, st_k0, st_k1; };
__device__ __forceinline__ void tile_info(const Blk& c, int kb, int qlo, int r32, unsigned sel, bool& act, bool& need, unsigned& W) {
    if (c.L > 0) { const int seq0 = qlo & ~(c.L - 1); int lowk = qlo - 128; if (lowk < seq0) lowk = seq0;
        act = (kb <= qlo + 31) && (kb + KVBLK - 1 >= lowk); need = true; const int wl = qlo + r32 - seq0 + 1; W = (unsigned)(wl < 129 ? wl : 129); }
    else if (kb >= c.R0) { act = kb <= qlo + 31; need = kb + KVBLK - 1 > qlo; W = 0x40000000u; }
    else { const int blk = (kb - c.base0) >> 8; const bool sb = (sel >> blk) & 1u; const unsigned long long bal = __ballot(sb);
        act = bal != 0ull; need = bal != ~0ull; W = sb ? 0x40000000u : 0u; }
}
template <int KB>
__device__ __forceinline__ void qkt2(f32x16& p0, f32x16& p1, const LAS char* K_lds, int r32, int hi, const bf16x8* qr, bool act, float slopeL, float a0) {
    if (!act) { const float NEG = -__builtin_inff();
#pragma unroll
        for (int r = 0; r < 16; ++r) { p0[r] = NEG; p1[r] = NEG; } return; }
#pragma unroll
    for (int r = 0; r < 16; ++r) { p0[r] = fmaf(slopeL, (float)((r & 3) + 8 * (r >> 2)), a0); p1[r] = fmaf(slopeL, (float)((r & 3) + 8 * (r >> 2) + 32), a0); }
    qkt<KB>(p0, p1, K_lds, r32, hi, qr);
}
#define ROWP(off, k0, rr) (wsb + ((size_t)(off) + (size_t)(k0) * (DM * 2)) + (unsigned)(((rr) * DM + sc) * 2))
#define VMW() asm volatile("s_waitcnt vmcnt(0)" ::: "memory")
#define SLOAD_H(Kp, Vp, k0) do { S.st_v0 = *(const bf16x8*)ROWP(Vp, k0, sr); S.st_v1 = *(const bf16x8*)ROWP(Vp, k0, 32 + sr); \
                                 S.st_k0 = *(const bf16x8*)ROWP(Kp, k0, sr); S.st_k1 = *(const bf16x8*)ROWP(Kp, k0, 32 + sr); } while (0)
#define SWRITE_HK(bf) do { *(LAS bf16x8*)(Kw + (bf) * SHM_K + kws) = S.st_k0; *(LAS bf16x8*)(Kw + (bf) * SHM_K + kws + 32 * 256) = S.st_k1; } while (0)
#define SWRITE_HV(bf) do { *(LAS bf16x8*)(Vw + (bf) * SHM_V + vst0) = S.st_v0; *(LAS bf16x8*)(Vw + (bf) * SHM_V + vst1) = S.st_v1; } while (0)
#define SWRITE_H(bf) do { SWRITE_HV(bf); SWRITE_HK(bf); } while (0)
__device__ __forceinline__ void prime(const unsigned char* wsb, const Blk& cur, unsigned char* lds, Seam& S, int tid) {
    const int wid = __builtin_amdgcn_readfirstlane(tid >> 6), lane = tid & 63, r32 = lane & 31, hi = lane >> 5;
    const int sr = tid >> 4, sc = (tid & 15) * 8, kws = KSWZ(sr, sc * 2);
    LAS char* Kw = (LAS char*)(LAS unsigned char*)lds + OFF_K;
#pragma unroll
    for (int d0 = 0; d0 < 8; ++d0) S.qr[d0] = *(const bf16x8*)(wsb + (size_t)cur.qoff + (unsigned)(((wid * 32 + r32) * DM + d0 * 16 + hi * 8) * 2));
    SLOAD_H(cur.koff, cur.voff, cur.kb0); VMW(); SWRITE_HK(0);
    __syncthreads();
}
template <int MODE>
__device__ __forceinline__ void block(const unsigned char* wsb, const Blk& cur, const Nxt& nxt, unsigned sel, unsigned char* lds, Seam& S, int tid) {
    const int wid = __builtin_amdgcn_readfirstlane(tid >> 6), lane = tid & 63, r32 = lane & 31, hi = lane >> 5;
    const LAS char* K_lds = (const LAS char*)(LAS unsigned char*)lds + OFF_K;
    LAS char* Kw = (LAS char*)(LAS unsigned char*)lds + OFF_K; LAS char* Vw = (LAS char*)(LAS unsigned char*)lds + OFF_V;
    LAS float* wsf = (LAS float*)((LAS unsigned char*)lds + OFF_WS) + wid * 64; LAS float* li_l = wsf; LAS float* al_l = wsf + 32;
    const int sr = tid >> 4, sc = (tid & 15) * 8, vst0 = v_st(sr, sc), vst1 = v_st(32 + sr, sc), kws = KSWZ(sr, sc * 2);
    const int vb0 = (int)(unsigned)(uintptr_t)((LAS unsigned char*)lds) + OFF_V + v_rd_base(lane);
    const int NT = cur.NT, qlo = cur.R0 + wid * 32, qm = qlo + r32 - 4 * hi;
    const float slopeL = cur.slopeL;
    const unsigned Kh = cur.koff, Vh = cur.voff;
    float m_reg = -1e30f, l_reg = 0.f; f32x16 o[4] = {};
#define KBASE(t) (cur.kb0 + (t) * KVBLK)
#define RESC(a) do { if (__any((a) < 1.f)) { if (hi == 0) al_l[r32] = (a); LDS_WAIT(); \
        _Pragma("unroll") for (int d_ = 0; d_ < 4; ++d_) _Pragma("unroll") for (int r = 0; r < 16; ++r) o[d_][r] *= al_l[crow(r, hi)]; } } while (0)
#define QKT(PX0, PX1, t, KB, ACTV) do { const int kb_ = KBASE(t); bool nd_; unsigned W_; tile_info(cur, kb_, qlo, r32, sel, ACTV, nd_, W_); \
        qkt2<KB>(PX0, PX1, K_lds, r32, hi, S.qr, ACTV, slopeL, slopeL * (float)(kb_ - qm)); } while (0)
#define MASKT(PX0, PX1, t) do { const int kb_ = KBASE(t); bool ac_, nd_; unsigned W_; tile_info(cur, kb_, qlo, r32, sel, ac_, nd_, W_); \
        if (ac_ && nd_) mask_tile(PX0, PX1, qm - kb_, W_); } while (0)
    f32x16 pA0, pA1, pB0, pB1; float alA, alB; bf16x8 pa0, pa1, pa2, pa3; bool actA, actB;
    SWRITE_HV(0); SBAR();
    SLOAD_H(Kh, Vh, KBASE(1));
    SBAR(); QKT(pA0, pA1, 0, 0, actA);
    MASKT(pA0, pA1, 0); partialSM(pA0, pA1, m_reg, alA);
    VMW(); SWRITE_H(1);
    __syncthreads();
#define HALF_STEP(PX0, PX1, alX, actX, PY0, PY1, alY, actY, t, KB, VB, SB) do {                                                 \
        SBAR(); QKT(PX0, PX1, t, KB, actX);                                                                                   \
        finishSM(PY0, PY1, alY, l_reg, pa0, pa1, pa2, pa3); SBAR();                                                           \
        if ((t) + 1 < NT) { SLOAD_H(Kh, Vh, KBASE((t) + 1)); SBAR(); }                                                        \
        if (actY) pv_tile<VB>(o, vb0, pa0, pa1, pa2, pa3);                                                                    \
        MASKT(PX0, PX1, (t)); partialSM(PX0, PX1, m_reg, alX);                                                                \
        __syncthreads();                                                                                                      \
        if ((t) + 1 < NT) { VMW(); SWRITE_H(SB); }                                                                            \
        RESC(alX); __syncthreads(); } while (0)
    for (int t = 1; t + 1 < NT; t += 2) {
        HALF_STEP(pB0, pB1, alB, actB, pA0, pA1, alA, actA, t, 1, 0, 0);
        HALF_STEP(pA0, pA1, alA, actA, pB0, pB1, alB, actB, t + 1, 0, 1, 1);
    }
    SBAR(); QKT(pB0, pB1, NT - 1, 1, actB); SBAR();
    SLOAD_H(nxt.koff, nxt.voff, nxt.kb0); SBAR();
#pragma unroll
    for (int d0 = 0; d0 < 8; ++d0) S.qr[d0] = *(const bf16x8*)(wsb + (size_t)nxt.qoff + (unsigned)(((wid * 32 + r32) * DM + d0 * 16 + hi * 8) * 2));
    SBAR();
    finishSM(pA0, pA1, alA, l_reg, pa0, pa1, pa2, pa3); SBAR();
    if (actA) pv_tile<0>(o, vb0, pa0, pa1, pa2, pa3);
    MASKT(pB0, pB1, NT - 1); partialSM(pB0, pB1, m_reg, alB); __syncthreads(); RESC(alB);
    finishSM(pB0, pB1, alB, l_reg, pa0, pa1, pa2, pa3); SBAR();
    if (actB) pv_tile<1>(o, vb0, pa0, pa1, pa2, pa3);
    SBAR(); asm volatile("s_waitcnt vmcnt(8)" ::: "memory"); SWRITE_HK(0); SBAR();
    int tid2 = tid; asm volatile("" : "+v"(tid2));
    const int lane2 = tid2 & 63, r32e = lane2 & 31, hie = lane2 >> 5;
    if (hie == 0) li_l[r32e] = l_reg;
    LDS_WAIT();
    LAS unsigned char* stg = (LAS unsigned char*)lds + OFF_OST + wid * OST_WAVE;
#pragma unroll
    for (int r = 0; r < 16; ++r) { const int orow = crow(r, hie); const float rl = __builtin_amdgcn_rcpf(li_l[orow]);
#pragma unroll
        for (int d0 = 0; d0 < 4; ++d0) *(LAS unsigned short*)(stg + orow * OST_ROW + (d0 * 32 + r32e) * 2) = (unsigned short)(cvt_pk_bf16(o[d0][r] * rl, 0.f) & 0xffffu); }
    LDS_WAIT();
    if (MODE == 0) { if (hie == 0) *(float*)(const_cast<unsigned char*>(wsb) + (size_t)cur.xoff + (unsigned)((qlo + r32e) * NH * 4)) = m_reg + log2f(l_reg); }
#pragma unroll
    for (int i = 0; i < 8; ++i) { const int row = i * 4 + (lane2 >> 4), ch = lane2 & 15;
        u32x4 v = *(const LAS u32x4*)(stg + row * OST_ROW + ch * 16);
        const unsigned go = (unsigned)(((qlo + row) * DM + ch * 8) * 2);
        if (MODE == 1) { const u32x4 z = *(const u32x4*)(wsb + (size_t)cur.xoff + go);
            v.x = cvt_pk_bf16(bflo(v.x) * silu_f(bflo(z.x)), bfhi(v.x) * silu_f(bfhi(z.x))); v.y = cvt_pk_bf16(bflo(v.y) * silu_f(bflo(z.y)), bfhi(v.y) * silu_f(bfhi(z.y)));
            v.z = cvt_pk_bf16(bflo(v.z) * silu_f(bflo(z.z)), bfhi(v.z) * silu_f(bfhi(z.z))); v.w = cvt_pk_bf16(bflo(v.w) * silu_f(bflo(z.w)), bfhi(v.w) * silu_f(bfhi(z.w))); }
        *(u32x4*)(const_cast<unsigned char*>(wsb) + (size_t)cur.ooff + go) = v; }
    __syncthreads();
#undef KBASE
#undef RESC
#undef QKT
#undef MASKT
#undef HALF_STEP
}
#undef ROWP
#undef VMW
#undef SLOAD_H
#undef SWRITE_HK
#undef SWRITE_HV
#undef SWRITE_H
#undef KSWZ
#undef SBAR
}

namespace fc {
using namespace fa;
constexpr int NSLOT = 3;
constexpr int R_K = 0, R_V = NSLOT * SHM_K, R_WS = R_V + NSLOT * SHM_V, WSW = 96, R_OST = R_WS + 8 * WSW * 4, OSTR = 144, OSTW = 32 * OSTR;
constexpr int R_GK = R_OST + 8 * OSTW, R_SEL = R_GK + 2 * 7 * 128 * 4, R_END = R_SEL + 256 * 4;
static_assert(R_END <= LDS_BYTES - 64, "attention LDS map");
#define KSWZ(row, colB) ((row) * 256 + ((colB) ^ (((row) & 7) << 4)))
#define SBAR() __builtin_amdgcn_sched_barrier(0)
struct Blk {
    unsigned qoff, koff, voff, ooff, xoff;
    unsigned zoff, goff;
    int R0, kb0, NT;
    float slopeL;
    int L, base0;
};
struct Nxt { unsigned qoff, koff, voff; int kb0; };
__device__ __forceinline__ void glds16(const void* sbase, unsigned voff, unsigned lds_dst) { unsigned keep;
    asm volatile("s_mov_b32 %0, m0\n\ts_mov_b32 m0, %3\n\ts_nop 0\n\tglobal_load_lds_dwordx4 %1, %2\n\ts_mov_b32 m0, %0" : "=&s"(keep) : "v"(voff), "s"(sbase), "s"(lds_dst) : "memory"); }
__device__ __forceinline__ void qkt_r(f32x16& p0, f32x16& p1, const LAS char* Kslot, int r32, int hi, const bf16x8* qr) {
    const LAS char* kb[4];
#pragma unroll
    for (int dd = 0; dd < 4; ++dd) kb[dd] = Kslot + KSWZ(r32, (dd * 16 + hi * 8) * 2);
    bf16x8 c0 = *reinterpret_cast<const LAS bf16x8*>(kb[0]), c1 = *reinterpret_cast<const LAS bf16x8*>(kb[0] + 32 * 256);
#pragma unroll
    for (int d0 = 0; d0 < 8; ++d0) {
        bf16x8 n0 = c0, n1 = c1;
        if (d0 < 7) { const LAS char* a = kb[(d0 + 1) & 3] + ((d0 + 1) >> 2) * 128; n0 = *reinterpret_cast<const LAS bf16x8*>(a); n1 = *reinterpret_cast<const LAS bf16x8*>(a + 32 * 256); }
        p0 = __builtin_amdgcn_mfma_f32_32x32x16_bf16(c0, qr[d0], p0, 0, 0, 0);
        p1 = __builtin_amdgcn_mfma_f32_32x32x16_bf16(c1, qr[d0], p1, 0, 0, 0);
        c0 = n0; c1 = n1; }
}
__device__ __forceinline__ void pv_r(f32x16* o, int vb, bf16x8 pa0, bf16x8 pa1, bf16x8 pa2, bf16x8 pa3) {
#define TRRD(dst, off) asm volatile("ds_read_b64_tr_b16 %0, %1 offset:%2" : "=&v"(dst) : "v"(vb), "i"(off) : "memory")
#define PV_D0(d0) do { s16x4 l0, l1, l2, l3, h0, h1, h2, h3; constexpr int b_ = v_rd_off(d0, 0, 0); \
        TRRD(l0, b_); TRRD(h0, b_ + 2048); TRRD(l1, b_ + 4096); TRRD(h1, b_ + 6144); TRRD(l2, b_ + 8192); TRRD(h2, b_ + 10240); TRRD(l3, b_ + 12288); TRRD(h3, b_ + 14336); \
        asm volatile("s_waitcnt lgkmcnt(0)" ::: "memory"); SBAR();   \
        o[d0] = __builtin_amdgcn_mfma_f32_32x32x16_bf16(pa0, (bf16x8){l0[0], l0[1], l0[2], l0[3], h0[0], h0[1], h0[2], h0[3]}, o[d0], 0, 0, 0);   \
        o[d0] = __builtin_amdgcn_mfma_f32_32x32x16_bf16(pa1, (bf16x8){l1[0], l1[1], l1[2], l1[3], h1[0], h1[1], h1[2], h1[3]}, o[d0], 0, 0, 0);   \
        o[d0] = __builtin_amdgcn_mfma_f32_32x32x16_bf16(pa2, (bf16x8){l2[0], l2[1], l2[2], l2[3], h2[0], h2[1], h2[2], h2[3]}, o[d0], 0, 0, 0);   \
        o[d0] = __builtin_amdgcn_mfma_f32_32x32x16_bf16(pa3, (bf16x8){l3[0], l3[1], l3[2], l3[3], h3[0], h3[1], h3[2], h3[3]}, o[d0], 0, 0, 0); } while (0)
    PV_D0(0); PV_D0(1); PV_D0(2); PV_D0(3);
#undef PV_D0
#undef TRRD
}
__device__ __forceinline__ void tile_info(const Blk& c, int kb, int qlo, int r32, unsigned sel, bool& act, bool& need, unsigned& W, bool& dead) {
    dead = false;
    if (c.L > 0) { const int seq0 = qlo & ~(c.L - 1); int lowk = qlo - 128; if (lowk < seq0) lowk = seq0;
        act = (kb <= qlo + 31) && (kb + KVBLK - 1 >= lowk); need = true; const int wl = qlo + r32 - seq0 + 1; W = (unsigned)(wl < 129 ? wl : 129); }
    else if (kb >= c.R0) { act = kb <= qlo + 31; need = kb + KVBLK - 1 > qlo; W = 0x40000000u; }
    else { const int blk = (kb - c.base0) >> 8; const bool sb = (sel >> blk) & 1u; act = __ballot(sb) != 0ull; need = false; W = 0x40000000u; dead = !sb; }
}
struct Ring { int kt; };
__device__ __forceinline__ int nx3(int s) { return s == 2 ? 0 : s + 1; }
struct DmaLane { unsigned vk0, vk1, vv0, vv1; };
__device__ __forceinline__ DmaLane dma_lane(int wid, int lane) {
    DmaLane d;
    { const int row0 = wid * 8 + (lane >> 4), row1 = row0 + 4, cs = lane & 15;
      d.vk0 = (unsigned)(row0 * DM * 2 + ((cs ^ (row0 & 7)) * 16)); d.vk1 = (unsigned)(row1 * DM * 2 + ((cs ^ (row1 & 7)) * 16)); }
    { const int gi = lane & 31, kk = wid * 8 + (gi >> 2), k = (kk & ~0xC) | ((kk & 4) << 1) | ((kk & 8) >> 1);
      const int c0 = ((lane >> 5)) * 32 + (gi & 3) * 8, c1 = c0 + 64;
      d.vv0 = (unsigned)(k * DM * 2 + c0 * 2); d.vv1 = (unsigned)(k * DM * 2 + c1 * 2); }
    return d;
}
#define DMA_K(srcoff, kbrow, slot) do { const unsigned char* sb_ = wsb + ((size_t)(srcoff) + (size_t)(kbrow) * (DM * 2)); const unsigned ld_ = ldsb + R_K + (slot) * SHM_K + wid * 2048; \
        glds16(sb_, dl.vk0, ld_); glds16(sb_, dl.vk1, ld_ + 1024); } while (0)
#define DMA_V(srcoff, kbrow, slot) do { const unsigned char* sb_ = wsb + ((size_t)(srcoff) + (size_t)(kbrow) * (DM * 2)); const unsigned ld_ = ldsb + R_V + (slot) * SHM_V + wid * 2048; \
        glds16(sb_, dl.vv0, ld_); glds16(sb_, dl.vv1, ld_ + 1024); } while (0)
#define WAITBAR(N) asm volatile("s_waitcnt vmcnt(" #N ") lgkmcnt(0)\n\ts_barrier" ::: "memory")
__device__ __forceinline__ void prime(const unsigned char* wsb, const Blk& cur, unsigned char* lds, bf16x8* qr, Ring& rg, int tid) {
    const int wid = __builtin_amdgcn_readfirstlane(tid >> 6), lane = tid & 63, r32 = lane & 31, hi = lane >> 5;
    const unsigned ldsb = (unsigned)(uintptr_t)((LAS unsigned char*)lds);
    const DmaLane dl = dma_lane(wid, lane);
    DMA_K(cur.koff, cur.kb0, 0); DMA_V(cur.voff, cur.kb0, 0); DMA_K(cur.koff, cur.kb0 + KVBLK, 1);
#pragma unroll
    for (int d0 = 0; d0 < 8; ++d0) qr[d0] = *(const bf16x8*)(wsb + (size_t)cur.qoff + (unsigned)(((wid * 32 + r32) * DM + d0 * 16 + hi * 8) * 2));
    rg.kt = 0;
    WAITBAR(0);
}
template <int MODE>
__device__ __forceinline__ void block(const unsigned char* wsb, const Blk& cur, const Nxt& nxt, bool has_next, unsigned sel, unsigned char* lds, bf16x8* qr, Ring& rg, int tid) {
    const int wid = __builtin_amdgcn_readfirstlane(tid >> 6), lane = tid & 63, r32 = lane & 31, hi = lane >> 5;
    const unsigned ldsb = (unsigned)(uintptr_t)((LAS unsigned char*)lds);
    const LAS char* K_lds = (const LAS char*)(LAS unsigned char*)lds + R_K;
    LAS float* wsf = (LAS float*)((LAS unsigned char*)lds + R_WS) + wid * WSW; LAS float* li_l = wsf; LAS float* al_l = wsf + 32;
    const int vbl = (int)ldsb + R_V + v_rd_base(lane);
    const DmaLane dl = dma_lane(wid, lane);
    const int NT = cur.NT, qlo = cur.R0 + wid * 32, qm = qlo + r32 - 4 * hi;
    const float slopeL = cur.slopeL;
    float m_reg = -1e30f, l_reg = 0.f; f32x16 o[4] = {};
    int kt = rg.kt;
#define RESC(a) do { if (__any((a) < 1.f)) { if (hi == 0) al_l[r32] = (a); LDS_WAIT(); \
        _Pragma("unroll") for (int d_ = 0; d_ < 4; ++d_) _Pragma("unroll") for (int r = 0; r < 16; ++r) o[d_][r] *= al_l[crow(r, hi)]; } } while (0)
#define STEPX(PX0, PX1, alX, actX, PY0, PY1, alY, actY, t, HAVEY) do {                                                                \
        const int kb_ = cur.kb0 + (t) * KVBLK; bool nd_, dd_; unsigned W_; tile_info(cur, kb_, qlo, r32, sel, actX, nd_, W_, dd_);   \
        SBAR();                                                                                                                       \
        if (actX) { const float a0_ = dd_ ? -__builtin_inff() : slopeL * (float)(kb_ - qm);                                           \
            _Pragma("unroll") for (int r = 0; r < 16; ++r) { PX0[r] = fmaf(slopeL, (float)((r & 3) + 8 * (r >> 2)), a0_); PX1[r] = fmaf(slopeL, (float)((r & 3) + 8 * (r >> 2) + 32), a0_); } \
            qkt_r(PX0, PX1, K_lds + kt * SHM_K, r32, hi, qr);                                                                         \
            if (HAVEY) finishSM(PY0, PY1, alY, l_reg, pa0, pa1, pa2, pa3); }                                                          \
        else { _Pragma("unroll") for (int r = 0; r < 16; ++r) { PX0[r] = -__builtin_inff(); PX1[r] = -__builtin_inff(); }             \
            if (HAVEY) finishSM(PY0, PY1, alY, l_reg, pa0, pa1, pa2, pa3); }                                                          \
        SBAR();                                                                                                                       \
        { const int s2_ = kt == 0 ? 2 : kt - 1, s1_ = nx3(kt);                           \
          const bool in2_ = (t) + 2 < NT, in1_ = (t) + 1 < NT;                                                                        \
          if (in2_) DMA_K(cur.koff, kb_ + 2 * KVBLK, s2_); else if (has_next) DMA_K(nxt.koff, nxt.kb0 + ((t) + 2 - NT) * KVBLK, s2_);        \
          if (in1_) DMA_V(cur.voff, kb_ + KVBLK, s1_); else if (has_next) DMA_V(nxt.voff, nxt.kb0 + ((t) + 1 - NT) * KVBLK, s1_); }         \
        SBAR();                                                                                                                       \
        if (HAVEY) { if (actY) pv_r(o, vbl + (kt == 0 ? 2 : kt - 1) * SHM_V, pa0, pa1, pa2, pa3); }                                   \
        if (actX && nd_) mask_tile(PX0, PX1, qm - kb_, W_);                                                                           \
        partialSM(PX0, PX1, m_reg, alX);                                                                                              \
        RESC(alX);                                                                                                                    \
        if ((t) + 2 < NT || has_next) WAITBAR(4); else if ((t) + 1 < NT) WAITBAR(2); else WAITBAR(0);                                 \
        kt = nx3(kt); } while (0)
    f32x16 pA0, pA1, pB0, pB1; float alA = 1.f, alB = 1.f; bf16x8 pa0, pa1, pa2, pa3; bool actA = false, actB = false;
    STEPX(pA0, pA1, alA, actA, pB0, pB1, alB, actB, 0, false);
    STEPX(pB0, pB1, alB, actB, pA0, pA1, alA, actA, 1, true);
    for (int t = 2; t < NT; t += 2) {
        STEPX(pA0, pA1, alA, actA, pB0, pB1, alB, actB, t, true);
        STEPX(pB0, pB1, alB, actB, pA0, pA1, alA, actA, t + 1, true);
    }
    finishSM(pB0, pB1, alB, l_reg, pa0, pa1, pa2, pa3); SBAR();
    if (actB) pv_r(o, vbl + (kt == 0 ? 2 : kt - 1) * SHM_V, pa0, pa1, pa2, pa3);
    SBAR();
    if (has_next) {
#pragma unroll
        for (int d0 = 0; d0 < 8; ++d0) qr[d0] = *(const bf16x8*)(wsb + (size_t)nxt.qoff + (unsigned)(((wid * 32 + r32) * DM + d0 * 16 + hi * 8) * 2));
    }
    SBAR();
    rg.kt = kt;
    int tid2 = tid; asm volatile("" : "+v"(tid2));
    const int lane2 = tid2 & 63, r32e = lane2 & 31, hie = lane2 >> 5;
    unsigned char* wsw = const_cast<unsigned char*>(wsb);
    if (MODE == 2) {
        if (hie == 0) { const int R = qlo + r32e, bb = R >> 11, t = ((R & 127) << 4) | ((R >> 7) & 15), T0 = (bb << 11) + t, T1 = (bb << 11) + ((t & 3) << 9) + (t >> 2);
            const float l2 = m_reg + log2f(l_reg);
            const float l0 = *(const float*)(wsb + (size_t)cur.xoff + (unsigned)(T0 * NH * 4)), l1 = *(const float*)(wsb + (size_t)cur.xoff + (size_t)MTOK * NH * 4 + (unsigned)(T1 * NH * 4));
            const float mx = fmaxf(l0, fmaxf(l1, l2)); const float e0 = exp2f(l0 - mx), e1 = exp2f(l1 - mx), e2 = exp2f(l2 - mx), inv = 1.f / (e0 + e1 + e2);
            li_l[r32e] = e2 * inv / l_reg; al_l[r32e] = e0 * inv; al_l[32 + r32e] = e1 * inv; }
    } else { if (hie == 0) li_l[r32e] = 1.f / l_reg; }
    LDS_WAIT();
    if (MODE == 0) { if (hie == 0) *(float*)(wsw + (size_t)cur.xoff + (unsigned)((qlo + r32e) * NH * 4)) = m_reg + log2f(l_reg); }
    LAS unsigned char* stg = (LAS unsigned char*)lds + R_OST + wid * OSTW;
    float rl[16];
#pragma unroll
    for (int r = 0; r < 16; ++r) rl[r] = li_l[crow(r, hie)];
    u32x4 pg0[4], pg1[4], pzz[4]; unsigned tof[4];
#define PREF(hf_) do { _Pragma("unroll") for (int i = 0; i < 4; ++i) { const int row = i * 8 + (lane2 >> 3), ch = lane2 & 7; const unsigned cb = (unsigned)(((hf_) * 64 + ch * 8) * 2); \
            const int R = qlo + row, bb = R >> 11, t = ((R & 127) << 4) | ((R >> 7) & 15), T0 = (bb << 11) + t, T1 = (bb << 11) + ((t & 3) << 9) + (t >> 2);                    \
            tof[i] = (unsigned)(T0 * DM * 2);                                                                                                                                   \
            pg0[i] = *(const u32x4*)(wsb + (size_t)cur.ooff + tof[i] + cb); pg1[i] = *(const u32x4*)(wsb + (size_t)cur.ooff + (size_t)PART * 2 + (unsigned)(T1 * DM * 2) + cb); \
            pzz[i] = *(const u32x4*)(wsb + (size_t)cur.zoff + tof[i] + cb); } } while (0)
    if (MODE == 2) PREF(0);
#pragma unroll
    for (int hf = 0; hf < 2; ++hf) {
#pragma unroll
        for (int r = 0; r < 16; ++r) { const int orow = crow(r, hie);
#pragma unroll
            for (int dd = 0; dd < 2; ++dd) *(LAS unsigned short*)(stg + orow * OSTR + (dd * 32 + r32e) * 2) = (unsigned short)(cvt_pk_bf16(o[2 * hf + dd][r] * rl[r], 0.f) & 0xffffu); }
        LDS_WAIT();
        if (MODE == 2) {
            u32x4 vv[4];
#pragma unroll
            for (int i = 0; i < 4; ++i) { const int row = i * 8 + (lane2 >> 3), ch = lane2 & 7;
                u32x4 v = *(const LAS u32x4*)(stg + row * OSTR + ch * 16);
                const float a0 = al_l[row], a1 = al_l[32 + row]; const u32x4 g0 = pg0[i], g1 = pg1[i], z = pzz[i];
#define MRG(F) v.F = cvt_pk_bf16((bflo(v.F) + a0 * bflo(g0.F) + a1 * bflo(g1.F)) * silu_f(bflo(z.F)), (bfhi(v.F) + a0 * bfhi(g0.F) + a1 * bfhi(g1.F)) * silu_f(bfhi(z.F)));
                MRG(x) MRG(y) MRG(z) MRG(w)
#undef MRG
                vv[i] = v; }
            unsigned tsv[4];
#pragma unroll
            for (int i = 0; i < 4; ++i) tsv[i] = tof[i];
            if (hf == 0) PREF(1);
#pragma unroll
            for (int i = 0; i < 4; ++i) { const int ch = lane2 & 7; store_wt(wsw + (size_t)cur.goff + tsv[i] + (unsigned)((hf * 64 + ch * 8) * 2), vv[i]); }
        } else {
#pragma unroll
            for (int i = 0; i < 4; ++i) { const int row = i * 8 + (lane2 >> 3), ch = lane2 & 7;
                u32x4 v = *(const LAS u32x4*)(stg + row * OSTR + ch * 16);
                const unsigned go = (unsigned)((qlo + row) * DM * 2) + (unsigned)((hf * 64 + ch * 8) * 2);
                if (MODE == 1) { const u32x4 z = *(const u32x4*)(wsb + (size_t)cur.xoff + go);
                    v.x = cvt_pk_bf16(bflo(v.x) * silu_f(bflo(z.x)), bfhi(v.x) * silu_f(bfhi(z.x))); v.y = cvt_pk_bf16(bflo(v.y) * silu_f(bflo(z.y)), bfhi(v.y) * silu_f(bfhi(z.y)));
                    v.z = cvt_pk_bf16(bflo(v.z) * silu_f(bflo(z.z)), bfhi(v.z) * silu_f(bfhi(z.z))); v.w = cvt_pk_bf16(bflo(v.w) * silu_f(bflo(z.w)), bfhi(v.w) * silu_f(bfhi(z.w))); }
                store_wt(wsw + (size_t)cur.ooff + go, v); } }
        LDS_WAIT();
    }
#undef PREF
#undef RESC
#undef STEPX
}
#undef DMA_K
#undef DMA_V
#undef WAITBAR
#undef KSWZ
#undef SBAR
}

namespace fd {
using namespace fa;
using fc::Blk; using fc::Nxt; using fc::Ring; using fc::DmaLane; using fc::dma_lane; using fc::glds16; using fc::qkt_r; using fc::pv_r; using fc::tile_info; using fc::nx3;
using fc::R_K; using fc::R_V; using fc::R_WS; using fc::R_OST; using fc::OSTR; using fc::OSTW;
#define SBAR() __builtin_amdgcn_sched_barrier(0)
#define DMA_K(srcoff, kbrow, slot) do { const unsigned char* sb_ = wsb + ((size_t)(srcoff) + (size_t)(kbrow) * (DM * 2)); const unsigned ld_ = ldsb + R_K + (slot) * SHM_K + wid * 2048; \
        glds16(sb_, dl.vk0, ld_); glds16(sb_, dl.vk1, ld_ + 1024); } while (0)
#define DMA_V(srcoff, kbrow, slot) do { const unsigned char* sb_ = wsb + ((size_t)(srcoff) + (size_t)(kbrow) * (DM * 2)); const unsigned ld_ = ldsb + R_V + (slot) * SHM_V + wid * 2048; \
        glds16(sb_, dl.vv0, ld_); glds16(sb_, dl.vv1, ld_ + 1024); } while (0)
#define WAITBAR(N) asm volatile("s_waitcnt vmcnt(" #N ") lgkmcnt(0)\n\ts_barrier" ::: "memory")
__device__ __forceinline__ void softmax_tile(f32x16& p0, f32x16& p1, float& m_reg, float& l_reg, float& alpha, bf16x8& pa0, bf16x8& pa1, bf16x8& pa2, bf16x8& pa3) {
    partialSM(p0, p1, m_reg, alpha);
    finishSM(p0, p1, alpha, l_reg, pa0, pa1, pa2, pa3);
}
__device__ __forceinline__ void prime(const unsigned char* wsb, const Blk& cur, unsigned char* lds, bf16x8* qr, Ring& rg, int tid) {
    const int wid = __builtin_amdgcn_readfirstlane(tid >> 6), lane = tid & 63, r32 = lane & 31, hi = lane >> 5;
    const unsigned ldsb = (unsigned)(uintptr_t)((LAS unsigned char*)lds);
    const DmaLane dl = dma_lane(wid, lane);
    DMA_K(cur.koff, cur.kb0, 0); DMA_V(cur.voff, cur.kb0, 0); DMA_K(cur.koff, cur.kb0 + KVBLK, 1);
#pragma unroll
    for (int d0 = 0; d0 < 8; ++d0) qr[d0] = *(const bf16x8*)(wsb + (size_t)cur.qoff + (unsigned)(((wid * 32 + r32) * DM + d0 * 16 + hi * 8) * 2));
    rg.kt = 0;
    WAITBAR(0);
    if (wid >= 4) WAITBAR(0);
}
__device__ __forceinline__ void finish(int tid) {
    const int wid = __builtin_amdgcn_readfirstlane(tid >> 6);
    if (wid < 4) WAITBAR(0);
}
template <int MODE>
__device__ __forceinline__ void block(const unsigned char* wsb, const Blk& cur, const Nxt& nxt, bool has_next, unsigned sel, unsigned char* lds, bf16x8* qr, Ring& rg, int tid) {
    const int wid = __builtin_amdgcn_readfirstlane(tid >> 6), lane = tid & 63, r32 = lane & 31, hi = lane >> 5;
    const unsigned ldsb = (unsigned)(uintptr_t)((LAS unsigned char*)lds);
    const LAS char* K_lds = (const LAS char*)(LAS unsigned char*)lds + R_K;
    LAS float* wsf = (LAS float*)((LAS unsigned char*)lds + R_WS) + wid * fc::WSW; LAS float* li_l = wsf; LAS float* al_l = wsf + 32;
    const int vbl = (int)ldsb + R_V + v_rd_base(lane);
    const DmaLane dl = dma_lane(wid, lane);
    const int NT = cur.NT, qlo = cur.R0 + wid * 32, qm = qlo + r32 - 4 * hi;
    const float slopeL = cur.slopeL;
    float m_reg = -1e30f, l_reg = 0.f; f32x16 o[4] = {};
    int kt = rg.kt;
    f32x16 p0, p1; bf16x8 pa0, pa1, pa2, pa3; bool actP = false;
    for (int t = 0; t < NT; ++t) {
        const int kb_ = cur.kb0 + t * KVBLK; bool act, nd_, dd_; unsigned W_; tile_info(cur, kb_, qlo, r32, sel, act, nd_, W_, dd_);
        { const int s2_ = kt == 0 ? 2 : kt - 1, s1_ = nx3(kt);
          const bool in2_ = t + 2 < NT, in1_ = t + 1 < NT;
          if (in2_) DMA_K(cur.koff, kb_ + 2 * KVBLK, s2_); else if (has_next) DMA_K(nxt.koff, nxt.kb0 + (t + 2 - NT) * KVBLK, s2_);
          if (in1_) DMA_V(cur.voff, kb_ + KVBLK, s1_); else if (has_next) DMA_V(nxt.voff, nxt.kb0 + (t + 1 - NT) * KVBLK, s1_); }
        SBAR();
        if (act) { const float a0_ = dd_ ? -__builtin_inff() : slopeL * (float)(kb_ - qm);
#pragma unroll
            for (int r = 0; r < 16; ++r) { p0[r] = fmaf(slopeL, (float)((r & 3) + 8 * (r >> 2)), a0_); p1[r] = fmaf(slopeL, (float)((r & 3) + 8 * (r >> 2) + 32), a0_); }
            qkt_r(p0, p1, K_lds + kt * SHM_K, r32, hi, qr); }
        if (actP) pv_r(o, vbl + (kt == 0 ? 2 : kt - 1) * SHM_V, pa0, pa1, pa2, pa3);
        SBAR();
        if (t + 2 < NT || has_next) WAITBAR(4); else WAITBAR(0);
        if (act) { float alpha;
            if (nd_) mask_tile(p0, p1, qm - kb_, W_);
            softmax_tile(p0, p1, m_reg, l_reg, alpha, pa0, pa1, pa2, pa3);
            if (__any(alpha < 1.f)) { if (hi == 0) al_l[r32] = alpha; LDS_WAIT();
#pragma unroll
                for (int d_ = 0; d_ < 4; ++d_)
#pragma unroll
                    for (int r = 0; r < 16; ++r) o[d_][r] *= al_l[crow(r, hi)]; } }
        actP = act;
        SBAR();
        if (t + 2 < NT || has_next) WAITBAR(4); else WAITBAR(0);
        kt = nx3(kt);
    }
    if (actP) pv_r(o, vbl + (kt == 0 ? 2 : kt - 1) * SHM_V, pa0, pa1, pa2, pa3);
    SBAR();
    if (has_next) {
#pragma unroll
        for (int d0 = 0; d0 < 8; ++d0) qr[d0] = *(const bf16x8*)(wsb + (size_t)nxt.qoff + (unsigned)(((wid * 32 + r32) * DM + d0 * 16 + hi * 8) * 2));
    }
    SBAR();
    rg.kt = kt;
    if (has_next) WAITBAR(4); else WAITBAR(0);
    int tid2 = tid; asm volatile("" : "+v"(tid2));
    const int lane2 = tid2 & 63, r32e = lane2 & 31, hie = lane2 >> 5;
    if (hie == 0) li_l[r32e] = l_reg;
    LDS_WAIT();
    if (MODE == 0) { if (hie == 0) *(float*)(const_cast<unsigned char*>(wsb) + (size_t)cur.xoff + (unsigned)((qlo + r32e) * NH * 4)) = m_reg + log2f(l_reg); }
    LAS unsigned char* stg = (LAS unsigned char*)lds + R_OST + wid * OSTW;
    float rl[16];
#pragma unroll
    for (int r = 0; r < 16; ++r) rl[r] = __builtin_amdgcn_rcpf(li_l[crow(r, hie)]);
#pragma unroll
    for (int hf = 0; hf < 2; ++hf) {
#pragma unroll
        for (int r = 0; r < 16; ++r) { const int orow = crow(r, hie);
#pragma unroll
            for (int dd = 0; dd < 2; ++dd) *(LAS unsigned short*)(stg + orow * OSTR + (dd * 32 + r32e) * 2) = (unsigned short)(cvt_pk_bf16(o[2 * hf + dd][r] * rl[r], 0.f) & 0xffffu); }
        LDS_WAIT();
#pragma unroll
        for (int i = 0; i < 4; ++i) { const int row = i * 8 + (lane2 >> 3), ch = lane2 & 7;
            u32x4 v = *(const LAS u32x4*)(stg + row * OSTR + ch * 16);
            const unsigned go = (unsigned)(((qlo + row) * DM + hf * 64 + ch * 8) * 2);
            if (MODE == 1) { const u32x4 z = *(const u32x4*)(wsb + (size_t)cur.xoff + go);
                v.x = cvt_pk_bf16(bflo(v.x) * silu_f(bflo(z.x)), bfhi(v.x) * silu_f(bfhi(z.x))); v.y = cvt_pk_bf16(bflo(v.y) * silu_f(bflo(z.y)), bfhi(v.y) * silu_f(bfhi(z.y)));
                v.z = cvt_pk_bf16(bflo(v.z) * silu_f(bflo(z.z)), bfhi(v.z) * silu_f(bfhi(z.z))); v.w = cvt_pk_bf16(bflo(v.w) * silu_f(bflo(z.w)), bfhi(v.w) * silu_f(bfhi(z.w))); }
            *(u32x4*)(const_cast<unsigned char*>(wsb) + (size_t)cur.ooff + go) = v; }
        LDS_WAIT();
    }
    if (has_next) WAITBAR(4); else WAITBAR(0);
}
#undef DMA_K
#undef DMA_V
#undef WAITBAR
#undef SBAR
}

__device__ __forceinline__ fb::Blk blk_a(int it) {
    const int g = it >> 9, rem = it & 511, h = rem & 15, rb = rem < 256 ? (rem >> 4) : 31 - ((rem - 256) >> 4), lg = 2 * g, L = SEQ >> lg, R0 = rb * 256;
    int kb0 = R0 - 128; { const int s0 = R0 & ~(L - 1); if (kb0 < s0) kb0 = s0; }
    fb::Blk b;
    b.qoff = (unsigned)(WS_QKV + ((size_t)(3 * g) * PART + (size_t)R0 * DM + h * HD) * 2); b.koff = (unsigned)(WS_QKV + ((size_t)(3 * g + 1) * PART + h * HD) * 2); b.voff = (unsigned)(WS_QKV + ((size_t)(3 * g + 2) * PART + h * HD) * 2);
    b.ooff = (unsigned)(WS_OG + ((size_t)g * PART + h * HD) * 2); b.xoff = (unsigned)(WS_LSE + ((size_t)g * MTOK * NH + h) * 4);
    b.R0 = R0; b.kb0 = kb0; b.NT = (R0 + 256 - kb0) >> 6; b.slopeL = slope_of(h) * (float)(1 << lg) * LOG2E; b.L = L; b.base0 = 0;
    return b;
}
__device__ __forceinline__ void attn_a_pipe(unsigned char* lds, int wv) {
    CParams& P = PP();
    const int tid = otid(wv);
    const unsigned char* wsb = P.ws;
    constexpr int TOTAL = 3 * NH * (MTOK / 256);
    int it = obid(); if (it >= TOTAL) return;
    fb::Blk cur = blk_a(it);
    fb::Seam S;
    fb::prime(wsb, cur, lds, S, tid);
    for (;;) {
        const int itn = it + (int)gridDim.x; const bool last = itn >= TOTAL;
        const fb::Blk nb = last ? cur : blk_a(itn);
        const fb::Nxt nxt{nb.qoff, nb.koff, nb.voff, nb.kb0};
        fb::block<0>(wsb, cur, nxt, 0u, lds, S, tid);
        if (last) break;
        cur = nb; it = itn;
    }
}
__device__ __forceinline__ int vit_b(int it) { return (it < 256) ? ((it & 7) * 32 + (it >> 3)) : it; }
__device__ __forceinline__ fb::Blk blk_b(int it_, int pass) {
    const int it = vit_b(it_); const int bh = it >> 2, s = it & 3, b = bh >> 4, h = bh & 15, n = pass ? 7 - s : s, R0 = (b << 11) + (n << 8);
    fb::Blk k;
    k.qoff = (unsigned)(WS_QKV + ((size_t)R0 * DM + h * HD) * 2); k.koff = (unsigned)(WS_QKV + (PART + h * HD) * 2); k.voff = (unsigned)(WS_QKV + (2 * PART + h * HD) * 2);
    k.ooff = (unsigned)(WS_G + (size_t)(h * HD) * 2); k.xoff = (unsigned)(WS_Z + (size_t)(h * HD) * 2);
    k.R0 = R0; k.kb0 = b << 11; k.NT = 4 * (n + 1); k.slopeL = slope_of(h) * LOG2E; k.L = 0; k.base0 = b << 11;
    return k;
}
__device__ __forceinline__ unsigned moba_gate(const unsigned char* wsb, unsigned char* lds, int b, int h, int n, int R0, int tid) {
    unsigned sel = (1u << n) - 1u;
    if (n >= 4) {
        asm volatile("" : "+v"(tid));
        const bf16_t* QKV = (const bf16_t*)(wsb + WS_QKV); const float* KS = (const float*)(wsb + WS_KSUM);
        LAS float* gk = (LAS float*)((LAS unsigned char*)lds + fc::R_GK); LAS unsigned* sel_l = (LAS unsigned*)((LAS unsigned char*)lds + fc::R_SEL);
        for (int i = tid; i < n * 128; i += NTHREADS) { const float* kp = KS + (size_t)(b * 8 + (i >> 7)) * DM + h * HD + (i & 127); gk[i] = kp[0] + kp[(size_t)32 * DM]; }
        __syncthreads();
        const int row = tid >> 1, half = tid & 1;
        const u32x4* qp = (const u32x4*)(QKV + (size_t)(R0 + row) * DM + h * HD + half * 64);
        float gt[7];
#pragma unroll
        for (int j = 0; j < 7; ++j) gt[j] = 0.f;
#pragma unroll
        for (int c = 0; c < 8; ++c) { const u32x4 w = qp[c]; const float q0 = bflo(w.x), q1 = bfhi(w.x), q2 = bflo(w.y), q3 = bfhi(w.y), q4 = bflo(w.z), q5 = bfhi(w.z), q6 = bflo(w.w), q7 = bfhi(w.w);
#pragma unroll
            for (int j = 0; j < 7; ++j) if (j < n) { const LAS f32x4* kk = (const LAS f32x4*)(gk + j * 128 + half * 64 + c * 8); const f32x4 ka = kk[0], kb2 = kk[1];
                gt[j] += (q0 * ka.x + q1 * ka.y) + (q2 * ka.z + q3 * ka.w) + (q4 * kb2.x + q5 * kb2.y) + (q6 * kb2.z + q7 * kb2.w); } }
#pragma unroll
        for (int j = 0; j < 7; ++j) gt[j] += __shfl_xor(gt[j], 1);
        unsigned mask = 0;
#pragma unroll
        for (int j = 0; j < 7; ++j) if (j < n) { int rank = 0;
#pragma unroll
            for (int j2 = 0; j2 < 7; ++j2) if (j2 < n && (gt[j2] > gt[j] || (gt[j2] == gt[j] && j2 < j))) ++rank;
            if (rank < 3) mask |= 1u << j; }
        if (half == 0) sel_l[row] = mask;
        __syncthreads();
        sel = sel_l[(tid >> 6) * 32 + (tid & 31)];
    }
    return sel;
}
__device__ __forceinline__ void attn_b_pipe(unsigned char* lds, int wv) {
    CParams& P = PP();
    const int tid = otid(wv);
    const unsigned char* wsb = P.ws;
    constexpr int TOTAL = NB * NH * 4;
    int it = obid(); if (it >= TOTAL) return;
    int pass = 0;
    fb::Blk cur = blk_b(it, 0);
    fb::Seam S;
    fb::prime(wsb, cur, lds, S, tid);
    for (;;) {
        int itn = it, passn = pass + 1; if (passn == 2) { passn = 0; itn = it + (int)gridDim.x; }
        const bool last = itn >= TOTAL;
        const fb::Blk nb = last ? cur : blk_b(itn, passn);
        const fb::Nxt nxt{nb.qoff, nb.koff, nb.voff, nb.kb0};
        const int vi = vit_b(it), bh = vi >> 2, s = vi & 3, n = pass ? 7 - s : s;
        const unsigned sel = moba_gate(wsb, lds, bh >> 4, bh & 15, n, cur.R0, tid);
        fb::block<1>(wsb, cur, nxt, sel, lds, S, tid);
        if (last) break;
        cur = nb; it = itn; pass = passn;
    }
}

__device__ __forceinline__ fc::Blk cblk_a(int it) { const fb::Blk b = blk_a(it); const int h = it & 15, g = it >> 9;
    fc::Blk c{b.qoff, b.koff, b.voff, b.ooff, b.xoff, 0u, 0u, b.R0, b.kb0, b.NT, b.slopeL, b.L, b.base0};
    if (g == 2) { c.ooff = (unsigned)(WS_OG + (size_t)(h * HD) * 2); c.xoff = (unsigned)(WS_LSE + (size_t)h * 4); c.zoff = (unsigned)(WS_Z + (size_t)(h * HD) * 2); c.goff = (unsigned)(WS_G + (size_t)(h * HD) * 2); }
    return c; }
__device__ __forceinline__ fc::Blk cblk_b(int it, int pass) { const fb::Blk b = blk_b(it, pass); return fc::Blk{b.qoff, b.koff, b.voff, b.ooff, b.xoff, 0u, 0u, b.R0, b.kb0, b.NT, b.slopeL, b.L, b.base0}; }
template <int MODE>
__device__ __forceinline__ void attn_a_dma(unsigned char* lds, int wv, int first, int count) {
    CParams& P = PP();
    const int tid = otid(wv);
    const unsigned char* wsb = P.ws;
    int it = obid(); if (it >= count) return;
    fc::Blk cur = cblk_a(first + it);
    bf16x8 qr[8]; fc::Ring rg;
    fc::prime(wsb, cur, lds, qr, rg, tid);
    for (;;) {
        const int itn = it + (int)gridDim.x; const bool last = itn >= count;
        const fc::Blk nb = last ? cur : cblk_a(first + itn);
        const fc::Nxt nxt{nb.qoff, nb.koff, nb.voff, nb.kb0};
        fc::block<MODE>(wsb, cur, nxt, !last, 0u, lds, qr, rg, tid);
        if (last) break;
        cur = nb; it = itn;
    }
}
__device__ __forceinline__ void attn_b_dma(unsigned char* lds, int wv) {
    CParams& P = PP();
    const int tid = otid(wv);
    const unsigned char* wsb = P.ws;
    constexpr int TOTAL = NB * NH * 4;
    int it = obid(); if (it >= TOTAL) return;
    int pass = 0;
    fc::Blk cur = cblk_b(it, 0);
    bf16x8 qr[8]; fc::Ring rg;
    fc::prime(wsb, cur, lds, qr, rg, tid);
    for (;;) {
        int itn = it, passn = pass + 1; if (passn == 2) { passn = 0; itn = it + (int)gridDim.x; }
        const bool last = itn >= TOTAL;
        const fc::Blk nb = last ? cur : cblk_b(itn, passn);
        const fc::Nxt nxt{nb.qoff, nb.koff, nb.voff, nb.kb0};
        const int vi = vit_b(it), bh = vi >> 2, s = vi & 3, n = pass ? 7 - s : s;
        const unsigned sel = moba_gate(wsb, lds, bh >> 4, bh & 15, n, cur.R0, tid);
        fc::block<1>(wsb, cur, nxt, !last, sel, lds, qr, rg, tid);
        if (last) break;
        cur = nb; it = itn; pass = passn;
    }
}

__device__ __forceinline__ unsigned moba_gate2(const unsigned char* wsb, unsigned char* lds, int b, int h, int n, int R0, int tid) {
    unsigned sel = (1u << n) - 1u;
    if (n >= 4) {
        asm volatile("" : "+v"(tid));
        const int grp = tid >> 8, tin = tid & 255;
        const bf16_t* QKV = (const bf16_t*)(wsb + WS_QKV); const float* KS = (const float*)(wsb + WS_KSUM);
        LAS float* gk = (LAS float*)((LAS unsigned char*)lds + fc::R_GK) + grp * (7 * 128); LAS unsigned* sel_l = (LAS unsigned*)((LAS unsigned char*)lds + fc::R_SEL);
        for (int i = tin; i < n * 128; i += 256) { const float* kp = KS + (size_t)(b * 8 + (i >> 7)) * DM + h * HD + (i & 127); gk[i] = kp[0] + kp[(size_t)32 * DM]; }
        __syncthreads();
        const int row = grp * 128 + (tin >> 1), half = tin & 1;
        const u32x4* qp = (const u32x4*)(QKV + (size_t)(R0 + row) * DM + h * HD + half * 64);
        float gt[7];
#pragma unroll
        for (int j = 0; j < 7; ++j) gt[j] = 0.f;
#pragma unroll
        for (int c = 0; c < 8; ++c) { const u32x4 w = qp[c]; const float q0 = bflo(w.x), q1 = bfhi(w.x), q2 = bflo(w.y), q3 = bfhi(w.y), q4 = bflo(w.z), q5 = bfhi(w.z), q6 = bflo(w.w), q7 = bfhi(w.w);
#pragma unroll
            for (int j = 0; j < 7; ++j) if (j < n) { const LAS f32x4* kk = (const LAS f32x4*)(gk + j * 128 + half * 64 + c * 8); const f32x4 ka = kk[0], kb2 = kk[1];
                gt[j] += (q0 * ka.x + q1 * ka.y) + (q2 * ka.z + q3 * ka.w) + (q4 * kb2.x + q5 * kb2.y) + (q6 * kb2.z + q7 * kb2.w); } }
#pragma unroll
        for (int j = 0; j < 7; ++j) gt[j] += __shfl_xor(gt[j], 1);
        unsigned mask = 0;
#pragma unroll
        for (int j = 0; j < 7; ++j) if (j < n) { int rank = 0;
#pragma unroll
            for (int j2 = 0; j2 < 7; ++j2) if (j2 < n && (gt[j2] > gt[j] || (gt[j2] == gt[j] && j2 < j))) ++rank;
            if (rank < 3) mask |= 1u << j; }
        if (half == 0) sel_l[row] = mask;
        __syncthreads();
        sel = sel_l[(tid >> 6) * 32 + (tid & 31)];
    }
    return sel;
}
__device__ __forceinline__ void attn_a_hs(unsigned char* lds, int wv) {
    CParams& P = PP();
    const int tid = otid(wv);
    const unsigned char* wsb = P.ws;
    constexpr int TOTAL = 3 * NH * (MTOK / 256);
    int it = obid(); if (it >= TOTAL) return;
    fc::Blk cur = cblk_a(it);
    bf16x8 qr[8]; fc::Ring rg;
    fd::prime(wsb, cur, lds, qr, rg, tid);
    for (;;) {
        const int itn = it + (int)gridDim.x; const bool last = itn >= TOTAL;
        const fc::Blk nb = last ? cur : cblk_a(itn);
        const fc::Nxt nxt{nb.qoff, nb.koff, nb.voff, nb.kb0};
        fd::block<0>(wsb, cur, nxt, !last, 0u, lds, qr, rg, tid);
        if (last) break;
        cur = nb; it = itn;
    }
    fd::finish(tid);
}
__device__ __forceinline__ void attn_b_hs(unsigned char* lds, int wv) {
    CParams& P = PP();
    const int tid = otid(wv);
    const unsigned char* wsb = P.ws;
    constexpr int TOTAL = NB * NH * 4;
    int it = obid(); if (it >= TOTAL) return;
    int pass = 0;
    fc::Blk cur = cblk_b(it, 0);
    bf16x8 qr[8]; fc::Ring rg;
    fd::prime(wsb, cur, lds, qr, rg, tid);
    for (;;) {
        int itn = it, passn = pass + 1; if (passn == 2) { passn = 0; itn = it + (int)gridDim.x; }
        const bool last = itn >= TOTAL;
        const fc::Blk nb = last ? cur : cblk_b(itn, passn);
        const fc::Nxt nxt{nb.qoff, nb.koff, nb.voff, nb.kb0};
        const int vi = vit_b(it), bh = vi >> 2, s = vi & 3, n = pass ? 7 - s : s;
        const unsigned sel = moba_gate2(wsb, lds, bh >> 4, bh & 15, n, cur.R0, tid);
        fd::block<1>(wsb, cur, nxt, !last, sel, lds, qr, rg, tid);
        if (last) break;
        cur = nb; it = itn; pass = passn;
    }
    fd::finish(tid);
}

__device__ __forceinline__ void attn_a_flash(unsigned char* lds, int wv) {
    CParams& P = PP();
    const int tid = otid(wv);
    const bf16_t* QKV = (const bf16_t*)(P.ws + WS_QKV); bf16_t* OG = (bf16_t*)(P.ws + WS_OG); float* LSE = (float*)(P.ws + WS_LSE);
    for (int it = obid(); it < 3 * NH * (MTOK / 256); it += gridDim.x) {
        const int g = it >> 9, rem = it & 511, h = rem & 15, rb = rem >> 4;
        const int lg = 2 * g, L = SEQ >> lg, R0 = rb * 256;
        int krow0 = R0 - 128; { const int s0 = R0 & ~(L - 1); if (krow0 < s0) krow0 = s0; }
        const int NT = (R0 + 256 - krow0) >> 6;
        const fa::MaskA mk{L};
        fa::flash_block<0>(QKV + (size_t)(3 * g) * PART + (size_t)R0 * DM + h * HD, QKV + (size_t)(3 * g + 1) * PART + h * HD, QKV + (size_t)(3 * g + 2) * PART + h * HD,
                           krow0, NT, R0, slope_of(h) * (float)(1 << lg) * LOG2E, mk, lds, OG + (size_t)g * PART + h * HD, LSE + (size_t)g * MTOK * NH + h, nullptr, tid);
    }
}
__device__ __forceinline__ void attn_b_flash(unsigned char* lds, int wv) {
    CParams& P = PP();
    const int tid = otid(wv);
    const bf16_t* QKV = (const bf16_t*)(P.ws + WS_QKV); const bf16_t* Z = (const bf16_t*)(P.ws + WS_Z); bf16_t* G = (bf16_t*)(P.ws + WS_G); const float* KS = (const float*)(P.ws + WS_KSUM);
    LAS float* gk = (LAS float*)((LAS unsigned char*)lds + fa::OFF_GK); LAS unsigned* sel_l = (LAS unsigned*)((LAS unsigned char*)lds + fa::OFF_SEL);
    for (int it = obid(); it < NB * NH * 4; it += gridDim.x) {
        const int bh = it >> 2, s = it & 3, b = bh >> 4, h = bh & 15;
        for (int pass = 0; pass < 2; ++pass) {
            const int n = pass ? 7 - s : s, R0 = (b << 11) + (n << 8);
            unsigned sel = (1u << n) - 1u;
            if (n >= 4) {
                for (int i = tid; i < n * 128; i += NTHREADS) { const float* kp = KS + (size_t)(b * 8 + (i >> 7)) * DM + h * HD + (i & 127); gk[i] = kp[0] + kp[(size_t)32 * DM]; }
                __syncthreads();
                const int row = tid >> 1, half = tid & 1;
                const u32x4* qp = (const u32x4*)(QKV + (size_t)(R0 + row) * DM + h * HD + half * 64);
                float gt[7];
#pragma unroll
                for (int j = 0; j < 7; ++j) gt[j] = 0.f;
#pragma unroll
                for (int c = 0; c < 8; ++c) { const u32x4 w = qp[c]; const float q0 = bflo(w.x), q1 = bfhi(w.x), q2 = bflo(w.y), q3 = bfhi(w.y), q4 = bflo(w.z), q5 = bfhi(w.z), q6 = bflo(w.w), q7 = bfhi(w.w);
#pragma unroll
                    for (int j = 0; j < 7; ++j) if (j < n) { const LAS f32x4* kk = (const LAS f32x4*)(gk + j * 128 + half * 64 + c * 8); const f32x4 ka = kk[0], kb2 = kk[1];
                        gt[j] += (q0 * ka.x + q1 * ka.y) + (q2 * ka.z + q3 * ka.w) + (q4 * kb2.x + q5 * kb2.y) + (q6 * kb2.z + q7 * kb2.w); } }
#pragma unroll
                for (int j = 0; j < 7; ++j) gt[j] += __shfl_xor(gt[j], 1);
                unsigned mask = 0;
#pragma unroll
                for (int j = 0; j < 7; ++j) if (j < n) { int rank = 0;
#pragma unroll
                    for (int j2 = 0; j2 < 7; ++j2) if (j2 < n && (gt[j2] > gt[j] || (gt[j2] == gt[j] && j2 < j))) ++rank;
                    if (rank < 3) mask |= 1u << j; }
                if (half == 0) sel_l[row] = mask;
                __syncthreads();
                sel = sel_l[(tid >> 6) * 32 + (tid & 31)];
            }
            const fa::MaskB mk{R0, b << 11, sel};
            fa::flash_block<1>(QKV + (size_t)R0 * DM + h * HD, QKV + PART + h * HD, QKV + 2 * PART + h * HD, b << 11, 4 * (n + 1), R0, slope_of(h) * LOG2E, mk, lds,
                               G + h * HD, nullptr, Z + h * HD, tid);
        }
    }
}

#define XB_TMO      128
#define XB_XCNT(j)  (256  + 64 * (j))
#define XB_XSUB(j)  (1280 + 64 * (j))
#define XB_XGEN(j)  (2304 + 64 * (j))
#define XB_TOP      3328
#define XB_TOPGEN   3392
#define XCD_BAR_WORDS 3456
#define XB_SPIN_CAP (1u << 20)
__device__ __forceinline__ unsigned xb_ld(unsigned* p)              { return __hip_atomic_load(p, __ATOMIC_RELAXED, __HIP_MEMORY_SCOPE_AGENT); }
__device__ __forceinline__ unsigned xb_add(unsigned* p, unsigned v) { return __hip_atomic_fetch_add(p, v, __ATOMIC_RELAXED, __HIP_MEMORY_SCOPE_AGENT); }
__device__ __forceinline__ unsigned xb_xcc_id() { return (unsigned)__builtin_amdgcn_s_getreg((3 << 11) | 20) & 0xFu; }
#define XB_SPIN(cond, bar) do { unsigned _sp = 0; while (cond) { __builtin_amdgcn_s_sleep(1); \
    if ((++_sp & 255u) == 0u) { if (xb_ld(&(bar)[XB_TMO])) break; if (_sp > XB_SPIN_CAP) { atomicAdd(&(bar)[XB_TMO], 1u); break; } } } } while (0)
struct XcdBarrier { unsigned* bar; unsigned x; volatile LAS unsigned* st; };
__device__ __forceinline__ XcdBarrier xcd_barrier_post(unsigned* bar, volatile LAS unsigned* st) {
    XcdBarrier b; b.bar = bar; b.x = xb_xcc_id(); b.st = st;
    if (threadIdx.x == 0) (void)xb_add(&bar[XB_XCNT(b.x)], 1u);
    return b;
}
__device__ __forceinline__ void xcd_barrier_complete(unsigned* bar, unsigned x, unsigned& nloc, unsigned& nx) {
    const unsigned G = gridDim.x * gridDim.y * gridDim.z;
    unsigned sum, cnt, mine, sp = 0u;
    for (;;) {
        sum = 0u; cnt = 0u; mine = 0u;
#pragma unroll
        for (unsigned j = 0; j < 16; ++j) { const unsigned c = xb_ld(&bar[XB_XCNT(j)]); sum += c; cnt += (c > 0u) ? 1u : 0u; mine = (j == x) ? c : mine; }
        if (sum == G) break;
        __builtin_amdgcn_s_sleep(1);
        if ((++sp & 255u) == 0u) { if (xb_ld(&bar[XB_TMO])) break; if (sp > XB_SPIN_CAP) { atomicAdd(&bar[XB_TMO], 1u); break; } }
    }
    nloc = mine > 0u ? mine : 1u; nx = cnt > 0u ? cnt : 1u;
}
__device__ __forceinline__ void xcd_barrier(const XcdBarrier& b) {
    asm volatile("s_waitcnt vmcnt(0)" ::: "memory");
    __syncthreads();
    if (threadIdx.x == 0) {
        unsigned* bar = b.bar;
        __builtin_amdgcn_s_waitcnt(0);
        unsigned nloc = b.st[0], nx = b.st[1];
        if (nloc == 0u) { xcd_barrier_complete(bar, b.x, nloc, nx); b.st[0] = nloc; b.st[1] = nx; }
        const unsigned old = xb_add(&bar[XB_XSUB(b.x)], 1u);
        const unsigned gen = old / nloc;
        if (old + 1u == (gen + 1u) * nloc) {
            __builtin_amdgcn_fence(__ATOMIC_RELEASE, "agent");
            asm volatile("s_waitcnt vmcnt(0)" ::: "memory");
            const unsigned og = xb_add(&bar[XB_TOP], 1u);
            const unsigned tg = og / nx;
            if (og + 1u == (tg + 1u) * nx) xb_add(&bar[XB_TOPGEN], 1u);
            else XB_SPIN(xb_ld(&bar[XB_TOPGEN]) == tg, bar);
            __builtin_amdgcn_fence(__ATOMIC_ACQUIRE, "agent");
            xb_add(&bar[XB_XGEN(b.x)], 1u);
            asm volatile("s_waitcnt vmcnt(0)" ::: "memory");
        } else {
            XB_SPIN(xb_ld(&bar[XB_XGEN(b.x)]) == gen, bar);
            __builtin_amdgcn_fence(__ATOMIC_ACQUIRE, "agent");
            asm volatile("s_waitcnt vmcnt(0)" ::: "memory");
        }
    }
    __syncthreads();
}

__global__ void __launch_bounds__(NTHREADS, 2) fwd_mega(Params Pin) {
    extern __shared__ __attribute__((aligned(16))) unsigned char lds[];
#if USE_CG_SYNC
    cg::grid_group grid = cg::this_grid();
#endif
    LAS unsigned char* lds3 = (LAS unsigned char*)lds;
    (void)Pin;
    const int wv = __builtin_amdgcn_readfirstlane((int)threadIdx.x >> 6);
    volatile LAS unsigned* bst = (volatile LAS unsigned*)(lds3 + (LDS_BYTES - 64));
    if (threadIdx.x < 2) bst[threadIdx.x] = 0u;
    __syncthreads();
    (void)xcd_barrier_post((unsigned*)(PP().ws + WS_CTL), bst);
#define GSYNC() do { XcdBarrier xb_; xb_.bar = (unsigned*)(PP().ws + WS_CTL); xb_.x = xb_xcc_id(); xb_.st = bst; xcd_barrier(xb_); } while (0)
    p0_mod(lds, wv);
    p0_weights(lds, wv);
#if PROBE == 1
    __syncthreads(); p0_mod(lds, wv); p0_weights(lds, wv);
#endif
#if USE_CG_SYNC
    grid.sync();
#else
    GSYNC();
#endif
    for (int layer = 0; layer < DEPTH; ++layer) {
        const bool isA = (layer & 1) == 0; const int j = layer >> 1;
        norm_phase(layer, !isA && !MOBA_QK_I8, wv);
#if PROBE == 2
        norm_phase(layer, !isA && !MOBA_QK_I8, wv);
#endif
#if PROBE == 6
        GSYNC(); GSYNC(); GSYNC(); GSYNC(); GSYNC();
#endif
        GSYNC();
        {
#if !MOBA_QK_I8
            if (!isA) {
                unsigned char* ws = PP().ws;
                pg8::Gemm g{ws + WS_H, ws + WS_WBQK + (size_t)j * 4096 * DM * 2, MTOK, 4096, DM * 2};
                pg8::StaticOrder S; S.init(MTOK, 4096, (int)gridDim.x, obid());
                pg8::Epi E{1, 0, (bf16_t*)(ws + WS_QKV), (bf16_t*)(ws + WS_Z), (float*)(ws + WS_KSUM), nullptr, nullptr, nullptr, nullptr, nullptr};
                pg8::gemm_phase<pg8::Epi, pg8::StaticOrder, GEMM_ALIGN, GEMM_SP2, false>(lds3, g, S, E, wv);
            }
#endif
            {
                unsigned char* ws = PP().ws;
#if MOBA_QK_I8
                pg8::Gemm g{ws + WS_HQ, isA ? ws + WS_WAIN + (size_t)j * A_N * DM : ws + WS_WBQK + (size_t)j * B_N * DM, MTOK, isA ? A_N : B_N, DM};
                pg8::StaticOrder S; S.init(MTOK, g.N, (int)gridDim.x, obid());
                pg8::Epi E{isA ? 0 : 1, 0, (bf16_t*)(ws + WS_QKV), (bf16_t*)(ws + WS_Z), (float*)(ws + WS_KSUM), (const float*)(ws + WS_RS),
                           isA ? (const float*)(ws + WS_CSA) + j * A_N : (const float*)(ws + WS_CSB) + j * B_N, nullptr, nullptr, nullptr};
#else
                pg8::Gemm g{ws + WS_HQ, isA ? ws + WS_WAIN + (size_t)j * A_N * DM : ws + WS_WBVZ + (size_t)j * 4096 * DM, MTOK, isA ? A_N : 4096, DM};
                pg8::StaticOrder S; S.init(MTOK, g.N, (int)gridDim.x, obid());
                pg8::Epi E{isA ? 0 : 1, isA ? 0 : 2, (bf16_t*)(ws + WS_QKV), (bf16_t*)(ws + WS_Z), nullptr, (const float*)(ws + WS_RS),
                           isA ? (const float*)(ws + WS_CSA) + j * A_N : (const float*)(ws + WS_CSB) + j * 4096, nullptr, nullptr, nullptr};
#endif
#if STAGGER_TICKS > 0
                if (isA) {
                    const unsigned long long t0_ = __builtin_amdgcn_s_memrealtime(); const unsigned long long dl_ = (unsigned long long)((obid() >> 3) & 7) * STAGGER_TICKS;
                    while (__builtin_amdgcn_s_memrealtime() - t0_ < dl_) __builtin_amdgcn_s_sleep(8);
                }
#endif
                pg8::gemm_phase<pg8::Epi, pg8::StaticOrder, GEMM_ALIGN, GEMM_SP2, true>(lds3, g, S, E, wv);
#if PROBE == 7
                pg8::gemm_phase<pg8::Epi, pg8::StaticOrder, GEMM_ALIGN, GEMM_SP2, true>(lds3, g, S, E, wv);
#endif
#if PROBE == 12 || PROBE == 13
                if (isA) { pg8::Epi E3 = E; E3.mode = PROBE == 12 ? 6 : 7; E3.qkv = (bf16_t*)(ws + WS_OG); pg8::gemm_phase<pg8::Epi, pg8::StaticOrder, GEMM_ALIGN, GEMM_SP2, true>(lds3, g, S, E3, wv); }
#endif
#if PROBE == 10 || PROBE == 11
                if (isA) { pg8::Epi E3 = E; E3.mode = PROBE == 10 ? 4 : 5; E3.qkv = (bf16_t*)(ws + WS_OG); pg8::gemm_phase<pg8::Epi, pg8::StaticOrder, GEMM_ALIGN, GEMM_SP2, true>(lds3, g, S, E3, wv); }
#endif
#if PROBE == 9
                { pg8::Epi E3 = E; E3.mode = 3; pg8::gemm_phase<pg8::Epi, pg8::StaticOrder, GEMM_ALIGN, GEMM_SP2, true>(lds3, g, S, E3, wv); }
#endif
            }
        }
        GSYNC();
#if PROBE == 3
        if (isA) attn_a_dma<0>(lds, wv, 0, 1024);
#endif
#if PROBE == 4
        if (!isA) attn_b_hs(lds, wv);
#endif
#if ATTN_HS
        if (isA) { attn_a_hs(lds, wv); GSYNC(); combine_phase(wv);
#elif ATTN_DMA
#if FUSE_COMBINE && !OUTA_I8
        if (isA) { attn_a_dma<0>(lds, wv, 0, 1024); GSYNC(); attn_a_dma<2>(lds, wv, 1024, 512);
#if PROBE == 14
            attn_a_dma<2>(lds, wv, 1024, 512);
#endif
#else
        if (isA) { attn_a_dma<0>(lds, wv, 0, 1536); GSYNC(); combine_phase(wv);
#endif
#elif ATTN_PIPE
        if (isA) { attn_a_pipe(lds, wv); GSYNC(); combine_phase(wv);
#else
        if (isA) { attn_a_flash(lds, wv); GSYNC(); combine_phase(wv);
#endif
#if PROBE == 5
            combine_phase(wv);
#endif
        }
#if ATTN_HS
        else { attn_b_hs(lds, wv); }
#elif ATTN_DMA
        else { attn_b_dma(lds, wv); }
#elif ATTN_PIPE
        else { attn_b_pipe(lds, wv); }
#else
        else { attn_b_flash(lds, wv); }
#endif
        GSYNC();
        {
            CParams& P = PP(); unsigned char* ws = P.ws;
            const bool i8o = OUTA_I8 && isA;
            pg8::Gemm g{i8o ? ws + WS_HQ : ws + WS_G, isA ? ws + WS_WAOUT + (size_t)j * DM * DM * (OUTA_I8 ? 1 : 2) : ws + WS_WBOUT + (size_t)j * DM * DM * 2, MTOK, DM, i8o ? DM : DM * 2};
            pg8::StaticOrder S; S.init(MTOK, DM, (int)gridDim.x, obid());
            pg8::Epi E{2, 0, nullptr, nullptr, nullptr, (const float*)(ws + WS_RS), (const float*)(ws + WS_CSO) + j * DM, layer == 0 ? P.x : P.out, P.out, (const float*)(ws + WS_MOD) + (size_t)layer * 4 * 6144 + 4096};
            {
                pg8::Unit u0; int ui = 0;
                while (S.next(ui, u0)) { const int t_ = otid(wv); const int w_ = __builtin_amdgcn_readfirstlane(t_ >> 6);
                    const float* xt = E.xin + (size_t)(u0.pm * 256 + (t_ >> 1)) * DM + u0.pn * 256 + (t_ & 1) * 128;
#pragma unroll
                    for (int q = 0; q < 4; ++q) __builtin_amdgcn_global_load_lds((const unsigned*)(xt + q * 32), (LAS unsigned*)(lds3 + 131072 + w_ * 1024 + q * 256), 4, 0, 0);
                    ++ui; } }
#if OUTA_I8
            if (isA) pg8::gemm_phase<pg8::Epi, pg8::StaticOrder, GEMM_ALIGN, GEMM_SP2, true>(lds3, g, S, E, wv);
            else
#endif
            pg8::gemm_phase<pg8::Epi, pg8::StaticOrder, GEMM_ALIGN, GEMM_SP2, false>(lds3, g, S, E, wv);
        }
        GSYNC();
    }
    final_norm_phase(wv);
}

extern "C" void kernel_launch(void* const* d_in, const int* in_sizes, int n_in, void* d_out, int out_size, void* d_ws, size_t ws_size, hipStream_t stream) {
    static int grid = 0;
    if (grid == 0) {
        if (n_in != 10 || in_sizes[0] != MTOK * DM || out_size != MTOK * DM || ws_size < WS_END) {
            fprintf(stderr, "kernel_launch: unexpected shapes/workspace (n_in %d, in0 %d, out %d, ws %zu, need %zu)\n", n_in, n_in > 0 ? in_sizes[0] : -1, out_size, ws_size, (size_t)WS_END); grid = -1; return; }
        int dev = 0, cus = 0, per_cu = 0;
        (void)hipGetDevice(&dev); (void)hipDeviceGetAttribute(&cus, hipDeviceAttributeMultiprocessorCount, dev);
        if (hipFuncSetAttribute((const void*)fwd_mega, hipFuncAttributeMaxDynamicSharedMemorySize, LDS_BYTES) != hipSuccess) { fprintf(stderr, "kernel_launch: hipFuncSetAttribute failed\n"); grid = -1; return; }
        if (hipOccupancyMaxActiveBlocksPerMultiprocessor(&per_cu, (const void*)fwd_mega, NTHREADS, LDS_BYTES) != hipSuccess || per_cu < 1) { fprintf(stderr, "kernel_launch: occupancy query says %d\n", per_cu); (void)hipGetLastError(); per_cu = 1; }
        if (per_cu > 1) per_cu = 1;
        grid = cus * per_cu;
    }
    if (grid < 0) return;
    (void)hipMemsetAsync((char*)d_ws + WS_CTL, 0, 16384, stream);
    Params p{};
    p.x = (const float*)d_in[0]; p.c = (const float*)d_in[1]; p.norm_w = (const float*)d_in[2]; p.mod_w = (const float*)d_in[3]; p.mod_b = (const float*)d_in[4];
    p.a_w_in = (const float*)d_in[5]; p.a_w_out = (const float*)d_in[6]; p.b_w_in = (const float*)d_in[7]; p.b_w_out = (const float*)d_in[8]; p.final_w = (const float*)d_in[9];
    p.out = (float*)d_out; p.ws = (unsigned char*)d_ws;
    void* args[] = {&p};
    hipError_t e = hipLaunchCooperativeKernel((const void*)fwd_mega, dim3(grid), dim3(NTHREADS), args, LDS_BYTES, stream);
    if (e != hipSuccess) fprintf(stderr, "kernel_launch: cooperative launch failed: %s (grid %d)\n", hipGetErrorString(e), grid);
}
```

```cpp
#include <hip/hip_runtime.h>
#include <hip/hip_cooperative_groups.h>
#include <cstdio>
#include <cstdint>
namespace cg = cooperative_groups;
#ifndef ATTN_A_FLASH
#define ATTN_A_FLASH 1
#endif
#ifndef GEMM_ALIGN
#define GEMM_ALIGN true
#endif
#ifndef GEMM_SP2
#define GEMM_SP2 true
#endif
#ifndef PROBE
#define PROBE 0
#endif
#ifndef MOBA_QK_I8
#define MOBA_QK_I8 1
#endif
#ifndef OUTA_I8
#define OUTA_I8 0
#endif
#ifndef GCLIP
#define GCLIP 1.0e9f
#endif
#ifndef STAGGER_TICKS
#define STAGGER_TICKS 0
#endif
#ifndef USE_CG_SYNC
#define USE_CG_SYNC 0
#endif
#ifndef ATTN_PIPE
#define ATTN_PIPE 1
#endif
#ifndef FUSE_NORM
#define FUSE_NORM 1
#endif
#ifndef EPI_SC1
#define EPI_SC1 1
#endif
#ifndef FUSE_COMBINE
#define FUSE_COMBINE 1
#endif
#ifndef ATTN_DMA
#define ATTN_DMA 1
#endif
#ifndef ATTN_HS
#define ATTN_HS 0
#endif
#ifndef ATTN_B_FLASH
#define ATTN_B_FLASH 1
#endif

#define LAS __attribute__((address_space(3)))
typedef unsigned short bf16_t;
typedef short bf16x8 __attribute__((ext_vector_type(8)));
typedef short s16x4 __attribute__((ext_vector_type(4)));
typedef float f32x4 __attribute__((ext_vector_type(4)));
typedef float f32x16 __attribute__((ext_vector_type(16)));
typedef unsigned u32x4 __attribute__((ext_vector_type(4)));
typedef unsigned u32x2 __attribute__((ext_vector_type(2)));
typedef int i32x4 __attribute__((ext_vector_type(4)));

constexpr int NB = 4, SEQ = 2048, DM = 2048, MTOK = NB * SEQ, NH = 16, HD = 128, DEPTH = 4;
constexpr int A_N = 10 * DM, B_N = 4 * DM;
constexpr float EPS = 1e-6f;
constexpr float LOG2E = 1.4426950408889634f;
constexpr float C2Q = 0.08838834764831845f * LOG2E;

constexpr size_t MiB = 1u << 20;
constexpr size_t WS_CTL = 0;
constexpr size_t WS_MOD = 1 * MiB;
constexpr size_t WS_KSUM = 2 * MiB;
constexpr size_t WS_LSE = 3 * MiB;
constexpr size_t WS_XS = 4 * MiB;
constexpr size_t WS_RS = 5 * MiB;
constexpr size_t WS_CSA = 6 * MiB;
constexpr size_t WS_CSB = 7 * MiB;
constexpr size_t WS_CSO = 7 * MiB + 512 * 1024;
constexpr size_t WS_WAIN = 8 * MiB;
constexpr size_t WS_WBQK = WS_WAIN + 80 * MiB;
constexpr size_t WS_WBVZ = WS_WBQK + 32 * MiB;
constexpr size_t WS_WAOUT = WS_WBVZ + 16 * MiB;
constexpr size_t WS_WBOUT = WS_WAOUT + 16 * MiB;
constexpr size_t WS_H = WS_WBOUT + 16 * MiB;
constexpr size_t WS_HQ = WS_H + 32 * MiB;
constexpr size_t WS_G = WS_HQ + 16 * MiB;
constexpr size_t WS_QKV = WS_G + 32 * MiB;
constexpr size_t WS_Z = WS_QKV + 288 * MiB;
constexpr size_t WS_OG = WS_Z + 32 * MiB;
constexpr size_t WS_END = WS_OG + 96 * MiB;
constexpr size_t PART = (size_t)MTOK * DM;

constexpr int LDS_BYTES = 147456;
constexpr int NTHREADS = 512;

typedef float f32x2_t __attribute__((ext_vector_type(2))); typedef __bf16 bf16x2_t __attribute__((ext_vector_type(2)));
__device__ __forceinline__ unsigned cvt_pk_bf16(float lo, float hi) { f32x2_t v = {lo, hi}; bf16x2_t b = __builtin_convertvector(v, bf16x2_t); return __builtin_bit_cast(unsigned, b); }
__device__ __forceinline__ float bf2f(unsigned short v) { return __uint_as_float(((unsigned)v) << 16); }
__device__ __forceinline__ float bflo(unsigned w) { return __uint_as_float(w << 16); }
__device__ __forceinline__ float bfhi(unsigned w) { return __uint_as_float(w & 0xffff0000u); }
__device__ __forceinline__ float wave_sum(float v) {
#pragma unroll
    for (int o = 1; o < 64; o <<= 1) v += __shfl_xor(v, o);
    return v;
}
__device__ __forceinline__ float wave_max(float v) {
#pragma unroll
    for (int o = 1; o < 64; o <<= 1) v = fmaxf(v, __shfl_xor(v, o));
    return v;
}
__device__ __forceinline__ float silu_f(float v) { return v * __builtin_amdgcn_rcpf(1.f + __builtin_amdgcn_exp2f(-1.4426950408889634f * v)); }
#define LDS_WAIT() asm volatile("s_waitcnt lgkmcnt(0)" ::: "memory")
template <class V> __device__ __forceinline__ void store_wt(void* p, V v) { static_assert(sizeof(V) == 16, "16-byte vectors only");
    asm volatile("global_store_dwordx4 %0, %1, off sc0 sc1\n\ts_nop 1" :: "v"(p), "v"(v) : "memory"); }
__device__ __forceinline__ int otid(int wv) { int l; asm volatile("v_mbcnt_lo_u32_b32 %0, -1, 0\n\tv_mbcnt_hi_u32_b32 %0, -1, %0" : "=v"(l)); return (wv << 6) | l; }
template <class T> __device__ __forceinline__ T* optr(T* p) { asm volatile("" : "+s"(p)); return p; }
__device__ __forceinline__ int obid() { int b = blockIdx.x; asm volatile("" : "+s"(b)); return b; }

namespace pg8 {
constexpr int BM = 256, BK = 64, HALF = 128, HTB = HALF * BK * 2, STAGE_BYTES = 8 * HTB, NXCD = 8, WGM = 4;
__host__ __device__ __forceinline__ int lds_byte(int r, int c) { const int st = (r >> 4) * 2 + (c >> 5), rr = r & 15, cc = c & 31, ob = rr * 64 + cc * 2; return st * 1024 + (ob ^ (((ob >> 9) & 1) << 5)); }
__host__ __device__ __forceinline__ void stage_rc(int b, int& R, int& C) { const int st = b / 1024, sb = b % 1024, swz = sb ^ (((sb >> 9) & 1) << 5); R = (st >> 1) * 16 + swz / 64; C = (st & 1) * 32 + (swz % 64) / 2; }
__host__ __device__ __forceinline__ int perm32(int rho) { const int n = rho >> 4, i = rho & 15; return 8 * (i >> 2) + 4 * n + (i & 3); }
struct Unit { int pm, pn; };
struct Gemm { const void* A; const void* Bt; int M, N, KB; };
struct StaticOrder {
    int nM, nN, nwg, G, c;
    __host__ __device__ void init(int M, int N, int G_, int c_) { nM = M / BM; nN = N / BM; nwg = nM * nN; G = G_; c = c_; }
    __host__ __device__ bool next(int i, Unit& u) const {
        const long L = (long)i * G + c; if (L >= nwg) return false;
        int wgid = (int)L; { const int q = nwg / NXCD, r = nwg % NXCD, xcd = wgid % NXCD, off = wgid / NXCD; wgid = (xcd < r ? xcd * (q + 1) : r * (q + 1) + (xcd - r) * q) + off; }
        const int nig = WGM * nN, gid = wgid / nig, fm = gid * WGM, gsz = (nM - fm) < WGM ? (nM - fm) : WGM;
        u.pm = fm + ((wgid % nig) % gsz); u.pn = (wgid % nig) / gsz; return true;
    }
    __device__ __forceinline__ void a_ready(const Unit&) const {}
    __device__ __forceinline__ void done(const Unit&) const {}
};

__device__ __forceinline__ f32x4 acc_f32(const f32x4& a) { return a; }
__device__ __forceinline__ f32x4 acc_f32(const i32x4& a) { return (f32x4){(float)a.x, (float)a.y, (float)a.z, (float)a.w}; }
struct Epi {
    static constexpr bool PERM = true, AFTER_DRAIN = false;
    int mode;
    int pbase;
    bf16_t* qkv; bf16_t* zbuf; float* ksum;
    const float* rs; const float* cs;
    const float* xin; float* xout; const float* gate;
    template <class AccT>
    __device__ __forceinline__ void operator()(const AccT (&acc)[2][2][4][2], const Unit& u, int wr, int wc, int fr, int fq) const {
        constexpr bool I8 = sizeof(AccT) == sizeof(i32x4) && !__is_same(AccT, f32x4);
        if (mode == 3) {
#pragma unroll
            for (int ai = 0; ai < 2; ++ai)
#pragma unroll
                for (int bj = 0; bj < 2; ++bj)
#pragma unroll
                    for (int m = 0; m < 4; ++m)
#pragma unroll
                        for (int n = 0; n < 2; ++n) asm volatile("" :: "v"(acc[ai][bj][m][n]));
            return; }
        if (mode == 2) {
            const int col0 = u.pn * BM + wc * 64 + 8 * fq; const int b = (u.pm * BM) >> 11;
            f32x4 gv[2][2];
#pragma unroll
            for (int bj = 0; bj < 2; ++bj)
#pragma unroll
                for (int n = 0; n < 2; ++n) { gv[bj][n] = *(const f32x4*)(gate + b * 6144 + col0 + bj * 32 + 4 * n); if (I8) gv[bj][n] = gv[bj][n] * *(const f32x4*)(cs + col0 + bj * 32 + 4 * n); }
#pragma unroll
            for (int ai = 0; ai < 2; ++ai) {
                f32x4 xv[4][2][2]; float rsv[4];
#pragma unroll
                for (int m = 0; m < 4; ++m) { const int row = u.pm * BM + ai * HALF + wr * 64 + m * 16 + fr; const size_t off = (size_t)row * DM + col0; rsv[m] = I8 ? rs[row] : 1.f;
#pragma unroll
                    for (int bj = 0; bj < 2; ++bj)
#pragma unroll
                        for (int n = 0; n < 2; ++n) xv[m][bj][n] = *(const f32x4*)(xin + off + bj * 32 + 4 * n); }
                asm volatile("" ::: "memory");
#pragma unroll
                for (int m = 0; m < 4; ++m) { const size_t off = (size_t)(u.pm * BM + ai * HALF + wr * 64 + m * 16 + fr) * DM + col0;
#pragma unroll
                    for (int bj = 0; bj < 2; ++bj)
#pragma unroll
                        for (int n = 0; n < 2; ++n) *(f32x4*)(xout + off + bj * 32 + 4 * n) = xv[m][bj][n] + gv[bj][n] * (acc_f32(acc[ai][bj][m][n]) * rsv[m]); }
                asm volatile("" ::: "memory"); }
            return;
        }
        const int p = pbase + (u.pn >> 3), colt = (u.pn & 7) * BM;
        int lg = 0; float sc = 1.f; bf16_t* base;
        const bool pr_nostore = mode == 4, pr_window = mode == 5, pr_pitch = mode >= 6;
        const int ldo = mode == 6 ? 2112 : DM;
        if (mode == 0 || mode >= 4) { if (p == 9) base = zbuf; else { const int g = p / 3, kind = p - 3 * g; lg = 2 * g; base = qkv + (size_t)p * PART; if (kind == 0) sc = C2Q; } }
        else { if (p == 3) base = zbuf; else { base = qkv + (size_t)p * PART; if (p == 0) sc = C2Q; } }
        const int col0 = colt + wc * 64 + 8 * fq;
        f32x4 cv[2][2];
        if (I8) {
#pragma unroll
            for (int bj = 0; bj < 2; ++bj)
#pragma unroll
                for (int n = 0; n < 2; ++n) cv[bj][n] = *(const f32x4*)(cs + u.pn * BM + wc * 64 + 8 * fq + bj * 32 + 4 * n) * sc;
        }
        float rsa[2][4];
#pragma unroll
        for (int ai = 0; ai < 2; ++ai)
#pragma unroll
            for (int m = 0; m < 4; ++m) rsa[ai][m] = I8 ? rs[u.pm * BM + ai * HALF + wr * 64 + m * 16 + fr] : sc;
#pragma unroll
        for (int ai = 0; ai < 2; ++ai)
#pragma unroll
            for (int m = 0; m < 4; ++m) {
                const int row = u.pm * BM + ai * HALF + wr * 64 + m * 16 + fr, b = row >> 11, t = row & 2047;
                const int R = (b << 11) + ((t & ((1 << lg) - 1)) << (11 - lg)) + (t >> lg);
                bf16_t* rowp = pr_pitch ? (qkv + (size_t)(p % 3) * 4096 * 2112 + (size_t)(R & 4095) * ldo + col0) : (base + (size_t)(pr_window ? (R & 255) : R) * DM + col0);
                const float rsv = rsa[ai][m];
#pragma unroll
                for (int bj = 0; bj < 2; ++bj) { f32x4 v0 = acc_f32(acc[ai][bj][m][0]) * rsv, v1 = acc_f32(acc[ai][bj][m][1]) * rsv;
                    if (I8) { v0 = v0 * cv[bj][0]; v1 = v1 * cv[bj][1]; }
                    u32x4 w; w.x = cvt_pk_bf16(v0[0], v0[1]); w.y = cvt_pk_bf16(v0[2], v0[3]); w.z = cvt_pk_bf16(v1[0], v1[1]); w.w = cvt_pk_bf16(v1[2], v1[3]);
                    if (pr_nostore) asm volatile("" :: "v"(w));
                    else {
#if EPI_SC1
                        asm volatile("global_store_dwordx4 %0, %1, off sc0 sc1\n\ts_nop 1" :: "v"(rowp + bj * 32), "v"(w) : "memory");
#else
                        *(u32x4*)(rowp + bj * 32) = w;
#endif
                    } } }
        if (mode == 1 && p == 1) {
#pragma unroll
            for (int bj = 0; bj < 2; ++bj)
#pragma unroll
                for (int n = 0; n < 2; ++n) { f32x4 s = {0.f, 0.f, 0.f, 0.f};
#pragma unroll
                    for (int ai = 0; ai < 2; ++ai)
#pragma unroll
                        for (int m = 0; m < 4; ++m) s += acc_f32(acc[ai][bj][m][n]) * (I8 ? rsa[ai][m] : 1.f);
                    if (I8) s = s * cv[bj][n];
#pragma unroll
                    for (int j = 0; j < 4; ++j) { float v = s[j]; v += __shfl_xor(v, 1); v += __shfl_xor(v, 2); v += __shfl_xor(v, 4); v += __shfl_xor(v, 8); s[j] = v; }
                    if (fr == 0) *(f32x4*)(ksum + ((size_t)(wr * 32 + u.pm) * DM + colt + bj * 32 + wc * 64 + 8 * fq + 4 * n)) = s; }
        }
    }
};

template <bool LASTL> struct EpiOutF {
    static constexpr bool PERM = true, AFTER_DRAIN = true;
    const float* xin; float* xout; const float* gate;
    const float* ca_w; const float* ca_scale; const float* cs_shift;
    unsigned char* hq; float* rsq; float* xs; unsigned* cnt;
    static constexpr bool last = LASTL;
    __device__ __forceinline__ void wait_cnt(unsigned* c, int wid) const {
        if (wid == 0) { unsigned sp = 0;
            while ((unsigned)__builtin_amdgcn_readfirstlane((int)__hip_atomic_load(c, __ATOMIC_RELAXED, __HIP_MEMORY_SCOPE_AGENT)) < 8u) { __builtin_amdgcn_s_sleep(1); if (++sp > (1u << 22)) break; }
            __builtin_amdgcn_fence(__ATOMIC_ACQUIRE, "agent"); asm volatile("s_waitcnt vmcnt(0)" ::: "memory"); }
        __syncthreads(); }
    __device__ __forceinline__ void fused(f32x4 (&acc)[2][2][4][2], const Unit& u, int wr, int wc, int fr, int fq, LAS unsigned char* lds, int wid, int lane) const {
        asm volatile("" : "+v"(fr), "+v"(fq), "+v"(lane));
        const int tid = wid * 64 + lane, b = (u.pm * BM) >> 11, col0 = u.pn * BM + wc * 64 + 8 * fq;
        LAS float* P = (LAS float*)lds;
        LAS float* T = (LAS float*)(lds + 4096);
        { f32x4 gv[2][2];
#pragma unroll
          for (int bj = 0; bj < 2; ++bj)
#pragma unroll
              for (int n = 0; n < 2; ++n) gv[bj][n] = *(const f32x4*)(gate + b * 6144 + col0 + bj * 32 + 4 * n);
#pragma unroll
          for (int ai = 0; ai < 2; ++ai)
#pragma unroll
            for (int mp = 0; mp < 2; ++mp) {
              f32x4 xv[2][2][2];
#pragma unroll
              for (int mm = 0; mm < 2; ++mm) { const int m = 2 * mp + mm; const size_t off = (size_t)(u.pm * BM + ai * HALF + wr * 64 + m * 16 + fr) * DM + col0;
#pragma unroll
                  for (int bj = 0; bj < 2; ++bj)
#pragma unroll
                      for (int n = 0; n < 2; ++n) xv[mm][bj][n] = *(const f32x4*)(xin + off + bj * 32 + 4 * n); }
              asm volatile("" ::: "memory");
#pragma unroll
              for (int mm = 0; mm < 2; ++mm) { const int m = 2 * mp + mm; const size_t off = (size_t)(u.pm * BM + ai * HALF + wr * 64 + m * 16 + fr) * DM + col0;
#pragma unroll
                  for (int bj = 0; bj < 2; ++bj)
#pragma unroll
                      for (int n = 0; n < 2; ++n) { acc[ai][bj][m][n] = xv[mm][bj][n] + gv[bj][n] * acc[ai][bj][m][n]; if constexpr (!LASTL) *(f32x4*)(xout + off + bj * 32 + 4 * n) = acc[ai][bj][m][n]; }
                  asm volatile("" : "+v"(acc[ai][0][m][0]), "+v"(acc[ai][0][m][1]), "+v"(acc[ai][1][m][0]), "+v"(acc[ai][1][m][1])); }
              asm volatile("" ::: "memory"); __builtin_amdgcn_sched_barrier(0); } }
#pragma unroll
        for (int ai = 0; ai < 2; ++ai)
#pragma unroll
            for (int m = 0; m < 4; ++m) { float q = 0.f;
#pragma unroll
                for (int bj = 0; bj < 2; ++bj)
#pragma unroll
                    for (int n = 0; n < 2; ++n) { const f32x4 v = acc[ai][bj][m][n]; q += (v[0] * v[0] + v[1] * v[1]) + (v[2] * v[2] + v[3] * v[3]); }
                q += __uint_as_float((unsigned)__builtin_amdgcn_ds_swizzle((int)__float_as_uint(q), (16 << 10) | 0x1f)); { auto r_ = __builtin_amdgcn_permlane32_swap(__float_as_uint(q), __float_as_uint(q), false, false); q = __uint_as_float(r_[0]) + __uint_as_float(r_[1]); }
                if (fq == 0) P[(ai * HALF + wr * 64 + m * 16 + fr) * 4 + wc] = q;
                __builtin_amdgcn_sched_barrier(0); }
        __syncthreads();
        if (tid < 256) { const float t = (P[tid * 4 + 0] + P[tid * 4 + 1]) + (P[tid * 4 + 2] + P[tid * 4 + 3]);
            __hip_atomic_store(xs + ((size_t)(u.pm * BM + tid) * 8 + u.pn), t, __ATOMIC_RELAXED, __HIP_MEMORY_SCOPE_AGENT); }
        asm volatile("s_waitcnt vmcnt(0)" ::: "memory");
        __syncthreads();
        if (tid == 0) __hip_atomic_fetch_add(cnt + 128 * u.pm, 1u, __ATOMIC_RELAXED, __HIP_MEMORY_SCOPE_AGENT);
        wait_cnt(cnt + 128 * u.pm, wid);
        if (tid < 256) { const float* sl = xs + (size_t)(u.pm * BM + tid) * 8; float t = 0.f;
#pragma unroll
            for (int k = 0; k < 8; ++k) t += __hip_atomic_load(sl + k, __ATOMIC_RELAXED, __HIP_MEMORY_SCOPE_AGENT);
            T[tid] = 1.0f / sqrtf(t * (1.f / DM) + EPS); }
        __syncthreads();
        f32x4 cav[2][2], csv[2][2];
#pragma unroll
        for (int bj = 0; bj < 2; ++bj)
#pragma unroll
            for (int n = 0; n < 2; ++n) { const int c = col0 + bj * 32 + 4 * n; const f32x4 w = *(const f32x4*)(ca_w + c);
                if constexpr (LASTL) { cav[bj][n] = w; csv[bj][n] = (f32x4){0.f, 0.f, 0.f, 0.f}; }
                else { cav[bj][n] = w * (*(const f32x4*)(ca_scale + b * 6144 + c) + 1.f); csv[bj][n] = *(const f32x4*)(cs_shift + b * 6144 + c); } }
        if constexpr (LASTL) {
            asm volatile("" : "+v"(fr));
#pragma unroll
            for (int ai = 0; ai < 2; ++ai)
#pragma unroll
                for (int m = 0; m < 4; ++m) { const int rl = ai * HALF + wr * 64 + m * 16 + fr; const float rs = T[rl]; const size_t off = (size_t)(u.pm * BM + rl) * DM + col0;
#pragma unroll
                    for (int bj = 0; bj < 2; ++bj)
#pragma unroll
                        for (int n = 0; n < 2; ++n) *(f32x4*)(xout + off + bj * 32 + 4 * n) = acc[ai][bj][m][n] * rs * cav[bj][n]; }
        } else {
        LAS float* P2 = (LAS float*)(lds + 8192); LAS float* T2 = (LAS float*)(lds + 12288);
#pragma unroll
        for (int ai = 0; ai < 2; ++ai)
#pragma unroll
            for (int m = 0; m < 4; ++m) { const int rl = ai * HALF + wr * 64 + m * 16 + fr; const float rs = T[rl]; float am = 0.f;
#pragma unroll
                for (int bj = 0; bj < 2; ++bj)
#pragma unroll
                    for (int n = 0; n < 2; ++n) { const f32x4 h = acc[ai][bj][m][n] * rs * cav[bj][n] + csv[bj][n]; acc[ai][bj][m][n] = h;
                        am = fmaxf(am, fmaxf(fmaxf(fabsf(h[0]), fabsf(h[1])), fmaxf(fabsf(h[2]), fabsf(h[3])))); }
                am = fmaxf(am, __uint_as_float((unsigned)__builtin_amdgcn_ds_swizzle((int)__float_as_uint(am), (16 << 10) | 0x1f))); { auto r_ = __builtin_amdgcn_permlane32_swap(__float_as_uint(am), __float_as_uint(am), false, false); am = fmaxf(__uint_as_float(r_[0]), __uint_as_float(r_[1])); }
                if (fq == 0) P2[rl * 4 + wc] = am;
                __builtin_amdgcn_sched_barrier(0); }
        __syncthreads();
        if (tid < 256) { const float t = fmaxf(fmaxf(P2[tid * 4 + 0], P2[tid * 4 + 1]), fmaxf(P2[tid * 4 + 2], P2[tid * 4 + 3]));
            __hip_atomic_store(xs + (size_t)MTOK * 8 + ((size_t)(u.pm * BM + tid) * 8 + u.pn), t, __ATOMIC_RELAXED, __HIP_MEMORY_SCOPE_AGENT); }
        asm volatile("s_waitcnt vmcnt(0)" ::: "memory");
        __syncthreads();
        if (tid == 0) __hip_atomic_fetch_add(cnt + 128 * u.pm + 64, 1u, __ATOMIC_RELAXED, __HIP_MEMORY_SCOPE_AGENT);
        wait_cnt(cnt + 128 * u.pm + 64, wid);
        if (tid < 256) { const float* sl = xs + (size_t)MTOK * 8 + (size_t)(u.pm * BM + tid) * 8; float t = 0.f;
#pragma unroll
            for (int k = 0; k < 8; ++k) t = fmaxf(t, __hip_atomic_load(sl + k, __ATOMIC_RELAXED, __HIP_MEMORY_SCOPE_AGENT));
            T2[tid] = t > 0.f ? 127.f / t : 0.f;
            if (u.pn == 0) rsq[u.pm * BM + tid] = t > 0.f ? t * (1.f / 127.f) : 1.f; }
        __syncthreads();
#pragma unroll
        for (int ai = 0; ai < 2; ++ai)
#pragma unroll
            for (int m = 0; m < 4; ++m) { const int rl = ai * HALF + wr * 64 + m * 16 + fr; const float inv = T2[rl]; unsigned char* qrow = hq + (size_t)(u.pm * BM + rl) * DM + col0;
#pragma unroll
                for (int bj = 0; bj < 2; ++bj) { unsigned w2[2];
#pragma unroll
                    for (int n = 0; n < 2; ++n) { const f32x4 h = acc[ai][bj][m][n] * inv;
                        w2[n] = ((unsigned)(int)rintf(h[0]) & 0xffu) | (((unsigned)(int)rintf(h[1]) & 0xffu) << 8) | (((unsigned)(int)rintf(h[2]) & 0xffu) << 16) | (((unsigned)(int)rintf(h[3]) & 0xffu) << 24); }
                    *(u32x2*)(qrow + bj * 32) = (u32x2){w2[0], w2[1]}; }
                __builtin_amdgcn_sched_barrier(0); }
        }
    }
};
template <bool I8> struct AccSel { typedef f32x4 type; };
template <> struct AccSel<true> { typedef i32x4 type; };
template <bool I8> __device__ __forceinline__ typename AccSel<I8>::type mma1(bf16x8 b, bf16x8 a, typename AccSel<I8>::type c) {
    if constexpr (I8) return __builtin_amdgcn_mfma_i32_16x16x64_i8(__builtin_bit_cast(i32x4, b), __builtin_bit_cast(i32x4, a), c, 0, 0, 0);
    else return __builtin_amdgcn_mfma_f32_16x16x32_bf16(b, a, c, 0, 0, 0);
}
template <class Epi, class Sched, bool ALIGN_EPI = false, bool SP2 = false, bool I8 = false>
__device__ __forceinline__ void gemm_phase(LAS unsigned char* lds, const Gemm g, const Sched& S, const Epi& E, int wv) {
    const int tid = otid(wv), wid = __builtin_amdgcn_readfirstlane(tid >> 6), lane = tid & 63, wr = wid >> 2, wc = wid & 3, fr = lane & 15, fq = lane >> 4;
    const int KBY = g.KB, nt = KBY / (BK * 2);
    unsigned voffA[2], voffB[2];
#pragma unroll
    for (int i = 0; i < 2; ++i) { int R, C; stage_rc(tid * 16 + i * 8192, R, C); const int Rb = Epi::PERM ? ((R & ~31) + perm32(R & 31)) : R;
        voffA[i] = (unsigned)(R * KBY + C * 2); voffB[i] = (unsigned)((Epi::PERM ? ((R >> 5) * 64 + perm32(R & 31)) : Rb) * KBY + C * 2); }
    const size_t kstep = (size_t)(BK * 2);
    const size_t hstep = (size_t)HALF * KBY;
    const size_t hstepB = Epi::PERM ? (size_t)32 * KBY : hstep;
    const size_t tstep = 2 * hstep;
    const unsigned ldsw = (unsigned)wid * 1024u;
    const int aoff = lds_byte(wr * 64 + fr, fq * 8), boff = lds_byte(wc * 32 + fr, fq * 8);
#define PG8_SA(b, h) (((b) * 2 + (h)) * HTB)
#define PG8_SB(b, h) ((4 + (b) * 2 + (h)) * HTB)
#define PG8_STAGE(bufoff, gbase, voff) do { _Pragma("unroll") for (int _i = 0; _i < 2; ++_i) \
        __builtin_amdgcn_global_load_lds((const unsigned*)((const char*)(gbase) + (voff)[_i]), (LAS unsigned*)(lds + (bufoff) + ldsw + _i * 8192), 16, 0, 0); } while (0)
#define PG8_LDA(dst, b, h) do { _Pragma("unroll") for (int m = 0; m < 4; ++m) _Pragma("unroll") for (int k = 0; k < 2; ++k) dst[m][k] = *(const LAS bf16x8*)(lds + PG8_SA(b, h) + aoff + m * 2048 + k * 1024); } while (0)
#define PG8_LDB(dst, b, h) do { _Pragma("unroll") for (int n = 0; n < 2; ++n) _Pragma("unroll") for (int k = 0; k < 2; ++k) dst[n][k] = *(const LAS bf16x8*)(lds + PG8_SB(b, h) + boff + n * 2048 + k * 1024); } while (0)
#define PG8_MMA(ai, bj, At, Bt) do { __builtin_amdgcn_s_setprio(1); _Pragma("unroll") for (int m = 0; m < 4; ++m) _Pragma("unroll") for (int n = 0; n < 2; ++n) _Pragma("unroll") for (int k = 0; k < 2; ++k) \
        acc[ai][bj][m][n] = mma1<I8>(Bt[n][k], At[m][k], acc[ai][bj][m][n]); __builtin_amdgcn_s_setprio(0); } while (0)
#define PG8_WAIT_V(n) asm volatile("s_waitcnt vmcnt(" #n ")" ::: "memory")
#define PG8_WAIT_L(n) asm volatile("s_waitcnt lgkmcnt(" #n ")" ::: "memory")
#define PG8_BAR __builtin_amdgcn_s_barrier()
#define PG8_SCHED __builtin_amdgcn_sched_barrier(0)
    Unit cur, nxt; int ui = 0;
    if (!S.next(0, cur)) return;
    typedef typename AccSel<I8>::type acc_t;
    acc_t acc[2][2][4][2];
#pragma unroll
    for (int a = 0; a < 2; ++a)
#pragma unroll
        for (int b = 0; b < 2; ++b)
#pragma unroll
            for (int m = 0; m < 4; ++m)
#pragma unroll
                for (int n = 0; n < 2; ++n) acc[a][b][m][n] = acc_t{};
    bf16x8 At[4][2], B0[2][2], B1[2][2];
    const char* cA = (const char*)g.A + (size_t)cur.pm * tstep; const char* cB = (const char*)g.Bt + (size_t)cur.pn * tstep;
    S.a_ready(cur);
    if constexpr (SP2) {
        PG8_STAGE(PG8_SB(0, 0), cB, voffB); PG8_STAGE(PG8_SB(0, 1), cB + hstepB, voffB); PG8_STAGE(PG8_SA(0, 0), cA, voffA); PG8_STAGE(PG8_SA(0, 1), cA + hstep, voffA);
        if (wr == 1) PG8_BAR;
        PG8_WAIT_V(2); PG8_BAR;
        PG8_STAGE(PG8_SB(1, 0), cB + kstep, voffB); PG8_STAGE(PG8_SA(1, 0), cA + kstep, voffA); PG8_STAGE(PG8_SB(1, 1), cB + hstepB + kstep, voffB);
        PG8_WAIT_V(6); PG8_BAR;
    } else {
        PG8_STAGE(PG8_SB(0, 0), cB, voffB); PG8_STAGE(PG8_SA(0, 0), cA, voffA); PG8_STAGE(PG8_SB(0, 1), cB + hstepB, voffB); PG8_STAGE(PG8_SA(0, 1), cA + hstep, voffA);
        if (wr == 1) PG8_BAR;
        PG8_WAIT_V(4); PG8_BAR;
        PG8_STAGE(PG8_SB(1, 0), cB + kstep, voffB); PG8_STAGE(PG8_SA(1, 0), cA + kstep, voffA); PG8_STAGE(PG8_SB(1, 1), cB + hstepB + kstep, voffB);
        PG8_WAIT_V(6); PG8_BAR;
    }
    for (;;) {
        const bool has_next = S.next(ui + 1, nxt);
        const char* nA = has_next ? (const char*)g.A + (size_t)nxt.pm * tstep : cA; const char* nB = has_next ? (const char*)g.Bt + (size_t)nxt.pn * tstep : cB;
        for (int t = 0; t < nt; t += 2) {
            const bool last = (t == nt - 2);
            const char* a1 = cA + (size_t)(t + 1) * kstep;
            const char* a2 = last ? nA : cA + (size_t)(t + 2) * kstep; const char* b2 = last ? nB : cB + (size_t)(t + 2) * kstep;
            const char* a3 = a2 + kstep; const char* b3 = b2 + kstep;
            if (last && has_next) S.a_ready(nxt);
            if constexpr (SP2) {
            PG8_LDB(B0, 0, 0); PG8_LDB(B1, 0, 1); PG8_SCHED; PG8_LDA(At, 0, 0); PG8_STAGE(PG8_SA(1, 1), a1 + hstep, voffA);
            PG8_WAIT_V(8); PG8_WAIT_L(0); PG8_BAR; PG8_MMA(0, 0, At, B0); PG8_MMA(0, 1, At, B1); PG8_BAR; PG8_SCHED;
            PG8_LDA(At, 0, 1); PG8_STAGE(PG8_SB(0, 0), b2, voffB); PG8_STAGE(PG8_SB(0, 1), b2 + hstepB, voffB); PG8_STAGE(PG8_SA(0, 0), a2, voffA);
            PG8_WAIT_V(8); PG8_WAIT_L(0); PG8_BAR; PG8_MMA(1, 0, At, B0); PG8_MMA(1, 1, At, B1); PG8_BAR; PG8_SCHED;
            PG8_LDB(B0, 1, 0); PG8_LDB(B1, 1, 1); PG8_SCHED; PG8_LDA(At, 1, 0); PG8_STAGE(PG8_SA(0, 1), a2 + hstep, voffA);
            PG8_WAIT_V(8); PG8_WAIT_L(0); PG8_BAR; PG8_MMA(0, 0, At, B0); PG8_MMA(0, 1, At, B1); PG8_BAR; PG8_SCHED;
            PG8_LDA(At, 1, 1); PG8_STAGE(PG8_SB(1, 0), b3, voffB); PG8_STAGE(PG8_SB(1, 1), b3 + hstepB, voffB); PG8_STAGE(PG8_SA(1, 0), a3, voffA);
            PG8_WAIT_V(8); PG8_WAIT_L(0); PG8_BAR; PG8_MMA(1, 0, At, B0); PG8_MMA(1, 1, At, B1); PG8_BAR; PG8_SCHED;
            } else {
            PG8_LDB(B0, 0, 0); PG8_SCHED; PG8_LDA(At, 0, 0); PG8_STAGE(PG8_SA(1, 1), a1 + hstep, voffA);
            PG8_WAIT_L(8); PG8_BAR; PG8_WAIT_L(0); PG8_MMA(0, 0, At, B0); PG8_BAR; PG8_SCHED;
            PG8_LDB(B1, 0, 1); PG8_STAGE(PG8_SB(0, 0), b2, voffB);
            PG8_BAR; PG8_WAIT_L(0); PG8_MMA(0, 1, At, B1); PG8_BAR;
            PG8_LDA(At, 0, 1); PG8_STAGE(PG8_SA(0, 0), a2, voffA);
            PG8_BAR; PG8_WAIT_L(0); PG8_MMA(1, 0, At, B0); PG8_BAR; PG8_SCHED;
            PG8_STAGE(PG8_SB(0, 1), b2 + hstepB, voffB);
            PG8_WAIT_V(6); PG8_BAR; PG8_MMA(1, 1, At, B1); PG8_BAR;
            PG8_LDB(B0, 1, 0); PG8_SCHED; PG8_LDA(At, 1, 0); PG8_STAGE(PG8_SA(0, 1), a2 + hstep, voffA);
            PG8_WAIT_L(8); PG8_BAR; PG8_WAIT_L(0); PG8_MMA(0, 0, At, B0); PG8_BAR; PG8_SCHED;
            PG8_LDB(B1, 1, 1); PG8_STAGE(PG8_SB(1, 0), b3, voffB);
            PG8_BAR; PG8_WAIT_L(0); PG8_MMA(0, 1, At, B1); PG8_BAR;
            PG8_LDA(At, 1, 1); PG8_STAGE(PG8_SA(1, 0), a3, voffA);
            PG8_BAR; PG8_WAIT_L(0); PG8_MMA(1, 0, At, B0); PG8_BAR; PG8_SCHED;
            PG8_STAGE(PG8_SB(1, 1), b3 + hstepB, voffB);
            PG8_WAIT_V(6); PG8_BAR; PG8_MMA(1, 1, At, B1); PG8_BAR;
            }
        }
        if constexpr (ALIGN_EPI) { if (wr == 0) PG8_BAR; }
        if constexpr (!Epi::AFTER_DRAIN) { E(acc, cur, wr, wc, fr, fq); S.done(cur); }
        if (!has_next) break;
#pragma unroll
        for (int a = 0; a < 2; ++a)
#pragma unroll
            for (int b = 0; b < 2; ++b)
#pragma unroll
                for (int m = 0; m < 4; ++m)
#pragma unroll
                    for (int n = 0; n < 2; ++n) acc[a][b][m][n] = acc_t{};
        cur = nxt; cA = nA; cB = nB; ++ui;
        if constexpr (ALIGN_EPI) { if (wr == 1) PG8_BAR; }
    }
    PG8_WAIT_V(0);
    if constexpr (!ALIGN_EPI) { if (wr == 0) PG8_BAR; }
    PG8_BAR;
    if constexpr (Epi::AFTER_DRAIN) { if constexpr (!I8) E.fused(acc, cur, wr, wc, fr, fq, lds, wid, lane); }
#undef PG8_SA
#undef PG8_SB
#undef PG8_STAGE
#undef PG8_LDA
#undef PG8_LDB
#undef PG8_MMA
#undef PG8_WAIT_V
#undef PG8_WAIT_L
#undef PG8_BAR
#undef PG8_SCHED
}
}

struct Params {
    const float *x, *c, *norm_w, *mod_w, *mod_b, *a_w_in, *a_w_out, *b_w_in, *b_w_out, *final_w;
    float* out; unsigned char* ws;
};

typedef const __attribute__((address_space(4))) Params CParams;
__device__ __forceinline__ CParams& PP() { CParams* p = (CParams*)__builtin_amdgcn_kernarg_segment_ptr(); asm volatile("" : "+s"(p)); return *p; }

__device__ __forceinline__ void p0_mod(unsigned char* lds, int wv) {
    CParams& P = PP();
    const int tid = otid(wv);
    f32x4* condT = (f32x4*)lds;
    float* red = (float*)(lds + 32768);
    float* MOD = (float*)(P.ws + WS_MOD);
    bool have = false;
    for (int item = obid(); item < 768; item += gridDim.x) {
        if (!have) { have = true;
            for (int k = tid; k < DM; k += NTHREADS) { f32x4 v; v.x = silu_f(P.c[k]); v.y = silu_f(P.c[DM + k]); v.z = silu_f(P.c[2 * DM + k]); v.w = silu_f(P.c[3 * DM + k]); condT[k] = v; }
            __syncthreads(); }
        const int l = item / 192, n0 = (item % 192) * 32, cq = tid & 7, kp = tid >> 3;
        f32x4 a0 = {0.f, 0.f, 0.f, 0.f}, a1 = a0, a2 = a0, a3 = a0;
        const float* wp = P.mod_w + ((size_t)l * DM + kp * 32) * 6144 + n0 + 4 * cq;
#pragma unroll 16
        for (int k = 0; k < 32; ++k) { const f32x4 w = *(const f32x4*)(wp + (size_t)k * 6144); const f32x4 cv = condT[kp * 32 + k];
            a0 += w * cv.x; a1 += w * cv.y; a2 += w * cv.z; a3 += w * cv.w; }
        *(f32x4*)(red + (kp * 4 + 0) * 32 + 4 * cq) = a0; *(f32x4*)(red + (kp * 4 + 1) * 32 + 4 * cq) = a1;
        *(f32x4*)(red + (kp * 4 + 2) * 32 + 4 * cq) = a2; *(f32x4*)(red + (kp * 4 + 3) * 32 + 4 * cq) = a3;
        __syncthreads();
        if (tid < 128) { const int b = tid >> 5, col = tid & 31; float s = P.mod_b[l * 6144 + n0 + col];
#pragma unroll 8
            for (int q = 0; q < 64; ++q) s += red[(q * 4 + b) * 32 + col];
            MOD[(l * 4 + b) * 6144 + n0 + col] = s; }
        __syncthreads();
    }
}
__device__ __forceinline__ void p0_transpose_item(const float* W, int ldn, int ncol0, int nblk, bf16_t* WT, unsigned char* scr, int item, int lane) {
    const int kb = item / nblk, nb = item - kb * nblk, k0 = kb * 64, n0 = nb * 64;
    const float* src = W + (size_t)(k0 + (lane >> 4)) * ldn + ncol0 + n0 + 4 * (lane & 15);
#pragma unroll 4
    for (int i = 0; i < 16; ++i) { const f32x4 v = *(const f32x4*)(src + (size_t)(4 * i) * ldn);
        unsigned* d = (unsigned*)(scr + (4 * i + (lane >> 4)) * 132 + 8 * (lane & 15));
        d[0] = cvt_pk_bf16(v.x, v.y); d[1] = cvt_pk_bf16(v.z, v.w); }
    LDS_WAIT();
    const int c = lane & 7;
#pragma unroll
    for (int j = 0; j < 8; ++j) { const int n = (lane >> 3) + 8 * j; const unsigned short* s = (const unsigned short*)(scr + (8 * c) * 132 + 2 * n);
        u32x4 o;
        o.x = (unsigned)s[0 * 66] | ((unsigned)s[1 * 66] << 16); o.y = (unsigned)s[2 * 66] | ((unsigned)s[3 * 66] << 16);
        o.z = (unsigned)s[4 * 66] | ((unsigned)s[5 * 66] << 16); o.w = (unsigned)s[6 * 66] | ((unsigned)s[7 * 66] << 16);
        *(u32x4*)(WT + (size_t)(n0 + n) * DM + k0 + 8 * c) = o; }
    LDS_WAIT();
}
__device__ __forceinline__ void p0_panel_i8(const float* W, int ldn, int n0, signed char* WT, float* cs, unsigned char* lds, int tid) {
    const int lane = tid & 63, wave = __builtin_amdgcn_readfirstlane(tid >> 6);
    float* maxbuf = (float*)(lds + 131072);
    f32x4 mx = {0.f, 0.f, 0.f, 0.f};
    { const float* src = W + (size_t)(wave * 256 + (lane >> 3)) * ldn + n0 + 4 * (lane & 7);
      unsigned char* dst = lds + (size_t)(wave * 256 + (lane >> 3)) * 64 + 8 * (lane & 7);
#pragma unroll 16
      for (int i = 0; i < 32; ++i) { const f32x4 v = *(const f32x4*)(src + (size_t)(8 * i) * ldn);
          mx.x = fmaxf(mx.x, fabsf(v.x)); mx.y = fmaxf(mx.y, fabsf(v.y)); mx.z = fmaxf(mx.z, fabsf(v.z)); mx.w = fmaxf(mx.w, fabsf(v.w));
          u32x2 w; w.x = cvt_pk_bf16(v.x, v.y); w.y = cvt_pk_bf16(v.z, v.w); *(u32x2*)(dst + (size_t)(8 * i) * 64) = w; } }
#pragma unroll
    for (int o = 8; o < 64; o <<= 1) { mx.x = fmaxf(mx.x, __shfl_xor(mx.x, o)); mx.y = fmaxf(mx.y, __shfl_xor(mx.y, o)); mx.z = fmaxf(mx.z, __shfl_xor(mx.z, o)); mx.w = fmaxf(mx.w, __shfl_xor(mx.w, o)); }
    if (lane < 8) *(f32x4*)(maxbuf + wave * 32 + 4 * lane) = mx;
    __syncthreads();
    { const int n = tid & 31, kc = tid >> 5;
      float cm = maxbuf[n];
#pragma unroll
      for (int w = 1; w < 8; ++w) cm = fmaxf(cm, maxbuf[w * 32 + n]);
      const float inv = cm > 0.f ? 127.f / cm : 0.f;
      if (kc == 0) cs[n0 + n] = cm > 0.f ? cm * (1.f / 127.f) : 1.f;
      const unsigned short* t = (const unsigned short*)lds + (size_t)(kc * 128) * 32 + n;
      signed char* orow = WT + (size_t)(n0 + n) * DM + kc * 128;
#pragma unroll 2
      for (int i = 0; i < 8; ++i) { unsigned w[4];
#pragma unroll
          for (int q = 0; q < 4; ++q) { unsigned acc = 0;
#pragma unroll
              for (int e = 0; e < 4; ++e) { const float v = bf2f(t[(size_t)(16 * i + 4 * q + e) * 32]) * inv; int iv = (int)rintf(v); iv = iv > 127 ? 127 : (iv < -127 ? -127 : iv); acc |= ((unsigned)iv & 0xffu) << (8 * e); }
              w[q] = acc; }
          *(u32x4*)(orow + 16 * i) = (u32x4){w[0], w[1], w[2], w[3]}; } }
    __syncthreads();
}
__device__ __forceinline__ void p0_weights(unsigned char* lds, int wv) {
    CParams& P = PP();
    const int tid_ = otid(wv); const int lane = tid_ & 63, wave = __builtin_amdgcn_readfirstlane(tid_ >> 6);
    constexpr int PA = A_N / 32, PB = (MOBA_QK_I8 ? B_N : 4096) / 32, PO = DM / 32, NPANEL = 2 * PA + 2 * PB + (OUTA_I8 ? 2 * PO : 0);
    for (int it = obid(); it < NPANEL; it += gridDim.x) {
        if (it < 2 * PA) { const int j = it / PA, pnl = it - j * PA;
            p0_panel_i8(P.a_w_in + (size_t)j * DM * A_N, A_N, pnl * 32, (signed char*)(P.ws + WS_WAIN) + (size_t)j * A_N * DM, (float*)(P.ws + WS_CSA) + j * A_N, lds, tid_); }
        else if (it < 2 * PA + 2 * PB) { const int r = it - 2 * PA, j = r / PB, pnl = r - j * PB;
#if MOBA_QK_I8
            p0_panel_i8(P.b_w_in + (size_t)j * DM * B_N, B_N, pnl * 32, (signed char*)(P.ws + WS_WBQK) + (size_t)j * B_N * DM, (float*)(P.ws + WS_CSB) + j * B_N, lds, tid_); }
#else
            p0_panel_i8(P.b_w_in + (size_t)j * DM * B_N + 4096, B_N, pnl * 32, (signed char*)(P.ws + WS_WBVZ) + (size_t)j * 4096 * DM, (float*)(P.ws + WS_CSB) + j * 4096, lds, tid_); }
#endif
#if OUTA_I8
        else { const int r = it - 2 * PA - 2 * PB, j = r / PO, pnl = r - j * PO;
            p0_panel_i8(P.a_w_out + (size_t)j * DM * DM, DM, pnl * 32, (signed char*)(P.ws + WS_WAOUT) + (size_t)j * DM * DM, (float*)(P.ws + WS_CSO) + j * DM, lds, tid_); }
#endif
    }
    unsigned char* scr = lds + 65536 + wave * 8448;
    const int gw = obid() * 8 + wave, NGW = gridDim.x * 8;
    constexpr int I_B = MOBA_QK_I8 ? 0 : 32 * 64, I_O = 32 * 32, I_AO = OUTA_I8 ? 0 : 32 * 32, TOTAL = 2 * I_B + 2 * I_AO + 2 * I_O;
    for (int it = gw; it < TOTAL; it += NGW) {
        int r = it;
        if (I_B > 0 && r < 2 * I_B) { const int j = r / (I_B > 0 ? I_B : 1); p0_transpose_item(P.b_w_in + (size_t)j * DM * B_N, B_N, 0, 64, (bf16_t*)(P.ws + WS_WBQK) + (size_t)j * 4096 * DM, scr, r - j * I_B, lane); continue; } r -= 2 * I_B;
        if (I_AO > 0 && r < 2 * I_AO) { const int j = r / (I_AO > 0 ? I_AO : 1); p0_transpose_item(P.a_w_out + (size_t)j * DM * DM, DM, 0, 32, (bf16_t*)(P.ws + WS_WAOUT) + (size_t)j * DM * DM, scr, r - j * I_AO, lane); continue; } r -= 2 * I_AO;
        { const int j = r / I_O; p0_transpose_item(P.b_w_out + (size_t)j * DM * DM, DM, 0, 32, (bf16_t*)(P.ws + WS_WBOUT) + (size_t)j * DM * DM, scr, r - j * I_O, lane); }
    }
}

__device__ __forceinline__ void norm_phase(int layer, bool want_bf16, int wv) {
    CParams& P = PP(); const float* xin = layer == 0 ? P.x : P.out;
    const int tid_ = otid(wv); const int lane = tid_ & 63, wave = __builtin_amdgcn_readfirstlane(tid_ >> 6);
    const int gw = obid() * 8 + wave, NGW = gridDim.x * 8;
    const float* MOD = (const float*)(P.ws + WS_MOD);
    bf16_t* Hb = (bf16_t*)(P.ws + WS_H); unsigned char* Hq = P.ws + WS_HQ; float* RS = (float*)(P.ws + WS_RS);
    for (int r0 = gw * 4; r0 < MTOK; r0 += NGW * 4) {
        const int b = r0 >> 11;
        const float* shift = MOD + (size_t)(layer * 4 + b) * 6144; const float* scale = shift + DM; const float* nw = P.norm_w + layer * DM;
        f32x4 ca[8], cs[8];
#pragma unroll
        for (int j = 0; j < 8; ++j) { const int c = 4 * lane + 256 * j; const f32x4 w = *(const f32x4*)(nw + c), s = *(const f32x4*)(scale + c); ca[j] = w * (s + 1.f); cs[j] = *(const f32x4*)(shift + c); }
        for (int rr = 0; rr < 4; ++rr) {
            const float* xr = xin + (size_t)(r0 + rr) * DM; f32x4 v[8]; float ss = 0.f;
#pragma unroll
            for (int j = 0; j < 8; ++j) { v[j] = *(const f32x4*)(xr + 4 * lane + 256 * j); ss += (v[j].x * v[j].x + v[j].y * v[j].y) + (v[j].z * v[j].z + v[j].w * v[j].w); }
            const float rs = 1.0f / sqrtf(wave_sum(ss) * (1.f / DM) + EPS);
            float am = 0.f;
#pragma unroll
            for (int j = 0; j < 8; ++j) { v[j] = v[j] * rs * ca[j] + cs[j]; am = fmaxf(am, fmaxf(fmaxf(fabsf(v[j].x), fabsf(v[j].y)), fmaxf(fabsf(v[j].z), fabsf(v[j].w)))); }
            am = wave_max(am);
            const float inv = am > 0.f ? 127.f / am : 0.f;
            if (lane == 0) RS[r0 + rr] = am > 0.f ? am * (1.f / 127.f) : 1.f;
            unsigned char* qr = Hq + (size_t)(r0 + rr) * DM;
#pragma unroll
            for (int j = 0; j < 8; ++j) { const f32x4 h = v[j] * inv;
                const int i0 = (int)rintf(h.x), i1 = (int)rintf(h.y), i2 = (int)rintf(h.z), i3 = (int)rintf(h.w);
                *(unsigned*)(qr + 4 * lane + 256 * j) = ((unsigned)i0 & 0xffu) | (((unsigned)i1 & 0xffu) << 8) | (((unsigned)i2 & 0xffu) << 16) | (((unsigned)i3 & 0xffu) << 24); }
            if (want_bf16) { bf16_t* hr = Hb + (size_t)(r0 + rr) * DM;
#pragma unroll
                for (int j = 0; j < 8; ++j) { u32x2 w; w.x = cvt_pk_bf16(v[j].x, v[j].y); w.y = cvt_pk_bf16(v[j].z, v[j].w); *(u32x2*)(hr + 4 * lane + 256 * j) = w; } }
        }
    }
}
__device__ __forceinline__ void final_norm_phase(int wv) {
    CParams& P = PP();
    const int tid_ = otid(wv); const int lane = tid_ & 63, wave = __builtin_amdgcn_readfirstlane(tid_ >> 6);
    const int gw = obid() * 8 + wave, NGW = gridDim.x * 8;
    f32x4 cw[8];
#pragma unroll
    for (int j = 0; j < 8; ++j) cw[j] = *(const f32x4*)(P.final_w + 4 * lane + 256 * j);
    for (int r = gw; r < MTOK; r += NGW) {
        float* xr = P.out + (size_t)r * DM; f32x4 v[8]; float ss = 0.f;
#pragma unroll
        for (int j = 0; j < 8; ++j) { v[j] = *(const f32x4*)(xr + 4 * lane + 256 * j); ss += (v[j].x * v[j].x + v[j].y * v[j].y) + (v[j].z * v[j].z + v[j].w * v[j].w); }
        const float rs = 1.0f / sqrtf(wave_sum(ss) * (1.f / DM) + EPS);
#pragma unroll
        for (int j = 0; j < 8; ++j) *(f32x4*)(xr + 4 * lane + 256 * j) = v[j] * rs * cw[j];
    }
}

__device__ __forceinline__ void naive_attend(const bf16_t* Kh, const bf16_t* Vh, const float* qf, float* sc, int own_start, int own_len, int blkbase, int mask, int qpos, float slopeL, int lane,
                                             float& o0, float& o1, float& lse2) {
    int base = 0; float mx = -3.0e38f;
    { int m2 = mask;
      for (int rr = 0;; ++rr) { int start, len;
        if (rr == 0) { start = own_start; len = own_len; } else { if (!m2) break; const int j = __builtin_ctz(m2); m2 &= m2 - 1; start = blkbase + (j << 8); len = 256; }
        for (int i = lane; i < len; i += 64) { const int key = start + i; const u32x4* kp = (const u32x4*)(Kh + (size_t)key * DM); float dot = 0.f;
#pragma unroll 4
            for (int cch = 0; cch < 16; ++cch) { const u32x4 w = kp[cch]; const float* q = qf + cch * 8;
                dot += q[0] * bflo(w.x) + q[1] * bfhi(w.x) + q[2] * bflo(w.y) + q[3] * bfhi(w.y) + q[4] * bflo(w.z) + q[5] * bfhi(w.z) + q[6] * bflo(w.w) + q[7] * bfhi(w.w); }
            const float s = dot + slopeL * (float)(key - qpos); sc[base + i] = s; mx = fmaxf(mx, s); }
        base += len; } }
    const int tot = base; mx = wave_max(mx);
    LDS_WAIT();
    float sum = 0.f;
    for (int i = lane; i < tot; i += 64) { const float p = exp2f(sc[i] - mx); sc[i] = p; sum += p; }
    sum = wave_sum(sum);
    LDS_WAIT();
    float a0 = 0.f, a1 = 0.f; base = 0;
    { int m2 = mask;
      for (int rr = 0;; ++rr) { int start, len;
        if (rr == 0) { start = own_start; len = own_len; } else { if (!m2) break; const int j = __builtin_ctz(m2); m2 &= m2 - 1; start = blkbase + (j << 8); len = 256; }
        const bf16_t* vp = Vh + (size_t)start * DM + 2 * lane;
        for (int i = 0; i < len; ++i) { const float p = sc[base + i]; const unsigned w = *(const unsigned*)(vp + (size_t)i * DM); a0 += p * bflo(w); a1 += p * bfhi(w); }
        base += len; } }
    LDS_WAIT();
    const float inv = 1.f / sum; o0 = a0 * inv; o1 = a1 * inv; lse2 = mx + log2f(sum);
}
__device__ __forceinline__ float slope_of(int h) { return exp2f(-0.5f * (float)(h + 1)); }

__device__ __forceinline__ void attn_a_naive(unsigned char* lds, int wv) {
    CParams& P = PP();
    const int tid_ = otid(wv); const int lane = tid_ & 63, wave = __builtin_amdgcn_readfirstlane(tid_ >> 6);
    float* qf = (float*)(lds + wave * 8192); float* sc = qf + 128;
    const bf16_t* QKV = (const bf16_t*)(P.ws + WS_QKV); bf16_t* OG = (bf16_t*)(P.ws + WS_OG); float* LSE = (float*)(P.ws + WS_LSE);
    const int gw = obid() * 8 + wave, NGW = gridDim.x * 8;
    for (int it = gw; it < 3 * MTOK * NH; it += NGW) {
        const int h = it & 15, R = (it >> 4) & (MTOK - 1), g = it >> 17;
        const int lg = 2 * g, L = SEQ >> lg;
        const bf16_t* Qp = QKV + (size_t)(3 * g) * PART + (size_t)R * DM + h * HD;
        { const unsigned w = *(const unsigned*)(Qp + 2 * lane); qf[2 * lane] = bflo(w); qf[2 * lane + 1] = bfhi(w); }
        LDS_WAIT();
        const int seq0 = R & ~(L - 1); int lo = R - 128; if (lo < seq0) lo = seq0;
        float o0, o1, lse2;
        naive_attend(QKV + (size_t)(3 * g + 1) * PART + h * HD, QKV + (size_t)(3 * g + 2) * PART + h * HD, qf, sc, lo, R - lo + 1, 0, 0, R, slope_of(h) * (float)(1 << lg) * LOG2E, lane, o0, o1, lse2);
        *(unsigned*)(OG + (size_t)g * PART + (size_t)R * DM + h * HD + 2 * lane) = cvt_pk_bf16(o0, o1);
        if (lane == 0) LSE[((size_t)g * MTOK + R) * NH + h] = lse2;
    }
}
__device__ __forceinline__ void combine_phase(int wv) {
    CParams& P = PP();
    const int tid_ = otid(wv); const int lane = tid_ & 63, wave = __builtin_amdgcn_readfirstlane(tid_ >> 6);
    const int gw = obid() * 8 + wave, NGW = gridDim.x * 8;
    const bf16_t* OG = (const bf16_t*)(P.ws + WS_OG); const float* LSE = (const float*)(P.ws + WS_LSE); const bf16_t* Z = (const bf16_t*)(P.ws + WS_Z);
    unsigned char* GQ = P.ws + WS_HQ; float* RS = (float*)(P.ws + WS_RS);
    for (int m = gw; m < MTOK; m += NGW) {
        const int b = m >> 11, t = m & 2047;
        const int R0 = m, R1 = (b << 11) + ((t & 3) << 9) + (t >> 2), R2 = (b << 11) + ((t & 15) << 7) + (t >> 4);
        float v[4][8]; float am = 0.f, sq = 0.f;
#pragma unroll
        for (int j = 0; j < 4; ++j) { const int col = 8 * lane + 512 * j, h = col >> 7;
            const float l0 = LSE[((size_t)0 * MTOK + R0) * NH + h], l1 = LSE[((size_t)1 * MTOK + R1) * NH + h], l2 = LSE[((size_t)2 * MTOK + R2) * NH + h];
            const float mx = fmaxf(l0, fmaxf(l1, l2)); float e0 = exp2f(l0 - mx), e1 = exp2f(l1 - mx), e2 = exp2f(l2 - mx); const float inv = 1.f / (e0 + e1 + e2); e0 *= inv; e1 *= inv; e2 *= inv;
            const u32x4 a = *(const u32x4*)(OG + (size_t)R0 * DM + col), bb = *(const u32x4*)(OG + PART + (size_t)R1 * DM + col), cc = *(const u32x4*)(OG + 2 * PART + (size_t)R2 * DM + col);
            const u32x4 zz = *(const u32x4*)(Z + (size_t)m * DM + col);
#define CMB(F, I) { v[j][I] = (e0 * bflo(a.F) + e1 * bflo(bb.F) + e2 * bflo(cc.F)) * silu_f(bflo(zz.F)); v[j][I + 1] = (e0 * bfhi(a.F) + e1 * bfhi(bb.F) + e2 * bfhi(cc.F)) * silu_f(bfhi(zz.F)); \
                    am = fmaxf(am, fmaxf(fabsf(v[j][I]), fabsf(v[j][I + 1]))); sq += v[j][I] * v[j][I] + v[j][I + 1] * v[j][I + 1]; }
            CMB(x, 0) CMB(y, 2) CMB(z, 4) CMB(w, 6)
#undef CMB
        }
#if !OUTA_I8
        { bf16_t* Gr = (bf16_t*)(P.ws + WS_G) + (size_t)m * DM;
#pragma unroll
          for (int j = 0; j < 4; ++j) { u32x4 o; o.x = cvt_pk_bf16(v[j][0], v[j][1]); o.y = cvt_pk_bf16(v[j][2], v[j][3]); o.z = cvt_pk_bf16(v[j][4], v[j][5]); o.w = cvt_pk_bf16(v[j][6], v[j][7]); *(u32x4*)(Gr + 8 * lane + 512 * j) = o; }
          continue; }
#endif
        am = wave_max(am); sq = wave_sum(sq);
        am = fminf(am, GCLIP * sqrtf(sq * (1.f / DM)));
        const float inv = am > 0.f ? 127.f / am : 0.f;
        if (lane == 0) RS[m] = am > 0.f ? am * (1.f / 127.f) : 1.f;
#pragma unroll
        for (int j = 0; j < 4; ++j) { unsigned w0 = 0, w1 = 0;
#pragma unroll
            for (int e = 0; e < 4; ++e) { w0 |= ((unsigned)(int)rintf(fminf(fmaxf(v[j][e] * inv, -127.f), 127.f)) & 0xffu) << (8 * e); w1 |= ((unsigned)(int)rintf(fminf(fmaxf(v[j][4 + e] * inv, -127.f), 127.f)) & 0xffu) << (8 * e); }
            *(u32x2*)(GQ + (size_t)m * DM + 8 * lane + 512 * j) = (u32x2){w0, w1}; }
    }
}
__device__ __forceinline__ void attn_b_naive(unsigned char* lds, int wv) {
    CParams& P = PP();
    const int tid_ = otid(wv); const int lane = tid_ & 63, wave = __builtin_amdgcn_readfirstlane(tid_ >> 6);
    float* qf = (float*)(lds + wave * 8192); float* sc = qf + 128;
    const bf16_t* QKV = (const bf16_t*)(P.ws + WS_QKV); const bf16_t* Z = (const bf16_t*)(P.ws + WS_Z); bf16_t* G = (bf16_t*)(P.ws + WS_G); const float* KS = (const float*)(P.ws + WS_KSUM);
    const int gw = obid() * 8 + wave, NGW = gridDim.x * 8;
    for (int it = gw; it < MTOK * NH; it += NGW) {
        const int h = it & 15, m = it >> 4, b = m >> 11, t = m & 2047, n = t >> 8;
        const bf16_t* Qp = QKV + (size_t)m * DM + h * HD;
        float q0, q1; { const unsigned w = *(const unsigned*)(Qp + 2 * lane); q0 = bflo(w); q1 = bfhi(w); qf[2 * lane] = q0; qf[2 * lane + 1] = q1; }
        LDS_WAIT();
        float gt[8];
#pragma unroll
        for (int j = 0; j < 8; ++j) { float v = 0.f;
            if (j < n) { const float* k0 = KS + (size_t)(b * 8 + j) * DM + h * HD + 2 * lane; const float* k1 = k0 + (size_t)32 * DM; v = q0 * (k0[0] + k1[0]) + q1 * (k0[1] + k1[1]); }
            gt[j] = wave_sum(v); }
        int mask = 0;
#pragma unroll
        for (int j = 0; j < 8; ++j) { if (j < n) { int rank = 0;
#pragma unroll
                for (int j2 = 0; j2 < 8; ++j2) if (j2 < n && (gt[j2] > gt[j] || (gt[j2] == gt[j] && j2 < j))) ++rank;
                if (rank < 3) mask |= 1 << j; } }
        float o0, o1, lse2;
        naive_attend(QKV + PART + h * HD, QKV + 2 * PART + h * HD, qf, sc, (b << 11) + (n << 8), (t & 255) + 1, b << 11, mask, m, slope_of(h) * LOG2E, lane, o0, o1, lse2);
        const unsigned zw = *(const unsigned*)(Z + (size_t)m * DM + h * HD + 2 * lane);
        *(unsigned*)(G + (size_t)m * DM + h * HD + 2 * lane) = cvt_pk_bf16(o0 * silu_f(bflo(zw)), o1 * silu_f(bfhi(zw)));
    }
}

namespace fa {
constexpr int KVBLK = 64, SHM_K = KVBLK * HD * 2, SHM_V = KVBLK * HD * 2;
constexpr int OFF_V = 0, OFF_K = 2 * SHM_V, OFF_WS = OFF_K + 2 * SHM_K, OFF_OST = OFF_WS + 8 * 256, OST_ROW = 272, OST_WAVE = 32 * OST_ROW;
constexpr int OFF_GK = OFF_OST + 8 * OST_WAVE, OFF_SEL = OFF_GK + 7 * 128 * 4, OFF_END = OFF_SEL + 256 * 4;
static_assert(OFF_END <= LDS_BYTES - 1024, "attention LDS map");
constexpr float THR = 11.5f;
#define KSWZ(row, colB) ((row) * 256 + ((colB) ^ (((row) & 7) << 4)))
#define SBAR() __builtin_amdgcn_sched_barrier(0)
__device__ __forceinline__ int v_st(int k, int c) { const int kk = (k & ~0xC) | ((k & 4) << 1) | ((k & 8) >> 1); return ((kk >> 3) * 4 + (c >> 5)) * 512 + ((kk & 7) * 32 + (c & 31)) * 2; }
__device__ __forceinline__ int v_rd_base(int lane) { return ((lane & 3) << 3) | (((lane >> 2) & 3) << 6) | (((lane >> 4) & 1) << 5) | (((lane >> 5) & 1) << 8); }
constexpr int v_rd_off(int d0, int ks, int half) { return d0 * 512 + ks * 4096 + half * 2048; }
__device__ __forceinline__ int crow(int r, int hi) { return (r & 3) + 8 * (r >> 2) + 4 * hi; }
__device__ __forceinline__ void mask_tile(f32x16& p0, f32x16& p1, int dq, unsigned W) {
    const float NEG = -__builtin_inff();
#pragma unroll
    for (int r = 0; r < 16; ++r) { const int c = (r & 3) + 8 * (r >> 2);
        if ((unsigned)(dq - c) >= W) p0[r] = NEG;
        if ((unsigned)(dq - c - 32) >= W) p1[r] = NEG; }
}
__device__ __forceinline__ void partialSM(f32x16& p0, f32x16& p1, float& m_reg, float& alpha) {
    float pmax = p0[0];
#pragma unroll
    for (int r = 1; r < 16; ++r) pmax = fmaxf(pmax, p0[r]);
#pragma unroll
    for (int r = 0; r < 16; ++r) pmax = fmaxf(pmax, p1[r]);
    { auto rr = __builtin_amdgcn_permlane32_swap(__float_as_uint(pmax), __float_as_uint(pmax), false, false); pmax = fmaxf(__uint_as_float(rr[0]), __uint_as_float(rr[1])); }
    float mn;
    if (__builtin_expect(__all(pmax - m_reg <= THR), 1)) { mn = m_reg; alpha = 1.f; }
    else { mn = fmaxf(m_reg, pmax); alpha = __builtin_amdgcn_exp2f(m_reg - mn); m_reg = mn; }
#pragma unroll
    for (int r = 0; r < 16; ++r) p0[r] = __builtin_amdgcn_exp2f(p0[r] - mn);
#pragma unroll
    for (int r = 0; r < 16; ++r) p1[r] = __builtin_amdgcn_exp2f(p1[r] - mn);
}
__device__ __forceinline__ void finishSM(f32x16& p0, f32x16& p1, float alpha, float& l_reg, bf16x8& pa0, bf16x8& pa1, bf16x8& pa2, bf16x8& pa3) {
    float ps = 0;
#pragma unroll
    for (int r = 0; r < 16; ++r) ps += p0[r];
#pragma unroll
    for (int r = 0; r < 16; ++r) ps += p1[r];
    { auto rr = __builtin_amdgcn_permlane32_swap(__float_as_uint(ps), __float_as_uint(ps), false, false); ps = __uint_as_float(rr[0]) + __uint_as_float(rr[1]); }
    l_reg = l_reg * alpha + ps;
#define PK4(P, B_, OUT) do { unsigned a0 = cvt_pk_bf16(P[B_+0], P[B_+1]), a1 = cvt_pk_bf16(P[B_+2], P[B_+3]);                          \
        unsigned b0 = cvt_pk_bf16(P[B_+4], P[B_+5]), b1 = cvt_pk_bf16(P[B_+6], P[B_+7]);                                             \
        auto r0 = __builtin_amdgcn_permlane32_swap(a0, b0, false, false); auto r1 = __builtin_amdgcn_permlane32_swap(a1, b1, false, false); \
        u32x4 w = {r0[0], r1[0], r0[1], r1[1]}; OUT = *reinterpret_cast<bf16x8*>(&w); } while (0)
    PK4(p0, 0, pa0); PK4(p0, 8, pa1); PK4(p1, 0, pa2); PK4(p1, 8, pa3);
#undef PK4
}
template <int KB>
__device__ __forceinline__ void qkt(f32x16& p0, f32x16& p1, const LAS char* K_lds, int r32, int hi, const bf16x8* qr) {
    const LAS char* kb[4];
#pragma unroll
    for (int dd = 0; dd < 4; ++dd) kb[dd] = K_lds + KB * SHM_K + KSWZ(r32, (dd * 16 + hi * 8) * 2);
#pragma unroll
    for (int d0 = 0; d0 < 8; ++d0) { const LAS char* a = kb[d0 & 3] + (d0 >> 2) * 128;
        const bf16x8 b0 = *reinterpret_cast<const LAS bf16x8*>(a);
        const bf16x8 b1 = *reinterpret_cast<const LAS bf16x8*>(a + 32 * 256);
        p0 = __builtin_amdgcn_mfma_f32_32x32x16_bf16(b0, qr[d0], p0, 0, 0, 0);
        p1 = __builtin_amdgcn_mfma_f32_32x32x16_bf16(b1, qr[d0], p1, 0, 0, 0); }
}
template <int VB>
__device__ __forceinline__ void pv_tile(f32x16* o, int vb0, bf16x8 pa0, bf16x8 pa1, bf16x8 pa2, bf16x8 pa3) {
#define TRRD(dst, off) asm volatile("ds_read_b64_tr_b16 %0, %1 offset:%2" : "=&v"(dst) : "v"(vb0), "i"(off) : "memory")
#define PV_D0(d0) do { s16x4 l0, l1, l2, l3, h0, h1, h2, h3; constexpr int b_ = VB * SHM_V + v_rd_off(d0, 0, 0); \
        TRRD(l0, b_); TRRD(h0, b_ + 2048); TRRD(l1, b_ + 4096); TRRD(h1, b_ + 6144); TRRD(l2, b_ + 8192); TRRD(h2, b_ + 10240); TRRD(l3, b_ + 12288); TRRD(h3, b_ + 14336); \
        asm volatile("s_waitcnt lgkmcnt(0)" ::: "memory"); SBAR();   \
        o[d0] = __builtin_amdgcn_mfma_f32_32x32x16_bf16(pa0, (bf16x8){l0[0], l0[1], l0[2], l0[3], h0[0], h0[1], h0[2], h0[3]}, o[d0], 0, 0, 0);   \
        o[d0] = __builtin_amdgcn_mfma_f32_32x32x16_bf16(pa1, (bf16x8){l1[0], l1[1], l1[2], l1[3], h1[0], h1[1], h1[2], h1[3]}, o[d0], 0, 0, 0);   \
        o[d0] = __builtin_amdgcn_mfma_f32_32x32x16_bf16(pa2, (bf16x8){l2[0], l2[1], l2[2], l2[3], h2[0], h2[1], h2[2], h2[3]}, o[d0], 0, 0, 0);   \
        o[d0] = __builtin_amdgcn_mfma_f32_32x32x16_bf16(pa3, (bf16x8){l3[0], l3[1], l3[2], l3[3], h3[0], h3[1], h3[2], h3[3]}, o[d0], 0, 0, 0); } while (0)
    PV_D0(0); PV_D0(1); PV_D0(2); PV_D0(3);
#undef PV_D0
#undef TRRD
}

template <int MODE, class MK>
__device__ __forceinline__ void flash_block(const bf16_t* Q, const bf16_t* K, const bf16_t* V, int krow0, int NT, int qrow0, float slopeL, const MK& mk,
                                            unsigned char* lds, bf16_t* Og, float* Lse, const bf16_t* Zg, int tid) {
    const int wid = __builtin_amdgcn_readfirstlane(tid >> 6), lane = tid & 63, r32 = lane & 31, hi = lane >> 5;
    const LAS char* K_lds = (const LAS char*)(LAS unsigned char*)lds + OFF_K;
    LAS char* Kw = (LAS char*)(LAS unsigned char*)lds + OFF_K; LAS char* Vw = (LAS char*)(LAS unsigned char*)lds + OFF_V;
    LAS float* wsf = (LAS float*)((LAS unsigned char*)lds + OFF_WS) + wid * 64; LAS float* li_l = wsf; LAS float* al_l = wsf + 32;
    const int sr = tid >> 4, sc = (tid & 15) * 8, vst0 = v_st(sr, sc), vst1 = v_st(32 + sr, sc), kws = KSWZ(sr, sc * 2);
    const int vb0 = (int)(unsigned)(uintptr_t)((LAS unsigned char*)lds) + OFF_V + v_rd_base(lane);
    const int qlo = qrow0 + wid * 32, qm = qlo + r32 - 4 * hi;
    bf16x8 st_k0, st_k1, st_v0, st_v1;
#define SLOAD(kb_) do { const size_t o0_ = (size_t)((kb_) + sr) * DM + sc, o1_ = o0_ + (size_t)32 * DM; \
        st_v0 = *(const bf16x8*)(V + o0_); st_v1 = *(const bf16x8*)(V + o1_); st_k0 = *(const bf16x8*)(K + o0_); st_k1 = *(const bf16x8*)(K + o1_); } while (0)
#define SWRITE(bf) do { *(LAS bf16x8*)(Vw + (bf) * SHM_V + vst0) = st_v0; *(LAS bf16x8*)(Vw + (bf) * SHM_V + vst1) = st_v1; \
        *(LAS bf16x8*)(Kw + (bf) * SHM_K + kws) = st_k0; *(LAS bf16x8*)(Kw + (bf) * SHM_K + kws + 32 * 256) = st_k1; } while (0)
    bf16x8 qr[8];
#pragma unroll
    for (int d0 = 0; d0 < 8; ++d0) qr[d0] = *(const bf16x8*)(Q + (size_t)(wid * 32 + r32) * DM + d0 * 16 + hi * 8);
    SLOAD(krow0); asm volatile("s_waitcnt vmcnt(0)" ::: "memory"); SWRITE(0);
    __syncthreads();
    float m_reg = -1e30f, l_reg = 0.f; f32x16 o[4] = {};
#define STEP(t, KB) do { const int kb_ = krow0 + (t) * KVBLK;                                                                   \
        if ((t) + 1 < NT) SLOAD(kb_ + KVBLK);                                                                                     \
        bool act_, need_; unsigned W_; mk.info(kb_, qlo, r32, act_, need_, W_);                                                 \
        if (act_) { f32x16 p0, p1; const float a0_ = slopeL * (float)(kb_ - qm);                                                  \
            _Pragma("unroll") for (int r = 0; r < 16; ++r) { p0[r] = fmaf(slopeL, (float)((r & 3) + 8 * (r >> 2)), a0_); p1[r] = p0[r] + 32.f * slopeL; } \
            qkt<KB>(p0, p1, K_lds, r32, hi, qr);                                                                                  \
            if (need_) mask_tile(p0, p1, qm - kb_, W_);                                                                           \
            float alpha_; partialSM(p0, p1, m_reg, alpha_);                                                                       \
            bf16x8 pa0, pa1, pa2, pa3; finishSM(p0, p1, alpha_, l_reg, pa0, pa1, pa2, pa3);                                       \
            if (__any(alpha_ < 1.f)) { if (hi == 0) al_l[r32] = alpha_; LDS_WAIT();                                               \
                _Pragma("unroll") for (int d_ = 0; d_ < 4; ++d_) _Pragma("unroll") for (int r = 0; r < 16; ++r) o[d_][r] *= al_l[crow(r, hi)]; } \
            SBAR(); pv_tile<KB>(o, vb0, pa0, pa1, pa2, pa3); }                                                                    \
        if ((t) + 1 < NT) { asm volatile("s_waitcnt vmcnt(0)" ::: "memory"); SWRITE((KB) ^ 1); }                               \
        __syncthreads(); } while (0)
    for (int t = 0; t < NT; t += 2) { STEP(t, 0); STEP(t + 1, 1); }
#undef STEP
#undef SLOAD
#undef SWRITE
    if (hi == 0) li_l[r32] = l_reg;
    LDS_WAIT();
    LAS unsigned char* stg = (LAS unsigned char*)lds + OFF_OST + wid * OST_WAVE;
#pragma unroll
    for (int r = 0; r < 16; ++r) { const int orow = crow(r, hi); const float rl = __builtin_amdgcn_rcpf(li_l[orow]);
#pragma unroll
        for (int d0 = 0; d0 < 4; ++d0) *(LAS unsigned short*)(stg + orow * OST_ROW + (d0 * 32 + r32) * 2) = (unsigned short)(cvt_pk_bf16(o[d0][r] * rl, 0.f) & 0xffffu); }
    LDS_WAIT();
    if (MODE == 0) { if (hi == 0) Lse[(size_t)(qlo + r32) * NH] = m_reg + log2f(l_reg); }
#pragma unroll
    for (int i = 0; i < 8; ++i) { const int row = i * 4 + (lane >> 4), ch = lane & 15;
        u32x4 v = *(const LAS u32x4*)(stg + row * OST_ROW + ch * 16);
        const size_t go = (size_t)(qlo + row) * DM + ch * 8;
        if (MODE == 1) { const u32x4 z = *(const u32x4*)(Zg + go);
            v.x = cvt_pk_bf16(bflo(v.x) * silu_f(bflo(z.x)), bfhi(v.x) * silu_f(bfhi(z.x))); v.y = cvt_pk_bf16(bflo(v.y) * silu_f(bflo(z.y)), bfhi(v.y) * silu_f(bfhi(z.y)));
            v.z = cvt_pk_bf16(bflo(v.z) * silu_f(bflo(z.z)), bfhi(v.z) * silu_f(bfhi(z.z))); v.w = cvt_pk_bf16(bflo(v.w) * silu_f(bflo(z.w)), bfhi(v.w) * silu_f(bfhi(z.w))); }
        *(u32x4*)(Og + go) = v; }
    LDS_WAIT();
}
struct MaskA {
    int L;
    __device__ __forceinline__ void info(int kb, int qlo, int r32, bool& act, bool& need, unsigned& W) const {
        const int seq0 = qlo & ~(L - 1); int lowk = qlo - 128; if (lowk < seq0) lowk = seq0;
        act = (kb <= qlo + 31) && (kb + KVBLK - 1 >= lowk); need = true;
        const int wl = qlo + r32 - seq0 + 1; W = (unsigned)(wl < 129 ? wl : 129);
    }
};
struct MaskB {
    int own0, base0; unsigned sel;
    __device__ __forceinline__ void info(int kb, int qlo, int r32, bool& act, bool& need, unsigned& W) const {
        if (kb >= own0) { act = kb <= qlo + 31; need = kb + KVBLK - 1 > qlo; W = 0x40000000u; }
        else { const int blk = (kb - base0) >> 8; const bool s = (sel >> blk) & 1u; const unsigned long long bal = __ballot(s);
            act = bal != 0ull; need = bal != ~0ull; W = s ? 0x40000000u : 0u; }
    }
};
#undef KSWZ
#undef SBAR
}

namespace fb {
using namespace fa;
#define KSWZ(row, colB) ((row) * 256 + ((colB) ^ (((row) & 7) << 4)))
#define SBAR() __builtin_amdgcn_sched_barrier(0)
struct Blk {
    unsigned qoff, koff, voff;
    unsigned ooff, xoff;
    int R0, kb0, NT;
    float slopeL;
    int L, base0;
};
struct Nxt { unsigned qoff, koff, voff; int kb0; };
struct Seam { bf16x8 qr[8]; bf16x8 st_v0, st_v1, st_k0, st_k1; };
__device__ __forceinline__ void tile_info(const Blk& c, int kb, int qlo, int r32, unsigned sel, bool& act, bool& need, unsigned& W) {
    if (c.L > 0) { const int seq0 = qlo & ~(c.L - 1); int lowk = qlo - 128; if (lowk < seq0) lowk = seq0;
        act = (kb <= qlo + 31) && (kb + KVBLK - 1 >= lowk); need = true; const int wl = qlo + r32 - seq0 + 1; W = (unsigned)(wl < 129 ? wl : 129); }
    else if (kb >= c.R0) { act = kb <= qlo + 31; need = kb + KVBLK - 1 > qlo; W = 0x40000000u; }
    else { const int blk = (kb - c.base0) >> 8; const bool sb = (sel >> blk) & 1u; const unsigned long long bal = __ballot(sb);
        act = bal != 0ull; need = bal != ~0ull; W = sb ? 0x40000000u : 0u; }
}
template <int KB>
__device__ __forceinline__ void qkt2(f32x16& p0, f32x16& p1, const LAS char* K_lds, int r32, int hi, const bf16x8* qr, bool act, float slopeL, float a0) {
    if (!act) { const float NEG = -__builtin_inff();
#pragma unroll
        for (int r = 0; r < 16; ++r) { p0[r] = NEG; p1[r] = NEG; } return; }
#pragma unroll
    for (int r = 0; r < 16; ++r) { p0[r] = fmaf(slopeL, (float)((r & 3) + 8 * (r >> 2)), a0); p1[r] = fmaf(slopeL, (float)((r & 3) + 8 * (r >> 2) + 32), a0); }
    qkt<KB>(p0, p1, K_lds, r32, hi, qr);
}
#define ROWP(off, k0, rr) (wsb + ((size_t)(off) + (size_t)(k0) * (DM * 2)) + (unsigned)(((rr) * DM + sc) * 2))
#define VMW() asm volatile("s_waitcnt vmcnt(0)" ::: "memory")
#define SLOAD_H(Kp, Vp, k0) do { S.st_v0 = *(const bf16x8*)ROWP(Vp, k0, sr); S.st_v1 = *(const bf16x8*)ROWP(Vp, k0, 32 + sr); \
                                 S.st_k0 = *(const bf16x8*)ROWP(Kp, k0, sr); S.st_k1 = *(const bf16x8*)ROWP(Kp, k0, 32 + sr); } while (0)
#define SWRITE_HK(bf) do { *(LAS bf16x8*)(Kw + (bf) * SHM_K + kws) = S.st_k0; *(LAS bf16x8*)(Kw + (bf) * SHM_K + kws + 32 * 256) = S.st_k1; } while (0)
#define SWRITE_HV(bf) do { *(LAS bf16x8*)(Vw + (bf) * SHM_V + vst0) = S.st_v0; *(LAS bf16x8*)(Vw + (bf) * SHM_V + vst1) = S.st_v1; } while (0)
#define SWRITE_H(bf) do { SWRITE_HV(bf); SWRITE_HK(bf); } while (0)
__device__ __forceinline__ void prime(const unsigned char* wsb, const Blk& cur, unsigned char* lds, Seam& S, int tid) {
    const int wid = __builtin_amdgcn_readfirstlane(tid >> 6), lane = tid & 63, r32 = lane & 31, hi = lane >> 5;
    const int sr = tid >> 4, sc = (tid & 15) * 8, kws = KSWZ(sr, sc * 2);
    LAS char* Kw = (LAS char*)(LAS unsigned char*)lds + OFF_K;
#pragma unroll
    for (int d0 = 0; d0 < 8; ++d0) S.qr[d0] = *(const bf16x8*)(wsb + (size_t)cur.qoff + (unsigned)(((wid * 32 + r32) * DM + d0 * 16 + hi * 8) * 2));
    SLOAD_H(cur.koff, cur.voff, cur.kb0); VMW(); SWRITE_HK(0);
    __syncthreads();
}
template <int MODE>
__device__ __forceinline__ void block(const unsigned char* wsb, const Blk& cur, const Nxt& nxt, unsigned sel, unsigned char* lds, Seam& S, int tid) {
    const int wid = __builtin_amdgcn_readfirstlane(tid >> 6), lane = tid & 63, r32 = lane & 31, hi = lane >> 5;
    const LAS char* K_lds = (const LAS char*)(LAS unsigned char*)lds + OFF_K;
    LAS char* Kw = (LAS char*)(LAS unsigned char*)lds + OFF_K; LAS char* Vw = (LAS char*)(LAS unsigned char*)lds + OFF_V;
    LAS float* wsf = (LAS float*)((LAS unsigned char*)lds + OFF_WS) + wid * 64; LAS float* li_l = wsf; LAS float* al_l = wsf + 32;
    const int sr = tid >> 4, sc = (tid & 15) * 8, vst0 = v_st(sr, sc), vst1 = v_st(32 + sr, sc), kws = KSWZ(sr, sc * 2);
    const int vb0 = (int)(unsigned)(uintptr_t)((LAS unsigned char*)lds) + OFF_V + v_rd_base(lane);
    const int NT = cur.NT, qlo = cur.R0 + wid * 32, qm = qlo + r32 - 4 * hi;
    const float slopeL = cur.slopeL;
    const unsigned Kh = cur.koff, Vh = cur.voff;
    float m_reg = -1e30f, l_reg = 0.f; f32x16 o[4] = {};
#define KBASE(t) (cur.kb0 + (t) * KVBLK)
#define RESC(a) do { if (__any((a) < 1.f)) { if (hi == 0) al_l[r32] = (a); LDS_WAIT(); \
        _Pragma("unroll") for (int d_ = 0; d_ < 4; ++d_) _Pragma("unroll") for (int r = 0; r < 16; ++r) o[d_][r] *= al_l[crow(r, hi)]; } } while (0)
#define QKT(PX0, PX1, t, KB, ACTV) do { const int kb_ = KBASE(t); bool nd_; unsigned W_; tile_info(cur, kb_, qlo, r32, sel, ACTV, nd_, W_); \
        qkt2<KB>(PX0, PX1, K_lds, r32, hi, S.qr, ACTV, slopeL, slopeL * (float)(kb_ - qm)); } while (0)
#define MASKT(PX0, PX1, t) do { const int kb_ = KBASE(t); bool ac_, nd_; unsigned W_; tile_info(cur, kb_, qlo, r32, sel, ac_, nd_, W_); \
        if (ac_ && nd_) mask_tile(PX0, PX1, qm - kb_, W_); } while (0)
    f32x16 pA0, pA1, pB0, pB1; float alA, alB; bf16x8 pa0, pa1, pa2, pa3; bool actA, actB;
    SWRITE_HV(0); SBAR();
    SLOAD_H(Kh, Vh, KBASE(1));
    SBAR(); QKT(pA0, pA1, 0, 0, actA);
    MASKT(pA0, pA1, 0); partialSM(pA0, pA1, m_reg, alA);
    VMW(); SWRITE_H(1);
    __syncthreads();
#define HALF_STEP(PX0, PX1, alX, actX, PY0, PY1, alY, actY, t, KB, VB, SB) do {                                                 \
        SBAR(); QKT(PX0, PX1, t, KB, actX);                                                                                   \
        finishSM(PY0, PY1, alY, l_reg, pa0, pa1, pa2, pa3); SBAR();                                                           \
        if ((t) + 1 < NT) { SLOAD_H(Kh, Vh, KBASE((t) + 1)); SBAR(); }                                                        \
        if (actY) pv_tile<VB>(o, vb0, pa0, pa1, pa2, pa3);                                                                    \
        MASKT(PX0, PX1, (t)); partialSM(PX0, PX1, m_reg, alX);                                                                \
        __syncthreads();                                                                                                      \
        if ((t) + 1 < NT) { VMW(); SWRITE_H(SB); }                                                                            \
        RESC(alX); __syncthreads(); } while (0)
    for (int t = 1; t + 1 < NT; t += 2) {
        HALF_STEP(pB0, pB1, alB, actB, pA0, pA1, alA, actA, t, 1, 0, 0);
        HALF_STEP(pA0, pA1, alA, actA, pB0, pB1, alB, actB, t + 1, 0, 1, 1);
    }
    SBAR(); QKT(pB0, pB1, NT - 1, 1, actB); SBAR();
    SLOAD_H(nxt.koff, nxt.voff, nxt.kb0); SBAR();
#pragma unroll
    for (int d0 = 0; d0 < 8; ++d0) S.qr[d0] = *(const bf16x8*)(wsb + (size_t)nxt.qoff + (unsigned)(((wid * 32 + r32) * DM + d0 * 16 + hi * 8) * 2));
    SBAR();
    finishSM(pA0, pA1, alA, l_reg, pa0, pa1, pa2, pa3); SBAR();
    if (actA) pv_tile<0>(o, vb0, pa0, pa1, pa2, pa3);
    MASKT(pB0, pB1, NT - 1); partialSM(pB0, pB1, m_reg, alB); __syncthreads(); RESC(alB);
    finishSM(pB0, pB1, alB, l_reg, pa0, pa1, pa2, pa3); SBAR();
    if (actB) pv_tile<1>(o, vb0, pa0, pa1, pa2, pa3);
    SBAR(); asm volatile("s_waitcnt vmcnt(8)" ::: "memory"); SWRITE_HK(0); SBAR();
    int tid2 = tid; asm volatile("" : "+v"(tid2));
    const int lane2 = tid2 & 63, r32e = lane2 & 31, hie = lane2 >> 5;
    if (hie == 0) li_l[r32e] = l_reg;
    LDS_WAIT();
    LAS unsigned char* stg = (LAS unsigned char*)lds + OFF_OST + wid * OST_WAVE;
#pragma unroll
    for (int r = 0; r < 16; ++r) { const int orow = crow(r, hie); const float rl = __builtin_amdgcn_rcpf(li_l[orow]);
#pragma unroll
        for (int d0 = 0; d0 < 4; ++d0) *(LAS unsigned short*)(stg + orow * OST_ROW + (d0 * 32 + r32e) * 2) = (unsigned short)(cvt_pk_bf16(o[d0][r] * rl, 0.f) & 0xffffu); }
    LDS_WAIT();
    if (MODE == 0) { if (hie == 0) *(float*)(const_cast<unsigned char*>(wsb) + (size_t)cur.xoff + (unsigned)((qlo + r32e) * NH * 4)) = m_reg + log2f(l_reg); }
#pragma unroll
    for (int i = 0; i < 8; ++i) { const int row = i * 4 + (lane2 >> 4), ch = lane2 & 15;
        u32x4 v = *(const LAS u32x4*)(stg + row * OST_ROW + ch * 16);
        const unsigned go = (unsigned)(((qlo + row) * DM + ch * 8) * 2);
        if (MODE == 1) { const u32x4 z = *(const u32x4*)(wsb + (size_t)cur.xoff + go);
            v.x = cvt_pk_bf16(bflo(v.x) * silu_f(bflo(z.x)), bfhi(v.x) * silu_f(bfhi(z.x))); v.y = cvt_pk_bf16(bflo(v.y) * silu_f(bflo(z.y)), bfhi(v.y) * silu_f(bfhi(z.y)));
            v.z = cvt_pk_bf16(bflo(v.z) * silu_f(bflo(z.z)), bfhi(v.z) * silu_f(bfhi(z.z))); v.w = cvt_pk_bf16(bflo(v.w) * silu_f(bflo(z.w)), bfhi(v.w) * silu_f(bfhi(z.w))); }
        *(u32x4*)(const_cast<unsigned char*>(wsb) + (size_t)cur.ooff + go) = v; }
    __syncthreads();
#undef KBASE
#undef RESC
#undef QKT
#undef MASKT
#undef HALF_STEP
}
#undef ROWP
#undef VMW
#undef SLOAD_H
#undef SWRITE_HK
#undef SWRITE_HV
#undef SWRITE_H
#undef KSWZ
#undef SBAR
}

namespace fc {
using namespace fa;
constexpr int NSLOT = 3;
constexpr int R_K = 0, R_V = NSLOT * SHM_K, R_WS = R_V + NSLOT * SHM_V, WSW = 96, R_OST = R_WS + 8 * WSW * 4, OSTR = 144, OSTW = 32 * OSTR;
constexpr int R_GK = R_OST + 8 * OSTW, R_SEL = R_GK + 2 * 7 * 128 * 4, R_END = R_SEL + 256 * 4;
static_assert(R_END <= LDS_BYTES - 64, "attention LDS map");
#define KSWZ(row, colB) ((row) * 256 + ((colB) ^ (((row) & 7) << 4)))
#define SBAR() __builtin_amdgcn_sched_barrier(0)
struct Blk {
    unsigned qoff, koff, voff, ooff, xoff;
    unsigned zoff, goff;
    int R0, kb0, NT;
    float slopeL;
    int L, base0;
};
struct Nxt { unsigned qoff, koff, voff; int kb0; };
__device__ __forceinline__ void glds16(const void* sbase, unsigned voff, unsigned lds_dst) { unsigned keep;
    asm volatile("s_mov_b32 %0, m0\n\ts_mov_b32 m0, %3\n\ts_nop 0\n\tglobal_load_lds_dwordx4 %1, %2\n\ts_mov_b32 m0, %0" : "=&s"(keep) : "v"(voff), "s"(sbase), "s"(lds_dst) : "memory"); }
__device__ __forceinline__ void qkt_r(f32x16& p0, f32x16& p1, const LAS char* Kslot, int r32, int hi, const bf16x8* qr) {
    const LAS char* kb[4];
#pragma unroll
    for (int dd = 0; dd < 4; ++dd) kb[dd] = Kslot + KSWZ(r32, (dd * 16 + hi * 8) * 2);
    bf16x8 c0 = *reinterpret_cast<const LAS bf16x8*>(kb[0]), c1 = *reinterpret_cast<const LAS bf16x8*>(kb[0] + 32 * 256);
#pragma unroll
    for (int d0 = 0; d0 < 8; ++d0) {
        bf16x8 n0 = c0, n1 = c1;
        if (d0 < 7) { const LAS char* a = kb[(d0 + 1) & 3] + ((d0 + 1) >> 2) * 128; n0 = *reinterpret_cast<const LAS bf16x8*>(a); n1 = *reinterpret_cast<const LAS bf16x8*>(a + 32 * 256); }
        p0 = __builtin_amdgcn_mfma_f32_32x32x16_bf16(c0, qr[d0], p0, 0, 0, 0);
        p1 = __builtin_amdgcn_mfma_f32_32x32x16_bf16(c1, qr[d0], p1, 0, 0, 0);
        c0 = n0; c1 = n1; }
}
__device__ __forceinline__ void pv_r(f32x16* o, int vb, bf16x8 pa0, bf16x8 pa1, bf16x8 pa2, bf16x8 pa3) {
#define TRRD(dst, off) asm volatile("ds_read_b64_tr_b16 %0, %1 offset:%2" : "=&v"(dst) : "v"(vb), "i"(off) : "memory")
#define PV_D0(d0) do { s16x4 l0, l1, l2, l3, h0, h1, h2, h3; constexpr int b_ = v_rd_off(d0, 0, 0); \
        TRRD(l0, b_); TRRD(h0, b_ + 2048); TRRD(l1, b_ + 4096); TRRD(h1, b_ + 6144); TRRD(l2, b_ + 8192); TRRD(h2, b_ + 10240); TRRD(l3, b_ + 12288); TRRD(h3, b_ + 14336); \
        asm volatile("s_waitcnt lgkmcnt(0)" ::: "memory"); SBAR();   \
        o[d0] = __builtin_amdgcn_mfma_f32_32x32x16_bf16(pa0, (bf16x8){l0[0], l0[1], l0[2], l0[3], h0[0], h0[1], h0[2], h0[3]}, o[d0], 0, 0, 0);   \
        o[d0] = __builtin_amdgcn_mfma_f32_32x32x16_bf16(pa1, (bf16x8){l1[0], l1[1], l1[2], l1[3], h1[0], h1[1], h1[2], h1[3]}, o[d0], 0, 0, 0);   \
        o[d0] = __builtin_amdgcn_mfma_f32_32x32x16_bf16(pa2, (bf16x8){l2[0], l2[1], l2[2], l2[3], h2[0], h2[1], h2[2], h2[3]}, o[d0], 0, 0, 0);   \
        o[d0] = __builtin_amdgcn_mfma_f32_32x32x16_bf16(pa3, (bf16x8){l3[0], l3[1], l3[2], l3[3], h3[0], h3[1], h3[2], h3[3]}, o[d0], 0, 0, 0); } while (0)
    PV_D0(0); PV_D0(1); PV_D0(2); PV_D0(3);
#undef PV_D0
#undef TRRD
}
__device__ __forceinline__ void tile_info(const Blk& c, int kb, int qlo, int r32, unsigned sel, bool& act, bool& need, unsigned& W, bool& dead) {
    dead = false;
    if (c.L > 0) { const int seq0 = qlo & ~(c.L - 1); int lowk = qlo - 128; if (lowk < seq0) lowk = seq0;
        act = (kb <= qlo + 31) && (kb + KVBLK - 1 >= lowk); need = true; const int wl = qlo + r32 - seq0 + 1; W = (unsigned)(wl < 129 ? wl : 129); }
    else if (kb >= c.R0) { act = kb <= qlo + 31; need = kb + KVBLK - 1 > qlo; W = 0x40000000u; }
    else { const int blk = (kb - c.base0) >> 8; const bool sb = (sel >> blk) & 1u; act = __ballot(sb) != 0ull; need = false; W = 0x40000000u; dead = !sb; }
}
struct Ring { int kt; };
__device__ __forceinline__ int nx3(int s) { return s == 2 ? 0 : s + 1; }
struct DmaLane { unsigned vk0, vk1, vv0, vv1; };
__device__ __forceinline__ DmaLane dma_lane(int wid, int lane) {
    DmaLane d;
    { const int row0 = wid * 8 + (lane >> 4), row1 = row0 + 4, cs = lane & 15;
      d.vk0 = (unsigned)(row0 * DM * 2 + ((cs ^ (row0 & 7)) * 16)); d.vk1 = (unsigned)(row1 * DM * 2 + ((cs ^ (row1 & 7)) * 16)); }
    { const int gi = lane & 31, kk = wid * 8 + (gi >> 2), k = (kk & ~0xC) | ((kk & 4) << 1) | ((kk & 8) >> 1);
      const int c0 = ((lane >> 5)) * 32 + (gi & 3) * 8, c1 = c0 + 64;
      d.vv0 = (unsigned)(k * DM * 2 + c0 * 2); d.vv1 = (unsigned)(k * DM * 2 + c1 * 2); }
    return d;
}
#define DMA_K(srcoff, kbrow, slot) do { const unsigned char* sb_ = wsb + ((size_t)(srcoff) + (size_t)(kbrow) * (DM * 2)); const unsigned ld_ = ldsb + R_K + (slot) * SHM_K + wid * 2048; \
        glds16(sb_, dl.vk0, ld_); glds16(sb_, dl.vk1, ld_ + 1024); } while (0)
#define DMA_V(srcoff, kbrow, slot) do { const unsigned char* sb_ = wsb + ((size_t)(srcoff) + (size_t)(kbrow) * (DM * 2)); const unsigned ld_ = ldsb + R_V + (slot) * SHM_V + wid * 2048; \
        glds16(sb_, dl.vv0, ld_); glds16(sb_, dl.vv1, ld_ + 1024); } while (0)
#define WAITBAR(N) asm volatile("s_waitcnt vmcnt(" #N ") lgkmcnt(0)\n\ts_barrier" ::: "memory")
__device__ __forceinline__ void prime(const unsigned char* wsb, const Blk& cur, unsigned char* lds, bf16x8* qr, Ring& rg, int tid) {
    const int wid = __builtin_amdgcn_readfirstlane(tid >> 6), lane = tid & 63, r32 = lane & 31, hi = lane >> 5;
    const unsigned ldsb = (unsigned)(uintptr_t)((LAS unsigned char*)lds);
    const DmaLane dl = dma_lane(wid, lane);
    DMA_K(cur.koff, cur.kb0, 0); DMA_V(cur.voff, cur.kb0, 0); DMA_K(cur.koff, cur.kb0 + KVBLK, 1);
#pragma unroll
    for (int d0 = 0; d0 < 8; ++d0) qr[d0] = *(const bf16x8*)(wsb + (size_t)cur.qoff + (unsigned)(((wid * 32 + r32) * DM + d0 * 16 + hi * 8) * 2));
    rg.kt = 0;
    WAITBAR(0);
}
template <int MODE>
__device__ __forceinline__ void block(const unsigned char* wsb, const Blk& cur, const Nxt& nxt, bool has_next, unsigned sel, unsigned char* lds, bf16x8* qr, Ring& rg, int tid) {
    const int wid = __builtin_amdgcn_readfirstlane(tid >> 6), lane = tid & 63, r32 = lane & 31, hi = lane >> 5;
    const unsigned ldsb = (unsigned)(uintptr_t)((LAS unsigned char*)lds);
    const LAS char* K_lds = (const LAS char*)(LAS unsigned char*)lds + R_K;
    LAS float* wsf = (LAS float*)((LAS unsigned char*)lds + R_WS) + wid * WSW; LAS float* li_l = wsf; LAS float* al_l = wsf + 32;
    const int vbl = (int)ldsb + R_V + v_rd_base(lane);
    const DmaLane dl = dma_lane(wid, lane);
    const int NT = cur.NT, qlo = cur.R0 + wid * 32, qm = qlo + r32 - 4 * hi;
    const float slopeL = cur.slopeL;
    float m_reg = -1e30f, l_reg = 0.f; f32x16 o[4] = {};
    int kt = rg.kt;
#define RESC(a) do { if (__any((a) < 1.f)) { if (hi == 0) al_l[r32] = (a); LDS_WAIT(); \
        _Pragma("unroll") for (int d_ = 0; d_ < 4; ++d_) _Pragma("unroll") for (int r = 0; r < 16; ++r) o[d_][r] *= al_l[crow(r, hi)]; } } while (0)
#define STEPX(PX0, PX1, alX, actX, PY0, PY1, alY, actY, t, HAVEY) do {                                                                \
        const int kb_ = cur.kb0 + (t) * KVBLK; bool nd_, dd_; unsigned W_; tile_info(cur, kb_, qlo, r32, sel, actX, nd_, W_, dd_);   \
        SBAR();                                                                                                                       \
        if (actX) { const float a0_ = dd_ ? -__builtin_inff() : slopeL * (float)(kb_ - qm);                                           \
            _Pragma("unroll") for (int r = 0; r < 16; ++r) { PX0[r] = fmaf(slopeL, (float)((r & 3) + 8 * (r >> 2)), a0_); PX1[r] = fmaf(slopeL, (float)((r & 3) + 8 * (r >> 2) + 32), a0_); } \
            qkt_r(PX0, PX1, K_lds + kt * SHM_K, r32, hi, qr);                                                                         \
            if (HAVEY) finishSM(PY0, PY1, alY, l_reg, pa0, pa1, pa2, pa3); }                                                          \
        else { _Pragma("unroll") for (int r = 0; r < 16; ++r) { PX0[r] = -__builtin_inff(); PX1[r] = -__builtin_inff(); }             \
            if (HAVEY) finishSM(PY0, PY1, alY, l_reg, pa0, pa1, pa2, pa3); }                                                          \
        SBAR();                                                                                                                       \
        { const int s2_ = kt == 0 ? 2 : kt - 1, s1_ = nx3(kt);                           \
          const bool in2_ = (t) + 2 < NT, in1_ = (t) + 1 < NT;                                                                        \
          if (in2_) DMA_K(cur.koff, kb_ + 2 * KVBLK, s2_); else if (has_next) DMA_K(nxt.koff, nxt.kb0 + ((t) + 2 - NT) * KVBLK, s2_);        \
          if (in1_) DMA_V(cur.voff, kb_ + KVBLK, s1_); else if (has_next) DMA_V(nxt.voff, nxt.kb0 + ((t) + 1 - NT) * KVBLK, s1_); }         \
        SBAR();                                                                                                                       \
        if (HAVEY) { if (actY) pv_r(o, vbl + (kt == 0 ? 2 : kt - 1) * SHM_V, pa0, pa1, pa2, pa3); }                                   \
        if (actX && nd_) mask_tile(PX0, PX1, qm - kb_, W_);                                                                           \
        partialSM(PX0, PX1, m_reg, alX);                                                                                              \
        RESC(alX);                                                                                                                    \
        if ((t) + 2 < NT || has_next) WAITBAR(4); else if ((t) + 1 < NT) WAITBAR(2); else WAITBAR(0);                                 \
        kt = nx3(kt); } while (0)
    f32x16 pA0, pA1, pB0, pB1; float alA = 1.f, alB = 1.f; bf16x8 pa0, pa1, pa2, pa3; bool actA = false, actB = false;
    STEPX(pA0, pA1, alA, actA, pB0, pB1, alB, actB, 0, false);
    STEPX(pB0, pB1, alB, actB, pA0, pA1, alA, actA, 1, true);
    for (int t = 2; t < NT; t += 2) {
        STEPX(pA0, pA1, alA, actA, pB0, pB1, alB, actB, t, true);
        STEPX(pB0, pB1, alB, actB, pA0, pA1, alA, actA, t + 1, true);
    }
    finishSM(pB0, pB1, alB, l_reg, pa0, pa1, pa2, pa3); SBAR();
    if (actB) pv_r(o, vbl + (kt == 0 ? 2 : kt - 1) * SHM_V, pa0, pa1, pa2, pa3);
    SBAR();
    if (has_next) {
#pragma unroll
        for (int d0 = 0; d0 < 8; ++d0) qr[d0] = *(const bf16x8*)(wsb + (size_t)nxt.qoff + (unsigned)(((wid * 32 + r32) * DM + d0 * 16 + hi * 8) * 2));
    }
    SBAR();
    rg.kt = kt;
    int tid2 = tid; asm volatile("" : "+v"(tid2));
    const int lane2 = tid2 & 63, r32e = lane2 & 31, hie = lane2 >> 5;
    unsigned char* wsw = const_cast<unsigned char*>(wsb);
    if (MODE == 2) {
        if (hie == 0) { const int R = qlo + r32e, bb = R >> 11, t = ((R & 127) << 4) | ((R >> 7) & 15), T0 = (bb << 11) + t, T1 = (bb << 11) + ((t & 3) << 9) + (t >> 2);
            const float l2 = m_reg + log2f(l_reg);
            const float l0 = *(const float*)(wsb + (size_t)cur.xoff + (unsigned)(T0 * NH * 4)), l1 = *(const float*)(wsb + (size_t)cur.xoff + (size_t)MTOK * NH * 4 + (unsigned)(T1 * NH * 4));
            const float mx = fmaxf(l0, fmaxf(l1, l2)); const float e0 = exp2f(l0 - mx), e1 = exp2f(l1 - mx), e2 = exp2f(l2 - mx), inv = 1.f / (e0 + e1 + e2);
            li_l[r32e] = e2 * inv / l_reg; al_l[r32e] = e0 * inv; al_l[32 + r32e] = e1 * inv; }
    } else { if (hie == 0) li_l[r32e] = 1.f / l_reg; }
    LDS_WAIT();
    if (MODE == 0) { if (hie == 0) *(float*)(wsw + (size_t)cur.xoff + (unsigned)((qlo + r32e) * NH * 4)) = m_reg + log2f(l_reg); }
    LAS unsigned char* stg = (LAS unsigned char*)lds + R_OST + wid * OSTW;
    float rl[16];
#pragma unroll
    for (int r = 0; r < 16; ++r) rl[r] = li_l[crow(r, hie)];
    u32x4 pg0[4], pg1[4], pzz[4]; unsigned tof[4];
#define PREF(hf_) do { _Pragma("unroll") for (int i = 0; i < 4; ++i) { const int row = i * 8 + (lane2 >> 3), ch = lane2 & 7; const unsigned cb = (unsigned)(((hf_) * 64 + ch * 8) * 2); \
            const int R = qlo + row, bb = R >> 11, t = ((R & 127) << 4) | ((R >> 7) & 15), T0 = (bb << 11) + t, T1 = (bb << 11) + ((t & 3) << 9) + (t >> 2);                    \
            tof[i] = (unsigned)(T0 * DM * 2);                                                                                                                                   \
            pg0[i] = *(const u32x4*)(wsb + (size_t)cur.ooff + tof[i] + cb); pg1[i] = *(const u32x4*)(wsb + (size_t)cur.ooff + (size_t)PART * 2 + (unsigned)(T1 * DM * 2) + cb); \
            pzz[i] = *(const u32x4*)(wsb + (size_t)cur.zoff + tof[i] + cb); } } while (0)
    if (MODE == 2) PREF(0);
#pragma unroll
    for (int hf = 0; hf < 2; ++hf) {
#pragma unroll
        for (int r = 0; r < 16; ++r) { const int orow = crow(r, hie);
#pragma unroll
            for (int dd = 0; dd < 2; ++dd) *(LAS unsigned short*)(stg + orow * OSTR + (dd * 32 + r32e) * 2) = (unsigned short)(cvt_pk_bf16(o[2 * hf + dd][r] * rl[r], 0.f) & 0xffffu); }
        LDS_WAIT();
        if (MODE == 2) {
            u32x4 vv[4];
#pragma unroll
            for (int i = 0; i < 4; ++i) { const int row = i * 8 + (lane2 >> 3), ch = lane2 & 7;
                u32x4 v = *(const LAS u32x4*)(stg + row * OSTR + ch * 16);
                const float a0 = al_l[row], a1 = al_l[32 + row]; const u32x4 g0 = pg0[i], g1 = pg1[i], z = pzz[i];
#define MRG(F) v.F = cvt_pk_bf16((bflo(v.F) + a0 * bflo(g0.F) + a1 * bflo(g1.F)) * silu_f(bflo(z.F)), (bfhi(v.F) + a0 * bfhi(g0.F) + a1 * bfhi(g1.F)) * silu_f(bfhi(z.F)));
                MRG(x) MRG(y) MRG(z) MRG(w)
#undef MRG
                vv[i] = v; }
            unsigned tsv[4];
#pragma unroll
            for (int i = 0; i < 4; ++i) tsv[i] = tof[i];
            if (hf == 0) PREF(1);
#pragma unroll
            for (int i = 0; i < 4; ++i) { const int ch = lane2 & 7; store_wt(wsw + (size_t)cur.goff + tsv[i] + (unsigned)((hf * 64 + ch * 8) * 2), vv[i]); }
        } else {
#pragma unroll
            for (int i = 0; i < 4; ++i) { const int row = i * 8 + (lane2 >> 3), ch = lane2 & 7;
                u32x4 v = *(const LAS u32x4*)(stg + row * OSTR + ch * 16);
                const unsigned go = (unsigned)((qlo + row) * DM * 2) + (unsigned)((hf * 64 + ch * 8) * 2);
                if (MODE == 1) { const u32x4 z = *(const u32x4*)(wsb + (size_t)cur.xoff + go);
                    v.x = cvt_pk_bf16(bflo(v.x) * silu_f(bflo(z.x)), bfhi(v.x) * silu_f(bfhi(z.x))); v.y = cvt_pk_bf16(bflo(v.y) * silu_f(bflo(z.y)), bfhi(v.y) * silu_f(bfhi(z.y)));
                    v.z = cvt_pk_bf16(bflo(v.z) * silu_f(bflo(z.z)), bfhi(v.z) * silu_f(bfhi(z.z))); v.w = cvt_pk_bf16(bflo(v.w) * silu_f(bflo(z.w)), bfhi(v.w) * silu_f(bfhi(z.w))); }
                store_wt(wsw + (size_t)cur.ooff + go, v); } }
        LDS_WAIT();
    }
#undef PREF
#undef RESC
#undef STEPX
}
#undef DMA_K
#undef DMA_V
#undef WAITBAR
#undef KSWZ
#undef SBAR
}

namespace fd {
using namespace fa;
using fc::Blk; using fc::Nxt; using fc::Ring; using fc::DmaLane; using fc::dma_lane; using fc::glds16; using fc::qkt_r; using fc::pv_r; using fc::tile_info; using fc::nx3;
using fc::R_K; using fc::R_V; using fc::R_WS; using fc::R_OST; using fc::OSTR; using fc::OSTW;
#define SBAR() __builtin_amdgcn_sched_barrier(0)
#define DMA_K(srcoff, kbrow, slot) do { const unsigned char* sb_ = wsb + ((size_t)(srcoff) + (size_t)(kbrow) * (DM * 2)); const unsigned ld_ = ldsb + R_K + (slot) * SHM_K + wid * 2048; \
        glds16(sb_, dl.vk0, ld_); glds16(sb_, dl.vk1, ld_ + 1024); } while (0)
#define DMA_V(srcoff, kbrow, slot) do { const unsigned char* sb_ = wsb + ((size_t)(srcoff) + (size_t)(kbrow) * (DM * 2)); const unsigned ld_ = ldsb + R_V + (slot) * SHM_V + wid * 2048; \
        glds16(sb_, dl.vv0, ld_); glds16(sb_, dl.vv1, ld_ + 1024); } while (0)
#define WAITBAR(N) asm volatile("s_waitcnt vmcnt(" #N ") lgkmcnt(0)\n\ts_barrier" ::: "memory")
__device__ __forceinline__ void softmax_tile(f32x16& p0, f32x16& p1, float& m_reg, float& l_reg, float& alpha, bf16x8& pa0, bf16x8& pa1, bf16x8& pa2, bf16x8& pa3) {
    partialSM(p0, p1, m_reg, alpha);
    finishSM(p0, p1, alpha, l_reg, pa0, pa1, pa2, pa3);
}
__device__ __forceinline__ void prime(const unsigned char* wsb, const Blk& cur, unsigned char* lds, bf16x8* qr, Ring& rg, int tid) {
    const int wid = __builtin_amdgcn_readfirstlane(tid >> 6), lane = tid & 63, r32 = lane & 31, hi = lane >> 5;
    const unsigned ldsb = (unsigned)(uintptr_t)((LAS unsigned char*)lds);
    const DmaLane dl = dma_lane(wid, lane);
    DMA_K(cur.koff, cur.kb0, 0); DMA_V(cur.voff, cur.kb0, 0); DMA_K(cur.koff, cur.kb0 + KVBLK, 1);
#pragma unroll
    for (int d0 = 0; d0 < 8; ++d0) qr[d0] = *(const bf16x8*)(wsb + (size_t)cur.qoff + (unsigned)(((wid * 32 + r32) * DM + d0 * 16 + hi * 8) * 2));
    rg.kt = 0;
    WAITBAR(0);
    if (wid >= 4) WAITBAR(0);
}
__device__ __forceinline__ void finish(int tid) {
    const int wid = __builtin_amdgcn_readfirstlane(tid >> 6);
    if (wid < 4) WAITBAR(0);
}
template <int MODE>
__device__ __forceinline__ void block(const unsigned char* wsb, const Blk& cur, const Nxt& nxt, bool has_next, unsigned sel, unsigned char* lds, bf16x8* qr, Ring& rg, int tid) {
    const int wid = __builtin_amdgcn_readfirstlane(tid >> 6), lane = tid & 63, r32 = lane & 31, hi = lane >> 5;
    const unsigned ldsb = (unsigned)(uintptr_t)((LAS unsigned char*)lds);
    const LAS char* K_lds = (const LAS char*)(LAS unsigned char*)lds + R_K;
    LAS float* wsf = (LAS float*)((LAS unsigned char*)lds + R_WS) + wid * fc::WSW; LAS float* li_l = wsf; LAS float* al_l = wsf + 32;
    const int vbl = (int)ldsb + R_V + v_rd_base(lane);
    const DmaLane dl = dma_lane(wid, lane);
    const int NT = cur.NT, qlo = cur.R0 + wid * 32, qm = qlo + r32 - 4 * hi;
    const float slopeL = cur.slopeL;
    float m_reg = -1e30f, l_reg = 0.f; f32x16 o[4] = {};
    int kt = rg.kt;
    f32x16 p0, p1; bf16x8 pa0, pa1, pa2, pa3; bool actP = false;
    for (int t = 0; t < NT; ++t) {
        const int kb_ = cur.kb0 + t * KVBLK; bool act, nd_, dd_; unsigned W_; tile_info(cur, kb_, qlo, r32, sel, act, nd_, W_, dd_);
        { const int s2_ = kt == 0 ? 2 : kt - 1, s1_ = nx3(kt);
          const bool in2_ = t + 2 < NT, in1_ = t + 1 < NT;
          if (in2_) DMA_K(cur.koff, kb_ + 2 * KVBLK, s2_); else if (has_next) DMA_K(nxt.koff, nxt.kb0 + (t + 2 - NT) * KVBLK, s2_);
          if (in1_) DMA_V(cur.voff, kb_ + KVBLK, s1_); else if (has_next) DMA_V(nxt.voff, nxt.kb0 + (t + 1 - NT) * KVBLK, s1_); }
        SBAR();
        if (act) { const float a0_ = dd_ ? -__builtin_inff() : slopeL * (float)(kb_ - qm);
#pragma unroll
            for (int r = 0; r < 16; ++r) { p0[r] = fmaf(slopeL, (float)((r & 3) + 8 * (r >> 2)), a0_); p1[r] = fmaf(slopeL, (float)((r & 3) + 8 * (r >> 2) + 32), a0_); }
            qkt_r(p0, p1, K_lds + kt * SHM_K, r32, hi, qr); }
        if (actP) pv_r(o, vbl + (kt == 0 ? 2 : kt - 1) * SHM_V, pa0, pa1, pa2, pa3);
        SBAR();
        if (t + 2 < NT || has_next) WAITBAR(4); else WAITBAR(0);
        if (act) { float alpha;
            if (nd_) mask_tile(p0, p1, qm - kb_, W_);
            softmax_tile(p0, p1, m_reg, l_reg, alpha, pa0, pa1, pa2, pa3);
            if (__any(alpha < 1.f)) { if (hi == 0) al_l[r32] = alpha; LDS_WAIT();
#pragma unroll
                for (int d_ = 0; d_ < 4; ++d_)
#pragma unroll
                    for (int r = 0; r < 16; ++r) o[d_][r] *= al_l[crow(r, hi)]; } }
        actP = act;
        SBAR();
        if (t + 2 < NT || has_next) WAITBAR(4); else WAITBAR(0);
        kt = nx3(kt);
    }
    if (actP) pv_r(o, vbl + (kt == 0 ? 2 : kt - 1) * SHM_V, pa0, pa1, pa2, pa3);
    SBAR();
    if (has_next) {
#pragma unroll
        for (int d0 = 0; d0 < 8; ++d0) qr[d0] = *(const bf16x8*)(wsb + (size_t)nxt.qoff + (unsigned)(((wid * 32 + r32) * DM + d0 * 16 + hi * 8) * 2));
    }
    SBAR();
    rg.kt = kt;
    if (has_next) WAITBAR(4); else WAITBAR(0);
    int tid2 = tid; asm volatile("" : "+v"(tid2));
    const int lane2 = tid2 & 63, r32e = lane2 & 31, hie = lane2 >> 5;
    if (hie == 0) li_l[r32e] = l_reg;
    LDS_WAIT();
    if (MODE == 0) { if (hie == 0) *(float*)(const_cast<unsigned char*>(wsb) + (size_t)cur.xoff + (unsigned)((qlo + r32e) * NH * 4)) = m_reg + log2f(l_reg); }
    LAS unsigned char* stg = (LAS unsigned char*)lds + R_OST + wid * OSTW;
    float rl[16];
#pragma unroll
    for (int r = 0; r < 16; ++r) rl[r] = __builtin_amdgcn_rcpf(li_l[crow(r, hie)]);
#pragma unroll
    for (int hf = 0; hf < 2; ++hf) {
#pragma unroll
        for (int r = 0; r < 16; ++r) { const int orow = crow(r, hie);
#pragma unroll
            for (int dd = 0; dd < 2; ++dd) *(LAS unsigned short*)(stg + orow * OSTR + (dd * 32 + r32e) * 2) = (unsigned short)(cvt_pk_bf16(o[2 * hf + dd][r] * rl[r], 0.f) & 0xffffu); }
        LDS_WAIT();
#pragma unroll
        for (int i = 0; i < 4; ++i) { const int row = i * 8 + (lane2 >> 3), ch = lane2 & 7;
            u32x4 v = *(const LAS u32x4*)(stg + row * OSTR + ch * 16);
            const unsigned go = (unsigned)(((qlo + row) * DM + hf * 64 + ch * 8) * 2);
            if (MODE == 1) { const u32x4 z = *(const u32x4*)(wsb + (size_t)cur.xoff + go);
                v.x = cvt_pk_bf16(bflo(v.x) * silu_f(bflo(z.x)), bfhi(v.x) * silu_f(bfhi(z.x))); v.y = cvt_pk_bf16(bflo(v.y) * silu_f(bflo(z.y)), bfhi(v.y) * silu_f(bfhi(z.y)));
                v.z = cvt_pk_bf16(bflo(v.z) * silu_f(bflo(z.z)), bfhi(v.z) * silu_f(bfhi(z.z))); v.w = cvt_pk_bf16(bflo(v.w) * silu_f(bflo(z.w)), bfhi(v.w) * silu_f(bfhi(z.w))); }
            *(u32x4*)(const_cast<unsigned char*>(wsb) + (size_t)cur.ooff + go) = v; }
        LDS_WAIT();
    }
    if (has_next) WAITBAR(4); else WAITBAR(0);
}
#undef DMA_K
#undef DMA_V
#undef WAITBAR
#undef SBAR
}

__device__ __forceinline__ fb::Blk blk_a(int it) {
    const int g = it >> 9, rem = it & 511, h = rem & 15, rb = rem < 256 ? (rem >> 4) : 31 - ((rem - 256) >> 4), lg = 2 * g, L = SEQ >> lg, R0 = rb * 256;
    int kb0 = R0 - 128; { const int s0 = R0 & ~(L - 1); if (kb0 < s0) kb0 = s0; }
    fb::Blk b;
    b.qoff = (unsigned)(WS_QKV + ((size_t)(3 * g) * PART + (size_t)R0 * DM + h * HD) * 2); b.koff = (unsigned)(WS_QKV + ((size_t)(3 * g + 1) * PART + h * HD) * 2); b.voff = (unsigned)(WS_QKV + ((size_t)(3 * g + 2) * PART + h * HD) * 2);
    b.ooff = (unsigned)(WS_OG + ((size_t)g * PART + h * HD) * 2); b.xoff = (unsigned)(WS_LSE + ((size_t)g * MTOK * NH + h) * 4);
    b.R0 = R0; b.kb0 = kb0; b.NT = (R0 + 256 - kb0) >> 6; b.slopeL = slope_of(h) * (float)(1 << lg) * LOG2E; b.L = L; b.base0 = 0;
    return b;
}
__device__ __forceinline__ void attn_a_pipe(unsigned char* lds, int wv) {
    CParams& P = PP();
    const int tid = otid(wv);
    const unsigned char* wsb = P.ws;
    constexpr int TOTAL = 3 * NH * (MTOK / 256);
    int it = obid(); if (it >= TOTAL) return;
    fb::Blk cur = blk_a(it);
    fb::Seam S;
    fb::prime(wsb, cur, lds, S, tid);
    for (;;) {
        const int itn = it + (int)gridDim.x; const bool last = itn >= TOTAL;
        const fb::Blk nb = last ? cur : blk_a(itn);
        const fb::Nxt nxt{nb.qoff, nb.koff, nb.voff, nb.kb0};
        fb::block<0>(wsb, cur, nxt, 0u, lds, S, tid);
        if (last) break;
        cur = nb; it = itn;
    }
}
__device__ __forceinline__ int vit_b(int it) { return (it < 256) ? ((it & 7) * 32 + (it >> 3)) : it; }
__device__ __forceinline__ fb::Blk blk_b(int it_, int pass) {
    const int it = vit_b(it_); const int bh = it >> 2, s = it & 3, b = bh >> 4, h = bh & 15, n = pass ? 7 - s : s, R0 = (b << 11) + (n << 8);
    fb::Blk k;
    k.qoff = (unsigned)(WS_QKV + ((size_t)R0 * DM + h * HD) * 2); k.koff = (unsigned)(WS_QKV + (PART + h * HD) * 2); k.voff = (unsigned)(WS_QKV + (2 * PART + h * HD) * 2);
    k.ooff = (unsigned)(WS_G + (size_t)(h * HD) * 2); k.xoff = (unsigned)(WS_Z + (size_t)(h * HD) * 2);
    k.R0 = R0; k.kb0 = b << 11; k.NT = 4 * (n + 1); k.slopeL = slope_of(h) * LOG2E; k.L = 0; k.base0 = b << 11;
    return k;
}
__device__ __forceinline__ unsigned moba_gate(const unsigned char* wsb, unsigned char* lds, int b, int h, int n, int R0, int tid) {
    unsigned sel = (1u << n) - 1u;
    if (n >= 4) {
        asm volatile("" : "+v"(tid));
        const bf16_t* QKV = (const bf16_t*)(wsb + WS_QKV); const float* KS = (const float*)(wsb + WS_KSUM);
        LAS float* gk = (LAS float*)((LAS unsigned char*)lds + fc::R_GK); LAS unsigned* sel_l = (LAS unsigned*)((LAS unsigned char*)lds + fc::R_SEL);
        for (int i = tid; i < n * 128; i += NTHREADS) { const float* kp = KS + (size_t)(b * 8 + (i >> 7)) * DM + h * HD + (i & 127); gk[i] = kp[0] + kp[(size_t)32 * DM]; }
        __syncthreads();
        const int row = tid >> 1, half = tid & 1;
        const u32x4* qp = (const u32x4*)(QKV + (size_t)(R0 + row) * DM + h * HD + half * 64);
        float gt[7];
#pragma unroll
        for (int j = 0; j < 7; ++j) gt[j] = 0.f;
#pragma unroll
        for (int c = 0; c < 8; ++c) { const u32x4 w = qp[c]; const float q0 = bflo(w.x), q1 = bfhi(w.x), q2 = bflo(w.y), q3 = bfhi(w.y), q4 = bflo(w.z), q5 = bfhi(w.z), q6 = bflo(w.w), q7 = bfhi(w.w);
#pragma unroll
            for (int j = 0; j < 7; ++j) if (j < n) { const LAS f32x4* kk = (const LAS f32x4*)(gk + j * 128 + half * 64 + c * 8); const f32x4 ka = kk[0], kb2 = kk[1];
                gt[j] += (q0 * ka.x + q1 * ka.y) + (q2 * ka.z + q3 * ka.w) + (q4 * kb2.x + q5 * kb2.y) + (q6 * kb2.z + q7 * kb2.w); } }
#pragma unroll
        for (int j = 0; j < 7; ++j) gt[j] += __shfl_xor(gt[j], 1);
        unsigned mask = 0;
#pragma unroll
        for (int j = 0; j < 7; ++j) if (j < n) { int rank = 0;
#pragma unroll
            for (int j2 = 0; j2 < 7; ++j2) if (j2 < n && (gt[j2] > gt[j] || (gt[j2] == gt[j] && j2 < j))) ++rank;
            if (rank < 3) mask |= 1u << j; }
        if (half == 0) sel_l[row] = mask;
        __syncthreads();
        sel = sel_l[(tid >> 6) * 32 + (tid & 31)];
    }
    return sel;
}
__device__ __forceinline__ void attn_b_pipe(unsigned char* lds, int wv) {
    CParams& P = PP();
    const int tid = otid(wv);
    const unsigned char* wsb = P.ws;
    constexpr int TOTAL = NB * NH * 4;
    int it = obid(); if (it >= TOTAL) return;
    int pass = 0;
    fb::Blk cur = blk_b(it, 0);
    fb::Seam S;
    fb::prime(wsb, cur, lds, S, tid);
    for (;;) {
        int itn = it, passn = pass + 1; if (passn == 2) { passn = 0; itn = it + (int)gridDim.x; }
        const bool last = itn >= TOTAL;
        const fb::Blk nb = last ? cur : blk_b(itn, passn);
        const fb::Nxt nxt{nb.qoff, nb.koff, nb.voff, nb.kb0};
        const int vi = vit_b(it), bh = vi >> 2, s = vi & 3, n = pass ? 7 - s : s;
        const unsigned sel = moba_gate(wsb, lds, bh >> 4, bh & 15, n, cur.R0, tid);
        fb::block<1>(wsb, cur, nxt, sel, lds, S, tid);
        if (last) break;
        cur = nb; it = itn; pass = passn;
    }
}

__device__ __forceinline__ fc::Blk cblk_a(int it) { const fb::Blk b = blk_a(it); const int h = it & 15, g = it >> 9;
    fc::Blk c{b.qoff, b.koff, b.voff, b.ooff, b.xoff, 0u, 0u, b.R0, b.kb0, b.NT, b.slopeL, b.L, b.base0};
    if (g == 2) { c.ooff = (unsigned)(WS_OG + (size_t)(h * HD) * 2); c.xoff = (unsigned)(WS_LSE + (size_t)h * 4); c.zoff = (unsigned)(WS_Z + (size_t)(h * HD) * 2); c.goff = (unsigned)(WS_G + (size_t)(h * HD) * 2); }
    return c; }
__device__ __forceinline__ fc::Blk cblk_b(int it, int pass) { const fb::Blk b = blk_b(it, pass); return fc::Blk{b.qoff, b.koff, b.voff, b.ooff, b.xoff, 0u, 0u, b.R0, b.kb0, b.NT, b.slopeL, b.L, b.base0}; }
template <int MODE>
__device__ __forceinline__ void attn_a_dma(unsigned char* lds, int wv, int first, int count) {
    CParams& P = PP();
    const int tid = otid(wv);
    const unsigned char* wsb = P.ws;
    int it = obid(); if (it >= count) return;
    fc::Blk cur = cblk_a(first + it);
    bf16x8 qr[8]; fc::Ring rg;
    fc::prime(wsb, cur, lds, qr, rg, tid);
    for (;;) {
        const int itn = it + (int)gridDim.x; const bool last = itn >= count;
        const fc::Blk nb = last ? cur : cblk_a(first + itn);
        const fc::Nxt nxt{nb.qoff, nb.koff, nb.voff, nb.kb0};
        fc::block<MODE>(wsb, cur, nxt, !last, 0u, lds, qr, rg, tid);
        if (last) break;
        cur = nb; it = itn;
    }
}
__device__ __forceinline__ void attn_b_dma(unsigned char* lds, int wv) {
    CParams& P = PP();
    const int tid = otid(wv);
    const unsigned char* wsb = P.ws;
    constexpr int TOTAL = NB * NH * 4;
    int it = obid(); if (it >= TOTAL) return;
    int pass = 0;
    fc::Blk cur = cblk_b(it, 0);
    bf16x8 qr[8]; fc::Ring rg;
    fc::prime(wsb, cur, lds, qr, rg, tid);
    for (;;) {
        int itn = it, passn = pass + 1; if (passn == 2) { passn = 0; itn = it + (int)gridDim.x; }
        const bool last = itn >= TOTAL;
        const fc::Blk nb = last ? cur : cblk_b(itn, passn);
        const fc::Nxt nxt{nb.qoff, nb.koff, nb.voff, nb.kb0};
        const int vi = vit_b(it), bh = vi >> 2, s = vi & 3, n = pass ? 7 - s : s;
        const unsigned sel = moba_gate(wsb, lds, bh >> 4, bh & 15, n, cur.R0, tid);
        fc::block<1>(wsb, cur, nxt, !last, sel, lds, qr, rg, tid);
        if (last) break;
        cur = nb; it = itn; pass = passn;
    }
}

__device__ __forceinline__ unsigned moba_gate2(const unsigned char* wsb, unsigned char* lds, int b, int h, int n, int R0, int tid) {
    unsigned sel = (1u << n) - 1u;
    if (n >= 4) {
        asm volatile("" : "+v"(tid));
        const int grp = tid >> 8, tin = tid & 255;
        const bf16_t* QKV = (const bf16_t*)(wsb + WS_QKV); const float* KS = (const float*)(wsb + WS_KSUM);
        LAS float* gk = (LAS float*)((LAS unsigned char*)lds + fc::R_GK) + grp * (7 * 128); LAS unsigned* sel_l = (LAS unsigned*)((LAS unsigned char*)lds + fc::R_SEL);
        for (int i = tin; i < n * 128; i += 256) { const float* kp = KS + (size_t)(b * 8 + (i >> 7)) * DM + h * HD + (i & 127); gk[i] = kp[0] + kp[(size_t)32 * DM]; }
        __syncthreads();
        const int row = grp * 128 + (tin >> 1), half = tin & 1;
        const u32x4* qp = (const u32x4*)(QKV + (size_t)(R0 + row) * DM + h * HD + half * 64);
        float gt[7];
#pragma unroll
        for (int j = 0; j < 7; ++j) gt[j] = 0.f;
#pragma unroll
        for (int c = 0; c < 8; ++c) { const u32x4 w = qp[c]; const float q0 = bflo(w.x), q1 = bfhi(w.x), q2 = bflo(w.y), q3 = bfhi(w.y), q4 = bflo(w.z), q5 = bfhi(w.z), q6 = bflo(w.w), q7 = bfhi(w.w);
#pragma unroll
            for (int j = 0; j < 7; ++j) if (j < n) { const LAS f32x4* kk = (const LAS f32x4*)(gk + j * 128 + half * 64 + c * 8); const f32x4 ka = kk[0], kb2 = kk[1];
                gt[j] += (q0 * ka.x + q1 * ka.y) + (q2 * ka.z + q3 * ka.w) + (q4 * kb2.x + q5 * kb2.y) + (q6 * kb2.z + q7 * kb2.w); } }
#pragma unroll
        for (int j = 0; j < 7; ++j) gt[j] += __shfl_xor(gt[j], 1);
        unsigned mask = 0;
#pragma unroll
        for (int j = 0; j < 7; ++j) if (j < n) { int rank = 0;
#pragma unroll
            for (int j2 = 0; j2 < 7; ++j2) if (j2 < n && (gt[j2] > gt[j] || (gt[j2] == gt[j] && j2 < j))) ++rank;
            if (rank < 3) mask |= 1u << j; }
        if (half == 0) sel_l[row] = mask;
        __syncthreads();
        sel = sel_l[(tid >> 6) * 32 + (tid & 31)];
    }
    return sel;
}
__device__ __forceinline__ void attn_a_hs(unsigned char* lds, int wv) {
    CParams& P = PP();
    const int tid = otid(wv);
    const unsigned char* wsb = P.ws;
    constexpr int TOTAL = 3 * NH * (MTOK / 256);
    int it = obid(); if (it >= TOTAL) return;
    fc::Blk cur = cblk_a(it);
    bf16x8 qr[8]; fc::Ring rg;
    fd::prime(wsb, cur, lds, qr, rg, tid);
    for (;;) {
        const int itn = it + (int)gridDim.x; const bool last = itn >= TOTAL;
        const fc::Blk nb = last ? cur : cblk_a(itn);
        const fc::Nxt nxt{nb.qoff, nb.koff, nb.voff, nb.kb0};
        fd::block<0>(wsb, cur, nxt, !last, 0u, lds, qr, rg, tid);
        if (last) break;
        cur = nb; it = itn;
    }
    fd::finish(tid);
}
__device__ __forceinline__ void attn_b_hs(unsigned char* lds, int wv) {
    CParams& P = PP();
    const int tid = otid(wv);
    const unsigned char* wsb = P.ws;
    constexpr int TOTAL = NB * NH * 4;
    int it = obid(); if (it >= TOTAL) return;
    int pass = 0;
    fc::Blk cur = cblk_b(it, 0);
    bf16x8 qr[8]; fc::Ring rg;
    fd::prime(wsb, cur, lds, qr, rg, tid);
    for (;;) {
        int itn = it, passn = pass + 1; if (passn == 2) { passn = 0; itn = it + (int)gridDim.x; }
        const bool last = itn >= TOTAL;
        const fc::Blk nb = last ? cur : cblk_b(itn, passn);
        const fc::Nxt nxt{nb.qoff, nb.koff, nb.voff, nb.kb0};
        const int vi = vit_b(it), bh = vi >> 2, s = vi & 3, n = pass ? 7 - s : s;
        const unsigned sel = moba_gate2(wsb, lds, bh >> 4, bh & 15, n, cur.R0, tid);
        fd::block<1>(wsb, cur, nxt, !last, sel, lds, qr, rg, tid);
        if (last) break;
        cur = nb; it = itn; pass = passn;
    }
    fd::finish(tid);
}

__device__ __forceinline__ void attn_a_flash(unsigned char* lds, int wv) {
    CParams& P = PP();
    const int tid = otid(wv);
    const bf16_t* QKV = (const bf16_t*)(P.ws + WS_QKV); bf16_t* OG = (bf16_t*)(P.ws + WS_OG); float* LSE = (float*)(P.ws + WS_LSE);
    for (int it = obid(); it < 3 * NH * (MTOK / 256); it += gridDim.x) {
        const int g = it >> 9, rem = it & 511, h = rem & 15, rb = rem >> 4;
        const int lg = 2 * g, L = SEQ >> lg, R0 = rb * 256;
        int krow0 = R0 - 128; { const int s0 = R0 & ~(L - 1); if (krow0 < s0) krow0 = s0; }
        const int NT = (R0 + 256 - krow0) >> 6;
        const fa::MaskA mk{L};
        fa::flash_block<0>(QKV + (size_t)(3 * g) * PART + (size_t)R0 * DM + h * HD, QKV + (size_t)(3 * g + 1) * PART + h * HD, QKV + (size_t)(3 * g + 2) * PART + h * HD,
                           krow0, NT, R0, slope_of(h) * (float)(1 << lg) * LOG2E, mk, lds, OG + (size_t)g * PART + h * HD, LSE + (size_t)g * MTOK * NH + h, nullptr, tid);
    }
}
__device__ __forceinline__ void attn_b_flash(unsigned char* lds, int wv) {
    CParams& P = PP();
    const int tid = otid(wv);
    const bf16_t* QKV = (const bf16_t*)(P.ws + WS_QKV); const bf16_t* Z = (const bf16_t*)(P.ws + WS_Z); bf16_t* G = (bf16_t*)(P.ws + WS_G); const float* KS = (const float*)(P.ws + WS_KSUM);
    LAS float* gk = (LAS float*)((LAS unsigned char*)lds + fa::OFF_GK); LAS unsigned* sel_l = (LAS unsigned*)((LAS unsigned char*)lds + fa::OFF_SEL);
    for (int it = obid(); it < NB * NH * 4; it += gridDim.x) {
        const int bh = it >> 2, s = it & 3, b = bh >> 4, h = bh & 15;
        for (int pass = 0; pass < 2; ++pass) {
            const int n = pass ? 7 - s : s, R0 = (b << 11) + (n << 8);
            unsigned sel = (1u << n) - 1u;
            if (n >= 4) {
                for (int i = tid; i < n * 128; i += NTHREADS) { const float* kp = KS + (size_t)(b * 8 + (i >> 7)) * DM + h * HD + (i & 127); gk[i] = kp[0] + kp[(size_t)32 * DM]; }
                __syncthreads();
                const int row = tid >> 1, half = tid & 1;
                const u32x4* qp = (const u32x4*)(QKV + (size_t)(R0 + row) * DM + h * HD + half * 64);
                float gt[7];
#pragma unroll
                for (int j = 0; j < 7; ++j) gt[j] = 0.f;
#pragma unroll
                for (int c = 0; c < 8; ++c) { const u32x4 w = qp[c]; const float q0 = bflo(w.x), q1 = bfhi(w.x), q2 = bflo(w.y), q3 = bfhi(w.y), q4 = bflo(w.z), q5 = bfhi(w.z), q6 = bflo(w.w), q7 = bfhi(w.w);
#pragma unroll
                    for (int j = 0; j < 7; ++j) if (j < n) { const LAS f32x4* kk = (const LAS f32x4*)(gk + j * 128 + half * 64 + c * 8); const f32x4 ka = kk[0], kb2 = kk[1];
                        gt[j] += (q0 * ka.x + q1 * ka.y) + (q2 * ka.z + q3 * ka.w) + (q4 * kb2.x + q5 * kb2.y) + (q6 * kb2.z + q7 * kb2.w); } }
#pragma unroll
                for (int j = 0; j < 7; ++j) gt[j] += __shfl_xor(gt[j], 1);
                unsigned mask = 0;
#pragma unroll
                for (int j = 0; j < 7; ++j) if (j < n) { int rank = 0;
#pragma unroll
                    for (int j2 = 0; j2 < 7; ++j2) if (j2 < n && (gt[j2] > gt[j] || (gt[j2] == gt[j] && j2 < j))) ++rank;
                    if (rank < 3) mask |= 1u << j; }
                if (half == 0) sel_l[row] = mask;
                __syncthreads();
                sel = sel_l[(tid >> 6) * 32 + (tid & 31)];
            }
            const fa::MaskB mk{R0, b << 11, sel};
            fa::flash_block<1>(QKV + (size_t)R0 * DM + h * HD, QKV + PART + h * HD, QKV + 2 * PART + h * HD, b << 11, 4 * (n + 1), R0, slope_of(h) * LOG2E, mk, lds,
                               G + h * HD, nullptr, Z + h * HD, tid);
        }
    }
}

#define XB_TMO      128
#define XB_XCNT(j)  (256  + 64 * (j))
#define XB_XSUB(j)  (1280 + 64 * (j))
#define XB_XGEN(j)  (2304 + 64 * (j))
#define XB_TOP      3328
#define XB_TOPGEN   3392
#define XCD_BAR_WORDS 3456
#define XB_SPIN_CAP (1u << 20)
__device__ __forceinline__ unsigned xb_ld(unsigned* p)              { return __hip_atomic_load(p, __ATOMIC_RELAXED, __HIP_MEMORY_SCOPE_AGENT); }
__device__ __forceinline__ unsigned xb_add(unsigned* p, unsigned v) { return __hip_atomic_fetch_add(p, v, __ATOMIC_RELAXED, __HIP_MEMORY_SCOPE_AGENT); }
__device__ __forceinline__ unsigned xb_xcc_id() { return (unsigned)__builtin_amdgcn_s_getreg((3 << 11) | 20) & 0xFu; }
#define XB_SPIN(cond, bar) do { unsigned _sp = 0; while (cond) { __builtin_amdgcn_s_sleep(1); \
    if ((++_sp & 255u) == 0u) { if (xb_ld(&(bar)[XB_TMO])) break; if (_sp > XB_SPIN_CAP) { atomicAdd(&(bar)[XB_TMO], 1u); break; } } } } while (0)
struct XcdBarrier { unsigned* bar; unsigned x; volatile LAS unsigned* st; };
__device__ __forceinline__ XcdBarrier xcd_barrier_post(unsigned* bar, volatile LAS unsigned* st) {
    XcdBarrier b; b.bar = bar; b.x = xb_xcc_id(); b.st = st;
    if (threadIdx.x == 0) (void)xb_add(&bar[XB_XCNT(b.x)], 1u);
    return b;
}
__device__ __forceinline__ void xcd_barrier_complete(unsigned* bar, unsigned x, unsigned& nloc, unsigned& nx) {
    const unsigned G = gridDim.x * gridDim.y * gridDim.z;
    unsigned sum, cnt, mine, sp = 0u;
    for (;;) {
        sum = 0u; cnt = 0u; mine = 0u;
#pragma unroll
        for (unsigned j = 0; j < 16; ++j) { const unsigned c = xb_ld(&bar[XB_XCNT(j)]); sum += c; cnt += (c > 0u) ? 1u : 0u; mine = (j == x) ? c : mine; }
        if (sum == G) break;
        __builtin_amdgcn_s_sleep(1);
        if ((++sp & 255u) == 0u) { if (xb_ld(&bar[XB_TMO])) break; if (sp > XB_SPIN_CAP) { atomicAdd(&bar[XB_TMO], 1u); break; } }
    }
    nloc = mine > 0u ? mine : 1u; nx = cnt > 0u ? cnt : 1u;
}
__device__ __forceinline__ void xcd_barrier(const XcdBarrier& b) {
    asm volatile("s_waitcnt vmcnt(0)" ::: "memory");
    __syncthreads();
    if (threadIdx.x == 0) {
        unsigned* bar = b.bar;
        __builtin_amdgcn_s_waitcnt(0);
        unsigned nloc = b.st[0], nx = b.st[1];
        if (nloc == 0u) { xcd_barrier_complete(bar, b.x, nloc, nx); b.st[0] = nloc; b.st[1] = nx; }
        const unsigned old = xb_add(&bar[XB_XSUB(b.x)], 1u);
        const unsigned gen = old / nloc;
        if (old + 1u == (gen + 1u) * nloc) {
            __builtin_amdgcn_fence(__ATOMIC_RELEASE, "agent");
            asm volatile("s_waitcnt vmcnt(0)" ::: "memory");
            const unsigned og = xb_add(&bar[XB_TOP], 1u);
            const unsigned tg = og / nx;
            if (og + 1u == (tg + 1u) * nx) xb_add(&bar[XB_TOPGEN], 1u);
            else XB_SPIN(xb_ld(&bar[XB_TOPGEN]) == tg, bar);
            __builtin_amdgcn_fence(__ATOMIC_ACQUIRE, "agent");
            xb_add(&bar[XB_XGEN(b.x)], 1u);
            asm volatile("s_waitcnt vmcnt(0)" ::: "memory");
        } else {
            XB_SPIN(xb_ld(&bar[XB_XGEN(b.x)]) == gen, bar);
            __builtin_amdgcn_fence(__ATOMIC_ACQUIRE, "agent");
            asm volatile("s_waitcnt vmcnt(0)" ::: "memory");
        }
    }
    __syncthreads();
}

#define GSYNC() do { XcdBarrier xb_; xb_.bar = (unsigned*)(PP().ws + WS_CTL); xb_.x = xb_xcc_id(); xb_.st = bst; xcd_barrier(xb_); } while (0)
template <int LAYER>
__device__ __forceinline__ void run_layer(unsigned char* lds, LAS unsigned char* lds3, volatile LAS unsigned* bst, int wv) {
    constexpr int layer = LAYER;
        const bool isA = (layer & 1) == 0; const int j = layer >> 1;
#if FUSE_NORM
        if (layer == 0) {
#endif
        norm_phase(layer, !isA && !MOBA_QK_I8, wv);
#if PROBE == 2
        norm_phase(layer, !isA && !MOBA_QK_I8, wv);
#endif
#if PROBE == 6
        GSYNC(); GSYNC(); GSYNC(); GSYNC(); GSYNC();
#endif
        GSYNC();
#if FUSE_NORM
        }
#endif
        {
#if !MOBA_QK_I8
            if (!isA) {
                unsigned char* ws = PP().ws;
                pg8::Gemm g{ws + WS_H, ws + WS_WBQK + (size_t)j * 4096 * DM * 2, MTOK, 4096, DM * 2};
                pg8::StaticOrder S; S.init(MTOK, 4096, (int)gridDim.x, obid());
                pg8::Epi E{1, 0, (bf16_t*)(ws + WS_QKV), (bf16_t*)(ws + WS_Z), (float*)(ws + WS_KSUM), nullptr, nullptr, nullptr, nullptr, nullptr};
                pg8::gemm_phase<pg8::Epi, pg8::StaticOrder, GEMM_ALIGN, GEMM_SP2, false>(lds3, g, S, E, wv);
            }
#endif
            {
                unsigned char* ws = PP().ws;
#if MOBA_QK_I8
                pg8::Gemm g{ws + WS_HQ, isA ? ws + WS_WAIN + (size_t)j * A_N * DM : ws + WS_WBQK + (size_t)j * B_N * DM, MTOK, isA ? A_N : B_N, DM};
                pg8::StaticOrder S; S.init(MTOK, g.N, (int)gridDim.x, obid());
                pg8::Epi E{isA ? 0 : 1, 0, (bf16_t*)(ws + WS_QKV), (bf16_t*)(ws + WS_Z), (float*)(ws + WS_KSUM), (const float*)(ws + WS_RS),
                           isA ? (const float*)(ws + WS_CSA) + j * A_N : (const float*)(ws + WS_CSB) + j * B_N, nullptr, nullptr, nullptr};
#else
                pg8::Gemm g{ws + WS_HQ, isA ? ws + WS_WAIN + (size_t)j * A_N * DM : ws + WS_WBVZ + (size_t)j * 4096 * DM, MTOK, isA ? A_N : 4096, DM};
                pg8::StaticOrder S; S.init(MTOK, g.N, (int)gridDim.x, obid());
                pg8::Epi E{isA ? 0 : 1, isA ? 0 : 2, (bf16_t*)(ws + WS_QKV), (bf16_t*)(ws + WS_Z), nullptr, (const float*)(ws + WS_RS),
                           isA ? (const float*)(ws + WS_CSA) + j * A_N : (const float*)(ws + WS_CSB) + j * 4096, nullptr, nullptr, nullptr};
#endif
#if STAGGER_TICKS > 0
                if (isA) {
                    const unsigned long long t0_ = __builtin_amdgcn_s_memrealtime(); const unsigned long long dl_ = (unsigned long long)((obid() >> 3) & 7) * STAGGER_TICKS;
                    while (__builtin_amdgcn_s_memrealtime() - t0_ < dl_) __builtin_amdgcn_s_sleep(8);
                }
#endif
                pg8::gemm_phase<pg8::Epi, pg8::StaticOrder, GEMM_ALIGN, GEMM_SP2, true>(lds3, g, S, E, wv);
#if PROBE == 7
                pg8::gemm_phase<pg8::Epi, pg8::StaticOrder, GEMM_ALIGN, GEMM_SP2, true>(lds3, g, S, E, wv);
#endif
#if PROBE == 12 || PROBE == 13
                if (isA) { pg8::Epi E3 = E; E3.mode = PROBE == 12 ? 6 : 7; E3.qkv = (bf16_t*)(ws + WS_OG); pg8::gemm_phase<pg8::Epi, pg8::StaticOrder, GEMM_ALIGN, GEMM_SP2, true>(lds3, g, S, E3, wv); }
#endif
#if PROBE == 10 || PROBE == 11
                if (isA) { pg8::Epi E3 = E; E3.mode = PROBE == 10 ? 4 : 5; E3.qkv = (bf16_t*)(ws + WS_OG); pg8::gemm_phase<pg8::Epi, pg8::StaticOrder, GEMM_ALIGN, GEMM_SP2, true>(lds3, g, S, E3, wv); }
#endif
#if PROBE == 9
                { pg8::Epi E3 = E; E3.mode = 3; pg8::gemm_phase<pg8::Epi, pg8::StaticOrder, GEMM_ALIGN, GEMM_SP2, true>(lds3, g, S, E3, wv); }
#endif
            }
        }
        GSYNC();
#if PROBE == 3
        if (isA) attn_a_dma<0>(lds, wv, 0, 1024);
#endif
#if PROBE == 4
        if (!isA) attn_b_hs(lds, wv);
#endif
#if ATTN_HS
        if (isA) { attn_a_hs(lds, wv); GSYNC(); combine_phase(wv);
#elif ATTN_DMA
#if FUSE_COMBINE && !OUTA_I8
        if (isA) { attn_a_dma<0>(lds, wv, 0, 1024); GSYNC(); attn_a_dma<2>(lds, wv, 1024, 512);
#if PROBE == 14
            attn_a_dma<2>(lds, wv, 1024, 512);
#endif
#else
        if (isA) { attn_a_dma<0>(lds, wv, 0, 1536); GSYNC(); combine_phase(wv);
#endif
#elif ATTN_PIPE
        if (isA) { attn_a_pipe(lds, wv); GSYNC(); combine_phase(wv);
#else
        if (isA) { attn_a_flash(lds, wv); GSYNC(); combine_phase(wv);
#endif
#if PROBE == 5
            combine_phase(wv);
#endif
        }
#if ATTN_HS
        else { attn_b_hs(lds, wv); }
#elif ATTN_DMA
        else { attn_b_dma(lds, wv); }
#elif ATTN_PIPE
        else { attn_b_pipe(lds, wv); }
#else
        else { attn_b_flash(lds, wv); }
#endif
        GSYNC();
        {
            CParams& P = PP(); unsigned char* ws = P.ws;
            const bool i8o = OUTA_I8 && isA;
            pg8::Gemm g{i8o ? ws + WS_HQ : ws + WS_G, isA ? ws + WS_WAOUT + (size_t)j * DM * DM * (OUTA_I8 ? 1 : 2) : ws + WS_WBOUT + (size_t)j * DM * DM * 2, MTOK, DM, i8o ? DM : DM * 2};
            pg8::StaticOrder S; S.init(MTOK, DM, (int)gridDim.x, obid());
            pg8::Epi E{2, 0, nullptr, nullptr, nullptr, (const float*)(ws + WS_RS), (const float*)(ws + WS_CSO) + j * DM, layer == 0 ? P.x : P.out, P.out, (const float*)(ws + WS_MOD) + (size_t)layer * 4 * 6144 + 4096};
            {
                pg8::Unit u0; int ui = 0;
                while (S.next(ui, u0)) { const int t_ = otid(wv); const int w_ = __builtin_amdgcn_readfirstlane(t_ >> 6);
                    const float* xt = E.xin + (size_t)(u0.pm * 256 + (t_ >> 1)) * DM + u0.pn * 256 + (t_ & 1) * 128;
#pragma unroll
                    for (int q = 0; q < 4; ++q) __builtin_amdgcn_global_load_lds((const unsigned*)(xt + q * 32), (LAS unsigned*)(lds3 + 131072 + w_ * 1024 + q * 256), 4, 0, 0);
                    ++ui; } }
#if FUSE_NORM && !OUTA_I8
            {
                const bool lastl = layer == DEPTH - 1; const float* MODp = (const float*)(ws + WS_MOD);
                float* MODn = const_cast<float*>(MODp) + (size_t)(layer + 1) * 4 * 6144; unsigned* cn = (unsigned*)(ws + WS_CTL + 65536) + (size_t)layer * 32 * 128;
                if (lastl) { pg8::EpiOutF<true> EF{E.xin, E.xout, E.gate, P.final_w, nullptr, nullptr, ws + WS_HQ, (float*)(ws + WS_RS), (float*)(ws + WS_XS), cn};
                    pg8::gemm_phase<pg8::EpiOutF<true>, pg8::StaticOrder, GEMM_ALIGN, GEMM_SP2, false>(lds3, g, S, EF, wv); }
                else { pg8::EpiOutF<false> EF{E.xin, E.xout, E.gate, P.norm_w + (layer + 1) * DM, MODn + DM, MODn, ws + WS_HQ, (float*)(ws + WS_RS), (float*)(ws + WS_XS), cn};
                    pg8::gemm_phase<pg8::EpiOutF<false>, pg8::StaticOrder, GEMM_ALIGN, GEMM_SP2, false>(lds3, g, S, EF, wv); }
            }
#else
#if OUTA_I8
            if (isA) pg8::gemm_phase<pg8::Epi, pg8::StaticOrder, GEMM_ALIGN, GEMM_SP2, true>(lds3, g, S, E, wv);
            else
#endif
            pg8::gemm_phase<pg8::Epi, pg8::StaticOrder, GEMM_ALIGN, GEMM_SP2, false>(lds3, g, S, E, wv);
#endif
        }
#if FUSE_NORM && !OUTA_I8
        if (layer + 1 < DEPTH) GSYNC();
#else
        GSYNC();
#endif
    }

__global__ void __launch_bounds__(NTHREADS, 2) fwd_mega(Params Pin) {
    extern __shared__ __attribute__((aligned(16))) unsigned char lds[];
#if USE_CG_SYNC
    cg::grid_group grid = cg::this_grid();
#endif
    LAS unsigned char* lds3 = (LAS unsigned char*)lds;
    (void)Pin;
    const int wv = __builtin_amdgcn_readfirstlane((int)threadIdx.x >> 6);
    volatile LAS unsigned* bst = (volatile LAS unsigned*)(lds3 + (LDS_BYTES - 64));
    if (threadIdx.x < 2) bst[threadIdx.x] = 0u;
    __syncthreads();
    (void)xcd_barrier_post((unsigned*)(PP().ws + WS_CTL), bst);
    p0_mod(lds, wv);
    p0_weights(lds, wv);
#if PROBE == 1
    __syncthreads(); p0_mod(lds, wv); p0_weights(lds, wv);
#endif
#if USE_CG_SYNC
    grid.sync();
#else
    GSYNC();
#endif
    run_layer<0>(lds, lds3, bst, wv); run_layer<1>(lds, lds3, bst, wv); run_layer<2>(lds, lds3, bst, wv); run_layer<3>(lds, lds3, bst, wv);
#if !(FUSE_NORM && !OUTA_I8)
    final_norm_phase(wv);
#endif
}

extern "C" void kernel_launch(void* const* d_in, const int* in_sizes, int n_in, void* d_out, int out_size, void* d_ws, size_t ws_size, hipStream_t stream) {
    static int grid = 0;
    if (grid == 0) {
        if (n_in != 10 || in_sizes[0] != MTOK * DM || out_size != MTOK * DM || ws_size < WS_END) {
            fprintf(stderr, "kernel_launch: unexpected shapes/workspace (n_in %d, in0 %d, out %d, ws %zu, need %zu)\n", n_in, n_in > 0 ? in_sizes[0] : -1, out_size, ws_size, (size_t)WS_END); grid = -1; return; }
        int dev = 0, cus = 0, per_cu = 0;
        (void)hipGetDevice(&dev); (void)hipDeviceGetAttribute(&cus, hipDeviceAttributeMultiprocessorCount, dev);
        if (hipFuncSetAttribute((const void*)fwd_mega, hipFuncAttributeMaxDynamicSharedMemorySize, LDS_BYTES) != hipSuccess) { fprintf(stderr, "kernel_launch: hipFuncSetAttribute failed\n"); grid = -1; return; }
        if (hipOccupancyMaxActiveBlocksPerMultiprocessor(&per_cu, (const void*)fwd_mega, NTHREADS, LDS_BYTES) != hipSuccess || per_cu < 1) { fprintf(stderr, "kernel_launch: occupancy query says %d\n", per_cu); (void)hipGetLastError(); per_cu = 1; }
        if (per_cu > 1) per_cu = 1;
        grid = cus * per_cu;
    }
    if (grid < 0) return;
    (void)hipMemsetAsync((char*)d_ws + WS_CTL, 0, 65536 + 4 * 32 * 128 * 4, stream);
    Params p{};
    p.x = (const float*)d_in[0]; p.c = (const float*)d_in[1]; p.norm_w = (const float*)d_in[2]; p.mod_w = (const float*)d_in[3]; p.mod_b = (const float*)d_in[4];
    p.a_w_in = (const float*)d_in[5]; p.a_w_out = (const float*)d_in[6]; p.b_w_in = (const float*)d_in[7]; p.b_w_out = (const float*)d_in[8]; p.final_w = (const float*)d_in[9];
    p.out = (float*)d_out; p.ws = (unsigned char*)d_ws;
    void* args[] = {&p};
    hipError_t e = hipLaunchCooperativeKernel((const void*)fwd_mega, dim3(grid), dim3(NTHREADS), args, LDS_BYTES, stream);
    if (e != hipSuccess) fprintf(stderr, "kernel_launch: cooperative launch failed: %s (grid %d)\n", hipGetErrorString(e), grid);
}
```

```cpp
#include <hip/hip_runtime.h>
#include <hip/hip_cooperative_groups.h>
#include <cstdio>
#include <cstdint>
namespace cg = cooperative_groups;
#ifndef ATTN_A_FLASH
#define ATTN_A_FLASH 1
#endif
#ifndef GEMM_ALIGN
#define GEMM_ALIGN true
#endif
#ifndef GEMM_SP2
#define GEMM_SP2 true
#endif
#ifndef PROBE
#define PROBE 0
#endif
#ifndef MOBA_QK_I8
#define MOBA_QK_I8 1
#endif
#ifndef OUTA_I8
#define OUTA_I8 0
#endif
#ifndef GCLIP
#define GCLIP 1.0e9f
#endif
#ifndef SPLIT_INPROJ
#define SPLIT_INPROJ 1
#endif
#ifndef STAGGER_TICKS
#define STAGGER_TICKS 0
#endif
#ifndef USE_CG_SYNC
#define USE_CG_SYNC 0
#endif
#ifndef ATTN_PIPE
#define ATTN_PIPE 1
#endif
#ifndef FUSE_NORM
#define FUSE_NORM 1
#endif
#ifndef EPI_SC1
#define EPI_SC1 1
#endif
#ifndef FUSE_COMBINE
#define FUSE_COMBINE 1
#endif
#ifndef ATTN_DMA
#define ATTN_DMA 1
#endif
#ifndef ATTN_HS
#define ATTN_HS 0
#endif
#ifndef ATTN_B_FLASH
#define ATTN_B_FLASH 1
#endif

#define LAS __attribute__((address_space(3)))
typedef unsigned short bf16_t;
typedef short bf16x8 __attribute__((ext_vector_type(8)));
typedef short s16x4 __attribute__((ext_vector_type(4)));
typedef float f32x4 __attribute__((ext_vector_type(4)));
typedef float f32x16 __attribute__((ext_vector_type(16)));
typedef unsigned u32x4 __attribute__((ext_vector_type(4)));
typedef unsigned u32x2 __attribute__((ext_vector_type(2)));
typedef int i32x4 __attribute__((ext_vector_type(4)));

constexpr int NB = 4, SEQ = 2048, DM = 2048, MTOK = NB * SEQ, NH = 16, HD = 128, DEPTH = 4;
constexpr int A_N = 10 * DM, B_N = 4 * DM;
constexpr float EPS = 1e-6f;
constexpr float LOG2E = 1.4426950408889634f;
constexpr float C2Q = 0.08838834764831845f * LOG2E;

constexpr size_t MiB = 1u << 20;
constexpr size_t WS_CTL = 0;
constexpr size_t WS_MOD = 1 * MiB;
constexpr size_t WS_KSUM = 2 * MiB;
constexpr size_t WS_LSE = 3 * MiB;
constexpr size_t WS_XS = 4 * MiB;
constexpr size_t WS_RS = 5 * MiB;
constexpr size_t WS_CSA = 6 * MiB;
constexpr size_t WS_CSB = 7 * MiB;
constexpr size_t WS_CSO = 7 * MiB + 512 * 1024;
constexpr size_t WS_WAIN = 8 * MiB;
constexpr size_t WS_WBQK = WS_WAIN + 80 * MiB;
constexpr size_t WS_WBVZ = WS_WBQK + 32 * MiB;
constexpr size_t WS_WAOUT = WS_WBVZ + 16 * MiB;
constexpr size_t WS_WBOUT = WS_WAOUT + 16 * MiB;
constexpr size_t WS_H = WS_WBOUT + 16 * MiB;
constexpr size_t WS_HQ = WS_H + 32 * MiB;
constexpr size_t WS_G = WS_HQ + 16 * MiB;
constexpr size_t WS_QKV = WS_G + 32 * MiB;
constexpr size_t WS_Z = WS_QKV + 288 * MiB;
constexpr size_t WS_OG = WS_Z + 32 * MiB;
constexpr size_t WS_END = WS_OG + 96 * MiB;
constexpr size_t PART = (size_t)MTOK * DM;

constexpr int LDS_BYTES = 147456;
constexpr int NTHREADS = 512;

typedef float f32x2_t __attribute__((ext_vector_type(2))); typedef __bf16 bf16x2_t __attribute__((ext_vector_type(2)));
__device__ __forceinline__ unsigned cvt_pk_bf16(float lo, float hi) { f32x2_t v = {lo, hi}; bf16x2_t b = __builtin_convertvector(v, bf16x2_t); return __builtin_bit_cast(unsigned, b); }
__device__ __forceinline__ float bf2f(unsigned short v) { return __uint_as_float(((unsigned)v) << 16); }
__device__ __forceinline__ float bflo(unsigned w) { return __uint_as_float(w << 16); }
__device__ __forceinline__ float bfhi(unsigned w) { return __uint_as_float(w & 0xffff0000u); }
__device__ __forceinline__ float wave_sum(float v) {
#pragma unroll
    for (int o = 1; o < 64; o <<= 1) v += __shfl_xor(v, o);
    return v;
}
__device__ __forceinline__ float wave_max(float v) {
#pragma unroll
    for (int o = 1; o < 64; o <<= 1) v = fmaxf(v, __shfl_xor(v, o));
    return v;
}
__device__ __forceinline__ float silu_f(float v) { return v * __builtin_amdgcn_rcpf(1.f + __builtin_amdgcn_exp2f(-1.4426950408889634f * v)); }
#define LDS_WAIT() asm volatile("s_waitcnt lgkmcnt(0)" ::: "memory")
template <class V> __device__ __forceinline__ void store_wt(void* p, V v) { static_assert(sizeof(V) == 16, "16-byte vectors only");
    asm volatile("global_store_dwordx4 %0, %1, off sc0 sc1\n\ts_nop 1" :: "v"(p), "v"(v) : "memory"); }
__device__ __forceinline__ int otid(int wv) { int l; asm volatile("v_mbcnt_lo_u32_b32 %0, -1, 0\n\tv_mbcnt_hi_u32_b32 %0, -1, %0" : "=v"(l)); return (wv << 6) | l; }
template <class T> __device__ __forceinline__ T* optr(T* p) { asm volatile("" : "+s"(p)); return p; }
__device__ __forceinline__ int obid() { int b = blockIdx.x; asm volatile("" : "+s"(b)); return b; }

namespace pg8 {
constexpr int BM = 256, BK = 64, HALF = 128, HTB = HALF * BK * 2, STAGE_BYTES = 8 * HTB, NXCD = 8, WGM = 4;
__host__ __device__ __forceinline__ int lds_byte(int r, int c) { const int st = (r >> 4) * 2 + (c >> 5), rr = r & 15, cc = c & 31, ob = rr * 64 + cc * 2; return st * 1024 + (ob ^ (((ob >> 9) & 1) << 5)); }
__host__ __device__ __forceinline__ void stage_rc(int b, int& R, int& C) { const int st = b / 1024, sb = b % 1024, swz = sb ^ (((sb >> 9) & 1) << 5); R = (st >> 1) * 16 + swz / 64; C = (st & 1) * 32 + (swz % 64) / 2; }
__host__ __device__ __forceinline__ int perm32(int rho) { const int n = rho >> 4, i = rho & 15; return 8 * (i >> 2) + 4 * n + (i & 3); }
struct Unit { int pm, pn; };
struct Gemm { const void* A; const void* Bt; int M, N, KB; };
struct StaticOrder {
    int nM, nN, nwg, G, c;
    __host__ __device__ void init(int M, int N, int G_, int c_) { nM = M / BM; nN = N / BM; nwg = nM * nN; G = G_; c = c_; }
    __host__ __device__ bool next(int i, Unit& u) const {
        const long L = (long)i * G + c; if (L >= nwg) return false;
        int wgid = (int)L; { const int q = nwg / NXCD, r = nwg % NXCD, xcd = wgid % NXCD, off = wgid / NXCD; wgid = (xcd < r ? xcd * (q + 1) : r * (q + 1) + (xcd - r) * q) + off; }
        const int nig = WGM * nN, gid = wgid / nig, fm = gid * WGM, gsz = (nM - fm) < WGM ? (nM - fm) : WGM;
        u.pm = fm + ((wgid % nig) % gsz); u.pn = (wgid % nig) / gsz; return true;
    }
    __device__ __forceinline__ void a_ready(const Unit&) const {}
    __device__ __forceinline__ void done(const Unit&) const {}
};

__device__ __forceinline__ f32x4 acc_f32(const f32x4& a) { return a; }
__device__ __forceinline__ f32x4 acc_f32(const i32x4& a) { return (f32x4){(float)a.x, (float)a.y, (float)a.z, (float)a.w}; }
struct Epi {
    static constexpr bool PERM = true, AFTER_DRAIN = false;
    int mode;
    int pbase;
    bf16_t* qkv; bf16_t* zbuf; float* ksum;
    const float* rs; const float* cs;
    const float* xin; float* xout; const float* gate;
    template <class AccT>
    __device__ __forceinline__ void operator()(const AccT (&acc)[2][2][4][2], const Unit& u, int wr, int wc, int fr, int fq) const {
        constexpr bool I8 = sizeof(AccT) == sizeof(i32x4) && !__is_same(AccT, f32x4);
        if (mode == 3) {
#pragma unroll
            for (int ai = 0; ai < 2; ++ai)
#pragma unroll
                for (int bj = 0; bj < 2; ++bj)
#pragma unroll
                    for (int m = 0; m < 4; ++m)
#pragma unroll
                        for (int n = 0; n < 2; ++n) asm volatile("" :: "v"(acc[ai][bj][m][n]));
            return; }
        if (mode == 2) {
            const int col0 = u.pn * BM + wc * 64 + 8 * fq; const int b = (u.pm * BM) >> 11;
            f32x4 gv[2][2];
#pragma unroll
            for (int bj = 0; bj < 2; ++bj)
#pragma unroll
                for (int n = 0; n < 2; ++n) { gv[bj][n] = *(const f32x4*)(gate + b * 6144 + col0 + bj * 32 + 4 * n); if (I8) gv[bj][n] = gv[bj][n] * *(const f32x4*)(cs + col0 + bj * 32 + 4 * n); }
#pragma unroll
            for (int ai = 0; ai < 2; ++ai) {
                f32x4 xv[4][2][2]; float rsv[4];
#pragma unroll
                for (int m = 0; m < 4; ++m) { const int row = u.pm * BM + ai * HALF + wr * 64 + m * 16 + fr; const size_t off = (size_t)row * DM + col0; rsv[m] = I8 ? rs[row] : 1.f;
#pragma unroll
                    for (int bj = 0; bj < 2; ++bj)
#pragma unroll
                        for (int n = 0; n < 2; ++n) xv[m][bj][n] = *(const f32x4*)(xin + off + bj * 32 + 4 * n); }
                asm volatile("" ::: "memory");
#pragma unroll
                for (int m = 0; m < 4; ++m) { const size_t off = (size_t)(u.pm * BM + ai * HALF + wr * 64 + m * 16 + fr) * DM + col0;
#pragma unroll
                    for (int bj = 0; bj < 2; ++bj)
#pragma unroll
                        for (int n = 0; n < 2; ++n) *(f32x4*)(xout + off + bj * 32 + 4 * n) = xv[m][bj][n] + gv[bj][n] * (acc_f32(acc[ai][bj][m][n]) * rsv[m]); }
                asm volatile("" ::: "memory"); }
            return;
        }
        const int p = pbase + (u.pn >> 3), colt = (u.pn & 7) * BM;
        int lg = 0; float sc = 1.f; bf16_t* base;
        const bool pr_nostore = mode == 4, pr_window = mode == 5, pr_pitch = mode >= 6;
        const int ldo = mode == 6 ? 2112 : DM;
        if (mode == 0 || mode >= 4) { if (p == 9) base = zbuf; else { const int g = p / 3, kind = p - 3 * g; lg = 2 * g; base = qkv + (size_t)p * PART; if (kind == 0) sc = C2Q; } }
        else { if (p == 3) base = zbuf; else { base = qkv + (size_t)p * PART; if (p == 0) sc = C2Q; } }
        const int col0 = colt + wc * 64 + 8 * fq;
        f32x4 cv[2][2];
        if (I8) {
#pragma unroll
            for (int bj = 0; bj < 2; ++bj)
#pragma unroll
                for (int n = 0; n < 2; ++n) cv[bj][n] = *(const f32x4*)(cs + u.pn * BM + wc * 64 + 8 * fq + bj * 32 + 4 * n) * sc;
        }
        float rsa[2][4];
#pragma unroll
        for (int ai = 0; ai < 2; ++ai)
#pragma unroll
            for (int m = 0; m < 4; ++m) rsa[ai][m] = I8 ? rs[u.pm * BM + ai * HALF + wr * 64 + m * 16 + fr] : sc;
#pragma unroll
        for (int ai = 0; ai < 2; ++ai)
#pragma unroll
            for (int m = 0; m < 4; ++m) {
                const int row = u.pm * BM + ai * HALF + wr * 64 + m * 16 + fr, b = row >> 11, t = row & 2047;
                const int R = (b << 11) + ((t & ((1 << lg) - 1)) << (11 - lg)) + (t >> lg);
                bf16_t* rowp = pr_pitch ? (qkv + (size_t)(p % 3) * 4096 * 2112 + (size_t)(R & 4095) * ldo + col0) : (base + (size_t)(pr_window ? (R & 255) : R) * DM + col0);
                const float rsv = rsa[ai][m];
#pragma unroll
                for (int bj = 0; bj < 2; ++bj) { f32x4 v0 = acc_f32(acc[ai][bj][m][0]) * rsv, v1 = acc_f32(acc[ai][bj][m][1]) * rsv;
                    if (I8) { v0 = v0 * cv[bj][0]; v1 = v1 * cv[bj][1]; }
                    u32x4 w; w.x = cvt_pk_bf16(v0[0], v0[1]); w.y = cvt_pk_bf16(v0[2], v0[3]); w.z = cvt_pk_bf16(v1[0], v1[1]); w.w = cvt_pk_bf16(v1[2], v1[3]);
                    if (pr_nostore) asm volatile("" :: "v"(w));
                    else {
#if EPI_SC1
                        asm volatile("global_store_dwordx4 %0, %1, off sc0 sc1\n\ts_nop 1" :: "v"(rowp + bj * 32), "v"(w) : "memory");
#else
                        *(u32x4*)(rowp + bj * 32) = w;
#endif
                    } } }
        if (mode == 1 && p == 1) {
#pragma unroll
            for (int bj = 0; bj < 2; ++bj)
#pragma unroll
                for (int n = 0; n < 2; ++n) { f32x4 s = {0.f, 0.f, 0.f, 0.f};
#pragma unroll
                    for (int ai = 0; ai < 2; ++ai)
#pragma unroll
                        for (int m = 0; m < 4; ++m) s += acc_f32(acc[ai][bj][m][n]) * (I8 ? rsa[ai][m] : 1.f);
                    if (I8) s = s * cv[bj][n];
#pragma unroll
                    for (int j = 0; j < 4; ++j) { float v = s[j]; v += __shfl_xor(v, 1); v += __shfl_xor(v, 2); v += __shfl_xor(v, 4); v += __shfl_xor(v, 8); s[j] = v; }
                    if (fr == 0) *(f32x4*)(ksum + ((size_t)(wr * 32 + u.pm) * DM + colt + bj * 32 + wc * 64 + 8 * fq + 4 * n)) = s; }
        }
    }
};

template <bool LASTL> struct EpiOutF {
    static constexpr bool PERM = true, AFTER_DRAIN = true;
    const float* xin; float* xout; const float* gate;
    const float* ca_w; const float* ca_scale; const float* cs_shift;
    unsigned char* hq; float* rsq; float* xs; unsigned* cnt;
    static constexpr bool last = LASTL;
    __device__ __forceinline__ void wait_cnt(unsigned* c, int wid) const {
        if (wid == 0) { unsigned sp = 0;
            while ((unsigned)__builtin_amdgcn_readfirstlane((int)__hip_atomic_load(c, __ATOMIC_RELAXED, __HIP_MEMORY_SCOPE_AGENT)) < 8u) { __builtin_amdgcn_s_sleep(1); if (++sp > (1u << 22)) break; }
            __builtin_amdgcn_fence(__ATOMIC_ACQUIRE, "agent"); asm volatile("s_waitcnt vmcnt(0)" ::: "memory"); }
        __syncthreads(); }
    __device__ __forceinline__ void fused(f32x4 (&acc)[2][2][4][2], const Unit& u, int wr, int wc, int fr, int fq, LAS unsigned char* lds, int wid, int lane) const {
        asm volatile("" : "+v"(fr), "+v"(fq), "+v"(lane));
        const int tid = wid * 64 + lane, b = (u.pm * BM) >> 11, col0 = u.pn * BM + wc * 64 + 8 * fq;
        LAS float* P = (LAS float*)lds;
        LAS float* T = (LAS float*)(lds + 4096);
        { f32x4 gv[2][2];
#pragma unroll
          for (int bj = 0; bj < 2; ++bj)
#pragma unroll
              for (int n = 0; n < 2; ++n) gv[bj][n] = *(const f32x4*)(gate + b * 6144 + col0 + bj * 32 + 4 * n);
#pragma unroll
          for (int ai = 0; ai < 2; ++ai)
#pragma unroll
            for (int mp = 0; mp < 2; ++mp) {
              f32x4 xv[2][2][2];
#pragma unroll
              for (int mm = 0; mm < 2; ++mm) { const int m = 2 * mp + mm; const size_t off = (size_t)(u.pm * BM + ai * HALF + wr * 64 + m * 16 + fr) * DM + col0;
#pragma unroll
                  for (int bj = 0; bj < 2; ++bj)
#pragma unroll
                      for (int n = 0; n < 2; ++n) xv[mm][bj][n] = *(const f32x4*)(xin + off + bj * 32 + 4 * n); }
              asm volatile("" ::: "memory");
#pragma unroll
              for (int mm = 0; mm < 2; ++mm) { const int m = 2 * mp + mm; const size_t off = (size_t)(u.pm * BM + ai * HALF + wr * 64 + m * 16 + fr) * DM + col0;
#pragma unroll
                  for (int bj = 0; bj < 2; ++bj)
#pragma unroll
                      for (int n = 0; n < 2; ++n) { acc[ai][bj][m][n] = xv[mm][bj][n] + gv[bj][n] * acc[ai][bj][m][n]; if constexpr (!LASTL) *(f32x4*)(xout + off + bj * 32 + 4 * n) = acc[ai][bj][m][n]; }
                  asm volatile("" : "+v"(acc[ai][0][m][0]), "+v"(acc[ai][0][m][1]), "+v"(acc[ai][1][m][0]), "+v"(acc[ai][1][m][1])); }
              asm volatile("" ::: "memory"); __builtin_amdgcn_sched_barrier(0); } }
#pragma unroll
        for (int ai = 0; ai < 2; ++ai)
#pragma unroll
            for (int m = 0; m < 4; ++m) { float q = 0.f;
#pragma unroll
                for (int bj = 0; bj < 2; ++bj)
#pragma unroll
                    for (int n = 0; n < 2; ++n) { const f32x4 v = acc[ai][bj][m][n]; q += (v[0] * v[0] + v[1] * v[1]) + (v[2] * v[2] + v[3] * v[3]); }
                q += __uint_as_float((unsigned)__builtin_amdgcn_ds_swizzle((int)__float_as_uint(q), (16 << 10) | 0x1f)); { auto r_ = __builtin_amdgcn_permlane32_swap(__float_as_uint(q), __float_as_uint(q), false, false); q = __uint_as_float(r_[0]) + __uint_as_float(r_[1]); }
                if (fq == 0) P[(ai * HALF + wr * 64 + m * 16 + fr) * 4 + wc] = q;
                __builtin_amdgcn_sched_barrier(0); }
        __syncthreads();
        if (tid < 256) { const float t = (P[tid * 4 + 0] + P[tid * 4 + 1]) + (P[tid * 4 + 2] + P[tid * 4 + 3]);
            __hip_atomic_store(xs + ((size_t)(u.pm * BM + tid) * 8 + u.pn), t, __ATOMIC_RELAXED, __HIP_MEMORY_SCOPE_AGENT); }
        asm volatile("s_waitcnt vmcnt(0)" ::: "memory");
        __syncthreads();
        if (tid == 0) __hip_atomic_fetch_add(cnt + 128 * u.pm, 1u, __ATOMIC_RELAXED, __HIP_MEMORY_SCOPE_AGENT);
        wait_cnt(cnt + 128 * u.pm, wid);
        if (tid < 256) { const float* sl = xs + (size_t)(u.pm * BM + tid) * 8; float t = 0.f;
#pragma unroll
            for (int k = 0; k < 8; ++k) t += __hip_atomic_load(sl + k, __ATOMIC_RELAXED, __HIP_MEMORY_SCOPE_AGENT);
            T[tid] = 1.0f / sqrtf(t * (1.f / DM) + EPS); }
        __syncthreads();
        f32x4 cav[2][2], csv[2][2];
#pragma unroll
        for (int bj = 0; bj < 2; ++bj)
#pragma unroll
            for (int n = 0; n < 2; ++n) { const int c = col0 + bj * 32 + 4 * n; const f32x4 w = *(const f32x4*)(ca_w + c);
                if constexpr (LASTL) { cav[bj][n] = w; csv[bj][n] = (f32x4){0.f, 0.f, 0.f, 0.f}; }
                else { cav[bj][n] = w * (*(const f32x4*)(ca_scale + b * 6144 + c) + 1.f); csv[bj][n] = *(const f32x4*)(cs_shift + b * 6144 + c); } }
        if constexpr (LASTL) {
            asm volatile("" : "+v"(fr));
#pragma unroll
            for (int ai = 0; ai < 2; ++ai)
#pragma unroll
                for (int m = 0; m < 4; ++m) { const int rl = ai * HALF + wr * 64 + m * 16 + fr; const float rs = T[rl]; const size_t off = (size_t)(u.pm * BM + rl) * DM + col0;
#pragma unroll
                    for (int bj = 0; bj < 2; ++bj)
#pragma unroll
                        for (int n = 0; n < 2; ++n) *(f32x4*)(xout + off + bj * 32 + 4 * n) = acc[ai][bj][m][n] * rs * cav[bj][n]; }
        } else {
        LAS float* P2 = (LAS float*)(lds + 8192); LAS float* T2 = (LAS float*)(lds + 12288);
#pragma unroll
        for (int ai = 0; ai < 2; ++ai)
#pragma unroll
            for (int m = 0; m < 4; ++m) { const int rl = ai * HALF + wr * 64 + m * 16 + fr; const float rs = T[rl]; float am = 0.f;
#pragma unroll
                for (int bj = 0; bj < 2; ++bj)
#pragma unroll
                    for (int n = 0; n < 2; ++n) { const f32x4 h = acc[ai][bj][m][n] * rs * cav[bj][n] + csv[bj][n]; acc[ai][bj][m][n] = h;
                        am = fmaxf(am, fmaxf(fmaxf(fabsf(h[0]), fabsf(h[1])), fmaxf(fabsf(h[2]), fabsf(h[3])))); }
                am = fmaxf(am, __uint_as_float((unsigned)__builtin_amdgcn_ds_swizzle((int)__float_as_uint(am), (16 << 10) | 0x1f))); { auto r_ = __builtin_amdgcn_permlane32_swap(__float_as_uint(am), __float_as_uint(am), false, false); am = fmaxf(__uint_as_float(r_[0]), __uint_as_float(r_[1])); }
                if (fq == 0) P2[rl * 4 + wc] = am;
                __builtin_amdgcn_sched_barrier(0); }
        __syncthreads();
        if (tid < 256) { const float t = fmaxf(fmaxf(P2[tid * 4 + 0], P2[tid * 4 + 1]), fmaxf(P2[tid * 4 + 2], P2[tid * 4 + 3]));
            __hip_atomic_store(xs + (size_t)MTOK * 8 + ((size_t)(u.pm * BM + tid) * 8 + u.pn), t, __ATOMIC_RELAXED, __HIP_MEMORY_SCOPE_AGENT); }
        asm volatile("s_waitcnt vmcnt(0)" ::: "memory");
        __syncthreads();
        if (tid == 0) __hip_atomic_fetch_add(cnt + 128 * u.pm + 64, 1u, __ATOMIC_RELAXED, __HIP_MEMORY_SCOPE_AGENT);
        wait_cnt(cnt + 128 * u.pm + 64, wid);
        if (tid < 256) { const float* sl = xs + (size_t)MTOK * 8 + (size_t)(u.pm * BM + tid) * 8; float t = 0.f;
#pragma unroll
            for (int k = 0; k < 8; ++k) t = fmaxf(t, __hip_atomic_load(sl + k, __ATOMIC_RELAXED, __HIP_MEMORY_SCOPE_AGENT));
            T2[tid] = t > 0.f ? 127.f / t : 0.f;
            if (u.pn == 0) rsq[u.pm * BM + tid] = t > 0.f ? t * (1.f / 127.f) : 1.f; }
        __syncthreads();
#pragma unroll
        for (int ai = 0; ai < 2; ++ai)
#pragma unroll
            for (int m = 0; m < 4; ++m) { const int rl = ai * HALF + wr * 64 + m * 16 + fr; const float inv = T2[rl]; unsigned char* qrow = hq + (size_t)(u.pm * BM + rl) * DM + col0;
#pragma unroll
                for (int bj = 0; bj < 2; ++bj) { unsigned w2[2];
#pragma unroll
                    for (int n = 0; n < 2; ++n) { const f32x4 h = acc[ai][bj][m][n] * inv;
                        w2[n] = ((unsigned)(int)rintf(h[0]) & 0xffu) | (((unsigned)(int)rintf(h[1]) & 0xffu) << 8) | (((unsigned)(int)rintf(h[2]) & 0xffu) << 16) | (((unsigned)(int)rintf(h[3]) & 0xffu) << 24); }
                    *(u32x2*)(qrow + bj * 32) = (u32x2){w2[0], w2[1]}; }
                __builtin_amdgcn_sched_barrier(0); }
        }
    }
};
template <bool I8> struct AccSel { typedef f32x4 type; };
template <> struct AccSel<true> { typedef i32x4 type; };
template <bool I8> __device__ __forceinline__ typename AccSel<I8>::type mma1(bf16x8 b, bf16x8 a, typename AccSel<I8>::type c) {
    if constexpr (I8) return __builtin_amdgcn_mfma_i32_16x16x64_i8(__builtin_bit_cast(i32x4, b), __builtin_bit_cast(i32x4, a), c, 0, 0, 0);
    else return __builtin_amdgcn_mfma_f32_16x16x32_bf16(b, a, c, 0, 0, 0);
}
template <class Epi, class Sched, bool ALIGN_EPI = false, bool SP2 = false, bool I8 = false>
__device__ __forceinline__ void gemm_phase(LAS unsigned char* lds, const Gemm g, const Sched& S, const Epi& E, int wv) {
    const int tid = otid(wv), wid = __builtin_amdgcn_readfirstlane(tid >> 6), lane = tid & 63, wr = wid >> 2, wc = wid & 3, fr = lane & 15, fq = lane >> 4;
    const int KBY = g.KB, nt = KBY / (BK * 2);
    unsigned voffA[2], voffB[2];
#pragma unroll
    for (int i = 0; i < 2; ++i) { int R, C; stage_rc(tid * 16 + i * 8192, R, C); const int Rb = Epi::PERM ? ((R & ~31) + perm32(R & 31)) : R;
        voffA[i] = (unsigned)(R * KBY + C * 2); voffB[i] = (unsigned)((Epi::PERM ? ((R >> 5) * 64 + perm32(R & 31)) : Rb) * KBY + C * 2); }
    const size_t kstep = (size_t)(BK * 2);
    const size_t hstep = (size_t)HALF * KBY;
    const size_t hstepB = Epi::PERM ? (size_t)32 * KBY : hstep;
    const size_t tstep = 2 * hstep;
    const unsigned ldsw = (unsigned)wid * 1024u;
    const int aoff = lds_byte(wr * 64 + fr, fq * 8), boff = lds_byte(wc * 32 + fr, fq * 8);
#define PG8_SA(b, h) (((b) * 2 + (h)) * HTB)
#define PG8_SB(b, h) ((4 + (b) * 2 + (h)) * HTB)
#define PG8_STAGE(bufoff, gbase, voff) do { _Pragma("unroll") for (int _i = 0; _i < 2; ++_i) \
        __builtin_amdgcn_global_load_lds((const unsigned*)((const char*)(gbase) + (voff)[_i]), (LAS unsigned*)(lds + (bufoff) + ldsw + _i * 8192), 16, 0, 0); } while (0)
#define PG8_LDA(dst, b, h) do { _Pragma("unroll") for (int m = 0; m < 4; ++m) _Pragma("unroll") for (int k = 0; k < 2; ++k) dst[m][k] = *(const LAS bf16x8*)(lds + PG8_SA(b, h) + aoff + m * 2048 + k * 1024); } while (0)
#define PG8_LDB(dst, b, h) do { _Pragma("unroll") for (int n = 0; n < 2; ++n) _Pragma("unroll") for (int k = 0; k < 2; ++k) dst[n][k] = *(const LAS bf16x8*)(lds + PG8_SB(b, h) + boff + n * 2048 + k * 1024); } while (0)
#define PG8_MMA(ai, bj, At, Bt) do { __builtin_amdgcn_s_setprio(1); _Pragma("unroll") for (int m = 0; m < 4; ++m) _Pragma("unroll") for (int n = 0; n < 2; ++n) _Pragma("unroll") for (int k = 0; k < 2; ++k) \
        acc[ai][bj][m][n] = mma1<I8>(Bt[n][k], At[m][k], acc[ai][bj][m][n]); __builtin_amdgcn_s_setprio(0); } while (0)
#define PG8_WAIT_V(n) asm volatile("s_waitcnt vmcnt(" #n ")" ::: "memory")
#define PG8_WAIT_L(n) asm volatile("s_waitcnt lgkmcnt(" #n ")" ::: "memory")
#define PG8_BAR __builtin_amdgcn_s_barrier()
#define PG8_SCHED __builtin_amdgcn_sched_barrier(0)
    Unit cur, nxt; int ui = 0;
    if (!S.next(0, cur)) return;
    typedef typename AccSel<I8>::type acc_t;
    acc_t acc[2][2][4][2];
#pragma unroll
    for (int a = 0; a < 2; ++a)
#pragma unroll
        for (int b = 0; b < 2; ++b)
#pragma unroll
            for (int m = 0; m < 4; ++m)
#pragma unroll
                for (int n = 0; n < 2; ++n) acc[a][b][m][n] = acc_t{};
    bf16x8 At[4][2], B0[2][2], B1[2][2];
    const char* cA = (const char*)g.A + (size_t)cur.pm * tstep; const char* cB = (const char*)g.Bt + (size_t)cur.pn * tstep;
    S.a_ready(cur);
    if constexpr (SP2) {
        PG8_STAGE(PG8_SB(0, 0), cB, voffB); PG8_STAGE(PG8_SB(0, 1), cB + hstepB, voffB); PG8_STAGE(PG8_SA(0, 0), cA, voffA); PG8_STAGE(PG8_SA(0, 1), cA + hstep, voffA);
        if (wr == 1) PG8_BAR;
        PG8_WAIT_V(2); PG8_BAR;
        PG8_STAGE(PG8_SB(1, 0), cB + kstep, voffB); PG8_STAGE(PG8_SA(1, 0), cA + kstep, voffA); PG8_STAGE(PG8_SB(1, 1), cB + hstepB + kstep, voffB);
        PG8_WAIT_V(6); PG8_BAR;
    } else {
        PG8_STAGE(PG8_SB(0, 0), cB, voffB); PG8_STAGE(PG8_SA(0, 0), cA, voffA); PG8_STAGE(PG8_SB(0, 1), cB + hstepB, voffB); PG8_STAGE(PG8_SA(0, 1), cA + hstep, voffA);
        if (wr == 1) PG8_BAR;
        PG8_WAIT_V(4); PG8_BAR;
        PG8_STAGE(PG8_SB(1, 0), cB + kstep, voffB); PG8_STAGE(PG8_SA(1, 0), cA + kstep, voffA); PG8_STAGE(PG8_SB(1, 1), cB + hstepB + kstep, voffB);
        PG8_WAIT_V(6); PG8_BAR;
    }
    for (;;) {
        const bool has_next = S.next(ui + 1, nxt);
        const char* nA = has_next ? (const char*)g.A + (size_t)nxt.pm * tstep : cA; const char* nB = has_next ? (const char*)g.Bt + (size_t)nxt.pn * tstep : cB;
        for (int t = 0; t < nt; t += 2) {
            const bool last = (t == nt - 2);
            const char* a1 = cA + (size_t)(t + 1) * kstep;
            const char* a2 = last ? nA : cA + (size_t)(t + 2) * kstep; const char* b2 = last ? nB : cB + (size_t)(t + 2) * kstep;
            const char* a3 = a2 + kstep; const char* b3 = b2 + kstep;
            if (last && has_next) S.a_ready(nxt);
            if constexpr (SP2) {
            PG8_LDB(B0, 0, 0); PG8_LDB(B1, 0, 1); PG8_SCHED; PG8_LDA(At, 0, 0); PG8_STAGE(PG8_SA(1, 1), a1 + hstep, voffA);
            PG8_WAIT_V(8); PG8_WAIT_L(0); PG8_BAR; PG8_MMA(0, 0, At, B0); PG8_MMA(0, 1, At, B1); PG8_BAR; PG8_SCHED;
            PG8_LDA(At, 0, 1); PG8_STAGE(PG8_SB(0, 0), b2, voffB); PG8_STAGE(PG8_SB(0, 1), b2 + hstepB, voffB); PG8_STAGE(PG8_SA(0, 0), a2, voffA);
            PG8_WAIT_V(8); PG8_WAIT_L(0); PG8_BAR; PG8_MMA(1, 0, At, B0); PG8_MMA(1, 1, At, B1); PG8_BAR; PG8_SCHED;
            PG8_LDB(B0, 1, 0); PG8_LDB(B1, 1, 1); PG8_SCHED; PG8_LDA(At, 1, 0); PG8_STAGE(PG8_SA(0, 1), a2 + hstep, voffA);
            PG8_WAIT_V(8); PG8_WAIT_L(0); PG8_BAR; PG8_MMA(0, 0, At, B0); PG8_MMA(0, 1, At, B1); PG8_BAR; PG8_SCHED;
            PG8_LDA(At, 1, 1); PG8_STAGE(PG8_SB(1, 0), b3, voffB); PG8_STAGE(PG8_SB(1, 1), b3 + hstepB, voffB); PG8_STAGE(PG8_SA(1, 0), a3, voffA);
            PG8_WAIT_V(8); PG8_WAIT_L(0); PG8_BAR; PG8_MMA(1, 0, At, B0); PG8_MMA(1, 1, At, B1); PG8_BAR; PG8_SCHED;
            } else {
            PG8_LDB(B0, 0, 0); PG8_SCHED; PG8_LDA(At, 0, 0); PG8_STAGE(PG8_SA(1, 1), a1 + hstep, voffA);
            PG8_WAIT_L(8); PG8_BAR; PG8_WAIT_L(0); PG8_MMA(0, 0, At, B0); PG8_BAR; PG8_SCHED;
            PG8_LDB(B1, 0, 1); PG8_STAGE(PG8_SB(0, 0), b2, voffB);
            PG8_BAR; PG8_WAIT_L(0); PG8_MMA(0, 1, At, B1); PG8_BAR;
            PG8_LDA(At, 0, 1); PG8_STAGE(PG8_SA(0, 0), a2, voffA);
            PG8_BAR; PG8_WAIT_L(0); PG8_MMA(1, 0, At, B0); PG8_BAR; PG8_SCHED;
            PG8_STAGE(PG8_SB(0, 1), b2 + hstepB, voffB);
            PG8_WAIT_V(6); PG8_BAR; PG8_MMA(1, 1, At, B1); PG8_BAR;
            PG8_LDB(B0, 1, 0); PG8_SCHED; PG8_LDA(At, 1, 0); PG8_STAGE(PG8_SA(0, 1), a2 + hstep, voffA);
            PG8_WAIT_L(8); PG8_BAR; PG8_WAIT_L(0); PG8_MMA(0, 0, At, B0); PG8_BAR; PG8_SCHED;
            PG8_LDB(B1, 1, 1); PG8_STAGE(PG8_SB(1, 0), b3, voffB);
            PG8_BAR; PG8_WAIT_L(0); PG8_MMA(0, 1, At, B1); PG8_BAR;
            PG8_LDA(At, 1, 1); PG8_STAGE(PG8_SA(1, 0), a3, voffA);
            PG8_BAR; PG8_WAIT_L(0); PG8_MMA(1, 0, At, B0); PG8_BAR; PG8_SCHED;
            PG8_STAGE(PG8_SB(1, 1), b3 + hstepB, voffB);
            PG8_WAIT_V(6); PG8_BAR; PG8_MMA(1, 1, At, B1); PG8_BAR;
            }
        }
        if constexpr (ALIGN_EPI) { if (wr == 0) PG8_BAR; }
        if constexpr (!Epi::AFTER_DRAIN) { E(acc, cur, wr, wc, fr, fq); S.done(cur); }
        if (!has_next) break;
#pragma unroll
        for (int a = 0; a < 2; ++a)
#pragma unroll
            for (int b = 0; b < 2; ++b)
#pragma unroll
                for (int m = 0; m < 4; ++m)
#pragma unroll
                    for (int n = 0; n < 2; ++n) acc[a][b][m][n] = acc_t{};
        cur = nxt; cA = nA; cB = nB; ++ui;
        if constexpr (ALIGN_EPI) { if (wr == 1) PG8_BAR; }
    }
    PG8_WAIT_V(0);
    if constexpr (!ALIGN_EPI) { if (wr == 0) PG8_BAR; }
    PG8_BAR;
    if constexpr (Epi::AFTER_DRAIN) { if constexpr (!I8) E.fused(acc, cur, wr, wc, fr, fq, lds, wid, lane); }
#undef PG8_SA
#undef PG8_SB
#undef PG8_STAGE
#undef PG8_LDA
#undef PG8_LDB
#undef PG8_MMA
#undef PG8_WAIT_V
#undef PG8_WAIT_L
#undef PG8_BAR
#undef PG8_SCHED
}
}

struct Params {
    const float *x, *c, *norm_w, *mod_w, *mod_b, *a_w_in, *a_w_out, *b_w_in, *b_w_out, *final_w;
    float* out; unsigned char* ws;
};

typedef const __attribute__((address_space(4))) Params CParams;
__device__ __forceinline__ CParams& PP() { CParams* p = (CParams*)__builtin_amdgcn_kernarg_segment_ptr(); asm volatile("" : "+s"(p)); return *p; }

__device__ __forceinline__ void p0_mod(unsigned char* lds, int wv) {
    CParams& P = PP();
    const int tid = otid(wv);
    f32x4* condT = (f32x4*)lds;
    float* red = (float*)(lds + 32768);
    float* MOD = (float*)(P.ws + WS_MOD);
    bool have = false;
    for (int item = obid(); item < 768; item += gridDim.x) {
        if (!have) { have = true;
            for (int k = tid; k < DM; k += NTHREADS) { f32x4 v; v.x = silu_f(P.c[k]); v.y = silu_f(P.c[DM + k]); v.z = silu_f(P.c[2 * DM + k]); v.w = silu_f(P.c[3 * DM + k]); condT[k] = v; }
            __syncthreads(); }
        const int l = item / 192, n0 = (item % 192) * 32, cq = tid & 7, kp = tid >> 3;
        f32x4 a0 = {0.f, 0.f, 0.f, 0.f}, a1 = a0, a2 = a0, a3 = a0;
        const float* wp = P.mod_w + ((size_t)l * DM + kp * 32) * 6144 + n0 + 4 * cq;
#pragma unroll 16
        for (int k = 0; k < 32; ++k) { const f32x4 w = *(const f32x4*)(wp + (size_t)k * 6144); const f32x4 cv = condT[kp * 32 + k];
            a0 += w * cv.x; a1 += w * cv.y; a2 += w * cv.z; a3 += w * cv.w; }
        *(f32x4*)(red + (kp * 4 + 0) * 32 + 4 * cq) = a0; *(f32x4*)(red + (kp * 4 + 1) * 32 + 4 * cq) = a1;
        *(f32x4*)(red + (kp * 4 + 2) * 32 + 4 * cq) = a2; *(f32x4*)(red + (kp * 4 + 3) * 32 + 4 * cq) = a3;
        __syncthreads();
        if (tid < 128) { const int b = tid >> 5, col = tid & 31; float s = P.mod_b[l * 6144 + n0 + col];
#pragma unroll 8
            for (int q = 0; q < 64; ++q) s += red[(q * 4 + b) * 32 + col];
            MOD[(l * 4 + b) * 6144 + n0 + col] = s; }
        __syncthreads();
    }
}
__device__ __forceinline__ void p0_transpose_item(const float* W, int ldn, int ncol0, int nblk, bf16_t* WT, unsigned char* scr, int item, int lane) {
    const int kb = item / nblk, nb = item - kb * nblk, k0 = kb * 64, n0 = nb * 64;
    const float* src = W + (size_t)(k0 + (lane >> 4)) * ldn + ncol0 + n0 + 4 * (lane & 15);
#pragma unroll 4
    for (int i = 0; i < 16; ++i) { const f32x4 v = *(const f32x4*)(src + (size_t)(4 * i) * ldn);
        unsigned* d = (unsigned*)(scr + (4 * i + (lane >> 4)) * 132 + 8 * (lane & 15));
        d[0] = cvt_pk_bf16(v.x, v.y); d[1] = cvt_pk_bf16(v.z, v.w); }
    LDS_WAIT();
    const int c = lane & 7;
#pragma unroll
    for (int j = 0; j < 8; ++j) { const int n = (lane >> 3) + 8 * j; const unsigned short* s = (const unsigned short*)(scr + (8 * c) * 132 + 2 * n);
        u32x4 o;
        o.x = (unsigned)s[0 * 66] | ((unsigned)s[1 * 66] << 16); o.y = (unsigned)s[2 * 66] | ((unsigned)s[3 * 66] << 16);
        o.z = (unsigned)s[4 * 66] | ((unsigned)s[5 * 66] << 16); o.w = (unsigned)s[6 * 66] | ((unsigned)s[7 * 66] << 16);
        *(u32x4*)(WT + (size_t)(n0 + n) * DM + k0 + 8 * c) = o; }
    LDS_WAIT();
}
__device__ __forceinline__ void p0_panel_i8(const float* W, int ldn, int n0, signed char* WT, float* cs, unsigned char* lds, int tid) {
    const int lane = tid & 63, wave = __builtin_amdgcn_readfirstlane(tid >> 6);
    float* maxbuf = (float*)(lds + 131072);
    f32x4 mx = {0.f, 0.f, 0.f, 0.f};
    { const float* src = W + (size_t)(wave * 256 + (lane >> 3)) * ldn + n0 + 4 * (lane & 7);
      unsigned char* dst = lds + (size_t)(wave * 256 + (lane >> 3)) * 64 + 8 * (lane & 7);
#pragma unroll 16
      for (int i = 0; i < 32; ++i) { const f32x4 v = *(const f32x4*)(src + (size_t)(8 * i) * ldn);
          mx.x = fmaxf(mx.x, fabsf(v.x)); mx.y = fmaxf(mx.y, fabsf(v.y)); mx.z = fmaxf(mx.z, fabsf(v.z)); mx.w = fmaxf(mx.w, fabsf(v.w));
          u32x2 w; w.x = cvt_pk_bf16(v.x, v.y); w.y = cvt_pk_bf16(v.z, v.w); *(u32x2*)(dst + (size_t)(8 * i) * 64) = w; } }
#pragma unroll
    for (int o = 8; o < 64; o <<= 1) { mx.x = fmaxf(mx.x, __shfl_xor(mx.x, o)); mx.y = fmaxf(mx.y, __shfl_xor(mx.y, o)); mx.z = fmaxf(mx.z, __shfl_xor(mx.z, o)); mx.w = fmaxf(mx.w, __shfl_xor(mx.w, o)); }
    if (lane < 8) *(f32x4*)(maxbuf + wave * 32 + 4 * lane) = mx;
    __syncthreads();
    { const int n = tid & 31, kc = tid >> 5;
      float cm = maxbuf[n];
#pragma unroll
      for (int w = 1; w < 8; ++w) cm = fmaxf(cm, maxbuf[w * 32 + n]);
      const float inv = cm > 0.f ? 127.f / cm : 0.f;
      if (kc == 0) cs[n0 + n] = cm > 0.f ? cm * (1.f / 127.f) : 1.f;
      const unsigned short* t = (const unsigned short*)lds + (size_t)(kc * 128) * 32 + n;
      signed char* orow = WT + (size_t)(n0 + n) * DM + kc * 128;
#pragma unroll 2
      for (int i = 0; i < 8; ++i) { unsigned w[4];
#pragma unroll
          for (int q = 0; q < 4; ++q) { unsigned acc = 0;
#pragma unroll
              for (int e = 0; e < 4; ++e) { const float v = bf2f(t[(size_t)(16 * i + 4 * q + e) * 32]) * inv; int iv = (int)rintf(v); iv = iv > 127 ? 127 : (iv < -127 ? -127 : iv); acc |= ((unsigned)iv & 0xffu) << (8 * e); }
              w[q] = acc; }
          *(u32x4*)(orow + 16 * i) = (u32x4){w[0], w[1], w[2], w[3]}; } }
    __syncthreads();
}
__device__ __forceinline__ void p0_weights(unsigned char* lds, int wv) {
    CParams& P = PP();
    const int tid_ = otid(wv); const int lane = tid_ & 63, wave = __builtin_amdgcn_readfirstlane(tid_ >> 6);
    constexpr int PA = A_N / 32, PB = (MOBA_QK_I8 ? B_N : 4096) / 32, PO = DM / 32, NPANEL = 2 * PA + 2 * PB + (OUTA_I8 ? 2 * PO : 0);
    for (int it = obid(); it < NPANEL; it += gridDim.x) {
        if (it < 2 * PA) { const int j = it / PA, pnl = it - j * PA;
            p0_panel_i8(P.a_w_in + (size_t)j * DM * A_N, A_N, pnl * 32, (signed char*)(P.ws + WS_WAIN) + (size_t)j * A_N * DM, (float*)(P.ws + WS_CSA) + j * A_N, lds, tid_); }
        else if (it < 2 * PA + 2 * PB) { const int r = it - 2 * PA, j = r / PB, pnl = r - j * PB;
#if MOBA_QK_I8
            p0_panel_i8(P.b_w_in + (size_t)j * DM * B_N, B_N, pnl * 32, (signed char*)(P.ws + WS_WBQK) + (size_t)j * B_N * DM, (float*)(P.ws + WS_CSB) + j * B_N, lds, tid_); }
#else
            p0_panel_i8(P.b_w_in + (size_t)j * DM * B_N + 4096, B_N, pnl * 32, (signed char*)(P.ws + WS_WBVZ) + (size_t)j * 4096 * DM, (float*)(P.ws + WS_CSB) + j * 4096, lds, tid_); }
#endif
#if OUTA_I8
        else { const int r = it - 2 * PA - 2 * PB, j = r / PO, pnl = r - j * PO;
            p0_panel_i8(P.a_w_out + (size_t)j * DM * DM, DM, pnl * 32, (signed char*)(P.ws + WS_WAOUT) + (size_t)j * DM * DM, (float*)(P.ws + WS_CSO) + j * DM, lds, tid_); }
#endif
    }
    unsigned char* scr = lds + 65536 + wave * 8448;
    const int gw = obid() * 8 + wave, NGW = gridDim.x * 8;
    constexpr int I_B = MOBA_QK_I8 ? 0 : 32 * 64, I_O = 32 * 32, I_AO = OUTA_I8 ? 0 : 32 * 32, TOTAL = 2 * I_B + 2 * I_AO + 2 * I_O;
    for (int it = gw; it < TOTAL; it += NGW) {
        int r = it;
        if (I_B > 0 && r < 2 * I_B) { const int j = r / (I_B > 0 ? I_B : 1); p0_transpose_item(P.b_w_in + (size_t)j * DM * B_N, B_N, 0, 64, (bf16_t*)(P.ws + WS_WBQK) + (size_t)j * 4096 * DM, scr, r - j * I_B, lane); continue; } r -= 2 * I_B;
        if (I_AO > 0 && r < 2 * I_AO) { const int j = r / (I_AO > 0 ? I_AO : 1); p0_transpose_item(P.a_w_out + (size_t)j * DM * DM, DM, 0, 32, (bf16_t*)(P.ws + WS_WAOUT) + (size_t)j * DM * DM, scr, r - j * I_AO, lane); continue; } r -= 2 * I_AO;
        { const int j = r / I_O; p0_transpose_item(P.b_w_out + (size_t)j * DM * DM, DM, 0, 32, (bf16_t*)(P.ws + WS_WBOUT) + (size_t)j * DM * DM, scr, r - j * I_O, lane); }
    }
}

__device__ __forceinline__ void norm_phase(int layer, bool want_bf16, int wv) {
    CParams& P = PP(); const float* xin = layer == 0 ? P.x : P.out;
    const int tid_ = otid(wv); const int lane = tid_ & 63, wave = __builtin_amdgcn_readfirstlane(tid_ >> 6);
    const int gw = obid() * 8 + wave, NGW = gridDim.x * 8;
    const float* MOD = (const float*)(P.ws + WS_MOD);
    bf16_t* Hb = (bf16_t*)(P.ws + WS_H); unsigned char* Hq = P.ws + WS_HQ; float* RS = (float*)(P.ws + WS_RS);
    for (int r0 = gw * 4; r0 < MTOK; r0 += NGW * 4) {
        const int b = r0 >> 11;
        const float* shift = MOD + (size_t)(layer * 4 + b) * 6144; const float* scale = shift + DM; const float* nw = P.norm_w + layer * DM;
        f32x4 ca[8], cs[8];
#pragma unroll
        for (int j = 0; j < 8; ++j) { const int c = 4 * lane + 256 * j; const f32x4 w = *(const f32x4*)(nw + c), s = *(const f32x4*)(scale + c); ca[j] = w * (s + 1.f); cs[j] = *(const f32x4*)(shift + c); }
        for (int rr = 0; rr < 4; ++rr) {
            const float* xr = xin + (size_t)(r0 + rr) * DM; f32x4 v[8]; float ss = 0.f;
#pragma unroll
            for (int j = 0; j < 8; ++j) { v[j] = *(const f32x4*)(xr + 4 * lane + 256 * j); ss += (v[j].x * v[j].x + v[j].y * v[j].y) + (v[j].z * v[j].z + v[j].w * v[j].w); }
            const float rs = 1.0f / sqrtf(wave_sum(ss) * (1.f / DM) + EPS);
            float am = 0.f;
#pragma unroll
            for (int j = 0; j < 8; ++j) { v[j] = v[j] * rs * ca[j] + cs[j]; am = fmaxf(am, fmaxf(fmaxf(fabsf(v[j].x), fabsf(v[j].y)), fmaxf(fabsf(v[j].z), fabsf(v[j].w)))); }
            am = wave_max(am);
            const float inv = am > 0.f ? 127.f / am : 0.f;
            if (lane == 0) RS[r0 + rr] = am > 0.f ? am * (1.f / 127.f) : 1.f;
            unsigned char* qr = Hq + (size_t)(r0 + rr) * DM;
#pragma unroll
            for (int j = 0; j < 8; ++j) { const f32x4 h = v[j] * inv;
                const int i0 = (int)rintf(h.x), i1 = (int)rintf(h.y), i2 = (int)rintf(h.z), i3 = (int)rintf(h.w);
                *(unsigned*)(qr + 4 * lane + 256 * j) = ((unsigned)i0 & 0xffu) | (((unsigned)i1 & 0xffu) << 8) | (((unsigned)i2 & 0xffu) << 16) | (((unsigned)i3 & 0xffu) << 24); }
            if (want_bf16) { bf16_t* hr = Hb + (size_t)(r0 + rr) * DM;
#pragma unroll
                for (int j = 0; j < 8; ++j) { u32x2 w; w.x = cvt_pk_bf16(v[j].x, v[j].y); w.y = cvt_pk_bf16(v[j].z, v[j].w); *(u32x2*)(hr + 4 * lane + 256 * j) = w; } }
        }
    }
}
__device__ __forceinline__ void final_norm_phase(int wv) {
    CParams& P = PP();
    const int tid_ = otid(wv); const int lane = tid_ & 63, wave = __builtin_amdgcn_readfirstlane(tid_ >> 6);
    const int gw = obid() * 8 + wave, NGW = gridDim.x * 8;
    f32x4 cw[8];
#pragma unroll
    for (int j = 0; j < 8; ++j) cw[j] = *(const f32x4*)(P.final_w + 4 * lane + 256 * j);
    for (int r = gw; r < MTOK; r += NGW) {
        float* xr = P.out + (size_t)r * DM; f32x4 v[8]; float ss = 0.f;
#pragma unroll
        for (int j = 0; j < 8; ++j) { v[j] = *(const f32x4*)(xr + 4 * lane + 256 * j); ss += (v[j].x * v[j].x + v[j].y * v[j].y) + (v[j].z * v[j].z + v[j].w * v[j].w); }
        const float rs = 1.0f / sqrtf(wave_sum(ss) * (1.f / DM) + EPS);
#pragma unroll
        for (int j = 0; j < 8; ++j) *(f32x4*)(xr + 4 * lane + 256 * j) = v[j] * rs * cw[j];
    }
}

__device__ __forceinline__ void naive_attend(const bf16_t* Kh, const bf16_t* Vh, const float* qf, float* sc, int own_start, int own_len, int blkbase, int mask, int qpos, float slopeL, int lane,
                                             float& o0, float& o1, float& lse2) {
    int base = 0; float mx = -3.0e38f;
    { int m2 = mask;
      for (int rr = 0;; ++rr) { int start, len;
        if (rr == 0) { start = own_start; len = own_len; } else { if (!m2) break; const int j = __builtin_ctz(m2); m2 &= m2 - 1; start = blkbase + (j << 8); len = 256; }
        for (int i = lane; i < len; i += 64) { const int key = start + i; const u32x4* kp = (const u32x4*)(Kh + (size_t)key * DM); float dot = 0.f;
#pragma unroll 4
            for (int cch = 0; cch < 16; ++cch) { const u32x4 w = kp[cch]; const float* q = qf + cch * 8;
                dot += q[0] * bflo(w.x) + q[1] * bfhi(w.x) + q[2] * bflo(w.y) + q[3] * bfhi(w.y) + q[4] * bflo(w.z) + q[5] * bfhi(w.z) + q[6] * bflo(w.w) + q[7] * bfhi(w.w); }
            const float s = dot + slopeL * (float)(key - qpos); sc[base + i] = s; mx = fmaxf(mx, s); }
        base += len; } }
    const int tot = base; mx = wave_max(mx);
    LDS_WAIT();
    float sum = 0.f;
    for (int i = lane; i < tot; i += 64) { const float p = exp2f(sc[i] - mx); sc[i] = p; sum += p; }
    sum = wave_sum(sum);
    LDS_WAIT();
    float a0 = 0.f, a1 = 0.f; base = 0;
    { int m2 = mask;
      for (int rr = 0;; ++rr) { int start, len;
        if (rr == 0) { start = own_start; len = own_len; } else { if (!m2) break; const int j = __builtin_ctz(m2); m2 &= m2 - 1; start = blkbase + (j << 8); len = 256; }
        const bf16_t* vp = Vh + (size_t)start * DM + 2 * lane;
        for (int i = 0; i < len; ++i) { const float p = sc[base + i]; const unsigned w = *(const unsigned*)(vp + (size_t)i * DM); a0 += p * bflo(w); a1 += p * bfhi(w); }
        base += len; } }
    LDS_WAIT();
    const float inv = 1.f / sum; o0 = a0 * inv; o1 = a1 * inv; lse2 = mx + log2f(sum);
}
__device__ __forceinline__ float slope_of(int h) { return exp2f(-0.5f * (float)(h + 1)); }

__device__ __forceinline__ void attn_a_naive(unsigned char* lds, int wv) {
    CParams& P = PP();
    const int tid_ = otid(wv); const int lane = tid_ & 63, wave = __builtin_amdgcn_readfirstlane(tid_ >> 6);
    float* qf = (float*)(lds + wave * 8192); float* sc = qf + 128;
    const bf16_t* QKV = (const bf16_t*)(P.ws + WS_QKV); bf16_t* OG = (bf16_t*)(P.ws + WS_OG); float* LSE = (float*)(P.ws + WS_LSE);
    const int gw = obid() * 8 + wave, NGW = gridDim.x * 8;
    for (int it = gw; it < 3 * MTOK * NH; it += NGW) {
        const int h = it & 15, R = (it >> 4) & (MTOK - 1), g = it >> 17;
        const int lg = 2 * g, L = SEQ >> lg;
        const bf16_t* Qp = QKV + (size_t)(3 * g) * PART + (size_t)R * DM + h * HD;
        { const unsigned w = *(const unsigned*)(Qp + 2 * lane); qf[2 * lane] = bflo(w); qf[2 * lane + 1] = bfhi(w); }
        LDS_WAIT();
        const int seq0 = R & ~(L - 1); int lo = R - 128; if (lo < seq0) lo = seq0;
        float o0, o1, lse2;
        naive_attend(QKV + (size_t)(3 * g + 1) * PART + h * HD, QKV + (size_t)(3 * g + 2) * PART + h * HD, qf, sc, lo, R - lo + 1, 0, 0, R, slope_of(h) * (float)(1 << lg) * LOG2E, lane, o0, o1, lse2);
        *(unsigned*)(OG + (size_t)g * PART + (size_t)R * DM + h * HD + 2 * lane) = cvt_pk_bf16(o0, o1);
        if (lane == 0) LSE[((size_t)g * MTOK + R) * NH + h] = lse2;
    }
}
__device__ __forceinline__ void combine_phase(int wv) {
    CParams& P = PP();
    const int tid_ = otid(wv); const int lane = tid_ & 63, wave = __builtin_amdgcn_readfirstlane(tid_ >> 6);
    const int gw = obid() * 8 + wave, NGW = gridDim.x * 8;
    const bf16_t* OG = (const bf16_t*)(P.ws + WS_OG); const float* LSE = (const float*)(P.ws + WS_LSE); const bf16_t* Z = (const bf16_t*)(P.ws + WS_Z);
    unsigned char* GQ = P.ws + WS_HQ; float* RS = (float*)(P.ws + WS_RS);
    for (int m = gw; m < MTOK; m += NGW) {
        const int b = m >> 11, t = m & 2047;
        const int R0 = m, R1 = (b << 11) + ((t & 3) << 9) + (t >> 2), R2 = (b << 11) + ((t & 15) << 7) + (t >> 4);
        float v[4][8]; float am = 0.f, sq = 0.f;
#pragma unroll
        for (int j = 0; j < 4; ++j) { const int col = 8 * lane + 512 * j, h = col >> 7;
            const float l0 = LSE[((size_t)0 * MTOK + R0) * NH + h], l1 = LSE[((size_t)1 * MTOK + R1) * NH + h], l2 = LSE[((size_t)2 * MTOK + R2) * NH + h];
            const float mx = fmaxf(l0, fmaxf(l1, l2)); float e0 = exp2f(l0 - mx), e1 = exp2f(l1 - mx), e2 = exp2f(l2 - mx); const float inv = 1.f / (e0 + e1 + e2); e0 *= inv; e1 *= inv; e2 *= inv;
            const u32x4 a = *(const u32x4*)(OG + (size_t)R0 * DM + col), bb = *(const u32x4*)(OG + PART + (size_t)R1 * DM + col), cc = *(const u32x4*)(OG + 2 * PART + (size_t)R2 * DM + col);
            const u32x4 zz = *(const u32x4*)(Z + (size_t)m * DM + col);
#define CMB(F, I) { v[j][I] = (e0 * bflo(a.F) + e1 * bflo(bb.F) + e2 * bflo(cc.F)) * silu_f(bflo(zz.F)); v[j][I + 1] = (e0 * bfhi(a.F) + e1 * bfhi(bb.F) + e2 * bfhi(cc.F)) * silu_f(bfhi(zz.F)); \
                    am = fmaxf(am, fmaxf(fabsf(v[j][I]), fabsf(v[j][I + 1]))); sq += v[j][I] * v[j][I] + v[j][I + 1] * v[j][I + 1]; }
            CMB(x, 0) CMB(y, 2) CMB(z, 4) CMB(w, 6)
#undef CMB
        }
#if !OUTA_I8
        { bf16_t* Gr = (bf16_t*)(P.ws + WS_G) + (size_t)m * DM;
#pragma unroll
          for (int j = 0; j < 4; ++j) { u32x4 o; o.x = cvt_pk_bf16(v[j][0], v[j][1]); o.y = cvt_pk_bf16(v[j][2], v[j][3]); o.z = cvt_pk_bf16(v[j][4], v[j][5]); o.w = cvt_pk_bf16(v[j][6], v[j][7]); *(u32x4*)(Gr + 8 * lane + 512 * j) = o; }
          continue; }
#endif
        am = wave_max(am); sq = wave_sum(sq);
        am = fminf(am, GCLIP * sqrtf(sq * (1.f / DM)));
        const float inv = am > 0.f ? 127.f / am : 0.f;
        if (lane == 0) RS[m] = am > 0.f ? am * (1.f / 127.f) : 1.f;
#pragma unroll
        for (int j = 0; j < 4; ++j) { unsigned w0 = 0, w1 = 0;
#pragma unroll
            for (int e = 0; e < 4; ++e) { w0 |= ((unsigned)(int)rintf(fminf(fmaxf(v[j][e] * inv, -127.f), 127.f)) & 0xffu) << (8 * e); w1 |= ((unsigned)(int)rintf(fminf(fmaxf(v[j][4 + e] * inv, -127.f), 127.f)) & 0xffu) << (8 * e); }
            *(u32x2*)(GQ + (size_t)m * DM + 8 * lane + 512 * j) = (u32x2){w0, w1}; }
    }
}
__device__ __forceinline__ void attn_b_naive(unsigned char* lds, int wv) {
    CParams& P = PP();
    const int tid_ = otid(wv); const int lane = tid_ & 63, wave = __builtin_amdgcn_readfirstlane(tid_ >> 6);
    float* qf = (float*)(lds + wave * 8192); float* sc = qf + 128;
    const bf16_t* QKV = (const bf16_t*)(P.ws + WS_QKV); const bf16_t* Z = (const bf16_t*)(P.ws + WS_Z); bf16_t* G = (bf16_t*)(P.ws + WS_G); const float* KS = (const float*)(P.ws + WS_KSUM);
    const int gw = obid() * 8 + wave, NGW = gridDim.x * 8;
    for (int it = gw; it < MTOK * NH; it += NGW) {
        const int h = it & 15, m = it >> 4, b = m >> 11, t = m & 2047, n = t >> 8;
        const bf16_t* Qp = QKV + (size_t)m * DM + h * HD;
        float q0, q1; { const unsigned w = *(const unsigned*)(Qp + 2 * lane); q0 = bflo(w); q1 = bfhi(w); qf[2 * lane] = q0; qf[2 * lane + 1] = q1; }
        LDS_WAIT();
        float gt[8];
#pragma unroll
        for (int j = 0; j < 8; ++j) { float v = 0.f;
            if (j < n) { const float* k0 = KS + (size_t)(b * 8 + j) * DM + h * HD + 2 * lane; const float* k1 = k0 + (size_t)32 * DM; v = q0 * (k0[0] + k1[0]) + q1 * (k0[1] + k1[1]); }
            gt[j] = wave_sum(v); }
        int mask = 0;
#pragma unroll
        for (int j = 0; j < 8; ++j) { if (j < n) { int rank = 0;
#pragma unroll
                for (int j2 = 0; j2 < 8; ++j2) if (j2 < n && (gt[j2] > gt[j] || (gt[j2] == gt[j] && j2 < j))) ++rank;
                if (rank < 3) mask |= 1 << j; } }
        float o0, o1, lse2;
        naive_attend(QKV + PART + h * HD, QKV + 2 * PART + h * HD, qf, sc, (b << 11) + (n << 8), (t & 255) + 1, b << 11, mask, m, slope_of(h) * LOG2E, lane, o0, o1, lse2);
        const unsigned zw = *(const unsigned*)(Z + (size_t)m * DM + h * HD + 2 * lane);
        *(unsigned*)(G + (size_t)m * DM + h * HD + 2 * lane) = cvt_pk_bf16(o0 * silu_f(bflo(zw)), o1 * silu_f(bfhi(zw)));
    }
}

namespace fa {
constexpr int KVBLK = 64, SHM_K = KVBLK * HD * 2, SHM_V = KVBLK * HD * 2;
constexpr int OFF_V = 0, OFF_K = 2 * SHM_V, OFF_WS = OFF_K + 2 * SHM_K, OFF_OST = OFF_WS + 8 * 256, OST_ROW = 272, OST_WAVE = 32 * OST_ROW;
constexpr int OFF_GK = OFF_OST + 8 * OST_WAVE, OFF_SEL = OFF_GK + 7 * 128 * 4, OFF_END = OFF_SEL + 256 * 4;
static_assert(OFF_END <= LDS_BYTES - 1024, "attention LDS map");
constexpr float THR = 11.5f;
#define KSWZ(row, colB) ((row) * 256 + ((colB) ^ (((row) & 7) << 4)))
#define SBAR() __builtin_amdgcn_sched_barrier(0)
__device__ __forceinline__ int v_st(int k, int c) { const int kk = (k & ~0xC) | ((k & 4) << 1) | ((k & 8) >> 1); return ((kk >> 3) * 4 + (c >> 5)) * 512 + ((kk & 7) * 32 + (c & 31)) * 2; }
__device__ __forceinline__ int v_rd_base(int lane) { return ((lane & 3) << 3) | (((lane >> 2) & 3) << 6) | (((lane >> 4) & 1) << 5) | (((lane >> 5) & 1) << 8); }
constexpr int v_rd_off(int d0, int ks, int half) { return d0 * 512 + ks * 4096 + half * 2048; }
__device__ __forceinline__ int crow(int r, int hi) { return (r & 3) + 8 * (r >> 2) + 4 * hi; }
__device__ __forceinline__ void mask_tile(f32x16& p0, f32x16& p1, int dq, unsigned W) {
    const float NEG = -__builtin_inff();
#pragma unroll
    for (int r = 0; r < 16; ++r) { const int c = (r & 3) + 8 * (r >> 2);
        if ((unsigned)(dq - c) >= W) p0[r] = NEG;
        if ((unsigned)(dq - c - 32) >= W) p1[r] = NEG; }
}
__device__ __forceinline__ void partialSM(f32x16& p0, f32x16& p1, float& m_reg, float& alpha) {
    float pmax = p0[0];
#pragma unroll
    for (int r = 1; r < 16; ++r) pmax = fmaxf(pmax, p0[r]);
#pragma unroll
    for (int r = 0; r < 16; ++r) pmax = fmaxf(pmax, p1[r]);
    { auto rr = __builtin_amdgcn_permlane32_swap(__float_as_uint(pmax), __float_as_uint(pmax), false, false); pmax = fmaxf(__uint_as_float(rr[0]), __uint_as_float(rr[1])); }
    float mn;
    if (__builtin_expect(__all(pmax - m_reg <= THR), 1)) { mn = m_reg; alpha = 1.f; }
    else { mn = fmaxf(m_reg, pmax); alpha = __builtin_amdgcn_exp2f(m_reg - mn); m_reg = mn; }
#pragma unroll
    for (int r = 0; r < 16; ++r) p0[r] = __builtin_amdgcn_exp2f(p0[r] - mn);
#pragma unroll
    for (int r = 0; r < 16; ++r) p1[r] = __builtin_amdgcn_exp2f(p1[r] - mn);
}
__device__ __forceinline__ void finishSM(f32x16& p0, f32x16& p1, float alpha, float& l_reg, bf16x8& pa0, bf16x8& pa1, bf16x8& pa2, bf16x8& pa3) {
    float ps = 0;
#pragma unroll
    for (int r = 0; r < 16; ++r) ps += p0[r];
#pragma unroll
    for (int r = 0; r < 16; ++r) ps += p1[r];
    { auto rr = __builtin_amdgcn_permlane32_swap(__float_as_uint(ps), __float_as_uint(ps), false, false); ps = __uint_as_float(rr[0]) + __uint_as_float(rr[1]); }
    l_reg = l_reg * alpha + ps;
#define PK4(P, B_, OUT) do { unsigned a0 = cvt_pk_bf16(P[B_+0], P[B_+1]), a1 = cvt_pk_bf16(P[B_+2], P[B_+3]);                          \
        unsigned b0 = cvt_pk_bf16(P[B_+4], P[B_+5]), b1 = cvt_pk_bf16(P[B_+6], P[B_+7]);                                             \
        auto r0 = __builtin_amdgcn_permlane32_swap(a0, b0, false, false); auto r1 = __builtin_amdgcn_permlane32_swap(a1, b1, false, false); \
        u32x4 w = {r0[0], r1[0], r0[1], r1[1]}; OUT = *reinterpret_cast<bf16x8*>(&w); } while (0)
    PK4(p0, 0, pa0); PK4(p0, 8, pa1); PK4(p1, 0, pa2); PK4(p1, 8, pa3);
#undef PK4
}
template <int KB>
__device__ __forceinline__ void qkt(f32x16& p0, f32x16& p1, const LAS char* K_lds, int r32, int hi, const bf16x8* qr) {
    const LAS char* kb[4];
#pragma unroll
    for (int dd = 0; dd < 4; ++dd) kb[dd] = K_lds + KB * SHM_K + KSWZ(r32, (dd * 16 + hi * 8) * 2);
#pragma unroll
    for (int d0 = 0; d0 < 8; ++d0) { const LAS char* a = kb[d0 & 3] + (d0 >> 2) * 128;
        const bf16x8 b0 = *reinterpret_cast<const LAS bf16x8*>(a);
        const bf16x8 b1 = *reinterpret_cast<const LAS bf16x8*>(a + 32 * 256);
        p0 = __builtin_amdgcn_mfma_f32_32x32x16_bf16(b0, qr[d0], p0, 0, 0, 0);
        p1 = __builtin_amdgcn_mfma_f32_32x32x16_bf16(b1, qr[d0], p1, 0, 0, 0); }
}
template <int VB>
__device__ __forceinline__ void pv_tile(f32x16* o, int vb0, bf16x8 pa0, bf16x8 pa1, bf16x8 pa2, bf16x8 pa3) {
#define TRRD(dst, off) asm volatile("ds_read_b64_tr_b16 %0, %1 offset:%2" : "=&v"(dst) : "v"(vb0), "i"(off) : "memory")
#define PV_D0(d0) do { s16x4 l0, l1, l2, l3, h0, h1, h2, h3; constexpr int b_ = VB * SHM_V + v_rd_off(d0, 0, 0); \
        TRRD(l0, b_); TRRD(h0, b_ + 2048); TRRD(l1, b_ + 4096); TRRD(h1, b_ + 6144); TRRD(l2, b_ + 8192); TRRD(h2, b_ + 10240); TRRD(l3, b_ + 12288); TRRD(h3, b_ + 14336); \
        asm volatile("s_waitcnt lgkmcnt(0)" ::: "memory"); SBAR();   \
        o[d0] = __builtin_amdgcn_mfma_f32_32x32x16_bf16(pa0, (bf16x8){l0[0], l0[1], l0[2], l0[3], h0[0], h0[1], h0[2], h0[3]}, o[d0], 0, 0, 0);   \
        o[d0] = __builtin_amdgcn_mfma_f32_32x32x16_bf16(pa1, (bf16x8){l1[0], l1[1], l1[2], l1[3], h1[0], h1[1], h1[2], h1[3]}, o[d0], 0, 0, 0);   \
        o[d0] = __builtin_amdgcn_mfma_f32_32x32x16_bf16(pa2, (bf16x8){l2[0], l2[1], l2[2], l2[3], h2[0], h2[1], h2[2], h2[3]}, o[d0], 0, 0, 0);   \
        o[d0] = __builtin_amdgcn_mfma_f32_32x32x16_bf16(pa3, (bf16x8){l3[0], l3[1], l3[2], l3[3], h3[0], h3[1], h3[2], h3[3]}, o[d0], 0, 0, 0); } while (0)
    PV_D0(0); PV_D0(1); PV_D0(2); PV_D0(3);
#undef PV_D0
#undef TRRD
}

template <int MODE, class MK>
__device__ __forceinline__ void flash_block(const bf16_t* Q, const bf16_t* K, const bf16_t* V, int krow0, int NT, int qrow0, float slopeL, const MK& mk,
                                            unsigned char* lds, bf16_t* Og, float* Lse, const bf16_t* Zg, int tid) {
    const int wid = __builtin_amdgcn_readfirstlane(tid >> 6), lane = tid & 63, r32 = lane & 31, hi = lane >> 5;
    const LAS char* K_lds = (const LAS char*)(LAS unsigned char*)lds + OFF_K;
    LAS char* Kw = (LAS char*)(LAS unsigned char*)lds + OFF_K; LAS char* Vw = (LAS char*)(LAS unsigned char*)lds + OFF_V;
    LAS float* wsf = (LAS float*)((LAS unsigned char*)lds + OFF_WS) + wid * 64; LAS float* li_l = wsf; LAS float* al_l = wsf + 32;
    const int sr = tid >> 4, sc = (tid & 15) * 8, vst0 = v_st(sr, sc), vst1 = v_st(32 + sr, sc), kws = KSWZ(sr, sc * 2);
    const int vb0 = (int)(unsigned)(uintptr_t)((LAS unsigned char*)lds) + OFF_V + v_rd_base(lane);
    const int qlo = qrow0 + wid * 32, qm = qlo + r32 - 4 * hi;
    bf16x8 st_k0, st_k1, st_v0, st_v1;
#define SLOAD(kb_) do { const size_t o0_ = (size_t)((kb_) + sr) * DM + sc, o1_ = o0_ + (size_t)32 * DM; \
        st_v0 = *(const bf16x8*)(V + o0_); st_v1 = *(const bf16x8*)(V + o1_); st_k0 = *(const bf16x8*)(K + o0_); st_k1 = *(const bf16x8*)(K + o1_); } while (0)
#define SWRITE(bf) do { *(LAS bf16x8*)(Vw + (bf) * SHM_V + vst0) = st_v0; *(LAS bf16x8*)(Vw + (bf) * SHM_V + vst1) = st_v1; \
        *(LAS bf16x8*)(Kw + (bf) * SHM_K + kws) = st_k0; *(LAS bf16x8*)(Kw + (bf) * SHM_K + kws + 32 * 256) = st_k1; } while (0)
    bf16x8 qr[8];
#pragma unroll
    for (int d0 = 0; d0 < 8; ++d0) qr[d0] = *(const bf16x8*)(Q + (size_t)(wid * 32 + r32) * DM + d0 * 16 + hi * 8);
    SLOAD(krow0); asm volatile("s_waitcnt vmcnt(0)" ::: "memory"); SWRITE(0);
    __syncthreads();
    float m_reg = -1e30f, l_reg = 0.f; f32x16 o[4] = {};
#define STEP(t, KB) do { const int kb_ = krow0 + (t) * KVBLK;                                                                   \
        if ((t) + 1 < NT) SLOAD(kb_ + KVBLK);                                                                                     \
        bool act_, need_; unsigned W_; mk.info(kb_, qlo, r32, act_, need_, W_);                                                 \
        if (act_) { f32x16 p0, p1; const float a0_ = slopeL * (float)(kb_ - qm);                                                  \
            _Pragma("unroll") for (int r = 0; r < 16; ++r) { p0[r] = fmaf(slopeL, (float)((r & 3) + 8 * (r >> 2)), a0_); p1[r] = p0[r] + 32.f * slopeL; } \
            qkt<KB>(p0, p1, K_lds, r32, hi, qr);                                                                                  \
            if (need_) mask_tile(p0, p1, qm - kb_, W_);                                                                           \
            float alpha_; partialSM(p0, p1, m_reg, alpha_);                                                                       \
            bf16x8 pa0, pa1, pa2, pa3; finishSM(p0, p1, alpha_, l_reg, pa0, pa1, pa2, pa3);                                       \
            if (__any(alpha_ < 1.f)) { if (hi == 0) al_l[r32] = alpha_; LDS_WAIT();                                               \
                _Pragma("unroll") for (int d_ = 0; d_ < 4; ++d_) _Pragma("unroll") for (int r = 0; r < 16; ++r) o[d_][r] *= al_l[crow(r, hi)]; } \
            SBAR(); pv_tile<KB>(o, vb0, pa0, pa1, pa2, pa3); }                                                                    \
        if ((t) + 1 < NT) { asm volatile("s_waitcnt vmcnt(0)" ::: "memory"); SWRITE((KB) ^ 1); }                               \
        __syncthreads(); } while (0)
    for (int t = 0; t < NT; t += 2) { STEP(t, 0); STEP(t + 1, 1); }
#undef STEP
#undef SLOAD
#undef SWRITE
    if (hi == 0) li_l[r32] = l_reg;
    LDS_WAIT();
    LAS unsigned char* stg = (LAS unsigned char*)lds + OFF_OST + wid * OST_WAVE;
#pragma unroll
    for (int r = 0; r < 16; ++r) { const int orow = crow(r, hi); const float rl = __builtin_amdgcn_rcpf(li_l[orow]);
#pragma unroll
        for (int d0 = 0; d0 < 4; ++d0) *(LAS unsigned short*)(stg + orow * OST_ROW + (d0 * 32 + r32) * 2) = (unsigned short)(cvt_pk_bf16(o[d0][r] * rl, 0.f) & 0xffffu); }
    LDS_WAIT();
    if (MODE == 0) { if (hi == 0) Lse[(size_t)(qlo + r32) * NH] = m_reg + log2f(l_reg); }
#pragma unroll
    for (int i = 0; i < 8; ++i) { const int row = i * 4 + (lane >> 4), ch = lane & 15;
        u32x4 v = *(const LAS u32x4*)(stg + row * OST_ROW + ch * 16);
        const size_t go = (size_t)(qlo + row) * DM + ch * 8;
        if (MODE == 1) { const u32x4 z = *(const u32x4*)(Zg + go);
            v.x = cvt_pk_bf16(bflo(v.x) * silu_f(bflo(z.x)), bfhi(v.x) * silu_f(bfhi(z.x))); v.y = cvt_pk_bf16(bflo(v.y) * silu_f(bflo(z.y)), bfhi(v.y) * silu_f(bfhi(z.y)));
            v.z = cvt_pk_bf16(bflo(v.z) * silu_f(bflo(z.z)), bfhi(v.z) * silu_f(bfhi(z.z))); v.w = cvt_pk_bf16(bflo(v.w) * silu_f(bflo(z.w)), bfhi(v.w) * silu_f(bfhi(z.w))); }
        *(u32x4*)(Og + go) = v; }
    LDS_WAIT();
}
struct MaskA {
    int L;
    __device__ __forceinline__ void info(int kb, int qlo, int r32, bool& act, bool& need, unsigned& W) const {
        const int seq0 = qlo & ~(L - 1); int lowk = qlo - 128; if (lowk < seq0) lowk = seq0;
        act = (kb <= qlo + 31) && (kb + KVBLK - 1 >= lowk); need = true;
        const int wl = qlo + r32 - seq0 + 1; W = (unsigned)(wl < 129 ? wl : 129);
    }
};
struct MaskB {
    int own0, base0; unsigned sel;
    __device__ __forceinline__ void info(int kb, int qlo, int r32, bool& act, bool& need, unsigned& W) const {
        if (kb >= own0) { act = kb <= qlo + 31; need = kb + KVBLK - 1 > qlo; W = 0x40000000u; }
        else { const int blk = (kb - base0) >> 8; const bool s = (sel >> blk) & 1u; const unsigned long long bal = __ballot(s);
            act = bal != 0ull; need = bal != ~0ull; W = s ? 0x40000000u : 0u; }
    }
};
#undef KSWZ
#undef SBAR
}

namespace fb {
using namespace fa;
#define KSWZ(row, colB) ((row) * 256 + ((colB) ^ (((row) & 7) << 4)))
#define SBAR() __builtin_amdgcn_sched_barrier(0)
struct Blk {
    unsigned qoff, koff, voff;
    unsigned ooff, xoff;
    int R0, kb0, NT;
    float slopeL;
    int L, base0;
};
struct Nxt { unsigned qoff, koff, voff; int kb0; };
struct Seam { bf16x8 qr[8]; bf16x8 st_v0, st_v1, st_k0, st_k1; };
__device__ __forceinline__ void tile_info(const Blk& c, int kb, int qlo, int r32, unsigned sel, bool& act, bool& need, unsigned& W) {
    if (c.L > 0) { const int seq0 = qlo & ~(c.L - 1); int lowk = qlo - 128; if (lowk < seq0) lowk = seq0;
        act = (kb <= qlo + 31) && (kb + KVBLK - 1 >= lowk); need = true; const int wl = qlo + r32 - seq0 + 1; W = (unsigned)(wl < 129 ? wl : 129); }
    else if (kb >= c.R0) { act = kb <= qlo + 31; need = kb + KVBLK - 1 > qlo; W = 0x40000000u; }
    else { const int blk = (kb - c.base0) >> 8; const bool sb = (sel >> blk) & 1u; const unsigned long long bal = __ballot(sb);
        act = bal != 0ull; need = bal != ~0ull; W = sb ? 0x40000000u : 0u; }
}
template <int KB>
__device__ __forceinline__ void qkt2(f32x16& p0, f32x16& p1, const LAS char* K_lds, int r32, int hi, const bf16x8* qr, bool act, float slopeL, float a0) {
    if (!act) { const float NEG = -__builtin_inff();
#pragma unroll
        for (int r = 0; r < 16; ++r) { p0[r] = NEG; p1[r] = NEG; } return; }
#pragma unroll
    for (int r = 0; r < 16; ++r) { p0[r] = fmaf(slopeL, (float)((r & 3) + 8 * (r >> 2)), a0); p1[r] = fmaf(slopeL, (float)((r & 3) + 8 * (r >> 2) + 32), a0); }
    qkt<KB>(p0, p1, K_lds, r32, hi, qr);
}
#define ROWP(off, k0, rr) (wsb + ((size_t)(off) + (size_t)(k0) * (DM * 2)) + (unsigned)(((rr) * DM + sc) * 2))
#define VMW() asm volatile("s_waitcnt vmcnt(0)" ::: "memory")
#define SLOAD_H(Kp, Vp, k0) do { S.st_v0 = *(const bf16x8*)ROWP(Vp, k0, sr); S.st_v1 = *(const bf16x8*)ROWP(Vp, k0, 32 + sr); \
                                 S.st_k0 = *(const bf16x8*)ROWP(Kp, k0, sr); S.st_k1 = *(const bf16x8*)ROWP(Kp, k0, 32 + sr); } while (0)
#define SWRITE_HK(bf) do { *(LAS bf16x8*)(Kw + (bf) * SHM_K + kws) = S.st_k0; *(LAS bf16x8*)(Kw + (bf) * SHM_K + kws + 32 * 256) = S.st_k1; } while (0)
#define SWRITE_HV(bf) do { *(LAS bf16x8*)(Vw + (bf) * SHM_V + vst0) = S.st_v0; *(LAS bf16x8*)(Vw + (bf) * SHM_V + vst1) = S.st_v1; } while (0)
#define SWRITE_H(bf) do { SWRITE_HV(bf); SWRITE_HK(bf); } while (0)
__device__ __forceinline__ void prime(const unsigned char* wsb, const Blk& cur, unsigned char* lds, Seam& S, int tid) {
    const int wid = __builtin_amdgcn_readfirstlane(tid >> 6), lane = tid & 63, r32 = lane & 31, hi = lane >> 5;
    const int sr = tid >> 4, sc = (tid & 15) * 8, kws = KSWZ(sr, sc * 2);
    LAS char* Kw = (LAS char*)(LAS unsigned char*)lds + OFF_K;
#pragma unroll
    for (int d0 = 0; d0 < 8; ++d0) S.qr[d0] = *(const bf16x8*)(wsb + (size_t)cur.qoff + (unsigned)(((wid * 32 + r32) * DM + d0 * 16 + hi * 8) * 2));
    SLOAD_H(cur.koff, cur.voff, cur.kb0); VMW(); SWRITE_HK(0);
    __syncthreads();
}
template <int MODE>
__device__ __forceinline__ void block(const unsigned char* wsb, const Blk& cur, const Nxt& nxt, unsigned sel, unsigned char* lds, Seam& S, int tid) {
    const int wid = __builtin_amdgcn_readfirstlane(tid >> 6), lane = tid & 63, r32 = lane & 31, hi = lane >> 5;
    const LAS char* K_lds = (const LAS char*)(LAS unsigned char*)lds + OFF_K;
    LAS char* Kw = (LAS char*)(LAS unsigned char*)lds + OFF_K; LAS char* Vw = (LAS char*)(LAS unsigned char*)lds + OFF_V;
    LAS float* wsf = (LAS float*)((LAS unsigned char*)lds + OFF_WS) + wid * 64; LAS float* li_l = wsf; LAS float* al_l = wsf + 32;
    const int sr = tid >> 4, sc = (tid & 15) * 8, vst0 = v_st(sr, sc), vst1 = v_st(32 + sr, sc), kws = KSWZ(sr, sc * 2);
    const int vb0 = (int)(unsigned)(uintptr_t)((LAS unsigned char*)lds) + OFF_V + v_rd_base(lane);
    const int NT = cur.NT, qlo = cur.R0 + wid * 32, qm = qlo + r32 - 4 * hi;
    const float slopeL = cur.slopeL;
    const unsigned Kh = cur.koff, Vh = cur.voff;
    float m_reg = -1e30f, l_reg = 0.f; f32x16 o[4] = {};
#define KBASE(t) (cur.kb0 + (t) * KVBLK)
#define RESC(a) do { if (__any((a) < 1.f)) { if (hi == 0) al_l[r32] = (a); LDS_WAIT(); \
        _Pragma("unroll") for (int d_ = 0; d_ < 4; ++d_) _Pragma("unroll") for (int r = 0; r < 16; ++r) o[d_][r] *= al_l[crow(r, hi)]; } } while (0)
#define QKT(PX0, PX1, t, KB, ACTV) do { const int kb_ = KBASE(t); bool nd_; unsigned W_; tile_info(cur, kb_, qlo, r32, sel, ACTV, nd_, W_); \
        qkt2<KB>(PX0, PX1, K_lds, r32, hi, S.qr, ACTV, slopeL, slopeL * (float)(kb_ - qm)); } while (0)
#define MASKT(PX0, PX1, t) do { const int kb_ = KBASE(t); bool ac_, nd_; unsigned W_; tile_info(cur, kb_, qlo, r32, sel, ac_, nd_, W_); \
        if (ac_ && nd_) mask_tile(PX0, PX1, qm - kb_, W_); } while (0)
    f32x16 pA0, pA1, pB0, pB1; float alA, alB; bf16x8 pa0, pa1, pa2, pa3; bool actA, actB;
    SWRITE_HV(0); SBAR();
    SLOAD_H(Kh, Vh, KBASE(1));
    SBAR(); QKT(pA0, pA1, 0, 0, actA);
    MASKT(pA0, pA1, 0); partialSM(pA0, pA1, m_reg, alA);
    VMW(); SWRITE_H(1);
    __syncthreads();
#define HALF_STEP(PX0, PX1, alX, actX, PY0, PY1, alY, actY, t, KB, VB, SB) do {                                                 \
        SBAR(); QKT(PX0, PX1, t, KB, actX);                                                                                   \
        finishSM(PY0, PY1, alY, l_reg, pa0, pa1, pa2, pa3); SBAR();                                                           \
        if ((t) + 1 < NT) { SLOAD_H(Kh, Vh, KBASE((t) + 1)); SBAR(); }                                                        \
        if (actY) pv_tile<VB>(o, vb0, pa0, pa1, pa2, pa3);                                                                    \
        MASKT(PX0, PX1, (t)); partialSM(PX0, PX1, m_reg, alX);                                                                \
        __syncthreads();                                                                                                      \
        if ((t) + 1 < NT) { VMW(); SWRITE_H(SB); }                                                                            \
        RESC(alX); __syncthreads(); } while (0)
    for (int t = 1; t + 1 < NT; t += 2) {
        HALF_STEP(pB0, pB1, alB, actB, pA0, pA1, alA, actA, t, 1, 0, 0);
        HALF_STEP(pA0, pA1, alA, actA, pB0, pB1, alB, actB, t + 1, 0, 1, 1);
    }
    SBAR(); QKT(pB0, pB1, NT - 1, 1, actB); SBAR();
    SLOAD_H(nxt.koff, nxt.voff, nxt.kb0); SBAR();
#pragma unroll
    for (int d0 = 0; d0 < 8; ++d0) S.qr[d0] = *(const bf16x8*)(wsb + (size_t)nxt.qoff + (unsigned)(((wid * 32 + r32) * DM + d0 * 16 + hi * 8) * 2));
    SBAR();
    finishSM(pA0, pA1, alA, l_reg, pa0, pa1, pa2, pa3); SBAR();
    if (actA) pv_tile<0>(o, vb0, pa0, pa1, pa2, pa3);
    MASKT(pB0, pB1, NT - 1); partialSM(pB0, pB1, m_reg, alB); __syncthreads(); RESC(alB);
    finishSM(pB0, pB1, alB, l_reg, pa0, pa1, pa2, pa3); SBAR();
    if (actB) pv_tile<1>(o, vb0, pa0, pa1, pa2, pa3);
    SBAR(); asm volatile("s_waitcnt vmcnt(8)" ::: "memory"); SWRITE_HK(0); SBAR();
    int tid2 = tid; asm volatile("" : "+v"(tid2));
    const int lane2 = tid2 & 63, r32e = lane2 & 31, hie = lane2 >> 5;
    if (hie == 0) li_l[r32e] = l_reg;
    LDS_WAIT();
    LAS unsigned char* stg = (LAS unsigned char*)lds + OFF_OST + wid * OST_WAVE;
#pragma unroll
    for (int r = 0; r < 16; ++r) { const int orow = crow(r, hie); const float rl = __builtin_amdgcn_rcpf(li_l[orow]);
#pragma unroll
        for (int d0 = 0; d0 < 4; ++d0) *(LAS unsigned short*)(stg + orow * OST_ROW + (d0 * 32 + r32e) * 2) = (unsigned short)(cvt_pk_bf16(o[d0][r] * rl, 0.f) & 0xffffu); }
    LDS_WAIT();
    if (MODE == 0) { if (hie == 0) *(float*)(const_cast<unsigned char*>(wsb) + (size_t)cur.xoff + (unsigned)((qlo + r32e) * NH * 4)) = m_reg + log2f(l_reg); }
#pragma unroll
    for (int i = 0; i < 8; ++i) { const int row = i * 4 + (lane2 >> 4), ch = lane2 & 15;
        u32x4 v = *(const LAS u32x4*)(stg + row * OST_ROW + ch * 16);
        const unsigned go = (unsigned)(((qlo + row) * DM + ch * 8) * 2);
        if (MODE == 1) { const u32x4 z = *(const u32x4*)(wsb + (size_t)cur.xoff + go);
            v.x = cvt_pk_bf16(bflo(v.x) * silu_f(bflo(z.x)), bfhi(v.x) * silu_f(bfhi(z.x))); v.y = cvt_pk_bf16(bflo(v.y) * silu_f(bflo(z.y)), bfhi(v.y) * silu_f(bfhi(z.y)));
            v.z = cvt_pk_bf16(bflo(v.z) * silu_f(bflo(z.z)), bfhi(v.z) * silu_f(bfhi(z.z))); v.w = cvt_pk_bf16(bflo(v.w) * silu_f(bflo(z.w)), bfhi(v.w) * silu_f(bfhi(z.w))); }
        *(u32x4*)(const_cast<unsigned char*>(wsb) + (size_t)cur.ooff + go) = v; }
    __syncthreads();
#undef KBASE
#undef RESC
#undef QKT
#undef MASKT
#undef HALF_STEP
}
#undef ROWP
#undef VMW
#undef SLOAD_H
#undef SWRITE_HK
#undef SWRITE_HV
#undef SWRITE_H
#undef KSWZ
#undef SBAR
}

namespace fc {
using namespace fa;
constexpr int NSLOT = 3;
constexpr int R_K = 0, R_V = NSLOT * SHM_K, R_WS = R_V + NSLOT * SHM_V, WSW = 96, R_OST = R_WS + 8 * WSW * 4, OSTR = 144, OSTW = 32 * OSTR;
constexpr int R_GK = R_OST + 8 * OSTW, R_SEL = R_GK + 2 * 7 * 128 * 4, R_END = R_SEL + 256 * 4;
static_assert(R_END <= LDS_BYTES - 64, "attention LDS map");
#define KSWZ(row, colB) ((row) * 256 + ((colB) ^ (((row) & 7) << 4)))
#define SBAR() __builtin_amdgcn_sched_barrier(0)
struct Blk {
    unsigned qoff, koff, voff, ooff, xoff;
    unsigned zoff, goff;
    int R0, kb0, NT;
    float slopeL;
    int L, base0;
};
struct Nxt { unsigned qoff, koff, voff; int kb0; };
__device__ __forceinline__ void glds16(const void* sbase, unsigned voff, unsigned lds_dst) { unsigned keep;
    asm volatile("s_mov_b32 %0, m0\n\ts_mov_b32 m0, %3\n\ts_nop 0\n\tglobal_load_lds_dwordx4 %1, %2\n\ts_mov_b32 m0, %0" : "=&s"(keep) : "v"(voff), "s"(sbase), "s"(lds_dst) : "memory"); }
__device__ __forceinline__ void qkt_r(f32x16& p0, f32x16& p1, const LAS char* Kslot, int r32, int hi, const bf16x8* qr) {
    const LAS char* kb[4];
#pragma unroll
    for (int dd = 0; dd < 4; ++dd) kb[dd] = Kslot + KSWZ(r32, (dd * 16 + hi * 8) * 2);
    bf16x8 c0 = *reinterpret_cast<const LAS bf16x8*>(kb[0]), c1 = *reinterpret_cast<const LAS bf16x8*>(kb[0] + 32 * 256);
#pragma unroll
    for (int d0 = 0; d0 < 8; ++d0) {
        bf16x8 n0 = c0, n1 = c1;
        if (d0 < 7) { const LAS char* a = kb[(d0 + 1) & 3] + ((d0 + 1) >> 2) * 128; n0 = *reinterpret_cast<const LAS bf16x8*>(a); n1 = *reinterpret_cast<const LAS bf16x8*>(a + 32 * 256); }
        p0 = __builtin_amdgcn_mfma_f32_32x32x16_bf16(c0, qr[d0], p0, 0, 0, 0);
        p1 = __builtin_amdgcn_mfma_f32_32x32x16_bf16(c1, qr[d0], p1, 0, 0, 0);
        c0 = n0; c1 = n1; }
}
__device__ __forceinline__ void pv_r(f32x16* o, int vb, bf16x8 pa0, bf16x8 pa1, bf16x8 pa2, bf16x8 pa3) {
#define TRRD(dst, off) asm volatile("ds_read_b64_tr_b16 %0, %1 offset:%2" : "=&v"(dst) : "v"(vb), "i"(off) : "memory")
#define PV_D0(d0) do { s16x4 l0, l1, l2, l3, h0, h1, h2, h3; constexpr int b_ = v_rd_off(d0, 0, 0); \
        TRRD(l0, b_); TRRD(h0, b_ + 2048); TRRD(l1, b_ + 4096); TRRD(h1, b_ + 6144); TRRD(l2, b_ + 8192); TRRD(h2, b_ + 10240); TRRD(l3, b_ + 12288); TRRD(h3, b_ + 14336); \
        asm volatile("s_waitcnt lgkmcnt(0)" ::: "memory"); SBAR();   \
        o[d0] = __builtin_amdgcn_mfma_f32_32x32x16_bf16(pa0, (bf16x8){l0[0], l0[1], l0[2], l0[3], h0[0], h0[1], h0[2], h0[3]}, o[d0], 0, 0, 0);   \
        o[d0] = __builtin_amdgcn_mfma_f32_32x32x16_bf16(pa1, (bf16x8){l1[0], l1[1], l1[2], l1[3], h1[0], h1[1], h1[2], h1[3]}, o[d0], 0, 0, 0);   \
        o[d0] = __builtin_amdgcn_mfma_f32_32x32x16_bf16(pa2, (bf16x8){l2[0], l2[1], l2[2], l2[3], h2[0], h2[1], h2[2], h2[3]}, o[d0], 0, 0, 0);   \
        o[d0] = __builtin_amdgcn_mfma_f32_32x32x16_bf16(pa3, (bf16x8){l3[0], l3[1], l3[2], l3[3], h3[0], h3[1], h3[2], h3[3]}, o[d0], 0, 0, 0); } while (0)
    PV_D0(0); PV_D0(1); PV_D0(2); PV_D0(3);
#undef PV_D0
#undef TRRD
}
__device__ __forceinline__ void tile_info(const Blk& c, int kb, int qlo, int r32, unsigned sel, bool& act, bool& need, unsigned& W, bool& dead) {
    dead = false;
    if (c.L > 0) { const int seq0 = qlo & ~(c.L - 1); int lowk = qlo - 128; if (lowk < seq0) lowk = seq0;
        act = (kb <= qlo + 31) && (kb + KVBLK - 1 >= lowk); need = true; const int wl = qlo + r32 - seq0 + 1; W = (unsigned)(wl < 129 ? wl : 129); }
    else if (kb >= c.R0) { act = kb <= qlo + 31; need = kb + KVBLK - 1 > qlo; W = 0x40000000u; }
    else { const int blk = (kb - c.base0) >> 8; const bool sb = (sel >> blk) & 1u; act = __ballot(sb) != 0ull; need = false; W = 0x40000000u; dead = !sb; }
}
struct Ring { int kt; };
__device__ __forceinline__ int nx3(int s) { return s == 2 ? 0 : s + 1; }
struct DmaLane { unsigned vk0, vk1, vv0, vv1; };
__device__ __forceinline__ DmaLane dma_lane(int wid, int lane) {
    DmaLane d;
    { const int row0 = wid * 8 + (lane >> 4), row1 = row0 + 4, cs = lane & 15;
      d.vk0 = (unsigned)(row0 * DM * 2 + ((cs ^ (row0 & 7)) * 16)); d.vk1 = (unsigned)(row1 * DM * 2 + ((cs ^ (row1 & 7)) * 16)); }
    { const int gi = lane & 31, kk = wid * 8 + (gi >> 2), k = (kk & ~0xC) | ((kk & 4) << 1) | ((kk & 8) >> 1);
      const int c0 = ((lane >> 5)) * 32 + (gi & 3) * 8, c1 = c0 + 64;
      d.vv0 = (unsigned)(k * DM * 2 + c0 * 2); d.vv1 = (unsigned)(k * DM * 2 + c1 * 2); }
    return d;
}
#define DMA_K(srcoff, kbrow, slot) do { const unsigned char* sb_ = wsb + ((size_t)(srcoff) + (size_t)(kbrow) * (DM * 2)); const unsigned ld_ = ldsb + R_K + (slot) * SHM_K + wid * 2048; \
        glds16(sb_, dl.vk0, ld_); glds16(sb_, dl.vk1, ld_ + 1024); } while (0)
#define DMA_V(srcoff, kbrow, slot) do { const unsigned char* sb_ = wsb + ((size_t)(srcoff) + (size_t)(kbrow) * (DM * 2)); const unsigned ld_ = ldsb + R_V + (slot) * SHM_V + wid * 2048; \
        glds16(sb_, dl.vv0, ld_); glds16(sb_, dl.vv1, ld_ + 1024); } while (0)
#define WAITBAR(N) asm volatile("s_waitcnt vmcnt(" #N ") lgkmcnt(0)\n\ts_barrier" ::: "memory")
__device__ __forceinline__ void prime(const unsigned char* wsb, const Blk& cur, unsigned char* lds, bf16x8* qr, Ring& rg, int tid) {
    const int wid = __builtin_amdgcn_readfirstlane(tid >> 6), lane = tid & 63, r32 = lane & 31, hi = lane >> 5;
    const unsigned ldsb = (unsigned)(uintptr_t)((LAS unsigned char*)lds);
    const DmaLane dl = dma_lane(wid, lane);
    DMA_K(cur.koff, cur.kb0, 0); DMA_V(cur.voff, cur.kb0, 0); DMA_K(cur.koff, cur.kb0 + KVBLK, 1);
#pragma unroll
    for (int d0 = 0; d0 < 8; ++d0) qr[d0] = *(const bf16x8*)(wsb + (size_t)cur.qoff + (unsigned)(((wid * 32 + r32) * DM + d0 * 16 + hi * 8) * 2));
    rg.kt = 0;
    WAITBAR(0);
}
template <int MODE>
__device__ __forceinline__ void block(const unsigned char* wsb, const Blk& cur, const Nxt& nxt, bool has_next, unsigned sel, unsigned char* lds, bf16x8* qr, Ring& rg, int tid) {
    const int wid = __builtin_amdgcn_readfirstlane(tid >> 6), lane = tid & 63, r32 = lane & 31, hi = lane >> 5;
    const unsigned ldsb = (unsigned)(uintptr_t)((LAS unsigned char*)lds);
    const LAS char* K_lds = (const LAS char*)(LAS unsigned char*)lds + R_K;
    LAS float* wsf = (LAS float*)((LAS unsigned char*)lds + R_WS) + wid * WSW; LAS float* li_l = wsf; LAS float* al_l = wsf + 32;
    const int vbl = (int)ldsb + R_V + v_rd_base(lane);
    const DmaLane dl = dma_lane(wid, lane);
    const int NT = cur.NT, qlo = cur.R0 + wid * 32, qm = qlo + r32 - 4 * hi;
    const float slopeL = cur.slopeL;
    float m_reg = -1e30f, l_reg = 0.f; f32x16 o[4] = {};
    int kt = rg.kt;
#define RESC(a) do { if (__any((a) < 1.f)) { if (hi == 0) al_l[r32] = (a); LDS_WAIT(); \
        _Pragma("unroll") for (int d_ = 0; d_ < 4; ++d_) _Pragma("unroll") for (int r = 0; r < 16; ++r) o[d_][r] *= al_l[crow(r, hi)]; } } while (0)
#define STEPX(PX0, PX1, alX, actX, PY0, PY1, alY, actY, t, HAVEY) do {                                                                \
        const int kb_ = cur.kb0 + (t) * KVBLK; bool nd_, dd_; unsigned W_; tile_info(cur, kb_, qlo, r32, sel, actX, nd_, W_, dd_);   \
        SBAR();                                                                                                                       \
        if (actX) { const float a0_ = dd_ ? -__builtin_inff() : slopeL * (float)(kb_ - qm);                                           \
            _Pragma("unroll") for (int r = 0; r < 16; ++r) { PX0[r] = fmaf(slopeL, (float)((r & 3) + 8 * (r >> 2)), a0_); PX1[r] = fmaf(slopeL, (float)((r & 3) + 8 * (r >> 2) + 32), a0_); } \
            qkt_r(PX0, PX1, K_lds + kt * SHM_K, r32, hi, qr);                                                                         \
            if (HAVEY) finishSM(PY0, PY1, alY, l_reg, pa0, pa1, pa2, pa3); }                                                          \
        else { _Pragma("unroll") for (int r = 0; r < 16; ++r) { PX0[r] = -__builtin_inff(); PX1[r] = -__builtin_inff(); }             \
            if (HAVEY) finishSM(PY0, PY1, alY, l_reg, pa0, pa1, pa2, pa3); }                                                          \
        SBAR();                                                                                                                       \
        { const int s2_ = kt == 0 ? 2 : kt - 1, s1_ = nx3(kt);                           \
          const bool in2_ = (t) + 2 < NT, in1_ = (t) + 1 < NT;                                                                        \
          if (in2_) DMA_K(cur.koff, kb_ + 2 * KVBLK, s2_); else if (has_next) DMA_K(nxt.koff, nxt.kb0 + ((t) + 2 - NT) * KVBLK, s2_);        \
          if (in1_) DMA_V(cur.voff, kb_ + KVBLK, s1_); else if (has_next) DMA_V(nxt.voff, nxt.kb0 + ((t) + 1 - NT) * KVBLK, s1_); }         \
        SBAR();                                                                                                                       \
        if (HAVEY) { if (actY) pv_r(o, vbl + (kt == 0 ? 2 : kt - 1) * SHM_V, pa0, pa1, pa2, pa3); }                                   \
        if (actX && nd_) mask_tile(PX0, PX1, qm - kb_, W_);                                                                           \
        partialSM(PX0, PX1, m_reg, alX);                                                                                              \
        RESC(alX);                                                                                                                    \
        if ((t) + 2 < NT || has_next) WAITBAR(4); else if ((t) + 1 < NT) WAITBAR(2); else WAITBAR(0);                                 \
        kt = nx3(kt); } while (0)
    f32x16 pA0, pA1, pB0, pB1; float alA = 1.f, alB = 1.f; bf16x8 pa0, pa1, pa2, pa3; bool actA = false, actB = false;
    STEPX(pA0, pA1, alA, actA, pB0, pB1, alB, actB, 0, false);
    STEPX(pB0, pB1, alB, actB, pA0, pA1, alA, actA, 1, true);
    for (int t = 2; t < NT; t += 2) {
        STEPX(pA0, pA1, alA, actA, pB0, pB1, alB, actB, t, true);
        STEPX(pB0, pB1, alB, actB, pA0, pA1, alA, actA, t + 1, true);
    }
    finishSM(pB0, pB1, alB, l_reg, pa0, pa1, pa2, pa3); SBAR();
    if (actB) pv_r(o, vbl + (kt == 0 ? 2 : kt - 1) * SHM_V, pa0, pa1, pa2, pa3);
    SBAR();
    if (has_next) {
#pragma unroll
        for (int d0 = 0; d0 < 8; ++d0) qr[d0] = *(const bf16x8*)(wsb + (size_t)nxt.qoff + (unsigned)(((wid * 32 + r32) * DM + d0 * 16 + hi * 8) * 2));
    }
    SBAR();
    rg.kt = kt;
    int tid2 = tid; asm volatile("" : "+v"(tid2));
    const int lane2 = tid2 & 63, r32e = lane2 & 31, hie = lane2 >> 5;
    unsigned char* wsw = const_cast<unsigned char*>(wsb);
    if (MODE == 2) {
        if (hie == 0) { const int R = qlo + r32e, bb = R >> 11, t = ((R & 127) << 4) | ((R >> 7) & 15), T0 = (bb << 11) + t, T1 = (bb << 11) + ((t & 3) << 9) + (t >> 2);
            const float l2 = m_reg + log2f(l_reg);
            const float l0 = *(const float*)(wsb + (size_t)cur.xoff + (unsigned)(T0 * NH * 4)), l1 = *(const float*)(wsb + (size_t)cur.xoff + (size_t)MTOK * NH * 4 + (unsigned)(T1 * NH * 4));
            const float mx = fmaxf(l0, fmaxf(l1, l2)); const float e0 = exp2f(l0 - mx), e1 = exp2f(l1 - mx), e2 = exp2f(l2 - mx), inv = 1.f / (e0 + e1 + e2);
            li_l[r32e] = e2 * inv / l_reg; al_l[r32e] = e0 * inv; al_l[32 + r32e] = e1 * inv; }
    } else { if (hie == 0) li_l[r32e] = 1.f / l_reg; }
    LDS_WAIT();
    if (MODE == 0) { if (hie == 0) *(float*)(wsw + (size_t)cur.xoff + (unsigned)((qlo + r32e) * NH * 4)) = m_reg + log2f(l_reg); }
    LAS unsigned char* stg = (LAS unsigned char*)lds + R_OST + wid * OSTW;
    float rl[16];
#pragma unroll
    for (int r = 0; r < 16; ++r) rl[r] = li_l[crow(r, hie)];
    u32x4 pg0[4], pg1[4], pzz[4]; unsigned tof[4];
#define PREF(hf_) do { _Pragma("unroll") for (int i = 0; i < 4; ++i) { const int row = i * 8 + (lane2 >> 3), ch = lane2 & 7; const unsigned cb = (unsigned)(((hf_) * 64 + ch * 8) * 2); \
            const int R = qlo + row, bb = R >> 11, t = ((R & 127) << 4) | ((R >> 7) & 15), T0 = (bb << 11) + t, T1 = (bb << 11) + ((t & 3) << 9) + (t >> 2);                    \
            tof[i] = (unsigned)(T0 * DM * 2);                                                                                                                                   \
            pg0[i] = *(const u32x4*)(wsb + (size_t)cur.ooff + tof[i] + cb); pg1[i] = *(const u32x4*)(wsb + (size_t)cur.ooff + (size_t)PART * 2 + (unsigned)(T1 * DM * 2) + cb); \
            pzz[i] = *(const u32x4*)(wsb + (size_t)cur.zoff + tof[i] + cb); } } while (0)
    if (MODE == 2) PREF(0);
#pragma unroll
    for (int hf = 0; hf < 2; ++hf) {
#pragma unroll
        for (int r = 0; r < 16; ++r) { const int orow = crow(r, hie);
#pragma unroll
            for (int dd = 0; dd < 2; ++dd) *(LAS unsigned short*)(stg + orow * OSTR + (dd * 32 + r32e) * 2) = (unsigned short)(cvt_pk_bf16(o[2 * hf + dd][r] * rl[r], 0.f) & 0xffffu); }
        LDS_WAIT();
        if (MODE == 2) {
            u32x4 vv[4];
#pragma unroll
            for (int i = 0; i < 4; ++i) { const int row = i * 8 + (lane2 >> 3), ch = lane2 & 7;
                u32x4 v = *(const LAS u32x4*)(stg + row * OSTR + ch * 16);
                const float a0 = al_l[row], a1 = al_l[32 + row]; const u32x4 g0 = pg0[i], g1 = pg1[i], z = pzz[i];
#define MRG(F) v.F = cvt_pk_bf16((bflo(v.F) + a0 * bflo(g0.F) + a1 * bflo(g1.F)) * silu_f(bflo(z.F)), (bfhi(v.F) + a0 * bfhi(g0.F) + a1 * bfhi(g1.F)) * silu_f(bfhi(z.F)));
                MRG(x) MRG(y) MRG(z) MRG(w)
#undef MRG
                vv[i] = v; }
            unsigned tsv[4];
#pragma unroll
            for (int i = 0; i < 4; ++i) tsv[i] = tof[i];
            if (hf == 0) PREF(1);
#pragma unroll
            for (int i = 0; i < 4; ++i) { const int ch = lane2 & 7; store_wt(wsw + (size_t)cur.goff + tsv[i] + (unsigned)((hf * 64 + ch * 8) * 2), vv[i]); }
        } else {
#pragma unroll
            for (int i = 0; i < 4; ++i) { const int row = i * 8 + (lane2 >> 3), ch = lane2 & 7;
                u32x4 v = *(const LAS u32x4*)(stg + row * OSTR + ch * 16);
                const unsigned go = (unsigned)((qlo + row) * DM * 2) + (unsigned)((hf * 64 + ch * 8) * 2);
                if (MODE == 1) { const u32x4 z = *(const u32x4*)(wsb + (size_t)cur.xoff + go);
                    v.x = cvt_pk_bf16(bflo(v.x) * silu_f(bflo(z.x)), bfhi(v.x) * silu_f(bfhi(z.x))); v.y = cvt_pk_bf16(bflo(v.y) * silu_f(bflo(z.y)), bfhi(v.y) * silu_f(bfhi(z.y)));
                    v.z = cvt_pk_bf16(bflo(v.z) * silu_f(bflo(z.z)), bfhi(v.z) * silu_f(bfhi(z.z))); v.w = cvt_pk_bf16(bflo(v.w) * silu_f(bflo(z.w)), bfhi(v.w) * silu_f(bfhi(z.w))); }
                store_wt(wsw + (size_t)cur.ooff + go, v); } }
        LDS_WAIT();
    }
#undef PREF
#undef RESC
#undef STEPX
}
#undef DMA_K
#undef DMA_V
#undef WAITBAR
#undef KSWZ
#undef SBAR
}

namespace fd {
using namespace fa;
using fc::Blk; using fc::Nxt; using fc::Ring; using fc::DmaLane; using fc::dma_lane; using fc::glds16; using fc::qkt_r; using fc::pv_r; using fc::tile_info; using fc::nx3;
using fc::R_K; using fc::R_V; using fc::R_WS; using fc::R_OST; using fc::OSTR; using fc::OSTW;
#define SBAR() __builtin_amdgcn_sched_barrier(0)
#define DMA_K(srcoff, kbrow, slot) do { const unsigned char* sb_ = wsb + ((size_t)(srcoff) + (size_t)(kbrow) * (DM * 2)); const unsigned ld_ = ldsb + R_K + (slot) * SHM_K + wid * 2048; \
        glds16(sb_, dl.vk0, ld_); glds16(sb_, dl.vk1, ld_ + 1024); } while (0)
#define DMA_V(srcoff, kbrow, slot) do { const unsigned char* sb_ = wsb + ((size_t)(srcoff) + (size_t)(kbrow) * (DM * 2)); const unsigned ld_ = ldsb + R_V + (slot) * SHM_V + wid * 2048; \
        glds16(sb_, dl.vv0, ld_); glds16(sb_, dl.vv1, ld_ + 1024); } while (0)
#define WAITBAR(N) asm volatile("s_waitcnt vmcnt(" #N ") lgkmcnt(0)\n\ts_barrier" ::: "memory")
__device__ __forceinline__ void softmax_tile(f32x16& p0, f32x16& p1, float& m_reg, float& l_reg, float& alpha, bf16x8& pa0, bf16x8& pa1, bf16x8& pa2, bf16x8& pa3) {
    partialSM(p0, p1, m_reg, alpha);
    finishSM(p0, p1, alpha, l_reg, pa0, pa1, pa2, pa3);
}
__device__ __forceinline__ void prime(const unsigned char* wsb, const Blk& cur, unsigned char* lds, bf16x8* qr, Ring& rg, int tid) {
    const int wid = __builtin_amdgcn_readfirstlane(tid >> 6), lane = tid & 63, r32 = lane & 31, hi = lane >> 5;
    const unsigned ldsb = (unsigned)(uintptr_t)((LAS unsigned char*)lds);
    const DmaLane dl = dma_lane(wid, lane);
    DMA_K(cur.koff, cur.kb0, 0); DMA_V(cur.voff, cur.kb0, 0); DMA_K(cur.koff, cur.kb0 + KVBLK, 1);
#pragma unroll
    for (int d0 = 0; d0 < 8; ++d0) qr[d0] = *(const bf16x8*)(wsb + (size_t)cur.qoff + (unsigned)(((wid * 32 + r32) * DM + d0 * 16 + hi * 8) * 2));
    rg.kt = 0;
    WAITBAR(0);
    if (wid >= 4) WAITBAR(0);
}
__device__ __forceinline__ void finish(int tid) {
    const int wid = __builtin_amdgcn_readfirstlane(tid >> 6);
    if (wid < 4) WAITBAR(0);
}
template <int MODE>
__device__ __forceinline__ void block(const unsigned char* wsb, const Blk& cur, const Nxt& nxt, bool has_next, unsigned sel, unsigned char* lds, bf16x8* qr, Ring& rg, int tid) {
    const int wid = __builtin_amdgcn_readfirstlane(tid >> 6), lane = tid & 63, r32 = lane & 31, hi = lane >> 5;
    const unsigned ldsb = (unsigned)(uintptr_t)((LAS unsigned char*)lds);
    const LAS char* K_lds = (const LAS char*)(LAS unsigned char*)lds + R_K;
    LAS float* wsf = (LAS float*)((LAS unsigned char*)lds + R_WS) + wid * fc::WSW; LAS float* li_l = wsf; LAS float* al_l = wsf + 32;
    const int vbl = (int)ldsb + R_V + v_rd_base(lane);
    const DmaLane dl = dma_lane(wid, lane);
    const int NT = cur.NT, qlo = cur.R0 + wid * 32, qm = qlo + r32 - 4 * hi;
    const float slopeL = cur.slopeL;
    float m_reg = -1e30f, l_reg = 0.f; f32x16 o[4] = {};
    int kt = rg.kt;
    f32x16 p0, p1; bf16x8 pa0, pa1, pa2, pa3; bool actP = false;
    for (int t = 0; t < NT; ++t) {
        const int kb_ = cur.kb0 + t * KVBLK; bool act, nd_, dd_; unsigned W_; tile_info(cur, kb_, qlo, r32, sel, act, nd_, W_, dd_);
        { const int s2_ = kt == 0 ? 2 : kt - 1, s1_ = nx3(kt);
          const bool in2_ = t + 2 < NT, in1_ = t + 1 < NT;
          if (in2_) DMA_K(cur.koff, kb_ + 2 * KVBLK, s2_); else if (has_next) DMA_K(nxt.koff, nxt.kb0 + (t + 2 - NT) * KVBLK, s2_);
          if (in1_) DMA_V(cur.voff, kb_ + KVBLK, s1_); else if (has_next) DMA_V(nxt.voff, nxt.kb0 + (t + 1 - NT) * KVBLK, s1_); }
        SBAR();
        if (act) { const float a0_ = dd_ ? -__builtin_inff() : slopeL * (float)(kb_ - qm);
#pragma unroll
            for (int r = 0; r < 16; ++r) { p0[r] = fmaf(slopeL, (float)((r & 3) + 8 * (r >> 2)), a0_); p1[r] = fmaf(slopeL, (float)((r & 3) + 8 * (r >> 2) + 32), a0_); }
            qkt_r(p0, p1, K_lds + kt * SHM_K, r32, hi, qr); }
        if (actP) pv_r(o, vbl + (kt == 0 ? 2 : kt - 1) * SHM_V, pa0, pa1, pa2, pa3);
        SBAR();
        if (t + 2 < NT || has_next) WAITBAR(4); else WAITBAR(0);
        if (act) { float alpha;
            if (nd_) mask_tile(p0, p1, qm - kb_, W_);
            softmax_tile(p0, p1, m_reg, l_reg, alpha, pa0, pa1, pa2, pa3);
            if (__any(alpha < 1.f)) { if (hi == 0) al_l[r32] = alpha; LDS_WAIT();
#pragma unroll
                for (int d_ = 0; d_ < 4; ++d_)
#pragma unroll
                    for (int r = 0; r < 16; ++r) o[d_][r] *= al_l[crow(r, hi)]; } }
        actP = act;
        SBAR();
        if (t + 2 < NT || has_next) WAITBAR(4); else WAITBAR(0);
        kt = nx3(kt);
    }
    if (actP) pv_r(o, vbl + (kt == 0 ? 2 : kt - 1) * SHM_V, pa0, pa1, pa2, pa3);
    SBAR();
    if (has_next) {
#pragma unroll
        for (int d0 = 0; d0 < 8; ++d0) qr[d0] = *(const bf16x8*)(wsb + (size_t)nxt.qoff + (unsigned)(((wid * 32 + r32) * DM + d0 * 16 + hi * 8) * 2));
    }
    SBAR();
    rg.kt = kt;
    if (has_next) WAITBAR(4); else WAITBAR(0);
    int tid2 = tid; asm volatile("" : "+v"(tid2));
    const int lane2 = tid2 & 63, r32e = lane2 & 31, hie = lane2 >> 5;
    if (hie == 0) li_l[r32e] = l_reg;
    LDS_WAIT();
    if (MODE == 0) { if (hie == 0) *(float*)(const_cast<unsigned char*>(wsb) + (size_t)cur.xoff + (unsigned)((qlo + r32e) * NH * 4)) = m_reg + log2f(l_reg); }
    LAS unsigned char* stg = (LAS unsigned char*)lds + R_OST + wid * OSTW;
    float rl[16];
#pragma unroll
    for (int r = 0; r < 16; ++r) rl[r] = __builtin_amdgcn_rcpf(li_l[crow(r, hie)]);
#pragma unroll
    for (int hf = 0; hf < 2; ++hf) {
#pragma unroll
        for (int r = 0; r < 16; ++r) { const int orow = crow(r, hie);
#pragma unroll
            for (int dd = 0; dd < 2; ++dd) *(LAS unsigned short*)(stg + orow * OSTR + (dd * 32 + r32e) * 2) = (unsigned short)(cvt_pk_bf16(o[2 * hf + dd][r] * rl[r], 0.f) & 0xffffu); }
        LDS_WAIT();
#pragma unroll
        for (int i = 0; i < 4; ++i) { const int row = i * 8 + (lane2 >> 3), ch = lane2 & 7;
            u32x4 v = *(const LAS u32x4*)(stg + row * OSTR + ch * 16);
            const unsigned go = (unsigned)(((qlo + row) * DM + hf * 64 + ch * 8) * 2);
            if (MODE == 1) { const u32x4 z = *(const u32x4*)(wsb + (size_t)cur.xoff + go);
                v.x = cvt_pk_bf16(bflo(v.x) * silu_f(bflo(z.x)), bfhi(v.x) * silu_f(bfhi(z.x))); v.y = cvt_pk_bf16(bflo(v.y) * silu_f(bflo(z.y)), bfhi(v.y) * silu_f(bfhi(z.y)));
                v.z = cvt_pk_bf16(bflo(v.z) * silu_f(bflo(z.z)), bfhi(v.z) * silu_f(bfhi(z.z))); v.w = cvt_pk_bf16(bflo(v.w) * silu_f(bflo(z.w)), bfhi(v.w) * silu_f(bfhi(z.w))); }
            *(u32x4*)(const_cast<unsigned char*>(wsb) + (size_t)cur.ooff + go) = v; }
        LDS_WAIT();
    }
    if (has_next) WAITBAR(4); else WAITBAR(0);
}
#undef DMA_K
#undef DMA_V
#undef WAITBAR
#undef SBAR
}

__device__ __forceinline__ fb::Blk blk_a(int it) {
    const int g = it >> 9, rem = it & 511, h = rem & 15, rb = rem < 256 ? (rem >> 4) : 31 - ((rem - 256) >> 4), lg = 2 * g, L = SEQ >> lg, R0 = rb * 256;
    int kb0 = R0 - 128; { const int s0 = R0 & ~(L - 1); if (kb0 < s0) kb0 = s0; }
    fb::Blk b;
    b.qoff = (unsigned)(WS_QKV + ((size_t)(3 * g) * PART + (size_t)R0 * DM + h * HD) * 2); b.koff = (unsigned)(WS_QKV + ((size_t)(3 * g + 1) * PART + h * HD) * 2); b.voff = (unsigned)(WS_QKV + ((size_t)(3 * g + 2) * PART + h * HD) * 2);
    b.ooff = (unsigned)(WS_OG + ((size_t)g * PART + h * HD) * 2); b.xoff = (unsigned)(WS_LSE + ((size_t)g * MTOK * NH + h) * 4);
    b.R0 = R0; b.kb0 = kb0; b.NT = (R0 + 256 - kb0) >> 6; b.slopeL = slope_of(h) * (float)(1 << lg) * LOG2E; b.L = L; b.base0 = 0;
    return b;
}
__device__ __forceinline__ void attn_a_pipe(unsigned char* lds, int wv) {
    CParams& P = PP();
    const int tid = otid(wv);
    const unsigned char* wsb = P.ws;
    constexpr int TOTAL = 3 * NH * (MTOK / 256);
    int it = obid(); if (it >= TOTAL) return;
    fb::Blk cur = blk_a(it);
    fb::Seam S;
    fb::prime(wsb, cur, lds, S, tid);
    for (;;) {
        const int itn = it + (int)gridDim.x; const bool last = itn >= TOTAL;
        const fb::Blk nb = last ? cur : blk_a(itn);
        const fb::Nxt nxt{nb.qoff, nb.koff, nb.voff, nb.kb0};
        fb::block<0>(wsb, cur, nxt, 0u, lds, S, tid);
        if (last) break;
        cur = nb; it = itn;
    }
}
__device__ __forceinline__ int vit_b(int it) { return (it < 256) ? ((it & 7) * 32 + (it >> 3)) : it; }
__device__ __forceinline__ fb::Blk blk_b(int it_, int pass) {
    const int it = vit_b(it_); const int bh = it >> 2, s = it & 3, b = bh >> 4, h = bh & 15, n = pass ? 7 - s : s, R0 = (b << 11) + (n << 8);
    fb::Blk k;
    k.qoff = (unsigned)(WS_QKV + ((size_t)R0 * DM + h * HD) * 2); k.koff = (unsigned)(WS_QKV + (PART + h * HD) * 2); k.voff = (unsigned)(WS_QKV + (2 * PART + h * HD) * 2);
    k.ooff = (unsigned)(WS_G + (size_t)(h * HD) * 2); k.xoff = (unsigned)(WS_Z + (size_t)(h * HD) * 2);
    k.R0 = R0; k.kb0 = b << 11; k.NT = 4 * (n + 1); k.slopeL = slope_of(h) * LOG2E; k.L = 0; k.base0 = b << 11;
    return k;
}
__device__ __forceinline__ unsigned moba_gate(const unsigned char* wsb, unsigned char* lds, int b, int h, int n, int R0, int tid) {
    unsigned sel = (1u << n) - 1u;
    if (n >= 4) {
        asm volatile("" : "+v"(tid));
        const bf16_t* QKV = (const bf16_t*)(wsb + WS_QKV); const float* KS = (const float*)(wsb + WS_KSUM);
        LAS float* gk = (LAS float*)((LAS unsigned char*)lds + fc::R_GK); LAS unsigned* sel_l = (LAS unsigned*)((LAS unsigned char*)lds + fc::R_SEL);
        for (int i = tid; i < n * 128; i += NTHREADS) { const float* kp = KS + (size_t)(b * 8 + (i >> 7)) * DM + h * HD + (i & 127); gk[i] = kp[0] + kp[(size_t)32 * DM]; }
        __syncthreads();
        const int row = tid >> 1, half = tid & 1;
        const u32x4* qp = (const u32x4*)(QKV + (size_t)(R0 + row) * DM + h * HD + half * 64);
        float gt[7];
#pragma unroll
        for (int j = 0; j < 7; ++j) gt[j] = 0.f;
#pragma unroll
        for (int c = 0; c < 8; ++c) { const u32x4 w = qp[c]; const float q0 = bflo(w.x), q1 = bfhi(w.x), q2 = bflo(w.y), q3 = bfhi(w.y), q4 = bflo(w.z), q5 = bfhi(w.z), q6 = bflo(w.w), q7 = bfhi(w.w);
#pragma unroll
            for (int j = 0; j < 7; ++j) if (j < n) { const LAS f32x4* kk = (const LAS f32x4*)(gk + j * 128 + half * 64 + c * 8); const f32x4 ka = kk[0], kb2 = kk[1];
                gt[j] += (q0 * ka.x + q1 * ka.y) + (q2 * ka.z + q3 * ka.w) + (q4 * kb2.x + q5 * kb2.y) + (q6 * kb2.z + q7 * kb2.w); } }
#pragma unroll
        for (int j = 0; j < 7; ++j) gt[j] += __shfl_xor(gt[j], 1);
        unsigned mask = 0;
#pragma unroll
        for (int j = 0; j < 7; ++j) if (j < n) { int rank = 0;
#pragma unroll
            for (int j2 = 0; j2 < 7; ++j2) if (j2 < n && (gt[j2] > gt[j] || (gt[j2] == gt[j] && j2 < j))) ++rank;
            if (rank < 3) mask |= 1u << j; }
        if (half == 0) sel_l[row] = mask;
        __syncthreads();
        sel = sel_l[(tid >> 6) * 32 + (tid & 31)];
    }
    return sel;
}
__device__ __forceinline__ void attn_b_pipe(unsigned char* lds, int wv) {
    CParams& P = PP();
    const int tid = otid(wv);
    const unsigned char* wsb = P.ws;
    constexpr int TOTAL = NB * NH * 4;
    int it = obid(); if (it >= TOTAL) return;
    int pass = 0;
    fb::Blk cur = blk_b(it, 0);
    fb::Seam S;
    fb::prime(wsb, cur, lds, S, tid);
    for (;;) {
        int itn = it, passn = pass + 1; if (passn == 2) { passn = 0; itn = it + (int)gridDim.x; }
        const bool last = itn >= TOTAL;
        const fb::Blk nb = last ? cur : blk_b(itn, passn);
        const fb::Nxt nxt{nb.qoff, nb.koff, nb.voff, nb.kb0};
        const int vi = vit_b(it), bh = vi >> 2, s = vi & 3, n = pass ? 7 - s : s;
        const unsigned sel = moba_gate(wsb, lds, bh >> 4, bh & 15, n, cur.R0, tid);
        fb::block<1>(wsb, cur, nxt, sel, lds, S, tid);
        if (last) break;
        cur = nb; it = itn; pass = passn;
    }
}

__device__ __forceinline__ fc::Blk cblk_a(int it) { const fb::Blk b = blk_a(it); const int h = it & 15, g = it >> 9;
    fc::Blk c{b.qoff, b.koff, b.voff, b.ooff, b.xoff, 0u, 0u, b.R0, b.kb0, b.NT, b.slopeL, b.L, b.base0};
    if (g == 2) { c.ooff = (unsigned)(WS_OG + (size_t)(h * HD) * 2); c.xoff = (unsigned)(WS_LSE + (size_t)h * 4); c.zoff = (unsigned)(WS_Z + (size_t)(h * HD) * 2); c.goff = (unsigned)(WS_G + (size_t)(h * HD) * 2); }
    return c; }
__device__ __forceinline__ fc::Blk cblk_b(int it, int pass) { const fb::Blk b = blk_b(it, pass); return fc::Blk{b.qoff, b.koff, b.voff, b.ooff, b.xoff, 0u, 0u, b.R0, b.kb0, b.NT, b.slopeL, b.L, b.base0}; }
template <int MODE>
__device__ __forceinline__ void attn_a_dma(unsigned char* lds, int wv, int first, int count) {
    CParams& P = PP();
    const int tid = otid(wv);
    const unsigned char* wsb = P.ws;
    int it = obid(); if (it >= count) return;
    fc::Blk cur = cblk_a(first + it);
    bf16x8 qr[8]; fc::Ring rg;
    fc::prime(wsb, cur, lds, qr, rg, tid);
    for (;;) {
        const int itn = it + (int)gridDim.x; const bool last = itn >= count;
        const fc::Blk nb = last ? cur : cblk_a(first + itn);
        const fc::Nxt nxt{nb.qoff, nb.koff, nb.voff, nb.kb0};
        fc::block<MODE>(wsb, cur, nxt, !last, 0u, lds, qr, rg, tid);
        if (last) break;
        cur = nb; it = itn;
    }
}
__device__ __forceinline__ void attn_b_dma(unsigned char* lds, int wv) {
    CParams& P = PP();
    const int tid = otid(wv);
    const unsigned char* wsb = P.ws;
    constexpr int TOTAL = NB * NH * 4;
    int it = obid(); if (it >= TOTAL) return;
    int pass = 0;
    fc::Blk cur = cblk_b(it, 0);
    bf16x8 qr[8]; fc::Ring rg;
    fc::prime(wsb, cur, lds, qr, rg, tid);
    for (;;) {
        int itn = it, passn = pass + 1; if (passn == 2) { passn = 0; itn = it + (int)gridDim.x; }
        const bool last = itn >= TOTAL;
        const fc::Blk nb = last ? cur : cblk_b(itn, passn);
        const fc::Nxt nxt{nb.qoff, nb.koff, nb.voff, nb.kb0};
        const int vi = vit_b(it), bh = vi >> 2, s = vi & 3, n = pass ? 7 - s : s;
        const unsigned sel = moba_gate(wsb, lds, bh >> 4, bh & 15, n, cur.R0, tid);
        fc::block<1>(wsb, cur, nxt, !last, sel, lds, qr, rg, tid);
        if (last) break;
        cur = nb; it = itn; pass = passn;
    }
}

__device__ __forceinline__ unsigned moba_gate2(const unsigned char* wsb, unsigned char* lds, int b, int h, int n, int R0, int tid) {
    unsigned sel = (1u << n) - 1u;
    if (n >= 4) {
        asm volatile("" : "+v"(tid));
        const int grp = tid >> 8, tin = tid & 255;
        const bf16_t* QKV = (const bf16_t*)(wsb + WS_QKV); const float* KS = (const float*)(wsb + WS_KSUM);
        LAS float* gk = (LAS float*)((LAS unsigned char*)lds + fc::R_GK) + grp * (7 * 128); LAS unsigned* sel_l = (LAS unsigned*)((LAS unsigned char*)lds + fc::R_SEL);
        for (int i = tin; i < n * 128; i += 256) { const float* kp = KS + (size_t)(b * 8 + (i >> 7)) * DM + h * HD + (i & 127); gk[i] = kp[0] + kp[(size_t)32 * DM]; }
        __syncthreads();
        const int row = grp * 128 + (tin >> 1), half = tin & 1;
        const u32x4* qp = (const u32x4*)(QKV + (size_t)(R0 + row) * DM + h * HD + half * 64);
        float gt[7];
#pragma unroll
        for (int j = 0; j < 7; ++j) gt[j] = 0.f;
#pragma unroll
        for (int c = 0; c < 8; ++c) { const u32x4 w = qp[c]; const float q0 = bflo(w.x), q1 = bfhi(w.x), q2 = bflo(w.y), q3 = bfhi(w.y), q4 = bflo(w.z), q5 = bfhi(w.z), q6 = bflo(w.w), q7 = bfhi(w.w);
#pragma unroll
            for (int j = 0; j < 7; ++j) if (j < n) { const LAS f32x4* kk = (const LAS f32x4*)(gk + j * 128 + half * 64 + c * 8); const f32x4 ka = kk[0], kb2 = kk[1];
                gt[j] += (q0 * ka.x + q1 * ka.y) + (q2 * ka.z + q3 * ka.w) + (q4 * kb2.x + q5 * kb2.y) + (q6 * kb2.z + q7 * kb2.w); } }
#pragma unroll
        for (int j = 0; j < 7; ++j) gt[j] += __shfl_xor(gt[j], 1);
        unsigned mask = 0;
#pragma unroll
        for (int j = 0; j < 7; ++j) if (j < n) { int rank = 0;
#pragma unroll
            for (int j2 = 0; j2 < 7; ++j2) if (j2 < n && (gt[j2] > gt[j] || (gt[j2] == gt[j] && j2 < j))) ++rank;
            if (rank < 3) mask |= 1u << j; }
        if (half == 0) sel_l[row] = mask;
        __syncthreads();
        sel = sel_l[(tid >> 6) * 32 + (tid & 31)];
    }
    return sel;
}
__device__ __forceinline__ void attn_a_hs(unsigned char* lds, int wv) {
    CParams& P = PP();
    const int tid = otid(wv);
    const unsigned char* wsb = P.ws;
    constexpr int TOTAL = 3 * NH * (MTOK / 256);
    int it = obid(); if (it >= TOTAL) return;
    fc::Blk cur = cblk_a(it);
    bf16x8 qr[8]; fc::Ring rg;
    fd::prime(wsb, cur, lds, qr, rg, tid);
    for (;;) {
        const int itn = it + (int)gridDim.x; const bool last = itn >= TOTAL;
        const fc::Blk nb = last ? cur : cblk_a(itn);
        const fc::Nxt nxt{nb.qoff, nb.koff, nb.voff, nb.kb0};
        fd::block<0>(wsb, cur, nxt, !last, 0u, lds, qr, rg, tid);
        if (last) break;
        cur = nb; it = itn;
    }
    fd::finish(tid);
}
__device__ __forceinline__ void attn_b_hs(unsigned char* lds, int wv) {
    CParams& P = PP();
    const int tid = otid(wv);
    const unsigned char* wsb = P.ws;
    constexpr int TOTAL = NB * NH * 4;
    int it = obid(); if (it >= TOTAL) return;
    int pass = 0;
    fc::Blk cur = cblk_b(it, 0);
    bf16x8 qr[8]; fc::Ring rg;
    fd::prime(wsb, cur, lds, qr, rg, tid);
    for (;;) {
        int itn = it, passn = pass + 1; if (passn == 2) { passn = 0; itn = it + (int)gridDim.x; }
        const bool last = itn >= TOTAL;
        const fc::Blk nb = last ? cur : cblk_b(itn, passn);
        const fc::Nxt nxt{nb.qoff, nb.koff, nb.voff, nb.kb0};
        const int vi = vit_b(it), bh = vi >> 2, s = vi & 3, n = pass ? 7 - s : s;
        const unsigned sel = moba_gate2(wsb, lds, bh >> 4, bh & 15, n, cur.R0, tid);
        fd::block<1>(wsb, cur, nxt, !last, sel, lds, qr, rg, tid);
        if (last) break;
        cur = nb; it = itn; pass = passn;
    }
    fd::finish(tid);
}

__device__ __forceinline__ void attn_a_flash(unsigned char* lds, int wv) {
    CParams& P = PP();
    const int tid = otid(wv);
    const bf16_t* QKV = (const bf16_t*)(P.ws + WS_QKV); bf16_t* OG = (bf16_t*)(P.ws + WS_OG); float* LSE = (float*)(P.ws + WS_LSE);
    for (int it = obid(); it < 3 * NH * (MTOK / 256); it += gridDim.x) {
        const int g = it >> 9, rem = it & 511, h = rem & 15, rb = rem >> 4;
        const int lg = 2 * g, L = SEQ >> lg, R0 = rb * 256;
        int krow0 = R0 - 128; { const int s0 = R0 & ~(L - 1); if (krow0 < s0) krow0 = s0; }
        const int NT = (R0 + 256 - krow0) >> 6;
        const fa::MaskA mk{L};
        fa::flash_block<0>(QKV + (size_t)(3 * g) * PART + (size_t)R0 * DM + h * HD, QKV + (size_t)(3 * g + 1) * PART + h * HD, QKV + (size_t)(3 * g + 2) * PART + h * HD,
                           krow0, NT, R0, slope_of(h) * (float)(1 << lg) * LOG2E, mk, lds, OG + (size_t)g * PART + h * HD, LSE + (size_t)g * MTOK * NH + h, nullptr, tid);
    }
}
__device__ __forceinline__ void attn_b_flash(unsigned char* lds, int wv) {
    CParams& P = PP();
    const int tid = otid(wv);
    const bf16_t* QKV = (const bf16_t*)(P.ws + WS_QKV); const bf16_t* Z = (const bf16_t*)(P.ws + WS_Z); bf16_t* G = (bf16_t*)(P.ws + WS_G); const float* KS = (const float*)(P.ws + WS_KSUM);
    LAS float* gk = (LAS float*)((LAS unsigned char*)lds + fa::OFF_GK); LAS unsigned* sel_l = (LAS unsigned*)((LAS unsigned char*)lds + fa::OFF_SEL);
    for (int it = obid(); it < NB * NH * 4; it += gridDim.x) {
        const int bh = it >> 2, s = it & 3, b = bh >> 4, h = bh & 15;
        for (int pass = 0; pass < 2; ++pass) {
            const int n = pass ? 7 - s : s, R0 = (b << 11) + (n << 8);
            unsigned sel = (1u << n) - 1u;
            if (n >= 4) {
                for (int i = tid; i < n * 128; i += NTHREADS) { const float* kp = KS + (size_t)(b * 8 + (i >> 7)) * DM + h * HD + (i & 127); gk[i] = kp[0] + kp[(size_t)32 * DM]; }
                __syncthreads();
                const int row = tid >> 1, half = tid & 1;
                const u32x4* qp = (const u32x4*)(QKV + (size_t)(R0 + row) * DM + h * HD + half * 64);
                float gt[7];
#pragma unroll
                for (int j = 0; j < 7; ++j) gt[j] = 0.f;
#pragma unroll
                for (int c = 0; c < 8; ++c) { const u32x4 w = qp[c]; const float q0 = bflo(w.x), q1 = bfhi(w.x), q2 = bflo(w.y), q3 = bfhi(w.y), q4 = bflo(w.z), q5 = bfhi(w.z), q6 = bflo(w.w), q7 = bfhi(w.w);
#pragma unroll
                    for (int j = 0; j < 7; ++j) if (j < n) { const LAS f32x4* kk = (const LAS f32x4*)(gk + j * 128 + half * 64 + c * 8); const f32x4 ka = kk[0], kb2 = kk[1];
                        gt[j] += (q0 * ka.x + q1 * ka.y) + (q2 * ka.z + q3 * ka.w) + (q4 * kb2.x + q5 * kb2.y) + (q6 * kb2.z + q7 * kb2.w); } }
#pragma unroll
                for (int j = 0; j < 7; ++j) gt[j] += __shfl_xor(gt[j], 1);
                unsigned mask = 0;
#pragma unroll
                for (int j = 0; j < 7; ++j) if (j < n) { int rank = 0;
#pragma unroll
                    for (int j2 = 0; j2 < 7; ++j2) if (j2 < n && (gt[j2] > gt[j] || (gt[j2] == gt[j] && j2 < j))) ++rank;
                    if (rank < 3) mask |= 1u << j; }
                if (half == 0) sel_l[row] = mask;
                __syncthreads();
                sel = sel_l[(tid >> 6) * 32 + (tid & 31)];
            }
            const fa::MaskB mk{R0, b << 11, sel};
            fa::flash_block<1>(QKV + (size_t)R0 * DM + h * HD, QKV + PART + h * HD, QKV + 2 * PART + h * HD, b << 11, 4 * (n + 1), R0, slope_of(h) * LOG2E, mk, lds,
                               G + h * HD, nullptr, Z + h * HD, tid);
        }
    }
}

#define XB_TMO      128
#define XB_XCNT(j)  (256  + 64 * (j))
#define XB_XSUB(j)  (1280 + 64 * (j))
#define XB_XGEN(j)  (2304 + 64 * (j))
#define XB_TOP      3328
#define XB_TOPGEN   3392
#define XCD_BAR_WORDS 3456
#define XB_SPIN_CAP (1u << 20)
__device__ __forceinline__ unsigned xb_ld(unsigned* p)              { return __hip_atomic_load(p, __ATOMIC_RELAXED, __HIP_MEMORY_SCOPE_AGENT); }
__device__ __forceinline__ unsigned xb_add(unsigned* p, unsigned v) { return __hip_atomic_fetch_add(p, v, __ATOMIC_RELAXED, __HIP_MEMORY_SCOPE_AGENT); }
__device__ __forceinline__ unsigned xb_xcc_id() { return (unsigned)__builtin_amdgcn_s_getreg((3 << 11) | 20) & 0xFu; }
#define XB_SPIN(cond, bar) do { unsigned _sp = 0; while (cond) { __builtin_amdgcn_s_sleep(1); \
    if ((++_sp & 255u) == 0u) { if (xb_ld(&(bar)[XB_TMO])) break; if (_sp > XB_SPIN_CAP) { atomicAdd(&(bar)[XB_TMO], 1u); break; } } } } while (0)
struct XcdBarrier { unsigned* bar; unsigned x; volatile LAS unsigned* st; };
__device__ __forceinline__ XcdBarrier xcd_barrier_post(unsigned* bar, volatile LAS unsigned* st) {
    XcdBarrier b; b.bar = bar; b.x = xb_xcc_id(); b.st = st;
    if (threadIdx.x == 0) (void)xb_add(&bar[XB_XCNT(b.x)], 1u);
    return b;
}
__device__ __forceinline__ void xcd_barrier_complete(unsigned* bar, unsigned x, unsigned& nloc, unsigned& nx) {
    const unsigned G = gridDim.x * gridDim.y * gridDim.z;
    unsigned sum, cnt, mine, sp = 0u;
    for (;;) {
        sum = 0u; cnt = 0u; mine = 0u;
#pragma unroll
        for (unsigned j = 0; j < 16; ++j) { const unsigned c = xb_ld(&bar[XB_XCNT(j)]); sum += c; cnt += (c > 0u) ? 1u : 0u; mine = (j == x) ? c : mine; }
        if (sum == G) break;
        __builtin_amdgcn_s_sleep(1);
        if ((++sp & 255u) == 0u) { if (xb_ld(&bar[XB_TMO])) break; if (sp > XB_SPIN_CAP) { atomicAdd(&bar[XB_TMO], 1u); break; } }
    }
    nloc = mine > 0u ? mine : 1u; nx = cnt > 0u ? cnt : 1u;
}
__device__ __forceinline__ void xcd_barrier(const XcdBarrier& b) {
    asm volatile("s_waitcnt vmcnt(0)" ::: "memory");
    __syncthreads();
    if (threadIdx.x == 0) {
        unsigned* bar = b.bar;
        __builtin_amdgcn_s_waitcnt(0);
        unsigned nloc = b.st[0], nx = b.st[1];
        if (nloc == 0u) { xcd_barrier_complete(bar, b.x, nloc, nx); b.st[0] = nloc; b.st[1] = nx; }
        const unsigned old = xb_add(&bar[XB_XSUB(b.x)], 1u);
        const unsigned gen = old / nloc;
        if (old + 1u == (gen + 1u) * nloc) {
            __builtin_amdgcn_fence(__ATOMIC_RELEASE, "agent");
            asm volatile("s_waitcnt vmcnt(0)" ::: "memory");
            const unsigned og = xb_add(&bar[XB_TOP], 1u);
            const unsigned tg = og / nx;
            if (og + 1u == (tg + 1u) * nx) xb_add(&bar[XB_TOPGEN], 1u);
            else XB_SPIN(xb_ld(&bar[XB_TOPGEN]) == tg, bar);
            __builtin_amdgcn_fence(__ATOMIC_ACQUIRE, "agent");
            xb_add(&bar[XB_XGEN(b.x)], 1u);
            asm volatile("s_waitcnt vmcnt(0)" ::: "memory");
        } else {
            XB_SPIN(xb_ld(&bar[XB_XGEN(b.x)]) == gen, bar);
            __builtin_amdgcn_fence(__ATOMIC_ACQUIRE, "agent");
            asm volatile("s_waitcnt vmcnt(0)" ::: "memory");
        }
    }
    __syncthreads();
}

#define GSYNC() do { XcdBarrier xb_; xb_.bar = (unsigned*)(PP().ws + WS_CTL); xb_.x = xb_xcc_id(); xb_.st = bst; xcd_barrier(xb_); } while (0)
template <int LAYER>
__device__ __forceinline__ void run_layer(unsigned char* lds, LAS unsigned char* lds3, volatile LAS unsigned* bst, int wv) {
    constexpr int layer = LAYER;
        const bool isA = (layer & 1) == 0; const int j = layer >> 1;
#if FUSE_NORM
        if (layer == 0) {
#endif
        norm_phase(layer, !isA && !MOBA_QK_I8, wv);
#if PROBE == 2
        norm_phase(layer, !isA && !MOBA_QK_I8, wv);
#endif
#if PROBE == 6
        GSYNC(); GSYNC(); GSYNC(); GSYNC(); GSYNC();
#endif
        GSYNC();
#if FUSE_NORM
        }
#endif
        {
#if !MOBA_QK_I8
            if (!isA) {
                unsigned char* ws = PP().ws;
                pg8::Gemm g{ws + WS_H, ws + WS_WBQK + (size_t)j * 4096 * DM * 2, MTOK, 4096, DM * 2};
                pg8::StaticOrder S; S.init(MTOK, 4096, (int)gridDim.x, obid());
                pg8::Epi E{1, 0, (bf16_t*)(ws + WS_QKV), (bf16_t*)(ws + WS_Z), (float*)(ws + WS_KSUM), nullptr, nullptr, nullptr, nullptr, nullptr};
                pg8::gemm_phase<pg8::Epi, pg8::StaticOrder, GEMM_ALIGN, GEMM_SP2, false>(lds3, g, S, E, wv);
            }
#endif
            {
                unsigned char* ws = PP().ws;
#if MOBA_QK_I8
                pg8::Gemm g{ws + WS_HQ, isA ? ws + WS_WAIN + (size_t)j * A_N * DM : ws + WS_WBQK + (size_t)j * B_N * DM, MTOK, isA ? (SPLIT_INPROJ ? 12288 : A_N) : B_N, DM};
                pg8::StaticOrder S; S.init(MTOK, g.N, (int)gridDim.x, obid());
                pg8::Epi E{isA ? 0 : 1, 0, (bf16_t*)(ws + WS_QKV), (bf16_t*)(ws + WS_Z), (float*)(ws + WS_KSUM), (const float*)(ws + WS_RS),
                           isA ? (const float*)(ws + WS_CSA) + j * A_N : (const float*)(ws + WS_CSB) + j * B_N, nullptr, nullptr, nullptr};
#else
                pg8::Gemm g{ws + WS_HQ, isA ? ws + WS_WAIN + (size_t)j * A_N * DM : ws + WS_WBVZ + (size_t)j * 4096 * DM, MTOK, isA ? A_N : 4096, DM};
                pg8::StaticOrder S; S.init(MTOK, g.N, (int)gridDim.x, obid());
                pg8::Epi E{isA ? 0 : 1, isA ? 0 : 2, (bf16_t*)(ws + WS_QKV), (bf16_t*)(ws + WS_Z), nullptr, (const float*)(ws + WS_RS),
                           isA ? (const float*)(ws + WS_CSA) + j * A_N : (const float*)(ws + WS_CSB) + j * 4096, nullptr, nullptr, nullptr};
#endif
#if STAGGER_TICKS > 0
                if (isA) {
                    const unsigned long long t0_ = __builtin_amdgcn_s_memrealtime(); const unsigned long long dl_ = (unsigned long long)((obid() >> 3) & 7) * STAGGER_TICKS;
                    while (__builtin_amdgcn_s_memrealtime() - t0_ < dl_) __builtin_amdgcn_s_sleep(8);
                }
#endif
                pg8::gemm_phase<pg8::Epi, pg8::StaticOrder, GEMM_ALIGN, GEMM_SP2, true>(lds3, g, S, E, wv);
#if PROBE == 7
                pg8::gemm_phase<pg8::Epi, pg8::StaticOrder, GEMM_ALIGN, GEMM_SP2, true>(lds3, g, S, E, wv);
#endif
#if PROBE == 12 || PROBE == 13
                if (isA) { pg8::Epi E3 = E; E3.mode = PROBE == 12 ? 6 : 7; E3.qkv = (bf16_t*)(ws + WS_OG); pg8::gemm_phase<pg8::Epi, pg8::StaticOrder, GEMM_ALIGN, GEMM_SP2, true>(lds3, g, S, E3, wv); }
#endif
#if PROBE == 10 || PROBE == 11
                if (isA) { pg8::Epi E3 = E; E3.mode = PROBE == 10 ? 4 : 5; E3.qkv = (bf16_t*)(ws + WS_OG); pg8::gemm_phase<pg8::Epi, pg8::StaticOrder, GEMM_ALIGN, GEMM_SP2, true>(lds3, g, S, E3, wv); }
#endif
#if PROBE == 9
                { pg8::Epi E3 = E; E3.mode = 3; pg8::gemm_phase<pg8::Epi, pg8::StaticOrder, GEMM_ALIGN, GEMM_SP2, true>(lds3, g, S, E3, wv); }
#endif
            }
        }
        GSYNC();
#if PROBE == 3
        if (isA) attn_a_dma<0>(lds, wv, 0, 1024);
#endif
#if PROBE == 4
        if (!isA) attn_b_hs(lds, wv);
#endif
#if ATTN_HS
        if (isA) { attn_a_hs(lds, wv); GSYNC(); combine_phase(wv);
#elif ATTN_DMA
#if FUSE_COMBINE && !OUTA_I8
        if (isA) { attn_a_dma<0>(lds, wv, 0, 1024);
#if SPLIT_INPROJ
            {
                __syncthreads();
                unsigned char* ws = PP().ws;
                pg8::Gemm g{ws + WS_HQ, ws + WS_WAIN + (size_t)j * A_N * DM + (size_t)12288 * DM, MTOK, 8192, DM};
                pg8::StaticOrder S; S.init(MTOK, g.N, (int)gridDim.x, obid());
                pg8::Epi E{0, 6, (bf16_t*)(ws + WS_QKV), (bf16_t*)(ws + WS_Z), (float*)(ws + WS_KSUM), (const float*)(ws + WS_RS), (const float*)(ws + WS_CSA) + j * A_N + 12288, nullptr, nullptr, nullptr};
                pg8::gemm_phase<pg8::Epi, pg8::StaticOrder, GEMM_ALIGN, GEMM_SP2, true>(lds3, g, S, E, wv);
            }
#endif
            GSYNC(); attn_a_dma<2>(lds, wv, 1024, 512);
#if PROBE == 14
            attn_a_dma<2>(lds, wv, 1024, 512);
#endif
#else
        if (isA) { attn_a_dma<0>(lds, wv, 0, 1536); GSYNC(); combine_phase(wv);
#endif
#elif ATTN_PIPE
        if (isA) { attn_a_pipe(lds, wv); GSYNC(); combine_phase(wv);
#else
        if (isA) { attn_a_flash(lds, wv); GSYNC(); combine_phase(wv);
#endif
#if PROBE == 5
            combine_phase(wv);
#endif
        }
#if ATTN_HS
        else { attn_b_hs(lds, wv); }
#elif ATTN_DMA
        else { attn_b_dma(lds, wv); }
#elif ATTN_PIPE
        else { attn_b_pipe(lds, wv); }
#else
        else { attn_b_flash(lds, wv); }
#endif
        GSYNC();
        {
            CParams& P = PP(); unsigned char* ws = P.ws;
            const bool i8o = OUTA_I8 && isA;
            pg8::Gemm g{i8o ? ws + WS_HQ : ws + WS_G, isA ? ws + WS_WAOUT + (size_t)j * DM * DM * (OUTA_I8 ? 1 : 2) : ws + WS_WBOUT + (size_t)j * DM * DM * 2, MTOK, DM, i8o ? DM : DM * 2};
            pg8::StaticOrder S; S.init(MTOK, DM, (int)gridDim.x, obid());
            pg8::Epi E{2, 0, nullptr, nullptr, nullptr, (const float*)(ws + WS_RS), (const float*)(ws + WS_CSO) + j * DM, layer == 0 ? P.x : P.out, P.out, (const float*)(ws + WS_MOD) + (size_t)layer * 4 * 6144 + 4096};
            {
                pg8::Unit u0; int ui = 0;
                while (S.next(ui, u0)) { const int t_ = otid(wv); const int w_ = __builtin_amdgcn_readfirstlane(t_ >> 6);
                    const float* xt = E.xin + (size_t)(u0.pm * 256 + (t_ >> 1)) * DM + u0.pn * 256 + (t_ & 1) * 128;
#pragma unroll
                    for (int q = 0; q < 4; ++q) __builtin_amdgcn_global_load_lds((const unsigned*)(xt + q * 32), (LAS unsigned*)(lds3 + 131072 + w_ * 1024 + q * 256), 4, 0, 0);
                    ++ui; } }
#if FUSE_NORM && !OUTA_I8
            {
                const bool lastl = layer == DEPTH - 1; const float* MODp = (const float*)(ws + WS_MOD);
                float* MODn = const_cast<float*>(MODp) + (size_t)(layer + 1) * 4 * 6144; unsigned* cn = (unsigned*)(ws + WS_CTL + 65536) + (size_t)layer * 32 * 128;
                if (lastl) { pg8::EpiOutF<true> EF{E.xin, E.xout, E.gate, P.final_w, nullptr, nullptr, ws + WS_HQ, (float*)(ws + WS_RS), (float*)(ws + WS_XS), cn};
                    pg8::gemm_phase<pg8::EpiOutF<true>, pg8::StaticOrder, GEMM_ALIGN, GEMM_SP2, false>(lds3, g, S, EF, wv); }
                else { pg8::EpiOutF<false> EF{E.xin, E.xout, E.gate, P.norm_w + (layer + 1) * DM, MODn + DM, MODn, ws + WS_HQ, (float*)(ws + WS_RS), (float*)(ws + WS_XS), cn};
                    pg8::gemm_phase<pg8::EpiOutF<false>, pg8::StaticOrder, GEMM_ALIGN, GEMM_SP2, false>(lds3, g, S, EF, wv); }
            }
#else
#if OUTA_I8
            if (isA) pg8::gemm_phase<pg8::Epi, pg8::StaticOrder, GEMM_ALIGN, GEMM_SP2, true>(lds3, g, S, E, wv);
            else
#endif
            pg8::gemm_phase<pg8::Epi, pg8::StaticOrder, GEMM_ALIGN, GEMM_SP2, false>(lds3, g, S, E, wv);
#endif
        }
#if FUSE_NORM && !OUTA_I8
        if (layer + 1 < DEPTH) GSYNC();
#else
        GSYNC();
#endif
    }

__global__ void __launch_bounds__(NTHREADS, 2) fwd_mega(Params Pin) {
    extern __shared__ __attribute__((aligned(16))) unsigned char lds[];
#if USE_CG_SYNC
    cg::grid_group grid = cg::this_grid();
#endif
    LAS unsigned char* lds3 = (LAS unsigned char*)lds;
    (void)Pin;
    const int wv = __builtin_amdgcn_readfirstlane((int)threadIdx.x >> 6);
    volatile LAS unsigned* bst = (volatile LAS unsigned*)(lds3 + (LDS_BYTES - 64));
    if (threadIdx.x < 2) bst[threadIdx.x] = 0u;
    __syncthreads();
    (void)xcd_barrier_post((unsigned*)(PP().ws + WS_CTL), bst);
    p0_mod(lds, wv);
    p0_weights(lds, wv);
#if PROBE == 1
    __syncthreads(); p0_mod(lds, wv); p0_weights(lds, wv);
#endif
#if USE_CG_SYNC
    grid.sync();
#else
    GSYNC();
#endif
    run_layer<0>(lds, lds3, bst, wv); run_layer<1>(lds, lds3, bst, wv); run_layer<2>(lds, lds3, bst, wv); run_layer<3>(lds, lds3, bst, wv);
#if !(FUSE_NORM && !OUTA_I8)
    final_norm_phase(wv);
#endif
}

extern "C" void kernel_launch(void* const* d_in, const int* in_sizes, int n_in, void* d_out, int out_size, void* d_ws, size_t ws_size, hipStream_t stream) {
    static int grid = 0;
    if (grid == 0) {
        if (n_in != 10 || in_sizes[0] != MTOK * DM || out_size != MTOK * DM || ws_size < WS_END) {
            fprintf(stderr, "kernel_launch: unexpected shapes/workspace (n_in %d, in0 %d, out %d, ws %zu, need %zu)\n", n_in, n_in > 0 ? in_sizes[0] : -1, out_size, ws_size, (size_t)WS_END); grid = -1; return; }
        int dev = 0, cus = 0, per_cu = 0;
        (void)hipGetDevice(&dev); (void)hipDeviceGetAttribute(&cus, hipDeviceAttributeMultiprocessorCount, dev);
        if (hipFuncSetAttribute((const void*)fwd_mega, hipFuncAttributeMaxDynamicSharedMemorySize, LDS_BYTES) != hipSuccess) { fprintf(stderr, "kernel_launch: hipFuncSetAttribute failed\n"); grid = -1; return; }
        if (hipOccupancyMaxActiveBlocksPerMultiprocessor(&per_cu, (const void*)fwd_mega, NTHREADS, LDS_BYTES) != hipSuccess || per_cu < 1) { fprintf(stderr, "kernel_launch: occupancy query says %d\n", per_cu); (void)hipGetLastError(); per_cu = 1; }
        if (per_cu > 1) per_cu = 1;
        grid = cus * per_cu;
    }
    if (grid < 0) return;
    (void)hipMemsetAsync((char*)d_ws + WS_CTL, 0, 65536 + 4 * 32 * 128 * 4, stream);
    Params p{};
    p.x = (const float*)d_in[0]; p.c = (const float*)d_in[1]; p.norm_w = (const float*)d_in[2]; p.mod_w = (const float*)d_in[3]; p.mod_b = (const float*)d_in[4];
    p.a_w_in = (const float*)d_in[5]; p.a_w_out = (const float*)d_in[6]; p.b_w_in = (const float*)d_in[7]; p.b_w_out = (const float*)d_in[8]; p.final_w = (const float*)d_in[9];
    p.out = (float*)d_out; p.ws = (unsigned char*)d_ws;
    void* args[] = {&p};
    hipError_t e = hipLaunchCooperativeKernel((const void*)fwd_mega, dim3(grid), dim3(NTHREADS), args, LDS_BYTES, stream);
    if (e != hipSuccess) fprintf(stderr, "kernel_launch: cooperative launch failed: %s (grid %d)\n", hipGetErrorString(e), grid);
}
```

```cpp
#include <hip/hip_runtime.h>
#include <hip/hip_cooperative_groups.h>
#include <cstdio>
#include <cstdint>
namespace cg = cooperative_groups;
#ifndef ATTN_A_FLASH
#define ATTN_A_FLASH 1
#endif
#ifndef GEMM_ALIGN
#define GEMM_ALIGN true
#endif
#ifndef GEMM_SP2
#define GEMM_SP2 true
#endif
#ifndef PROBE
#define PROBE 0
#endif
#ifndef MOBA_QK_I8
#define MOBA_QK_I8 1
#endif
#ifndef OUTA_I8
#define OUTA_I8 0
#endif
#ifndef GCLIP
#define GCLIP 1.0e9f
#endif
#ifndef SPLIT_INPROJ
#define SPLIT_INPROJ 1
#endif
#ifndef STAGGER_TICKS
#define STAGGER_TICKS 0
#endif
#ifndef USE_CG_SYNC
#define USE_CG_SYNC 0
#endif
#ifndef ATTN_PIPE
#define ATTN_PIPE 1
#endif
#ifndef FUSE_NORM
#define FUSE_NORM 1
#endif
#ifndef EPI_SC1
#define EPI_SC1 1
#endif
#ifndef FUSE_COMBINE
#define FUSE_COMBINE 1
#endif
#ifndef ATTN_DMA
#define ATTN_DMA 1
#endif
#ifndef ATTN_HS
#define ATTN_HS 0
#endif
#ifndef ATTN_B_FLASH
#define ATTN_B_FLASH 1
#endif

#define LAS __attribute__((address_space(3)))
typedef unsigned short bf16_t;
typedef short bf16x8 __attribute__((ext_vector_type(8)));
typedef short s16x4 __attribute__((ext_vector_type(4)));
typedef float f32x4 __attribute__((ext_vector_type(4)));
typedef float f32x16 __attribute__((ext_vector_type(16)));
typedef unsigned u32x4 __attribute__((ext_vector_type(4)));
typedef unsigned u32x2 __attribute__((ext_vector_type(2)));
typedef int i32x4 __attribute__((ext_vector_type(4)));

constexpr int NB = 4, SEQ = 2048, DM = 2048, MTOK = NB * SEQ, NH = 16, HD = 128, DEPTH = 4;
constexpr int A_N = 10 * DM, B_N = 4 * DM;
constexpr float EPS = 1e-6f;
constexpr float LOG2E = 1.4426950408889634f;
constexpr float C2Q = 0.08838834764831845f * LOG2E;

constexpr size_t MiB = 1u << 20;
constexpr size_t WS_CTL = 0;
constexpr size_t WS_MOD = 1 * MiB;
constexpr size_t WS_KSUM = 2 * MiB;
constexpr size_t WS_LSE = 3 * MiB;
constexpr size_t WS_XS = 4 * MiB;
constexpr size_t WS_RS = 5 * MiB;
constexpr size_t WS_CSA = 6 * MiB;
constexpr size_t WS_CSB = 7 * MiB;
constexpr size_t WS_CSO = 7 * MiB + 512 * 1024;
constexpr size_t WS_WAIN = 8 * MiB;
constexpr size_t WS_WBQK = WS_WAIN + 80 * MiB;
constexpr size_t WS_WBVZ = WS_WBQK + 32 * MiB;
constexpr size_t WS_WAOUT = WS_WBVZ + 16 * MiB;
constexpr size_t WS_WBOUT = WS_WAOUT + 16 * MiB;
constexpr size_t WS_H = WS_WBOUT + 16 * MiB;
constexpr size_t WS_HQ = WS_H + 32 * MiB;
constexpr size_t WS_G = WS_HQ + 16 * MiB;
constexpr size_t WS_QKV = WS_G + 32 * MiB;
constexpr size_t WS_Z = WS_QKV + 288 * MiB;
constexpr size_t WS_OG = WS_Z + 32 * MiB;
constexpr size_t WS_XB = WS_OG + 96 * MiB;
constexpr size_t WS_END = WS_XB + 32 * MiB;
constexpr size_t PART = (size_t)MTOK * DM;

constexpr int LDS_BYTES = 147456;
constexpr int NTHREADS = 512;

typedef float f32x2_t __attribute__((ext_vector_type(2))); typedef __bf16 bf16x2_t __attribute__((ext_vector_type(2)));
__device__ __forceinline__ unsigned cvt_pk_bf16(float lo, float hi) { f32x2_t v = {lo, hi}; bf16x2_t b = __builtin_convertvector(v, bf16x2_t); return __builtin_bit_cast(unsigned, b); }
__device__ __forceinline__ float bf2f(unsigned short v) { return __uint_as_float(((unsigned)v) << 16); }
__device__ __forceinline__ float bflo(unsigned w) { return __uint_as_float(w << 16); }
__device__ __forceinline__ float bfhi(unsigned w) { return __uint_as_float(w & 0xffff0000u); }
__device__ __forceinline__ float wave_sum(float v) {
#pragma unroll
    for (int o = 1; o < 64; o <<= 1) v += __shfl_xor(v, o);
    return v;
}
__device__ __forceinline__ float wave_max(float v) {
#pragma unroll
    for (int o = 1; o < 64; o <<= 1) v = fmaxf(v, __shfl_xor(v, o));
    return v;
}
__device__ __forceinline__ float silu_f(float v) { return v * __builtin_amdgcn_rcpf(1.f + __builtin_amdgcn_exp2f(-1.4426950408889634f * v)); }
#define LDS_WAIT() asm volatile("s_waitcnt lgkmcnt(0)" ::: "memory")
template <class V> __device__ __forceinline__ void store_wt(void* p, V v) { static_assert(sizeof(V) == 16, "16-byte vectors only");
    asm volatile("global_store_dwordx4 %0, %1, off sc1\n\ts_nop 1" :: "v"(p), "v"(v) : "memory"); }
__device__ __forceinline__ int otid(int wv) { int l; asm volatile("v_mbcnt_lo_u32_b32 %0, -1, 0\n\tv_mbcnt_hi_u32_b32 %0, -1, %0" : "=v"(l)); return (wv << 6) | l; }
template <class T> __device__ __forceinline__ T* optr(T* p) { asm volatile("" : "+s"(p)); return p; }
__device__ __forceinline__ int obid() { int b = blockIdx.x; asm volatile("" : "+s"(b)); return b; }

namespace pg8 {
constexpr int BM = 256, BK = 64, HALF = 128, HTB = HALF * BK * 2, STAGE_BYTES = 8 * HTB, NXCD = 8, WGM = 4;
__host__ __device__ __forceinline__ int lds_byte(int r, int c) { const int st = (r >> 4) * 2 + (c >> 5), rr = r & 15, cc = c & 31, ob = rr * 64 + cc * 2; return st * 1024 + (ob ^ (((ob >> 9) & 1) << 5)); }
__host__ __device__ __forceinline__ void stage_rc(int b, int& R, int& C) { const int st = b / 1024, sb = b % 1024, swz = sb ^ (((sb >> 9) & 1) << 5); R = (st >> 1) * 16 + swz / 64; C = (st & 1) * 32 + (swz % 64) / 2; }
__host__ __device__ __forceinline__ int perm32(int rho) { const int n = rho >> 4, i = rho & 15; return 8 * (i >> 2) + 4 * n + (i & 3); }
struct Unit { int pm, pn; };
struct Gemm { const void* A; const void* Bt; int M, N, KB; };
struct StaticOrder {
    int nM, nN, nwg, G, c;
    __host__ __device__ void init(int M, int N, int G_, int c_) { nM = M / BM; nN = N / BM; nwg = nM * nN; G = G_; c = c_; }
    __host__ __device__ bool next(int i, Unit& u) const {
        const long L = (long)i * G + c; if (L >= nwg) return false;
        int wgid = (int)L; { const int q = nwg / NXCD, r = nwg % NXCD, xcd = wgid % NXCD, off = wgid / NXCD; wgid = (xcd < r ? xcd * (q + 1) : r * (q + 1) + (xcd - r) * q) + off; }
        const int nig = WGM * nN, gid = wgid / nig, fm = gid * WGM, gsz = (nM - fm) < WGM ? (nM - fm) : WGM;
        u.pm = fm + ((wgid % nig) % gsz); u.pn = (wgid % nig) / gsz; return true;
    }
    __device__ __forceinline__ void a_ready(const Unit&) const {}
    __device__ __forceinline__ void done(const Unit&) const {}
};

__device__ __forceinline__ f32x4 acc_f32(const f32x4& a) { return a; }
__device__ __forceinline__ f32x4 acc_f32(const i32x4& a) { return (f32x4){(float)a.x, (float)a.y, (float)a.z, (float)a.w}; }
struct Epi {
    static constexpr bool PERM = true, AFTER_DRAIN = false;
    int mode;
    int pbase;
    bf16_t* qkv; bf16_t* zbuf; float* ksum;
    const float* rs; const float* cs;
    const float* xin; float* xout; const float* gate;
    template <class AccT>
    __device__ __forceinline__ void operator()(const AccT (&acc)[2][2][4][2], const Unit& u, int wr, int wc, int fr, int fq) const {
        constexpr bool I8 = sizeof(AccT) == sizeof(i32x4) && !__is_same(AccT, f32x4);
        if (mode == 3) {
#pragma unroll
            for (int ai = 0; ai < 2; ++ai)
#pragma unroll
                for (int bj = 0; bj < 2; ++bj)
#pragma unroll
                    for (int m = 0; m < 4; ++m)
#pragma unroll
                        for (int n = 0; n < 2; ++n) asm volatile("" :: "v"(acc[ai][bj][m][n]));
            return; }
        if (mode == 2) {
            const int col0 = u.pn * BM + wc * 64 + 8 * fq; const int b = (u.pm * BM) >> 11;
            f32x4 gv[2][2];
#pragma unroll
            for (int bj = 0; bj < 2; ++bj)
#pragma unroll
                for (int n = 0; n < 2; ++n) { gv[bj][n] = *(const f32x4*)(gate + b * 6144 + col0 + bj * 32 + 4 * n); if (I8) gv[bj][n] = gv[bj][n] * *(const f32x4*)(cs + col0 + bj * 32 + 4 * n); }
#pragma unroll
            for (int ai = 0; ai < 2; ++ai) {
                f32x4 xv[4][2][2]; float rsv[4];
#pragma unroll
                for (int m = 0; m < 4; ++m) { const int row = u.pm * BM + ai * HALF + wr * 64 + m * 16 + fr; const size_t off = (size_t)row * DM + col0; rsv[m] = I8 ? rs[row] : 1.f;
#pragma unroll
                    for (int bj = 0; bj < 2; ++bj)
#pragma unroll
                        for (int n = 0; n < 2; ++n) xv[m][bj][n] = *(const f32x4*)(xin + off + bj * 32 + 4 * n); }
                asm volatile("" ::: "memory");
#pragma unroll
                for (int m = 0; m < 4; ++m) { const size_t off = (size_t)(u.pm * BM + ai * HALF + wr * 64 + m * 16 + fr) * DM + col0;
#pragma unroll
                    for (int bj = 0; bj < 2; ++bj)
#pragma unroll
                        for (int n = 0; n < 2; ++n) *(f32x4*)(xout + off + bj * 32 + 4 * n) = xv[m][bj][n] + gv[bj][n] * (acc_f32(acc[ai][bj][m][n]) * rsv[m]); }
                asm volatile("" ::: "memory"); }
            return;
        }
        const int p = pbase + (u.pn >> 3), colt = (u.pn & 7) * BM;
        int lg = 0; float sc = 1.f; bf16_t* base;
        const bool pr_nostore = mode == 4, pr_window = mode == 5, pr_pitch = mode >= 6;
        const int ldo = mode == 6 ? 2112 : DM;
        if (mode == 0 || mode >= 4) { if (p == 9) base = zbuf; else { const int g = p / 3, kind = p - 3 * g; lg = 2 * g; base = qkv + (size_t)p * PART; if (kind == 0) sc = C2Q; } }
        else { if (p == 3) base = zbuf; else { base = qkv + (size_t)p * PART; if (p == 0) sc = C2Q; } }
        const int col0 = colt + wc * 64 + 8 * fq;
        f32x4 cv[2][2];
        if (I8) {
#pragma unroll
            for (int bj = 0; bj < 2; ++bj)
#pragma unroll
                for (int n = 0; n < 2; ++n) cv[bj][n] = *(const f32x4*)(cs + u.pn * BM + wc * 64 + 8 * fq + bj * 32 + 4 * n) * sc;
        }
        float rsa[2][4];
#pragma unroll
        for (int ai = 0; ai < 2; ++ai)
#pragma unroll
            for (int m = 0; m < 4; ++m) rsa[ai][m] = I8 ? rs[u.pm * BM + ai * HALF + wr * 64 + m * 16 + fr] : sc;
#pragma unroll
        for (int ai = 0; ai < 2; ++ai)
#pragma unroll
            for (int m = 0; m < 4; ++m) {
                const int row = u.pm * BM + ai * HALF + wr * 64 + m * 16 + fr, b = row >> 11, t = row & 2047;
                const int R = (b << 11) + ((t & ((1 << lg) - 1)) << (11 - lg)) + (t >> lg);
                bf16_t* rowp = pr_pitch ? (qkv + (size_t)(p % 3) * 4096 * 2112 + (size_t)(R & 4095) * ldo + col0) : (base + (size_t)(pr_window ? (R & 255) : R) * DM + col0);
                const float rsv = rsa[ai][m];
                u32x4 wq[2];
#pragma unroll
                for (int bj = 0; bj < 2; ++bj) { f32x4 v0 = acc_f32(acc[ai][bj][m][0]) * rsv, v1 = acc_f32(acc[ai][bj][m][1]) * rsv;
                    if (I8) { v0 = v0 * cv[bj][0]; v1 = v1 * cv[bj][1]; }
                    wq[bj].x = cvt_pk_bf16(v0[0], v0[1]); wq[bj].y = cvt_pk_bf16(v0[2], v0[3]); wq[bj].z = cvt_pk_bf16(v1[0], v1[1]); wq[bj].w = cvt_pk_bf16(v1[2], v1[3]); }
                if (pr_nostore) { asm volatile("" :: "v"(wq[0]), "v"(wq[1])); }
                else {
                    const bool oddr = (fr & 1) != 0;
                    const int t1 = t ^ 1, R1 = (b << 11) + ((t1 & ((1 << lg) - 1)) << (11 - lg)) + (t1 >> lg);
                    bf16_t* prow = pr_pitch ? (qkv + (size_t)(p % 3) * 4096 * 2112 + (size_t)(R1 & 4095) * ldo + col0) : (base + (size_t)(pr_window ? (R1 & 255) : R1) * DM + col0);
                    const u32x4 snd = oddr ? wq[0] : wq[1]; u32x4 rcv;
                    rcv.x = (unsigned)__builtin_amdgcn_mov_dpp((int)snd.x, 0xB1, 0xf, 0xf, true); rcv.y = (unsigned)__builtin_amdgcn_mov_dpp((int)snd.y, 0xB1, 0xf, 0xf, true);
                    rcv.z = (unsigned)__builtin_amdgcn_mov_dpp((int)snd.z, 0xB1, 0xf, 0xf, true); rcv.w = (unsigned)__builtin_amdgcn_mov_dpp((int)snd.w, 0xB1, 0xf, 0xf, true);
                    bf16_t* a1 = oddr ? prow + 32 : rowp; const u32x4 d1 = oddr ? rcv : wq[0];
                    bf16_t* a2 = oddr ? rowp + 32 : prow; const u32x4 d2 = oddr ? wq[1] : rcv;
                    asm volatile("global_store_dwordx4 %0, %1, off sc1\n\ts_nop 1" :: "v"(a1), "v"(d1) : "memory");
                    asm volatile("global_store_dwordx4 %0, %1, off sc1\n\ts_nop 1" :: "v"(a2), "v"(d2) : "memory");
                } }
        if (mode == 1 && p == 1) {
#pragma unroll
            for (int bj = 0; bj < 2; ++bj)
#pragma unroll
                for (int n = 0; n < 2; ++n) { f32x4 s = {0.f, 0.f, 0.f, 0.f};
#pragma unroll
                    for (int ai = 0; ai < 2; ++ai)
#pragma unroll
                        for (int m = 0; m < 4; ++m) s += acc_f32(acc[ai][bj][m][n]) * (I8 ? rsa[ai][m] : 1.f);
                    if (I8) s = s * cv[bj][n];
#pragma unroll
                    for (int j = 0; j < 4; ++j) { float v = s[j]; v += __shfl_xor(v, 1); v += __shfl_xor(v, 2); v += __shfl_xor(v, 4); v += __shfl_xor(v, 8); s[j] = v; }
                    if (fr == 0) *(f32x4*)(ksum + ((size_t)(wr * 32 + u.pm) * DM + colt + bj * 32 + wc * 64 + 8 * fq + 4 * n)) = s; }
        }
    }
};

typedef _Float16 f16x8_t __attribute__((ext_vector_type(8))); typedef float f32x8_t __attribute__((ext_vector_type(8)));
__device__ __forceinline__ f16x8_t f16_pack8(const f32x4& a0, const f32x4& a1) {
    f32x8_t v = {a0[0], a0[1], a0[2], a0[3], a1[0], a1[1], a1[2], a1[3]};
#pragma unroll
    for (int i = 0; i < 8; ++i) v[i] = __builtin_amdgcn_fmed3f(v[i], -65504.f, 65504.f);
    return __builtin_convertvector(v, f16x8_t); }
__device__ __forceinline__ void store_x1_lines(_Float16* rowp, bool oddr, const u32x4& h0, const u32x4& h1) {
    const u32x4 snd = oddr ? h0 : h1; u32x4 rcv;
    rcv.x = (unsigned)__builtin_amdgcn_mov_dpp((int)snd.x, 0xB1, 0xf, 0xf, true); rcv.y = (unsigned)__builtin_amdgcn_mov_dpp((int)snd.y, 0xB1, 0xf, 0xf, true);
    rcv.z = (unsigned)__builtin_amdgcn_mov_dpp((int)snd.z, 0xB1, 0xf, 0xf, true); rcv.w = (unsigned)__builtin_amdgcn_mov_dpp((int)snd.w, 0xB1, 0xf, 0xf, true);
    _Float16* prow = oddr ? rowp - DM : rowp + DM;
    store_wt(oddr ? prow + 32 : rowp, oddr ? rcv : h0);
    store_wt(oddr ? rowp + 32 : prow, oddr ? h1 : rcv);
}
template <bool LASTL, bool XINB> struct EpiOutF {
    static constexpr bool PERM = true, AFTER_DRAIN = true;
    const void* xin; void* xout; const float* gate;
    const float* ca_w; const float* ca_scale; const float* cs_shift;
    unsigned char* hq; float* rsq; float* xs; unsigned* cnt;
    static constexpr bool last = LASTL;
    __device__ __forceinline__ void wait_cnt(unsigned* c, int wid) const {
        if (wid == 0) { unsigned sp = 0;
            while ((unsigned)__builtin_amdgcn_readfirstlane((int)__hip_atomic_load(c, __ATOMIC_RELAXED, __HIP_MEMORY_SCOPE_AGENT)) < 8u) { __builtin_amdgcn_s_sleep(1); if (++sp > (1u << 22)) break; }
            asm volatile("s_waitcnt vmcnt(0)" ::: "memory"); }
        __syncthreads(); }
    __device__ __forceinline__ void fused(f32x4 (&acc)[2][2][4][2], const Unit& u, int wr, int wc, int fr, int fq, LAS unsigned char* lds, int wid, int lane) const {
        asm volatile("" : "+v"(fr), "+v"(fq), "+v"(lane));
        const int tid = wid * 64 + lane, b = (u.pm * BM) >> 11, col0 = u.pn * BM + wc * 64 + 8 * fq;
        LAS float* P = (LAS float*)lds;
        LAS float* T = (LAS float*)(lds + 4096);
        { f32x4 gv[2][2];
#pragma unroll
          for (int bj = 0; bj < 2; ++bj)
#pragma unroll
              for (int n = 0; n < 2; ++n) gv[bj][n] = *(const f32x4*)(gate + b * 6144 + col0 + bj * 32 + 4 * n);
          if constexpr (XINB) {
              f16x8_t xb[2][4][2];
#pragma unroll
              for (int ai = 0; ai < 2; ++ai)
#pragma unroll
                  for (int m = 0; m < 4; ++m) { const size_t off = (size_t)(u.pm * BM + ai * HALF + wr * 64 + m * 16 + fr) * DM + col0;
#pragma unroll
                      for (int bj = 0; bj < 2; ++bj) xb[ai][m][bj] = *(const f16x8_t*)((const _Float16*)xin + off + bj * 32); }
              asm volatile("" ::: "memory");
#pragma unroll
              for (int ai = 0; ai < 2; ++ai)
#pragma unroll
                  for (int m = 0; m < 4; ++m) { const size_t off = (size_t)(u.pm * BM + ai * HALF + wr * 64 + m * 16 + fr) * DM + col0;
#pragma unroll
                      for (int bj = 0; bj < 2; ++bj) { const f32x8_t w = __builtin_convertvector(xb[ai][m][bj], f32x8_t);
                          acc[ai][bj][m][0] = (f32x4){w[0], w[1], w[2], w[3]} + gv[bj][0] * acc[ai][bj][m][0];
                          acc[ai][bj][m][1] = (f32x4){w[4], w[5], w[6], w[7]} + gv[bj][1] * acc[ai][bj][m][1]; }
                      if constexpr (!LASTL) store_x1_lines((_Float16*)xout + off, (fr & 1) != 0, __builtin_bit_cast(u32x4, f16_pack8(acc[ai][0][m][0], acc[ai][0][m][1])), __builtin_bit_cast(u32x4, f16_pack8(acc[ai][1][m][0], acc[ai][1][m][1])));
                      asm volatile("" : "+v"(acc[ai][0][m][0]), "+v"(acc[ai][0][m][1]), "+v"(acc[ai][1][m][0]), "+v"(acc[ai][1][m][1])); }
              asm volatile("" ::: "memory"); __builtin_amdgcn_sched_barrier(0);
          } else {
#pragma unroll
          for (int ai = 0; ai < 2; ++ai) {
              f32x4 xv[4][2][2];
#pragma unroll
              for (int m = 0; m < 4; ++m) { const size_t off = (size_t)(u.pm * BM + ai * HALF + wr * 64 + m * 16 + fr) * DM + col0;
#pragma unroll
                  for (int bj = 0; bj < 2; ++bj)
#pragma unroll
                      for (int n = 0; n < 2; ++n) xv[m][bj][n] = *(const f32x4*)((const float*)xin + off + bj * 32 + 4 * n); }
              asm volatile("" ::: "memory");
#pragma unroll
              for (int m = 0; m < 4; ++m) { const size_t off = (size_t)(u.pm * BM + ai * HALF + wr * 64 + m * 16 + fr) * DM + col0;
#pragma unroll
                  for (int bj = 0; bj < 2; ++bj) {
#pragma unroll
                      for (int n = 0; n < 2; ++n) acc[ai][bj][m][n] = xv[m][bj][n] + gv[bj][n] * acc[ai][bj][m][n]; }
                  if constexpr (!LASTL) store_x1_lines((_Float16*)xout + off, (fr & 1) != 0, __builtin_bit_cast(u32x4, f16_pack8(acc[ai][0][m][0], acc[ai][0][m][1])), __builtin_bit_cast(u32x4, f16_pack8(acc[ai][1][m][0], acc[ai][1][m][1])));
                  asm volatile("" : "+v"(acc[ai][0][m][0]), "+v"(acc[ai][0][m][1]), "+v"(acc[ai][1][m][0]), "+v"(acc[ai][1][m][1])); }
              asm volatile("" ::: "memory"); __builtin_amdgcn_sched_barrier(0); } } }
#pragma unroll
        for (int ai = 0; ai < 2; ++ai)
#pragma unroll
            for (int m = 0; m < 4; ++m) { float q = 0.f;
#pragma unroll
                for (int bj = 0; bj < 2; ++bj)
#pragma unroll
                    for (int n = 0; n < 2; ++n) { const f32x4 v = acc[ai][bj][m][n]; q += (v[0] * v[0] + v[1] * v[1]) + (v[2] * v[2] + v[3] * v[3]); }
                q += __uint_as_float((unsigned)__builtin_amdgcn_ds_swizzle((int)__float_as_uint(q), (16 << 10) | 0x1f)); { auto r_ = __builtin_amdgcn_permlane32_swap(__float_as_uint(q), __float_as_uint(q), false, false); q = __uint_as_float(r_[0]) + __uint_as_float(r_[1]); }
                if (fq == 0) P[(ai * HALF + wr * 64 + m * 16 + fr) * 4 + wc] = q;
                __builtin_amdgcn_sched_barrier(0); }
        __syncthreads();
        if (tid < 256) { const float t = (P[tid * 4 + 0] + P[tid * 4 + 1]) + (P[tid * 4 + 2] + P[tid * 4 + 3]);
            __hip_atomic_store(xs + ((size_t)(u.pm * BM + tid) * 8 + u.pn), t, __ATOMIC_RELAXED, __HIP_MEMORY_SCOPE_AGENT); }
        asm volatile("s_waitcnt vmcnt(0)" ::: "memory");
        __syncthreads();
        if (tid == 0) __hip_atomic_fetch_add(cnt + 128 * u.pm, 1u, __ATOMIC_RELAXED, __HIP_MEMORY_SCOPE_AGENT);
        wait_cnt(cnt + 128 * u.pm, wid);
        if (tid < 256) { const float* sl = xs + (size_t)(u.pm * BM + tid) * 8; float t = 0.f;
#pragma unroll
            for (int k = 0; k < 8; ++k) t += __hip_atomic_load(sl + k, __ATOMIC_RELAXED, __HIP_MEMORY_SCOPE_AGENT);
            T[tid] = 1.0f / sqrtf(t * (1.f / DM) + EPS); }
        __syncthreads();
        f32x4 cav[2][2], csv[2][2];
#pragma unroll
        for (int bj = 0; bj < 2; ++bj)
#pragma unroll
            for (int n = 0; n < 2; ++n) { const int c = col0 + bj * 32 + 4 * n; const f32x4 w = *(const f32x4*)(ca_w + c);
                if constexpr (LASTL) { cav[bj][n] = w; csv[bj][n] = (f32x4){0.f, 0.f, 0.f, 0.f}; }
                else { cav[bj][n] = w * (*(const f32x4*)(ca_scale + b * 6144 + c) + 1.f); csv[bj][n] = *(const f32x4*)(cs_shift + b * 6144 + c); } }
        if constexpr (LASTL) {
            asm volatile("" : "+v"(fr));
#pragma unroll
            for (int ai = 0; ai < 2; ++ai)
#pragma unroll
                for (int m = 0; m < 4; ++m) { const int rl = ai * HALF + wr * 64 + m * 16 + fr; const float rs = T[rl]; const size_t off = (size_t)(u.pm * BM + rl) * DM + col0;
#pragma unroll
                    for (int bj = 0; bj < 2; ++bj)
#pragma unroll
                        for (int n = 0; n < 2; ++n) *(f32x4*)((float*)xout + off + bj * 32 + 4 * n) = acc[ai][bj][m][n] * rs * cav[bj][n]; }
        } else {
        LAS float* P2 = (LAS float*)(lds + 8192); LAS float* T2 = (LAS float*)(lds + 12288);
#pragma unroll
        for (int ai = 0; ai < 2; ++ai)
#pragma unroll
            for (int m = 0; m < 4; ++m) { const int rl = ai * HALF + wr * 64 + m * 16 + fr; const float rs = T[rl]; float am = 0.f;
#pragma unroll
                for (int bj = 0; bj < 2; ++bj)
#pragma unroll
                    for (int n = 0; n < 2; ++n) { const f32x4 h = acc[ai][bj][m][n] * rs * cav[bj][n] + csv[bj][n]; acc[ai][bj][m][n] = h;
                        am = fmaxf(am, fmaxf(fmaxf(fabsf(h[0]), fabsf(h[1])), fmaxf(fabsf(h[2]), fabsf(h[3])))); }
                am = fmaxf(am, __uint_as_float((unsigned)__builtin_amdgcn_ds_swizzle((int)__float_as_uint(am), (16 << 10) | 0x1f))); { auto r_ = __builtin_amdgcn_permlane32_swap(__float_as_uint(am), __float_as_uint(am), false, false); am = fmaxf(__uint_as_float(r_[0]), __uint_as_float(r_[1])); }
                if (fq == 0) P2[rl * 4 + wc] = am;
                __builtin_amdgcn_sched_barrier(0); }
        __syncthreads();
        if (tid < 256) { const float t = fmaxf(fmaxf(P2[tid * 4 + 0], P2[tid * 4 + 1]), fmaxf(P2[tid * 4 + 2], P2[tid * 4 + 3]));
            __hip_atomic_store(xs + (size_t)MTOK * 8 + ((size_t)(u.pm * BM + tid) * 8 + u.pn), t, __ATOMIC_RELAXED, __HIP_MEMORY_SCOPE_AGENT); }
        asm volatile("s_waitcnt vmcnt(0)" ::: "memory");
        __syncthreads();
        if (tid == 0) __hip_atomic_fetch_add(cnt + 128 * u.pm + 64, 1u, __ATOMIC_RELAXED, __HIP_MEMORY_SCOPE_AGENT);
        wait_cnt(cnt + 128 * u.pm + 64, wid);
        if (tid < 256) { const float* sl = xs + (size_t)MTOK * 8 + (size_t)(u.pm * BM + tid) * 8; float t = 0.f;
#pragma unroll
            for (int k = 0; k < 8; ++k) t = fmaxf(t, __hip_atomic_load(sl + k, __ATOMIC_RELAXED, __HIP_MEMORY_SCOPE_AGENT));
            T2[tid] = t > 0.f ? 127.f / t : 0.f;
            if (u.pn == 0) rsq[u.pm * BM + tid] = t > 0.f ? t * (1.f / 127.f) : 1.f; }
        __syncthreads();
#pragma unroll
        for (int ai = 0; ai < 2; ++ai)
#pragma unroll
            for (int m = 0; m < 4; ++m) { const int rl = ai * HALF + wr * 64 + m * 16 + fr; const float inv = T2[rl]; unsigned char* qrow = hq + (size_t)(u.pm * BM + rl) * DM + col0;
                unsigned w2[2][2];
#pragma unroll
                for (int bj = 0; bj < 2; ++bj)
#pragma unroll
                    for (int n = 0; n < 2; ++n) { const f32x4 h = acc[ai][bj][m][n] * inv;
                        w2[bj][n] = ((unsigned)(int)rintf(h[0]) & 0xffu) | (((unsigned)(int)rintf(h[1]) & 0xffu) << 8) | (((unsigned)(int)rintf(h[2]) & 0xffu) << 16) | (((unsigned)(int)rintf(h[3]) & 0xffu) << 24); }
                const bool odd = (fq & 1) != 0;
                const unsigned s0 = odd ? w2[0][0] : w2[1][0], s1 = odd ? w2[0][1] : w2[1][1];
                const unsigned r0 = (unsigned)__builtin_amdgcn_ds_swizzle((int)s0, (16 << 10) | 0x1f), r1 = (unsigned)__builtin_amdgcn_ds_swizzle((int)s1, (16 << 10) | 0x1f);
                const u32x4 o = odd ? (u32x4){r0, r1, w2[1][0], w2[1][1]} : (u32x4){w2[0][0], w2[0][1], r0, r1};
                store_wt(qrow + (odd ? 24 : 0), o);
                __builtin_amdgcn_sched_barrier(0); }
        }
    }
};
template <bool I8> struct AccSel { typedef f32x4 type; };
template <> struct AccSel<true> { typedef i32x4 type; };
template <bool I8> __device__ __forceinline__ typename AccSel<I8>::type mma1(bf16x8 b, bf16x8 a, typename AccSel<I8>::type c) {
    if constexpr (I8) return __builtin_amdgcn_mfma_i32_16x16x64_i8(__builtin_bit_cast(i32x4, b), __builtin_bit_cast(i32x4, a), c, 0, 0, 0);
    else return __builtin_amdgcn_mfma_f32_16x16x32_bf16(b, a, c, 0, 0, 0);
}
template <class Epi, class Sched, bool ALIGN_EPI = false, bool SP2 = false, bool I8 = false>
__device__ __forceinline__ void gemm_phase(LAS unsigned char* lds, const Gemm g, const Sched& S, const Epi& E, int wv) {
    const int tid = otid(wv), wid = __builtin_amdgcn_readfirstlane(tid >> 6), lane = tid & 63, wr = wid >> 2, wc = wid & 3, fr = lane & 15, fq = lane >> 4;
    const int KBY = g.KB, nt = KBY / (BK * 2);
    unsigned voffA[2], voffB[2];
#pragma unroll
    for (int i = 0; i < 2; ++i) { int R, C; stage_rc(tid * 16 + i * 8192, R, C); const int Rb = Epi::PERM ? ((R & ~31) + perm32(R & 31)) : R;
        voffA[i] = (unsigned)(R * KBY + C * 2); voffB[i] = (unsigned)((Epi::PERM ? ((R >> 5) * 64 + perm32(R & 31)) : Rb) * KBY + C * 2); }
    const size_t kstep = (size_t)(BK * 2);
    const size_t hstep = (size_t)HALF * KBY;
    const size_t hstepB = Epi::PERM ? (size_t)32 * KBY : hstep;
    const size_t tstep = 2 * hstep;
    const unsigned ldsw = (unsigned)wid * 1024u;
    const int aoff = lds_byte(wr * 64 + fr, fq * 8), boff = lds_byte(wc * 32 + fr, fq * 8);
#define PG8_SA(b, h) (((b) * 2 + (h)) * HTB)
#define PG8_SB(b, h) ((4 + (b) * 2 + (h)) * HTB)
#define PG8_STAGE(bufoff, gbase, voff) do { _Pragma("unroll") for (int _i = 0; _i < 2; ++_i) \
        __builtin_amdgcn_global_load_lds((const unsigned*)((const char*)(gbase) + (voff)[_i]), (LAS unsigned*)(lds + (bufoff) + ldsw + _i * 8192), 16, 0, 0); } while (0)
#define PG8_LDA(dst, b, h) do { _Pragma("unroll") for (int m = 0; m < 4; ++m) _Pragma("unroll") for (int k = 0; k < 2; ++k) dst[m][k] = *(const LAS bf16x8*)(lds + PG8_SA(b, h) + aoff + m * 2048 + k * 1024); } while (0)
#define PG8_LDB(dst, b, h) do { _Pragma("unroll") for (int n = 0; n < 2; ++n) _Pragma("unroll") for (int k = 0; k < 2; ++k) dst[n][k] = *(const LAS bf16x8*)(lds + PG8_SB(b, h) + boff + n * 2048 + k * 1024); } while (0)
#define PG8_MMA(ai, bj, At, Bt) do { __builtin_amdgcn_s_setprio(1); _Pragma("unroll") for (int m = 0; m < 4; ++m) _Pragma("unroll") for (int n = 0; n < 2; ++n) _Pragma("unroll") for (int k = 0; k < 2; ++k) \
        acc[ai][bj][m][n] = mma1<I8>(Bt[n][k], At[m][k], acc[ai][bj][m][n]); __builtin_amdgcn_s_setprio(0); } while (0)
#define PG8_WAIT_V(n) asm volatile("s_waitcnt vmcnt(" #n ")" ::: "memory")
#define PG8_WAIT_L(n) asm volatile("s_waitcnt lgkmcnt(" #n ")" ::: "memory")
#define PG8_BAR __builtin_amdgcn_s_barrier()
#define PG8_SCHED __builtin_amdgcn_sched_barrier(0)
    Unit cur, nxt; int ui = 0;
    if (!S.next(0, cur)) return;
    typedef typename AccSel<I8>::type acc_t;
    acc_t acc[2][2][4][2];
#pragma unroll
    for (int a = 0; a < 2; ++a)
#pragma unroll
        for (int b = 0; b < 2; ++b)
#pragma unroll
            for (int m = 0; m < 4; ++m)
#pragma unroll
                for (int n = 0; n < 2; ++n) acc[a][b][m][n] = acc_t{};
    bf16x8 At[4][2], B0[2][2], B1[2][2];
    const char* cA = (const char*)g.A + (size_t)cur.pm * tstep; const char* cB = (const char*)g.Bt + (size_t)cur.pn * tstep;
    S.a_ready(cur);
    if constexpr (SP2) {
        PG8_STAGE(PG8_SB(0, 0), cB, voffB); PG8_STAGE(PG8_SB(0, 1), cB + hstepB, voffB); PG8_STAGE(PG8_SA(0, 0), cA, voffA); PG8_STAGE(PG8_SA(0, 1), cA + hstep, voffA);
        if (wr == 1) PG8_BAR;
        PG8_WAIT_V(2); PG8_BAR;
        PG8_STAGE(PG8_SB(1, 0), cB + kstep, voffB); PG8_STAGE(PG8_SA(1, 0), cA + kstep, voffA); PG8_STAGE(PG8_SB(1, 1), cB + hstepB + kstep, voffB);
        PG8_WAIT_V(6); PG8_BAR;
    } else {
        PG8_STAGE(PG8_SB(0, 0), cB, voffB); PG8_STAGE(PG8_SA(0, 0), cA, voffA); PG8_STAGE(PG8_SB(0, 1), cB + hstepB, voffB); PG8_STAGE(PG8_SA(0, 1), cA + hstep, voffA);
        if (wr == 1) PG8_BAR;
        PG8_WAIT_V(4); PG8_BAR;
        PG8_STAGE(PG8_SB(1, 0), cB + kstep, voffB); PG8_STAGE(PG8_SA(1, 0), cA + kstep, voffA); PG8_STAGE(PG8_SB(1, 1), cB + hstepB + kstep, voffB);
        PG8_WAIT_V(6); PG8_BAR;
    }
    for (;;) {
        const bool has_next = S.next(ui + 1, nxt);
        const char* nA = has_next ? (const char*)g.A + (size_t)nxt.pm * tstep : cA; const char* nB = has_next ? (const char*)g.Bt + (size_t)nxt.pn * tstep : cB;
        for (int t = 0; t < nt; t += 2) {
            const bool last = (t == nt - 2);
            const char* a1 = cA + (size_t)(t + 1) * kstep;
            const char* a2 = last ? nA : cA + (size_t)(t + 2) * kstep; const char* b2 = last ? nB : cB + (size_t)(t + 2) * kstep;
            const char* a3 = a2 + kstep; const char* b3 = b2 + kstep;
            if (last && has_next) S.a_ready(nxt);
            if constexpr (SP2) {
            PG8_LDB(B0, 0, 0); PG8_LDB(B1, 0, 1); PG8_SCHED; PG8_LDA(At, 0, 0); PG8_STAGE(PG8_SA(1, 1), a1 + hstep, voffA);
            PG8_WAIT_V(8); PG8_WAIT_L(0); PG8_BAR; PG8_MMA(0, 0, At, B0); PG8_MMA(0, 1, At, B1); PG8_BAR; PG8_SCHED;
            PG8_LDA(At, 0, 1); PG8_STAGE(PG8_SB(0, 0), b2, voffB); PG8_STAGE(PG8_SB(0, 1), b2 + hstepB, voffB); PG8_STAGE(PG8_SA(0, 0), a2, voffA);
            PG8_WAIT_V(8); PG8_WAIT_L(0); PG8_BAR; PG8_MMA(1, 0, At, B0); PG8_MMA(1, 1, At, B1); PG8_BAR; PG8_SCHED;
            PG8_LDB(B0, 1, 0); PG8_LDB(B1, 1, 1); PG8_SCHED; PG8_LDA(At, 1, 0); PG8_STAGE(PG8_SA(0, 1), a2 + hstep, voffA);
            PG8_WAIT_V(8); PG8_WAIT_L(0); PG8_BAR; PG8_MMA(0, 0, At, B0); PG8_MMA(0, 1, At, B1); PG8_BAR; PG8_SCHED;
            PG8_LDA(At, 1, 1); PG8_STAGE(PG8_SB(1, 0), b3, voffB); PG8_STAGE(PG8_SB(1, 1), b3 + hstepB, voffB); PG8_STAGE(PG8_SA(1, 0), a3, voffA);
            PG8_WAIT_V(8); PG8_WAIT_L(0); PG8_BAR; PG8_MMA(1, 0, At, B0); PG8_MMA(1, 1, At, B1); PG8_BAR; PG8_SCHED;
            } else {
            PG8_LDB(B0, 0, 0); PG8_SCHED; PG8_LDA(At, 0, 0); PG8_STAGE(PG8_SA(1, 1), a1 + hstep, voffA);
            PG8_WAIT_L(8); PG8_BAR; PG8_WAIT_L(0); PG8_MMA(0, 0, At, B0); PG8_BAR; PG8_SCHED;
            PG8_LDB(B1, 0, 1); PG8_STAGE(PG8_SB(0, 0), b2, voffB);
            PG8_BAR; PG8_WAIT_L(0); PG8_MMA(0, 1, At, B1); PG8_BAR;
            PG8_LDA(At, 0, 1); PG8_STAGE(PG8_SA(0, 0), a2, voffA);
            PG8_BAR; PG8_WAIT_L(0); PG8_MMA(1, 0, At, B0); PG8_BAR; PG8_SCHED;
            PG8_STAGE(PG8_SB(0, 1), b2 + hstepB, voffB);
            PG8_WAIT_V(6); PG8_BAR; PG8_MMA(1, 1, At, B1); PG8_BAR;
            PG8_LDB(B0, 1, 0); PG8_SCHED; PG8_LDA(At, 1, 0); PG8_STAGE(PG8_SA(0, 1), a2 + hstep, voffA);
            PG8_WAIT_L(8); PG8_BAR; PG8_WAIT_L(0); PG8_MMA(0, 0, At, B0); PG8_BAR; PG8_SCHED;
            PG8_LDB(B1, 1, 1); PG8_STAGE(PG8_SB(1, 0), b3, voffB);
            PG8_BAR; PG8_WAIT_L(0); PG8_MMA(0, 1, At, B1); PG8_BAR;
            PG8_LDA(At, 1, 1); PG8_STAGE(PG8_SA(1, 0), a3, voffA);
            PG8_BAR; PG8_WAIT_L(0); PG8_MMA(1, 0, At, B0); PG8_BAR; PG8_SCHED;
            PG8_STAGE(PG8_SB(1, 1), b3 + hstepB, voffB);
            PG8_WAIT_V(6); PG8_BAR; PG8_MMA(1, 1, At, B1); PG8_BAR;
            }
        }
        if constexpr (ALIGN_EPI) { if (wr == 0) PG8_BAR; }
        if constexpr (!Epi::AFTER_DRAIN) { E(acc, cur, wr, wc, fr, fq); S.done(cur); }
        if (!has_next) break;
#pragma unroll
        for (int a = 0; a < 2; ++a)
#pragma unroll
            for (int b = 0; b < 2; ++b)
#pragma unroll
                for (int m = 0; m < 4; ++m)
#pragma unroll
                    for (int n = 0; n < 2; ++n) acc[a][b][m][n] = acc_t{};
        cur = nxt; cA = nA; cB = nB; ++ui;
        if constexpr (ALIGN_EPI) { if (wr == 1) PG8_BAR; }
    }
    PG8_WAIT_V(0);
    if constexpr (!ALIGN_EPI) { if (wr == 0) PG8_BAR; }
    PG8_BAR;
    if constexpr (Epi::AFTER_DRAIN) { if constexpr (!I8) E.fused(acc, cur, wr, wc, fr, fq, lds, wid, lane); }
#undef PG8_SA
#undef PG8_SB
#undef PG8_STAGE
#undef PG8_LDA
#undef PG8_LDB
#undef PG8_MMA
#undef PG8_WAIT_V
#undef PG8_WAIT_L
#undef PG8_BAR
#undef PG8_SCHED
}
}

struct Params {
    const float *x, *c, *norm_w, *mod_w, *mod_b, *a_w_in, *a_w_out, *b_w_in, *b_w_out, *final_w;
    float* out; unsigned char* ws;
};

typedef const __attribute__((address_space(4))) Params CParams;
__device__ __forceinline__ CParams& PP() { CParams* p = (CParams*)__builtin_amdgcn_kernarg_segment_ptr(); asm volatile("" : "+s"(p)); return *p; }

__device__ __forceinline__ void p0_mod(unsigned char* lds, int wv) {
    CParams& P = PP();
    const int tid = otid(wv);
    f32x4* condT = (f32x4*)lds;
    float* red = (float*)(lds + 32768);
    float* MOD = (float*)(P.ws + WS_MOD);
    bool have = false;
    for (int item = obid(); item < 768; item += gridDim.x) {
        if (!have) { have = true;
            for (int k = tid; k < DM; k += NTHREADS) { f32x4 v; v.x = silu_f(P.c[k]); v.y = silu_f(P.c[DM + k]); v.z = silu_f(P.c[2 * DM + k]); v.w = silu_f(P.c[3 * DM + k]); condT[k] = v; }
            __syncthreads(); }
        const int l = item / 192, n0 = (item % 192) * 32, cq = tid & 7, kp = tid >> 3;
        f32x4 a0 = {0.f, 0.f, 0.f, 0.f}, a1 = a0, a2 = a0, a3 = a0;
        const float* wp = P.mod_w + ((size_t)l * DM + kp * 32) * 6144 + n0 + 4 * cq;
#pragma unroll 16
        for (int k = 0; k < 32; ++k) { const f32x4 w = __builtin_nontemporal_load((const f32x4*)(wp + (size_t)k * 6144)); const f32x4 cv = condT[kp * 32 + k];
            a0 += w * cv.x; a1 += w * cv.y; a2 += w * cv.z; a3 += w * cv.w; }
        *(f32x4*)(red + (kp * 4 + 0) * 32 + 4 * cq) = a0; *(f32x4*)(red + (kp * 4 + 1) * 32 + 4 * cq) = a1;
        *(f32x4*)(red + (kp * 4 + 2) * 32 + 4 * cq) = a2; *(f32x4*)(red + (kp * 4 + 3) * 32 + 4 * cq) = a3;
        __syncthreads();
        if (tid < 128) { const int b = tid >> 5, col = tid & 31; float s = P.mod_b[l * 6144 + n0 + col];
#pragma unroll 8
            for (int q = 0; q < 64; ++q) s += red[(q * 4 + b) * 32 + col];
            MOD[(l * 4 + b) * 6144 + n0 + col] = s; }
        __syncthreads();
    }
}
__device__ __forceinline__ void p0_transpose_item(const float* W, int ldn, int ncol0, int nblk, bf16_t* WT, unsigned char* scr, int item, int lane) {
    const int kb = item / nblk, nb = item - kb * nblk, k0 = kb * 64, n0 = nb * 64;
    const float* src = W + (size_t)(k0 + (lane >> 4)) * ldn + ncol0 + n0 + 4 * (lane & 15);
#pragma unroll 4
    for (int i = 0; i < 16; ++i) { const f32x4 v = __builtin_nontemporal_load((const f32x4*)(src + (size_t)(4 * i) * ldn));
        unsigned* d = (unsigned*)(scr + (4 * i + (lane >> 4)) * 132 + 8 * (lane & 15));
        d[0] = cvt_pk_bf16(v.x, v.y); d[1] = cvt_pk_bf16(v.z, v.w); }
    LDS_WAIT();
    const int c = lane & 7;
#pragma unroll
    for (int j = 0; j < 8; ++j) { const int n = (lane >> 3) + 8 * j; const unsigned short* s = (const unsigned short*)(scr + (8 * c) * 132 + 2 * n);
        u32x4 o;
        o.x = (unsigned)s[0 * 66] | ((unsigned)s[1 * 66] << 16); o.y = (unsigned)s[2 * 66] | ((unsigned)s[3 * 66] << 16);
        o.z = (unsigned)s[4 * 66] | ((unsigned)s[5 * 66] << 16); o.w = (unsigned)s[6 * 66] | ((unsigned)s[7 * 66] << 16);
        *(u32x4*)(WT + (size_t)(n0 + n) * DM + k0 + 8 * c) = o; }
    LDS_WAIT();
}
__device__ __forceinline__ void p0_panel_i8(const float* W, int ldn, int n0, signed char* WT, float* cs, unsigned char* lds, int tid) {
    const int lane = tid & 63, wave = __builtin_amdgcn_readfirstlane(tid >> 6);
    float* maxbuf = (float*)(lds + 131072);
    f32x4 mx = {0.f, 0.f, 0.f, 0.f};
    { const float* src = W + (size_t)(wave * 256 + (lane >> 3)) * ldn + n0 + 4 * (lane & 7);
      unsigned char* dst = lds + (size_t)(wave * 256 + (lane >> 3)) * 64 + 8 * (lane & 7);
#pragma unroll 16
      for (int i = 0; i < 32; ++i) { const f32x4 v = __builtin_nontemporal_load((const f32x4*)(src + (size_t)(8 * i) * ldn));
          mx.x = fmaxf(mx.x, fabsf(v.x)); mx.y = fmaxf(mx.y, fabsf(v.y)); mx.z = fmaxf(mx.z, fabsf(v.z)); mx.w = fmaxf(mx.w, fabsf(v.w));
          u32x2 w; w.x = cvt_pk_bf16(v.x, v.y); w.y = cvt_pk_bf16(v.z, v.w); *(u32x2*)(dst + (size_t)(8 * i) * 64) = w; } }
#pragma unroll
    for (int o = 8; o < 64; o <<= 1) { mx.x = fmaxf(mx.x, __shfl_xor(mx.x, o)); mx.y = fmaxf(mx.y, __shfl_xor(mx.y, o)); mx.z = fmaxf(mx.z, __shfl_xor(mx.z, o)); mx.w = fmaxf(mx.w, __shfl_xor(mx.w, o)); }
    if (lane < 8) *(f32x4*)(maxbuf + wave * 32 + 4 * lane) = mx;
    __syncthreads();
    { const int n = tid & 31, kc = tid >> 5;
      float cm = maxbuf[n];
#pragma unroll
      for (int w = 1; w < 8; ++w) cm = fmaxf(cm, maxbuf[w * 32 + n]);
      const float inv = cm > 0.f ? 127.f / cm : 0.f;
      if (kc == 0) cs[n0 + n] = cm > 0.f ? cm * (1.f / 127.f) : 1.f;
      const unsigned short* t = (const unsigned short*)lds + (size_t)(kc * 128) * 32 + n;
      signed char* orow = WT + (size_t)(n0 + n) * DM + kc * 128;
#pragma unroll 2
      for (int i = 0; i < 8; ++i) { unsigned w[4];
#pragma unroll
          for (int q = 0; q < 4; ++q) { unsigned acc = 0;
#pragma unroll
              for (int e = 0; e < 4; ++e) { const float v = bf2f(t[(size_t)(16 * i + 4 * q + e) * 32]) * inv; int iv = (int)rintf(v); iv = iv > 127 ? 127 : (iv < -127 ? -127 : iv); acc |= ((unsigned)iv & 0xffu) << (8 * e); }
              w[q] = acc; }
          *(u32x4*)(orow + 16 * i) = (u32x4){w[0], w[1], w[2], w[3]}; } }
    __syncthreads();
}
__device__ __forceinline__ void p0_weights(unsigned char* lds, int wv) {
    CParams& P = PP();
    const int tid_ = otid(wv); const int lane = tid_ & 63, wave = __builtin_amdgcn_readfirstlane(tid_ >> 6);
    constexpr int PA = A_N / 32, PB = (MOBA_QK_I8 ? B_N : 4096) / 32, PO = DM / 32, NPANEL = 2 * PA + 2 * PB + (OUTA_I8 ? 2 * PO : 0);
    for (int it = obid(); it < NPANEL; it += gridDim.x) {
        if (it < 2 * PA) { const int j = it / PA, pnl = it - j * PA;
            p0_panel_i8(P.a_w_in + (size_t)j * DM * A_N, A_N, pnl * 32, (signed char*)(P.ws + WS_WAIN) + (size_t)j * A_N * DM, (float*)(P.ws + WS_CSA) + j * A_N, lds, tid_); }
        else if (it < 2 * PA + 2 * PB) { const int r = it - 2 * PA, j = r / PB, pnl = r - j * PB;
#if MOBA_QK_I8
            p0_panel_i8(P.b_w_in + (size_t)j * DM * B_N, B_N, pnl * 32, (signed char*)(P.ws + WS_WBQK) + (size_t)j * B_N * DM, (float*)(P.ws + WS_CSB) + j * B_N, lds, tid_); }
#else
            p0_panel_i8(P.b_w_in + (size_t)j * DM * B_N + 4096, B_N, pnl * 32, (signed char*)(P.ws + WS_WBVZ) + (size_t)j * 4096 * DM, (float*)(P.ws + WS_CSB) + j * 4096, lds, tid_); }
#endif
#if OUTA_I8
        else { const int r = it - 2 * PA - 2 * PB, j = r / PO, pnl = r - j * PO;
            p0_panel_i8(P.a_w_out + (size_t)j * DM * DM, DM, pnl * 32, (signed char*)(P.ws + WS_WAOUT) + (size_t)j * DM * DM, (float*)(P.ws + WS_CSO) + j * DM, lds, tid_); }
#endif
    }
    unsigned char* scr = lds + 65536 + wave * 8448;
    const int gw = obid() * 8 + wave, NGW = gridDim.x * 8;
    constexpr int I_B = MOBA_QK_I8 ? 0 : 32 * 64, I_O = 32 * 32, I_AO = OUTA_I8 ? 0 : 32 * 32, TOTAL = 2 * I_B + 2 * I_AO + 2 * I_O;
    for (int it = gw; it < TOTAL; it += NGW) {
        int r = it;
        if (I_B > 0 && r < 2 * I_B) { const int j = r / (I_B > 0 ? I_B : 1); p0_transpose_item(P.b_w_in + (size_t)j * DM * B_N, B_N, 0, 64, (bf16_t*)(P.ws + WS_WBQK) + (size_t)j * 4096 * DM, scr, r - j * I_B, lane); continue; } r -= 2 * I_B;
        if (I_AO > 0 && r < 2 * I_AO) { const int j = r / (I_AO > 0 ? I_AO : 1); p0_transpose_item(P.a_w_out + (size_t)j * DM * DM, DM, 0, 32, (bf16_t*)(P.ws + WS_WAOUT) + (size_t)j * DM * DM, scr, r - j * I_AO, lane); continue; } r -= 2 * I_AO;
        { const int j = r / I_O; p0_transpose_item(P.b_w_out + (size_t)j * DM * DM, DM, 0, 32, (bf16_t*)(P.ws + WS_WBOUT) + (size_t)j * DM * DM, scr, r - j * I_O, lane); }
    }
}

__device__ __forceinline__ void norm_phase(int layer, bool want_bf16, int wv) {
    CParams& P = PP(); const float* xin = layer == 0 ? P.x : P.out;
    const int tid_ = otid(wv); const int lane = tid_ & 63, wave = __builtin_amdgcn_readfirstlane(tid_ >> 6);
    const int gw = obid() * 8 + wave, NGW = gridDim.x * 8;
    const float* MOD = (const float*)(P.ws + WS_MOD);
    bf16_t* Hb = (bf16_t*)(P.ws + WS_H); unsigned char* Hq = P.ws + WS_HQ; float* RS = (float*)(P.ws + WS_RS);
    for (int r0 = gw * 4; r0 < MTOK; r0 += NGW * 4) {
        const int b = r0 >> 11;
        const float* shift = MOD + (size_t)(layer * 4 + b) * 6144; const float* scale = shift + DM; const float* nw = P.norm_w + layer * DM;
        f32x4 ca[8], cs[8];
#pragma unroll
        for (int j = 0; j < 8; ++j) { const int c = 4 * lane + 256 * j; const f32x4 w = *(const f32x4*)(nw + c), s = *(const f32x4*)(scale + c); ca[j] = w * (s + 1.f); cs[j] = *(const f32x4*)(shift + c); }
        for (int rr = 0; rr < 4; ++rr) {
            const float* xr = xin + (size_t)(r0 + rr) * DM; f32x4 v[8]; float ss = 0.f;
#pragma unroll
            for (int j = 0; j < 8; ++j) { v[j] = *(const f32x4*)(xr + 4 * lane + 256 * j); ss += (v[j].x * v[j].x + v[j].y * v[j].y) + (v[j].z * v[j].z + v[j].w * v[j].w); }
            const float rs = 1.0f / sqrtf(wave_sum(ss) * (1.f / DM) + EPS);
            float am = 0.f;
#pragma unroll
            for (int j = 0; j < 8; ++j) { v[j] = v[j] * rs * ca[j] + cs[j]; am = fmaxf(am, fmaxf(fmaxf(fabsf(v[j].x), fabsf(v[j].y)), fmaxf(fabsf(v[j].z), fabsf(v[j].w)))); }
            am = wave_max(am);
            const float inv = am > 0.f ? 127.f / am : 0.f;
            if (lane == 0) RS[r0 + rr] = am > 0.f ? am * (1.f / 127.f) : 1.f;
            unsigned char* qr = Hq + (size_t)(r0 + rr) * DM;
#pragma unroll
            for (int j = 0; j < 8; ++j) { const f32x4 h = v[j] * inv;
                const int i0 = (int)rintf(h.x), i1 = (int)rintf(h.y), i2 = (int)rintf(h.z), i3 = (int)rintf(h.w);
                *(unsigned*)(qr + 4 * lane + 256 * j) = ((unsigned)i0 & 0xffu) | (((unsigned)i1 & 0xffu) << 8) | (((unsigned)i2 & 0xffu) << 16) | (((unsigned)i3 & 0xffu) << 24); }
            if (want_bf16) { bf16_t* hr = Hb + (size_t)(r0 + rr) * DM;
#pragma unroll
                for (int j = 0; j < 8; ++j) { u32x2 w; w.x = cvt_pk_bf16(v[j].x, v[j].y); w.y = cvt_pk_bf16(v[j].z, v[j].w); *(u32x2*)(hr + 4 * lane + 256 * j) = w; } }
        }
    }
}
__device__ __forceinline__ void final_norm_phase(int wv) {
    CParams& P = PP();
    const int tid_ = otid(wv); const int lane = tid_ & 63, wave = __builtin_amdgcn_readfirstlane(tid_ >> 6);
    const int gw = obid() * 8 + wave, NGW = gridDim.x * 8;
    f32x4 cw[8];
#pragma unroll
    for (int j = 0; j < 8; ++j) cw[j] = *(const f32x4*)(P.final_w + 4 * lane + 256 * j);
    for (int r = gw; r < MTOK; r += NGW) {
        float* xr = P.out + (size_t)r * DM; f32x4 v[8]; float ss = 0.f;
#pragma unroll
        for (int j = 0; j < 8; ++j) { v[j] = *(const f32x4*)(xr + 4 * lane + 256 * j); ss += (v[j].x * v[j].x + v[j].y * v[j].y) + (v[j].z * v[j].z + v[j].w * v[j].w); }
        const float rs = 1.0f / sqrtf(wave_sum(ss) * (1.f / DM) + EPS);
#pragma unroll
        for (int j = 0; j < 8; ++j) *(f32x4*)(xr + 4 * lane + 256 * j) = v[j] * rs * cw[j];
    }
}

__device__ __forceinline__ void naive_attend(const bf16_t* Kh, const bf16_t* Vh, const float* qf, float* sc, int own_start, int own_len, int blkbase, int mask, int qpos, float slopeL, int lane,
                                             float& o0, float& o1, float& lse2) {
    int base = 0; float mx = -3.0e38f;
    { int m2 = mask;
      for (int rr = 0;; ++rr) { int start, len;
        if (rr == 0) { start = own_start; len = own_len; } else { if (!m2) break; const int j = __builtin_ctz(m2); m2 &= m2 - 1; start = blkbase + (j << 8); len = 256; }
        for (int i = lane; i < len; i += 64) { const int key = start + i; const u32x4* kp = (const u32x4*)(Kh + (size_t)key * DM); float dot = 0.f;
#pragma unroll 4
            for (int cch = 0; cch < 16; ++cch) { const u32x4 w = kp[cch]; const float* q = qf + cch * 8;
                dot += q[0] * bflo(w.x) + q[1] * bfhi(w.x) + q[2] * bflo(w.y) + q[3] * bfhi(w.y) + q[4] * bflo(w.z) + q[5] * bfhi(w.z) + q[6] * bflo(w.w) + q[7] * bfhi(w.w); }
            const float s = dot + slopeL * (float)(key - qpos); sc[base + i] = s; mx = fmaxf(mx, s); }
        base += len; } }
    const int tot = base; mx = wave_max(mx);
    LDS_WAIT();
    float sum = 0.f;
    for (int i = lane; i < tot; i += 64) { const float p = exp2f(sc[i] - mx); sc[i] = p; sum += p; }
    sum = wave_sum(sum);
    LDS_WAIT();
    float a0 = 0.f, a1 = 0.f; base = 0;
    { int m2 = mask;
      for (int rr = 0;; ++rr) { int start, len;
        if (rr == 0) { start = own_start; len = own_len; } else { if (!m2) break; const int j = __builtin_ctz(m2); m2 &= m2 - 1; start = blkbase + (j << 8); len = 256; }
        const bf16_t* vp = Vh + (size_t)start * DM + 2 * lane;
        for (int i = 0; i < len; ++i) { const float p = sc[base + i]; const unsigned w = *(const unsigned*)(vp + (size_t)i * DM); a0 += p * bflo(w); a1 += p * bfhi(w); }
        base += len; } }
    LDS_WAIT();
    const float inv = 1.f / sum; o0 = a0 * inv; o1 = a1 * inv; lse2 = mx + log2f(sum);
}
__device__ __forceinline__ float slope_of(int h) { return exp2f(-0.5f * (float)(h + 1)); }

__device__ __forceinline__ void attn_a_naive(unsigned char* lds, int wv) {
    CParams& P = PP();
    const int tid_ = otid(wv); const int lane = tid_ & 63, wave = __builtin_amdgcn_readfirstlane(tid_ >> 6);
    float* qf = (float*)(lds + wave * 8192); float* sc = qf + 128;
    const bf16_t* QKV = (const bf16_t*)(P.ws + WS_QKV); bf16_t* OG = (bf16_t*)(P.ws + WS_OG); float* LSE = (float*)(P.ws + WS_LSE);
    const int gw = obid() * 8 + wave, NGW = gridDim.x * 8;
    for (int it = gw; it < 3 * MTOK * NH; it += NGW) {
        const int h = it & 15, R = (it >> 4) & (MTOK - 1), g = it >> 17;
        const int lg = 2 * g, L = SEQ >> lg;
        const bf16_t* Qp = QKV + (size_t)(3 * g) * PART + (size_t)R * DM + h * HD;
        { const unsigned w = *(const unsigned*)(Qp + 2 * lane); qf[2 * lane] = bflo(w); qf[2 * lane + 1] = bfhi(w); }
        LDS_WAIT();
        const int seq0 = R & ~(L - 1); int lo = R - 128; if (lo < seq0) lo = seq0;
        float o0, o1, lse2;
        naive_attend(QKV + (size_t)(3 * g + 1) * PART + h * HD, QKV + (size_t)(3 * g + 2) * PART + h * HD, qf, sc, lo, R - lo + 1, 0, 0, R, slope_of(h) * (float)(1 << lg) * LOG2E, lane, o0, o1, lse2);
        *(unsigned*)(OG + (size_t)g * PART + (size_t)R * DM + h * HD + 2 * lane) = cvt_pk_bf16(o0, o1);
        if (lane == 0) LSE[((size_t)g * MTOK + R) * NH + h] = lse2;
    }
}
__device__ __forceinline__ void combine_phase(int wv) {
    CParams& P = PP();
    const int tid_ = otid(wv); const int lane = tid_ & 63, wave = __builtin_amdgcn_readfirstlane(tid_ >> 6);
    const int gw = obid() * 8 + wave, NGW = gridDim.x * 8;
    const bf16_t* OG = (const bf16_t*)(P.ws + WS_OG); const float* LSE = (const float*)(P.ws + WS_LSE); const bf16_t* Z = (const bf16_t*)(P.ws + WS_Z);
    unsigned char* GQ = P.ws + WS_HQ; float* RS = (float*)(P.ws + WS_RS);
    for (int m = gw; m < MTOK; m += NGW) {
        const int b = m >> 11, t = m & 2047;
        const int R0 = m, R1 = (b << 11) + ((t & 3) << 9) + (t >> 2), R2 = (b << 11) + ((t & 15) << 7) + (t >> 4);
        float v[4][8]; float am = 0.f, sq = 0.f;
#pragma unroll
        for (int j = 0; j < 4; ++j) { const int col = 8 * lane + 512 * j, h = col >> 7;
            const float l0 = LSE[((size_t)0 * MTOK + R0) * NH + h], l1 = LSE[((size_t)1 * MTOK + R1) * NH + h], l2 = LSE[((size_t)2 * MTOK + R2) * NH + h];
            const float mx = fmaxf(l0, fmaxf(l1, l2)); float e0 = exp2f(l0 - mx), e1 = exp2f(l1 - mx), e2 = exp2f(l2 - mx); const float inv = 1.f / (e0 + e1 + e2); e0 *= inv; e1 *= inv; e2 *= inv;
            const u32x4 a = *(const u32x4*)(OG + (size_t)R0 * DM + col), bb = *(const u32x4*)(OG + PART + (size_t)R1 * DM + col), cc = *(const u32x4*)(OG + 2 * PART + (size_t)R2 * DM + col);
            const u32x4 zz = *(const u32x4*)(Z + (size_t)m * DM + col);
#define CMB(F, I) { v[j][I] = (e0 * bflo(a.F) + e1 * bflo(bb.F) + e2 * bflo(cc.F)) * silu_f(bflo(zz.F)); v[j][I + 1] = (e0 * bfhi(a.F) + e1 * bfhi(bb.F) + e2 * bfhi(cc.F)) * silu_f(bfhi(zz.F)); \
                    am = fmaxf(am, fmaxf(fabsf(v[j][I]), fabsf(v[j][I + 1]))); sq += v[j][I] * v[j][I] + v[j][I + 1] * v[j][I + 1]; }
            CMB(x, 0) CMB(y, 2) CMB(z, 4) CMB(w, 6)
#undef CMB
        }
#if !OUTA_I8
        { bf16_t* Gr = (bf16_t*)(P.ws + WS_G) + (size_t)m * DM;
#pragma unroll
          for (int j = 0; j < 4; ++j) { u32x4 o; o.x = cvt_pk_bf16(v[j][0], v[j][1]); o.y = cvt_pk_bf16(v[j][2], v[j][3]); o.z = cvt_pk_bf16(v[j][4], v[j][5]); o.w = cvt_pk_bf16(v[j][6], v[j][7]); *(u32x4*)(Gr + 8 * lane + 512 * j) = o; }
          continue; }
#endif
        am = wave_max(am); sq = wave_sum(sq);
        am = fminf(am, GCLIP * sqrtf(sq * (1.f / DM)));
        const float inv = am > 0.f ? 127.f / am : 0.f;
        if (lane == 0) RS[m] = am > 0.f ? am * (1.f / 127.f) : 1.f;
#pragma unroll
        for (int j = 0; j < 4; ++j) { unsigned w0 = 0, w1 = 0;
#pragma unroll
            for (int e = 0; e < 4; ++e) { w0 |= ((unsigned)(int)rintf(fminf(fmaxf(v[j][e] * inv, -127.f), 127.f)) & 0xffu) << (8 * e); w1 |= ((unsigned)(int)rintf(fminf(fmaxf(v[j][4 + e] * inv, -127.f), 127.f)) & 0xffu) << (8 * e); }
            *(u32x2*)(GQ + (size_t)m * DM + 8 * lane + 512 * j) = (u32x2){w0, w1}; }
    }
}
__device__ __forceinline__ void attn_b_naive(unsigned char* lds, int wv) {
    CParams& P = PP();
    const int tid_ = otid(wv); const int lane = tid_ & 63, wave = __builtin_amdgcn_readfirstlane(tid_ >> 6);
    float* qf = (float*)(lds + wave * 8192); float* sc = qf + 128;
    const bf16_t* QKV = (const bf16_t*)(P.ws + WS_QKV); const bf16_t* Z = (const bf16_t*)(P.ws + WS_Z); bf16_t* G = (bf16_t*)(P.ws + WS_G); const float* KS = (const float*)(P.ws + WS_KSUM);
    const int gw = obid() * 8 + wave, NGW = gridDim.x * 8;
    for (int it = gw; it < MTOK * NH; it += NGW) {
        const int h = it & 15, m = it >> 4, b = m >> 11, t = m & 2047, n = t >> 8;
        const bf16_t* Qp = QKV + (size_t)m * DM + h * HD;
        float q0, q1; { const unsigned w = *(const unsigned*)(Qp + 2 * lane); q0 = bflo(w); q1 = bfhi(w); qf[2 * lane] = q0; qf[2 * lane + 1] = q1; }
        LDS_WAIT();
        float gt[8];
#pragma unroll
        for (int j = 0; j < 8; ++j) { float v = 0.f;
            if (j < n) { const float* k0 = KS + (size_t)(b * 8 + j) * DM + h * HD + 2 * lane; const float* k1 = k0 + (size_t)32 * DM; v = q0 * (k0[0] + k1[0]) + q1 * (k0[1] + k1[1]); }
            gt[j] = wave_sum(v); }
        int mask = 0;
#pragma unroll
        for (int j = 0; j < 8; ++j) { if (j < n) { int rank = 0;
#pragma unroll
                for (int j2 = 0; j2 < 8; ++j2) if (j2 < n && (gt[j2] > gt[j] || (gt[j2] == gt[j] && j2 < j))) ++rank;
                if (rank < 3) mask |= 1 << j; } }
        float o0, o1, lse2;
        naive_attend(QKV + PART + h * HD, QKV + 2 * PART + h * HD, qf, sc, (b << 11) + (n << 8), (t & 255) + 1, b << 11, mask, m, slope_of(h) * LOG2E, lane, o0, o1, lse2);
        const unsigned zw = *(const unsigned*)(Z + (size_t)m * DM + h * HD + 2 * lane);
        *(unsigned*)(G + (size_t)m * DM + h * HD + 2 * lane) = cvt_pk_bf16(o0 * silu_f(bflo(zw)), o1 * silu_f(bfhi(zw)));
    }
}

namespace fa {
constexpr int KVBLK = 64, SHM_K = KVBLK * HD * 2, SHM_V = KVBLK * HD * 2;
constexpr int OFF_V = 0, OFF_K = 2 * SHM_V, OFF_WS = OFF_K + 2 * SHM_K, OFF_OST = OFF_WS + 8 * 256, OST_ROW = 272, OST_WAVE = 32 * OST_ROW;
constexpr int OFF_GK = OFF_OST + 8 * OST_WAVE, OFF_SEL = OFF_GK + 7 * 128 * 4, OFF_END = OFF_SEL + 256 * 4;
static_assert(OFF_END <= LDS_BYTES - 1024, "attention LDS map");
constexpr float THR = 11.5f;
#define KSWZ(row, colB) ((row) * 256 + ((colB) ^ (((row) & 7) << 4)))
#define SBAR() __builtin_amdgcn_sched_barrier(0)
__device__ __forceinline__ int v_st(int k, int c) { const int kk = (k & ~0xC) | ((k & 4) << 1) | ((k & 8) >> 1); return ((kk >> 3) * 4 + (c >> 5)) * 512 + ((kk & 7) * 32 + (c & 31)) * 2; }
__device__ __forceinline__ int v_rd_base(int lane) { return ((lane & 3) << 3) | (((lane >> 2) & 3) << 6) | (((lane >> 4) & 1) << 5) | (((lane >> 5) & 1) << 8); }
constexpr int v_rd_off(int d0, int ks, int half) { return d0 * 512 + ks * 4096 + half * 2048; }
__device__ __forceinline__ int crow(int r, int hi) { return (r & 3) + 8 * (r >> 2) + 4 * hi; }
__device__ __forceinline__ void mask_tile(f32x16& p0, f32x16& p1, int dq, unsigned W) {
    const float NEG = -__builtin_inff();
#pragma unroll
    for (int r = 0; r < 16; ++r) { const int c = (r & 3) + 8 * (r >> 2);
        if ((unsigned)(dq - c) >= W) p0[r] = NEG;
        if ((unsigned)(dq - c - 32) >= W) p1[r] = NEG; }
}
__device__ __forceinline__ void partialSM(f32x16& p0, f32x16& p1, float& m_reg, float& alpha) {
    float pmax = p0[0];
#pragma unroll
    for (int r = 1; r < 16; ++r) pmax = fmaxf(pmax, p0[r]);
#pragma unroll
    for (int r = 0; r < 16; ++r) pmax = fmaxf(pmax, p1[r]);
    { auto rr = __builtin_amdgcn_permlane32_swap(__float_as_uint(pmax), __float_as_uint(pmax), false, false); pmax = fmaxf(__uint_as_float(rr[0]), __uint_as_float(rr[1])); }
    float mn;
    if (__builtin_expect(__all(pmax - m_reg <= THR), 1)) { mn = m_reg; alpha = 1.f; }
    else { mn = fmaxf(m_reg, pmax); alpha = __builtin_amdgcn_exp2f(m_reg - mn); m_reg = mn; }
#pragma unroll
    for (int r = 0; r < 16; ++r) p0[r] = __builtin_amdgcn_exp2f(p0[r] - mn);
#pragma unroll
    for (int r = 0; r < 16; ++r) p1[r] = __builtin_amdgcn_exp2f(p1[r] - mn);
}
__device__ __forceinline__ void finishSM(f32x16& p0, f32x16& p1, float alpha, float& l_reg, bf16x8& pa0, bf16x8& pa1, bf16x8& pa2, bf16x8& pa3) {
    float ps = 0;
#pragma unroll
    for (int r = 0; r < 16; ++r) ps += p0[r];
#pragma unroll
    for (int r = 0; r < 16; ++r) ps += p1[r];
    { auto rr = __builtin_amdgcn_permlane32_swap(__float_as_uint(ps), __float_as_uint(ps), false, false); ps = __uint_as_float(rr[0]) + __uint_as_float(rr[1]); }
    l_reg = l_reg * alpha + ps;
#define PK4(P, B_, OUT) do { unsigned a0 = cvt_pk_bf16(P[B_+0], P[B_+1]), a1 = cvt_pk_bf16(P[B_+2], P[B_+3]);                          \
        unsigned b0 = cvt_pk_bf16(P[B_+4], P[B_+5]), b1 = cvt_pk_bf16(P[B_+6], P[B_+7]);                                             \
        auto r0 = __builtin_amdgcn_permlane32_swap(a0, b0, false, false); auto r1 = __builtin_amdgcn_permlane32_swap(a1, b1, false, false); \
        u32x4 w = {r0[0], r1[0], r0[1], r1[1]}; OUT = *reinterpret_cast<bf16x8*>(&w); } while (0)
    PK4(p0, 0, pa0); PK4(p0, 8, pa1); PK4(p1, 0, pa2); PK4(p1, 8, pa3);
#undef PK4
}
template <int KB>
__device__ __forceinline__ void qkt(f32x16& p0, f32x16& p1, const LAS char* K_lds, int r32, int hi, const bf16x8* qr) {
    const LAS char* kb[4];
#pragma unroll
    for (int dd = 0; dd < 4; ++dd) kb[dd] = K_lds + KB * SHM_K + KSWZ(r32, (dd * 16 + hi * 8) * 2);
#pragma unroll
    for (int d0 = 0; d0 < 8; ++d0) { const LAS char* a = kb[d0 & 3] + (d0 >> 2) * 128;
        const bf16x8 b0 = *reinterpret_cast<const LAS bf16x8*>(a);
        const bf16x8 b1 = *reinterpret_cast<const LAS bf16x8*>(a + 32 * 256);
        p0 = __builtin_amdgcn_mfma_f32_32x32x16_bf16(b0, qr[d0], p0, 0, 0, 0);
        p1 = __builtin_amdgcn_mfma_f32_32x32x16_bf16(b1, qr[d0], p1, 0, 0, 0); }
}
template <int VB>
__device__ __forceinline__ void pv_tile(f32x16* o, int vb0, bf16x8 pa0, bf16x8 pa1, bf16x8 pa2, bf16x8 pa3) {
#define TRRD(dst, off) asm volatile("ds_read_b64_tr_b16 %0, %1 offset:%2" : "=&v"(dst) : "v"(vb0), "i"(off) : "memory")
#define PV_D0(d0) do { s16x4 l0, l1, l2, l3, h0, h1, h2, h3; constexpr int b_ = VB * SHM_V + v_rd_off(d0, 0, 0); \
        TRRD(l0, b_); TRRD(h0, b_ + 2048); TRRD(l1, b_ + 4096); TRRD(h1, b_ + 6144); TRRD(l2, b_ + 8192); TRRD(h2, b_ + 10240); TRRD(l3, b_ + 12288); TRRD(h3, b_ + 14336); \
        asm volatile("s_waitcnt lgkmcnt(0)" ::: "memory"); SBAR();   \
        o[d0] = __builtin_amdgcn_mfma_f32_32x32x16_bf16(pa0, (bf16x8){l0[0], l0[1], l0[2], l0[3], h0[0], h0[1], h0[2], h0[3]}, o[d0], 0, 0, 0);   \
        o[d0] = __builtin_amdgcn_mfma_f32_32x32x16_bf16(pa1, (bf16x8){l1[0], l1[1], l1[2], l1[3], h1[0], h1[1], h1[2], h1[3]}, o[d0], 0, 0, 0);   \
        o[d0] = __builtin_amdgcn_mfma_f32_32x32x16_bf16(pa2, (bf16x8){l2[0], l2[1], l2[2], l2[3], h2[0], h2[1], h2[2], h2[3]}, o[d0], 0, 0, 0);   \
        o[d0] = __builtin_amdgcn_mfma_f32_32x32x16_bf16(pa3, (bf16x8){l3[0], l3[1], l3[2], l3[3], h3[0], h3[1], h3[2], h3[3]}, o[d0], 0, 0, 0); } while (0)
    PV_D0(0); PV_D0(1); PV_D0(2); PV_D0(3);
#undef PV_D0
#undef TRRD
}

template <int MODE, class MK>
__device__ __forceinline__ void flash_block(const bf16_t* Q, const bf16_t* K, const bf16_t* V, int krow0, int NT, int qrow0, float slopeL, const MK& mk,
                                            unsigned char* lds, bf16_t* Og, float* Lse, const bf16_t* Zg, int tid) {
    const int wid = __builtin_amdgcn_readfirstlane(tid >> 6), lane = tid & 63, r32 = lane & 31, hi = lane >> 5;
    const LAS char* K_lds = (const LAS char*)(LAS unsigned char*)lds + OFF_K;
    LAS char* Kw = (LAS char*)(LAS unsigned char*)lds + OFF_K; LAS char* Vw = (LAS char*)(LAS unsigned char*)lds + OFF_V;
    LAS float* wsf = (LAS float*)((LAS unsigned char*)lds + OFF_WS) + wid * 64; LAS float* li_l = wsf; LAS float* al_l = wsf + 32;
    const int sr = tid >> 4, sc = (tid & 15) * 8, vst0 = v_st(sr, sc), vst1 = v_st(32 + sr, sc), kws = KSWZ(sr, sc * 2);
    const int vb0 = (int)(unsigned)(uintptr_t)((LAS unsigned char*)lds) + OFF_V + v_rd_base(lane);
    const int qlo = qrow0 + wid * 32, qm = qlo + r32 - 4 * hi;
    bf16x8 st_k0, st_k1, st_v0, st_v1;
#define SLOAD(kb_) do { const size_t o0_ = (size_t)((kb_) + sr) * DM + sc, o1_ = o0_ + (size_t)32 * DM; \
        st_v0 = *(const bf16x8*)(V + o0_); st_v1 = *(const bf16x8*)(V + o1_); st_k0 = *(const bf16x8*)(K + o0_); st_k1 = *(const bf16x8*)(K + o1_); } while (0)
#define SWRITE(bf) do { *(LAS bf16x8*)(Vw + (bf) * SHM_V + vst0) = st_v0; *(LAS bf16x8*)(Vw + (bf) * SHM_V + vst1) = st_v1; \
        *(LAS bf16x8*)(Kw + (bf) * SHM_K + kws) = st_k0; *(LAS bf16x8*)(Kw + (bf) * SHM_K + kws + 32 * 256) = st_k1; } while (0)
    bf16x8 qr[8];
#pragma unroll
    for (int d0 = 0; d0 < 8; ++d0) qr[d0] = *(const bf16x8*)(Q + (size_t)(wid * 32 + r32) * DM + d0 * 16 + hi * 8);
    SLOAD(krow0); asm volatile("s_waitcnt vmcnt(0)" ::: "memory"); SWRITE(0);
    __syncthreads();
    float m_reg = -1e30f, l_reg = 0.f; f32x16 o[4] = {};
#define STEP(t, KB) do { const int kb_ = krow0 + (t) * KVBLK;                                                                   \
        if ((t) + 1 < NT) SLOAD(kb_ + KVBLK);                                                                                     \
        bool act_, need_; unsigned W_; mk.info(kb_, qlo, r32, act_, need_, W_);                                                 \
        if (act_) { f32x16 p0, p1; const float a0_ = slopeL * (float)(kb_ - qm);                                                  \
            _Pragma("unroll") for (int r = 0; r < 16; ++r) { p0[r] = fmaf(slopeL, (float)((r & 3) + 8 * (r >> 2)), a0_); p1[r] = p0[r] + 32.f * slopeL; } \
            qkt<KB>(p0, p1, K_lds, r32, hi, qr);                                                                                  \
            if (need_) mask_tile(p0, p1, qm - kb_, W_);                                                                           \
            float alpha_; partialSM(p0, p1, m_reg, alpha_);                                                                       \
            bf16x8 pa0, pa1, pa2, pa3; finishSM(p0, p1, alpha_, l_reg, pa0, pa1, pa2, pa3);                                       \
            if (__any(alpha_ < 1.f)) { if (hi == 0) al_l[r32] = alpha_; LDS_WAIT();                                               \
                _Pragma("unroll") for (int d_ = 0; d_ < 4; ++d_) _Pragma("unroll") for (int r = 0; r < 16; ++r) o[d_][r] *= al_l[crow(r, hi)]; } \
            SBAR(); pv_tile<KB>(o, vb0, pa0, pa1, pa2, pa3); }                                                                    \
        if ((t) + 1 < NT) { asm volatile("s_waitcnt vmcnt(0)" ::: "memory"); SWRITE((KB) ^ 1); }                               \
        __syncthreads(); } while (0)
    for (int t = 0; t < NT; t += 2) { STEP(t, 0); STEP(t + 1, 1); }
#undef STEP
#undef SLOAD
#undef SWRITE
    if (hi == 0) li_l[r32] = l_reg;
    LDS_WAIT();
    LAS unsigned char* stg = (LAS unsigned char*)lds + OFF_OST + wid * OST_WAVE;
#pragma unroll
    for (int r = 0; r < 16; ++r) { const int orow = crow(r, hi); const float rl = __builtin_amdgcn_rcpf(li_l[orow]);
#pragma unroll
        for (int d0 = 0; d0 < 4; ++d0) *(LAS unsigned short*)(stg + orow * OST_ROW + (d0 * 32 + r32) * 2) = (unsigned short)(cvt_pk_bf16(o[d0][r] * rl, 0.f) & 0xffffu); }
    LDS_WAIT();
    if (MODE == 0) { if (hi == 0) Lse[(size_t)(qlo + r32) * NH] = m_reg + log2f(l_reg); }
#pragma unroll
    for (int i = 0; i < 8; ++i) { const int row = i * 4 + (lane >> 4), ch = lane & 15;
        u32x4 v = *(const LAS u32x4*)(stg + row * OST_ROW + ch * 16);
        const size_t go = (size_t)(qlo + row) * DM + ch * 8;
        if (MODE == 1) { const u32x4 z = *(const u32x4*)(Zg + go);
            v.x = cvt_pk_bf16(bflo(v.x) * silu_f(bflo(z.x)), bfhi(v.x) * silu_f(bfhi(z.x))); v.y = cvt_pk_bf16(bflo(v.y) * silu_f(bflo(z.y)), bfhi(v.y) * silu_f(bfhi(z.y)));
            v.z = cvt_pk_bf16(bflo(v.z) * silu_f(bflo(z.z)), bfhi(v.z) * silu_f(bfhi(z.z))); v.w = cvt_pk_bf16(bflo(v.w) * silu_f(bflo(z.w)), bfhi(v.w) * silu_f(bfhi(z.w))); }
        *(u32x4*)(Og + go) = v; }
    LDS_WAIT();
}
struct MaskA {
    int L;
    __device__ __forceinline__ void info(int kb, int qlo, int r32, bool& act, bool& need, unsigned& W) const {
        const int seq0 = qlo & ~(L - 1); int lowk = qlo - 128; if (lowk < seq0) lowk = seq0;
        act = (kb <= qlo + 31) && (kb + KVBLK - 1 >= lowk); need = true;
        const int wl = qlo + r32 - seq0 + 1; W = (unsigned)(wl < 129 ? wl : 129);
    }
};
struct MaskB {
    int own0, base0; unsigned sel;
    __device__ __forceinline__ void info(int kb, int qlo, int r32, bool& act, bool& need, unsigned& W) const {
        if (kb >= own0) { act = kb <= qlo + 31; need = kb + KVBLK - 1 > qlo; W = 0x40000000u; }
        else { const int blk = (kb - base0) >> 8; const bool s = (sel >> blk) & 1u; const unsigned long long bal = __ballot(s);
            act = bal != 0ull; need = bal != ~0ull; W = s ? 0x40000000u : 0u; }
    }
};
#undef KSWZ
#undef SBAR
}

namespace fb {
using namespace fa;
#define KSWZ(row, colB) ((row) * 256 + ((colB) ^ (((row) & 7) << 4)))
#define SBAR() __builtin_amdgcn_sched_barrier(0)
struct Blk {
    unsigned qoff, koff, voff;
    unsigned ooff, xoff;
    int R0, kb0, NT;
    float slopeL;
    int L, base0;
};
struct Nxt { unsigned qoff, koff, voff; int kb0; };
struct Seam { bf16x8 qr[8]; bf16x8 st_v0, st_v1, st_k0, st_k1; };
__device__ __forceinline__ void tile_info(const Blk& c, int kb, int qlo, int r32, unsigned sel, bool& act, bool& need, unsigned& W) {
    if (c.L > 0) { const int seq0 = qlo & ~(c.L - 1); int lowk = qlo - 128; if (lowk < seq0) lowk = seq0;
        act = (kb <= qlo + 31) && (kb + KVBLK - 1 >= lowk); need = true; const int wl = qlo + r32 - seq0 + 1; W = (unsigned)(wl < 129 ? wl : 129); }
    else if (kb >= c.R0) { act = kb <= qlo + 31; need = kb + KVBLK - 1 > qlo; W = 0x40000000u; }
    else { const int blk = (kb - c.base0) >> 8; const bool sb = (sel >> blk) & 1u; const unsigned long long bal = __ballot(sb);
        act = bal != 0ull; need = bal != ~0ull; W = sb ? 0x40000000u : 0u; }
}
template <int KB>
__device__ __forceinline__ void qkt2(f32x16& p0, f32x16& p1, const LAS char* K_lds, int r32, int hi, const bf16x8* qr, bool act, float slopeL, float a0) {
    if (!act) { const float NEG = -__builtin_inff();
#pragma unroll
        for (int r = 0; r < 16; ++r) { p0[r] = NEG; p1[r] = NEG; } return; }
#pragma unroll
    for (int r = 0; r < 16; ++r) { p0[r] = fmaf(slopeL, (float)((r & 3) + 8 * (r >> 2)), a0); p1[r] = fmaf(slopeL, (float)((r & 3) + 8 * (r >> 2) + 32), a0); }
    qkt<KB>(p0, p1, K_lds, r32, hi, qr);
}
#define ROWP(off, k0, rr) (wsb + ((size_t)(off) + (size_t)(k0) * (DM * 2)) + (unsigned)(((rr) * DM + sc) * 2))
#define VMW() asm volatile("s_waitcnt vmcnt(0)" ::: "memory")
#define SLOAD_H(Kp, Vp, k0) do { S.st_v0 = *(const bf16x8*)ROWP(Vp, k0, sr); S.st_v1 = *(const bf16x8*)ROWP(Vp, k0, 32 + sr); \
                                 S.st_k0 = *(const bf16x8*)ROWP(Kp, k0, sr); S.st_k1 = *(const bf16x8*)ROWP(Kp, k0, 32 + sr); } while (0)
#define SWRITE_HK(bf) do { *(LAS bf16x8*)(Kw + (bf) * SHM_K + kws) = S.st_k0; *(LAS bf16x8*)(Kw + (bf) * SHM_K + kws + 32 * 256) = S.st_k1; } while (0)
#define SWRITE_HV(bf) do { *(LAS bf16x8*)(Vw + (bf) * SHM_V + vst0) = S.st_v0; *(LAS bf16x8*)(Vw + (bf) * SHM_V + vst1) = S.st_v1; } while (0)
#define SWRITE_H(bf) do { SWRITE_HV(bf); SWRITE_HK(bf); } while (0)
__device__ __forceinline__ void prime(const unsigned char* wsb, const Blk& cur, unsigned char* lds, Seam& S, int tid) {
    const int wid = __builtin_amdgcn_readfirstlane(tid >> 6), lane = tid & 63, r32 = lane & 31, hi = lane >> 5;
    const int sr = tid >> 4, sc = (tid & 15) * 8, kws = KSWZ(sr, sc * 2);
    LAS char* Kw = (LAS char*)(LAS unsigned char*)lds + OFF_K;
#pragma unroll
    for (int d0 = 0; d0 < 8; ++d0) S.qr[d0] = *(const bf16x8*)(wsb + (size_t)cur.qoff + (unsigned)(((wid * 32 + r32) * DM + d0 * 16 + hi * 8) * 2));
    SLOAD_H(cur.koff, cur.voff, cur.kb0); VMW(); SWRITE_HK(0);
    __syncthreads();
}
template <int MODE>
__device__ __forceinline__ void block(const unsigned char* wsb, const Blk& cur, const Nxt& nxt, unsigned sel, unsigned char* lds, Seam& S, int tid) {
    const int wid = __builtin_amdgcn_readfirstlane(tid >> 6), lane = tid & 63, r32 = lane & 31, hi = lane >> 5;
    const LAS char* K_lds = (const LAS char*)(LAS unsigned char*)lds + OFF_K;
    LAS char* Kw = (LAS char*)(LAS unsigned char*)lds + OFF_K; LAS char* Vw = (LAS char*)(LAS unsigned char*)lds + OFF_V;
    LAS float* wsf = (LAS float*)((LAS unsigned char*)lds + OFF_WS) + wid * 64; LAS float* li_l = wsf; LAS float* al_l = wsf + 32;
    const int sr = tid >> 4, sc = (tid & 15) * 8, vst0 = v_st(sr, sc), vst1 = v_st(32 + sr, sc), kws = KSWZ(sr, sc * 2);
    const int vb0 = (int)(unsigned)(uintptr_t)((LAS unsigned char*)lds) + OFF_V + v_rd_base(lane);
    const int NT = cur.NT, qlo = cur.R0 + wid * 32, qm = qlo + r32 - 4 * hi;
    const float slopeL = cur.slopeL;
    const unsigned Kh = cur.koff, Vh = cur.voff;
    float m_reg = -1e30f, l_reg = 0.f; f32x16 o[4] = {};
#define KBASE(t) (cur.kb0 + (t) * KVBLK)
#define RESC(a) do { if (__any((a) < 1.f)) { if (hi == 0) al_l[r32] = (a); LDS_WAIT(); \
        _Pragma("unroll") for (int d_ = 0; d_ < 4; ++d_) _Pragma("unroll") for (int r = 0; r < 16; ++r) o[d_][r] *= al_l[crow(r, hi)]; } } while (0)
#define QKT(PX0, PX1, t, KB, ACTV) do { const int kb_ = KBASE(t); bool nd_; unsigned W_; tile_info(cur, kb_, qlo, r32, sel, ACTV, nd_, W_); \
        qkt2<KB>(PX0, PX1, K_lds, r32, hi, S.qr, ACTV, slopeL, slopeL * (float)(kb_ - qm)); } while (0)
#define MASKT(PX0, PX1, t) do { const int kb_ = KBASE(t); bool ac_, nd_; unsigned W_; tile_info(cur, kb_, qlo, r32, sel, ac_, nd_, W_); \
        if (ac_ && nd_) mask_tile(PX0, PX1, qm - kb_, W_); } while (0)
    f32x16 pA0, pA1, pB0, pB1; float alA, alB; bf16x8 pa0, pa1, pa2, pa3; bool actA, actB;
    SWRITE_HV(0); SBAR();
    SLOAD_H(Kh, Vh, KBASE(1));
    SBAR(); QKT(pA0, pA1, 0, 0, actA);
    MASKT(pA0, pA1, 0); partialSM(pA0, pA1, m_reg, alA);
    VMW(); SWRITE_H(1);
    __syncthreads();
#define HALF_STEP(PX0, PX1, alX, actX, PY0, PY1, alY, actY, t, KB, VB, SB) do {                                                 \
        SBAR(); QKT(PX0, PX1, t, KB, actX);                                                                                   \
        finishSM(PY0, PY1, alY, l_reg, pa0, pa1, pa2, pa3); SBAR();                                                           \
        if ((t) + 1 < NT) { SLOAD_H(Kh, Vh, KBASE((t) + 1)); SBAR(); }                                                        \
        if (actY) pv_tile<VB>(o, vb0, pa0, pa1, pa2, pa3);                                                                    \
        MASKT(PX0, PX1, (t)); partialSM(PX0, PX1, m_reg, alX);                                                                \
        __syncthreads();                                                                                                      \
        if ((t) + 1 < NT) { VMW(); SWRITE_H(SB); }                                                                            \
        RESC(alX); __syncthreads(); } while (0)
    for (int t = 1; t + 1 < NT; t += 2) {
        HALF_STEP(pB0, pB1, alB, actB, pA0, pA1, alA, actA, t, 1, 0, 0);
        HALF_STEP(pA0, pA1, alA, actA, pB0, pB1, alB, actB, t + 1, 0, 1, 1);
    }
    SBAR(); QKT(pB0, pB1, NT - 1, 1, actB); SBAR();
    SLOAD_H(nxt.koff, nxt.voff, nxt.kb0); SBAR();
#pragma unroll
    for (int d0 = 0; d0 < 8; ++d0) S.qr[d0] = *(const bf16x8*)(wsb + (size_t)nxt.qoff + (unsigned)(((wid * 32 + r32) * DM + d0 * 16 + hi * 8) * 2));
    SBAR();
    finishSM(pA0, pA1, alA, l_reg, pa0, pa1, pa2, pa3); SBAR();
    if (actA) pv_tile<0>(o, vb0, pa0, pa1, pa2, pa3);
    MASKT(pB0, pB1, NT - 1); partialSM(pB0, pB1, m_reg, alB); __syncthreads(); RESC(alB);
    finishSM(pB0, pB1, alB, l_reg, pa0, pa1, pa2, pa3); SBAR();
    if (actB) pv_tile<1>(o, vb0, pa0, pa1, pa2, pa3);
    SBAR(); asm volatile("s_waitcnt vmcnt(8)" ::: "memory"); SWRITE_HK(0); SBAR();
    int tid2 = tid; asm volatile("" : "+v"(tid2));
    const int lane2 = tid2 & 63, r32e = lane2 & 31, hie = lane2 >> 5;
    if (hie == 0) li_l[r32e] = l_reg;
    LDS_WAIT();
    LAS unsigned char* stg = (LAS unsigned char*)lds + OFF_OST + wid * OST_WAVE;
#pragma unroll
    for (int r = 0; r < 16; ++r) { const int orow = crow(r, hie); const float rl = __builtin_amdgcn_rcpf(li_l[orow]);
#pragma unroll
        for (int d0 = 0; d0 < 4; ++d0) *(LAS unsigned short*)(stg + orow * OST_ROW + (d0 * 32 + r32e) * 2) = (unsigned short)(cvt_pk_bf16(o[d0][r] * rl, 0.f) & 0xffffu); }
    LDS_WAIT();
    if (MODE == 0) { if (hie == 0) *(float*)(const_cast<unsigned char*>(wsb) + (size_t)cur.xoff + (unsigned)((qlo + r32e) * NH * 4)) = m_reg + log2f(l_reg); }
#pragma unroll
    for (int i = 0; i < 8; ++i) { const int row = i * 4 + (lane2 >> 4), ch = lane2 & 15;
        u32x4 v = *(const LAS u32x4*)(stg + row * OST_ROW + ch * 16);
        const unsigned go = (unsigned)(((qlo + row) * DM + ch * 8) * 2);
        if (MODE == 1) { const u32x4 z = *(const u32x4*)(wsb + (size_t)cur.xoff + go);
            v.x = cvt_pk_bf16(bflo(v.x) * silu_f(bflo(z.x)), bfhi(v.x) * silu_f(bfhi(z.x))); v.y = cvt_pk_bf16(bflo(v.y) * silu_f(bflo(z.y)), bfhi(v.y) * silu_f(bfhi(z.y)));
            v.z = cvt_pk_bf16(bflo(v.z) * silu_f(bflo(z.z)), bfhi(v.z) * silu_f(bfhi(z.z))); v.w = cvt_pk_bf16(bflo(v.w) * silu_f(bflo(z.w)), bfhi(v.w) * silu_f(bfhi(z.w))); }
        *(u32x4*)(const_cast<unsigned char*>(wsb) + (size_t)cur.ooff + go) = v; }
    __syncthreads();
#undef KBASE
#undef RESC
#undef QKT
#undef MASKT
#undef HALF_STEP
}
#undef ROWP
#undef VMW
#undef SLOAD_H
#undef SWRITE_HK
#undef SWRITE_HV
#undef SWRITE_H
#undef KSWZ
#undef SBAR
}

namespace fc {
using namespace fa;
constexpr int NSLOT = 3;
constexpr int R_K = 0, R_V = NSLOT * SHM_K, R_WS = R_V + NSLOT * SHM_V, WSW = 96, R_OST = R_WS + 8 * WSW * 4, OSTR = 144, OSTW = 32 * OSTR;
constexpr int R_GK = R_OST + 8 * OSTW, R_SEL = R_GK + 2 * 7 * 128 * 4, R_END = R_SEL + 256 * 4;
static_assert(R_END <= LDS_BYTES - 64, "attention LDS map");
#define KSWZ(row, colB) ((row) * 256 + ((colB) ^ (((row) & 7) << 4)))
#define SBAR() __builtin_amdgcn_sched_barrier(0)
struct Blk {
    unsigned qoff, koff, voff, ooff, xoff;
    unsigned zoff, goff;
    int R0, kb0, NT;
    float slopeL;
    int L, base0;
};
struct Nxt { unsigned qoff, koff, voff; int kb0; };
__device__ __forceinline__ void glds16(const void* sbase, unsigned voff, unsigned lds_dst) { unsigned keep;
    asm volatile("s_mov_b32 %0, m0\n\ts_mov_b32 m0, %3\n\ts_nop 0\n\tglobal_load_lds_dwordx4 %1, %2\n\ts_mov_b32 m0, %0" : "=&s"(keep) : "v"(voff), "s"(sbase), "s"(lds_dst) : "memory"); }
__device__ __forceinline__ void qkt_r(f32x16& p0, f32x16& p1, const LAS char* Kslot, int r32, int hi, const bf16x8* qr) {
    const LAS char* kb[4];
#pragma unroll
    for (int dd = 0; dd < 4; ++dd) kb[dd] = Kslot + KSWZ(r32, (dd * 16 + hi * 8) * 2);
    bf16x8 c0 = *reinterpret_cast<const LAS bf16x8*>(kb[0]), c1 = *reinterpret_cast<const LAS bf16x8*>(kb[0] + 32 * 256);
#pragma unroll
    for (int d0 = 0; d0 < 8; ++d0) {
        bf16x8 n0 = c0, n1 = c1;
        if (d0 < 7) { const LAS char* a = kb[(d0 + 1) & 3] + ((d0 + 1) >> 2) * 128; n0 = *reinterpret_cast<const LAS bf16x8*>(a); n1 = *reinterpret_cast<const LAS bf16x8*>(a + 32 * 256); }
        p0 = __builtin_amdgcn_mfma_f32_32x32x16_bf16(c0, qr[d0], p0, 0, 0, 0);
        p1 = __builtin_amdgcn_mfma_f32_32x32x16_bf16(c1, qr[d0], p1, 0, 0, 0);
        c0 = n0; c1 = n1; }
}
__device__ __forceinline__ void pv_r(f32x16* o, int vb, bf16x8 pa0, bf16x8 pa1, bf16x8 pa2, bf16x8 pa3) {
#define TRRD(dst, off) asm volatile("ds_read_b64_tr_b16 %0, %1 offset:%2" : "=&v"(dst) : "v"(vb), "i"(off) : "memory")
#define PV_D0(d0) do { s16x4 l0, l1, l2, l3, h0, h1, h2, h3; constexpr int b_ = v_rd_off(d0, 0, 0); \
        TRRD(l0, b_); TRRD(h0, b_ + 2048); TRRD(l1, b_ + 4096); TRRD(h1, b_ + 6144); TRRD(l2, b_ + 8192); TRRD(h2, b_ + 10240); TRRD(l3, b_ + 12288); TRRD(h3, b_ + 14336); \
        asm volatile("s_waitcnt lgkmcnt(0)" ::: "memory"); SBAR();   \
        o[d0] = __builtin_amdgcn_mfma_f32_32x32x16_bf16(pa0, (bf16x8){l0[0], l0[1], l0[2], l0[3], h0[0], h0[1], h0[2], h0[3]}, o[d0], 0, 0, 0);   \
        o[d0] = __builtin_amdgcn_mfma_f32_32x32x16_bf16(pa1, (bf16x8){l1[0], l1[1], l1[2], l1[3], h1[0], h1[1], h1[2], h1[3]}, o[d0], 0, 0, 0);   \
        o[d0] = __builtin_amdgcn_mfma_f32_32x32x16_bf16(pa2, (bf16x8){l2[0], l2[1], l2[2], l2[3], h2[0], h2[1], h2[2], h2[3]}, o[d0], 0, 0, 0);   \
        o[d0] = __builtin_amdgcn_mfma_f32_32x32x16_bf16(pa3, (bf16x8){l3[0], l3[1], l3[2], l3[3], h3[0], h3[1], h3[2], h3[3]}, o[d0], 0, 0, 0); } while (0)
    PV_D0(0); PV_D0(1); PV_D0(2); PV_D0(3);
#undef PV_D0
#undef TRRD
}
__device__ __forceinline__ void tile_info(const Blk& c, int kb, int qlo, int r32, unsigned sel, bool& act, bool& need, unsigned& W, bool& dead) {
    dead = false;
    if (c.L > 0) { const int seq0 = qlo & ~(c.L - 1); int lowk = qlo - 128; if (lowk < seq0) lowk = seq0;
        act = (kb <= qlo + 31) && (kb + KVBLK - 1 >= lowk); need = true; const int wl = qlo + r32 - seq0 + 1; W = (unsigned)(wl < 129 ? wl : 129); }
    else if (kb >= c.R0) { act = kb <= qlo + 31; need = kb + KVBLK - 1 > qlo; W = 0x40000000u; }
    else { const int blk = (kb - c.base0) >> 8; const bool sb = (sel >> blk) & 1u; act = __ballot(sb) != 0ull; need = false; W = 0x40000000u; dead = !sb; }
}
struct Ring { int kt; };
__device__ __forceinline__ int nx3(int s) { return s == 2 ? 0 : s + 1; }
struct DmaLane { unsigned vk0, vk1, vv0, vv1; };
__device__ __forceinline__ DmaLane dma_lane(int wid, int lane) {
    DmaLane d;
    { const int row0 = wid * 8 + (lane >> 4), row1 = row0 + 4, cs = lane & 15;
      d.vk0 = (unsigned)(row0 * DM * 2 + ((cs ^ (row0 & 7)) * 16)); d.vk1 = (unsigned)(row1 * DM * 2 + ((cs ^ (row1 & 7)) * 16)); }
    { const int gi = lane & 31, kk = wid * 8 + (gi >> 2), k = (kk & ~0xC) | ((kk & 4) << 1) | ((kk & 8) >> 1);
      const int c0 = ((lane >> 5)) * 32 + (gi & 3) * 8, c1 = c0 + 64;
      d.vv0 = (unsigned)(k * DM * 2 + c0 * 2); d.vv1 = (unsigned)(k * DM * 2 + c1 * 2); }
    return d;
}
#define DMA_K(srcoff, kbrow, slot) do { const unsigned char* sb_ = wsb + ((size_t)(srcoff) + (size_t)(kbrow) * (DM * 2)); const unsigned ld_ = ldsb + R_K + (slot) * SHM_K + wid * 2048; \
        glds16(sb_, dl.vk0, ld_); glds16(sb_, dl.vk1, ld_ + 1024); } while (0)
#define DMA_V(srcoff, kbrow, slot) do { const unsigned char* sb_ = wsb + ((size_t)(srcoff) + (size_t)(kbrow) * (DM * 2)); const unsigned ld_ = ldsb + R_V + (slot) * SHM_V + wid * 2048; \
        glds16(sb_, dl.vv0, ld_); glds16(sb_, dl.vv1, ld_ + 1024); } while (0)
#define WAITBAR(N) asm volatile("s_waitcnt vmcnt(" #N ") lgkmcnt(0)\n\ts_barrier" ::: "memory")
__device__ __forceinline__ void prime(const unsigned char* wsb, const Blk& cur, unsigned char* lds, bf16x8* qr, Ring& rg, int tid) {
    const int wid = __builtin_amdgcn_readfirstlane(tid >> 6), lane = tid & 63, r32 = lane & 31, hi = lane >> 5;
    const unsigned ldsb = (unsigned)(uintptr_t)((LAS unsigned char*)lds);
    const DmaLane dl = dma_lane(wid, lane);
    DMA_K(cur.koff, cur.kb0, 0); DMA_V(cur.voff, cur.kb0, 0); DMA_K(cur.koff, cur.kb0 + KVBLK, 1);
#pragma unroll
    for (int d0 = 0; d0 < 8; ++d0) qr[d0] = *(const bf16x8*)(wsb + (size_t)cur.qoff + (unsigned)(((wid * 32 + r32) * DM + d0 * 16 + hi * 8) * 2));
    rg.kt = 0;
    WAITBAR(0);
}
template <int MODE>
__device__ __forceinline__ void block(const unsigned char* wsb, const Blk& cur, const Nxt& nxt, bool has_next, unsigned sel, unsigned char* lds, bf16x8* qr, Ring& rg, int tid) {
    const int wid = __builtin_amdgcn_readfirstlane(tid >> 6), lane = tid & 63, r32 = lane & 31, hi = lane >> 5;
    const unsigned ldsb = (unsigned)(uintptr_t)((LAS unsigned char*)lds);
    const LAS char* K_lds = (const LAS char*)(LAS unsigned char*)lds + R_K;
    LAS float* wsf = (LAS float*)((LAS unsigned char*)lds + R_WS) + wid * WSW; LAS float* li_l = wsf; LAS float* al_l = wsf + 32;
    const int vbl = (int)ldsb + R_V + v_rd_base(lane);
    const DmaLane dl = dma_lane(wid, lane);
    const int NT = cur.NT, qlo = cur.R0 + wid * 32, qm = qlo + r32 - 4 * hi;
    const float slopeL = cur.slopeL;
    float m_reg = -1e30f, l_reg = 0.f; f32x16 o[4] = {};
    int kt = rg.kt;
#define RESC(a) do { if (__any((a) < 1.f)) { if (hi == 0) al_l[r32] = (a); LDS_WAIT(); \
        _Pragma("unroll") for (int d_ = 0; d_ < 4; ++d_) _Pragma("unroll") for (int r = 0; r < 16; ++r) o[d_][r] *= al_l[crow(r, hi)]; } } while (0)
#define STEPX(PX0, PX1, alX, actX, PY0, PY1, alY, actY, t, HAVEY) do {                                                                \
        const int kb_ = cur.kb0 + (t) * KVBLK; bool nd_, dd_; unsigned W_; tile_info(cur, kb_, qlo, r32, sel, actX, nd_, W_, dd_);   \
        SBAR();                                                                                                                       \
        if (actX) { const float a0_ = dd_ ? -__builtin_inff() : slopeL * (float)(kb_ - qm);                                           \
            _Pragma("unroll") for (int r = 0; r < 16; ++r) { PX0[r] = fmaf(slopeL, (float)((r & 3) + 8 * (r >> 2)), a0_); PX1[r] = fmaf(slopeL, (float)((r & 3) + 8 * (r >> 2) + 32), a0_); } \
            qkt_r(PX0, PX1, K_lds + kt * SHM_K, r32, hi, qr);                                                                         \
            if (HAVEY) finishSM(PY0, PY1, alY, l_reg, pa0, pa1, pa2, pa3); }                                                          \
        else { _Pragma("unroll") for (int r = 0; r < 16; ++r) { PX0[r] = -__builtin_inff(); PX1[r] = -__builtin_inff(); }             \
            if (HAVEY) finishSM(PY0, PY1, alY, l_reg, pa0, pa1, pa2, pa3); }                                                          \
        SBAR();                                                                                                                       \
        { const int s2_ = kt == 0 ? 2 : kt - 1, s1_ = nx3(kt);                           \
          const bool in2_ = (t) + 2 < NT, in1_ = (t) + 1 < NT;                                                                        \
          if (in2_) DMA_K(cur.koff, kb_ + 2 * KVBLK, s2_); else if (has_next) DMA_K(nxt.koff, nxt.kb0 + ((t) + 2 - NT) * KVBLK, s2_);        \
          if (in1_) DMA_V(cur.voff, kb_ + KVBLK, s1_); else if (has_next) DMA_V(nxt.voff, nxt.kb0 + ((t) + 1 - NT) * KVBLK, s1_); }         \
        SBAR();                                                                                                                       \
        if (HAVEY) { if (actY) pv_r(o, vbl + (kt == 0 ? 2 : kt - 1) * SHM_V, pa0, pa1, pa2, pa3); }                                   \
        if (actX && nd_) mask_tile(PX0, PX1, qm - kb_, W_);                                                                           \
        partialSM(PX0, PX1, m_reg, alX);                                                                                              \
        RESC(alX);                                                                                                                    \
        if ((t) + 2 < NT || has_next) WAITBAR(4); else if ((t) + 1 < NT) WAITBAR(2); else WAITBAR(0);                                 \
        kt = nx3(kt); } while (0)
    f32x16 pA0, pA1, pB0, pB1; float alA = 1.f, alB = 1.f; bf16x8 pa0, pa1, pa2, pa3; bool actA = false, actB = false;
    STEPX(pA0, pA1, alA, actA, pB0, pB1, alB, actB, 0, false);
    STEPX(pB0, pB1, alB, actB, pA0, pA1, alA, actA, 1, true);
    for (int t = 2; t < NT; t += 2) {
        STEPX(pA0, pA1, alA, actA, pB0, pB1, alB, actB, t, true);
        STEPX(pB0, pB1, alB, actB, pA0, pA1, alA, actA, t + 1, true);
    }
    finishSM(pB0, pB1, alB, l_reg, pa0, pa1, pa2, pa3); SBAR();
    if (actB) pv_r(o, vbl + (kt == 0 ? 2 : kt - 1) * SHM_V, pa0, pa1, pa2, pa3);
    SBAR();
    if (has_next) {
#pragma unroll
        for (int d0 = 0; d0 < 8; ++d0) qr[d0] = *(const bf16x8*)(wsb + (size_t)nxt.qoff + (unsigned)(((wid * 32 + r32) * DM + d0 * 16 + hi * 8) * 2));
    }
    SBAR();
    rg.kt = kt;
    int tid2 = tid; asm volatile("" : "+v"(tid2));
    const int lane2 = tid2 & 63, r32e = lane2 & 31, hie = lane2 >> 5;
    unsigned char* wsw = const_cast<unsigned char*>(wsb);
    if (MODE == 2) {
        if (hie == 0) { const int R = qlo + r32e, bb = R >> 11, t = ((R & 127) << 4) | ((R >> 7) & 15), T0 = (bb << 11) + t, T1 = (bb << 11) + ((t & 3) << 9) + (t >> 2);
            const float l2 = m_reg + log2f(l_reg);
            const float l0 = *(const float*)(wsb + (size_t)cur.xoff + (unsigned)(T0 * NH * 4)), l1 = *(const float*)(wsb + (size_t)cur.xoff + (size_t)MTOK * NH * 4 + (unsigned)(T1 * NH * 4));
            const float mx = fmaxf(l0, fmaxf(l1, l2)); const float e0 = exp2f(l0 - mx), e1 = exp2f(l1 - mx), e2 = exp2f(l2 - mx), inv = 1.f / (e0 + e1 + e2);
            li_l[r32e] = e2 * inv / l_reg; al_l[r32e] = e0 * inv; al_l[32 + r32e] = e1 * inv; }
    } else { if (hie == 0) li_l[r32e] = 1.f / l_reg; }
    LDS_WAIT();
    if (MODE == 0) { if (hie == 0) *(float*)(wsw + (size_t)cur.xoff + (unsigned)((qlo + r32e) * NH * 4)) = m_reg + log2f(l_reg); }
    LAS unsigned char* stg = (LAS unsigned char*)lds + R_OST + wid * OSTW;
    float rl[16];
#pragma unroll
    for (int r = 0; r < 16; ++r) rl[r] = li_l[crow(r, hie)];
    u32x4 pg0[4], pg1[4], pzz[4]; unsigned tof[4];
#define PREF(hf_) do { _Pragma("unroll") for (int i = 0; i < 4; ++i) { const int row = i * 8 + (lane2 >> 3), ch = lane2 & 7; const unsigned cb = (unsigned)(((hf_) * 64 + ch * 8) * 2); \
            const int R = qlo + row, bb = R >> 11, t = ((R & 127) << 4) | ((R >> 7) & 15), T0 = (bb << 11) + t, T1 = (bb << 11) + ((t & 3) << 9) + (t >> 2);                    \
            tof[i] = (unsigned)(T0 * DM * 2);                                                                                                                                   \
            pg0[i] = *(const u32x4*)(wsb + (size_t)cur.ooff + tof[i] + cb); pg1[i] = *(const u32x4*)(wsb + (size_t)cur.ooff + (size_t)PART * 2 + (unsigned)(T1 * DM * 2) + cb); \
            pzz[i] = *(const u32x4*)(wsb + (size_t)cur.zoff + tof[i] + cb); } } while (0)
    if (MODE == 2) PREF(0);
#pragma unroll
    for (int hf = 0; hf < 2; ++hf) {
#pragma unroll
        for (int r = 0; r < 16; ++r) { const int orow = crow(r, hie);
#pragma unroll
            for (int dd = 0; dd < 2; ++dd) *(LAS unsigned short*)(stg + orow * OSTR + (dd * 32 + r32e) * 2) = (unsigned short)(cvt_pk_bf16(o[2 * hf + dd][r] * rl[r], 0.f) & 0xffffu); }
        LDS_WAIT();
        if (MODE == 2) {
            u32x4 vv[4];
#pragma unroll
            for (int i = 0; i < 4; ++i) { const int row = i * 8 + (lane2 >> 3), ch = lane2 & 7;
                u32x4 v = *(const LAS u32x4*)(stg + row * OSTR + ch * 16);
                const float a0 = al_l[row], a1 = al_l[32 + row]; const u32x4 g0 = pg0[i], g1 = pg1[i], z = pzz[i];
#define MRG(F) v.F = cvt_pk_bf16((bflo(v.F) + a0 * bflo(g0.F) + a1 * bflo(g1.F)) * silu_f(bflo(z.F)), (bfhi(v.F) + a0 * bfhi(g0.F) + a1 * bfhi(g1.F)) * silu_f(bfhi(z.F)));
                MRG(x) MRG(y) MRG(z) MRG(w)
#undef MRG
                vv[i] = v; }
            unsigned tsv[4];
#pragma unroll
            for (int i = 0; i < 4; ++i) tsv[i] = tof[i];
            if (hf == 0) PREF(1);
#pragma unroll
            for (int i = 0; i < 4; ++i) { const int ch = lane2 & 7; store_wt(wsw + (size_t)cur.goff + tsv[i] + (unsigned)((hf * 64 + ch * 8) * 2), vv[i]); }
        } else {
#pragma unroll
            for (int i = 0; i < 4; ++i) { const int row = i * 8 + (lane2 >> 3), ch = lane2 & 7;
                u32x4 v = *(const LAS u32x4*)(stg + row * OSTR + ch * 16);
                const unsigned go = (unsigned)((qlo + row) * DM * 2) + (unsigned)((hf * 64 + ch * 8) * 2);
                if (MODE == 1) { const u32x4 z = *(const u32x4*)(wsb + (size_t)cur.xoff + go);
                    v.x = cvt_pk_bf16(bflo(v.x) * silu_f(bflo(z.x)), bfhi(v.x) * silu_f(bfhi(z.x))); v.y = cvt_pk_bf16(bflo(v.y) * silu_f(bflo(z.y)), bfhi(v.y) * silu_f(bfhi(z.y)));
                    v.z = cvt_pk_bf16(bflo(v.z) * silu_f(bflo(z.z)), bfhi(v.z) * silu_f(bfhi(z.z))); v.w = cvt_pk_bf16(bflo(v.w) * silu_f(bflo(z.w)), bfhi(v.w) * silu_f(bfhi(z.w))); }
                store_wt(wsw + (size_t)cur.ooff + go, v); } }
        LDS_WAIT();
    }
#undef PREF
#undef RESC
#undef STEPX
}
#undef DMA_K
#undef DMA_V
#undef WAITBAR
#undef KSWZ
#undef SBAR
}

namespace fd {
using namespace fa;
using fc::Blk; using fc::Nxt; using fc::Ring; using fc::DmaLane; using fc::dma_lane; using fc::glds16; using fc::qkt_r; using fc::pv_r; using fc::tile_info; using fc::nx3;
using fc::R_K; using fc::R_V; using fc::R_WS; using fc::R_OST; using fc::OSTR; using fc::OSTW;
#define SBAR() __builtin_amdgcn_sched_barrier(0)
#define DMA_K(srcoff, kbrow, slot) do { const unsigned char* sb_ = wsb + ((size_t)(srcoff) + (size_t)(kbrow) * (DM * 2)); const unsigned ld_ = ldsb + R_K + (slot) * SHM_K + wid * 2048; \
        glds16(sb_, dl.vk0, ld_); glds16(sb_, dl.vk1, ld_ + 1024); } while (0)
#define DMA_V(srcoff, kbrow, slot) do { const unsigned char* sb_ = wsb + ((size_t)(srcoff) + (size_t)(kbrow) * (DM * 2)); const unsigned ld_ = ldsb + R_V + (slot) * SHM_V + wid * 2048; \
        glds16(sb_, dl.vv0, ld_); glds16(sb_, dl.vv1, ld_ + 1024); } while (0)
#define WAITBAR(N) asm volatile("s_waitcnt vmcnt(" #N ") lgkmcnt(0)\n\ts_barrier" ::: "memory")
__device__ __forceinline__ void softmax_tile(f32x16& p0, f32x16& p1, float& m_reg, float& l_reg, float& alpha, bf16x8& pa0, bf16x8& pa1, bf16x8& pa2, bf16x8& pa3) {
    partialSM(p0, p1, m_reg, alpha);
    finishSM(p0, p1, alpha, l_reg, pa0, pa1, pa2, pa3);
}
__device__ __forceinline__ void prime(const unsigned char* wsb, const Blk& cur, unsigned char* lds, bf16x8* qr, Ring& rg, int tid) {
    const int wid = __builtin_amdgcn_readfirstlane(tid >> 6), lane = tid & 63, r32 = lane & 31, hi = lane >> 5;
    const unsigned ldsb = (unsigned)(uintptr_t)((LAS unsigned char*)lds);
    const DmaLane dl = dma_lane(wid, lane);
    DMA_K(cur.koff, cur.kb0, 0); DMA_V(cur.voff, cur.kb0, 0); DMA_K(cur.koff, cur.kb0 + KVBLK, 1);
#pragma unroll
    for (int d0 = 0; d0 < 8; ++d0) qr[d0] = *(const bf16x8*)(wsb + (size_t)cur.qoff + (unsigned)(((wid * 32 + r32) * DM + d0 * 16 + hi * 8) * 2));
    rg.kt = 0;
    WAITBAR(0);
    if (wid >= 4) WAITBAR(0);
}
__device__ __forceinline__ void finish(int tid) {
    const int wid = __builtin_amdgcn_readfirstlane(tid >> 6);
    if (wid < 4) WAITBAR(0);
}
template <int MODE>
__device__ __forceinline__ void block(const unsigned char* wsb, const Blk& cur, const Nxt& nxt, bool has_next, unsigned sel, unsigned char* lds, bf16x8* qr, Ring& rg, int tid) {
    const int wid = __builtin_amdgcn_readfirstlane(tid >> 6), lane = tid & 63, r32 = lane & 31, hi = lane >> 5;
    const unsigned ldsb = (unsigned)(uintptr_t)((LAS unsigned char*)lds);
    const LAS char* K_lds = (const LAS char*)(LAS unsigned char*)lds + R_K;
    LAS float* wsf = (LAS float*)((LAS unsigned char*)lds + R_WS) + wid * fc::WSW; LAS float* li_l = wsf; LAS float* al_l = wsf + 32;
    const int vbl = (int)ldsb + R_V + v_rd_base(lane);
    const DmaLane dl = dma_lane(wid, lane);
    const int NT = cur.NT, qlo = cur.R0 + wid * 32, qm = qlo + r32 - 4 * hi;
    const float slopeL = cur.slopeL;
    float m_reg = -1e30f, l_reg = 0.f; f32x16 o[4] = {};
    int kt = rg.kt;
    f32x16 p0, p1; bf16x8 pa0, pa1, pa2, pa3; bool actP = false;
    for (int t = 0; t < NT; ++t) {
        const int kb_ = cur.kb0 + t * KVBLK; bool act, nd_, dd_; unsigned W_; tile_info(cur, kb_, qlo, r32, sel, act, nd_, W_, dd_);
        { const int s2_ = kt == 0 ? 2 : kt - 1, s1_ = nx3(kt);
          const bool in2_ = t + 2 < NT, in1_ = t + 1 < NT;
          if (in2_) DMA_K(cur.koff, kb_ + 2 * KVBLK, s2_); else if (has_next) DMA_K(nxt.koff, nxt.kb0 + (t + 2 - NT) * KVBLK, s2_);
          if (in1_) DMA_V(cur.voff, kb_ + KVBLK, s1_); else if (has_next) DMA_V(nxt.voff, nxt.kb0 + (t + 1 - NT) * KVBLK, s1_); }
        SBAR();
        if (act) { const float a0_ = dd_ ? -__builtin_inff() : slopeL * (float)(kb_ - qm);
#pragma unroll
            for (int r = 0; r < 16; ++r) { p0[r] = fmaf(slopeL, (float)((r & 3) + 8 * (r >> 2)), a0_); p1[r] = fmaf(slopeL, (float)((r & 3) + 8 * (r >> 2) + 32), a0_); }
            qkt_r(p0, p1, K_lds + kt * SHM_K, r32, hi, qr); }
        if (actP) pv_r(o, vbl + (kt == 0 ? 2 : kt - 1) * SHM_V, pa0, pa1, pa2, pa3);
        SBAR();
        if (t + 2 < NT || has_next) WAITBAR(4); else WAITBAR(0);
        if (act) { float alpha;
            if (nd_) mask_tile(p0, p1, qm - kb_, W_);
            softmax_tile(p0, p1, m_reg, l_reg, alpha, pa0, pa1, pa2, pa3);
            if (__any(alpha < 1.f)) { if (hi == 0) al_l[r32] = alpha; LDS_WAIT();
#pragma unroll
                for (int d_ = 0; d_ < 4; ++d_)
#pragma unroll
                    for (int r = 0; r < 16; ++r) o[d_][r] *= al_l[crow(r, hi)]; } }
        actP = act;
        SBAR();
        if (t + 2 < NT || has_next) WAITBAR(4); else WAITBAR(0);
        kt = nx3(kt);
    }
    if (actP) pv_r(o, vbl + (kt == 0 ? 2 : kt - 1) * SHM_V, pa0, pa1, pa2, pa3);
    SBAR();
    if (has_next) {
#pragma unroll
        for (int d0 = 0; d0 < 8; ++d0) qr[d0] = *(const bf16x8*)(wsb + (size_t)nxt.qoff + (unsigned)(((wid * 32 + r32) * DM + d0 * 16 + hi * 8) * 2));
    }
    SBAR();
    rg.kt = kt;
    if (has_next) WAITBAR(4); else WAITBAR(0);
    int tid2 = tid; asm volatile("" : "+v"(tid2));
    const int lane2 = tid2 & 63, r32e = lane2 & 31, hie = lane2 >> 5;
    if (hie == 0) li_l[r32e] = l_reg;
    LDS_WAIT();
    if (MODE == 0) { if (hie == 0) *(float*)(const_cast<unsigned char*>(wsb) + (size_t)cur.xoff + (unsigned)((qlo + r32e) * NH * 4)) = m_reg + log2f(l_reg); }
    LAS unsigned char* stg = (LAS unsigned char*)lds + R_OST + wid * OSTW;
    float rl[16];
#pragma unroll
    for (int r = 0; r < 16; ++r) rl[r] = __builtin_amdgcn_rcpf(li_l[crow(r, hie)]);
#pragma unroll
    for (int hf = 0; hf < 2; ++hf) {
#pragma unroll
        for (int r = 0; r < 16; ++r) { const int orow = crow(r, hie);
#pragma unroll
            for (int dd = 0; dd < 2; ++dd) *(LAS unsigned short*)(stg + orow * OSTR + (dd * 32 + r32e) * 2) = (unsigned short)(cvt_pk_bf16(o[2 * hf + dd][r] * rl[r], 0.f) & 0xffffu); }
        LDS_WAIT();
#pragma unroll
        for (int i = 0; i < 4; ++i) { const int row = i * 8 + (lane2 >> 3), ch = lane2 & 7;
            u32x4 v = *(const LAS u32x4*)(stg + row * OSTR + ch * 16);
            const unsigned go = (unsigned)(((qlo + row) * DM + hf * 64 + ch * 8) * 2);
            if (MODE == 1) { const u32x4 z = *(const u32x4*)(wsb + (size_t)cur.xoff + go);
                v.x = cvt_pk_bf16(bflo(v.x) * silu_f(bflo(z.x)), bfhi(v.x) * silu_f(bfhi(z.x))); v.y = cvt_pk_bf16(bflo(v.y) * silu_f(bflo(z.y)), bfhi(v.y) * silu_f(bfhi(z.y)));
                v.z = cvt_pk_bf16(bflo(v.z) * silu_f(bflo(z.z)), bfhi(v.z) * silu_f(bfhi(z.z))); v.w = cvt_pk_bf16(bflo(v.w) * silu_f(bflo(z.w)), bfhi(v.w) * silu_f(bfhi(z.w))); }
            *(u32x4*)(const_cast<unsigned char*>(wsb) + (size_t)cur.ooff + go) = v; }
        LDS_WAIT();
    }
    if (has_next) WAITBAR(4); else WAITBAR(0);
}
#undef DMA_K
#undef DMA_V
#undef WAITBAR
#undef SBAR
}

__device__ __forceinline__ fb::Blk blk_a(int it) {
    const int g = it >> 9, rem = it & 511, h = rem & 15, rb = rem < 256 ? (rem >> 4) : 31 - ((rem - 256) >> 4), lg = 2 * g, L = SEQ >> lg, R0 = rb * 256;
    int kb0 = R0 - 128; { const int s0 = R0 & ~(L - 1); if (kb0 < s0) kb0 = s0; }
    fb::Blk b;
    b.qoff = (unsigned)(WS_QKV + ((size_t)(3 * g) * PART + (size_t)R0 * DM + h * HD) * 2); b.koff = (unsigned)(WS_QKV + ((size_t)(3 * g + 1) * PART + h * HD) * 2); b.voff = (unsigned)(WS_QKV + ((size_t)(3 * g + 2) * PART + h * HD) * 2);
    b.ooff = (unsigned)(WS_OG + ((size_t)g * PART + h * HD) * 2); b.xoff = (unsigned)(WS_LSE + ((size_t)g * MTOK * NH + h) * 4);
    b.R0 = R0; b.kb0 = kb0; b.NT = (R0 + 256 - kb0) >> 6; b.slopeL = slope_of(h) * (float)(1 << lg) * LOG2E; b.L = L; b.base0 = 0;
    return b;
}
__device__ __forceinline__ void attn_a_pipe(unsigned char* lds, int wv) {
    CParams& P = PP();
    const int tid = otid(wv);
    const unsigned char* wsb = P.ws;
    constexpr int TOTAL = 3 * NH * (MTOK / 256);
    int it = obid(); if (it >= TOTAL) return;
    fb::Blk cur = blk_a(it);
    fb::Seam S;
    fb::prime(wsb, cur, lds, S, tid);
    for (;;) {
        const int itn = it + (int)gridDim.x; const bool last = itn >= TOTAL;
        const fb::Blk nb = last ? cur : blk_a(itn);
        const fb::Nxt nxt{nb.qoff, nb.koff, nb.voff, nb.kb0};
        fb::block<0>(wsb, cur, nxt, 0u, lds, S, tid);
        if (last) break;
        cur = nb; it = itn;
    }
}
__device__ __forceinline__ int vit_b(int it) { return (it < 256) ? ((it & 7) * 32 + (it >> 3)) : it; }
__device__ __forceinline__ fb::Blk blk_b(int it_, int pass) {
    const int it = vit_b(it_); const int bh = it >> 2, s = it & 3, b = bh >> 4, h = bh & 15, n = pass ? 7 - s : s, R0 = (b << 11) + (n << 8);
    fb::Blk k;
    k.qoff = (unsigned)(WS_QKV + ((size_t)R0 * DM + h * HD) * 2); k.koff = (unsigned)(WS_QKV + (PART + h * HD) * 2); k.voff = (unsigned)(WS_QKV + (2 * PART + h * HD) * 2);
    k.ooff = (unsigned)(WS_G + (size_t)(h * HD) * 2); k.xoff = (unsigned)(WS_Z + (size_t)(h * HD) * 2);
    k.R0 = R0; k.kb0 = b << 11; k.NT = 4 * (n + 1); k.slopeL = slope_of(h) * LOG2E; k.L = 0; k.base0 = b << 11;
    return k;
}
__device__ __forceinline__ unsigned moba_gate(const unsigned char* wsb, unsigned char* lds, int b, int h, int n, int R0, int tid) {
    unsigned sel = (1u << n) - 1u;
    if (n >= 4) {
        asm volatile("" : "+v"(tid));
        const bf16_t* QKV = (const bf16_t*)(wsb + WS_QKV); const float* KS = (const float*)(wsb + WS_KSUM);
        LAS float* gk = (LAS float*)((LAS unsigned char*)lds + fc::R_GK); LAS unsigned* sel_l = (LAS unsigned*)((LAS unsigned char*)lds + fc::R_SEL);
        for (int i = tid; i < n * 128; i += NTHREADS) { const float* kp = KS + (size_t)(b * 8 + (i >> 7)) * DM + h * HD + (i & 127); gk[i] = kp[0] + kp[(size_t)32 * DM]; }
        __syncthreads();
        const int row = tid >> 1, half = tid & 1;
        const u32x4* qp = (const u32x4*)(QKV + (size_t)(R0 + row) * DM + h * HD + half * 64);
        float gt[7];
#pragma unroll
        for (int j = 0; j < 7; ++j) gt[j] = 0.f;
#pragma unroll
        for (int c = 0; c < 8; ++c) { const u32x4 w = qp[c]; const float q0 = bflo(w.x), q1 = bfhi(w.x), q2 = bflo(w.y), q3 = bfhi(w.y), q4 = bflo(w.z), q5 = bfhi(w.z), q6 = bflo(w.w), q7 = bfhi(w.w);
#pragma unroll
            for (int j = 0; j < 7; ++j) if (j < n) { const LAS f32x4* kk = (const LAS f32x4*)(gk + j * 128 + half * 64 + c * 8); const f32x4 ka = kk[0], kb2 = kk[1];
                gt[j] += (q0 * ka.x + q1 * ka.y) + (q2 * ka.z + q3 * ka.w) + (q4 * kb2.x + q5 * kb2.y) + (q6 * kb2.z + q7 * kb2.w); } }
#pragma unroll
        for (int j = 0; j < 7; ++j) gt[j] += __shfl_xor(gt[j], 1);
        unsigned mask = 0;
#pragma unroll
        for (int j = 0; j < 7; ++j) if (j < n) { int rank = 0;
#pragma unroll
            for (int j2 = 0; j2 < 7; ++j2) if (j2 < n && (gt[j2] > gt[j] || (gt[j2] == gt[j] && j2 < j))) ++rank;
            if (rank < 3) mask |= 1u << j; }
        if (half == 0) sel_l[row] = mask;
        __syncthreads();
        sel = sel_l[(tid >> 6) * 32 + (tid & 31)];
    }
    return sel;
}
__device__ __forceinline__ void attn_b_pipe(unsigned char* lds, int wv) {
    CParams& P = PP();
    const int tid = otid(wv);
    const unsigned char* wsb = P.ws;
    constexpr int TOTAL = NB * NH * 4;
    int it = obid(); if (it >= TOTAL) return;
    int pass = 0;
    fb::Blk cur = blk_b(it, 0);
    fb::Seam S;
    fb::prime(wsb, cur, lds, S, tid);
    for (;;) {
        int itn = it, passn = pass + 1; if (passn == 2) { passn = 0; itn = it + (int)gridDim.x; }
        const bool last = itn >= TOTAL;
        const fb::Blk nb = last ? cur : blk_b(itn, passn);
        const fb::Nxt nxt{nb.qoff, nb.koff, nb.voff, nb.kb0};
        const int vi = vit_b(it), bh = vi >> 2, s = vi & 3, n = pass ? 7 - s : s;
        const unsigned sel = moba_gate(wsb, lds, bh >> 4, bh & 15, n, cur.R0, tid);
        fb::block<1>(wsb, cur, nxt, sel, lds, S, tid);
        if (last) break;
        cur = nb; it = itn; pass = passn;
    }
}

__device__ __forceinline__ fc::Blk cblk_a(int it) { const fb::Blk b = blk_a(it); const int h = it & 15, g = it >> 9;
    fc::Blk c{b.qoff, b.koff, b.voff, b.ooff, b.xoff, 0u, 0u, b.R0, b.kb0, b.NT, b.slopeL, b.L, b.base0};
    if (g == 2) { c.ooff = (unsigned)(WS_OG + (size_t)(h * HD) * 2); c.xoff = (unsigned)(WS_LSE + (size_t)h * 4); c.zoff = (unsigned)(WS_Z + (size_t)(h * HD) * 2); c.goff = (unsigned)(WS_G + (size_t)(h * HD) * 2); }
    return c; }
__device__ __forceinline__ fc::Blk cblk_b(int it, int pass) { const fb::Blk b = blk_b(it, pass); return fc::Blk{b.qoff, b.koff, b.voff, b.ooff, b.xoff, 0u, 0u, b.R0, b.kb0, b.NT, b.slopeL, b.L, b.base0}; }
template <int MODE>
__device__ __forceinline__ void attn_a_dma(unsigned char* lds, int wv, int first, int count) {
    CParams& P = PP();
    const int tid = otid(wv);
    const unsigned char* wsb = P.ws;
    int it = obid(); if (it >= count) return;
    fc::Blk cur = cblk_a(first + it);
    bf16x8 qr[8]; fc::Ring rg;
    fc::prime(wsb, cur, lds, qr, rg, tid);
    for (;;) {
        const int itn = it + (int)gridDim.x; const bool last = itn >= count;
        const fc::Blk nb = last ? cur : cblk_a(first + itn);
        const fc::Nxt nxt{nb.qoff, nb.koff, nb.voff, nb.kb0};
        fc::block<MODE>(wsb, cur, nxt, !last, 0u, lds, qr, rg, tid);
        if (last) break;
        cur = nb; it = itn;
    }
}
__device__ __forceinline__ void attn_b_dma(unsigned char* lds, int wv) {
    CParams& P = PP();
    const int tid = otid(wv);
    const unsigned char* wsb = P.ws;
    constexpr int TOTAL = NB * NH * 4;
    int it = obid(); if (it >= TOTAL) return;
    int pass = 0;
    fc::Blk cur = cblk_b(it, 0);
    bf16x8 qr[8]; fc::Ring rg;
    fc::prime(wsb, cur, lds, qr, rg, tid);
    for (;;) {
        int itn = it, passn = pass + 1; if (passn == 2) { passn = 0; itn = it + (int)gridDim.x; }
        const bool last = itn >= TOTAL;
        const fc::Blk nb = last ? cur : cblk_b(itn, passn);
        const fc::Nxt nxt{nb.qoff, nb.koff, nb.voff, nb.kb0};
        const int vi = vit_b(it), bh = vi >> 2, s = vi & 3, n = pass ? 7 - s : s;
        const unsigned sel = moba_gate(wsb, lds, bh >> 4, bh & 15, n, cur.R0, tid);
        fc::block<1>(wsb, cur, nxt, !last, sel, lds, qr, rg, tid);
        if (last) break;
        cur = nb; it = itn; pass = passn;
    }
}

__device__ __forceinline__ unsigned moba_gate2(const unsigned char* wsb, unsigned char* lds, int b, int h, int n, int R0, int tid) {
    unsigned sel = (1u << n) - 1u;
    if (n >= 4) {
        asm volatile("" : "+v"(tid));
        const int grp = tid >> 8, tin = tid & 255;
        const bf16_t* QKV = (const bf16_t*)(wsb + WS_QKV); const float* KS = (const float*)(wsb + WS_KSUM);
        LAS float* gk = (LAS float*)((LAS unsigned char*)lds + fc::R_GK) + grp * (7 * 128); LAS unsigned* sel_l = (LAS unsigned*)((LAS unsigned char*)lds + fc::R_SEL);
        for (int i = tin; i < n * 128; i += 256) { const float* kp = KS + (size_t)(b * 8 + (i >> 7)) * DM + h * HD + (i & 127); gk[i] = kp[0] + kp[(size_t)32 * DM]; }
        __syncthreads();
        const int row = grp * 128 + (tin >> 1), half = tin & 1;
        const u32x4* qp = (const u32x4*)(QKV + (size_t)(R0 + row) * DM + h * HD + half * 64);
        float gt[7];
#pragma unroll
        for (int j = 0; j < 7; ++j) gt[j] = 0.f;
#pragma unroll
        for (int c = 0; c < 8; ++c) { const u32x4 w = qp[c]; const float q0 = bflo(w.x), q1 = bfhi(w.x), q2 = bflo(w.y), q3 = bfhi(w.y), q4 = bflo(w.z), q5 = bfhi(w.z), q6 = bflo(w.w), q7 = bfhi(w.w);
#pragma unroll
            for (int j = 0; j < 7; ++j) if (j < n) { const LAS f32x4* kk = (const LAS f32x4*)(gk + j * 128 + half * 64 + c * 8); const f32x4 ka = kk[0], kb2 = kk[1];
                gt[j] += (q0 * ka.x + q1 * ka.y) + (q2 * ka.z + q3 * ka.w) + (q4 * kb2.x + q5 * kb2.y) + (q6 * kb2.z + q7 * kb2.w); } }
#pragma unroll
        for (int j = 0; j < 7; ++j) gt[j] += __shfl_xor(gt[j], 1);
        unsigned mask = 0;
#pragma unroll
        for (int j = 0; j < 7; ++j) if (j < n) { int rank = 0;
#pragma unroll
            for (int j2 = 0; j2 < 7; ++j2) if (j2 < n && (gt[j2] > gt[j] || (gt[j2] == gt[j] && j2 < j))) ++rank;
            if (rank < 3) mask |= 1u << j; }
        if (half == 0) sel_l[row] = mask;
        __syncthreads();
        sel = sel_l[(tid >> 6) * 32 + (tid & 31)];
    }
    return sel;
}
__device__ __forceinline__ void attn_a_hs(unsigned char* lds, int wv) {
    CParams& P = PP();
    const int tid = otid(wv);
    const unsigned char* wsb = P.ws;
    constexpr int TOTAL = 3 * NH * (MTOK / 256);
    int it = obid(); if (it >= TOTAL) return;
    fc::Blk cur = cblk_a(it);
    bf16x8 qr[8]; fc::Ring rg;
    fd::prime(wsb, cur, lds, qr, rg, tid);
    for (;;) {
        const int itn = it + (int)gridDim.x; const bool last = itn >= TOTAL;
        const fc::Blk nb = last ? cur : cblk_a(itn);
        const fc::Nxt nxt{nb.qoff, nb.koff, nb.voff, nb.kb0};
        fd::block<0>(wsb, cur, nxt, !last, 0u, lds, qr, rg, tid);
        if (last) break;
        cur = nb; it = itn;
    }
    fd::finish(tid);
}
__device__ __forceinline__ void attn_b_hs(unsigned char* lds, int wv) {
    CParams& P = PP();
    const int tid = otid(wv);
    const unsigned char* wsb = P.ws;
    constexpr int TOTAL = NB * NH * 4;
    int it = obid(); if (it >= TOTAL) return;
    int pass = 0;
    fc::Blk cur = cblk_b(it, 0);
    bf16x8 qr[8]; fc::Ring rg;
    fd::prime(wsb, cur, lds, qr, rg, tid);
    for (;;) {
        int itn = it, passn = pass + 1; if (passn == 2) { passn = 0; itn = it + (int)gridDim.x; }
        const bool last = itn >= TOTAL;
        const fc::Blk nb = last ? cur : cblk_b(itn, passn);
        const fc::Nxt nxt{nb.qoff, nb.koff, nb.voff, nb.kb0};
        const int vi = vit_b(it), bh = vi >> 2, s = vi & 3, n = pass ? 7 - s : s;
        const unsigned sel = moba_gate2(wsb, lds, bh >> 4, bh & 15, n, cur.R0, tid);
        fd::block<1>(wsb, cur, nxt, !last, sel, lds, qr, rg, tid);
        if (last) break;
        cur = nb; it = itn; pass = passn;
    }
    fd::finish(tid);
}

__device__ __forceinline__ void attn_a_flash(unsigned char* lds, int wv) {
    CParams& P = PP();
    const int tid = otid(wv);
    const bf16_t* QKV = (const bf16_t*)(P.ws + WS_QKV); bf16_t* OG = (bf16_t*)(P.ws + WS_OG); float* LSE = (float*)(P.ws + WS_LSE);
    for (int it = obid(); it < 3 * NH * (MTOK / 256); it += gridDim.x) {
        const int g = it >> 9, rem = it & 511, h = rem & 15, rb = rem >> 4;
        const int lg = 2 * g, L = SEQ >> lg, R0 = rb * 256;
        int krow0 = R0 - 128; { const int s0 = R0 & ~(L - 1); if (krow0 < s0) krow0 = s0; }
        const int NT = (R0 + 256 - krow0) >> 6;
        const fa::MaskA mk{L};
        fa::flash_block<0>(QKV + (size_t)(3 * g) * PART + (size_t)R0 * DM + h * HD, QKV + (size_t)(3 * g + 1) * PART + h * HD, QKV + (size_t)(3 * g + 2) * PART + h * HD,
                           krow0, NT, R0, slope_of(h) * (float)(1 << lg) * LOG2E, mk, lds, OG + (size_t)g * PART + h * HD, LSE + (size_t)g * MTOK * NH + h, nullptr, tid);
    }
}
__device__ __forceinline__ void attn_b_flash(unsigned char* lds, int wv) {
    CParams& P = PP();
    const int tid = otid(wv);
    const bf16_t* QKV = (const bf16_t*)(P.ws + WS_QKV); const bf16_t* Z = (const bf16_t*)(P.ws + WS_Z); bf16_t* G = (bf16_t*)(P.ws + WS_G); const float* KS = (const float*)(P.ws + WS_KSUM);
    LAS float* gk = (LAS float*)((LAS unsigned char*)lds + fa::OFF_GK); LAS unsigned* sel_l = (LAS unsigned*)((LAS unsigned char*)lds + fa::OFF_SEL);
    for (int it = obid(); it < NB * NH * 4; it += gridDim.x) {
        const int bh = it >> 2, s = it & 3, b = bh >> 4, h = bh & 15;
        for (int pass = 0; pass < 2; ++pass) {
            const int n = pass ? 7 - s : s, R0 = (b << 11) + (n << 8);
            unsigned sel = (1u << n) - 1u;
            if (n >= 4) {
                for (int i = tid; i < n * 128; i += NTHREADS) { const float* kp = KS + (size_t)(b * 8 + (i >> 7)) * DM + h * HD + (i & 127); gk[i] = kp[0] + kp[(size_t)32 * DM]; }
                __syncthreads();
                const int row = tid >> 1, half = tid & 1;
                const u32x4* qp = (const u32x4*)(QKV + (size_t)(R0 + row) * DM + h * HD + half * 64);
                float gt[7];
#pragma unroll
                for (int j = 0; j < 7; ++j) gt[j] = 0.f;
#pragma unroll
                for (int c = 0; c < 8; ++c) { const u32x4 w = qp[c]; const float q0 = bflo(w.x), q1 = bfhi(w.x), q2 = bflo(w.y), q3 = bfhi(w.y), q4 = bflo(w.z), q5 = bfhi(w.z), q6 = bflo(w.w), q7 = bfhi(w.w);
#pragma unroll
                    for (int j = 0; j < 7; ++j) if (j < n) { const LAS f32x4* kk = (const LAS f32x4*)(gk + j * 128 + half * 64 + c * 8); const f32x4 ka = kk[0], kb2 = kk[1];
                        gt[j] += (q0 * ka.x + q1 * ka.y) + (q2 * ka.z + q3 * ka.w) + (q4 * kb2.x + q5 * kb2.y) + (q6 * kb2.z + q7 * kb2.w); } }
#pragma unroll
                for (int j = 0; j < 7; ++j) gt[j] += __shfl_xor(gt[j], 1);
                unsigned mask = 0;
#pragma unroll
                for (int j = 0; j < 7; ++j) if (j < n) { int rank = 0;
#pragma unroll
                    for (int j2 = 0; j2 < 7; ++j2) if (j2 < n && (gt[j2] > gt[j] || (gt[j2] == gt[j] && j2 < j))) ++rank;
                    if (rank < 3) mask |= 1u << j; }
                if (half == 0) sel_l[row] = mask;
                __syncthreads();
                sel = sel_l[(tid >> 6) * 32 + (tid & 31)];
            }
            const fa::MaskB mk{R0, b << 11, sel};
            fa::flash_block<1>(QKV + (size_t)R0 * DM + h * HD, QKV + PART + h * HD, QKV + 2 * PART + h * HD, b << 11, 4 * (n + 1), R0, slope_of(h) * LOG2E, mk, lds,
                               G + h * HD, nullptr, Z + h * HD, tid);
        }
    }
}

#define XB_TMO      128
#define XB_XCNT(j)  (256  + 64 * (j))
#define XB_XSUB(j)  (1280 + 64 * (j))
#define XB_XGEN(j)  (2304 + 64 * (j))
#define XB_TOP      3328
#define XB_TOPGEN   3392
#define XCD_BAR_WORDS 3456
#define XB_SPIN_CAP (1u << 20)
__device__ __forceinline__ unsigned xb_ld(unsigned* p)              { return __hip_atomic_load(p, __ATOMIC_RELAXED, __HIP_MEMORY_SCOPE_AGENT); }
__device__ __forceinline__ unsigned xb_add(unsigned* p, unsigned v) { return __hip_atomic_fetch_add(p, v, __ATOMIC_RELAXED, __HIP_MEMORY_SCOPE_AGENT); }
__device__ __forceinline__ unsigned xb_xcc_id() { return (unsigned)__builtin_amdgcn_s_getreg((3 << 11) | 20) & 0xFu; }
#define XB_SPIN(cond, bar) do { unsigned _sp = 0; while (cond) { __builtin_amdgcn_s_sleep(1); \
    if ((++_sp & 255u) == 0u) { if (xb_ld(&(bar)[XB_TMO])) break; if (_sp > XB_SPIN_CAP) { atomicAdd(&(bar)[XB_TMO], 1u); break; } } } } while (0)
struct XcdBarrier { unsigned* bar; unsigned x; volatile LAS unsigned* st; };
__device__ __forceinline__ XcdBarrier xcd_barrier_post(unsigned* bar, volatile LAS unsigned* st) {
    XcdBarrier b; b.bar = bar; b.x = xb_xcc_id(); b.st = st;
    if (threadIdx.x == 0) (void)xb_add(&bar[XB_XCNT(b.x)], 1u);
    return b;
}
__device__ __forceinline__ void xcd_barrier_complete(unsigned* bar, unsigned x, unsigned& nloc, unsigned& nx) {
    const unsigned G = gridDim.x * gridDim.y * gridDim.z;
    unsigned sum, cnt, mine, sp = 0u;
    for (;;) {
        sum = 0u; cnt = 0u; mine = 0u;
#pragma unroll
        for (unsigned j = 0; j < 16; ++j) { const unsigned c = xb_ld(&bar[XB_XCNT(j)]); sum += c; cnt += (c > 0u) ? 1u : 0u; mine = (j == x) ? c : mine; }
        if (sum == G) break;
        __builtin_amdgcn_s_sleep(1);
        if ((++sp & 255u) == 0u) { if (xb_ld(&bar[XB_TMO])) break; if (sp > XB_SPIN_CAP) { atomicAdd(&bar[XB_TMO], 1u); break; } }
    }
    nloc = mine > 0u ? mine : 1u; nx = cnt > 0u ? cnt : 1u;
}
__device__ __forceinline__ void xcd_barrier(const XcdBarrier& b) {
    asm volatile("s_waitcnt vmcnt(0)" ::: "memory");
    __syncthreads();
    if (threadIdx.x == 0) {
        unsigned* bar = b.bar;
        __builtin_amdgcn_s_waitcnt(0);
        unsigned nloc = b.st[0], nx = b.st[1];
        if (nloc == 0u) { xcd_barrier_complete(bar, b.x, nloc, nx); b.st[0] = nloc; b.st[1] = nx; }
        const unsigned old = xb_add(&bar[XB_XSUB(b.x)], 1u);
        const unsigned gen = old / nloc;
        if (old + 1u == (gen + 1u) * nloc) {
            __builtin_amdgcn_fence(__ATOMIC_RELEASE, "agent");
            asm volatile("s_waitcnt vmcnt(0)" ::: "memory");
            const unsigned og = xb_add(&bar[XB_TOP], 1u);
            const unsigned tg = og / nx;
            if (og + 1u == (tg + 1u) * nx) xb_add(&bar[XB_TOPGEN], 1u);
            else XB_SPIN(xb_ld(&bar[XB_TOPGEN]) == tg, bar);
            __builtin_amdgcn_fence(__ATOMIC_ACQUIRE, "agent");
            asm volatile("s_waitcnt vmcnt(0)" ::: "memory");
            xb_add(&bar[XB_XGEN(b.x)], 1u);
            asm volatile("s_waitcnt vmcnt(0)" ::: "memory");
        } else {
            asm volatile("buffer_inv sc1" ::: "memory");
            XB_SPIN(xb_ld(&bar[XB_XGEN(b.x)]) == gen, bar);
            asm volatile("s_waitcnt vmcnt(0)" ::: "memory");
        }
    }
    __syncthreads();
}

#define GSYNC() do { XcdBarrier xb_; xb_.bar = (unsigned*)(PP().ws + WS_CTL); xb_.x = xb_xcc_id(); xb_.st = bst; xcd_barrier(xb_); } while (0)
template <int LAYER>
__device__ __forceinline__ void run_layer(unsigned char* lds, LAS unsigned char* lds3, volatile LAS unsigned* bst, int wv) {
    constexpr int layer = LAYER;
        const bool isA = (layer & 1) == 0; const int j = layer >> 1;
#if FUSE_NORM
        if (layer == 0) {
#endif
        norm_phase(layer, !isA && !MOBA_QK_I8, wv);
#if PROBE == 2
        norm_phase(layer, !isA && !MOBA_QK_I8, wv);
#endif
#if PROBE == 6
        GSYNC(); GSYNC(); GSYNC(); GSYNC(); GSYNC();
#endif
        GSYNC();
#if FUSE_NORM
        }
#endif
        {
#if !MOBA_QK_I8
            if (!isA) {
                unsigned char* ws = PP().ws;
                pg8::Gemm g{ws + WS_H, ws + WS_WBQK + (size_t)j * 4096 * DM * 2, MTOK, 4096, DM * 2};
                pg8::StaticOrder S; S.init(MTOK, 4096, (int)gridDim.x, obid());
                pg8::Epi E{1, 0, (bf16_t*)(ws + WS_QKV), (bf16_t*)(ws + WS_Z), (float*)(ws + WS_KSUM), nullptr, nullptr, nullptr, nullptr, nullptr};
                pg8::gemm_phase<pg8::Epi, pg8::StaticOrder, GEMM_ALIGN, GEMM_SP2, false>(lds3, g, S, E, wv);
            }
#endif
            {
                unsigned char* ws = PP().ws;
#if MOBA_QK_I8
                pg8::Gemm g{ws + WS_HQ, isA ? ws + WS_WAIN + (size_t)j * A_N * DM : ws + WS_WBQK + (size_t)j * B_N * DM, MTOK, isA ? (SPLIT_INPROJ ? 12288 : A_N) : B_N, DM};
                pg8::StaticOrder S; S.init(MTOK, g.N, (int)gridDim.x, obid());
                pg8::Epi E{isA ? 0 : 1, 0, (bf16_t*)(ws + WS_QKV), (bf16_t*)(ws + WS_Z), (float*)(ws + WS_KSUM), (const float*)(ws + WS_RS),
                           isA ? (const float*)(ws + WS_CSA) + j * A_N : (const float*)(ws + WS_CSB) + j * B_N, nullptr, nullptr, nullptr};
#else
                pg8::Gemm g{ws + WS_HQ, isA ? ws + WS_WAIN + (size_t)j * A_N * DM : ws + WS_WBVZ + (size_t)j * 4096 * DM, MTOK, isA ? A_N : 4096, DM};
                pg8::StaticOrder S; S.init(MTOK, g.N, (int)gridDim.x, obid());
                pg8::Epi E{isA ? 0 : 1, isA ? 0 : 2, (bf16_t*)(ws + WS_QKV), (bf16_t*)(ws + WS_Z), nullptr, (const float*)(ws + WS_RS),
                           isA ? (const float*)(ws + WS_CSA) + j * A_N : (const float*)(ws + WS_CSB) + j * 4096, nullptr, nullptr, nullptr};
#endif
#if STAGGER_TICKS > 0
                if (isA) {
                    const unsigned long long t0_ = __builtin_amdgcn_s_memrealtime(); const unsigned long long dl_ = (unsigned long long)((obid() >> 3) & 7) * STAGGER_TICKS;
                    while (__builtin_amdgcn_s_memrealtime() - t0_ < dl_) __builtin_amdgcn_s_sleep(8);
                }
#endif
                pg8::gemm_phase<pg8::Epi, pg8::StaticOrder, GEMM_ALIGN, GEMM_SP2, true>(lds3, g, S, E, wv);
#if PROBE == 7
                pg8::gemm_phase<pg8::Epi, pg8::StaticOrder, GEMM_ALIGN, GEMM_SP2, true>(lds3, g, S, E, wv);
#endif
#if PROBE == 12 || PROBE == 13
                if (isA) { pg8::Epi E3 = E; E3.mode = PROBE == 12 ? 6 : 7; E3.qkv = (bf16_t*)(ws + WS_OG); pg8::gemm_phase<pg8::Epi, pg8::StaticOrder, GEMM_ALIGN, GEMM_SP2, true>(lds3, g, S, E3, wv); }
#endif
#if PROBE == 10 || PROBE == 11
                if (isA) { pg8::Epi E3 = E; E3.mode = PROBE == 10 ? 4 : 5; E3.qkv = (bf16_t*)(ws + WS_OG); pg8::gemm_phase<pg8::Epi, pg8::StaticOrder, GEMM_ALIGN, GEMM_SP2, true>(lds3, g, S, E3, wv); }
#endif
#if PROBE == 9
                { pg8::Epi E3 = E; E3.mode = 3; pg8::gemm_phase<pg8::Epi, pg8::StaticOrder, GEMM_ALIGN, GEMM_SP2, true>(lds3, g, S, E3, wv); }
#endif
            }
        }
        GSYNC();
#if PROBE == 3
        if (isA) attn_a_dma<0>(lds, wv, 0, 1024);
#endif
#if PROBE == 4
        if (!isA) attn_b_hs(lds, wv);
#endif
#if ATTN_HS
        if (isA) { attn_a_hs(lds, wv); GSYNC(); combine_phase(wv);
#elif ATTN_DMA
#if FUSE_COMBINE && !OUTA_I8
        if (isA) { attn_a_dma<0>(lds, wv, 0, 1024);
#if SPLIT_INPROJ
            {
                __syncthreads();
                unsigned char* ws = PP().ws;
                pg8::Gemm g{ws + WS_HQ, ws + WS_WAIN + (size_t)j * A_N * DM + (size_t)12288 * DM, MTOK, 8192, DM};
                pg8::StaticOrder S; S.init(MTOK, g.N, (int)gridDim.x, obid());
                pg8::Epi E{0, 6, (bf16_t*)(ws + WS_QKV), (bf16_t*)(ws + WS_Z), (float*)(ws + WS_KSUM), (const float*)(ws + WS_RS), (const float*)(ws + WS_CSA) + j * A_N + 12288, nullptr, nullptr, nullptr};
                pg8::gemm_phase<pg8::Epi, pg8::StaticOrder, GEMM_ALIGN, GEMM_SP2, true>(lds3, g, S, E, wv);
            }
#endif
            GSYNC(); attn_a_dma<2>(lds, wv, 1024, 512);
#if PROBE == 14
            attn_a_dma<2>(lds, wv, 1024, 512);
#endif
#else
        if (isA) { attn_a_dma<0>(lds, wv, 0, 1536); GSYNC(); combine_phase(wv);
#endif
#elif ATTN_PIPE
        if (isA) { attn_a_pipe(lds, wv); GSYNC(); combine_phase(wv);
#else
        if (isA) { attn_a_flash(lds, wv); GSYNC(); combine_phase(wv);
#endif
#if PROBE == 5
            combine_phase(wv);
#endif
        }
#if ATTN_HS
        else { attn_b_hs(lds, wv); }
#elif ATTN_DMA
        else { attn_b_dma(lds, wv); }
#elif ATTN_PIPE
        else { attn_b_pipe(lds, wv); }
#else
        else { attn_b_flash(lds, wv); }
#endif
        GSYNC();
        {
            CParams& P = PP(); unsigned char* ws = P.ws;
            const bool i8o = OUTA_I8 && isA;
            pg8::Gemm g{i8o ? ws + WS_HQ : ws + WS_G, isA ? ws + WS_WAOUT + (size_t)j * DM * DM * (OUTA_I8 ? 1 : 2) : ws + WS_WBOUT + (size_t)j * DM * DM * 2, MTOK, DM, i8o ? DM : DM * 2};
            pg8::StaticOrder S; S.init(MTOK, DM, (int)gridDim.x, obid());
            pg8::Epi E{2, 0, nullptr, nullptr, nullptr, (const float*)(ws + WS_RS), (const float*)(ws + WS_CSO) + j * DM, layer == 0 ? P.x : P.out, P.out, (const float*)(ws + WS_MOD) + (size_t)layer * 4 * 6144 + 4096};
            {
                pg8::Unit u0; int ui = 0;
                while (S.next(ui, u0)) { const int t_ = otid(wv); const int w_ = __builtin_amdgcn_readfirstlane(t_ >> 6);
                    if (LAYER == 0) { const float* xt = E.xin + (size_t)(u0.pm * 256 + (t_ >> 1)) * DM + u0.pn * 256 + (t_ & 1) * 128;
#pragma unroll
                        for (int q = 0; q < 4; ++q) __builtin_amdgcn_global_load_lds((const unsigned*)(xt + q * 32), (LAS unsigned*)(lds3 + 131072 + w_ * 1024 + q * 256), 4, 0, 0); }
                    else { const bf16_t* xt = (const bf16_t*)(ws + WS_XB) + (size_t)(u0.pm * 256 + (t_ >> 1)) * DM + u0.pn * 256 + (t_ & 1) * 128;
#pragma unroll
                        for (int q = 0; q < 2; ++q) __builtin_amdgcn_global_load_lds((const unsigned*)(xt + q * 64), (LAS unsigned*)(lds3 + 131072 + w_ * 1024 + q * 256), 4, 0, 0); }
                    ++ui; } }
#if FUSE_NORM && !OUTA_I8
            {
                const bool lastl = layer == DEPTH - 1; const float* MODp = (const float*)(ws + WS_MOD);
                float* MODn = const_cast<float*>(MODp) + (size_t)(layer + 1) * 4 * 6144; unsigned* cn = (unsigned*)(ws + WS_CTL + 65536) + (size_t)layer * 32 * 128;
                constexpr bool xinb = LAYER > 0; const void* xin_ = xinb ? (const void*)(ws + WS_XB) : (const void*)P.x;
                if (lastl) { pg8::EpiOutF<true, xinb> EF{xin_, (void*)P.out, E.gate, P.final_w, nullptr, nullptr, ws + WS_HQ, (float*)(ws + WS_RS), (float*)(ws + WS_XS), cn};
                    pg8::gemm_phase<pg8::EpiOutF<true, xinb>, pg8::StaticOrder, GEMM_ALIGN, GEMM_SP2, false>(lds3, g, S, EF, wv); }
                else { pg8::EpiOutF<false, xinb> EF{xin_, (void*)(ws + WS_XB), E.gate, P.norm_w + (layer + 1) * DM, MODn + DM, MODn, ws + WS_HQ, (float*)(ws + WS_RS), (float*)(ws + WS_XS), cn};
                    pg8::gemm_phase<pg8::EpiOutF<false, xinb>, pg8::StaticOrder, GEMM_ALIGN, GEMM_SP2, false>(lds3, g, S, EF, wv); }
            }
#else
#if OUTA_I8
            if (isA) pg8::gemm_phase<pg8::Epi, pg8::StaticOrder, GEMM_ALIGN, GEMM_SP2, true>(lds3, g, S, E, wv);
            else
#endif
            pg8::gemm_phase<pg8::Epi, pg8::StaticOrder, GEMM_ALIGN, GEMM_SP2, false>(lds3, g, S, E, wv);
#endif
        }
#if FUSE_NORM && !OUTA_I8
        if (layer + 1 < DEPTH) GSYNC();
#else
        GSYNC();
#endif
    }

__global__ void __launch_bounds__(NTHREADS, 2) fwd_mega(Params Pin) {
    extern __shared__ __attribute__((aligned(16))) unsigned char lds[];
#if USE_CG_SYNC
    cg::grid_group grid = cg::this_grid();
#endif
    LAS unsigned char* lds3 = (LAS unsigned char*)lds;
    (void)Pin;
    const int wv = __builtin_amdgcn_readfirstlane((int)threadIdx.x >> 6);
    volatile LAS unsigned* bst = (volatile LAS unsigned*)(lds3 + (LDS_BYTES - 64));
    if (threadIdx.x < 2) bst[threadIdx.x] = 0u;
    __syncthreads();
    (void)xcd_barrier_post((unsigned*)(PP().ws + WS_CTL), bst);
    p0_mod(lds, wv);
    p0_weights(lds, wv);
#if PROBE == 1
    __syncthreads(); p0_mod(lds, wv); p0_weights(lds, wv);
#endif
#if USE_CG_SYNC
    grid.sync();
#else
    GSYNC();
#endif
    run_layer<0>(lds, lds3, bst, wv); run_layer<1>(lds, lds3, bst, wv); run_layer<2>(lds, lds3, bst, wv); run_layer<3>(lds, lds3, bst, wv);
#if !(FUSE_NORM && !OUTA_I8)
    final_norm_phase(wv);
#endif
}

extern "C" void kernel_launch(void* const* d_in, const int* in_sizes, int n_in, void* d_out, int out_size, void* d_ws, size_t ws_size, hipStream_t stream) {
    static int grid = 0;
    if (grid == 0) {
        if (n_in != 10 || in_sizes[0] != MTOK * DM || out_size != MTOK * DM || ws_size < WS_END) {
            fprintf(stderr, "kernel_launch: unexpected shapes/workspace (n_in %d, in0 %d, out %d, ws %zu, need %zu)\n", n_in, n_in > 0 ? in_sizes[0] : -1, out_size, ws_size, (size_t)WS_END); grid = -1; return; }
        int dev = 0, cus = 0, per_cu = 0;
        (void)hipGetDevice(&dev); (void)hipDeviceGetAttribute(&cus, hipDeviceAttributeMultiprocessorCount, dev);
        if (hipFuncSetAttribute((const void*)fwd_mega, hipFuncAttributeMaxDynamicSharedMemorySize, LDS_BYTES) != hipSuccess) { fprintf(stderr, "kernel_launch: hipFuncSetAttribute failed\n"); grid = -1; return; }
        if (hipOccupancyMaxActiveBlocksPerMultiprocessor(&per_cu, (const void*)fwd_mega, NTHREADS, LDS_BYTES) != hipSuccess || per_cu < 1) { fprintf(stderr, "kernel_launch: occupancy query says %d\n", per_cu); (void)hipGetLastError(); per_cu = 1; }
        if (per_cu > 1) per_cu = 1;
        grid = cus * per_cu;
    }
    if (grid < 0) return;
    (void)hipMemsetAsync((char*)d_ws + WS_CTL, 0, 65536 + 4 * 32 * 128 * 4, stream);
    Params p{};
    p.x = (const float*)d_in[0]; p.c = (const float*)d_in[1]; p.norm_w = (const float*)d_in[2]; p.mod_w = (const float*)d_in[3]; p.mod_b = (const float*)d_in[4];
    p.a_w_in = (const float*)d_in[5]; p.a_w_out = (const float*)d_in[6]; p.b_w_in = (const float*)d_in[7]; p.b_w_out = (const float*)d_in[8]; p.final_w = (const float*)d_in[9];
    p.out = (float*)d_out; p.ws = (unsigned char*)d_ws;
    void* args[] = {&p};
    hipError_t e = hipLaunchCooperativeKernel((const void*)fwd_mega, dim3(grid), dim3(NTHREADS), args, LDS_BYTES, stream);
    if (e != hipSuccess) fprintf(stderr, "kernel_launch: cooperative launch failed: %s (grid %d)\n", hipGetErrorString(e), grid);
}
```
